# Optimizing an MI355X kernel written in HIP

```python
import math
import jax, jax.numpy as jnp
from jax import lax
import numpy as np

D_MODEL = 1024
BATCH = 8
SEQ = 8192
DEPTH = 2

GRID_W = 64
NORM_EPS = 1e-6
NEG_INF = -1e30

HY_D = D_MODEL // 4
HY_EMB = 33
HY_BANDS = (HY_EMB - 1) // 2
HY_FFN = 64
HY_MIN_DECAY = math.log(1e-2) / 1.5
HY_MAX_DECAY = math.log(1e-2) / 0.3

RW_N = 64
RW_D = D_MODEL // 2
RW_H = RW_D // RW_N
RW_W_LORA = 64
RW_A_LORA = 64
RW_G_LORA = 128
RW_GN_EPS = 64e-5

NA_HD = 64
NA_D = D_MODEL // 4
NA_H = NA_D // NA_HD
NA_KR = 8
NA_KC = 16

MIX_D = HY_D + RW_D + NA_D
IN_SIZES = (3 * HY_D, 3 * RW_D, RW_G_LORA, 2 * RW_W_LORA, 2 * RW_A_LORA, 3 * NA_D)
IN_D = sum(IN_SIZES)

MOE_GROUPS = 4
MOE_PER_GROUP = 8
MOE_EXPERTS = MOE_GROUPS * MOE_PER_GROUP
MOE_TOPK = 2
MOE_FF = 512
MOE_BLOCK = 256

kernel_name = 'hybrid_hyena_rwkv7_natten_hmoe_encoder'


def rmsnorm(x, g):
    x32 = x.astype(jnp.float32)
    y = x32 * lax.rsqrt(jnp.mean(x32 * x32, axis=-1, keepdims=True) + NORM_EPS)
    return y.astype(x.dtype) * g


def shift_prev(u):
    return jnp.pad(u, ((0, 0), (1, 0), (0, 0)))[:, :-1]


def shift_next(u):
    return jnp.pad(u, ((0, 0), (0, 1), (0, 0)))[:, 1:]


def hyena_positional_features(L):
    t = jnp.linspace(0.0, 1.0, L, dtype=jnp.float32)[:, None]
    w = (2.0 * math.pi / L) * jnp.arange(L, dtype=jnp.float32)[:, None]
    f = jnp.linspace(1e-4, HY_BANDS - 1, HY_BANDS, dtype=jnp.float32)[None, :]
    z = jnp.concatenate([t, jnp.cos(f * w), -jnp.sin(f * w)], axis=-1)
    return z, t


def hyena_filters(z, t, w1, b1, w2, b2, w3, b3, wout, freq):
    f32 = jnp.float32
    fr = freq.astype(f32)
    act = lambda u: jnp.sin(fr * u)
    h = act(z @ w1.astype(f32) + b1.astype(f32))
    h = act(h @ w2.astype(f32) + b2.astype(f32))
    h = act(h @ w3.astype(f32) + b3.astype(f32))
    h = (h @ wout.astype(f32)).reshape(-1, 2, HY_D)
    deltas = jnp.abs(jnp.linspace(HY_MIN_DECAY, HY_MAX_DECAY, HY_D, dtype=f32))
    h = h * jnp.exp(-t[:, :, None] * deltas)
    return h * lax.rsqrt(jnp.sum(h * h, axis=(0, 1), keepdims=True) + 1e-6)


def hyena_mixer(u, conv_w, conv_b, filt, skip):
    up = jnp.pad(u, ((0, 0), (1, 1), (0, 0)))
    uc = up[:, :-2] * conv_w[0] + up[:, 1:-1] * conv_w[1] + up[:, 2:] * conv_w[2] + conv_b
    x0, x1, v = jnp.split(uc, 3, axis=-1)
    z = (v * x1).astype(jnp.float32)
    L = z.shape[1]
    k2 = jnp.concatenate([filt[:1, 0] + filt[:1, 1], filt[1:, 0],
                          jnp.zeros((1, HY_D), jnp.float32), filt[1:, 1][::-1]], axis=0)
    y = jnp.fft.irfft(jnp.fft.rfft(z, n=2 * L, axis=1) * jnp.fft.rfft(k2, axis=0)[None],
                      n=2 * L, axis=1)[:, :L]
    y = y + z * skip.astype(jnp.float32)
    return (x0.astype(jnp.float32) * y).astype(u.dtype)


def wkv7_scan(r, w, k, v, a, b, reverse):
    Bn, L, H, N = r.shape
    xs = tuple(jnp.moveaxis(u, 1, 0) for u in (r, w, k, v, a, b))

    def step(S, inp):
        rt, wt, kt, vt, at, bt = inp
        sa = jnp.einsum('bhvk,bhk->bhv', S, at)
        S = S * wt[:, :, None, :] + sa[..., None] * bt[:, :, None, :] + vt[..., None] * kt[:, :, None, :]
        return S, jnp.einsum('bhvk,bhk->bhv', S, rt)

    _, y = lax.scan(step, jnp.zeros((Bn, H, N, N), jnp.float32), xs, reverse=reverse)
    return jnp.moveaxis(y, 0, 1)


def rwkv7_mixer(r, k, v, g_lo, w_lo, a_lo, mu, w0, w2, a0, a2, k_k, k_a, r_k, g2, ln_w, ln_b):
    f32 = jnp.float32
    Bn, L, C = r.shape

    def tshift(u, m):
        return u + m[0] * (shift_prev(u) - u) + m[1] * (shift_next(u) - u)

    r, k, v = (tshift(u, m).astype(f32) for u, m in zip((r, k, v), mu))
    w_lo = w_lo.astype(f32).reshape(Bn, L, 2, RW_W_LORA)
    a_lo = a_lo.astype(f32).reshape(Bn, L, 2, RW_A_LORA)
    w_log = -jax.nn.softplus(-(w0.astype(f32) + jnp.einsum('bldr,drc->bldc', jnp.tanh(w_lo), w2.astype(f32)))) - 0.5
    decay = jnp.exp(-jnp.exp(w_log))
    a = jax.nn.sigmoid(a0.astype(f32) + jnp.einsum('bldr,drc->bldc', a_lo, a2.astype(f32)))
    heads = lambda u: u.reshape(u.shape[:-1] + (RW_H, RW_N))
    kk = heads(k * k_k.astype(f32))
    kk = (kk * lax.rsqrt(jnp.maximum(jnp.sum(kk * kk, axis=-1, keepdims=True), 1e-24))).reshape(Bn, L, C)
    k_dir = k[:, :, None] * (1.0 + (a - 1.0) * k_a.astype(f32))
    rh, vh = heads(r), heads(v)
    y_f = wkv7_scan(rh, heads(decay[:, :, 0]), heads(k_dir[:, :, 0]), vh, heads(-kk), heads(kk * a[:, :, 0]), False)
    y_b = wkv7_scan(rh, heads(decay[:, :, 1]), heads(k_dir[:, :, 1]), vh, heads(-kk), heads(kk * a[:, :, 1]), True)
    y = y_f + y_b
    mean = jnp.mean(y, axis=-1, keepdims=True)
    var = jnp.mean(jnp.square(y - mean), axis=-1, keepdims=True)
    y = ((y - mean) * lax.rsqrt(var + RW_GN_EPS)).reshape(Bn, L, C) * ln_w.astype(f32) + ln_b.astype(f32)
    bonus = jnp.sum(rh * heads(k_dir[:, :, 0] + k_dir[:, :, 1]) * r_k.astype(f32), axis=-1, keepdims=True) * vh
    gate = jax.nn.sigmoid(g_lo.astype(f32)) @ g2.astype(f32)
    return ((y + bonus.reshape(Bn, L, C)) * gate).astype(g_lo.dtype)


def neighborhood_attention(q, k, v, rpb):
    Bn, L, H, Dh = q.shape
    R = L // GRID_W
    KR = min(NA_KR, R)
    f32 = jnp.float32
    grid = lambda u: u.reshape(Bn, R, GRID_W, H, Dh)
    rows = jnp.arange(R)
    row_idx = jnp.clip(rows - KR // 2, 0, R - KR)[:, None] + jnp.arange(KR)[None, :]
    k_rows = grid(k)[:, row_idx]
    v_rows = grid(v)[:, row_idx]
    cols = jnp.arange(GRID_W)
    col_start = jnp.clip(cols - NA_KC // 2, 0, GRID_W - NA_KC)
    in_band = (cols[None, :] >= col_start[:, None]) & (cols[None, :] < col_start[:, None] + NA_KC)
    dr = row_idx - rows[:, None] + (NA_KR - 1)
    dc = jnp.clip(cols[None, :] - cols[:, None], -(NA_KC - 1), NA_KC - 1) + (NA_KC - 1)
    bias = rpb.astype(f32)[:, dr[:, None, :, None], dc[None, :, None, :]]
    bias = jnp.where(in_band[None, None, :, None, :], bias, NEG_INF)
    s = jnp.einsum('brqhd,brikhd->bhrqik', grid(q).astype(f32), k_rows.astype(f32)) * (Dh ** -0.5)
    p = jax.nn.softmax(s + bias[None], axis=(-2, -1))
    o = jnp.einsum('bhrqik,brikhd->brqhd', p, v_rows.astype(f32))
    return o.reshape(Bn, L, H * Dh).astype(q.dtype)


def hier_moe(h, wg, bg, we, be, w1, w3, w2):
    N, Dm = h.shape
    f32 = jnp.float32
    h32 = h.astype(f32)
    g_logits = h32 @ wg.astype(f32) + bg.astype(f32)
    g_sel = jnp.argmax(g_logits, axis=-1)
    g_prob = jnp.take_along_axis(jax.nn.softmax(g_logits, axis=-1), g_sel[:, None], axis=-1)
    e_logits = (h32 @ we.astype(f32) + be.astype(f32)).reshape(N, MOE_GROUPS, MOE_PER_GROUP)
    e_logits = jnp.take_along_axis(e_logits, g_sel[:, None, None], axis=1)[:, 0]
    top_val, top_idx = lax.top_k(e_logits, MOE_TOPK)
    gate = g_prob * jax.nn.softmax(top_val, axis=-1)
    expert = g_sel[:, None] * MOE_PER_GROUP + top_idx
    M = N * MOE_TOPK
    flat_e = expert.reshape(M)
    order = jnp.argsort(flat_e)
    e_sorted = flat_e[order]
    counts = jnp.bincount(flat_e, length=MOE_EXPERTS)
    padded = (counts + MOE_BLOCK - 1) // MOE_BLOCK * MOE_BLOCK
    pad_end = jnp.cumsum(padded)
    first = (jnp.cumsum(counts) - counts)[e_sorted]
    slot = (pad_end - padded)[e_sorted] + jnp.arange(M) - first
    n_blocks = -(-M // MOE_BLOCK) + MOE_EXPERTS
    slot_src = jnp.full((n_blocks * MOE_BLOCK,), M, jnp.int32).at[slot].set(order.astype(jnp.int32))
    tok_src = jnp.append(jnp.arange(M, dtype=jnp.int32) // MOE_TOPK, N)[slot_src].reshape(n_blocks, MOE_BLOCK)
    w_src = jnp.append(gate.reshape(M), 0.0)[slot_src].reshape(n_blocks, MOE_BLOCK)
    block_e = jnp.minimum(jnp.searchsorted(pad_end, jnp.arange(n_blocks) * MOE_BLOCK, side='right'),
                          MOE_EXPERTS - 1)
    h_pad = jnp.concatenate([h, jnp.zeros((1, Dm), h.dtype)], axis=0)

    def expert_block(args):
        tok, wt, e = args
        xb = h_pad[tok]
        yb = (jax.nn.silu(xb @ w1[e]) * (xb @ w3[e])) @ w2[e]
        return yb * wt[:, None].astype(yb.dtype)

    y = lax.map(expert_block, (tok_src, w_src, block_e))
    return jnp.zeros((N + 1, Dm), h.dtype).at[tok_src.reshape(-1)].add(y.reshape(-1, Dm))[:N]


def setup_inputs(seed: int = 0) -> dict:
    key = jax.random.key(seed)
    ks = iter(jax.random.split(key, 48))

    def nrm(shape, scale):
        return scale * jax.random.normal(next(ks), shape, jnp.float32)

    Ld = DEPTH
    w0_ramp = jnp.linspace(-6.0, -1.0, RW_D, dtype=jnp.float32)
    return {
        'x': nrm((BATCH, SEQ, D_MODEL), 1.0),
        'norm1_g': 1.0 + nrm((Ld, D_MODEL), 0.05),
        'w_in': nrm((Ld, D_MODEL, IN_D), D_MODEL ** -0.5),
        'hy_conv_w': nrm((Ld, 3, 3 * HY_D), 3 ** -0.5),
        'hy_conv_b': nrm((Ld, 3 * HY_D), 0.1),
        'hy_w1': nrm((Ld, HY_EMB, HY_FFN), HY_EMB ** -0.5),
        'hy_b1': nrm((Ld, HY_FFN), 0.1),
        'hy_w2': nrm((Ld, HY_FFN, HY_FFN), HY_FFN ** -0.5),
        'hy_b2': nrm((Ld, HY_FFN), 0.1),
        'hy_w3': nrm((Ld, HY_FFN, HY_FFN), HY_FFN ** -0.5),
        'hy_b3': nrm((Ld, HY_FFN), 0.1),
        'hy_wout': nrm((Ld, HY_FFN, 2 * HY_D), HY_FFN ** -0.5),
        'hy_freq': 1.0 + nrm((Ld, HY_FFN), 0.1),
        'hy_skip': nrm((Ld, HY_D), 0.5),
        'rw_mu': jax.random.uniform(next(ks), (Ld, 3, 2, RW_D), jnp.float32, 0.0, 0.5),
        'rw_w0': w0_ramp + nrm((Ld, 2, RW_D), 0.1),
        'rw_w2': nrm((Ld, 2, RW_W_LORA, RW_D), 0.1 * RW_W_LORA ** -0.5),
        'rw_a0': nrm((Ld, 2, RW_D), 0.1),
        'rw_a2': nrm((Ld, 2, RW_A_LORA, RW_D), 0.1 * RW_A_LORA ** -0.5),
        'rw_kk': 0.85 + nrm((Ld, RW_D), 0.05),
        'rw_ka': 1.0 + nrm((Ld, RW_D), 0.05),
        'rw_rk': nrm((Ld, RW_H, RW_N), 0.1),
        'rw_g2': nrm((Ld, RW_G_LORA, RW_D), RW_G_LORA ** -0.5),
        'rw_ln_w': 1.0 + nrm((Ld, RW_D), 0.05),
        'rw_ln_b': nrm((Ld, RW_D), 0.01),
        'na_rpb': nrm((Ld, NA_H, 2 * NA_KR - 1, 2 * NA_KC - 1), 0.02),
        'w_out': nrm((Ld, MIX_D, D_MODEL), MIX_D ** -0.5),
        'norm2_g': 1.0 + nrm((Ld, D_MODEL), 0.05),
        'moe_wg': nrm((Ld, D_MODEL, MOE_GROUPS), D_MODEL ** -0.5),
        'moe_bg': nrm((Ld, MOE_GROUPS), 0.01),
        'moe_we': nrm((Ld, D_MODEL, MOE_EXPERTS), D_MODEL ** -0.5),
        'moe_be': nrm((Ld, MOE_EXPERTS), 0.01),
        'moe_w1': nrm((Ld, MOE_EXPERTS, D_MODEL, MOE_FF), D_MODEL ** -0.5),
        'moe_w3': nrm((Ld, MOE_EXPERTS, D_MODEL, MOE_FF), D_MODEL ** -0.5),
        'moe_w2': nrm((Ld, MOE_EXPERTS, MOE_FF, D_MODEL), MOE_FF ** -0.5),
        'norm_f_g': 1.0 + nrm((D_MODEL,), 0.05),
    }


def reference(x, norm1_g, w_in, hy_conv_w, hy_conv_b, hy_w1, hy_b1, hy_w2, hy_b2, hy_w3, hy_b3,
              hy_wout, hy_freq, hy_skip, rw_mu, rw_w0, rw_w2, rw_a0, rw_a2, rw_kk, rw_ka, rw_rk,
              rw_g2, rw_ln_w, rw_ln_b, na_rpb, w_out, norm2_g, moe_wg, moe_bg, moe_we, moe_be,
              moe_w1, moe_w3, moe_w2, norm_f_g):
    Bn, L, _ = x.shape
    z_pos, t_pos = hyena_positional_features(L)
    splits = np.cumsum(IN_SIZES)[:-1].tolist()
    for l in range(DEPTH):
        h = rmsnorm(x, norm1_g[l])
        proj = h @ w_in[l]
        hy_u, rw_rkv, rw_g, rw_w, rw_a, na_qkv = jnp.split(proj, splits, axis=-1)
        filt = hyena_filters(z_pos, t_pos, hy_w1[l], hy_b1[l], hy_w2[l], hy_b2[l],
                             hy_w3[l], hy_b3[l], hy_wout[l], hy_freq[l])
        y_hy = hyena_mixer(hy_u, hy_conv_w[l], hy_conv_b[l], filt, hy_skip[l])
        r, k, v = jnp.split(rw_rkv, 3, axis=-1)
        y_rw = rwkv7_mixer(r, k, v, rw_g, rw_w, rw_a, rw_mu[l], rw_w0[l], rw_w2[l], rw_a0[l],
                           rw_a2[l], rw_kk[l], rw_ka[l], rw_rk[l], rw_g2[l], rw_ln_w[l], rw_ln_b[l])
        q, kn, vn = (u.reshape(Bn, L, NA_H, NA_HD) for u in jnp.split(na_qkv, 3, axis=-1))
        y_na = neighborhood_attention(q, kn, vn, na_rpb[l])
        x = x + jnp.concatenate([y_hy, y_rw, y_na], axis=-1) @ w_out[l]
        h = rmsnorm(x, norm2_g[l]).reshape(Bn * L, D_MODEL)
        x = x + hier_moe(h, moe_wg[l], moe_bg[l], moe_we[l], moe_be[l],
                         moe_w1[l], moe_w3[l], moe_w2[l]).reshape(Bn, L, D_MODEL)
    return rmsnorm(x, norm_f_g)
```

```cpp
#include <hip/hip_runtime.h>
#include <hip/hip_cooperative_groups.h>
#include <cstdio>
#include <cstdint>
namespace cg = cooperative_groups;

#define LAS __attribute__((address_space(3)))
typedef unsigned short bf16_t;
typedef short bf16x8 __attribute__((ext_vector_type(8)));
typedef float f32x4 __attribute__((ext_vector_type(4)));
typedef float f32x2 __attribute__((ext_vector_type(2)));
typedef unsigned u32x4 __attribute__((ext_vector_type(4)));
typedef unsigned u32x2 __attribute__((ext_vector_type(2)));

constexpr int D = 1024, NB = 8, L = 8192, NT = NB * L, DEPTH = 2;
constexpr int IN_D = 3456, IN_DP = 3584;
constexpr int C_HX0 = 0, C_HX1 = 256, C_HV = 512, C_RR = 768, C_RK = 1280, C_RV = 1792, C_RG = 2304, C_RW = 2432, C_RA = 2560, C_NQ = 2688, C_NK = 2944, C_NV = 3200;
constexpr int NEXP = 32, FF = 512;
constexpr float NORM_EPS = 1e-6f;

constexpr size_t MiB = 1u << 20;
constexpr size_t OFF_CTL = 0;
constexpr size_t OFF_WTIN = 1 * MiB;
constexpr size_t OFF_WTOUT = 15 * MiB;
constexpr size_t OFF_RS = 19 * MiB;
constexpr size_t OFF_RGW = 20 * MiB;
constexpr size_t OFF_LTOK = 21 * MiB;
constexpr size_t OFF_LGATE = 29 * MiB;
constexpr size_t OFF_FILT = 37 * MiB;
constexpr size_t OFF_MOEW = 69 * MiB;
constexpr size_t OFF_W13T = OFF_MOEW, OFF_W2T = OFF_MOEW + 64 * MiB;
constexpr size_t OFF_ZT = OFF_MOEW;
constexpr size_t OFF_YT = OFF_MOEW + 32 * MiB;
constexpr size_t OFF_XB = 165 * MiB;
constexpr size_t OFF_MIX = 869 * MiB;
constexpr size_t OFF_PROJ = 293 * MiB;
constexpr size_t OFF_ACT = OFF_PROJ;
constexpr size_t OFF_YBUF = OFF_PROJ + 136 * MiB;
constexpr size_t OFF_YF = 741 * MiB;
constexpr size_t OFF_YB = 805 * MiB;
constexpr size_t OFF_BON = 997 * MiB;
constexpr size_t OFF_LRS = 1001 * MiB;
constexpr size_t WS_END = 1009 * MiB;
constexpr int LCAP = 65536;

constexpr int LDS_BYTES = 147456;
constexpr int NTHREADS = 512;

struct Params { const float* in[36]; float* out; unsigned char* ws; };

__device__ __forceinline__ float bf2f(unsigned b) { return __uint_as_float(b << 16); }
typedef __bf16 bf16x2_t __attribute__((ext_vector_type(2)));
__device__ __forceinline__ unsigned f2bf(float f) { return (unsigned)__builtin_bit_cast(unsigned short, (__bf16)f); }
__device__ __forceinline__ unsigned pk2(float lo, float hi) { const f32x2 v = {lo, hi}; return __builtin_bit_cast(unsigned, __builtin_convertvector(v, bf16x2_t)); }
#define DPPF(v, ctrl) __int_as_float(__builtin_amdgcn_update_dpp(0, __float_as_int(v), (ctrl), 0xF, 0xF, true))
__device__ __forceinline__ float rdlane(float v, int l) { return __int_as_float(__builtin_amdgcn_readlane(__float_as_int(v), l)); }
__device__ __forceinline__ float wave_sum(float v) {
    v += DPPF(v, 0xB1); v += DPPF(v, 0x4E); v += DPPF(v, 0x141); v += DPPF(v, 0x140);
    return (rdlane(v, 0) + rdlane(v, 16)) + (rdlane(v, 32) + rdlane(v, 48));
}
__device__ __forceinline__ float sum8(float v) { v += DPPF(v, 0xB1); v += DPPF(v, 0x4E); v += DPPF(v, 0x141); return v; }
__device__ __forceinline__ void unpack8(const u32x4 w, float* f) {
    f[0] = bf2f(w.x & 0xffffu); f[1] = __uint_as_float(w.x & 0xffff0000u);
    f[2] = bf2f(w.y & 0xffffu); f[3] = __uint_as_float(w.y & 0xffff0000u);
    f[4] = bf2f(w.z & 0xffffu); f[5] = __uint_as_float(w.z & 0xffff0000u);
    f[6] = bf2f(w.w & 0xffffu); f[7] = __uint_as_float(w.w & 0xffff0000u);
}
__device__ __forceinline__ float frcp(float x) { return __builtin_amdgcn_rcpf(x); }
__device__ __forceinline__ float ftanh(float x) { const float e = __expf(2.0f * x); return 1.0f - 2.0f * frcp(e + 1.0f); }
#define LDS_WAIT() asm volatile("s_waitcnt lgkmcnt(0)" ::: "memory")
__device__ __forceinline__ int opaque_tid(int wvx) { int ln; asm volatile("v_mbcnt_lo_u32_b32 %0, -1, 0\n\tv_mbcnt_hi_u32_b32 %0, -1, %0" : "=v"(ln)); return wvx * 64 + ln; }

namespace pg8 {
constexpr int BM = 256, BK = 64, HALF = 128, HTB = HALF * BK * 2, STAGE_BYTES = 8 * HTB;
__device__ __forceinline__ int lds_byte(int r, int c) { const int st = (r >> 4) * 2 + (c >> 5), rr = r & 15, cc = c & 31, ob = rr * 64 + cc * 2; return st * 1024 + (ob ^ (((ob >> 9) & 1) << 5)); }
__device__ __forceinline__ void stage_rc(int b, int& R, int& C) { const int st = b / 1024, sb = b % 1024, swz = sb ^ (((sb >> 9) & 1) << 5); R = (st >> 1) * 16 + swz / 64; C = (st & 1) * 32 + (swz % 64) / 2; }
__device__ __forceinline__ int perm32(int rho) { const int n = rho >> 4, i = rho & 15; return 8 * (i >> 2) + 4 * n + (i & 3); }
__device__ __forceinline__ unsigned cvt_pk_bf16(float lo, float hi) { return pk2(lo, hi); }

struct Unit { const char* A; const char* B; int pm, pn, e, cnt; };

template <class Epi, class Sched, bool GATHER>
__device__ __forceinline__ void gemm_phase(LAS unsigned char* lds, const int K, const Sched& S, const Epi& E, const int wvx) {
    const int tid = opaque_tid(wvx), wid = __builtin_amdgcn_readfirstlane(tid >> 6), lane = tid & 63, wr = wid >> 2, wc = wid & 3, fr = lane & 15, fq = lane >> 4;
    const int nt = K / BK;
    int Rr[2], Cc[2];
    unsigned voffB[2];
#pragma unroll
    for (int i = 0; i < 2; ++i) { stage_rc(tid * 16 + i * 8192, Rr[i], Cc[i]); const int Rb = Epi::PERM ? ((Rr[i] & ~31) + perm32(Rr[i] & 31)) : Rr[i];
        voffB[i] = (unsigned)(Rb * K + Cc[i]) * 2u; }
    const size_t kstep = (size_t)(BK * 2);
    const size_t hstep = (size_t)HALF * K * 2;
    const unsigned ldsw = (unsigned)wid * 1024u;
    const int aoff = lds_byte(wr * 64 + fr, fq * 8), boff = lds_byte(wc * 32 + fr, fq * 8);
#define PG8_SA(b, h) (((b) * 2 + (h)) * HTB)
#define PG8_SB(b, h) ((4 + (b) * 2 + (h)) * HTB)
#define PG8_STAGE(bufoff, gbase, voff) do { _Pragma("unroll") for (int _i = 0; _i < 2; ++_i) \
        __builtin_amdgcn_global_load_lds((const unsigned*)((const char*)(gbase) + (voff)[_i]), (LAS unsigned*)(lds + (bufoff) + ldsw + _i * 8192), 16, 0, 0); } while (0)
#define PG8_LDA(dst, b, h) do { _Pragma("unroll") for (int m = 0; m < 4; ++m) _Pragma("unroll") for (int k = 0; k < 2; ++k) dst[m][k] = *(const LAS bf16x8*)(lds + PG8_SA(b, h) + aoff + m * 2048 + k * 1024); } while (0)
#define PG8_LDB(dst, b, h) do { _Pragma("unroll") for (int n = 0; n < 2; ++n) _Pragma("unroll") for (int k = 0; k < 2; ++k) dst[n][k] = *(const LAS bf16x8*)(lds + PG8_SB(b, h) + boff + n * 2048 + k * 1024); } while (0)
#define PG8_MMA(ai, bj, At, Bt) do { __builtin_amdgcn_s_setprio(1); _Pragma("unroll") for (int m = 0; m < 4; ++m) _Pragma("unroll") for (int n = 0; n < 2; ++n) _Pragma("unroll") for (int k = 0; k < 2; ++k) \
        acc[ai][bj][m][n] = __builtin_amdgcn_mfma_f32_16x16x32_bf16(Bt[n][k], At[m][k], acc[ai][bj][m][n], 0, 0, 0); __builtin_amdgcn_s_setprio(0); } while (0)
#define PG8_WAIT_V(n) asm volatile("s_waitcnt vmcnt(" #n ")" ::: "memory")
#define PG8_WAIT_L(n) asm volatile("s_waitcnt lgkmcnt(" #n ")" ::: "memory")
#define PG8_BAR __builtin_amdgcn_s_barrier()
#define PG8_SCHED __builtin_amdgcn_sched_barrier(0)
    Unit cur, nxt; int ui = 0;
    if (!S.next(0, cur)) return;
    f32x4 acc[2][2][4][2];
#pragma unroll
    for (int a = 0; a < 2; ++a)
#pragma unroll
        for (int b = 0; b < 2; ++b)
#pragma unroll
            for (int m = 0; m < 4; ++m)
#pragma unroll
                for (int n = 0; n < 2; ++n) acc[a][b][m][n] = (f32x4){0.f, 0.f, 0.f, 0.f};
    bf16x8 At[4][2], B0[2][2], B1[2][2];
    typename Epi::Pre epre;
    unsigned vA[2][2];
    LAS u32x4* stash = (LAS u32x4*)(lds + STAGE_BYTES) + tid;
    if (GATHER) S.aoff(cur, tid, vA);
    else {
#pragma unroll
        for (int h = 0; h < 2; ++h)
#pragma unroll
            for (int i = 0; i < 2; ++i) vA[h][i] = (unsigned)((h * HALF + Rr[i]) * K + Cc[i]) * 2u;
    }
    const char* cA = cur.A; const char* cB = cur.B;
    PG8_STAGE(PG8_SB(0, 0), cB, voffB); PG8_STAGE(PG8_SB(0, 1), cB + hstep, voffB); PG8_STAGE(PG8_SA(0, 0), cA, vA[0]); PG8_STAGE(PG8_SA(0, 1), cA, vA[1]);
    if (wr == 1) PG8_BAR;
    PG8_WAIT_V(2); PG8_BAR;
    PG8_STAGE(PG8_SB(1, 0), cB + kstep, voffB); PG8_STAGE(PG8_SA(1, 0), cA + kstep, vA[0]); PG8_STAGE(PG8_SB(1, 1), cB + hstep + kstep, voffB);
    PG8_WAIT_V(6); PG8_BAR;
    for (;;) {
        const bool has_next = S.next(ui + 1, nxt);
        const char* nA = has_next ? nxt.A : cA; const char* nB = has_next ? nxt.B : cB;
        if (GATHER) { unsigned vn[2][2];
            if (has_next) { S.aoff(nxt, tid, vn); *stash = (u32x4){vn[0][0], vn[0][1], vn[1][0], vn[1][1]}; }
            else *stash = (u32x4){vA[0][0], vA[0][1], vA[1][0], vA[1][1]}; }
        for (int t = 0; t < nt; t += 2) {
            const bool last = (t == nt - 2);
            const char* a1 = cA + (size_t)(t + 1) * kstep;
            const char* a2 = last ? nA : cA + (size_t)(t + 2) * kstep; const char* b2 = last ? nB : cB + (size_t)(t + 2) * kstep;
            const char* a3 = a2 + kstep; const char* b3 = b2 + kstep;
            if (last) E.prefetch(epre, cur, wr, wc, fr, fq);
            PG8_LDB(B0, 0, 0); PG8_LDB(B1, 0, 1); PG8_SCHED; PG8_LDA(At, 0, 0); PG8_STAGE(PG8_SA(1, 1), a1, vA[1]);
            if (GATHER && last) { const u32x4 sv = *stash; vA[0][0] = sv.x; vA[0][1] = sv.y; vA[1][0] = sv.z; vA[1][1] = sv.w; }
            PG8_WAIT_V(8); PG8_WAIT_L(0); PG8_BAR; PG8_MMA(0, 0, At, B0); PG8_MMA(0, 1, At, B1); PG8_BAR; PG8_SCHED;
            PG8_LDA(At, 0, 1); PG8_STAGE(PG8_SB(0, 0), b2, voffB); PG8_STAGE(PG8_SB(0, 1), b2 + hstep, voffB); PG8_STAGE(PG8_SA(0, 0), a2, vA[0]);
            PG8_WAIT_V(8); PG8_WAIT_L(0); PG8_BAR; PG8_MMA(1, 0, At, B0); PG8_MMA(1, 1, At, B1); PG8_BAR; PG8_SCHED;
            PG8_LDB(B0, 1, 0); PG8_LDB(B1, 1, 1); PG8_SCHED; PG8_LDA(At, 1, 0); PG8_STAGE(PG8_SA(0, 1), a2, vA[1]);
            PG8_WAIT_V(8); PG8_WAIT_L(0); PG8_BAR; PG8_MMA(0, 0, At, B0); PG8_MMA(0, 1, At, B1); PG8_BAR; PG8_SCHED;
            PG8_LDA(At, 1, 1); PG8_STAGE(PG8_SB(1, 0), b3, voffB); PG8_STAGE(PG8_SB(1, 1), b3 + hstep, voffB); PG8_STAGE(PG8_SA(1, 0), a3, vA[0]);
            PG8_WAIT_V(8); PG8_WAIT_L(0); PG8_BAR; PG8_MMA(1, 0, At, B0); PG8_MMA(1, 1, At, B1); PG8_BAR; PG8_SCHED;
        }
        if (wr == 0) PG8_BAR;
        {
            Unit eu = cur; int efr = fr, efq = fq;
            eu.pm = __builtin_amdgcn_readfirstlane(eu.pm); eu.pn = __builtin_amdgcn_readfirstlane(eu.pn); eu.e = __builtin_amdgcn_readfirstlane(eu.e); eu.cnt = __builtin_amdgcn_readfirstlane(eu.cnt);
            asm volatile("" : "+s"(eu.pm), "+s"(eu.pn), "+s"(eu.e), "+s"(eu.cnt), "+v"(efr), "+v"(efq));
            E(acc, eu, wr, wc, efr, efq, epre);
        }
        if (!has_next) break;
#pragma unroll
        for (int a = 0; a < 2; ++a)
#pragma unroll
            for (int b = 0; b < 2; ++b)
#pragma unroll
                for (int m = 0; m < 4; ++m)
#pragma unroll
                    for (int n = 0; n < 2; ++n) acc[a][b][m][n] = (f32x4){0.f, 0.f, 0.f, 0.f};
        cur = nxt; cA = nA; cB = nB; ++ui;
        if (wr == 1) PG8_BAR;
    }
    PG8_WAIT_V(0);
    PG8_BAR;
#undef PG8_SA
#undef PG8_SB
#undef PG8_STAGE
#undef PG8_LDA
#undef PG8_LDB
#undef PG8_MMA
#undef PG8_WAIT_V
#undef PG8_WAIT_L
#undef PG8_BAR
#undef PG8_SCHED
}
}

struct DenseSched {
    const bf16_t* A; const bf16_t* Bt; int K, nM, nN, nwg, G, c;
    __device__ void init(const bf16_t* A_, const bf16_t* Bt_, int M, int N, int K_, int G_, int c_) { A = A_; Bt = Bt_; K = K_; nM = M / 256; nN = N / 256; nwg = nM * nN; G = G_; c = c_; }
    __device__ __forceinline__ bool next(int i, pg8::Unit& u) const {
        const long Lx = (long)i * G + c; if (Lx >= nwg) return false;
        int wgid = (int)Lx; { const int q = nwg / 8, r = nwg % 8, xcd = wgid % 8, off = wgid / 8; wgid = (xcd < r ? xcd * (q + 1) : r * (q + 1) + (xcd - r) * q) + off; }
        const int nig = 8 * nN, gid = wgid / nig, fm = gid * 8, gsz = (nM - fm) < 8 ? (nM - fm) : 8;
        u.pm = fm + ((wgid % nig) % gsz); u.pn = (wgid % nig) / gsz; u.e = 0; u.cnt = 0;
        u.A = (const char*)A + (size_t)u.pm * 256 * K * 2; u.B = (const char*)Bt + (size_t)u.pn * 256 * K * 2; return true;
    }
    __device__ __forceinline__ void aoff(const pg8::Unit&, int, unsigned (&)[2][2]) const {}
};
struct MoeSched {
    const bf16_t* A; const bf16_t* Bt; size_t bstride;
    const int* ltok;
    LAS int* tp;
    int K, G, c, total;
    __device__ void init(const int* cnt_, const bf16_t* A_, const bf16_t* Bt_, size_t bstride_, const int* ltok_, int K_, int G_, int c_, LAS int* lds_tab, int tid) {
        A = A_; Bt = Bt_; bstride = bstride_; ltok = ltok_; K = K_; G = G_; c = (G_ % 8 == 0) ? (c_ & 7) * (G_ >> 3) + (c_ >> 3) : c_;
        tp = lds_tab;
        __syncthreads();
        if (tid < 32) tp[64 + tid] = cnt_[tid];
        __syncthreads();
        if (tid == 0) { int t = 0; for (int e = 0; e < NEXP; ++e) { tp[e] = t; t += (tp[64 + e] + 255) >> 8; } tp[32] = t; }
        __syncthreads();
        total = __builtin_amdgcn_readfirstlane(tp[32]);
    }
    __device__ __forceinline__ bool next(int i, pg8::Unit& u) const {
        const long Lx = (long)i * G + c; if (Lx >= (long)total * 4) return false;
        const int ti = (int)(Lx >> 2); u.pn = (int)(Lx & 3);
        int ln; asm volatile("v_mbcnt_lo_u32_b32 %0, -1, 0\n\tv_mbcnt_hi_u32_b32 %0, -1, %0" : "=v"(ln));
        const int l5 = ln & 31; const int lo = tp[l5], hi = tp[l5 + 1];
        const unsigned long long mask = __builtin_amdgcn_ballot_w64(lo <= ti && ti < hi);
        const int e = __builtin_amdgcn_readfirstlane((int)__builtin_ctzll(mask) & 31);
        const int base = __builtin_amdgcn_readfirstlane(tp[e]), ce = __builtin_amdgcn_readfirstlane(tp[64 + e]);
        u.e = e; u.pm = ti; u.cnt = ce - (ti - base) * 256;
        u.A = ltok ? (const char*)A : (const char*)A + (size_t)ti * 256 * K * 2;
        u.B = (const char*)(Bt + (size_t)e * bstride) + (size_t)u.pn * 256 * K * 2;
        u.pm = ti | ((ti - base) << 16);
        return true;
    }
    __device__ __forceinline__ void aoff(const pg8::Unit& u, int tid, unsigned (&v)[2][2]) const {
        const int lt = u.pm >> 16; int Rr[2], Cc[2]; pg8::stage_rc(tid * 16, Rr[0], Cc[0]); pg8::stage_rc(tid * 16 + 8192, Rr[1], Cc[1]);
        int tk[2][2];
#pragma unroll
        for (int h = 0; h < 2; ++h)
#pragma unroll
            for (int i = 0; i < 2; ++i) { const int r = h * 128 + Rr[i]; tk[h][i] = ltok[(size_t)u.e * LCAP + lt * 256 + (r < u.cnt ? r : 0)]; }
#pragma unroll
        for (int h = 0; h < 2; ++h)
#pragma unroll
            for (int i = 0; i < 2; ++i) { const int r = h * 128 + Rr[i]; const int tok = (r < u.cnt) ? (tk[h][i] >> 1) : 0; v[h][i] = (unsigned)(tok * K + Cc[i]) * 2u; }
    }
};

struct EpiProj {
    static constexpr bool PERM = true;
    struct Pre { float rs[8]; };
    bf16_t* O; const float* rs;
    __device__ __forceinline__ void prefetch(Pre& pr, const pg8::Unit& u, int wr, int wc, int fr, int fq) const {
        const int row0 = (u.pm & 0xffff) * 256 + wr * 64 + fr;
#pragma unroll
        for (int ai = 0; ai < 2; ++ai)
#pragma unroll
            for (int m = 0; m < 4; ++m) pr.rs[ai * 4 + m] = rs[row0 + ai * 128 + m * 16];
    }
    __device__ __forceinline__ void operator()(const f32x4 (&acc)[2][2][4][2], const pg8::Unit& u, int wr, int wc, int fr, int fq, const Pre& pr) const {
        const int row0 = u.pm * 256 + wr * 64 + fr, col0 = u.pn * 256 + wc * 32 + 8 * fq;
#pragma unroll
        for (int ai = 0; ai < 2; ++ai)
#pragma unroll
            for (int m = 0; m < 4; ++m) { const int row = row0 + ai * 128 + m * 16; const float s = pr.rs[ai * 4 + m]; bf16_t* rowp = O + (size_t)row * IN_DP + col0;
#pragma unroll
                for (int bj = 0; bj < 2; ++bj) { const f32x4 v0 = acc[ai][bj][m][0] * s, v1 = acc[ai][bj][m][1] * s;
                    u32x4 w; w.x = pg8::cvt_pk_bf16(v0[0], v0[1]); w.y = pg8::cvt_pk_bf16(v0[2], v0[3]); w.z = pg8::cvt_pk_bf16(v1[0], v1[1]); w.w = pg8::cvt_pk_bf16(v1[2], v1[3]);
                    *(u32x4*)(rowp + bj * 128) = w; } }
    }
};
struct EpiRes {
    static constexpr bool PERM = true;
    struct Pre { int dummy; };
    bf16_t* x16;
    __device__ __forceinline__ void prefetch(Pre&, const pg8::Unit&, int, int, int, int) const {}
    __device__ __forceinline__ void operator()(const f32x4 (&acc)[2][2][4][2], const pg8::Unit& u, int wr, int wc, int fr, int fq, const Pre&) const {
        const int row0 = u.pm * 256 + wr * 64 + fr, col0 = u.pn * 256 + wc * 32 + 8 * fq;
#pragma unroll
        for (int ai = 0; ai < 2; ++ai) {
            u32x4 braw[4][2];
#pragma unroll
            for (int m = 0; m < 4; ++m)
#pragma unroll
                for (int bj = 0; bj < 2; ++bj) braw[m][bj] = *(const u32x4*)(x16 + (size_t)(row0 + ai * 128 + m * 16) * D + col0 + bj * 128);
            asm volatile("" ::: "memory");
#pragma unroll
            for (int m = 0; m < 4; ++m) { const size_t off = (size_t)(row0 + ai * 128 + m * 16) * D + col0;
#pragma unroll
                for (int bj = 0; bj < 2; ++bj) { const f32x4 v0 = acc[ai][bj][m][0], v1 = acc[ai][bj][m][1]; float bb[8]; unpack8(braw[m][bj], bb);
                    u32x4 w; w.x = pk2(bb[0] + v0[0], bb[1] + v0[1]); w.y = pk2(bb[2] + v0[2], bb[3] + v0[3]); w.z = pk2(bb[4] + v1[0], bb[5] + v1[1]); w.w = pk2(bb[6] + v1[2], bb[7] + v1[3]);
                    *(u32x4*)(x16 + off + bj * 128) = w; } }
            asm volatile("" ::: "memory");
        }
    }
};
struct EpiMoe1 {
    static constexpr bool PERM = true;
    struct Pre { int dummy; };
    bf16_t* act; const float* lrs;
    __device__ __forceinline__ void prefetch(Pre&, const pg8::Unit&, int, int, int, int) const {}
    __device__ __forceinline__ void operator()(const f32x4 (&acc)[2][2][4][2], const pg8::Unit& u, int wr, int wc, int fr, int fq, const Pre&) const {
        const int ti = u.pm & 0xffff, lt = u.pm >> 16;
        const int r0 = wr * 64 + fr, col0 = u.pn * 256 + wc * 32 + 8 * fq;
        float sv[8];
#pragma unroll
        for (int q = 0; q < 8; ++q) { const int r = r0 + (q >> 2) * 128 + (q & 3) * 16; sv[q] = (r < u.cnt) ? lrs[(size_t)u.e * LCAP + lt * 256 + r] : 0.f; }
        asm volatile("" ::: "memory");
#pragma unroll
        for (int ai = 0; ai < 2; ++ai)
#pragma unroll
            for (int m = 0; m < 4; ++m) { const int r = r0 + ai * 128 + m * 16;
                const float s = sv[ai * 4 + m];
                bf16_t* rowp = act + ((size_t)ti * 256 + r) * FF + (col0 >> 1);
#pragma unroll
                for (int bj = 0; bj < 2; ++bj) { const f32x4 v0 = acc[ai][bj][m][0] * s, v1 = acc[ai][bj][m][1] * s;
                    const float o0 = v0[0] * frcp(1.f + __expf(-v0[0])) * v0[1], o1 = v0[2] * frcp(1.f + __expf(-v0[2])) * v0[3];
                    const float o2 = v1[0] * frcp(1.f + __expf(-v1[0])) * v1[1], o3 = v1[2] * frcp(1.f + __expf(-v1[2])) * v1[3];
                    u32x2 w; w.x = pg8::cvt_pk_bf16(o0, o1); w.y = pg8::cvt_pk_bf16(o2, o3);
                    *(u32x2*)(rowp + bj * 64) = w; } }
    }
};
struct EpiMoe2 {
    static constexpr bool PERM = true;
    struct Pre { int dummy; };
    bf16_t* ybuf; const int* ltok; const float* lgate;
    __device__ __forceinline__ void prefetch(Pre&, const pg8::Unit&, int, int, int, int) const {}
    __device__ __forceinline__ void operator()(const f32x4 (&acc)[2][2][4][2], const pg8::Unit& u, int wr, int wc, int fr, int fq, const Pre&) const {
        const int lt = u.pm >> 16, r0 = wr * 64 + fr, col0 = u.pn * 256 + wc * 32 + 8 * fq;
        int dv[8]; float gv[8];
#pragma unroll
        for (int q = 0; q < 8; ++q) { const int r = r0 + (q >> 2) * 128 + (q & 3) * 16; const bool ok = r < u.cnt;
            const size_t li = (size_t)u.e * LCAP + lt * 256 + (ok ? r : 0); const int d = ltok[li]; const float g = lgate[li];
            dv[q] = ok ? d : -1; gv[q] = g; }
        asm volatile("" ::: "memory");
#pragma unroll
        for (int ai = 0; ai < 2; ++ai)
#pragma unroll
            for (int m = 0; m < 4; ++m) { const int dest = dv[ai * 4 + m];
                if (dest >= 0) { const float g = gv[ai * 4 + m];
                    bf16_t* rowp = ybuf + (size_t)dest * D + col0;
#pragma unroll
                    for (int bj = 0; bj < 2; ++bj) { const f32x4 v0 = acc[ai][bj][m][0] * g, v1 = acc[ai][bj][m][1] * g;
                        u32x4 w; w.x = pg8::cvt_pk_bf16(v0[0], v0[1]); w.y = pg8::cvt_pk_bf16(v0[2], v0[3]); w.z = pg8::cvt_pk_bf16(v1[0], v1[1]); w.w = pg8::cvt_pk_bf16(v1[2], v1[3]);
                        *(u32x4*)(rowp + bj * 128) = w; } } }
    }
};

__device__ __forceinline__ void transpose_item(const float* __restrict__ W, int K, int N, bf16_t* WT, int rmul, int radd, const float* __restrict__ g, LAS float* scr, int item, int lane) {
    const int nblk = N / 32, kb = item / nblk, nb = item % nblk, k0 = 64 * kb, n0 = 32 * nb;
    f32x4 v[8]; float gv[8];
#pragma unroll
    for (int i = 0; i < 8; ++i) { v[i] = *(const f32x4*)(W + (size_t)(k0 + 8 * i + (lane >> 3)) * N + n0 + 4 * (lane & 7)); gv[i] = g ? g[k0 + 8 * i + (lane >> 3)] : 1.0f; }
#pragma unroll
    for (int i = 0; i < 8; ++i) { const int kk = 8 * i + (lane >> 3); *(LAS f32x4*)(scr + kk * 36 + 4 * (lane & 7)) = v[i] * gv[i]; }
    LDS_WAIT(); asm volatile("" ::: "memory");
    const int c = lane & 7;
#pragma unroll
    for (int j = 0; j < 4; ++j) { const int n = (lane >> 3) + 8 * j; const LAS float* s = scr + (8 * c) * 36 + n;
        u32x4 o; o.x = pk2(s[0 * 36], s[1 * 36]); o.y = pk2(s[2 * 36], s[3 * 36]); o.z = pk2(s[4 * 36], s[5 * 36]); o.w = pk2(s[6 * 36], s[7 * 36]);
        *(u32x4*)(WT + (size_t)(rmul * (n0 + n) + radd) * K + k0 + 8 * c) = o; }
    LDS_WAIT(); asm volatile("" ::: "memory");
}

__device__ __forceinline__ void filt_item8(const Params& p, int l, int m0, int lane, float* G) {
    const float* w1 = p.in[5] + l * 33 * 64; const float* w2 = p.in[7] + l * 4096; const float* w3 = p.in[9] + l * 4096; const float* wout = p.in[11] + l * 64 * 512;
    const float b1v = p.in[6][l * 64 + lane], b2v = p.in[8][l * 64 + lane], b3v = p.in[10][l * 64 + lane], fr = p.in[12][l * 64 + lane];
    float hcur[8], acc[8];
    {
#pragma unroll
        for (int j = 0; j < 8; ++j) { const int m = m0 + j; float zl = 0.f;
            const float wv = (6.283185307179586f / 8192.0f) * (float)m; const float fstep = (15.0f - 1e-4f) / 15.0f;
            if (lane == 0) zl = (float)m / 8191.0f; else if (lane <= 16) zl = cosf((1e-4f + (float)(lane - 1) * fstep) * wv); else if (lane <= 32) zl = -sinf((1e-4f + (float)(lane - 17) * fstep) * wv);
            hcur[j] = zl; acc[j] = b1v; }
        float wc[33];
#pragma unroll
        for (int i = 0; i < 33; ++i) wc[i] = w1[i * 64 + lane];
#pragma unroll
        for (int i = 0; i < 33; ++i)
#pragma unroll
            for (int j = 0; j < 8; ++j) acc[j] += rdlane(hcur[j], i) * wc[i];
#pragma unroll
        for (int j = 0; j < 8; ++j) { hcur[j] = sinf(fr * acc[j]); acc[j] = b2v; }
    }
    asm volatile("" ::: "memory");
    {   float wc[64];
#pragma unroll
        for (int i = 0; i < 64; ++i) wc[i] = w2[i * 64 + lane];
#pragma unroll
        for (int i = 0; i < 64; ++i)
#pragma unroll
            for (int j = 0; j < 8; ++j) acc[j] += rdlane(hcur[j], i) * wc[i];
#pragma unroll
        for (int j = 0; j < 8; ++j) { hcur[j] = sinf(fr * acc[j]); acc[j] = b3v; }
    }
    asm volatile("" ::: "memory");
    {   float wc[64];
#pragma unroll
        for (int i = 0; i < 64; ++i) wc[i] = w3[i * 64 + lane];
#pragma unroll
        for (int i = 0; i < 64; ++i)
#pragma unroll
            for (int j = 0; j < 8; ++j) acc[j] += rdlane(hcur[j], i) * wc[i];
#pragma unroll
        for (int j = 0; j < 8; ++j) hcur[j] = sinf(fr * acc[j]);
    }
    asm volatile("" ::: "memory");
    float (&h3)[8] = hcur;
    float o[8][8];
#pragma unroll
    for (int j = 0; j < 8; ++j)
#pragma unroll
        for (int q = 0; q < 8; ++q) o[j][q] = 0.f;
#pragma unroll 2
    for (int i = 0; i < 64; ++i) { float wo[8];
#pragma unroll
        for (int q = 0; q < 8; ++q) wo[q] = wout[i * 512 + q * 64 + lane];
#pragma unroll
        for (int j = 0; j < 8; ++j) { const float hv = rdlane(h3[j], i);
#pragma unroll
            for (int q = 0; q < 8; ++q) o[j][q] += hv * wo[q]; } }
    const float dmin = -3.0701134573253944f, dmax = -15.350567286626972f;
#pragma unroll
    for (int q = 0; q < 8; ++q) { const int n = q * 64 + lane, d = n >> 8, c = n & 255;
        const float delta = fabsf(dmin + (float)c * ((dmax - dmin) / 255.0f));
        float v[8];
#pragma unroll
        for (int j = 0; j < 8; ++j) v[j] = o[j][q] * expf(-((float)(m0 + j) / 8191.0f) * delta);
        float* dst = G + (size_t)c * 16384 + d * 8192 + m0;
        *(f32x4*)dst = (f32x4){v[0], v[1], v[2], v[3]}; *(f32x4*)(dst + 4) = (f32x4){v[4], v[5], v[6], v[7]}; }
}

__device__ __forceinline__ void phase_prologue(const Params& p, LAS unsigned char* lds, int G_, int bid, const int wvx) {
    const int tid = opaque_tid(wvx), lane = tid & 63, wave = tid >> 6;
    const int gw = bid * 8 + wave, NGW = G_ * 8;
    LAS float* scr = (LAS float*)(lds + wave * 16384);
    unsigned char* ws = p.ws;
    for (int it = gw; it < 16 * 108; it += NGW) transpose_item(p.in[2], D, IN_D, (bf16_t*)(ws + OFF_WTIN), 1, 0, p.in[1], scr, it, lane);
    for (int i = bid * NTHREADS + tid; i < 2 * 128 * D / 8; i += G_ * NTHREADS) { const int l = i / (128 * D / 8), r = i % (128 * D / 8);
        *(u32x4*)((bf16_t*)(ws + OFF_WTIN) + (size_t)l * IN_DP * D + (size_t)IN_D * D + (size_t)r * 8) = (u32x4){0u, 0u, 0u, 0u}; }
    for (int i = bid * NTHREADS + tid; i < 2 * 48 * D; i += G_ * NTHREADS) { const int l = i / (48 * D), r = i % (48 * D), o = r / D, k = r % D;
        const float g = p.in[27][l * D + k]; const float w = g * ((o < 4) ? p.in[28][((size_t)l * D + k) * 4 + o] : (o < 36 ? p.in[30][((size_t)l * D + k) * 32 + (o - 4)] : 0.f));
        const unsigned hi = f2bf(w); const float lo = w - bf2f(hi);
        bf16_t* rg = (bf16_t*)(ws + OFF_RGW) + (size_t)l * 2 * 48 * D; rg[o * D + k] = (bf16_t)hi; rg[48 * D + o * D + k] = (bf16_t)f2bf(lo); }
}
__device__ __forceinline__ void filters_all(const Params& p, int nwg, int rank, const int wvx) {
    const int tid = opaque_tid(wvx), lane = tid & 63, wave = tid >> 6;
    for (int it = rank * 8 + wave; it < 2 * (L / 8); it += nwg * 8) { const int l = it / (L / 8), m0 = (it % (L / 8)) * 8; filt_item8(p, l, m0, lane, (float*)(p.ws + OFF_FILT) + (size_t)l * 256 * 16384); }
}

__device__ __forceinline__ void moe_weights_chunk(const Params& p, LAS unsigned char* lds, int l, int chunk, const int wvx) {
    const int tid = opaque_tid(wvx), lane = tid & 63, wave = tid >> 6;
    LAS float* scr = (LAS float*)(lds + wave * 16384);
    bf16_t* W13 = (bf16_t*)(p.ws + OFF_W13T); bf16_t* W2 = (bf16_t*)(p.ws + OFF_W2T);
    const float* g = p.in[27] + l * D;
#pragma unroll 1
    for (int k = 0; k < 8; ++k) { const int it = chunk * 64 + wave * 8 + k;
        if (it >= NEXP * 768) { const int x = it - NEXP * 768;
            if (x < 16 * 108) transpose_item(p.in[2] + (size_t)D * IN_D, D, IN_D, (bf16_t*)(p.ws + OFF_WTIN) + (size_t)IN_DP * D, 1, 0, p.in[1] + D, scr, x, lane);
            else if (x < 16 * 108 + 1024) { const int y = x - 16 * 108, lo = y >> 9; transpose_item(p.in[26] + (size_t)lo * D * D, D, D, (bf16_t*)(p.ws + OFF_WTOUT) + (size_t)lo * D * D, 1, 0, nullptr, scr, y & 511, lane); }
            continue; }
        const int e = it / 768, r = it % 768;
        if (r < 256) transpose_item(p.in[32] + ((size_t)l * NEXP + e) * D * FF, D, FF, W13 + (size_t)e * 1024 * D, 2, 0, g, scr, r, lane);
        else if (r < 512) transpose_item(p.in[33] + ((size_t)l * NEXP + e) * D * FF, D, FF, W13 + (size_t)e * 1024 * D, 2, 1, g, scr, r - 256, lane);
        else transpose_item(p.in[34] + ((size_t)l * NEXP + e) * FF * D, FF, D, W2 + (size_t)e * D * FF, 1, 0, nullptr, scr, r - 512, lane); }
}
__device__ __forceinline__ void phase_rownorm(const float* x, bf16_t* xb, float* rs, int G_, int bid, const int wvx) {
    const int tid = opaque_tid(wvx), lane = tid & 63, wave = tid >> 6;
    for (int row = bid * 8 + wave; row < NT; row += G_ * 8) {
        const f32x4* xr = (const f32x4*)(x + (size_t)row * D) + lane; f32x4 v[4]; float s = 0.f;
#pragma unroll
        for (int j = 0; j < 4; ++j) { v[j] = xr[64 * j]; s += (v[j].x * v[j].x + v[j].y * v[j].y) + (v[j].z * v[j].z + v[j].w * v[j].w); }
        s = wave_sum(s);
        if (lane == 0) rs[row] = 1.0f / sqrtf(s * (1.0f / D) + NORM_EPS);
        u32x2* o = (u32x2*)(xb + (size_t)row * D) + lane;
#pragma unroll
        for (int j = 0; j < 4; ++j) o[64 * j] = (u32x2){pk2(v[j].x, v[j].y), pk2(v[j].z, v[j].w)};
    }
}

__device__ __forceinline__ void load8(const bf16_t* p, bool ok, float* f) { if (ok) { unpack8(*(const u32x4*)p, f); } else {
#pragma unroll
    for (int j = 0; j < 8; ++j) f[j] = 0.f; } }

__device__ __forceinline__ void hy_pre_unit(const Params& p, LAS unsigned char* lds, int l, int unit, const int wvx) {
    const int tid = opaque_tid(wvx);
    const int ct = unit & 3, tt = (unit >> 2) & 127, b = unit >> 9;
    const bf16_t* proj = (const bf16_t*)(p.ws + OFF_PROJ);
    bf16_t* zT = (bf16_t*)(p.ws + OFF_ZT);
    const float* cw = p.in[3] + l * 3 * 768; const float* cb = p.in[4] + l * 768;
    LAS bf16_t* tile = (LAS bf16_t*)lds;
    {
        const int tl = tid >> 3, c8 = (tid & 7) * 8, t = tt * 64 + tl, c = ct * 64 + c8;
        const bf16_t* row = proj + ((size_t)b * L + t) * IN_DP;
        float x1[3][8], vv[3][8];
        load8(row - IN_DP + C_HX1 + c, t > 0, x1[0]); load8(row + C_HX1 + c, true, x1[1]); load8(row + IN_DP + C_HX1 + c, t < L - 1, x1[2]);
        load8(row - IN_DP + C_HV + c, t > 0, vv[0]); load8(row + C_HV + c, true, vv[1]); load8(row + IN_DP + C_HV + c, t < L - 1, vv[2]);
#pragma unroll
        for (int j = 0; j < 8; ++j) { const int c1 = C_HX1 + c + j, c2 = C_HV + c + j;
            const float a = x1[0][j] * cw[c1] + x1[1][j] * cw[768 + c1] + x1[2][j] * cw[1536 + c1] + cb[c1];
            const float v = vv[0][j] * cw[c2] + vv[1][j] * cw[768 + c2] + vv[2][j] * cw[1536 + c2] + cb[c2];
            tile[(c8 + j) * 72 + tl] = (bf16_t)f2bf(a * v); }
    }
    __syncthreads();
    {
        const int cl = tid >> 3, seg = tid & 7;
        const u32x4 w = *(const LAS u32x4*)(tile + cl * 72 + seg * 8);
        *(u32x4*)(zT + ((size_t)(ct * 64 + cl) * NB + b) * L + tt * 64 + seg * 8) = w;
    }
    __syncthreads();
}

typedef float f32x16 __attribute__((ext_vector_type(16)));
__device__ __forceinline__ void hy_conv_unit(const Params& p, LAS unsigned char* lds, int l, int c, const int wvx) {
    const int tid = opaque_tid(wvx), lane = tid & 63, wave = __builtin_amdgcn_readfirstlane(tid >> 6);
    const float* G = (const float*)(p.ws + OFF_FILT) + ((size_t)l * 256 + c) * 16384;
    const bf16_t* zT = (const bf16_t*)(p.ws + OFF_ZT) + (size_t)c * NB * L;
    float* yT = (float*)(p.ws + OFF_YT) + (size_t)c * NB * L;
    LAS bf16_t* Re = (LAS bf16_t*)lds; LAS bf16_t* Ro = Re + 16384;
    LAS unsigned char* Zs = lds + 65536;
    constexpr int ZB = 8976;
    LAS float* red = (LAS float*)(lds + 65536 + 8 * ZB);
    __syncthreads();
    float ss = 0.f; const float GF0 = G[8192];
#pragma unroll 1
    for (int i0 = 0; i0 < 16384; i0 += 8 * NTHREADS) { float gq[8];
#pragma unroll
        for (int k = 0; k < 8; ++k) gq[k] = G[i0 + k * NTHREADS + tid];
#pragma unroll
        for (int k = 0; k < 8; ++k) { const int i = i0 + k * NTHREADS + tid; const float g = gq[k]; ss += g * g;
            if (i == 8192) { Ro[16383] = 0; Re[0] = 0; }
            else { const int dl = (i < 8192) ? i : (8192 - i); const bf16_t bv = (bf16_t)f2bf(i == 0 ? g + GF0 : g); Re[8192 - dl] = bv; Ro[8191 - dl] = bv; } } }
    ss = wave_sum(ss); if (lane == 0) red[wave] = ss;
    f32x16 acc[2][4];
#pragma unroll
    for (int mt = 0; mt < 2; ++mt)
#pragma unroll
        for (int i = 0; i < 4; ++i)
#pragma unroll
            for (int e = 0; e < 16; ++e) acc[mt][i][e] = 0.f;
    const int r = lane & 31, hh = lane >> 5;
#pragma unroll 1
    for (int h = 0; h < 2; ++h) {
        __syncthreads();
        { u32x4 zq[9];
#pragma unroll
          for (int k = 0; k < 9; ++k) { const int q = tid + k * NTHREADS; const int ch = q & 7, Jp = (q >> 3) % 70, b = (q >> 3) / 70; const int J = 64 * h + Jp - 3;
            zq[k] = (u32x4){0u, 0u, 0u, 0u}; if (q < 4480 && Jp >= 3 && Jp < 67) zq[k] = *(const u32x4*)(zT + (size_t)b * L + J * 64 + ch * 8); }
#pragma unroll
          for (int k = 0; k < 9; ++k) { const int q = tid + k * NTHREADS; const int ch = q & 7, Jp = (q >> 3) % 70, b = (q >> 3) / 70;
            if (q < 4480) *(LAS u32x4*)(Zs + b * ZB + Jp * 128 + ch * 16) = zq[k]; } }
        __syncthreads();
        int d_hi = 16 * wave + 15 - 64 * h, d_lo = 16 * wave - 64 * h - 63; d_hi = d_hi > 127 ? 127 : d_hi; d_lo = d_lo < -127 ? -127 : d_lo;
#pragma unroll 1
        for (int d = d_lo; d <= d_hi; ++d) {
            const int J0b = 16 * wave - d;
            const int aelem = 8192 + 8 * hh - r - (r & 1) - 64 * d - 32;
            const LAS unsigned* ap = (const LAS unsigned*)(lds + (r & 1) * 32768 + aelem * 2);
            bf16x8 Af[2][4];
#pragma unroll
            for (int mt = 0; mt < 2; ++mt)
#pragma unroll
                for (int ks = 0; ks < 4; ++ks) { const LAS unsigned* q = ap + (16 * ks + 32 * (1 - mt)) / 2; const u32x4 t = (u32x4){q[0], q[1], q[2], q[3]}; Af[mt][ks] = __builtin_bit_cast(bf16x8, t); }
            const LAS unsigned char* bp = Zs + (r & 7) * ZB + ((r >> 3) + J0b - 64 * h + 3) * 128 + hh * 16;
#pragma unroll
            for (int i = 0; i < 4; ++i) { const int J0 = J0b + 4 * i;
                if (J0 + 3 >= 64 * h && J0 <= 64 * h + 63) {
                    bf16x8 Bf[4];
#pragma unroll
                    for (int ks = 0; ks < 4; ++ks) Bf[ks] = *(const LAS bf16x8*)(bp + i * 512 + ks * 32);
#pragma unroll
                    for (int ks = 0; ks < 4; ++ks)
#pragma unroll
                        for (int mt = 0; mt < 2; ++mt) acc[mt][i] = __builtin_amdgcn_mfma_f32_32x32x16_bf16(Af[mt][ks], Bf[ks], acc[mt][i], 0, 0, 0);
                } }
        }
    }
    float tot = 0.f;
#pragma unroll
    for (int w = 0; w < 8; ++w) tot += red[w];
    const float scale = 1.0f / sqrtf(tot + 1e-6f);
#pragma unroll
    for (int mt = 0; mt < 2; ++mt)
#pragma unroll
        for (int i = 0; i < 4; ++i)
#pragma unroll
            for (int g = 0; g < 4; ++g) { const int t = 64 * (16 * wave + 4 * i + (r >> 3)) + 32 * mt + 8 * g + 4 * hh;
                const f32x4 v = (f32x4){acc[mt][i][4 * g] * scale, acc[mt][i][4 * g + 1] * scale, acc[mt][i][4 * g + 2] * scale, acc[mt][i][4 * g + 3] * scale};
                *(f32x4*)(yT + (size_t)(r & 7) * L + t) = v; }
    __syncthreads();
}

__device__ __forceinline__ void hy_post_unit(const Params& p, LAS unsigned char* lds, int l, int unit, const int wvx) {
    const int tid = opaque_tid(wvx);
    const int ct = unit & 3, tt = (unit >> 2) & 127, b = unit >> 9;
    const bf16_t* proj = (const bf16_t*)(p.ws + OFF_PROJ);
    const bf16_t* zT = (const bf16_t*)(p.ws + OFF_ZT);
    const float* yT = (const float*)(p.ws + OFF_YT);
    bf16_t* mix = (bf16_t*)(p.ws + OFF_MIX);
    const float* cw = p.in[3] + l * 3 * 768; const float* cb = p.in[4] + l * 768; const float* skip = p.in[13] + l * 256;
    LAS float* tile = (LAS float*)lds;
    {
        const int cl = tid >> 3, seg = tid & 7, c = ct * 64 + cl;
        const size_t off = ((size_t)c * NB + b) * L + tt * 64 + seg * 8;
        float z[8]; unpack8(*(const u32x4*)(zT + off), z);
        const f32x4 y0 = *(const f32x4*)(yT + off), y1 = *(const f32x4*)(yT + off + 4);
        const float sk = skip[c];
        tile[cl * 65 + seg * 8 + 0] = y0.x + z[0] * sk; tile[cl * 65 + seg * 8 + 1] = y0.y + z[1] * sk; tile[cl * 65 + seg * 8 + 2] = y0.z + z[2] * sk; tile[cl * 65 + seg * 8 + 3] = y0.w + z[3] * sk;
        tile[cl * 65 + seg * 8 + 4] = y1.x + z[4] * sk; tile[cl * 65 + seg * 8 + 5] = y1.y + z[5] * sk; tile[cl * 65 + seg * 8 + 6] = y1.z + z[6] * sk; tile[cl * 65 + seg * 8 + 7] = y1.w + z[7] * sk;
    }
    __syncthreads();
    {
        const int tl = tid >> 3, c8 = (tid & 7) * 8, t = tt * 64 + tl, c = ct * 64 + c8;
        const bf16_t* row = proj + ((size_t)b * L + t) * IN_DP;
        float x0[3][8];
        load8(row - IN_DP + C_HX0 + c, t > 0, x0[0]); load8(row + C_HX0 + c, true, x0[1]); load8(row + IN_DP + C_HX0 + c, t < L - 1, x0[2]);
        float o[8];
#pragma unroll
        for (int j = 0; j < 8; ++j) { const int c0 = c + j; const float a = x0[0][j] * cw[c0] + x0[1][j] * cw[768 + c0] + x0[2][j] * cw[1536 + c0] + cb[c0];
            o[j] = a * tile[(c8 + j) * 65 + tl]; }
        u32x4 w; w.x = pk2(o[0], o[1]); w.y = pk2(o[2], o[3]); w.z = pk2(o[4], o[5]); w.w = pk2(o[6], o[7]);
        *(u32x4*)(mix + ((size_t)b * L + t) * D + c) = w;
    }
    __syncthreads();
}


namespace rw {
constexpr int MATB = 9216, PITCH = 144;
constexpr int O_W2T = 0, O_A2T = MATB, O_SB = 2 * MATB, O_GBUF = 3 * MATB, O_SLOT = O_GBUF + 16384;
constexpr int O_GC = O_SLOT + 10 * MATB, O_APP = O_GC + 256, O_TPP = O_APP + 5120, O_CT = O_TPP + 2560;
__device__ __forceinline__ constexpr int slot(int k) { return O_SLOT + k * MATB; }
#define MFMA16(a, b, c) __builtin_amdgcn_mfma_f32_16x16x32_bf16((a), (b), (c), 0, 0, 0)
__device__ __forceinline__ f32x4 tile64(const LAS unsigned char* A, const LAS unsigned char* Bt, int rt, int ct, int fr, int fq, f32x4 acc) {
#pragma unroll
    for (int ks = 0; ks < 2; ++ks) { const bf16x8 a = *(const LAS bf16x8*)(A + (16 * rt + fr) * PITCH + ks * 64 + fq * 16); const bf16x8 b = *(const LAS bf16x8*)(Bt + (16 * ct + fr) * PITCH + ks * 64 + fq * 16);
        acc = MFMA16(a, b, acc); }
    return acc;
}
__device__ __forceinline__ unsigned pkbf(float lo, float hi) { return pg8::cvt_pk_bf16(lo, hi); }
}

namespace rw {
typedef short s16x4 __attribute__((ext_vector_type(4)));
__device__ __forceinline__ bf16x8 fragN(const LAS unsigned char* img, int row, int ks, int fq) { return *(const LAS bf16x8*)(img + row * PITCH + ks * 64 + fq * 16); }
__device__ __forceinline__ bf16x8 fragP(const LAS unsigned char* img, int row, int ks, int fq) {
    const u32x2 a = *(const LAS u32x2*)(img + row * PITCH + (32 * ks + 4 * fq) * 2), b = *(const LAS u32x2*)(img + row * PITCH + (32 * ks + 16 + 4 * fq) * 2);
    const u32x4 v = (u32x4){a.x, a.y, b.x, b.y}; return __builtin_bit_cast(bf16x8, v); }
__device__ __forceinline__ bf16x8 fragT(const LAS unsigned char* img, int c0, int ks, int fr, int fq) {
    const LAS unsigned char* q = img + (32 * ks + 4 * fq + (fr >> 2)) * PITCH + (c0 + 4 * (fr & 3)) * 2;
    const s16x4 a = __builtin_amdgcn_ds_read_tr16_b64_v4i16((LAS s16x4*)q), b = __builtin_amdgcn_ds_read_tr16_b64_v4i16((LAS s16x4*)(q + 16 * PITCH));
    return (bf16x8){a[0], a[1], a[2], a[3], b[0], b[1], b[2], b[3]}; }
}

__device__ __forceinline__ void rw_chain_unit(const Params& p, LAS unsigned char* lds, int l, int unit, const int wvx) {
    using namespace rw;
    const int tid = opaque_tid(wvx), wave = __builtin_amdgcn_readfirstlane(tid >> 6);
    const int dir = unit & 1, h = (unit >> 1) & 7, b = unit >> 4;
    const bf16_t* proj = (const bf16_t*)(p.ws + OFF_PROJ);
    bf16_t* Y = (bf16_t*)(p.ws + (dir ? OFF_YB : OFF_YF));
    LAS float* gbuf = (LAS float*)(lds + O_GBUF);
    LAS float* GC = (LAS float*)(lds + O_GC);
    LAS bf16_t* TPP = (LAS bf16_t*)(lds + O_TPP);
    LAS float* CT = (LAS float*)(lds + O_CT);
    float* BON = (float*)(p.ws + OFF_BON) + (size_t)dir * NT * 8;
    __syncthreads();
    {
        const float* w2 = p.in[16] + ((size_t)l * 2 + dir) * 64 * 512 + h * 64; const float* a2 = p.in[18] + ((size_t)l * 2 + dir) * 64 * 512 + h * 64;
        for (int i = tid; i < 4096; i += NTHREADS) { const int r = i >> 6, n = i & 63;
            *(LAS bf16_t*)(lds + O_W2T + n * PITCH + r * 2) = (bf16_t)f2bf(w2[r * 512 + n]); *(LAS bf16_t*)(lds + O_A2T + n * PITCH + r * 2) = (bf16_t)f2bf(a2[r * 512 + n]); }
        for (int i = tid; i < MATB / 4; i += NTHREADS) ((LAS unsigned*)(lds + O_SB))[i] = 0u;
        const float* mu = p.in[14] + (size_t)l * 3 * 2 * 512;
        for (int i = tid; i < 704; i += NTHREADS) { const int row = i >> 6, n = i & 63, col = h * 64 + n; float v;
            if (row < 6) v = mu[(row >> 1) * 1024 + (row & 1) * 512 + col];
            else if (row == 6) v = p.in[15][((size_t)l * 2 + dir) * 512 + col];
            else if (row == 7) v = p.in[17][((size_t)l * 2 + dir) * 512 + col];
            else if (row == 8) v = p.in[19][l * 512 + col];
            else if (row == 9) v = p.in[20][l * 512 + col];
            else v = p.in[21][l * 512 + col];
            CT[i] = v; }
    }
    f32x4 Sreg[4];
#pragma unroll
    for (int it = 0; it < 4; ++it) Sreg[it] = (f32x4){0.f, 0.f, 0.f, 0.f};
    const int rt = wave >> 1, chh = wave & 1;
    u32x4 pre[8];
#define issue_loads(CC) do { const int t0n = (dir ? (L / 64 - 1 - (CC)) : (CC)) * 64; int tq_ = tid; asm volatile("" : "+v"(tq_));     \
        _Pragma("unroll") for (int k = 0; k < 4; ++k) { const int q = tq_ + k * NTHREADS; pre[k] = (u32x4){0u, 0u, 0u, 0u}; \
            if (q < 1584) { const int which = q / 528, rem = q - which * 528, rr = rem >> 3, ch = rem & 7; const int t = t0n - 1 + rr; \
                if (t >= 0 && t < L) pre[k] = *(const u32x4*)(proj + ((size_t)b * L + t) * IN_DP + C_RR + which * 512 + h * 64 + ch * 8); } } \
        { const int pq_ = 16 * rt + (tq_ & 15), kq_ = ((tq_ >> 4) & 3) * 8; const int ttn = dir ? (t0n + 63 - pq_) : (t0n + pq_); const bf16_t* row = proj + ((size_t)b * L + ttn) * IN_DP; \
          pre[4] = *(const u32x4*)(row + C_RW + dir * 64 + kq_); pre[5] = *(const u32x4*)(row + C_RW + dir * 64 + 32 + kq_); pre[6] = *(const u32x4*)(row + C_RA + dir * 64 + kq_); pre[7] = *(const u32x4*)(row + C_RA + dir * 64 + 32 + kq_); } } while (0)
    issue_loads(0);
#pragma unroll 1
    for (int cc = 0; cc < L / 64; ++cc) {
        const int t0 = (dir ? (L / 64 - 1 - cc) : cc) * 64;
        int tq = tid; asm volatile("" : "+v"(tq));
        const int fr = tq & 15, fq = (tq >> 4) & 3, pp = tq >> 3, ig = tq & 7, i0 = ig * 8;
        const int tt = dir ? (t0 + 63 - pp) : (t0 + pp);
        __syncthreads();
#pragma unroll
        for (int k = 0; k < 4; ++k) { const int q = tid + k * NTHREADS; if (q < 1584) { const int which = q / 528, rem = q - which * 528; *(LAS u32x4*)(lds + slot(which) + (rem >> 3) * 128 + (rem & 7) * 16) = pre[k]; } }
        asm volatile("" ::: "memory");
        if (cc > 0) { const int t0p = (dir ? (L / 64 - cc) : (cc - 1)) * 64; const int ttp = dir ? (t0p + 63 - pp) : (t0p + pp);
            *(u32x4*)(Y + ((size_t)b * L + ttp) * 512 + h * 64 + i0) = *(const LAS u32x4*)(lds + slot(9) + pp * PITCH + ig * 16); }
        { bf16x8 tw0, tw1;
          { float f[8]; unpack8(pre[4], f); u32x4 w; w.x = pk2(ftanh(f[0]), ftanh(f[1])); w.y = pk2(ftanh(f[2]), ftanh(f[3])); w.z = pk2(ftanh(f[4]), ftanh(f[5])); w.w = pk2(ftanh(f[6]), ftanh(f[7])); tw0 = __builtin_bit_cast(bf16x8, w); }
          { float f[8]; unpack8(pre[5], f); u32x4 w; w.x = pk2(ftanh(f[0]), ftanh(f[1])); w.y = pk2(ftanh(f[2]), ftanh(f[3])); w.z = pk2(ftanh(f[4]), ftanh(f[5])); w.w = pk2(ftanh(f[6]), ftanh(f[7])); tw1 = __builtin_bit_cast(bf16x8, w); }
          const bf16x8 al0 = __builtin_bit_cast(bf16x8, pre[6]), al1 = __builtin_bit_cast(bf16x8, pre[7]);
#pragma unroll
          for (int ct = 0; ct < 2; ++ct) { const int ctt = 2 * chh + ct;
            f32x4 wv = (f32x4){0.f, 0.f, 0.f, 0.f}, av = wv;
            wv = MFMA16(tw0, fragN(lds + O_W2T, 16 * ctt + fr, 0, fq), wv); wv = MFMA16(tw1, fragN(lds + O_W2T, 16 * ctt + fr, 1, fq), wv);
            av = MFMA16(al0, fragN(lds + O_A2T, 16 * ctt + fr, 0, fq), av); av = MFMA16(al1, fragN(lds + O_A2T, 16 * ctt + fr, 1, fq), av);
#pragma unroll
            for (int e = 0; e < 4; ++e) { gbuf[(16 * rt + 4 * fq + e) * 64 + 16 * ctt + fr] = wv[e]; *(LAS bf16_t*)(lds + slot(5) + (16 * rt + 4 * fq + e) * PITCH + (16 * ctt + fr) * 2) = (bf16_t)f2bf(av[e]); } } }
        if (cc + 1 < L / 64) issue_loads(cc + 1);
        __syncthreads();
        {
            const int rr = tt - t0 + 1;
#define LD2(dst, ptr) do { const f32x4 _a = *(const LAS f32x4*)(ptr), _b = *(const LAS f32x4*)((ptr) + 4); dst[0] = (f32x2){_a.x, _a.y}; dst[1] = (f32x2){_a.z, _a.w}; dst[2] = (f32x2){_b.x, _b.y}; dst[3] = (f32x2){_b.z, _b.w}; } while (0)
#define UP2(dst, wsrc_) do { const u32x4 _w = (wsrc_); dst[0] = (f32x2){bf2f(_w.x & 0xffffu), __uint_as_float(_w.x & 0xffff0000u)}; dst[1] = (f32x2){bf2f(_w.y & 0xffffu), __uint_as_float(_w.y & 0xffff0000u)}; \
                         dst[2] = (f32x2){bf2f(_w.z & 0xffffu), __uint_as_float(_w.z & 0xffff0000u)}; dst[3] = (f32x2){bf2f(_w.w & 0xffffu), __uint_as_float(_w.w & 0xffff0000u)}; } while (0)
#define TSHIFT(dst, sl, c0row) do { f32x2 xp[4], xc[4], xn[4], m0[4], m1[4]; \
                UP2(xp, *(const LAS u32x4*)(lds + slot(sl) + (rr - 1) * 128 + ig * 16)); UP2(xc, *(const LAS u32x4*)(lds + slot(sl) + rr * 128 + ig * 16)); UP2(xn, *(const LAS u32x4*)(lds + slot(sl) + (rr + 1) * 128 + ig * 16)); \
                LD2(m0, CT + (c0row) * 64 + i0); LD2(m1, CT + ((c0row) + 1) * 64 + i0); \
                _Pragma("unroll") for (int j2 = 0; j2 < 4; ++j2) dst[j2] = xc[j2] + m0[j2] * (xp[j2] - xc[j2]) + m1[j2] * (xn[j2] - xc[j2]); } while (0)
            f32x2 r2[4], v2[4], k2[4], lw2[4], a2v[4], kd2[4], kkr2[4];
            TSHIFT(r2, 0, 0);
            TSHIFT(v2, 2, 4);
            {   f32x2 ap[4], wr[4], c6[4], c7[4];
                UP2(ap, *(const LAS u32x4*)(lds + slot(5) + pp * PITCH + ig * 16)); LD2(wr, gbuf + pp * 64 + i0); LD2(c6, CT + 6 * 64 + i0); LD2(c7, CT + 7 * 64 + i0);
#pragma unroll
                for (int j2 = 0; j2 < 4; ++j2) { const f32x2 wraw = wr[j2] + c6[j2], araw = ap[j2] + c7[j2];
                    lw2[j2] = (f32x2){-0.60653066f * frcp(1.0f + __expf(-wraw.x)), -0.60653066f * frcp(1.0f + __expf(-wraw.y))};
                    a2v[j2] = (f32x2){frcp(1.0f + __expf(-araw.x)), frcp(1.0f + __expf(-araw.y))}; } }
            TSHIFT(k2, 1, 2);
            f32x2 ss2 = (f32x2){0.f, 0.f}, bs2 = ss2;
            {   f32x2 c8[4], c9[4], c10[4]; LD2(c8, CT + 8 * 64 + i0); LD2(c9, CT + 9 * 64 + i0); LD2(c10, CT + 10 * 64 + i0);
#pragma unroll
                for (int j2 = 0; j2 < 4; ++j2) { kkr2[j2] = k2[j2] * c8[j2]; ss2 += kkr2[j2] * kkr2[j2]; kd2[j2] = k2[j2] * (1.0f + (a2v[j2] - 1.0f) * c9[j2]); bs2 += r2[j2] * kd2[j2] * c10[j2]; } }
            const float ss = sum8(ss2.x + ss2.y);
            { const float bs = sum8(bs2.x + bs2.y); if (ig == 0) BON[((size_t)b * 8 + h) * L + tt] = bs; }
            const float rn_ = __builtin_amdgcn_rsqf(fmaxf(ss, 1e-24f));
            f32x2 aa2[4], bb2[4];
#pragma unroll
            for (int j2 = 0; j2 < 4; ++j2) { const f32x2 kk = kkr2[j2] * rn_; aa2[j2] = -kk; bb2[j2] = kk * a2v[j2]; }
#define PK4(v) ((u32x4){pk2(v[0].x, v[0].y), pk2(v[1].x, v[1].y), pk2(v[2].x, v[2].y), pk2(v[3].x, v[3].y)})
            *(LAS u32x4*)(lds + slot(7) + pp * PITCH + ig * 16) = PK4(aa2);
            *(LAS u32x4*)(lds + slot(8) + pp * PITCH + ig * 16) = PK4(r2);
            *(LAS u32x4*)(lds + slot(9) + pp * PITCH + ig * 16) = PK4(bb2);
            *(LAS u32x4*)(lds + slot(3) + pp * PITCH + ig * 16) = PK4(kd2);
            *(LAS u32x4*)(lds + slot(6) + pp * PITCH + ig * 16) = PK4(v2);
            *(LAS u32x4*)(lds + slot(4) + pp * PITCH + ig * 16) = PK4(lw2);
#undef TSHIFT
        }
        __syncthreads();
#pragma unroll
        for (int ct = 0; ct < 2; ++ct) { const int ctt = 2 * chh + ct; f32x4 acc = (f32x4){0.f, 0.f, 0.f, 0.f};
#pragma unroll
            for (int ks = 0; ks < 2; ++ks) if (32 * ks <= 16 * rt + 15) {
                const int pa = 16 * rt + fr - 32 * ks - 4 * fq, pb2 = pa - 16;
                u32x4 lt;
                lt.x = (pa >= 1 ? 0x3F803F80u : (pa == 0 ? 0x00003F80u : 0u)); lt.y = (pa >= 3 ? 0x3F803F80u : (pa == 2 ? 0x00003F80u : 0u));
                lt.z = (pb2 >= 1 ? 0x3F803F80u : (pb2 == 0 ? 0x00003F80u : 0u)); lt.w = (pb2 >= 3 ? 0x3F803F80u : (pb2 == 2 ? 0x00003F80u : 0u));
                acc = MFMA16(__builtin_bit_cast(bf16x8, lt), fragT(lds + slot(4), 16 * ctt, ks, fr, fq), acc); }
#pragma unroll
            for (int e = 0; e < 4; ++e) gbuf[(16 * rt + 4 * fq + e) * 64 + 16 * ctt + fr] = acc[e]; }
        __syncthreads();
        {
            f32x2 aa2[4], r2[4], bb2[4], kd2[4], gi2[4], ge2[4];
            UP2(aa2, *(const LAS u32x4*)(lds + slot(7) + pp * PITCH + ig * 16)); UP2(r2, *(const LAS u32x4*)(lds + slot(8) + pp * PITCH + ig * 16));
            UP2(bb2, *(const LAS u32x4*)(lds + slot(9) + pp * PITCH + ig * 16)); UP2(kd2, *(const LAS u32x4*)(lds + slot(3) + pp * PITCH + ig * 16));
            LD2(gi2, gbuf + pp * 64 + i0);
            if (pp > 0) LD2(ge2, gbuf + (pp - 1) * 64 + i0); else { ge2[0] = (f32x2){0.f, 0.f}; ge2[1] = ge2[0]; ge2[2] = ge2[0]; ge2[3] = ge2[0]; }
            f32x2 At[4], Rt[4], Bb[4], Kb[4];
#pragma unroll
            for (int j2 = 0; j2 < 4; ++j2) { const f32x2 ei = (f32x2){__expf(gi2[j2].x), __expf(gi2[j2].y)}, ee = (f32x2){__expf(ge2[j2].x), __expf(ge2[j2].y)}, inv = (f32x2){frcp(ei.x), frcp(ei.y)};
                At[j2] = aa2[j2] * ee; Rt[j2] = r2[j2] * ei; Bb[j2] = bb2[j2] * inv; Kb[j2] = kd2[j2] * inv;
                if (pp == 63) { GC[i0 + 2 * j2] = ei.x; GC[i0 + 2 * j2 + 1] = ei.y; } }
            *(LAS u32x4*)(lds + slot(0) + pp * PITCH + ig * 16) = PK4(At);
            *(LAS u32x4*)(lds + slot(1) + pp * PITCH + ig * 16) = PK4(Rt);
            *(LAS u32x4*)(lds + slot(2) + pp * PITCH + ig * 16) = PK4(Bb);
            *(LAS u32x4*)(lds + slot(3) + pp * PITCH + ig * 16) = PK4(Kb);
#undef PK4
#undef UP2
#undef LD2
        }
        __syncthreads();
        { const bf16x8 at0 = fragN(lds + slot(0), 16 * rt + fr, 0, fq), at1 = fragN(lds + slot(0), 16 * rt + fr, 1, fq), rt0 = fragN(lds + slot(1), 16 * rt + fr, 0, fq), rt1 = fragN(lds + slot(1), 16 * rt + fr, 1, fq);
#pragma unroll
          for (int ct = 0; ct < 2; ++ct) { const int ctt = 2 * chh + ct;
            f32x4 ab = (f32x4){0.f, 0.f, 0.f, 0.f}, ak = ab, rb = ab, rk = ab;
            if (ctt <= rt) {
                const bf16x8 b0 = fragN(lds + slot(2), 16 * ctt + fr, 0, fq), b1 = fragN(lds + slot(2), 16 * ctt + fr, 1, fq), k0 = fragN(lds + slot(3), 16 * ctt + fr, 0, fq), k1 = fragN(lds + slot(3), 16 * ctt + fr, 1, fq);
                ab = MFMA16(at0, b0, ab); ab = MFMA16(at1, b1, ab); ak = MFMA16(at0, k0, ak); ak = MFMA16(at1, k1, ak);
                rb = MFMA16(rt0, b0, rb); rb = MFMA16(rt1, b1, rb); rk = MFMA16(rt0, k0, rk); rk = MFMA16(rt1, k1, rk); }
            float vab[4], vak[4], vrb[4], vrk[4];
#pragma unroll
            for (int e = 0; e < 4; ++e) { const int prow = 16 * rt + 4 * fq + e, jcol = 16 * ctt + fr; const bool st = prow > jcol, inc = prow >= jcol;
                vab[e] = st ? ab[e] : 0.f; vak[e] = st ? ak[e] : 0.f; vrb[e] = inc ? rb[e] : 0.f; vrk[e] = inc ? rk[e] : 0.f; }
            const int off = (16 * ctt + fr) * PITCH + (16 * rt + 4 * fq) * 2;
            *(LAS u32x2*)(lds + O_GBUF + off) = (u32x2){pkbf(vab[0], vab[1]), pkbf(vab[2], vab[3])};
            *(LAS u32x2*)(lds + slot(7) + off) = (u32x2){pkbf(vak[0], vak[1]), pkbf(vak[2], vak[3])};
            *(LAS u32x2*)(lds + slot(8) + off) = (u32x2){pkbf(vrb[0], vrb[1]), pkbf(vrb[2], vrb[3])};
            *(LAS u32x2*)(lds + slot(9) + off) = (u32x2){pkbf(vrk[0], vrk[1]), pkbf(vrk[2], vrk[3])}; } }
        __syncthreads();
        f32x4 accA[4];
        f32x4 accK[4];
#pragma unroll
        for (int q = 0; q < 4; ++q) { accA[q] = (f32x4){0.f, 0.f, 0.f, 0.f}; accK[q] = accA[q]; }
        const int yg = (wave == 4) ? 3 : wave - 5;
        if (wave < 4) {
            const bf16x8 s0 = fragN(lds + O_SB, 16 * wave + fr, 0, fq), s1 = fragN(lds + O_SB, 16 * wave + fr, 1, fq), v0 = fragT(lds + slot(6), 16 * wave, 0, fr, fq), v1 = fragT(lds + slot(6), 16 * wave, 1, fr, fq);
#pragma unroll
            for (int q = 0; q < 4; ++q) { f32x4 a = accA[q];
                a = MFMA16(fragN(lds + slot(0), 16 * q + fr, 0, fq), s0, a); a = MFMA16(fragN(lds + slot(0), 16 * q + fr, 1, fq), s1, a);
                a = MFMA16(fragT(lds + slot(7), 16 * q, 0, fr, fq), v0, a); if (q >= 2) a = MFMA16(fragT(lds + slot(7), 16 * q, 1, fr, fq), v1, a);
                accA[q] = a;
                f32x4 kx = accK[q]; kx = MFMA16(fragT(lds + slot(3), 16 * q, 0, fr, fq), v0, kx); kx = MFMA16(fragT(lds + slot(3), 16 * q, 1, fr, fq), v1, kx); accK[q] = kx;
                asm volatile("" ::: "memory"); }
        } else if (wave == 4) {
            const int pb = fq, j = fr; float T[16];
#pragma unroll
            for (int q = 0; q < 16; ++q) T[q] = (q == j) ? 1.f : 0.f;
#pragma unroll
            for (int sg = 0; sg < 4; ++sg) {
                u32x4 ar[4][2];
#pragma unroll
                for (int r4 = 0; r4 < 4; ++r4) { ar[r4][0] = *(const LAS u32x4*)(lds + O_GBUF + (16 * pb + 4 * sg + r4) * PITCH + 32 * pb); ar[r4][1] = *(const LAS u32x4*)(lds + O_GBUF + (16 * pb + 4 * sg + r4) * PITCH + 32 * pb + 16); }
#pragma unroll
                for (int r4 = 0; r4 < 4; ++r4) { const int s2 = 4 * sg + r4; float av[16]; unpack8(ar[r4][0], av); unpack8(ar[r4][1], av + 8);
#pragma unroll
                    for (int q = s2 + 1; q < 16; ++q) T[q] += av[q] * T[s2]; }
                asm volatile("" ::: "memory");
            }
#pragma unroll
            for (int q = 0; q < 16; ++q) TPP[(pb * 16 + q) * 20 + j] = (bf16_t)f2bf(T[q]);
        }
#define Y_PART() do { const bf16x8 s0 = fragN(lds + O_SB, 16 * yg + fr, 0, fq), s1 = fragN(lds + O_SB, 16 * yg + fr, 1, fq), v0 = fragT(lds + slot(6), 16 * yg, 0, fr, fq), v1 = fragT(lds + slot(6), 16 * yg, 1, fr, fq); \
            _Pragma("unroll") for (int q = 0; q < 4; ++q) { f32x4 a = accA[q]; \
                a = MFMA16(fragN(lds + slot(1), 16 * q + fr, 0, fq), s0, a); a = MFMA16(fragN(lds + slot(1), 16 * q + fr, 1, fq), s1, a); \
                a = MFMA16(fragT(lds + slot(9), 16 * q, 0, fr, fq), v0, a); if (q >= 2) a = MFMA16(fragT(lds + slot(9), 16 * q, 1, fr, fq), v1, a); \
                accA[q] = a; asm volatile("" ::: "memory"); } } while (0)
        if (wave >= 5) Y_PART();
        __syncthreads();
        if (wave < 4) {
            u32x2 Ub[4];
            bf16x8 fa[4]; u32x2 ft[4];
#pragma unroll
            for (int z = 0; z < 4; ++z) { const int pb = (z == 3) ? 3 : z + 1, k2 = (z == 3) ? 1 : 0;
                fa[z] = fragT(lds + O_GBUF, 16 * pb, k2, fr, fq);
                ft[z] = *(const LAS u32x2*)(lds + O_TPP + ((z * 16 + fr) * 20 + 4 * fq) * 2); }
#pragma unroll
            for (int pb = 0; pb < 4; ++pb) {
                f32x4 tmp = accA[pb];
#pragma unroll
                for (int k2 = 0; k2 < 2; ++k2) if (2 * k2 < pb) { const int z = (pb == 3 && k2 == 1) ? 3 : pb - 1;
                    const u32x2 b0 = Ub[2 * k2]; const u32x2 b1 = (2 * k2 + 1 < pb) ? Ub[2 * k2 + 1] : (u32x2){0u, 0u};
                    const u32x4 bv = (u32x4){b0.x, b0.y, b1.x, b1.y};
                    tmp = MFMA16(fa[z], __builtin_bit_cast(bf16x8, bv), tmp); }
                const u32x4 av = (u32x4){ft[pb].x, ft[pb].y, 0u, 0u}, bv = (u32x4){pkbf(tmp[0], tmp[1]), pkbf(tmp[2], tmp[3]), 0u, 0u};
                const f32x4 U = MFMA16(__builtin_bit_cast(bf16x8, av), __builtin_bit_cast(bf16x8, bv), ((f32x4){0.f, 0.f, 0.f, 0.f}));
                Ub[pb] = (u32x2){pkbf(U[0], U[1]), pkbf(U[2], U[3])};
                *(LAS u32x2*)(lds + slot(4) + (16 * wave + fr) * PITCH + (16 * pb + 4 * fq) * 2) = Ub[pb];
            }
        } else if (wave == 4) Y_PART();
#undef Y_PART
        __syncthreads();
        if (wave >= 4) {
            const bf16x8 u0 = fragP(lds + slot(4), 16 * yg + fr, 0, fq), u1 = fragP(lds + slot(4), 16 * yg + fr, 1, fq);
#pragma unroll
            for (int q = 0; q < 4; ++q) { f32x4 a = accA[q];
                a = MFMA16(fragT(lds + slot(8), 16 * q, 0, fr, fq), u0, a); if (q >= 2) a = MFMA16(fragT(lds + slot(8), 16 * q, 1, fr, fq), u1, a);
#pragma unroll
                for (int e = 0; e < 4; ++e) *(LAS bf16_t*)(lds + slot(9) + (16 * q + 4 * fq + e) * PITCH + (16 * yg + fr) * 2) = (bf16_t)f2bf(a[e]); }
        } else {
            const bf16x8 u0 = fragP(lds + slot(4), 16 * wave + fr, 0, fq), u1 = fragP(lds + slot(4), 16 * wave + fr, 1, fq);
#pragma unroll
            for (int it = 0; it < 4; ++it) { f32x4 a = Sreg[it] + accK[it];
                a = MFMA16(fragT(lds + slot(2), 16 * it, 0, fr, fq), u0, a); a = MFMA16(fragT(lds + slot(2), 16 * it, 1, fr, fq), u1, a);
                const f32x4 gc = *(const LAS f32x4*)(GC + 16 * it + 4 * fq);
                a = a * gc; Sreg[it] = a;
                *(LAS u32x2*)(lds + O_SB + (16 * wave + fr) * PITCH + (16 * it + 4 * fq) * 2) = (u32x2){pkbf(a[0], a[1]), pkbf(a[2], a[3])};
                asm volatile("" ::: "memory"); }
        }
    }
    __syncthreads();
    { int tq = tid; asm volatile("" : "+v"(tq)); const int pp = tq >> 3, ig = tq & 7, i0 = ig * 8;
      const int t0p = (dir ? 0 : (L / 64 - 1)) * 64; const int ttp = dir ? (t0p + 63 - pp) : (t0p + pp);
      *(u32x4*)(Y + ((size_t)b * L + ttp) * 512 + h * 64 + i0) = *(const LAS u32x4*)(lds + slot(9) + pp * PITCH + ig * 16); }
    __syncthreads();
#undef issue_loads
}

constexpr int PT = 128;
__device__ __forceinline__ void rw_post_wg(const Params& p, LAS unsigned char* lds, int l, int G_, int bid, const int wvx) {
    const int tid = opaque_tid(wvx), lane = tid & 63, wave = __builtin_amdgcn_readfirstlane(tid >> 6), fr = lane & 15, fq = lane >> 4;
    const int h = bid & 7;
    const bf16_t* proj = (const bf16_t*)(p.ws + OFF_PROJ);
    const bf16_t* YF = (const bf16_t*)(p.ws + OFF_YF); const bf16_t* YB = (const bf16_t*)(p.ws + OFF_YB);
    const float* BONF = (const float*)(p.ws + OFF_BON); const float* BONB = BONF + (size_t)NT * 8;
    bf16_t* mix = (bf16_t*)(p.ws + OFF_MIX);
    constexpr int GP = 272;
    LAS unsigned char* G2T = lds;
    LAS unsigned char* SG = lds + 17408;
    LAS unsigned char* RAWV = lds + 52224;
    LAS unsigned char* GATE = lds + 68864;
    __syncthreads();
    { const float* g2 = p.in[22] + (size_t)l * 128 * 512 + h * 64;
        for (int i = tid; i < 8192; i += NTHREADS) { const int r = i >> 6, n = i & 63; *(LAS bf16_t*)(G2T + n * GP + r * 2) = (bf16_t)f2bf(g2[r * 512 + n]); } }
    const int ig = tid & 7, i0 = ig * 8, col = h * 64 + i0;
    float mv0[8], mv1[8], lnw[8], lnb[8];
#pragma unroll
    for (int j = 0; j < 8; ++j) { mv0[j] = p.in[14][(size_t)l * 3072 + 2 * 1024 + col + j]; mv1[j] = p.in[14][(size_t)l * 3072 + 2 * 1024 + 512 + col + j]; lnw[j] = p.in[23][l * 512 + col + j]; lnb[j] = p.in[24][l * 512 + col + j]; }
#pragma unroll 1
    for (int tile = bid >> 3; tile < NT / PT; tile += G_ >> 3) {
        const int row0 = tile * PT, tb0 = row0 & (L - 1);
        __syncthreads();
        u32x4 gq[4], vq[3]; u32x4 yq[2][2]; float bq[2];
#pragma unroll
        for (int k = 0; k < 4; ++k) { const int q = tid + k * NTHREADS; gq[k] = *(const u32x4*)(proj + (size_t)(row0 + (q >> 4)) * IN_DP + C_RG + (q & 15) * 8); }
#pragma unroll
        for (int k = 0; k < 3; ++k) { const int q = tid + k * NTHREADS; const int rr = q >> 3, ch = q & 7; const int tt = tb0 - 1 + rr; vq[k] = (u32x4){0u, 0u, 0u, 0u};
            if (q < 1040 && tt >= 0 && tt < L) vq[k] = *(const u32x4*)(proj + (size_t)(row0 - 1 + rr) * IN_DP + C_RV + h * 64 + ch * 8); }
#pragma unroll
        for (int sl = 0; sl < 2; ++sl) { const size_t row = (size_t)row0 + (tid >> 3) + 64 * sl; yq[sl][0] = *(const u32x4*)(YF + row * 512 + col); yq[sl][1] = *(const u32x4*)(YB + row * 512 + col);
            const size_t bi = ((size_t)(row >> 13) * 8 + h) * L + (row & (L - 1)); bq[sl] = BONF[bi] + BONB[bi]; }
#pragma unroll
        for (int k = 0; k < 4; ++k) { const int q = tid + k * NTHREADS; const int t = q >> 4, ch = q & 15; float f[8]; unpack8(gq[k], f);
            u32x4 w; w.x = pk2(frcp(1.f + __expf(-f[0])), frcp(1.f + __expf(-f[1]))); w.y = pk2(frcp(1.f + __expf(-f[2])), frcp(1.f + __expf(-f[3])));
            w.z = pk2(frcp(1.f + __expf(-f[4])), frcp(1.f + __expf(-f[5]))); w.w = pk2(frcp(1.f + __expf(-f[6])), frcp(1.f + __expf(-f[7])));
            *(LAS u32x4*)(SG + t * GP + ch * 16) = w; }
#pragma unroll
        for (int k = 0; k < 3; ++k) { const int q = tid + k * NTHREADS; if (q < 1040) *(LAS u32x4*)(RAWV + (q >> 3) * 128 + (q & 7) * 16) = vq[k]; }
        __syncthreads();
#pragma unroll
        for (int ct = 0; ct < 4; ++ct) { f32x4 acc = (f32x4){0.f, 0.f, 0.f, 0.f};
#pragma unroll
            for (int ks = 0; ks < 4; ++ks) { const bf16x8 a = *(const LAS bf16x8*)(SG + (16 * wave + fr) * GP + ks * 64 + fq * 16); const bf16x8 b = *(const LAS bf16x8*)(G2T + (16 * ct + fr) * GP + ks * 64 + fq * 16);
                acc = __builtin_amdgcn_mfma_f32_16x16x32_bf16(a, b, acc, 0, 0, 0); }
#pragma unroll
            for (int e = 0; e < 4; ++e) *(LAS bf16_t*)(GATE + (16 * wave + 4 * fq + e) * 144 + (16 * ct + fr) * 2) = (bf16_t)f2bf(acc[e]); }
        __syncthreads();
#pragma unroll
        for (int sl = 0; sl < 2; ++sl) { const int t = (tid >> 3) + 64 * sl; const size_t row = (size_t)row0 + t;
            float vp[8], vc[8], vn[8], gt[8];
            unpack8(*(const LAS u32x4*)(RAWV + t * 128 + ig * 16), vp); unpack8(*(const LAS u32x4*)(RAWV + (t + 1) * 128 + ig * 16), vc); unpack8(*(const LAS u32x4*)(RAWV + (t + 2) * 128 + ig * 16), vn);
            unpack8(*(const LAS u32x4*)(GATE + t * 144 + ig * 16), gt);
            float yf8[8], yb8[8]; unpack8(yq[sl][0], yf8); unpack8(yq[sl][1], yb8);
            const float bon = bq[sl];
            float y[8] = {yf8[0] + yb8[0], yf8[1] + yb8[1], yf8[2] + yb8[2], yf8[3] + yb8[3], yf8[4] + yb8[4], yf8[5] + yb8[5], yf8[6] + yb8[6], yf8[7] + yb8[7]};
            float sm = 0.f;
#pragma unroll
            for (int j = 0; j < 8; ++j) sm += y[j];
            const float mean = sum8(sm) * (1.0f / 64.0f);
            float sq = 0.f;
#pragma unroll
            for (int j = 0; j < 8; ++j) { y[j] -= mean; sq += y[j] * y[j]; }
            const float rstd = __builtin_amdgcn_rsqf(sum8(sq) * (1.0f / 64.0f) + 64e-5f);
            float o[8];
#pragma unroll
            for (int j = 0; j < 8; ++j) { const float v = vc[j] + mv0[j] * (vp[j] - vc[j]) + mv1[j] * (vn[j] - vc[j]); o[j] = (y[j] * rstd * lnw[j] + lnb[j] + bon * v) * gt[j]; }
            u32x4 w; w.x = pk2(o[0], o[1]); w.y = pk2(o[2], o[3]); w.z = pk2(o[4], o[5]); w.w = pk2(o[6], o[7]);
            *(u32x4*)(mix + row * D + 256 + col) = w; }
    }
    __syncthreads();
}

namespace na {
constexpr int O_K = 0, O_V = 65536, O_RPB = 131072, O_MX = 133120, O_QW = 142080;
__device__ __forceinline__ int rowoff(int keycol, int byte) { return keycol * 128 + ((((byte >> 5) ^ keycol) & 3) << 5) + (byte & 31); }
typedef short s16x4 __attribute__((ext_vector_type(4)));
}
__device__ __forceinline__ void na_strip(const Params& p, LAS unsigned char* lds, int l, int strip, const int wvx) {
    using namespace na;
    const int tid = opaque_tid(wvx), lane = tid & 63, wave = __builtin_amdgcn_readfirstlane(tid >> 6), fr = lane & 15, fq = lane >> 4;
    const int b = strip >> 5, h = (strip >> 3) & 3, i0 = (strip & 7) * 16;
    const int g = wave & 3, kh = wave >> 2;
    const bf16_t* proj = (const bf16_t*)(p.ws + OFF_PROJ);
    bf16_t* mix = (bf16_t*)(p.ws + OFF_MIX);
    LAS float* RPB = (LAS float*)(lds + O_RPB);
    LAS unsigned char* MX = lds + O_MX + g * 2240;
    const int j0 = 16 * g, c0 = (g == 0) ? 0 : ((g == 3) ? 32 : 16 * g - 8);
    __syncthreads();
    for (int q = tid; q < 465; q += NTHREADS) RPB[q] = p.in[25][((size_t)l * 4 + h) * 465 + q];
    { int rs = i0 - 4; rs = rs < 0 ? 0 : (rs > 120 ? 120 : rs);
        u32x4 fw[16];
#pragma unroll
        for (int k = 0; k < 16; ++k) { const int q = tid + k * NTHREADS; const int r8 = q >> 10, which = (q >> 9) & 1, col = (q >> 3) & 63, ch = q & 7; const int kr = rs + r8;
            fw[k] = *(const u32x4*)(proj + ((size_t)b * L + kr * 64 + col) * IN_DP + (which ? C_NV : C_NK) + h * 64 + ch * 8); }
#pragma unroll
        for (int k = 0; k < 16; ++k) { const int q = tid + k * NTHREADS; const int r8 = q >> 10, which = (q >> 9) & 1, col = (q >> 3) & 63, ch = q & 7; const int kr = rs + r8;
            *(LAS u32x4*)(lds + (which ? O_V : O_K) + (kr & 7) * 8192 + rowoff(col, 16 * ch)) = fw[k]; } }
    bf16x8 Bq[2];
#pragma unroll
    for (int ks = 0; ks < 2; ++ks) Bq[ks] = *(const bf16x8*)(proj + ((size_t)b * L + i0 * 64 + j0 + fr) * IN_DP + C_NQ + h * 64 + 32 * ks + 8 * fq);
    const int jq = j0 + fr;
    int cs = jq - 8; cs = cs < 0 ? 0 : (cs > 48 ? 48 : cs);
    const u32x4 onesv = (u32x4){0x3F803F80u, 0x3F803F80u, 0x3F803F80u, 0x3F803F80u};
#pragma unroll 1
    for (int i = i0; i < i0 + 16; ++i) {
        int rs = i - 4; rs = rs < 0 ? 0 : (rs > 120 ? 120 : rs);
        int rsn = i + 1 - 4; rsn = rsn < 0 ? 0 : (rsn > 120 ? 120 : rsn);
        const bool more = (i + 1 < i0 + 16), newrow = more && (rsn > rs);
        __syncthreads();
        u32x4 pre0 = (u32x4){0u, 0u, 0u, 0u}, pre1 = pre0; bf16x8 Bqn[2] = {Bq[0], Bq[1]};
        if (newrow) { const int kr = rsn + 7;
            { const int q = tid; const int which = q >> 9, col = (q >> 3) & 63, ch = q & 7; pre0 = *(const u32x4*)(proj + ((size_t)b * L + kr * 64 + col) * IN_DP + (which ? C_NV : C_NK) + h * 64 + ch * 8); }
            { const int q = tid + 512; const int which = q >> 9, col = (q >> 3) & 63, ch = q & 7; pre1 = *(const u32x4*)(proj + ((size_t)b * L + kr * 64 + col) * IN_DP + (which ? C_NV : C_NK) + h * 64 + ch * 8); } }
        if (more) {
#pragma unroll
            for (int ks = 0; ks < 2; ++ks) Bqn[ks] = *(const bf16x8*)(proj + ((size_t)b * L + (i + 1) * 64 + j0 + fr) * IN_DP + C_NQ + h * 64 + 32 * ks + 8 * fq); }
        f32x4 S[4][2]; float mloc = -1e30f;
#pragma unroll
        for (int r4 = 0; r4 < 4; ++r4) { const int krow = rs + 4 * kh + r4, slot = krow & 7, dr = krow - i + 7;
#pragma unroll
            for (int ct = 0; ct < 2; ++ct) { const int keycol = c0 + 16 * ct + fr; f32x4 acc = (f32x4){0.f, 0.f, 0.f, 0.f};
#pragma unroll
                for (int ks = 0; ks < 2; ++ks) { const bf16x8 a = *(const LAS bf16x8*)(lds + O_K + slot * 8192 + rowoff(keycol, 64 * ks + 16 * fq)); acc = __builtin_amdgcn_mfma_f32_16x16x32_bf16(a, Bq[ks], acc, 0, 0, 0); }
#pragma unroll
                for (int e = 0; e < 4; ++e) { const int kc = c0 + 16 * ct + 4 * fq + e; const bool valid = (kc >= cs) && (kc < cs + 16);
                    int dc = kc - jq; dc = dc < -15 ? -15 : (dc > 15 ? 15 : dc); dc += 15;
                    const float sc = valid ? (acc[e] * 0.125f + RPB[dr * 31 + dc]) : -1e30f; acc[e] = sc; mloc = fmaxf(mloc, sc); }
                S[r4][ct] = acc; } }
        { int lid; asm volatile("v_mbcnt_lo_u32_b32 %0, -1, 0\n\tv_mbcnt_hi_u32_b32 %0, -1, %0" : "=v"(lid));
          mloc = fmaxf(mloc, __int_as_float(__builtin_amdgcn_ds_bpermute((lid ^ 16) << 2, __float_as_int(mloc))));
          mloc = fmaxf(mloc, __int_as_float(__builtin_amdgcn_ds_bpermute((lid ^ 32) << 2, __float_as_int(mloc)))); }
        bf16x8 Ap[4];
#pragma unroll
        for (int r4 = 0; r4 < 4; ++r4) { float pv[8];
#pragma unroll
            for (int ct = 0; ct < 2; ++ct)
#pragma unroll
                for (int e = 0; e < 4; ++e) { const float sc = S[r4][ct][e]; pv[ct * 4 + e] = (sc > -1e29f) ? __expf(sc - mloc) : 0.f; }
            const u32x4 w = (u32x4){pk2(pv[0], pv[1]), pk2(pv[2], pv[3]), pk2(pv[4], pv[5]), pk2(pv[6], pv[7])}; Ap[r4] = __builtin_bit_cast(bf16x8, w); }
        f32x4 O[4], Ls = (f32x4){0.f, 0.f, 0.f, 0.f};
#pragma unroll
        for (int dt = 0; dt < 4; ++dt) O[dt] = (f32x4){0.f, 0.f, 0.f, 0.f};
#pragma unroll
        for (int r4 = 0; r4 < 4; ++r4) { const int slot = (rs + 4 * kh + r4) & 7; const int kc0 = c0 + 4 * fq + (fr >> 2), kc1 = kc0 + 16;
            Ls = __builtin_amdgcn_mfma_f32_16x16x32_bf16(Ap[r4], __builtin_bit_cast(bf16x8, onesv), Ls, 0, 0, 0);
#pragma unroll
            for (int dt = 0; dt < 4; ++dt) {
                const s16x4 v0 = __builtin_amdgcn_ds_read_tr16_b64_v4i16((LAS s16x4*)(lds + O_V + slot * 8192 + rowoff(kc0, 32 * dt + 8 * (fr & 3))));
                const s16x4 v1 = __builtin_amdgcn_ds_read_tr16_b64_v4i16((LAS s16x4*)(lds + O_V + slot * 8192 + rowoff(kc1, 32 * dt + 8 * (fr & 3))));
                const bf16x8 bv = (bf16x8){v0[0], v0[1], v0[2], v0[3], v1[0], v1[1], v1[2], v1[3]};
                O[dt] = __builtin_amdgcn_mfma_f32_16x16x32_bf16(Ap[r4], bv, O[dt], 0, 0, 0); } }
        if (fq == 0) *(LAS float*)(MX + kh * 64 + fr * 4) = mloc;
        if (kh == 1) { if (fr == 0) *(LAS f32x4*)(MX + 128 + fq * 16) = Ls;
#pragma unroll
            for (int dt = 0; dt < 4; ++dt)
#pragma unroll
                for (int e = 0; e < 4; ++e) *(LAS bf16_t*)(MX + 192 + (4 * fq + e) * 128 + (16 * dt + fr) * 2) = (bf16_t)f2bf(O[dt][e]); }
        __syncthreads();
        if (newrow) { const int kr = rsn + 7;
            { const int q = tid; const int which = q >> 9, col = (q >> 3) & 63, ch = q & 7; *(LAS u32x4*)(lds + (which ? O_V : O_K) + (kr & 7) * 8192 + rowoff(col, 16 * ch)) = pre0; }
            { const int q = tid + 512; const int which = q >> 9, col = (q >> 3) & 63, ch = q & 7; *(LAS u32x4*)(lds + (which ? O_V : O_K) + (kr & 7) * 8192 + rowoff(col, 16 * ch)) = pre1; } }
        if (kh == 0) {
            const f32x4 m0 = *(const LAS f32x4*)(MX + fq * 16), m1 = *(const LAS f32x4*)(MX + 64 + fq * 16), l1 = *(const LAS f32x4*)(MX + 128 + fq * 16);
#pragma unroll
            for (int e = 0; e < 4; ++e) { const float M = fmaxf(m0[e], m1[e]), a0 = __expf(m0[e] - M), a1 = __expf(m1[e] - M); const float inv = frcp(Ls[e] * a0 + l1[e] * a1);
                const size_t row = (size_t)b * L + i * 64 + j0 + 4 * fq + e;
#pragma unroll
                for (int dt = 0; dt < 4; ++dt) { const float o1 = bf2f(*(const LAS bf16_t*)(MX + 192 + (4 * fq + e) * 128 + (16 * dt + fr) * 2));
                    mix[row * D + 768 + h * 64 + 16 * dt + fr] = (bf16_t)f2bf((O[dt][e] * a0 + o1 * a1) * inv); } }
        }
        Bq[0] = Bqn[0]; Bq[1] = Bqn[1];
    }
    __syncthreads();
}

__device__ __forceinline__ void wg_signal(int* ctr, const bool leader) {
    asm volatile("s_waitcnt vmcnt(0)" ::: "memory");
    __syncthreads();
    if (leader) { __builtin_amdgcn_fence(__ATOMIC_RELEASE, "agent"); asm volatile("s_waitcnt vmcnt(0)" ::: "memory"); __hip_atomic_fetch_add(ctr, 1, __ATOMIC_RELAXED, __HIP_MEMORY_SCOPE_AGENT); }
}
__device__ __forceinline__ void wg_wait(int* ctr, int target, const bool leader) {
    if (leader) { unsigned sp = 0;
        while (__hip_atomic_load(ctr, __ATOMIC_RELAXED, __HIP_MEMORY_SCOPE_AGENT) < target) { __builtin_amdgcn_s_sleep(2); if (++sp > (1u << 24)) break; }
        __builtin_amdgcn_fence(__ATOMIC_ACQUIRE, "agent"); asm volatile("s_waitcnt vmcnt(0)" ::: "memory"); }
    __syncthreads();
}
__device__ __forceinline__ int wg_pop(int* ctr, LAS int* qw, const bool leader) {
    __syncthreads();
    if (leader) *qw = __hip_atomic_fetch_add(ctr, 1, __ATOMIC_RELAXED, __HIP_MEMORY_SCOPE_AGENT);
    __syncthreads();
    return __builtin_amdgcn_readfirstlane(*qw);
}
__device__ __forceinline__ void na_queue(const Params& p, LAS unsigned char* lds, int l, const int wvx) {
    int* ctr = (int*)(p.ws + OFF_CTL) + 16 + l;
    LAS int* qw = (LAS int*)(lds + na::O_QW);
    for (;;) {
        __syncthreads();
        if (opaque_tid(wvx) == 0) *qw = atomicAdd(ctr, 1);
        __syncthreads();
        const int strip = __builtin_amdgcn_readfirstlane(*qw);
        if (strip >= 256) break;
        na_strip(p, lds, l, strip, wvx);
    }
}

__device__ __forceinline__ void phase_router(const Params& p, LAS unsigned char* lds, int l, int G_, int bid, const int wvx) {
    const int tid = opaque_tid(wvx), lane = tid & 63, wave = __builtin_amdgcn_readfirstlane(tid >> 6), fr = lane & 15, fq = lane >> 4;
    const bf16_t* x = (const bf16_t*)(p.ws + OFF_XB); float* rs = (float*)(p.ws + OFF_RS);
    const bf16_t* rgh = (const bf16_t*)(p.ws + OFF_RGW) + (size_t)l * 2 * 48 * D; const bf16_t* rgl = rgh + 48 * D;
    int* cnt = (int*)(p.ws + OFF_CTL) + 64 + l * 64;
    int* ltok = (int*)(p.ws + OFF_LTOK); float* lgate = (float*)(p.ws + OFF_LGATE); float* lrs = (float*)(p.ws + OFF_LRS);
    LAS int* lcnt = (LAS int*)lds;
    LAS int* lbase = lcnt + 32;
    LAS int* se = lbase + 32;
    LAS int* sp = se + 512;
    LAS float* sg = (LAS float*)(sp + 512);
    LAS float* LG = (LAS float*)(lds + 8192);
    LAS float* SQ = LG + 256 * 52;
    const float* bg = p.in[29] + l * 4; const float* be = p.in[31] + l * 32;
    for (int chunk = bid; chunk < NT / 256; chunk += G_) {
        __syncthreads();
        if (tid < 32) lcnt[tid] = 0;
        const int tl0 = wave * 32;
        const bf16_t* xa_p = x + (size_t)(chunk * 256 + tl0 + fr) * D + 8 * fq; const bf16_t* xb_p = xa_p + 16 * D;
        const bf16_t* wh_p = rgh + (size_t)fr * D + 8 * fq; const bf16_t* wl_p = rgl + (size_t)fr * D + 8 * fq;
        f32x4 acc[2][3];
#pragma unroll
        for (int t = 0; t < 2; ++t)
#pragma unroll
            for (int c = 0; c < 3; ++c) acc[t][c] = (f32x4){0.f, 0.f, 0.f, 0.f};
        float ssa = 0.f, ssb = 0.f;
#pragma unroll 2
        for (int ks = 0; ks < 32; ++ks) {
            const u32x4 ar = *(const u32x4*)(xa_p + 32 * ks), br = *(const u32x4*)(xb_p + 32 * ks);
            bf16x8 wh[3], wl[3];
#pragma unroll
            for (int c = 0; c < 3; ++c) { wh[c] = *(const bf16x8*)(wh_p + (size_t)16 * c * D + 32 * ks); wl[c] = *(const bf16x8*)(wl_p + (size_t)16 * c * D + 32 * ks); }
            { float f[8]; unpack8(ar, f);
#pragma unroll
              for (int j = 0; j < 8; ++j) ssa += f[j] * f[j];
              unpack8(br, f);
#pragma unroll
              for (int j = 0; j < 8; ++j) ssb += f[j] * f[j]; }
            const bf16x8 a0 = __builtin_bit_cast(bf16x8, ar), a1 = __builtin_bit_cast(bf16x8, br);
#pragma unroll
            for (int c = 0; c < 3; ++c) {
                acc[0][c] = __builtin_amdgcn_mfma_f32_16x16x32_bf16(a0, wh[c], acc[0][c], 0, 0, 0); acc[0][c] = __builtin_amdgcn_mfma_f32_16x16x32_bf16(a0, wl[c], acc[0][c], 0, 0, 0);
                acc[1][c] = __builtin_amdgcn_mfma_f32_16x16x32_bf16(a1, wh[c], acc[1][c], 0, 0, 0); acc[1][c] = __builtin_amdgcn_mfma_f32_16x16x32_bf16(a1, wl[c], acc[1][c], 0, 0, 0); }
        }
#pragma unroll
        for (int t = 0; t < 2; ++t)
#pragma unroll
            for (int c = 0; c < 3; ++c)
#pragma unroll
                for (int e = 0; e < 4; ++e) LG[(tl0 + 16 * t + 4 * fq + e) * 52 + 16 * c + fr] = acc[t][c][e];
        SQ[(tl0 + fr) * 4 + fq] = ssa; SQ[(tl0 + 16 + fr) * 4 + fq] = ssb;
        __syncthreads();
        if (lane < 32) { const int tl = tl0 + lane, row = chunk * 256 + tl;
            const f32x4 s4 = *(const LAS f32x4*)(SQ + tl * 4);
            const float rr = 1.0f / sqrtf(((s4.x + s4.y) + (s4.z + s4.w)) * (1.0f / D) + NORM_EPS);
            rs[row] = rr; SQ[tl * 4] = rr;
            const LAS float* lg = LG + tl * 52;
            const float g0 = lg[0] * rr + bg[0], g1 = lg[1] * rr + bg[1], g2 = lg[2] * rr + bg[2], g3 = lg[3] * rr + bg[3];
            int gs = 0; float gm = g0; if (g1 > gm) { gm = g1; gs = 1; } if (g2 > gm) { gm = g2; gs = 2; } if (g3 > gm) { gm = g3; gs = 3; }
            const float gprob = 1.0f / (expf(g0 - gm) + expf(g1 - gm) + expf(g2 - gm) + expf(g3 - gm));
            float ev[8];
#pragma unroll
            for (int e = 0; e < 8; ++e) ev[e] = lg[4 + gs * 8 + e] * rr + be[gs * 8 + e];
            int i0 = 0; float v0 = ev[0];
#pragma unroll
            for (int e = 1; e < 8; ++e) if (ev[e] > v0) { v0 = ev[e]; i0 = e; }
            int i1 = -1; float v1 = -3.0e38f;
#pragma unroll
            for (int e = 0; e < 8; ++e) if (e != i0 && ev[e] > v1) { v1 = ev[e]; i1 = e; }
            const float e1 = expf(v1 - v0), den = 1.0f + e1;
            const int ea = gs * 8 + i0, eb = gs * 8 + i1;
            se[tl * 2] = ea; se[tl * 2 + 1] = eb; sg[tl * 2] = gprob / den; sg[tl * 2 + 1] = gprob * e1 / den;
            sp[tl * 2] = atomicAdd((int*)lcnt + ea, 1); sp[tl * 2 + 1] = atomicAdd((int*)lcnt + eb, 1); }
        __syncthreads();
        if (tid < 32) lbase[tid] = atomicAdd(cnt + tid, lcnt[tid]);
        __syncthreads();
        { const int tl = tid >> 1, k = tid & 1, e = se[tid]; const size_t li = (size_t)e * LCAP + lbase[e] + sp[tid];
            ltok[li] = (chunk * 256 + tl) * 2 + k; lgate[li] = sg[tid]; lrs[li] = SQ[tl * 4]; }
    }
    __syncthreads();
}

__device__ __forceinline__ void phase_combine(const Params& p, bool last, int G_, int bid, const int wvx) {
    const int tid = opaque_tid(wvx), lane = tid & 63, wave = tid >> 6;
    float* out = p.out; bf16_t* x16 = (bf16_t*)(p.ws + OFF_XB); float* rs = (float*)(p.ws + OFF_RS);
    const bf16_t* yb = (const bf16_t*)(p.ws + OFF_YBUF);
    const float* gf = p.in[35];
    for (int row = bid * 8 + wave; row < NT; row += G_ * 8) {
        u32x2* xr = (u32x2*)(x16 + (size_t)row * D) + lane; const u32x2* y0 = (const u32x2*)(yb + (size_t)(2 * row) * D) + lane; const u32x2* y1 = (const u32x2*)(yb + (size_t)(2 * row + 1) * D) + lane;
        f32x4 v[4]; float s = 0.f; u32x2 xq[4], aq[4], cq[4];
#pragma unroll
        for (int j = 0; j < 4; ++j) { xq[j] = xr[64 * j]; aq[j] = y0[64 * j]; cq[j] = y1[64 * j]; }
#pragma unroll
        for (int j = 0; j < 4; ++j) { const u32x2 xx = xq[j], a = aq[j], c = cq[j];
            v[j].x = bf2f(xx.x & 0xffffu) + bf2f(a.x & 0xffffu) + bf2f(c.x & 0xffffu); v[j].y = __uint_as_float(xx.x & 0xffff0000u) + __uint_as_float(a.x & 0xffff0000u) + __uint_as_float(c.x & 0xffff0000u);
            v[j].z = bf2f(xx.y & 0xffffu) + bf2f(a.y & 0xffffu) + bf2f(c.y & 0xffffu); v[j].w = __uint_as_float(xx.y & 0xffff0000u) + __uint_as_float(a.y & 0xffff0000u) + __uint_as_float(c.y & 0xffff0000u);
            s += (v[j].x * v[j].x + v[j].y * v[j].y) + (v[j].z * v[j].z + v[j].w * v[j].w); }
        s = wave_sum(s);
        const float rr = 1.0f / sqrtf(s * (1.0f / D) + NORM_EPS);
        if (last) { f32x4* orow = (f32x4*)(out + (size_t)row * D) + lane;
#pragma unroll
            for (int j = 0; j < 4; ++j) { const f32x4 g = ((const f32x4*)gf)[lane + 64 * j]; orow[64 * j] = v[j] * rr * g; }
        } else {
            if (lane == 0) rs[row] = rr;
#pragma unroll
            for (int j = 0; j < 4; ++j) xr[64 * j] = (u32x2){pk2(v[j].x, v[j].y), pk2(v[j].z, v[j].w)};
        }
    }
}

#ifndef PH_MASK
#define PH_MASK 0xFFFFF
#endif
#define PH(k) if (PH_MASK & (1 << (k)))

#define XB_TMO      128
#define XB_XCNT(j)  (256  + 64 * (j))
#define XB_XSUB(j)  (1280 + 64 * (j))
#define XB_XGEN(j)  (2304 + 64 * (j))
#define XB_TOP      3328
#define XB_TOPGEN   3392
#define XCD_BAR_WORDS 3456
#define XB_SPIN_CAP (1u << 22)
__device__ __forceinline__ unsigned xb_ld(unsigned* p)              { return __hip_atomic_load(p, __ATOMIC_RELAXED, __HIP_MEMORY_SCOPE_AGENT); }
__device__ __forceinline__ unsigned xb_add(unsigned* p, unsigned v) { return __hip_atomic_fetch_add(p, v, __ATOMIC_RELAXED, __HIP_MEMORY_SCOPE_AGENT); }
__device__ __forceinline__ unsigned xb_xcc_id() { return (unsigned)__builtin_amdgcn_s_getreg((3 << 11) | 20) & 0xFu; }
#define XB_SPIN(cond, bar) do { unsigned _sp = 0; while (cond) { __builtin_amdgcn_s_sleep(1); \
    if ((++_sp & 255u) == 0u) { if (xb_ld(&(bar)[XB_TMO])) break; if (_sp > XB_SPIN_CAP) { atomicAdd(&(bar)[XB_TMO], 1u); break; } } } } while (0)
struct XcdBarrier { unsigned* bar; unsigned x; volatile LAS unsigned* st; };
__device__ __forceinline__ void xcd_barrier_complete(unsigned* bar, unsigned x, unsigned& nloc, unsigned& nx) {
    const unsigned G = gridDim.x * gridDim.y * gridDim.z;
    unsigned sum, cnt, mine, sp = 0u;
    for (;;) {
        sum = 0u; cnt = 0u; mine = 0u;
#pragma unroll
        for (unsigned j = 0; j < 16; ++j) { const unsigned c = xb_ld(&bar[XB_XCNT(j)]); sum += c; cnt += (c > 0u) ? 1u : 0u; mine = (j == x) ? c : mine; }
        if (sum == G) break;
        __builtin_amdgcn_s_sleep(1);
        if ((++sp & 255u) == 0u) { if (xb_ld(&bar[XB_TMO])) break; if (sp > XB_SPIN_CAP) { atomicAdd(&bar[XB_TMO], 1u); break; } }
    }
    nloc = mine > 0u ? mine : 1u; nx = cnt > 0u ? cnt : 1u;
}
__device__ __forceinline__ void xcd_barrier(const XcdBarrier& b, const bool leader) {
    asm volatile("s_waitcnt vmcnt(0)" ::: "memory");
    __syncthreads();
    if (leader) {
        unsigned* bar = b.bar;
        __builtin_amdgcn_s_waitcnt(0);
        unsigned nloc = b.st[0], nx = b.st[1];
        if (nloc == 0u) { xcd_barrier_complete(bar, b.x, nloc, nx); b.st[0] = nloc; b.st[1] = nx; }
        const unsigned old = xb_add(&bar[XB_XSUB(b.x)], 1u);
        const unsigned gen = old / nloc;
        if (old + 1u == (gen + 1u) * nloc) {
            __builtin_amdgcn_fence(__ATOMIC_RELEASE, "agent");
            asm volatile("s_waitcnt vmcnt(0)" ::: "memory");
            const unsigned og = xb_add(&bar[XB_TOP], 1u);
            const unsigned tg = og / nx;
            if (og + 1u == (tg + 1u) * nx) xb_add(&bar[XB_TOPGEN], 1u);
            else XB_SPIN(xb_ld(&bar[XB_TOPGEN]) == tg, bar);
            __builtin_amdgcn_fence(__ATOMIC_ACQUIRE, "agent");
            xb_add(&bar[XB_XGEN(b.x)], 1u);
            asm volatile("s_waitcnt vmcnt(0)" ::: "memory");
        } else {
            XB_SPIN(xb_ld(&bar[XB_XGEN(b.x)]) == gen, bar);
            __builtin_amdgcn_fence(__ATOMIC_ACQUIRE, "agent");
            asm volatile("s_waitcnt vmcnt(0)" ::: "memory");
        }
    }
    __syncthreads();
}

__device__ __forceinline__ Params load_params() {
#if defined(__HIP_DEVICE_COMPILE__)
    auto k = __builtin_amdgcn_kernarg_segment_ptr();
    asm volatile("" : "+s"(k));
    return *(const __attribute__((address_space(4))) Params*)k;
#else
    return Params{};
#endif
}
__global__ void __launch_bounds__(NTHREADS, 2) fwd_megakernel(Params p_unused) {
    extern __shared__ __attribute__((aligned(16))) unsigned char lds_raw[];
    LAS unsigned char* lds = (LAS unsigned char*)lds_raw;
    cg::grid_group grid = cg::this_grid();
    const int G_ = gridDim.x, bid = blockIdx.x;
    const int wvx = __builtin_amdgcn_readfirstlane((int)threadIdx.x >> 6);
    const bool leader = (threadIdx.x == 0);
    volatile LAS unsigned* bst = (volatile LAS unsigned*)(lds + LDS_BYTES - 16);
    if (leader) { bst[0] = 0u; bst[1] = 0u; }
    XcdBarrier xbar;
    { const Params p = load_params(); xbar.bar = (unsigned*)(p.ws + OFF_CTL) + 4096; xbar.x = xb_xcc_id(); xbar.st = bst;
      if (leader) (void)xb_add(&xbar.bar[XB_XCNT(xbar.x)], 1u); }
    __syncthreads();
#define GRID_BAR() do { const Params pb = load_params(); XcdBarrier xb2; xb2.bar = (unsigned*)(pb.ws + OFF_CTL) + 4096; xb2.x = xb_xcc_id(); xb2.st = bst; xcd_barrier(xb2, opaque_tid(wvx) == 0); } while (0)

    { const Params p = load_params(); PH(0) phase_prologue(p, lds, G_, bid, wvx); }
    { const Params p = load_params(); PH(0) filters_all(p, G_, bid, wvx); }
    { const Params p = load_params(); PH(1) phase_rownorm(p.in[0], (bf16_t*)(p.ws + OFF_XB), (float*)(p.ws + OFF_RS), G_, bid, wvx); }
    grid.sync();

#pragma unroll 1
    for (int l = 0; l < DEPTH; ++l) {
        PH(2) { const Params p = load_params(); unsigned char* ws = p.ws;
            DenseSched S; S.init((const bf16_t*)(ws + OFF_XB), (const bf16_t*)(ws + OFF_WTIN) + (size_t)l * IN_DP * D, NT, IN_DP, D, G_, bid);
            EpiProj E{(bf16_t*)(ws + OFF_PROJ), (const float*)(ws + OFF_RS)};
            pg8::gemm_phase<EpiProj, DenseSched, false>(lds, D, S, E, wvx);
        }
        GRID_BAR();
        {
            const bool lead = (opaque_tid(wvx) == 0);
            LAS int* qw = (LAS int*)(lds + na::O_QW);
#define CTR(k) ((int*)(load_params().ws + OFF_CTL) + 32 + l * 16 + (k))
            if (bid < 128) { PH(5) { const Params p = load_params(); rw_chain_unit(p, lds, l, bid, wvx); } }
            else {
                PH(3) for (;;) { const int u = wg_pop(CTR(0), qw, lead); if (u >= 4096) break; { const Params p = load_params(); hy_pre_unit(p, lds, l, u, wvx); } wg_signal(CTR(1), lead); }
                wg_wait(CTR(1), 4096, lead);
                PH(4) for (int c = bid - 128; c < 256; c += 128) { { const Params p = load_params(); hy_conv_unit(p, lds, l, c, wvx); } wg_signal(CTR(2), lead); }
            }
            PH(6) { const Params p = load_params(); na_queue(p, lds, l, wvx); }
            wg_wait(CTR(2), 256, lead);
            PH(7) for (;;) { const int u = wg_pop(CTR(3), qw, lead); if (u >= 4096) break; { const Params p = load_params(); hy_post_unit(p, lds, l, u, wvx); } wg_signal(CTR(4), lead); }
            wg_wait(CTR(4), 4096, lead);
            PH(10) for (;;) { const int u = wg_pop(CTR(5), qw, lead); if (u >= NEXP * 768 / 64 + (l == 0 ? 43 : 0)) break; { const Params p = load_params(); moe_weights_chunk(p, lds, l, u, wvx); } }
#undef CTR
        }
        GRID_BAR();
        PH(8) { const Params p = load_params(); rw_post_wg(p, lds, l, G_, bid, wvx); }
        GRID_BAR();
        PH(9) { const Params p = load_params(); unsigned char* ws = p.ws;
            DenseSched S; S.init((const bf16_t*)(ws + OFF_MIX), (const bf16_t*)(ws + OFF_WTOUT) + (size_t)l * D * D, NT, D, D, G_, bid);
            EpiRes E{(bf16_t*)(ws + OFF_XB)};
            pg8::gemm_phase<EpiRes, DenseSched, false>(lds, D, S, E, wvx);
        }
        GRID_BAR();
        PH(11) { const Params p = load_params(); phase_router(p, lds, l, G_, bid, wvx); }
        GRID_BAR();
        PH(12) { const Params p = load_params(); unsigned char* ws = p.ws;
            const int* cnt = (const int*)(ws + OFF_CTL) + 64 + l * 64;
            MoeSched S; S.init(cnt, (const bf16_t*)(ws + OFF_XB), (const bf16_t*)(ws + OFF_W13T), (size_t)1024 * D, (const int*)(ws + OFF_LTOK), D, G_, bid, (LAS int*)(lds + 139264), opaque_tid(wvx));
            EpiMoe1 E{(bf16_t*)(ws + OFF_ACT), (const float*)(ws + OFF_LRS)};
            pg8::gemm_phase<EpiMoe1, MoeSched, true>(lds, D, S, E, wvx);
        }
        GRID_BAR();
        PH(13) { const Params p = load_params(); unsigned char* ws = p.ws;
            const int* cnt = (const int*)(ws + OFF_CTL) + 64 + l * 64;
            MoeSched S; S.init(cnt, (const bf16_t*)(ws + OFF_ACT), (const bf16_t*)(ws + OFF_W2T), (size_t)D * FF, nullptr, FF, G_, bid, (LAS int*)(lds + 139264), opaque_tid(wvx));
            EpiMoe2 E{(bf16_t*)(ws + OFF_YBUF), (const int*)(ws + OFF_LTOK), (const float*)(ws + OFF_LGATE)};
            pg8::gemm_phase<EpiMoe2, MoeSched, false>(lds, FF, S, E, wvx);
        }
        GRID_BAR();
        PH(14) { const Params p = load_params(); phase_combine(p, l == DEPTH - 1, G_, bid, wvx); }
        if (l < DEPTH - 1) GRID_BAR();
    }
}

extern "C" void kernel_launch(void* const* d_in, const int* in_sizes, int n_in, void* d_out, int out_size, void* d_ws, size_t ws_size, hipStream_t stream) {
    static int grid = 0;
    if (grid == 0) {
        if (n_in != 36 || ws_size < WS_END) { fprintf(stderr, "kernel_launch: unexpected n_in %d / ws_size %zu (need %zu)\n", n_in, ws_size, (size_t)WS_END); grid = -1; return; }
        int dev = 0, cus = 0, per_cu = 0;
        hipGetDevice(&dev);
        hipDeviceGetAttribute(&cus, hipDeviceAttributeMultiprocessorCount, dev);
        hipFuncSetAttribute((const void*)fwd_megakernel, hipFuncAttributeMaxDynamicSharedMemorySize, LDS_BYTES);
        hipOccupancyMaxActiveBlocksPerMultiprocessor(&per_cu, (const void*)fwd_megakernel, NTHREADS, LDS_BYTES);
        if (per_cu < 1) { fprintf(stderr, "kernel_launch: occupancy query says %d blocks per CU\n", per_cu); per_cu = 1; }
        if (per_cu > 1) per_cu = 1;
        grid = cus * per_cu;
        if (grid != 256) { fprintf(stderr, "kernel_launch: this kernel needs exactly 256 co-resident workgroups (got %d)\n", grid); if (grid > 256) grid = 256; }
        fprintf(stderr, "kernel_launch: grid %d (cus %d), ws %zu\n", grid, cus, ws_size);
    }
    if (grid < 0) return;
    hipMemsetAsync((char*)d_ws + OFF_CTL, 0, 65536, stream);
    Params p{};
    for (int i = 0; i < 36; ++i) p.in[i] = (const float*)d_in[i];
    p.out = (float*)d_out; p.ws = (unsigned char*)d_ws;
    void* args[] = {&p};
    hipError_t e = hipLaunchCooperativeKernel((const void*)fwd_megakernel, dim3(grid), dim3(NTHREADS), args, LDS_BYTES, stream);
    if (e != hipSuccess) fprintf(stderr, "cooperative launch failed: %s (grid %d)\n", hipGetErrorString(e), grid);
}
```

```cpp
#include <hip/hip_runtime.h>
#include <hip/hip_cooperative_groups.h>
#include <cstdio>
#include <cstdint>
namespace cg = cooperative_groups;

#define LAS __attribute__((address_space(3)))
typedef unsigned short bf16_t;
typedef short bf16x8 __attribute__((ext_vector_type(8)));
typedef float f32x4 __attribute__((ext_vector_type(4)));
typedef float f32x2 __attribute__((ext_vector_type(2)));
typedef unsigned u32x4 __attribute__((ext_vector_type(4)));
typedef unsigned u32x2 __attribute__((ext_vector_type(2)));

constexpr int D = 1024, NB = 8, L = 8192, NT = NB * L, DEPTH = 2;
constexpr int IN_D = 3456, IN_DP = 3584;
constexpr int C_HX0 = 0, C_HX1 = 256, C_HV = 512, C_RR = 768, C_RK = 1280, C_RV = 1792, C_RG = 2304, C_RW = 2432, C_RA = 2560, C_NQ = 2688, C_NK = 2944, C_NV = 3200;
constexpr int NEXP = 32, FF = 512;
constexpr float NORM_EPS = 1e-6f;

constexpr size_t MiB = 1u << 20;
constexpr size_t OFF_CTL = 0;
constexpr size_t OFF_WTIN = 1 * MiB;
constexpr size_t OFF_WTOUT = 15 * MiB;
constexpr size_t OFF_RS = 19 * MiB;
constexpr size_t OFF_RGW = 20 * MiB;
constexpr size_t OFF_LTOK = 21 * MiB;
constexpr size_t OFF_LGATE = 29 * MiB;
constexpr size_t OFF_FILT = 37 * MiB;
constexpr size_t OFF_MOEW = 69 * MiB;
constexpr size_t OFF_W13T = OFF_MOEW, OFF_W2T = OFF_MOEW + 64 * MiB;
constexpr size_t OFF_ZT = OFF_MOEW;
constexpr size_t OFF_YT = OFF_MOEW + 32 * MiB;
constexpr size_t OFF_XB = 165 * MiB;
constexpr size_t OFF_MIX = 869 * MiB;
constexpr size_t OFF_PROJ = 293 * MiB;
constexpr size_t OFF_ACT = OFF_PROJ;
constexpr size_t OFF_YBUF = OFF_PROJ + 136 * MiB;
constexpr size_t OFF_YF = 741 * MiB;
constexpr size_t OFF_YB = 805 * MiB;
constexpr size_t OFF_BON = 997 * MiB;
constexpr size_t OFF_LRS = 1001 * MiB;
constexpr size_t WS_END = 1009 * MiB;
constexpr int LCAP = 65536;

constexpr int LDS_BYTES = 147456;
constexpr int NTHREADS = 512;

struct Params { const float* in[36]; float* out; unsigned char* ws; };

__device__ __forceinline__ float bf2f(unsigned b) { return __uint_as_float(b << 16); }
typedef __bf16 bf16x2_t __attribute__((ext_vector_type(2)));
__device__ __forceinline__ unsigned f2bf(float f) { return (unsigned)__builtin_bit_cast(unsigned short, (__bf16)f); }
__device__ __forceinline__ unsigned pk2(float lo, float hi) { const f32x2 v = {lo, hi}; return __builtin_bit_cast(unsigned, __builtin_convertvector(v, bf16x2_t)); }
#define DPPF(v, ctrl) __int_as_float(__builtin_amdgcn_update_dpp(0, __float_as_int(v), (ctrl), 0xF, 0xF, true))
__device__ __forceinline__ float rdlane(float v, int l) { return __int_as_float(__builtin_amdgcn_readlane(__float_as_int(v), l)); }
__device__ __forceinline__ float wave_sum(float v) {
    v += DPPF(v, 0xB1); v += DPPF(v, 0x4E); v += DPPF(v, 0x141); v += DPPF(v, 0x140);
    return (rdlane(v, 0) + rdlane(v, 16)) + (rdlane(v, 32) + rdlane(v, 48));
}
__device__ __forceinline__ float sum8(float v) { v += DPPF(v, 0xB1); v += DPPF(v, 0x4E); v += DPPF(v, 0x141); return v; }
__device__ __forceinline__ void unpack8(const u32x4 w, float* f) {
    f[0] = bf2f(w.x & 0xffffu); f[1] = __uint_as_float(w.x & 0xffff0000u);
    f[2] = bf2f(w.y & 0xffffu); f[3] = __uint_as_float(w.y & 0xffff0000u);
    f[4] = bf2f(w.z & 0xffffu); f[5] = __uint_as_float(w.z & 0xffff0000u);
    f[6] = bf2f(w.w & 0xffffu); f[7] = __uint_as_float(w.w & 0xffff0000u);
}
__device__ __forceinline__ float frcp(float x) { return __builtin_amdgcn_rcpf(x); }
__device__ __forceinline__ float ftanh(float x) { const float e = __expf(2.0f * x); return 1.0f - 2.0f * frcp(e + 1.0f); }
#define LDS_WAIT() asm volatile("s_waitcnt lgkmcnt(0)" ::: "memory")
__device__ __forceinline__ int opaque_tid(int wvx) { int ln; asm volatile("v_mbcnt_lo_u32_b32 %0, -1, 0\n\tv_mbcnt_hi_u32_b32 %0, -1, %0" : "=v"(ln)); return wvx * 64 + ln; }

namespace pg8 {
constexpr int BM = 256, BK = 64, HALF = 128, HTB = HALF * BK * 2, STAGE_BYTES = 8 * HTB;
__device__ __forceinline__ int lds_byte(int r, int c) { const int st = (r >> 4) * 2 + (c >> 5), rr = r & 15, cc = c & 31, ob = rr * 64 + cc * 2; return st * 1024 + (ob ^ (((ob >> 9) & 1) << 5)); }
__device__ __forceinline__ void stage_rc(int b, int& R, int& C) { const int st = b / 1024, sb = b % 1024, swz = sb ^ (((sb >> 9) & 1) << 5); R = (st >> 1) * 16 + swz / 64; C = (st & 1) * 32 + (swz % 64) / 2; }
__device__ __forceinline__ int perm32(int rho) { const int n = rho >> 4, i = rho & 15; return 8 * (i >> 2) + 4 * n + (i & 3); }
__device__ __forceinline__ unsigned cvt_pk_bf16(float lo, float hi) { return pk2(lo, hi); }

struct Unit { const char* A; const char* B; int pm, pn, e, cnt; };

template <class Epi, class Sched, bool GATHER>
__device__ __forceinline__ void gemm_phase(LAS unsigned char* lds, const int K, const Sched& S, const Epi& E, const int wvx) {
    const int tid = opaque_tid(wvx), wid = __builtin_amdgcn_readfirstlane(tid >> 6), lane = tid & 63, wr = wid >> 2, wc = wid & 3, fr = lane & 15, fq = lane >> 4;
    const int nt = K / BK;
    int Rr[2], Cc[2];
    unsigned voffB[2];
#pragma unroll
    for (int i = 0; i < 2; ++i) { stage_rc(tid * 16 + i * 8192, Rr[i], Cc[i]); const int Rb = Epi::PERM ? ((Rr[i] & ~31) + perm32(Rr[i] & 31)) : Rr[i];
        voffB[i] = (unsigned)(Rb * K + Cc[i]) * 2u; }
    const size_t kstep = (size_t)(BK * 2);
    const size_t hstep = (size_t)HALF * K * 2;
    const unsigned ldsw = (unsigned)wid * 1024u;
    const int aoff = lds_byte(wr * 64 + fr, fq * 8), boff = lds_byte(wc * 32 + fr, fq * 8);
#define PG8_SA(b, h) (((b) * 2 + (h)) * HTB)
#define PG8_SB(b, h) ((4 + (b) * 2 + (h)) * HTB)
#define PG8_STAGE(bufoff, gbase, voff) do { _Pragma("unroll") for (int _i = 0; _i < 2; ++_i) \
        __builtin_amdgcn_global_load_lds((const unsigned*)((const char*)(gbase) + (voff)[_i]), (LAS unsigned*)(lds + (bufoff) + ldsw + _i * 8192), 16, 0, 0); } while (0)
#define PG8_LDA(dst, b, h) do { _Pragma("unroll") for (int m = 0; m < 4; ++m) _Pragma("unroll") for (int k = 0; k < 2; ++k) dst[m][k] = *(const LAS bf16x8*)(lds + PG8_SA(b, h) + aoff + m * 2048 + k * 1024); } while (0)
#define PG8_LDB(dst, b, h) do { _Pragma("unroll") for (int n = 0; n < 2; ++n) _Pragma("unroll") for (int k = 0; k < 2; ++k) dst[n][k] = *(const LAS bf16x8*)(lds + PG8_SB(b, h) + boff + n * 2048 + k * 1024); } while (0)
#define PG8_MMA(ai, bj, At, Bt) do { __builtin_amdgcn_s_setprio(1); _Pragma("unroll") for (int m = 0; m < 4; ++m) _Pragma("unroll") for (int n = 0; n < 2; ++n) _Pragma("unroll") for (int k = 0; k < 2; ++k) \
        acc[ai][bj][m][n] = __builtin_amdgcn_mfma_f32_16x16x32_bf16(Bt[n][k], At[m][k], acc[ai][bj][m][n], 0, 0, 0); __builtin_amdgcn_s_setprio(0); } while (0)
#define PG8_WAIT_V(n) asm volatile("s_waitcnt vmcnt(" #n ")" ::: "memory")
#define PG8_WAIT_L(n) asm volatile("s_waitcnt lgkmcnt(" #n ")" ::: "memory")
#define PG8_BAR __builtin_amdgcn_s_barrier()
#define PG8_SCHED __builtin_amdgcn_sched_barrier(0)
    Unit cur, nxt; int ui = 0;
    if (!S.next(0, cur)) return;
    f32x4 acc[2][2][4][2];
#pragma unroll
    for (int a = 0; a < 2; ++a)
#pragma unroll
        for (int b = 0; b < 2; ++b)
#pragma unroll
            for (int m = 0; m < 4; ++m)
#pragma unroll
                for (int n = 0; n < 2; ++n) acc[a][b][m][n] = (f32x4){0.f, 0.f, 0.f, 0.f};
    bf16x8 At[4][2], B0[2][2], B1[2][2];
    typename Epi::Pre epre;
    unsigned vA[2][2];
    LAS u32x4* stash = (LAS u32x4*)(lds + STAGE_BYTES) + tid;
    if (GATHER) S.aoff(cur, tid, vA);
    else {
#pragma unroll
        for (int h = 0; h < 2; ++h)
#pragma unroll
            for (int i = 0; i < 2; ++i) vA[h][i] = (unsigned)((h * HALF + Rr[i]) * K + Cc[i]) * 2u;
    }
    const char* cA = cur.A; const char* cB = cur.B;
    PG8_STAGE(PG8_SB(0, 0), cB, voffB); PG8_STAGE(PG8_SB(0, 1), cB + hstep, voffB); PG8_STAGE(PG8_SA(0, 0), cA, vA[0]); PG8_STAGE(PG8_SA(0, 1), cA, vA[1]);
    if (wr == 1) PG8_BAR;
    PG8_WAIT_V(2); PG8_BAR;
    PG8_STAGE(PG8_SB(1, 0), cB + kstep, voffB); PG8_STAGE(PG8_SA(1, 0), cA + kstep, vA[0]); PG8_STAGE(PG8_SB(1, 1), cB + hstep + kstep, voffB);
    PG8_WAIT_V(6); PG8_BAR;
    for (;;) {
        const bool has_next = S.next(ui + 1, nxt);
        const char* nA = has_next ? nxt.A : cA; const char* nB = has_next ? nxt.B : cB;
        if (GATHER) { unsigned vn[2][2];
            if (has_next) { S.aoff(nxt, tid, vn); *stash = (u32x4){vn[0][0], vn[0][1], vn[1][0], vn[1][1]}; }
            else *stash = (u32x4){vA[0][0], vA[0][1], vA[1][0], vA[1][1]}; }
        for (int t = 0; t < nt; t += 2) {
            const bool last = (t == nt - 2);
            const char* a1 = cA + (size_t)(t + 1) * kstep;
            const char* a2 = last ? nA : cA + (size_t)(t + 2) * kstep; const char* b2 = last ? nB : cB + (size_t)(t + 2) * kstep;
            const char* a3 = a2 + kstep; const char* b3 = b2 + kstep;
            if (last) E.prefetch(epre, cur, wr, wc, fr, fq);
            PG8_LDB(B0, 0, 0); PG8_LDB(B1, 0, 1); PG8_SCHED; PG8_LDA(At, 0, 0); PG8_STAGE(PG8_SA(1, 1), a1, vA[1]);
            if (GATHER && last) { const u32x4 sv = *stash; vA[0][0] = sv.x; vA[0][1] = sv.y; vA[1][0] = sv.z; vA[1][1] = sv.w; }
            PG8_WAIT_V(8); PG8_WAIT_L(0); PG8_BAR; PG8_MMA(0, 0, At, B0); PG8_MMA(0, 1, At, B1); PG8_BAR; PG8_SCHED;
            PG8_LDA(At, 0, 1); PG8_STAGE(PG8_SB(0, 0), b2, voffB); PG8_STAGE(PG8_SB(0, 1), b2 + hstep, voffB); PG8_STAGE(PG8_SA(0, 0), a2, vA[0]);
            PG8_WAIT_V(8); PG8_WAIT_L(0); PG8_BAR; PG8_MMA(1, 0, At, B0); PG8_MMA(1, 1, At, B1); PG8_BAR; PG8_SCHED;
            PG8_LDB(B0, 1, 0); PG8_LDB(B1, 1, 1); PG8_SCHED; PG8_LDA(At, 1, 0); PG8_STAGE(PG8_SA(0, 1), a2, vA[1]);
            PG8_WAIT_V(8); PG8_WAIT_L(0); PG8_BAR; PG8_MMA(0, 0, At, B0); PG8_MMA(0, 1, At, B1); PG8_BAR; PG8_SCHED;
            PG8_LDA(At, 1, 1); PG8_STAGE(PG8_SB(1, 0), b3, voffB); PG8_STAGE(PG8_SB(1, 1), b3 + hstep, voffB); PG8_STAGE(PG8_SA(1, 0), a3, vA[0]);
            PG8_WAIT_V(8); PG8_WAIT_L(0); PG8_BAR; PG8_MMA(1, 0, At, B0); PG8_MMA(1, 1, At, B1); PG8_BAR; PG8_SCHED;
        }
        if (wr == 0) PG8_BAR;
        {
            Unit eu = cur; int efr = fr, efq = fq;
            eu.pm = __builtin_amdgcn_readfirstlane(eu.pm); eu.pn = __builtin_amdgcn_readfirstlane(eu.pn); eu.e = __builtin_amdgcn_readfirstlane(eu.e); eu.cnt = __builtin_amdgcn_readfirstlane(eu.cnt);
            asm volatile("" : "+s"(eu.pm), "+s"(eu.pn), "+s"(eu.e), "+s"(eu.cnt), "+v"(efr), "+v"(efq));
            E(acc, eu, wr, wc, efr, efq, epre);
        }
        if (!has_next) break;
#pragma unroll
        for (int a = 0; a < 2; ++a)
#pragma unroll
            for (int b = 0; b < 2; ++b)
#pragma unroll
                for (int m = 0; m < 4; ++m)
#pragma unroll
                    for (int n = 0; n < 2; ++n) acc[a][b][m][n] = (f32x4){0.f, 0.f, 0.f, 0.f};
        cur = nxt; cA = nA; cB = nB; ++ui;
        if (wr == 1) PG8_BAR;
    }
    PG8_WAIT_V(0);
    PG8_BAR;
#undef PG8_SA
#undef PG8_SB
#undef PG8_STAGE
#undef PG8_LDA
#undef PG8_LDB
#undef PG8_MMA
#undef PG8_WAIT_V
#undef PG8_WAIT_L
#undef PG8_BAR
#undef PG8_SCHED
}
}

struct DenseSched {
    const bf16_t* A; const bf16_t* Bt; int K, nM, nN, nwg, G, c;
    __device__ void init(const bf16_t* A_, const bf16_t* Bt_, int M, int N, int K_, int G_, int c_) { A = A_; Bt = Bt_; K = K_; nM = M / 256; nN = N / 256; nwg = nM * nN; G = G_; c = c_; }
    __device__ __forceinline__ bool next(int i, pg8::Unit& u) const {
        const long Lx = (long)i * G + c; if (Lx >= nwg) return false;
        int wgid = (int)Lx; { const int q = nwg / 8, r = nwg % 8, xcd = wgid % 8, off = wgid / 8; wgid = (xcd < r ? xcd * (q + 1) : r * (q + 1) + (xcd - r) * q) + off; }
        const int nig = 8 * nN, gid = wgid / nig, fm = gid * 8, gsz = (nM - fm) < 8 ? (nM - fm) : 8;
        u.pm = fm + ((wgid % nig) % gsz); u.pn = (wgid % nig) / gsz; u.e = 0; u.cnt = 0;
        u.A = (const char*)A + (size_t)u.pm * 256 * K * 2; u.B = (const char*)Bt + (size_t)u.pn * 256 * K * 2; return true;
    }
    __device__ __forceinline__ void aoff(const pg8::Unit&, int, unsigned (&)[2][2]) const {}
};
struct MoeSched {
    const bf16_t* A; const bf16_t* Bt; size_t bstride;
    const int* ltok;
    LAS int* tp;
    int K, G, c, total;
    __device__ void init(const int* cnt_, const bf16_t* A_, const bf16_t* Bt_, size_t bstride_, const int* ltok_, int K_, int G_, int c_, LAS int* lds_tab, int tid) {
        A = A_; Bt = Bt_; bstride = bstride_; ltok = ltok_; K = K_; G = G_; c = (G_ % 8 == 0) ? (c_ & 7) * (G_ >> 3) + (c_ >> 3) : c_;
        tp = lds_tab;
        __syncthreads();
        if (tid < 32) tp[64 + tid] = cnt_[tid];
        __syncthreads();
        if (tid == 0) { int t = 0; for (int e = 0; e < NEXP; ++e) { tp[e] = t; t += (tp[64 + e] + 255) >> 8; } tp[32] = t; }
        __syncthreads();
        total = __builtin_amdgcn_readfirstlane(tp[32]);
    }
    __device__ __forceinline__ bool next(int i, pg8::Unit& u) const {
        const long Lx = (long)i * G + c; if (Lx >= (long)total * 4) return false;
        const int ti = (int)(Lx >> 2); u.pn = (int)(Lx & 3);
        int ln; asm volatile("v_mbcnt_lo_u32_b32 %0, -1, 0\n\tv_mbcnt_hi_u32_b32 %0, -1, %0" : "=v"(ln));
        const int l5 = ln & 31; const int lo = tp[l5], hi = tp[l5 + 1];
        const unsigned long long mask = __builtin_amdgcn_ballot_w64(lo <= ti && ti < hi);
        const int e = __builtin_amdgcn_readfirstlane((int)__builtin_ctzll(mask) & 31);
        const int base = __builtin_amdgcn_readfirstlane(tp[e]), ce = __builtin_amdgcn_readfirstlane(tp[64 + e]);
        u.e = e; u.pm = ti; u.cnt = ce - (ti - base) * 256;
        u.A = ltok ? (const char*)A : (const char*)A + (size_t)ti * 256 * K * 2;
        u.B = (const char*)(Bt + (size_t)e * bstride) + (size_t)u.pn * 256 * K * 2;
        u.pm = ti | ((ti - base) << 16);
        return true;
    }
    __device__ __forceinline__ void aoff(const pg8::Unit& u, int tid, unsigned (&v)[2][2]) const {
        const int lt = u.pm >> 16; int Rr[2], Cc[2]; pg8::stage_rc(tid * 16, Rr[0], Cc[0]); pg8::stage_rc(tid * 16 + 8192, Rr[1], Cc[1]);
        int tk[2][2];
#pragma unroll
        for (int h = 0; h < 2; ++h)
#pragma unroll
            for (int i = 0; i < 2; ++i) { const int r = h * 128 + Rr[i]; tk[h][i] = ltok[(size_t)u.e * LCAP + lt * 256 + (r < u.cnt ? r : 0)]; }
#pragma unroll
        for (int h = 0; h < 2; ++h)
#pragma unroll
            for (int i = 0; i < 2; ++i) { const int r = h * 128 + Rr[i]; const int tok = (r < u.cnt) ? (tk[h][i] >> 1) : 0; v[h][i] = (unsigned)(tok * K + Cc[i]) * 2u; }
    }
};

struct EpiProj {
    static constexpr bool PERM = true;
    struct Pre { float rs[8]; };
    bf16_t* O; const float* rs;
    __device__ __forceinline__ void prefetch(Pre& pr, const pg8::Unit& u, int wr, int wc, int fr, int fq) const {
        const int row0 = (u.pm & 0xffff) * 256 + wr * 64 + fr;
#pragma unroll
        for (int ai = 0; ai < 2; ++ai)
#pragma unroll
            for (int m = 0; m < 4; ++m) pr.rs[ai * 4 + m] = rs[row0 + ai * 128 + m * 16];
    }
    __device__ __forceinline__ void operator()(const f32x4 (&acc)[2][2][4][2], const pg8::Unit& u, int wr, int wc, int fr, int fq, const Pre& pr) const {
        const int row0 = u.pm * 256 + wr * 64 + fr, col0 = u.pn * 256 + wc * 32 + 8 * fq;
#pragma unroll
        for (int ai = 0; ai < 2; ++ai)
#pragma unroll
            for (int m = 0; m < 4; ++m) { const int row = row0 + ai * 128 + m * 16; const float s = pr.rs[ai * 4 + m]; bf16_t* rowp = O + (size_t)row * IN_DP + col0;
#pragma unroll
                for (int bj = 0; bj < 2; ++bj) { const f32x4 v0 = acc[ai][bj][m][0] * s, v1 = acc[ai][bj][m][1] * s;
                    u32x4 w; w.x = pg8::cvt_pk_bf16(v0[0], v0[1]); w.y = pg8::cvt_pk_bf16(v0[2], v0[3]); w.z = pg8::cvt_pk_bf16(v1[0], v1[1]); w.w = pg8::cvt_pk_bf16(v1[2], v1[3]);
                    *(u32x4*)(rowp + bj * 128) = w; } }
    }
};
struct EpiRes {
    static constexpr bool PERM = true;
    struct Pre { int dummy; };
    bf16_t* x16;
    __device__ __forceinline__ void prefetch(Pre&, const pg8::Unit&, int, int, int, int) const {}
    __device__ __forceinline__ void operator()(const f32x4 (&acc)[2][2][4][2], const pg8::Unit& u, int wr, int wc, int fr, int fq, const Pre&) const {
        const int row0 = u.pm * 256 + wr * 64 + fr, col0 = u.pn * 256 + wc * 32 + 8 * fq;
#pragma unroll
        for (int ai = 0; ai < 2; ++ai) {
            u32x4 braw[4][2];
#pragma unroll
            for (int m = 0; m < 4; ++m)
#pragma unroll
                for (int bj = 0; bj < 2; ++bj) braw[m][bj] = *(const u32x4*)(x16 + (size_t)(row0 + ai * 128 + m * 16) * D + col0 + bj * 128);
            asm volatile("" ::: "memory");
#pragma unroll
            for (int m = 0; m < 4; ++m) { const size_t off = (size_t)(row0 + ai * 128 + m * 16) * D + col0;
#pragma unroll
                for (int bj = 0; bj < 2; ++bj) { const f32x4 v0 = acc[ai][bj][m][0], v1 = acc[ai][bj][m][1]; float bb[8]; unpack8(braw[m][bj], bb);
                    u32x4 w; w.x = pk2(bb[0] + v0[0], bb[1] + v0[1]); w.y = pk2(bb[2] + v0[2], bb[3] + v0[3]); w.z = pk2(bb[4] + v1[0], bb[5] + v1[1]); w.w = pk2(bb[6] + v1[2], bb[7] + v1[3]);
                    *(u32x4*)(x16 + off + bj * 128) = w; } }
            asm volatile("" ::: "memory");
        }
    }
};
struct EpiMoe1 {
    static constexpr bool PERM = true;
    struct Pre { int dummy; };
    bf16_t* act; const float* lrs;
    __device__ __forceinline__ void prefetch(Pre&, const pg8::Unit&, int, int, int, int) const {}
    __device__ __forceinline__ void operator()(const f32x4 (&acc)[2][2][4][2], const pg8::Unit& u, int wr, int wc, int fr, int fq, const Pre&) const {
        const int ti = u.pm & 0xffff, lt = u.pm >> 16;
        const int r0 = wr * 64 + fr, col0 = u.pn * 256 + wc * 32 + 8 * fq;
        float sv[8];
#pragma unroll
        for (int q = 0; q < 8; ++q) { const int r = r0 + (q >> 2) * 128 + (q & 3) * 16; sv[q] = (r < u.cnt) ? lrs[(size_t)u.e * LCAP + lt * 256 + r] : 0.f; }
        asm volatile("" ::: "memory");
#pragma unroll
        for (int ai = 0; ai < 2; ++ai)
#pragma unroll
            for (int m = 0; m < 4; ++m) { const int r = r0 + ai * 128 + m * 16;
                const float s = sv[ai * 4 + m];
                bf16_t* rowp = act + ((size_t)ti * 256 + r) * FF + (col0 >> 1);
#pragma unroll
                for (int bj = 0; bj < 2; ++bj) { const f32x4 v0 = acc[ai][bj][m][0] * s, v1 = acc[ai][bj][m][1] * s;
                    const float o0 = v0[0] * frcp(1.f + __expf(-v0[0])) * v0[1], o1 = v0[2] * frcp(1.f + __expf(-v0[2])) * v0[3];
                    const float o2 = v1[0] * frcp(1.f + __expf(-v1[0])) * v1[1], o3 = v1[2] * frcp(1.f + __expf(-v1[2])) * v1[3];
                    u32x2 w; w.x = pg8::cvt_pk_bf16(o0, o1); w.y = pg8::cvt_pk_bf16(o2, o3);
                    *(u32x2*)(rowp + bj * 64) = w; } }
    }
};
struct EpiMoe2 {
    static constexpr bool PERM = true;
    struct Pre { int dummy; };
    bf16_t* ybuf; const int* ltok; const float* lgate;
    __device__ __forceinline__ void prefetch(Pre&, const pg8::Unit&, int, int, int, int) const {}
    __device__ __forceinline__ void operator()(const f32x4 (&acc)[2][2][4][2], const pg8::Unit& u, int wr, int wc, int fr, int fq, const Pre&) const {
        const int lt = u.pm >> 16, r0 = wr * 64 + fr, col0 = u.pn * 256 + wc * 32 + 8 * fq;
        int dv[8]; float gv[8];
#pragma unroll
        for (int q = 0; q < 8; ++q) { const int r = r0 + (q >> 2) * 128 + (q & 3) * 16; const bool ok = r < u.cnt;
            const size_t li = (size_t)u.e * LCAP + lt * 256 + (ok ? r : 0); const int d = ltok[li]; const float g = lgate[li];
            dv[q] = ok ? d : -1; gv[q] = g; }
        asm volatile("" ::: "memory");
#pragma unroll
        for (int ai = 0; ai < 2; ++ai)
#pragma unroll
            for (int m = 0; m < 4; ++m) { const int dest = dv[ai * 4 + m];
                if (dest >= 0) { const float g = gv[ai * 4 + m];
                    bf16_t* rowp = ybuf + (size_t)dest * D + col0;
#pragma unroll
                    for (int bj = 0; bj < 2; ++bj) { const f32x4 v0 = acc[ai][bj][m][0] * g, v1 = acc[ai][bj][m][1] * g;
                        u32x4 w; w.x = pg8::cvt_pk_bf16(v0[0], v0[1]); w.y = pg8::cvt_pk_bf16(v0[2], v0[3]); w.z = pg8::cvt_pk_bf16(v1[0], v1[1]); w.w = pg8::cvt_pk_bf16(v1[2], v1[3]);
                        *(u32x4*)(rowp + bj * 128) = w; } } }
    }
};

__device__ __forceinline__ void transpose_item(const float* __restrict__ W, int K, int N, bf16_t* WT, int rmul, int radd, const float* __restrict__ g, LAS float* scr, int item, int lane) {
    const int nblk = N / 32, kb = item / nblk, nb = item % nblk, k0 = 64 * kb, n0 = 32 * nb;
    f32x4 v[8]; float gv[8];
#pragma unroll
    for (int i = 0; i < 8; ++i) { v[i] = *(const f32x4*)(W + (size_t)(k0 + 8 * i + (lane >> 3)) * N + n0 + 4 * (lane & 7)); gv[i] = g ? g[k0 + 8 * i + (lane >> 3)] : 1.0f; }
#pragma unroll
    for (int i = 0; i < 8; ++i) { const int kk = 8 * i + (lane >> 3); *(LAS f32x4*)(scr + kk * 36 + 4 * (lane & 7)) = v[i] * gv[i]; }
    LDS_WAIT(); asm volatile("" ::: "memory");
    const int c = lane & 7;
#pragma unroll
    for (int j = 0; j < 4; ++j) { const int n = (lane >> 3) + 8 * j; const LAS float* s = scr + (8 * c) * 36 + n;
        u32x4 o; o.x = pk2(s[0 * 36], s[1 * 36]); o.y = pk2(s[2 * 36], s[3 * 36]); o.z = pk2(s[4 * 36], s[5 * 36]); o.w = pk2(s[6 * 36], s[7 * 36]);
        *(u32x4*)(WT + (size_t)(rmul * (n0 + n) + radd) * K + k0 + 8 * c) = o; }
    LDS_WAIT(); asm volatile("" ::: "memory");
}

__device__ __forceinline__ void filt_item8(const Params& p, int l, int m0, int lane, float* G) {
    const float* w1 = p.in[5] + l * 33 * 64; const float* w2 = p.in[7] + l * 4096; const float* w3 = p.in[9] + l * 4096; const float* wout = p.in[11] + l * 64 * 512;
    const float b1v = p.in[6][l * 64 + lane], b2v = p.in[8][l * 64 + lane], b3v = p.in[10][l * 64 + lane], fr = p.in[12][l * 64 + lane];
    float hcur[8], acc[8];
    {
#pragma unroll
        for (int j = 0; j < 8; ++j) { const int m = m0 + j; float zl = 0.f;
            const float wv = (6.283185307179586f / 8192.0f) * (float)m; const float fstep = (15.0f - 1e-4f) / 15.0f;
            if (lane == 0) zl = (float)m / 8191.0f; else if (lane <= 16) zl = cosf((1e-4f + (float)(lane - 1) * fstep) * wv); else if (lane <= 32) zl = -sinf((1e-4f + (float)(lane - 17) * fstep) * wv);
            hcur[j] = zl; acc[j] = b1v; }
        float wc[33];
#pragma unroll
        for (int i = 0; i < 33; ++i) wc[i] = w1[i * 64 + lane];
#pragma unroll
        for (int i = 0; i < 33; ++i)
#pragma unroll
            for (int j = 0; j < 8; ++j) acc[j] += rdlane(hcur[j], i) * wc[i];
#pragma unroll
        for (int j = 0; j < 8; ++j) { hcur[j] = sinf(fr * acc[j]); acc[j] = b2v; }
    }
    asm volatile("" ::: "memory");
    {   float wc[64];
#pragma unroll
        for (int i = 0; i < 64; ++i) wc[i] = w2[i * 64 + lane];
#pragma unroll
        for (int i = 0; i < 64; ++i)
#pragma unroll
            for (int j = 0; j < 8; ++j) acc[j] += rdlane(hcur[j], i) * wc[i];
#pragma unroll
        for (int j = 0; j < 8; ++j) { hcur[j] = sinf(fr * acc[j]); acc[j] = b3v; }
    }
    asm volatile("" ::: "memory");
    {   float wc[64];
#pragma unroll
        for (int i = 0; i < 64; ++i) wc[i] = w3[i * 64 + lane];
#pragma unroll
        for (int i = 0; i < 64; ++i)
#pragma unroll
            for (int j = 0; j < 8; ++j) acc[j] += rdlane(hcur[j], i) * wc[i];
#pragma unroll
        for (int j = 0; j < 8; ++j) hcur[j] = sinf(fr * acc[j]);
    }
    asm volatile("" ::: "memory");
    float (&h3)[8] = hcur;
    float o[8][8];
#pragma unroll
    for (int j = 0; j < 8; ++j)
#pragma unroll
        for (int q = 0; q < 8; ++q) o[j][q] = 0.f;
#pragma unroll 2
    for (int i = 0; i < 64; ++i) { float wo[8];
#pragma unroll
        for (int q = 0; q < 8; ++q) wo[q] = wout[i * 512 + q * 64 + lane];
#pragma unroll
        for (int j = 0; j < 8; ++j) { const float hv = rdlane(h3[j], i);
#pragma unroll
            for (int q = 0; q < 8; ++q) o[j][q] += hv * wo[q]; } }
    const float dmin = -3.0701134573253944f, dmax = -15.350567286626972f;
#pragma unroll
    for (int q = 0; q < 8; ++q) { const int n = q * 64 + lane, d = n >> 8, c = n & 255;
        const float delta = fabsf(dmin + (float)c * ((dmax - dmin) / 255.0f));
        float v[8];
#pragma unroll
        for (int j = 0; j < 8; ++j) v[j] = o[j][q] * expf(-((float)(m0 + j) / 8191.0f) * delta);
        float* dst = G + (size_t)c * 16384 + d * 8192 + m0;
        *(f32x4*)dst = (f32x4){v[0], v[1], v[2], v[3]}; *(f32x4*)(dst + 4) = (f32x4){v[4], v[5], v[6], v[7]}; }
}

__device__ __forceinline__ void phase_prologue(const Params& p, LAS unsigned char* lds, int G_, int bid, const int wvx) {
    const int tid = opaque_tid(wvx), lane = tid & 63, wave = tid >> 6;
    const int gw = bid * 8 + wave, NGW = G_ * 8;
    LAS float* scr = (LAS float*)(lds + wave * 16384);
    unsigned char* ws = p.ws;
    for (int it = gw; it < 16 * 108; it += NGW) transpose_item(p.in[2], D, IN_D, (bf16_t*)(ws + OFF_WTIN), 1, 0, p.in[1], scr, it, lane);
    for (int i = bid * NTHREADS + tid; i < 2 * 128 * D / 8; i += G_ * NTHREADS) { const int l = i / (128 * D / 8), r = i % (128 * D / 8);
        *(u32x4*)((bf16_t*)(ws + OFF_WTIN) + (size_t)l * IN_DP * D + (size_t)IN_D * D + (size_t)r * 8) = (u32x4){0u, 0u, 0u, 0u}; }
    for (int i = bid * NTHREADS + tid; i < 2 * 48 * D; i += G_ * NTHREADS) { const int l = i / (48 * D), r = i % (48 * D), o = r / D, k = r % D;
        const float g = p.in[27][l * D + k]; const float w = g * ((o < 4) ? p.in[28][((size_t)l * D + k) * 4 + o] : (o < 36 ? p.in[30][((size_t)l * D + k) * 32 + (o - 4)] : 0.f));
        const unsigned hi = f2bf(w); const float lo = w - bf2f(hi);
        bf16_t* rg = (bf16_t*)(ws + OFF_RGW) + (size_t)l * 2 * 48 * D; rg[o * D + k] = (bf16_t)hi; rg[48 * D + o * D + k] = (bf16_t)f2bf(lo); }
}
__device__ __forceinline__ void filters_all(const Params& p, int nwg, int rank, const int wvx) {
    const int tid = opaque_tid(wvx), lane = tid & 63, wave = tid >> 6;
    for (int it = rank * 8 + wave; it < 2 * (L / 8); it += nwg * 8) { const int l = it / (L / 8), m0 = (it % (L / 8)) * 8; filt_item8(p, l, m0, lane, (float*)(p.ws + OFF_FILT) + (size_t)l * 256 * 16384); }
}

__device__ __forceinline__ void moe_weights_chunk(const Params& p, LAS unsigned char* lds, int l, int chunk, const int wvx) {
    const int tid = opaque_tid(wvx), lane = tid & 63, wave = tid >> 6;
    LAS float* scr = (LAS float*)(lds + wave * 16384);
    bf16_t* W13 = (bf16_t*)(p.ws + OFF_W13T); bf16_t* W2 = (bf16_t*)(p.ws + OFF_W2T);
    const float* g = p.in[27] + l * D;
#pragma unroll 1
    for (int k = 0; k < 8; ++k) { const int it = chunk * 64 + wave * 8 + k;
        if (it >= NEXP * 768) { const int x = it - NEXP * 768;
            if (x < 16 * 108) transpose_item(p.in[2] + (size_t)D * IN_D, D, IN_D, (bf16_t*)(p.ws + OFF_WTIN) + (size_t)IN_DP * D, 1, 0, p.in[1] + D, scr, x, lane);
            else if (x < 16 * 108 + 1024) { const int y = x - 16 * 108, lo = y >> 9; transpose_item(p.in[26] + (size_t)lo * D * D, D, D, (bf16_t*)(p.ws + OFF_WTOUT) + (size_t)lo * D * D, 1, 0, nullptr, scr, y & 511, lane); }
            continue; }
        const int e = it / 768, r = it % 768;
        if (r < 256) transpose_item(p.in[32] + ((size_t)l * NEXP + e) * D * FF, D, FF, W13 + (size_t)e * 1024 * D, 2, 0, g, scr, r, lane);
        else if (r < 512) transpose_item(p.in[33] + ((size_t)l * NEXP + e) * D * FF, D, FF, W13 + (size_t)e * 1024 * D, 2, 1, g, scr, r - 256, lane);
        else transpose_item(p.in[34] + ((size_t)l * NEXP + e) * FF * D, FF, D, W2 + (size_t)e * D * FF, 1, 0, nullptr, scr, r - 512, lane); }
}
__device__ __forceinline__ void phase_rownorm(const float* x, bf16_t* xb, float* rs, int G_, int bid, const int wvx) {
    const int tid = opaque_tid(wvx), lane = tid & 63, wave = tid >> 6;
    for (int row = bid * 8 + wave; row < NT; row += G_ * 8) {
        const f32x4* xr = (const f32x4*)(x + (size_t)row * D) + lane; f32x4 v[4]; float s = 0.f;
#pragma unroll
        for (int j = 0; j < 4; ++j) { v[j] = xr[64 * j]; s += (v[j].x * v[j].x + v[j].y * v[j].y) + (v[j].z * v[j].z + v[j].w * v[j].w); }
        s = wave_sum(s);
        if (lane == 0) rs[row] = 1.0f / sqrtf(s * (1.0f / D) + NORM_EPS);
        u32x2* o = (u32x2*)(xb + (size_t)row * D) + lane;
#pragma unroll
        for (int j = 0; j < 4; ++j) o[64 * j] = (u32x2){pk2(v[j].x, v[j].y), pk2(v[j].z, v[j].w)};
    }
}

__device__ __forceinline__ void load8(const bf16_t* p, bool ok, float* f) { if (ok) { unpack8(*(const u32x4*)p, f); } else {
#pragma unroll
    for (int j = 0; j < 8; ++j) f[j] = 0.f; } }

__device__ __forceinline__ void hy_pre_unit(const Params& p, LAS unsigned char* lds, int l, int unit, const int wvx) {
    const int tid = opaque_tid(wvx);
    const int ct = unit & 3, tt = (unit >> 2) & 127, b = unit >> 9;
    const bf16_t* proj = (const bf16_t*)(p.ws + OFF_PROJ);
    bf16_t* zT = (bf16_t*)(p.ws + OFF_ZT);
    const float* cw = p.in[3] + l * 3 * 768; const float* cb = p.in[4] + l * 768;
    LAS bf16_t* tile = (LAS bf16_t*)lds;
    {
        const int tl = tid >> 3, c8 = (tid & 7) * 8, t = tt * 64 + tl, c = ct * 64 + c8;
        const bf16_t* row = proj + ((size_t)b * L + t) * IN_DP;
        float x1[3][8], vv[3][8];
        load8(row - IN_DP + C_HX1 + c, t > 0, x1[0]); load8(row + C_HX1 + c, true, x1[1]); load8(row + IN_DP + C_HX1 + c, t < L - 1, x1[2]);
        load8(row - IN_DP + C_HV + c, t > 0, vv[0]); load8(row + C_HV + c, true, vv[1]); load8(row + IN_DP + C_HV + c, t < L - 1, vv[2]);
#pragma unroll
        for (int j = 0; j < 8; ++j) { const int c1 = C_HX1 + c + j, c2 = C_HV + c + j;
            const float a = x1[0][j] * cw[c1] + x1[1][j] * cw[768 + c1] + x1[2][j] * cw[1536 + c1] + cb[c1];
            const float v = vv[0][j] * cw[c2] + vv[1][j] * cw[768 + c2] + vv[2][j] * cw[1536 + c2] + cb[c2];
            tile[(c8 + j) * 72 + tl] = (bf16_t)f2bf(a * v); }
    }
    __syncthreads();
    {
        const int cl = tid >> 3, seg = tid & 7;
        const u32x4 w = *(const LAS u32x4*)(tile + cl * 72 + seg * 8);
        *(u32x4*)(zT + ((size_t)(ct * 64 + cl) * NB + b) * L + tt * 64 + seg * 8) = w;
    }
    __syncthreads();
}

typedef float f32x16 __attribute__((ext_vector_type(16)));
__device__ __forceinline__ void hy_conv_unit(const Params& p, LAS unsigned char* lds, int l, int c, const int wvx) {
    const int tid = opaque_tid(wvx), lane = tid & 63, wave = __builtin_amdgcn_readfirstlane(tid >> 6);
    const float* G = (const float*)(p.ws + OFF_FILT) + ((size_t)l * 256 + c) * 16384;
    const bf16_t* zT = (const bf16_t*)(p.ws + OFF_ZT) + (size_t)c * NB * L;
    float* yT = (float*)(p.ws + OFF_YT) + (size_t)c * NB * L;
    LAS bf16_t* Re = (LAS bf16_t*)lds; LAS bf16_t* Ro = Re + 16384;
    LAS unsigned char* Zs = lds + 65536;
    constexpr int ZB = 8976;
    LAS float* red = (LAS float*)(lds + 65536 + 8 * ZB);
    __syncthreads();
    float ss = 0.f; const float GF0 = G[8192];
#pragma unroll 1
    for (int i0 = 0; i0 < 16384; i0 += 8 * NTHREADS) { float gq[8];
#pragma unroll
        for (int k = 0; k < 8; ++k) gq[k] = G[i0 + k * NTHREADS + tid];
#pragma unroll
        for (int k = 0; k < 8; ++k) { const int i = i0 + k * NTHREADS + tid; const float g = gq[k]; ss += g * g;
            if (i == 8192) { Ro[16383] = 0; Re[0] = 0; }
            else { const int dl = (i < 8192) ? i : (8192 - i); const bf16_t bv = (bf16_t)f2bf(i == 0 ? g + GF0 : g); Re[8192 - dl] = bv; Ro[8191 - dl] = bv; } } }
    ss = wave_sum(ss); if (lane == 0) red[wave] = ss;
    f32x16 acc[2][4];
#pragma unroll
    for (int mt = 0; mt < 2; ++mt)
#pragma unroll
        for (int i = 0; i < 4; ++i)
#pragma unroll
            for (int e = 0; e < 16; ++e) acc[mt][i][e] = 0.f;
    const int r = lane & 31, hh = lane >> 5;
#pragma unroll 1
    for (int h = 0; h < 2; ++h) {
        __syncthreads();
        { u32x4 zq[9];
#pragma unroll
          for (int k = 0; k < 9; ++k) { const int q = tid + k * NTHREADS; const int ch = q & 7, Jp = (q >> 3) % 70, b = (q >> 3) / 70; const int J = 64 * h + Jp - 3;
            zq[k] = (u32x4){0u, 0u, 0u, 0u}; if (q < 4480 && Jp >= 3 && Jp < 67) zq[k] = *(const u32x4*)(zT + (size_t)b * L + J * 64 + ch * 8); }
#pragma unroll
          for (int k = 0; k < 9; ++k) { const int q = tid + k * NTHREADS; const int ch = q & 7, Jp = (q >> 3) % 70, b = (q >> 3) / 70;
            if (q < 4480) *(LAS u32x4*)(Zs + b * ZB + Jp * 128 + ch * 16) = zq[k]; } }
        __syncthreads();
        int d_hi = 16 * wave + 15 - 64 * h, d_lo = 16 * wave - 64 * h - 63; d_hi = d_hi > 127 ? 127 : d_hi; d_lo = d_lo < -127 ? -127 : d_lo;
#pragma unroll 1
        for (int d = d_lo; d <= d_hi; ++d) {
            const int J0b = 16 * wave - d;
            const int aelem = 8192 + 8 * hh - r - (r & 1) - 64 * d - 32;
            const LAS unsigned* ap = (const LAS unsigned*)(lds + (r & 1) * 32768 + aelem * 2);
            bf16x8 Af[2][4];
#pragma unroll
            for (int mt = 0; mt < 2; ++mt)
#pragma unroll
                for (int ks = 0; ks < 4; ++ks) { const LAS unsigned* q = ap + (16 * ks + 32 * (1 - mt)) / 2; const u32x4 t = (u32x4){q[0], q[1], q[2], q[3]}; Af[mt][ks] = __builtin_bit_cast(bf16x8, t); }
            const LAS unsigned char* bp = Zs + (r & 7) * ZB + ((r >> 3) + J0b - 64 * h + 3) * 128 + hh * 16;
#pragma unroll
            for (int i = 0; i < 4; ++i) { const int J0 = J0b + 4 * i;
                if (J0 + 3 >= 64 * h && J0 <= 64 * h + 63) {
                    bf16x8 Bf[4];
#pragma unroll
                    for (int ks = 0; ks < 4; ++ks) Bf[ks] = *(const LAS bf16x8*)(bp + i * 512 + ks * 32);
#pragma unroll
                    for (int ks = 0; ks < 4; ++ks)
#pragma unroll
                        for (int mt = 0; mt < 2; ++mt) acc[mt][i] = __builtin_amdgcn_mfma_f32_32x32x16_bf16(Af[mt][ks], Bf[ks], acc[mt][i], 0, 0, 0);
                } }
        }
    }
    float tot = 0.f;
#pragma unroll
    for (int w = 0; w < 8; ++w) tot += red[w];
    const float scale = 1.0f / sqrtf(tot + 1e-6f);
#pragma unroll
    for (int mt = 0; mt < 2; ++mt)
#pragma unroll
        for (int i = 0; i < 4; ++i)
#pragma unroll
            for (int g = 0; g < 4; ++g) { const int t = 64 * (16 * wave + 4 * i + (r >> 3)) + 32 * mt + 8 * g + 4 * hh;
                const f32x4 v = (f32x4){acc[mt][i][4 * g] * scale, acc[mt][i][4 * g + 1] * scale, acc[mt][i][4 * g + 2] * scale, acc[mt][i][4 * g + 3] * scale};
                *(f32x4*)(yT + (size_t)(r & 7) * L + t) = v; }
    __syncthreads();
}

__device__ __forceinline__ void hy_post_unit(const Params& p, LAS unsigned char* lds, int l, int unit, const int wvx) {
    const int tid = opaque_tid(wvx);
    const int ct = unit & 3, tt = (unit >> 2) & 127, b = unit >> 9;
    const bf16_t* proj = (const bf16_t*)(p.ws + OFF_PROJ);
    const bf16_t* zT = (const bf16_t*)(p.ws + OFF_ZT);
    const float* yT = (const float*)(p.ws + OFF_YT);
    bf16_t* mix = (bf16_t*)(p.ws + OFF_MIX);
    const float* cw = p.in[3] + l * 3 * 768; const float* cb = p.in[4] + l * 768; const float* skip = p.in[13] + l * 256;
    LAS float* tile = (LAS float*)lds;
    {
        const int cl = tid >> 3, seg = tid & 7, c = ct * 64 + cl;
        const size_t off = ((size_t)c * NB + b) * L + tt * 64 + seg * 8;
        float z[8]; unpack8(*(const u32x4*)(zT + off), z);
        const f32x4 y0 = *(const f32x4*)(yT + off), y1 = *(const f32x4*)(yT + off + 4);
        const float sk = skip[c];
        tile[cl * 65 + seg * 8 + 0] = y0.x + z[0] * sk; tile[cl * 65 + seg * 8 + 1] = y0.y + z[1] * sk; tile[cl * 65 + seg * 8 + 2] = y0.z + z[2] * sk; tile[cl * 65 + seg * 8 + 3] = y0.w + z[3] * sk;
        tile[cl * 65 + seg * 8 + 4] = y1.x + z[4] * sk; tile[cl * 65 + seg * 8 + 5] = y1.y + z[5] * sk; tile[cl * 65 + seg * 8 + 6] = y1.z + z[6] * sk; tile[cl * 65 + seg * 8 + 7] = y1.w + z[7] * sk;
    }
    __syncthreads();
    {
        const int tl = tid >> 3, c8 = (tid & 7) * 8, t = tt * 64 + tl, c = ct * 64 + c8;
        const bf16_t* row = proj + ((size_t)b * L + t) * IN_DP;
        float x0[3][8];
        load8(row - IN_DP + C_HX0 + c, t > 0, x0[0]); load8(row + C_HX0 + c, true, x0[1]); load8(row + IN_DP + C_HX0 + c, t < L - 1, x0[2]);
        float o[8];
#pragma unroll
        for (int j = 0; j < 8; ++j) { const int c0 = c + j; const float a = x0[0][j] * cw[c0] + x0[1][j] * cw[768 + c0] + x0[2][j] * cw[1536 + c0] + cb[c0];
            o[j] = a * tile[(c8 + j) * 65 + tl]; }
        u32x4 w; w.x = pk2(o[0], o[1]); w.y = pk2(o[2], o[3]); w.z = pk2(o[4], o[5]); w.w = pk2(o[6], o[7]);
        *(u32x4*)(mix + ((size_t)b * L + t) * D + c) = w;
    }
    __syncthreads();
}


namespace rw {
constexpr int MATB = 9216, PITCH = 144;
constexpr int O_W2T = 0, O_A2T = MATB, O_SB = 2 * MATB, O_GBUF = 3 * MATB, O_SLOT = O_GBUF + 16384;
constexpr int O_GC = O_SLOT + 10 * MATB, O_APP = O_GC + 256, O_TPP = O_APP + 5120, O_CT = O_TPP + 2560;
__device__ __forceinline__ constexpr int slot(int k) { return O_SLOT + k * MATB; }
#define MFMA16(a, b, c) __builtin_amdgcn_mfma_f32_16x16x32_bf16((a), (b), (c), 0, 0, 0)
__device__ __forceinline__ f32x4 tile64(const LAS unsigned char* A, const LAS unsigned char* Bt, int rt, int ct, int fr, int fq, f32x4 acc) {
#pragma unroll
    for (int ks = 0; ks < 2; ++ks) { const bf16x8 a = *(const LAS bf16x8*)(A + (16 * rt + fr) * PITCH + ks * 64 + fq * 16); const bf16x8 b = *(const LAS bf16x8*)(Bt + (16 * ct + fr) * PITCH + ks * 64 + fq * 16);
        acc = MFMA16(a, b, acc); }
    return acc;
}
__device__ __forceinline__ unsigned pkbf(float lo, float hi) { return pg8::cvt_pk_bf16(lo, hi); }
}

namespace rw {
typedef short s16x4 __attribute__((ext_vector_type(4)));
__device__ __forceinline__ bf16x8 fragN(const LAS unsigned char* img, int row, int ks, int fq) { return *(const LAS bf16x8*)(img + row * PITCH + ks * 64 + fq * 16); }
__device__ __forceinline__ bf16x8 fragP(const LAS unsigned char* img, int row, int ks, int fq) {
    const u32x2 a = *(const LAS u32x2*)(img + row * PITCH + (32 * ks + 4 * fq) * 2), b = *(const LAS u32x2*)(img + row * PITCH + (32 * ks + 16 + 4 * fq) * 2);
    const u32x4 v = (u32x4){a.x, a.y, b.x, b.y}; return __builtin_bit_cast(bf16x8, v); }
__device__ __forceinline__ bf16x8 fragT(const LAS unsigned char* img, int c0, int ks, int fr, int fq) {
    const LAS unsigned char* q = img + (32 * ks + 4 * fq + (fr >> 2)) * PITCH + (c0 + 4 * (fr & 3)) * 2;
    const s16x4 a = __builtin_amdgcn_ds_read_tr16_b64_v4i16((LAS s16x4*)q), b = __builtin_amdgcn_ds_read_tr16_b64_v4i16((LAS s16x4*)(q + 16 * PITCH));
    return (bf16x8){a[0], a[1], a[2], a[3], b[0], b[1], b[2], b[3]}; }
}

__device__ __forceinline__ void rw_chain_unit(const Params& p, LAS unsigned char* lds, int l, int unit, const int wvx) {
    using namespace rw;
    const int tid = opaque_tid(wvx), wave = __builtin_amdgcn_readfirstlane(tid >> 6);
    const int dir = unit & 1, h = (unit >> 1) & 7, b = unit >> 4;
    const bf16_t* proj = (const bf16_t*)(p.ws + OFF_PROJ);
    bf16_t* Y = (bf16_t*)(p.ws + (dir ? OFF_YB : OFF_YF));
    LAS float* gbuf = (LAS float*)(lds + O_GBUF);
    LAS float* GC = (LAS float*)(lds + O_GC);
    LAS bf16_t* TPP = (LAS bf16_t*)(lds + O_TPP);
    LAS float* CT = (LAS float*)(lds + O_CT);
    float* BON = (float*)(p.ws + OFF_BON) + (size_t)dir * NT * 8;
    __syncthreads();
    {
        const float* w2 = p.in[16] + ((size_t)l * 2 + dir) * 64 * 512 + h * 64; const float* a2 = p.in[18] + ((size_t)l * 2 + dir) * 64 * 512 + h * 64;
        for (int i = tid; i < 4096; i += NTHREADS) { const int r = i >> 6, n = i & 63;
            *(LAS bf16_t*)(lds + O_W2T + n * PITCH + r * 2) = (bf16_t)f2bf(w2[r * 512 + n]); *(LAS bf16_t*)(lds + O_A2T + n * PITCH + r * 2) = (bf16_t)f2bf(a2[r * 512 + n]); }
        for (int i = tid; i < MATB / 4; i += NTHREADS) ((LAS unsigned*)(lds + O_SB))[i] = 0u;
        const float* mu = p.in[14] + (size_t)l * 3 * 2 * 512;
        for (int i = tid; i < 704; i += NTHREADS) { const int row = i >> 6, n = i & 63, col = h * 64 + n; float v;
            if (row < 6) v = mu[(row >> 1) * 1024 + (row & 1) * 512 + col];
            else if (row == 6) v = p.in[15][((size_t)l * 2 + dir) * 512 + col];
            else if (row == 7) v = p.in[17][((size_t)l * 2 + dir) * 512 + col];
            else if (row == 8) v = p.in[19][l * 512 + col];
            else if (row == 9) v = p.in[20][l * 512 + col];
            else v = p.in[21][l * 512 + col];
            CT[i] = v; }
    }
    f32x4 Sreg[4];
#pragma unroll
    for (int it = 0; it < 4; ++it) Sreg[it] = (f32x4){0.f, 0.f, 0.f, 0.f};
    const int rt = wave >> 1, chh = wave & 1;
    u32x4 pre[8];
#define issue_loads(CC) do { const int t0n = (dir ? (L / 64 - 1 - (CC)) : (CC)) * 64; int tq_ = tid; asm volatile("" : "+v"(tq_));     \
        _Pragma("unroll") for (int k = 0; k < 4; ++k) { const int q = tq_ + k * NTHREADS; pre[k] = (u32x4){0u, 0u, 0u, 0u}; \
            if (q < 1584) { const int which = q / 528, rem = q - which * 528, rr = rem >> 3, ch = rem & 7; const int t = t0n - 1 + rr; \
                if (t >= 0 && t < L) pre[k] = *(const u32x4*)(proj + ((size_t)b * L + t) * IN_DP + C_RR + which * 512 + h * 64 + ch * 8); } } \
        { const int pq_ = 16 * rt + (tq_ & 15), kq_ = ((tq_ >> 4) & 3) * 8; const int ttn = dir ? (t0n + 63 - pq_) : (t0n + pq_); const bf16_t* row = proj + ((size_t)b * L + ttn) * IN_DP; \
          pre[4] = *(const u32x4*)(row + C_RW + dir * 64 + kq_); pre[5] = *(const u32x4*)(row + C_RW + dir * 64 + 32 + kq_); pre[6] = *(const u32x4*)(row + C_RA + dir * 64 + kq_); pre[7] = *(const u32x4*)(row + C_RA + dir * 64 + 32 + kq_); } } while (0)
    issue_loads(0);
#pragma unroll 1
    for (int cc = 0; cc < L / 64; ++cc) {
        const int t0 = (dir ? (L / 64 - 1 - cc) : cc) * 64;
        int tq = tid; asm volatile("" : "+v"(tq));
        const int fr = tq & 15, fq = (tq >> 4) & 3, pp = tq >> 3, ig = tq & 7, i0 = ig * 8;
        const int tt = dir ? (t0 + 63 - pp) : (t0 + pp);
        __syncthreads();
#pragma unroll
        for (int k = 0; k < 4; ++k) { const int q = tid + k * NTHREADS; if (q < 1584) { const int which = q / 528, rem = q - which * 528; *(LAS u32x4*)(lds + slot(which) + (rem >> 3) * 128 + (rem & 7) * 16) = pre[k]; } }
        asm volatile("" ::: "memory");
        if (cc > 0) { const int t0p = (dir ? (L / 64 - cc) : (cc - 1)) * 64; const int ttp = dir ? (t0p + 63 - pp) : (t0p + pp);
            *(u32x4*)(Y + ((size_t)b * L + ttp) * 512 + h * 64 + i0) = *(const LAS u32x4*)(lds + slot(9) + pp * PITCH + ig * 16); }
        { bf16x8 tw0, tw1;
          { float f[8]; unpack8(pre[4], f); u32x4 w; w.x = pk2(ftanh(f[0]), ftanh(f[1])); w.y = pk2(ftanh(f[2]), ftanh(f[3])); w.z = pk2(ftanh(f[4]), ftanh(f[5])); w.w = pk2(ftanh(f[6]), ftanh(f[7])); tw0 = __builtin_bit_cast(bf16x8, w); }
          { float f[8]; unpack8(pre[5], f); u32x4 w; w.x = pk2(ftanh(f[0]), ftanh(f[1])); w.y = pk2(ftanh(f[2]), ftanh(f[3])); w.z = pk2(ftanh(f[4]), ftanh(f[5])); w.w = pk2(ftanh(f[6]), ftanh(f[7])); tw1 = __builtin_bit_cast(bf16x8, w); }
          const bf16x8 al0 = __builtin_bit_cast(bf16x8, pre[6]), al1 = __builtin_bit_cast(bf16x8, pre[7]);
#pragma unroll
          for (int ct = 0; ct < 2; ++ct) { const int ctt = 2 * chh + ct;
            f32x4 wv = (f32x4){0.f, 0.f, 0.f, 0.f}, av = wv;
            wv = MFMA16(tw0, fragN(lds + O_W2T, 16 * ctt + fr, 0, fq), wv); wv = MFMA16(tw1, fragN(lds + O_W2T, 16 * ctt + fr, 1, fq), wv);
            av = MFMA16(al0, fragN(lds + O_A2T, 16 * ctt + fr, 0, fq), av); av = MFMA16(al1, fragN(lds + O_A2T, 16 * ctt + fr, 1, fq), av);
#pragma unroll
            for (int e = 0; e < 4; ++e) { gbuf[(16 * rt + 4 * fq + e) * 64 + 16 * ctt + fr] = wv[e]; *(LAS bf16_t*)(lds + slot(5) + (16 * rt + 4 * fq + e) * PITCH + (16 * ctt + fr) * 2) = (bf16_t)f2bf(av[e]); } } }
        if (cc + 1 < L / 64) issue_loads(cc + 1);
        __syncthreads();
        {
            const int rr = tt - t0 + 1;
#define LD2(dst, ptr) do { const f32x4 _a = *(const LAS f32x4*)(ptr), _b = *(const LAS f32x4*)((ptr) + 4); dst[0] = (f32x2){_a.x, _a.y}; dst[1] = (f32x2){_a.z, _a.w}; dst[2] = (f32x2){_b.x, _b.y}; dst[3] = (f32x2){_b.z, _b.w}; } while (0)
#define UP2(dst, wsrc_) do { const u32x4 _w = (wsrc_); dst[0] = (f32x2){bf2f(_w.x & 0xffffu), __uint_as_float(_w.x & 0xffff0000u)}; dst[1] = (f32x2){bf2f(_w.y & 0xffffu), __uint_as_float(_w.y & 0xffff0000u)}; \
                         dst[2] = (f32x2){bf2f(_w.z & 0xffffu), __uint_as_float(_w.z & 0xffff0000u)}; dst[3] = (f32x2){bf2f(_w.w & 0xffffu), __uint_as_float(_w.w & 0xffff0000u)}; } while (0)
#define TSHIFT(dst, sl, c0row) do { f32x2 xp[4], xc[4], xn[4], m0[4], m1[4]; \
                UP2(xp, *(const LAS u32x4*)(lds + slot(sl) + (rr - 1) * 128 + ig * 16)); UP2(xc, *(const LAS u32x4*)(lds + slot(sl) + rr * 128 + ig * 16)); UP2(xn, *(const LAS u32x4*)(lds + slot(sl) + (rr + 1) * 128 + ig * 16)); \
                LD2(m0, CT + (c0row) * 64 + i0); LD2(m1, CT + ((c0row) + 1) * 64 + i0); \
                _Pragma("unroll") for (int j2 = 0; j2 < 4; ++j2) dst[j2] = xc[j2] + m0[j2] * (xp[j2] - xc[j2]) + m1[j2] * (xn[j2] - xc[j2]); } while (0)
            f32x2 r2[4], v2[4], k2[4], lw2[4], a2v[4], kd2[4], kkr2[4];
            TSHIFT(r2, 0, 0);
            TSHIFT(v2, 2, 4);
            {   f32x2 ap[4], wr[4], c6[4], c7[4];
                UP2(ap, *(const LAS u32x4*)(lds + slot(5) + pp * PITCH + ig * 16)); LD2(wr, gbuf + pp * 64 + i0); LD2(c6, CT + 6 * 64 + i0); LD2(c7, CT + 7 * 64 + i0);
#pragma unroll
                for (int j2 = 0; j2 < 4; ++j2) { const f32x2 wraw = wr[j2] + c6[j2], araw = ap[j2] + c7[j2];
                    lw2[j2] = (f32x2){-0.60653066f * frcp(1.0f + __expf(-wraw.x)), -0.60653066f * frcp(1.0f + __expf(-wraw.y))};
                    a2v[j2] = (f32x2){frcp(1.0f + __expf(-araw.x)), frcp(1.0f + __expf(-araw.y))}; } }
            TSHIFT(k2, 1, 2);
            f32x2 ss2 = (f32x2){0.f, 0.f}, bs2 = ss2;
            {   f32x2 c8[4], c9[4], c10[4]; LD2(c8, CT + 8 * 64 + i0); LD2(c9, CT + 9 * 64 + i0); LD2(c10, CT + 10 * 64 + i0);
#pragma unroll
                for (int j2 = 0; j2 < 4; ++j2) { kkr2[j2] = k2[j2] * c8[j2]; ss2 += kkr2[j2] * kkr2[j2]; kd2[j2] = k2[j2] * (1.0f + (a2v[j2] - 1.0f) * c9[j2]); bs2 += r2[j2] * kd2[j2] * c10[j2]; } }
            const float ss = sum8(ss2.x + ss2.y);
            { const float bs = sum8(bs2.x + bs2.y); if (ig == 0) BON[((size_t)b * 8 + h) * L + tt] = bs; }
            const float rn_ = __builtin_amdgcn_rsqf(fmaxf(ss, 1e-24f));
            f32x2 aa2[4], bb2[4];
#pragma unroll
            for (int j2 = 0; j2 < 4; ++j2) { const f32x2 kk = kkr2[j2] * rn_; aa2[j2] = -kk; bb2[j2] = kk * a2v[j2]; }
#define PK4(v) ((u32x4){pk2(v[0].x, v[0].y), pk2(v[1].x, v[1].y), pk2(v[2].x, v[2].y), pk2(v[3].x, v[3].y)})
            *(LAS u32x4*)(lds + slot(7) + pp * PITCH + ig * 16) = PK4(aa2);
            *(LAS u32x4*)(lds + slot(8) + pp * PITCH + ig * 16) = PK4(r2);
            *(LAS u32x4*)(lds + slot(9) + pp * PITCH + ig * 16) = PK4(bb2);
            *(LAS u32x4*)(lds + slot(3) + pp * PITCH + ig * 16) = PK4(kd2);
            *(LAS u32x4*)(lds + slot(6) + pp * PITCH + ig * 16) = PK4(v2);
            *(LAS u32x4*)(lds + slot(4) + pp * PITCH + ig * 16) = PK4(lw2);
#undef TSHIFT
        }
        __syncthreads();
#pragma unroll
        for (int ct = 0; ct < 2; ++ct) { const int ctt = 2 * chh + ct; f32x4 acc = (f32x4){0.f, 0.f, 0.f, 0.f};
#pragma unroll
            for (int ks = 0; ks < 2; ++ks) if (32 * ks <= 16 * rt + 15) {
                const int pa = 16 * rt + fr - 32 * ks - 4 * fq, pb2 = pa - 16;
                u32x4 lt;
                lt.x = (pa >= 1 ? 0x3F803F80u : (pa == 0 ? 0x00003F80u : 0u)); lt.y = (pa >= 3 ? 0x3F803F80u : (pa == 2 ? 0x00003F80u : 0u));
                lt.z = (pb2 >= 1 ? 0x3F803F80u : (pb2 == 0 ? 0x00003F80u : 0u)); lt.w = (pb2 >= 3 ? 0x3F803F80u : (pb2 == 2 ? 0x00003F80u : 0u));
                acc = MFMA16(__builtin_bit_cast(bf16x8, lt), fragT(lds + slot(4), 16 * ctt, ks, fr, fq), acc); }
#pragma unroll
            for (int e = 0; e < 4; ++e) gbuf[(16 * rt + 4 * fq + e) * 64 + 16 * ctt + fr] = acc[e]; }
        __syncthreads();
        {
            f32x2 aa2[4], r2[4], bb2[4], kd2[4], gi2[4], ge2[4];
            UP2(aa2, *(const LAS u32x4*)(lds + slot(7) + pp * PITCH + ig * 16)); UP2(r2, *(const LAS u32x4*)(lds + slot(8) + pp * PITCH + ig * 16));
            UP2(bb2, *(const LAS u32x4*)(lds + slot(9) + pp * PITCH + ig * 16)); UP2(kd2, *(const LAS u32x4*)(lds + slot(3) + pp * PITCH + ig * 16));
            LD2(gi2, gbuf + pp * 64 + i0);
            LD2(ge2, gbuf + (pp > 0 ? pp - 1 : 0) * 64 + i0);
            if (pp == 0) { ge2[0] = (f32x2){0.f, 0.f}; ge2[1] = ge2[0]; ge2[2] = ge2[0]; ge2[3] = ge2[0]; }
            f32x2 At[4], Rt[4], Bb[4], Kb[4];
#pragma unroll
            for (int j2 = 0; j2 < 4; ++j2) { const f32x2 ei = (f32x2){__expf(gi2[j2].x), __expf(gi2[j2].y)}, ee = (f32x2){__expf(ge2[j2].x), __expf(ge2[j2].y)}, inv = (f32x2){frcp(ei.x), frcp(ei.y)};
                At[j2] = aa2[j2] * ee; Rt[j2] = r2[j2] * ei; Bb[j2] = bb2[j2] * inv; Kb[j2] = kd2[j2] * inv;
                if (pp == 63) { GC[i0 + 2 * j2] = ei.x; GC[i0 + 2 * j2 + 1] = ei.y; } }
            *(LAS u32x4*)(lds + slot(0) + pp * PITCH + ig * 16) = PK4(At);
            *(LAS u32x4*)(lds + slot(1) + pp * PITCH + ig * 16) = PK4(Rt);
            *(LAS u32x4*)(lds + slot(2) + pp * PITCH + ig * 16) = PK4(Bb);
            *(LAS u32x4*)(lds + slot(3) + pp * PITCH + ig * 16) = PK4(Kb);
#undef PK4
#undef UP2
#undef LD2
        }
        __syncthreads();
        { const bf16x8 at0 = fragN(lds + slot(0), 16 * rt + fr, 0, fq), at1 = fragN(lds + slot(0), 16 * rt + fr, 1, fq), rt0 = fragN(lds + slot(1), 16 * rt + fr, 0, fq), rt1 = fragN(lds + slot(1), 16 * rt + fr, 1, fq);
#pragma unroll
          for (int ct = 0; ct < 2; ++ct) { const int ctt = 2 * chh + ct;
            f32x4 ab = (f32x4){0.f, 0.f, 0.f, 0.f}, ak = ab, rb = ab, rk = ab;
            if (ctt <= rt) {
                const bf16x8 b0 = fragN(lds + slot(2), 16 * ctt + fr, 0, fq), b1 = fragN(lds + slot(2), 16 * ctt + fr, 1, fq), k0 = fragN(lds + slot(3), 16 * ctt + fr, 0, fq), k1 = fragN(lds + slot(3), 16 * ctt + fr, 1, fq);
                ab = MFMA16(at0, b0, ab); ab = MFMA16(at1, b1, ab); ak = MFMA16(at0, k0, ak); ak = MFMA16(at1, k1, ak);
                rb = MFMA16(rt0, b0, rb); rb = MFMA16(rt1, b1, rb); rk = MFMA16(rt0, k0, rk); rk = MFMA16(rt1, k1, rk); }
            float vab[4], vak[4], vrb[4], vrk[4];
#pragma unroll
            for (int e = 0; e < 4; ++e) { const int prow = 16 * rt + 4 * fq + e, jcol = 16 * ctt + fr; const bool st = prow > jcol, inc = prow >= jcol;
                vab[e] = st ? ab[e] : 0.f; vak[e] = st ? ak[e] : 0.f; vrb[e] = inc ? rb[e] : 0.f; vrk[e] = inc ? rk[e] : 0.f; }
            const int off = (16 * ctt + fr) * PITCH + (16 * rt + 4 * fq) * 2;
            *(LAS u32x2*)(lds + O_GBUF + off) = (u32x2){pkbf(vab[0], vab[1]), pkbf(vab[2], vab[3])};
            *(LAS u32x2*)(lds + slot(7) + off) = (u32x2){pkbf(vak[0], vak[1]), pkbf(vak[2], vak[3])};
            *(LAS u32x2*)(lds + slot(8) + off) = (u32x2){pkbf(vrb[0], vrb[1]), pkbf(vrb[2], vrb[3])};
            *(LAS u32x2*)(lds + slot(9) + off) = (u32x2){pkbf(vrk[0], vrk[1]), pkbf(vrk[2], vrk[3])}; } }
        __syncthreads();
        f32x4 accA[4];
        f32x4 accK[4];
#pragma unroll
        for (int q = 0; q < 4; ++q) { accA[q] = (f32x4){0.f, 0.f, 0.f, 0.f}; accK[q] = accA[q]; }
        const int yg = (wave == 4) ? 3 : wave - 5;
        if (wave < 4) {
            const bf16x8 s0 = fragN(lds + O_SB, 16 * wave + fr, 0, fq), s1 = fragN(lds + O_SB, 16 * wave + fr, 1, fq), v0 = fragT(lds + slot(6), 16 * wave, 0, fr, fq), v1 = fragT(lds + slot(6), 16 * wave, 1, fr, fq);
#pragma unroll
            for (int q = 0; q < 4; ++q) { f32x4 a = accA[q];
                a = MFMA16(fragN(lds + slot(0), 16 * q + fr, 0, fq), s0, a); a = MFMA16(fragN(lds + slot(0), 16 * q + fr, 1, fq), s1, a);
                a = MFMA16(fragT(lds + slot(7), 16 * q, 0, fr, fq), v0, a); if (q >= 2) a = MFMA16(fragT(lds + slot(7), 16 * q, 1, fr, fq), v1, a);
                accA[q] = a;
                f32x4 kx = accK[q]; kx = MFMA16(fragT(lds + slot(3), 16 * q, 0, fr, fq), v0, kx); kx = MFMA16(fragT(lds + slot(3), 16 * q, 1, fr, fq), v1, kx); accK[q] = kx;
                asm volatile("" ::: "memory"); }
        } else if (wave == 4) {
            const int pb = fq, j = fr; float T[16];
#pragma unroll
            for (int q = 0; q < 16; ++q) T[q] = (q == j) ? 1.f : 0.f;
#pragma unroll
            for (int sg = 0; sg < 4; ++sg) {
                u32x4 ar[4][2];
#pragma unroll
                for (int r4 = 0; r4 < 4; ++r4) { ar[r4][0] = *(const LAS u32x4*)(lds + O_GBUF + (16 * pb + 4 * sg + r4) * PITCH + 32 * pb); ar[r4][1] = *(const LAS u32x4*)(lds + O_GBUF + (16 * pb + 4 * sg + r4) * PITCH + 32 * pb + 16); }
#pragma unroll
                for (int r4 = 0; r4 < 4; ++r4) { const int s2 = 4 * sg + r4; float av[16]; unpack8(ar[r4][0], av); unpack8(ar[r4][1], av + 8);
#pragma unroll
                    for (int q = s2 + 1; q < 16; ++q) T[q] += av[q] * T[s2]; }
                asm volatile("" ::: "memory");
            }
#pragma unroll
            for (int q = 0; q < 16; ++q) TPP[(pb * 16 + q) * 20 + j] = (bf16_t)f2bf(T[q]);
        }
#define Y_PART() do { const bf16x8 s0 = fragN(lds + O_SB, 16 * yg + fr, 0, fq), s1 = fragN(lds + O_SB, 16 * yg + fr, 1, fq), v0 = fragT(lds + slot(6), 16 * yg, 0, fr, fq), v1 = fragT(lds + slot(6), 16 * yg, 1, fr, fq); \
            _Pragma("unroll") for (int q = 0; q < 4; ++q) { f32x4 a = accA[q]; \
                a = MFMA16(fragN(lds + slot(1), 16 * q + fr, 0, fq), s0, a); a = MFMA16(fragN(lds + slot(1), 16 * q + fr, 1, fq), s1, a); \
                a = MFMA16(fragT(lds + slot(9), 16 * q, 0, fr, fq), v0, a); if (q >= 2) a = MFMA16(fragT(lds + slot(9), 16 * q, 1, fr, fq), v1, a); \
                accA[q] = a; asm volatile("" ::: "memory"); } } while (0)
        if (wave >= 5) Y_PART();
        __syncthreads();
        if (wave < 4) {
            u32x2 Ub[4];
            bf16x8 fa[4]; u32x2 ft[4];
#pragma unroll
            for (int z = 0; z < 4; ++z) { const int pb = (z == 3) ? 3 : z + 1, k2 = (z == 3) ? 1 : 0;
                fa[z] = fragT(lds + O_GBUF, 16 * pb, k2, fr, fq);
                ft[z] = *(const LAS u32x2*)(lds + O_TPP + ((z * 16 + fr) * 20 + 4 * fq) * 2); }
#pragma unroll
            for (int pb = 0; pb < 4; ++pb) {
                f32x4 tmp = accA[pb];
#pragma unroll
                for (int k2 = 0; k2 < 2; ++k2) if (2 * k2 < pb) { const int z = (pb == 3 && k2 == 1) ? 3 : pb - 1;
                    const u32x2 b0 = Ub[2 * k2]; const u32x2 b1 = (2 * k2 + 1 < pb) ? Ub[2 * k2 + 1] : (u32x2){0u, 0u};
                    const u32x4 bv = (u32x4){b0.x, b0.y, b1.x, b1.y};
                    tmp = MFMA16(fa[z], __builtin_bit_cast(bf16x8, bv), tmp); }
                const u32x4 av = (u32x4){ft[pb].x, ft[pb].y, 0u, 0u}, bv = (u32x4){pkbf(tmp[0], tmp[1]), pkbf(tmp[2], tmp[3]), 0u, 0u};
                const f32x4 U = MFMA16(__builtin_bit_cast(bf16x8, av), __builtin_bit_cast(bf16x8, bv), ((f32x4){0.f, 0.f, 0.f, 0.f}));
                Ub[pb] = (u32x2){pkbf(U[0], U[1]), pkbf(U[2], U[3])};
                *(LAS u32x2*)(lds + slot(4) + (16 * wave + fr) * PITCH + (16 * pb + 4 * fq) * 2) = Ub[pb];
            }
        } else if (wave == 4) Y_PART();
#undef Y_PART
        __syncthreads();
        if (wave >= 4) {
            const bf16x8 u0 = fragP(lds + slot(4), 16 * yg + fr, 0, fq), u1 = fragP(lds + slot(4), 16 * yg + fr, 1, fq);
#pragma unroll
            for (int q = 0; q < 4; ++q) { f32x4 a = accA[q];
                a = MFMA16(fragT(lds + slot(8), 16 * q, 0, fr, fq), u0, a); if (q >= 2) a = MFMA16(fragT(lds + slot(8), 16 * q, 1, fr, fq), u1, a);
#pragma unroll
                for (int e = 0; e < 4; ++e) *(LAS bf16_t*)(lds + slot(9) + (16 * q + 4 * fq + e) * PITCH + (16 * yg + fr) * 2) = (bf16_t)f2bf(a[e]); }
        } else {
            const bf16x8 u0 = fragP(lds + slot(4), 16 * wave + fr, 0, fq), u1 = fragP(lds + slot(4), 16 * wave + fr, 1, fq);
#pragma unroll
            for (int it = 0; it < 4; ++it) { f32x4 a = Sreg[it] + accK[it];
                a = MFMA16(fragT(lds + slot(2), 16 * it, 0, fr, fq), u0, a); a = MFMA16(fragT(lds + slot(2), 16 * it, 1, fr, fq), u1, a);
                const f32x4 gc = *(const LAS f32x4*)(GC + 16 * it + 4 * fq);
                a = a * gc; Sreg[it] = a;
                *(LAS u32x2*)(lds + O_SB + (16 * wave + fr) * PITCH + (16 * it + 4 * fq) * 2) = (u32x2){pkbf(a[0], a[1]), pkbf(a[2], a[3])};
                asm volatile("" ::: "memory"); }
        }
    }
    __syncthreads();
    { int tq = tid; asm volatile("" : "+v"(tq)); const int pp = tq >> 3, ig = tq & 7, i0 = ig * 8;
      const int t0p = (dir ? 0 : (L / 64 - 1)) * 64; const int ttp = dir ? (t0p + 63 - pp) : (t0p + pp);
      *(u32x4*)(Y + ((size_t)b * L + ttp) * 512 + h * 64 + i0) = *(const LAS u32x4*)(lds + slot(9) + pp * PITCH + ig * 16); }
    __syncthreads();
#undef issue_loads
}

constexpr int PT = 128;
__device__ __forceinline__ void rw_post_wg(const Params& p, LAS unsigned char* lds, int l, int G_, int bid, const int wvx) {
    const int tid = opaque_tid(wvx), lane = tid & 63, wave = __builtin_amdgcn_readfirstlane(tid >> 6), fr = lane & 15, fq = lane >> 4;
    const int h = bid & 7;
    const bf16_t* proj = (const bf16_t*)(p.ws + OFF_PROJ);
    const bf16_t* YF = (const bf16_t*)(p.ws + OFF_YF); const bf16_t* YB = (const bf16_t*)(p.ws + OFF_YB);
    const float* BONF = (const float*)(p.ws + OFF_BON); const float* BONB = BONF + (size_t)NT * 8;
    bf16_t* mix = (bf16_t*)(p.ws + OFF_MIX);
    constexpr int GP = 272;
    LAS unsigned char* G2T = lds;
    LAS unsigned char* SG = lds + 17408;
    LAS unsigned char* RAWV = lds + 52224;
    LAS unsigned char* GATE = lds + 68864;
    __syncthreads();
    { const float* g2 = p.in[22] + (size_t)l * 128 * 512 + h * 64;
        for (int i = tid; i < 8192; i += NTHREADS) { const int r = i >> 6, n = i & 63; *(LAS bf16_t*)(G2T + n * GP + r * 2) = (bf16_t)f2bf(g2[r * 512 + n]); } }
    const int ig = tid & 7, i0 = ig * 8, col = h * 64 + i0;
    float mv0[8], mv1[8], lnw[8], lnb[8];
#pragma unroll
    for (int j = 0; j < 8; ++j) { mv0[j] = p.in[14][(size_t)l * 3072 + 2 * 1024 + col + j]; mv1[j] = p.in[14][(size_t)l * 3072 + 2 * 1024 + 512 + col + j]; lnw[j] = p.in[23][l * 512 + col + j]; lnb[j] = p.in[24][l * 512 + col + j]; }
#pragma unroll 1
    for (int tile = bid >> 3; tile < NT / PT; tile += G_ >> 3) {
        const int row0 = tile * PT, tb0 = row0 & (L - 1);
        __syncthreads();
        u32x4 gq[4], vq[3]; u32x4 yq[2][2]; float bq[2];
#pragma unroll
        for (int k = 0; k < 4; ++k) { const int q = tid + k * NTHREADS; gq[k] = *(const u32x4*)(proj + (size_t)(row0 + (q >> 4)) * IN_DP + C_RG + (q & 15) * 8); }
#pragma unroll
        for (int k = 0; k < 3; ++k) { const int q = tid + k * NTHREADS; const int rr = q >> 3, ch = q & 7; const int tt = tb0 - 1 + rr; vq[k] = (u32x4){0u, 0u, 0u, 0u};
            if (q < 1040 && tt >= 0 && tt < L) vq[k] = *(const u32x4*)(proj + (size_t)(row0 - 1 + rr) * IN_DP + C_RV + h * 64 + ch * 8); }
#pragma unroll
        for (int sl = 0; sl < 2; ++sl) { const size_t row = (size_t)row0 + (tid >> 3) + 64 * sl; yq[sl][0] = *(const u32x4*)(YF + row * 512 + col); yq[sl][1] = *(const u32x4*)(YB + row * 512 + col);
            const size_t bi = ((size_t)(row >> 13) * 8 + h) * L + (row & (L - 1)); bq[sl] = BONF[bi] + BONB[bi]; }
#pragma unroll
        for (int k = 0; k < 4; ++k) { const int q = tid + k * NTHREADS; const int t = q >> 4, ch = q & 15; float f[8]; unpack8(gq[k], f);
            u32x4 w; w.x = pk2(frcp(1.f + __expf(-f[0])), frcp(1.f + __expf(-f[1]))); w.y = pk2(frcp(1.f + __expf(-f[2])), frcp(1.f + __expf(-f[3])));
            w.z = pk2(frcp(1.f + __expf(-f[4])), frcp(1.f + __expf(-f[5]))); w.w = pk2(frcp(1.f + __expf(-f[6])), frcp(1.f + __expf(-f[7])));
            *(LAS u32x4*)(SG + t * GP + ch * 16) = w; }
#pragma unroll
        for (int k = 0; k < 3; ++k) { const int q = tid + k * NTHREADS; if (q < 1040) *(LAS u32x4*)(RAWV + (q >> 3) * 128 + (q & 7) * 16) = vq[k]; }
        __syncthreads();
#pragma unroll
        for (int ct = 0; ct < 4; ++ct) { f32x4 acc = (f32x4){0.f, 0.f, 0.f, 0.f};
#pragma unroll
            for (int ks = 0; ks < 4; ++ks) { const bf16x8 a = *(const LAS bf16x8*)(SG + (16 * wave + fr) * GP + ks * 64 + fq * 16); const bf16x8 b = *(const LAS bf16x8*)(G2T + (16 * ct + fr) * GP + ks * 64 + fq * 16);
                acc = __builtin_amdgcn_mfma_f32_16x16x32_bf16(a, b, acc, 0, 0, 0); }
#pragma unroll
            for (int e = 0; e < 4; ++e) *(LAS bf16_t*)(GATE + (16 * wave + 4 * fq + e) * 144 + (16 * ct + fr) * 2) = (bf16_t)f2bf(acc[e]); }
        __syncthreads();
#pragma unroll
        for (int sl = 0; sl < 2; ++sl) { const int t = (tid >> 3) + 64 * sl; const size_t row = (size_t)row0 + t;
            float vp[8], vc[8], vn[8], gt[8];
            unpack8(*(const LAS u32x4*)(RAWV + t * 128 + ig * 16), vp); unpack8(*(const LAS u32x4*)(RAWV + (t + 1) * 128 + ig * 16), vc); unpack8(*(const LAS u32x4*)(RAWV + (t + 2) * 128 + ig * 16), vn);
            unpack8(*(const LAS u32x4*)(GATE + t * 144 + ig * 16), gt);
            float yf8[8], yb8[8]; unpack8(yq[sl][0], yf8); unpack8(yq[sl][1], yb8);
            const float bon = bq[sl];
            float y[8] = {yf8[0] + yb8[0], yf8[1] + yb8[1], yf8[2] + yb8[2], yf8[3] + yb8[3], yf8[4] + yb8[4], yf8[5] + yb8[5], yf8[6] + yb8[6], yf8[7] + yb8[7]};
            float sm = 0.f;
#pragma unroll
            for (int j = 0; j < 8; ++j) sm += y[j];
            const float mean = sum8(sm) * (1.0f / 64.0f);
            float sq = 0.f;
#pragma unroll
            for (int j = 0; j < 8; ++j) { y[j] -= mean; sq += y[j] * y[j]; }
            const float rstd = __builtin_amdgcn_rsqf(sum8(sq) * (1.0f / 64.0f) + 64e-5f);
            float o[8];
#pragma unroll
            for (int j = 0; j < 8; ++j) { const float v = vc[j] + mv0[j] * (vp[j] - vc[j]) + mv1[j] * (vn[j] - vc[j]); o[j] = (y[j] * rstd * lnw[j] + lnb[j] + bon * v) * gt[j]; }
            u32x4 w; w.x = pk2(o[0], o[1]); w.y = pk2(o[2], o[3]); w.z = pk2(o[4], o[5]); w.w = pk2(o[6], o[7]);
            *(u32x4*)(mix + row * D + 256 + col) = w; }
    }
    __syncthreads();
}

namespace na {
constexpr int O_K = 0, O_V = 65536, O_RPB = 131072, O_MX = 133120, O_QW = 142080;
__device__ __forceinline__ int rowoff(int keycol, int byte) { return keycol * 128 + ((((byte >> 5) ^ keycol) & 3) << 5) + (byte & 31); }
typedef short s16x4 __attribute__((ext_vector_type(4)));
}
__device__ __forceinline__ void na_strip(const Params& p, LAS unsigned char* lds, int l, int strip, const int wvx) {
    using namespace na;
    const int tid = opaque_tid(wvx), lane = tid & 63, wave = __builtin_amdgcn_readfirstlane(tid >> 6), fr = lane & 15, fq = lane >> 4;
    const int b = strip >> 5, h = (strip >> 3) & 3, i0 = (strip & 7) * 16;
    const int g = wave & 3, kh = wave >> 2;
    const bf16_t* proj = (const bf16_t*)(p.ws + OFF_PROJ);
    bf16_t* mix = (bf16_t*)(p.ws + OFF_MIX);
    LAS float* RPB = (LAS float*)(lds + O_RPB);
    LAS unsigned char* MX = lds + O_MX + g * 2240;
    const int j0 = 16 * g, c0 = (g == 0) ? 0 : ((g == 3) ? 32 : 16 * g - 8);
    __syncthreads();
    for (int q = tid; q < 465; q += NTHREADS) RPB[q] = p.in[25][((size_t)l * 4 + h) * 465 + q];
    { int rs = i0 - 4; rs = rs < 0 ? 0 : (rs > 120 ? 120 : rs);
        u32x4 fw[16];
#pragma unroll
        for (int k = 0; k < 16; ++k) { const int q = tid + k * NTHREADS; const int r8 = q >> 10, which = (q >> 9) & 1, col = (q >> 3) & 63, ch = q & 7; const int kr = rs + r8;
            fw[k] = *(const u32x4*)(proj + ((size_t)b * L + kr * 64 + col) * IN_DP + (which ? C_NV : C_NK) + h * 64 + ch * 8); }
#pragma unroll
        for (int k = 0; k < 16; ++k) { const int q = tid + k * NTHREADS; const int r8 = q >> 10, which = (q >> 9) & 1, col = (q >> 3) & 63, ch = q & 7; const int kr = rs + r8;
            *(LAS u32x4*)(lds + (which ? O_V : O_K) + (kr & 7) * 8192 + rowoff(col, 16 * ch)) = fw[k]; } }
    bf16x8 Bq[2];
#pragma unroll
    for (int ks = 0; ks < 2; ++ks) Bq[ks] = *(const bf16x8*)(proj + ((size_t)b * L + i0 * 64 + j0 + fr) * IN_DP + C_NQ + h * 64 + 32 * ks + 8 * fq);
    const int jq = j0 + fr;
    int cs = jq - 8; cs = cs < 0 ? 0 : (cs > 48 ? 48 : cs);
    const u32x4 onesv = (u32x4){0x3F803F80u, 0x3F803F80u, 0x3F803F80u, 0x3F803F80u};
#pragma unroll 1
    for (int i = i0; i < i0 + 16; ++i) {
        int rs = i - 4; rs = rs < 0 ? 0 : (rs > 120 ? 120 : rs);
        int rsn = i + 1 - 4; rsn = rsn < 0 ? 0 : (rsn > 120 ? 120 : rsn);
        const bool more = (i + 1 < i0 + 16), newrow = more && (rsn > rs);
        __syncthreads();
        u32x4 pre0 = (u32x4){0u, 0u, 0u, 0u}, pre1 = pre0; bf16x8 Bqn[2] = {Bq[0], Bq[1]};
        if (newrow) { const int kr = rsn + 7;
            { const int q = tid; const int which = q >> 9, col = (q >> 3) & 63, ch = q & 7; pre0 = *(const u32x4*)(proj + ((size_t)b * L + kr * 64 + col) * IN_DP + (which ? C_NV : C_NK) + h * 64 + ch * 8); }
            { const int q = tid + 512; const int which = q >> 9, col = (q >> 3) & 63, ch = q & 7; pre1 = *(const u32x4*)(proj + ((size_t)b * L + kr * 64 + col) * IN_DP + (which ? C_NV : C_NK) + h * 64 + ch * 8); } }
        if (more) {
#pragma unroll
            for (int ks = 0; ks < 2; ++ks) Bqn[ks] = *(const bf16x8*)(proj + ((size_t)b * L + (i + 1) * 64 + j0 + fr) * IN_DP + C_NQ + h * 64 + 32 * ks + 8 * fq); }
        f32x4 S[4][2]; float mloc = -1e30f;
#pragma unroll
        for (int r4 = 0; r4 < 4; ++r4) { const int krow = rs + 4 * kh + r4, slot = krow & 7, dr = krow - i + 7;
#pragma unroll
            for (int ct = 0; ct < 2; ++ct) { const int keycol = c0 + 16 * ct + fr; f32x4 acc = (f32x4){0.f, 0.f, 0.f, 0.f};
#pragma unroll
                for (int ks = 0; ks < 2; ++ks) { const bf16x8 a = *(const LAS bf16x8*)(lds + O_K + slot * 8192 + rowoff(keycol, 64 * ks + 16 * fq)); acc = __builtin_amdgcn_mfma_f32_16x16x32_bf16(a, Bq[ks], acc, 0, 0, 0); }
#pragma unroll
                for (int e = 0; e < 4; ++e) { const int kc = c0 + 16 * ct + 4 * fq + e; const bool valid = (kc >= cs) && (kc < cs + 16);
                    int dc = kc - jq; dc = dc < -15 ? -15 : (dc > 15 ? 15 : dc); dc += 15;
                    const float sc = valid ? (acc[e] * 0.125f + RPB[dr * 31 + dc]) : -1e30f; acc[e] = sc; mloc = fmaxf(mloc, sc); }
                S[r4][ct] = acc; } }
        { int lid; asm volatile("v_mbcnt_lo_u32_b32 %0, -1, 0\n\tv_mbcnt_hi_u32_b32 %0, -1, %0" : "=v"(lid));
          mloc = fmaxf(mloc, __int_as_float(__builtin_amdgcn_ds_bpermute((lid ^ 16) << 2, __float_as_int(mloc))));
          mloc = fmaxf(mloc, __int_as_float(__builtin_amdgcn_ds_bpermute((lid ^ 32) << 2, __float_as_int(mloc)))); }
        bf16x8 Ap[4];
#pragma unroll
        for (int r4 = 0; r4 < 4; ++r4) { float pv[8];
#pragma unroll
            for (int ct = 0; ct < 2; ++ct)
#pragma unroll
                for (int e = 0; e < 4; ++e) { const float sc = S[r4][ct][e]; pv[ct * 4 + e] = (sc > -1e29f) ? __expf(sc - mloc) : 0.f; }
            const u32x4 w = (u32x4){pk2(pv[0], pv[1]), pk2(pv[2], pv[3]), pk2(pv[4], pv[5]), pk2(pv[6], pv[7])}; Ap[r4] = __builtin_bit_cast(bf16x8, w); }
        f32x4 O[4], Ls = (f32x4){0.f, 0.f, 0.f, 0.f};
#pragma unroll
        for (int dt = 0; dt < 4; ++dt) O[dt] = (f32x4){0.f, 0.f, 0.f, 0.f};
#pragma unroll
        for (int r4 = 0; r4 < 4; ++r4) { const int slot = (rs + 4 * kh + r4) & 7; const int kc0 = c0 + 4 * fq + (fr >> 2), kc1 = kc0 + 16;
            Ls = __builtin_amdgcn_mfma_f32_16x16x32_bf16(Ap[r4], __builtin_bit_cast(bf16x8, onesv), Ls, 0, 0, 0);
#pragma unroll
            for (int dt = 0; dt < 4; ++dt) {
                const s16x4 v0 = __builtin_amdgcn_ds_read_tr16_b64_v4i16((LAS s16x4*)(lds + O_V + slot * 8192 + rowoff(kc0, 32 * dt + 8 * (fr & 3))));
                const s16x4 v1 = __builtin_amdgcn_ds_read_tr16_b64_v4i16((LAS s16x4*)(lds + O_V + slot * 8192 + rowoff(kc1, 32 * dt + 8 * (fr & 3))));
                const bf16x8 bv = (bf16x8){v0[0], v0[1], v0[2], v0[3], v1[0], v1[1], v1[2], v1[3]};
                O[dt] = __builtin_amdgcn_mfma_f32_16x16x32_bf16(Ap[r4], bv, O[dt], 0, 0, 0); } }
        if (fq == 0) *(LAS float*)(MX + kh * 64 + fr * 4) = mloc;
        if (kh == 1) { if (fr == 0) *(LAS f32x4*)(MX + 128 + fq * 16) = Ls;
#pragma unroll
            for (int dt = 0; dt < 4; ++dt)
#pragma unroll
                for (int e = 0; e < 4; ++e) *(LAS bf16_t*)(MX + 192 + (4 * fq + e) * 128 + (16 * dt + fr) * 2) = (bf16_t)f2bf(O[dt][e]); }
        __syncthreads();
        if (newrow) { const int kr = rsn + 7;
            { const int q = tid; const int which = q >> 9, col = (q >> 3) & 63, ch = q & 7; *(LAS u32x4*)(lds + (which ? O_V : O_K) + (kr & 7) * 8192 + rowoff(col, 16 * ch)) = pre0; }
            { const int q = tid + 512; const int which = q >> 9, col = (q >> 3) & 63, ch = q & 7; *(LAS u32x4*)(lds + (which ? O_V : O_K) + (kr & 7) * 8192 + rowoff(col, 16 * ch)) = pre1; } }
        if (kh == 0) {
            const f32x4 m0 = *(const LAS f32x4*)(MX + fq * 16), m1 = *(const LAS f32x4*)(MX + 64 + fq * 16), l1 = *(const LAS f32x4*)(MX + 128 + fq * 16);
#pragma unroll
            for (int e = 0; e < 4; ++e) { const float M = fmaxf(m0[e], m1[e]), a0 = __expf(m0[e] - M), a1 = __expf(m1[e] - M); const float inv = frcp(Ls[e] * a0 + l1[e] * a1);
                const size_t row = (size_t)b * L + i * 64 + j0 + 4 * fq + e;
#pragma unroll
                for (int dt = 0; dt < 4; ++dt) { const float o1 = bf2f(*(const LAS bf16_t*)(MX + 192 + (4 * fq + e) * 128 + (16 * dt + fr) * 2));
                    mix[row * D + 768 + h * 64 + 16 * dt + fr] = (bf16_t)f2bf((O[dt][e] * a0 + o1 * a1) * inv); } }
        }
        Bq[0] = Bqn[0]; Bq[1] = Bqn[1];
    }
    __syncthreads();
}

__device__ __forceinline__ void wg_signal(int* ctr, const bool leader) {
    asm volatile("s_waitcnt vmcnt(0)" ::: "memory");
    __syncthreads();
    if (leader) { __builtin_amdgcn_fence(__ATOMIC_RELEASE, "agent"); asm volatile("s_waitcnt vmcnt(0)" ::: "memory"); __hip_atomic_fetch_add(ctr, 1, __ATOMIC_RELAXED, __HIP_MEMORY_SCOPE_AGENT); }
}
__device__ __forceinline__ void wg_wait(int* ctr, int target, const bool leader) {
    if (leader) { unsigned sp = 0;
        while (__hip_atomic_load(ctr, __ATOMIC_RELAXED, __HIP_MEMORY_SCOPE_AGENT) < target) { __builtin_amdgcn_s_sleep(2); if (++sp > (1u << 24)) break; }
        __builtin_amdgcn_fence(__ATOMIC_ACQUIRE, "agent"); asm volatile("s_waitcnt vmcnt(0)" ::: "memory"); }
    __syncthreads();
}
__device__ __forceinline__ int wg_pop(int* ctr, LAS int* qw, const bool leader) {
    __syncthreads();
    if (leader) *qw = __hip_atomic_fetch_add(ctr, 1, __ATOMIC_RELAXED, __HIP_MEMORY_SCOPE_AGENT);
    __syncthreads();
    return __builtin_amdgcn_readfirstlane(*qw);
}
__device__ __forceinline__ void na_queue(const Params& p, LAS unsigned char* lds, int l, const int wvx) {
    int* ctr = (int*)(p.ws + OFF_CTL) + 16 + l;
    LAS int* qw = (LAS int*)(lds + na::O_QW);
    for (;;) {
        __syncthreads();
        if (opaque_tid(wvx) == 0) *qw = atomicAdd(ctr, 1);
        __syncthreads();
        const int strip = __builtin_amdgcn_readfirstlane(*qw);
        if (strip >= 256) break;
        na_strip(p, lds, l, strip, wvx);
    }
}

__device__ __forceinline__ void phase_router(const Params& p, LAS unsigned char* lds, int l, int G_, int bid, const int wvx) {
    const int tid = opaque_tid(wvx), lane = tid & 63, wave = __builtin_amdgcn_readfirstlane(tid >> 6), fr = lane & 15, fq = lane >> 4;
    const bf16_t* x = (const bf16_t*)(p.ws + OFF_XB); float* rs = (float*)(p.ws + OFF_RS);
    const bf16_t* rgh = (const bf16_t*)(p.ws + OFF_RGW) + (size_t)l * 2 * 48 * D; const bf16_t* rgl = rgh + 48 * D;
    int* cnt = (int*)(p.ws + OFF_CTL) + 64 + l * 64;
    int* ltok = (int*)(p.ws + OFF_LTOK); float* lgate = (float*)(p.ws + OFF_LGATE); float* lrs = (float*)(p.ws + OFF_LRS);
    LAS int* lcnt = (LAS int*)lds;
    LAS int* lbase = lcnt + 32;
    LAS int* se = lbase + 32;
    LAS int* sp = se + 512;
    LAS float* sg = (LAS float*)(sp + 512);
    LAS float* LG = (LAS float*)(lds + 8192);
    LAS float* SQ = LG + 256 * 52;
    const float* bg = p.in[29] + l * 4; const float* be = p.in[31] + l * 32;
    for (int chunk = bid; chunk < NT / 256; chunk += G_) {
        __syncthreads();
        if (tid < 32) lcnt[tid] = 0;
        const int tl0 = wave * 32;
        const bf16_t* xa_p = x + (size_t)(chunk * 256 + tl0 + fr) * D + 8 * fq; const bf16_t* xb_p = xa_p + 16 * D;
        const bf16_t* wh_p = rgh + (size_t)fr * D + 8 * fq; const bf16_t* wl_p = rgl + (size_t)fr * D + 8 * fq;
        f32x4 acc[2][3];
#pragma unroll
        for (int t = 0; t < 2; ++t)
#pragma unroll
            for (int c = 0; c < 3; ++c) acc[t][c] = (f32x4){0.f, 0.f, 0.f, 0.f};
        float ssa = 0.f, ssb = 0.f;
#pragma unroll 2
        for (int ks = 0; ks < 32; ++ks) {
            const u32x4 ar = *(const u32x4*)(xa_p + 32 * ks), br = *(const u32x4*)(xb_p + 32 * ks);
            bf16x8 wh[3], wl[3];
#pragma unroll
            for (int c = 0; c < 3; ++c) { wh[c] = *(const bf16x8*)(wh_p + (size_t)16 * c * D + 32 * ks); wl[c] = *(const bf16x8*)(wl_p + (size_t)16 * c * D + 32 * ks); }
            { float f[8]; unpack8(ar, f);
#pragma unroll
              for (int j = 0; j < 8; ++j) ssa += f[j] * f[j];
              unpack8(br, f);
#pragma unroll
              for (int j = 0; j < 8; ++j) ssb += f[j] * f[j]; }
            const bf16x8 a0 = __builtin_bit_cast(bf16x8, ar), a1 = __builtin_bit_cast(bf16x8, br);
#pragma unroll
            for (int c = 0; c < 3; ++c) {
                acc[0][c] = __builtin_amdgcn_mfma_f32_16x16x32_bf16(a0, wh[c], acc[0][c], 0, 0, 0); acc[0][c] = __builtin_amdgcn_mfma_f32_16x16x32_bf16(a0, wl[c], acc[0][c], 0, 0, 0);
                acc[1][c] = __builtin_amdgcn_mfma_f32_16x16x32_bf16(a1, wh[c], acc[1][c], 0, 0, 0); acc[1][c] = __builtin_amdgcn_mfma_f32_16x16x32_bf16(a1, wl[c], acc[1][c], 0, 0, 0); }
        }
#pragma unroll
        for (int t = 0; t < 2; ++t)
#pragma unroll
            for (int c = 0; c < 3; ++c)
#pragma unroll
                for (int e = 0; e < 4; ++e) LG[(tl0 + 16 * t + 4 * fq + e) * 52 + 16 * c + fr] = acc[t][c][e];
        SQ[(tl0 + fr) * 4 + fq] = ssa; SQ[(tl0 + 16 + fr) * 4 + fq] = ssb;
        __syncthreads();
        if (lane < 32) { const int tl = tl0 + lane, row = chunk * 256 + tl;
            const f32x4 s4 = *(const LAS f32x4*)(SQ + tl * 4);
            const float rr = 1.0f / sqrtf(((s4.x + s4.y) + (s4.z + s4.w)) * (1.0f / D) + NORM_EPS);
            rs[row] = rr; SQ[tl * 4] = rr;
            const LAS float* lg = LG + tl * 52;
            const float g0 = lg[0] * rr + bg[0], g1 = lg[1] * rr + bg[1], g2 = lg[2] * rr + bg[2], g3 = lg[3] * rr + bg[3];
            int gs = 0; float gm = g0; if (g1 > gm) { gm = g1; gs = 1; } if (g2 > gm) { gm = g2; gs = 2; } if (g3 > gm) { gm = g3; gs = 3; }
            const float gprob = 1.0f / (expf(g0 - gm) + expf(g1 - gm) + expf(g2 - gm) + expf(g3 - gm));
            float ev[8];
#pragma unroll
            for (int e = 0; e < 8; ++e) ev[e] = lg[4 + gs * 8 + e] * rr + be[gs * 8 + e];
            int i0 = 0; float v0 = ev[0];
#pragma unroll
            for (int e = 1; e < 8; ++e) if (ev[e] > v0) { v0 = ev[e]; i0 = e; }
            int i1 = -1; float v1 = -3.0e38f;
#pragma unroll
            for (int e = 0; e < 8; ++e) if (e != i0 && ev[e] > v1) { v1 = ev[e]; i1 = e; }
            const float e1 = expf(v1 - v0), den = 1.0f + e1;
            const int ea = gs * 8 + i0, eb = gs * 8 + i1;
            se[tl * 2] = ea; se[tl * 2 + 1] = eb; sg[tl * 2] = gprob / den; sg[tl * 2 + 1] = gprob * e1 / den;
            sp[tl * 2] = atomicAdd((int*)lcnt + ea, 1); sp[tl * 2 + 1] = atomicAdd((int*)lcnt + eb, 1); }
        __syncthreads();
        if (tid < 32) lbase[tid] = atomicAdd(cnt + tid, lcnt[tid]);
        __syncthreads();
        { const int tl = tid >> 1, k = tid & 1, e = se[tid]; const size_t li = (size_t)e * LCAP + lbase[e] + sp[tid];
            ltok[li] = (chunk * 256 + tl) * 2 + k; lgate[li] = sg[tid]; lrs[li] = SQ[tl * 4]; }
    }
    __syncthreads();
}

__device__ __forceinline__ void phase_combine(const Params& p, bool last, int G_, int bid, const int wvx) {
    const int tid = opaque_tid(wvx), lane = tid & 63, wave = tid >> 6;
    float* out = p.out; bf16_t* x16 = (bf16_t*)(p.ws + OFF_XB); float* rs = (float*)(p.ws + OFF_RS);
    const bf16_t* yb = (const bf16_t*)(p.ws + OFF_YBUF);
    const float* gf = p.in[35];
    for (int row = bid * 8 + wave; row < NT; row += G_ * 8) {
        u32x2* xr = (u32x2*)(x16 + (size_t)row * D) + lane; const u32x2* y0 = (const u32x2*)(yb + (size_t)(2 * row) * D) + lane; const u32x2* y1 = (const u32x2*)(yb + (size_t)(2 * row + 1) * D) + lane;
        f32x4 v[4]; float s = 0.f; u32x2 xq[4], aq[4], cq[4];
#pragma unroll
        for (int j = 0; j < 4; ++j) { xq[j] = xr[64 * j]; aq[j] = y0[64 * j]; cq[j] = y1[64 * j]; }
#pragma unroll
        for (int j = 0; j < 4; ++j) { const u32x2 xx = xq[j], a = aq[j], c = cq[j];
            v[j].x = bf2f(xx.x & 0xffffu) + bf2f(a.x & 0xffffu) + bf2f(c.x & 0xffffu); v[j].y = __uint_as_float(xx.x & 0xffff0000u) + __uint_as_float(a.x & 0xffff0000u) + __uint_as_float(c.x & 0xffff0000u);
            v[j].z = bf2f(xx.y & 0xffffu) + bf2f(a.y & 0xffffu) + bf2f(c.y & 0xffffu); v[j].w = __uint_as_float(xx.y & 0xffff0000u) + __uint_as_float(a.y & 0xffff0000u) + __uint_as_float(c.y & 0xffff0000u);
            s += (v[j].x * v[j].x + v[j].y * v[j].y) + (v[j].z * v[j].z + v[j].w * v[j].w); }
        s = wave_sum(s);
        const float rr = 1.0f / sqrtf(s * (1.0f / D) + NORM_EPS);
        if (last) { f32x4* orow = (f32x4*)(out + (size_t)row * D) + lane;
#pragma unroll
            for (int j = 0; j < 4; ++j) { const f32x4 g = ((const f32x4*)gf)[lane + 64 * j]; orow[64 * j] = v[j] * rr * g; }
        } else {
            if (lane == 0) rs[row] = rr;
#pragma unroll
            for (int j = 0; j < 4; ++j) xr[64 * j] = (u32x2){pk2(v[j].x, v[j].y), pk2(v[j].z, v[j].w)};
        }
    }
}

#ifndef PH_MASK
#define PH_MASK 0xFFFFF
#endif
#define PH(k) if (PH_MASK & (1 << (k)))

#define XB_TMO      128
#define XB_XCNT(j)  (256  + 64 * (j))
#define XB_XSUB(j)  (1280 + 64 * (j))
#define XB_XGEN(j)  (2304 + 64 * (j))
#define XB_TOP      3328
#define XB_TOPGEN   3392
#define XCD_BAR_WORDS 3456
#define XB_SPIN_CAP (1u << 22)
__device__ __forceinline__ unsigned xb_ld(unsigned* p)              { return __hip_atomic_load(p, __ATOMIC_RELAXED, __HIP_MEMORY_SCOPE_AGENT); }
__device__ __forceinline__ unsigned xb_add(unsigned* p, unsigned v) { return __hip_atomic_fetch_add(p, v, __ATOMIC_RELAXED, __HIP_MEMORY_SCOPE_AGENT); }
__device__ __forceinline__ unsigned xb_xcc_id() { return (unsigned)__builtin_amdgcn_s_getreg((3 << 11) | 20) & 0xFu; }
#define XB_SPIN(cond, bar) do { unsigned _sp = 0; while (cond) { __builtin_amdgcn_s_sleep(1); \
    if ((++_sp & 255u) == 0u) { if (xb_ld(&(bar)[XB_TMO])) break; if (_sp > XB_SPIN_CAP) { atomicAdd(&(bar)[XB_TMO], 1u); break; } } } } while (0)
struct XcdBarrier { unsigned* bar; unsigned x; volatile LAS unsigned* st; };
__device__ __forceinline__ void xcd_barrier_complete(unsigned* bar, unsigned x, unsigned& nloc, unsigned& nx) {
    const unsigned G = gridDim.x * gridDim.y * gridDim.z;
    unsigned sum, cnt, mine, sp = 0u;
    for (;;) {
        sum = 0u; cnt = 0u; mine = 0u;
#pragma unroll
        for (unsigned j = 0; j < 16; ++j) { const unsigned c = xb_ld(&bar[XB_XCNT(j)]); sum += c; cnt += (c > 0u) ? 1u : 0u; mine = (j == x) ? c : mine; }
        if (sum == G) break;
        __builtin_amdgcn_s_sleep(1);
        if ((++sp & 255u) == 0u) { if (xb_ld(&bar[XB_TMO])) break; if (sp > XB_SPIN_CAP) { atomicAdd(&bar[XB_TMO], 1u); break; } }
    }
    nloc = mine > 0u ? mine : 1u; nx = cnt > 0u ? cnt : 1u;
}
__device__ __forceinline__ void xcd_barrier(const XcdBarrier& b, const bool leader) {
    asm volatile("s_waitcnt vmcnt(0)" ::: "memory");
    __syncthreads();
    if (leader) {
        unsigned* bar = b.bar;
        __builtin_amdgcn_s_waitcnt(0);
        unsigned nloc = b.st[0], nx = b.st[1];
        if (nloc == 0u) { xcd_barrier_complete(bar, b.x, nloc, nx); b.st[0] = nloc; b.st[1] = nx; }
        const unsigned old = xb_add(&bar[XB_XSUB(b.x)], 1u);
        const unsigned gen = old / nloc;
        if (old + 1u == (gen + 1u) * nloc) {
            __builtin_amdgcn_fence(__ATOMIC_RELEASE, "agent");
            asm volatile("s_waitcnt vmcnt(0)" ::: "memory");
            const unsigned og = xb_add(&bar[XB_TOP], 1u);
            const unsigned tg = og / nx;
            if (og + 1u == (tg + 1u) * nx) xb_add(&bar[XB_TOPGEN], 1u);
            else XB_SPIN(xb_ld(&bar[XB_TOPGEN]) == tg, bar);
            __builtin_amdgcn_fence(__ATOMIC_ACQUIRE, "agent");
            xb_add(&bar[XB_XGEN(b.x)], 1u);
            asm volatile("s_waitcnt vmcnt(0)" ::: "memory");
        } else {
            XB_SPIN(xb_ld(&bar[XB_XGEN(b.x)]) == gen, bar);
            __builtin_amdgcn_fence(__ATOMIC_ACQUIRE, "agent");
            asm volatile("s_waitcnt vmcnt(0)" ::: "memory");
        }
    }
    __syncthreads();
}

__device__ __forceinline__ Params load_params() {
#if defined(__HIP_DEVICE_COMPILE__)
    auto k = __builtin_amdgcn_kernarg_segment_ptr();
    asm volatile("" : "+s"(k));
    return *(const __attribute__((address_space(4))) Params*)k;
#else
    return Params{};
#endif
}
__global__ void __launch_bounds__(NTHREADS, 2) fwd_megakernel(Params p_unused) {
    extern __shared__ __attribute__((aligned(16))) unsigned char lds_raw[];
    LAS unsigned char* lds = (LAS unsigned char*)lds_raw;
    cg::grid_group grid = cg::this_grid();
    const int G_ = gridDim.x, bid = blockIdx.x;
    const int wvx = __builtin_amdgcn_readfirstlane((int)threadIdx.x >> 6);
    const bool leader = (threadIdx.x == 0);
    volatile LAS unsigned* bst = (volatile LAS unsigned*)(lds + LDS_BYTES - 16);
    if (leader) { bst[0] = 0u; bst[1] = 0u; }
    XcdBarrier xbar;
    { const Params p = load_params(); xbar.bar = (unsigned*)(p.ws + OFF_CTL) + 4096; xbar.x = xb_xcc_id(); xbar.st = bst;
      if (leader) (void)xb_add(&xbar.bar[XB_XCNT(xbar.x)], 1u); }
    __syncthreads();
#define GRID_BAR() do { const Params pb = load_params(); XcdBarrier xb2; xb2.bar = (unsigned*)(pb.ws + OFF_CTL) + 4096; xb2.x = xb_xcc_id(); xb2.st = bst; xcd_barrier(xb2, opaque_tid(wvx) == 0); } while (0)

    { const Params p = load_params(); PH(0) phase_prologue(p, lds, G_, bid, wvx); }
    { const Params p = load_params(); PH(0) filters_all(p, G_, bid, wvx); }
    { const Params p = load_params(); PH(1) phase_rownorm(p.in[0], (bf16_t*)(p.ws + OFF_XB), (float*)(p.ws + OFF_RS), G_, bid, wvx); }
    grid.sync();

#pragma unroll 1
    for (int l = 0; l < DEPTH; ++l) {
        PH(2) { const Params p = load_params(); unsigned char* ws = p.ws;
            DenseSched S; S.init((const bf16_t*)(ws + OFF_XB), (const bf16_t*)(ws + OFF_WTIN) + (size_t)l * IN_DP * D, NT, IN_DP, D, G_, bid);
            EpiProj E{(bf16_t*)(ws + OFF_PROJ), (const float*)(ws + OFF_RS)};
            pg8::gemm_phase<EpiProj, DenseSched, false>(lds, D, S, E, wvx);
        }
        GRID_BAR();
        {
            const bool lead = (opaque_tid(wvx) == 0);
            LAS int* qw = (LAS int*)(lds + na::O_QW);
#define CTR(k) ((int*)(load_params().ws + OFF_CTL) + 32 + l * 16 + (k))
            if (bid < 128) { PH(5) { const Params p = load_params(); rw_chain_unit(p, lds, l, bid, wvx); } }
            else {
                PH(3) for (;;) { const int u = wg_pop(CTR(0), qw, lead); if (u >= 4096) break; { const Params p = load_params(); hy_pre_unit(p, lds, l, u, wvx); } wg_signal(CTR(1), lead); }
                wg_wait(CTR(1), 4096, lead);
                PH(4) for (int c = bid - 128; c < 256; c += 128) { { const Params p = load_params(); hy_conv_unit(p, lds, l, c, wvx); } wg_signal(CTR(2), lead); }
            }
            PH(6) { const Params p = load_params(); na_queue(p, lds, l, wvx); }
            wg_wait(CTR(2), 256, lead);
            PH(7) for (;;) { const int u = wg_pop(CTR(3), qw, lead); if (u >= 4096) break; { const Params p = load_params(); hy_post_unit(p, lds, l, u, wvx); } wg_signal(CTR(4), lead); }
            wg_wait(CTR(4), 4096, lead);
            PH(10) for (;;) { const int u = wg_pop(CTR(5), qw, lead); if (u >= NEXP * 768 / 64 + (l == 0 ? 43 : 0)) break; { const Params p = load_params(); moe_weights_chunk(p, lds, l, u, wvx); } }
#undef CTR
        }
        GRID_BAR();
        PH(8) { const Params p = load_params(); rw_post_wg(p, lds, l, G_, bid, wvx); }
        GRID_BAR();
        PH(9) { const Params p = load_params(); unsigned char* ws = p.ws;
            DenseSched S; S.init((const bf16_t*)(ws + OFF_MIX), (const bf16_t*)(ws + OFF_WTOUT) + (size_t)l * D * D, NT, D, D, G_, bid);
            EpiRes E{(bf16_t*)(ws + OFF_XB)};
            pg8::gemm_phase<EpiRes, DenseSched, false>(lds, D, S, E, wvx);
        }
        GRID_BAR();
        PH(11) { const Params p = load_params(); phase_router(p, lds, l, G_, bid, wvx); }
        GRID_BAR();
        PH(12) { const Params p = load_params(); unsigned char* ws = p.ws;
            const int* cnt = (const int*)(ws + OFF_CTL) + 64 + l * 64;
            MoeSched S; S.init(cnt, (const bf16_t*)(ws + OFF_XB), (const bf16_t*)(ws + OFF_W13T), (size_t)1024 * D, (const int*)(ws + OFF_LTOK), D, G_, bid, (LAS int*)(lds + 139264), opaque_tid(wvx));
            EpiMoe1 E{(bf16_t*)(ws + OFF_ACT), (const float*)(ws + OFF_LRS)};
            pg8::gemm_phase<EpiMoe1, MoeSched, true>(lds, D, S, E, wvx);
        }
        GRID_BAR();
        PH(13) { const Params p = load_params(); unsigned char* ws = p.ws;
            const int* cnt = (const int*)(ws + OFF_CTL) + 64 + l * 64;
            MoeSched S; S.init(cnt, (const bf16_t*)(ws + OFF_ACT), (const bf16_t*)(ws + OFF_W2T), (size_t)D * FF, nullptr, FF, G_, bid, (LAS int*)(lds + 139264), opaque_tid(wvx));
            EpiMoe2 E{(bf16_t*)(ws + OFF_YBUF), (const int*)(ws + OFF_LTOK), (const float*)(ws + OFF_LGATE)};
            pg8::gemm_phase<EpiMoe2, MoeSched, false>(lds, FF, S, E, wvx);
        }
        GRID_BAR();
        PH(14) { const Params p = load_params(); phase_combine(p, l == DEPTH - 1, G_, bid, wvx); }
        if (l < DEPTH - 1) GRID_BAR();
    }
}

extern "C" void kernel_launch(void* const* d_in, const int* in_sizes, int n_in, void* d_out, int out_size, void* d_ws, size_t ws_size, hipStream_t stream) {
    static int grid = 0;
    if (grid == 0) {
        if (n_in != 36 || ws_size < WS_END) { fprintf(stderr, "kernel_launch: unexpected n_in %d / ws_size %zu (need %zu)\n", n_in, ws_size, (size_t)WS_END); grid = -1; return; }
        int dev = 0, cus = 0, per_cu = 0;
        hipGetDevice(&dev);
        hipDeviceGetAttribute(&cus, hipDeviceAttributeMultiprocessorCount, dev);
        hipFuncSetAttribute((const void*)fwd_megakernel, hipFuncAttributeMaxDynamicSharedMemorySize, LDS_BYTES);
        hipOccupancyMaxActiveBlocksPerMultiprocessor(&per_cu, (const void*)fwd_megakernel, NTHREADS, LDS_BYTES);
        if (per_cu < 1) { fprintf(stderr, "kernel_launch: occupancy query says %d blocks per CU\n", per_cu); per_cu = 1; }
        if (per_cu > 1) per_cu = 1;
        grid = cus * per_cu;
        if (grid != 256) { fprintf(stderr, "kernel_launch: this kernel needs exactly 256 co-resident workgroups (got %d)\n", grid); if (grid > 256) grid = 256; }
        fprintf(stderr, "kernel_launch: grid %d (cus %d), ws %zu\n", grid, cus, ws_size);
    }
    if (grid < 0) return;
    hipMemsetAsync((char*)d_ws + OFF_CTL, 0, 65536, stream);
    Params p{};
    for (int i = 0; i < 36; ++i) p.in[i] = (const float*)d_in[i];
    p.out = (float*)d_out; p.ws = (unsigned char*)d_ws;
    void* args[] = {&p};
    hipError_t e = hipLaunchCooperativeKernel((const void*)fwd_megakernel, dim3(grid), dim3(NTHREADS), args, LDS_BYTES, stream);
    if (e != hipSuccess) fprintf(stderr, "cooperative launch failed: %s (grid %d)\n", hipGetErrorString(e), grid);
}
```

```cpp
#include <hip/hip_runtime.h>
#include <hip/hip_cooperative_groups.h>
#include <cstdio>
#include <cstdint>
namespace cg = cooperative_groups;

#define LAS __attribute__((address_space(3)))
typedef unsigned short bf16_t;
typedef short bf16x8 __attribute__((ext_vector_type(8)));
typedef float f32x4 __attribute__((ext_vector_type(4)));
typedef float f32x2 __attribute__((ext_vector_type(2)));
typedef unsigned u32x4 __attribute__((ext_vector_type(4)));
typedef unsigned u32x2 __attribute__((ext_vector_type(2)));

constexpr int D = 1024, NB = 8, L = 8192, NT = NB * L, DEPTH = 2;
constexpr int IN_D = 3456, IN_DP = 3584;
constexpr int C_HX0 = 0, C_HX1 = 256, C_HV = 512, C_RR = 768, C_RK = 1280, C_RV = 1792, C_RG = 2304, C_RW = 2432, C_RA = 2560, C_NQ = 2688, C_NK = 2944, C_NV = 3200;
constexpr int NEXP = 32, FF = 512;
constexpr float NORM_EPS = 1e-6f;

constexpr size_t MiB = 1u << 20;
constexpr size_t OFF_CTL = 0;
constexpr size_t OFF_WTIN = 1 * MiB;
constexpr size_t OFF_WTOUT = 15 * MiB;
constexpr size_t OFF_RS = 19 * MiB;
constexpr size_t OFF_RGW = 20 * MiB;
constexpr size_t OFF_LTOK = 21 * MiB;
constexpr size_t OFF_LGATE = 29 * MiB;
constexpr size_t OFF_FILT = 37 * MiB;
constexpr size_t OFF_MOEW = 69 * MiB;
constexpr size_t OFF_W13T = OFF_MOEW, OFF_W2T = OFF_MOEW + 64 * MiB;
constexpr size_t OFF_ZT = OFF_MOEW;
constexpr size_t OFF_YT = OFF_MOEW + 32 * MiB;
constexpr size_t OFF_XB = 165 * MiB;
constexpr size_t OFF_MIX = 869 * MiB;
constexpr size_t OFF_PROJ = 293 * MiB;
constexpr size_t OFF_ACT = OFF_PROJ;
constexpr size_t OFF_YBUF = OFF_PROJ + 136 * MiB;
constexpr size_t OFF_YF = 741 * MiB;
constexpr size_t OFF_YB = 805 * MiB;
constexpr size_t OFF_BON = 997 * MiB;
constexpr size_t OFF_LRS = 1001 * MiB;
constexpr size_t WS_END = 1009 * MiB;
constexpr int LCAP = 65536;

constexpr int LDS_BYTES = 147456;
constexpr int NTHREADS = 512;

struct Params { const float* in[36]; float* out; unsigned char* ws; };

__device__ __forceinline__ float bf2f(unsigned b) { return __uint_as_float(b << 16); }
typedef __bf16 bf16x2_t __attribute__((ext_vector_type(2)));
__device__ __forceinline__ unsigned f2bf(float f) { return (unsigned)__builtin_bit_cast(unsigned short, (__bf16)f); }
__device__ __forceinline__ unsigned pk2(float lo, float hi) { const f32x2 v = {lo, hi}; return __builtin_bit_cast(unsigned, __builtin_convertvector(v, bf16x2_t)); }
#define DPPF(v, ctrl) __int_as_float(__builtin_amdgcn_update_dpp(0, __float_as_int(v), (ctrl), 0xF, 0xF, true))
__device__ __forceinline__ float rdlane(float v, int l) { return __int_as_float(__builtin_amdgcn_readlane(__float_as_int(v), l)); }
__device__ __forceinline__ float wave_sum(float v) {
    v += DPPF(v, 0xB1); v += DPPF(v, 0x4E); v += DPPF(v, 0x141); v += DPPF(v, 0x140);
    return (rdlane(v, 0) + rdlane(v, 16)) + (rdlane(v, 32) + rdlane(v, 48));
}
__device__ __forceinline__ float sum8(float v) { v += DPPF(v, 0xB1); v += DPPF(v, 0x4E); v += DPPF(v, 0x141); return v; }
__device__ __forceinline__ void unpack8(const u32x4 w, float* f) {
    f[0] = bf2f(w.x & 0xffffu); f[1] = __uint_as_float(w.x & 0xffff0000u);
    f[2] = bf2f(w.y & 0xffffu); f[3] = __uint_as_float(w.y & 0xffff0000u);
    f[4] = bf2f(w.z & 0xffffu); f[5] = __uint_as_float(w.z & 0xffff0000u);
    f[6] = bf2f(w.w & 0xffffu); f[7] = __uint_as_float(w.w & 0xffff0000u);
}
__device__ __forceinline__ float frcp(float x) { return __builtin_amdgcn_rcpf(x); }
__device__ __forceinline__ float ftanh(float x) { const float e = __expf(2.0f * x); return 1.0f - 2.0f * frcp(e + 1.0f); }
#define LDS_WAIT() asm volatile("s_waitcnt lgkmcnt(0)" ::: "memory")
__device__ __forceinline__ int opaque_tid(int wvx) { int ln; asm volatile("v_mbcnt_lo_u32_b32 %0, -1, 0\n\tv_mbcnt_hi_u32_b32 %0, -1, %0" : "=v"(ln)); return wvx * 64 + ln; }

namespace pg8 {
constexpr int BM = 256, BK = 64, HALF = 128, HTB = HALF * BK * 2, STAGE_BYTES = 8 * HTB;
__device__ __forceinline__ int lds_byte(int r, int c) { const int st = (r >> 4) * 2 + (c >> 5), rr = r & 15, cc = c & 31, ob = rr * 64 + cc * 2; return st * 1024 + (ob ^ (((ob >> 9) & 1) << 5)); }
__device__ __forceinline__ void stage_rc(int b, int& R, int& C) { const int st = b / 1024, sb = b % 1024, swz = sb ^ (((sb >> 9) & 1) << 5); R = (st >> 1) * 16 + swz / 64; C = (st & 1) * 32 + (swz % 64) / 2; }
__device__ __forceinline__ int perm32(int rho) { const int n = rho >> 4, i = rho & 15; return 8 * (i >> 2) + 4 * n + (i & 3); }
__device__ __forceinline__ unsigned cvt_pk_bf16(float lo, float hi) { return pk2(lo, hi); }

struct Unit { const char* A; const char* B; int pm, pn, e, cnt; };

template <class Epi, class Sched, bool GATHER>
__device__ __forceinline__ void gemm_phase(LAS unsigned char* lds, const int K, const Sched& S, const Epi& E, const int wvx) {
    const int tid = opaque_tid(wvx), wid = __builtin_amdgcn_readfirstlane(tid >> 6), lane = tid & 63, wr = wid >> 2, wc = wid & 3, fr = lane & 15, fq = lane >> 4;
    const int nt = K / BK;
    int Rr[2], Cc[2];
    unsigned voffB[2];
#pragma unroll
    for (int i = 0; i < 2; ++i) { stage_rc(tid * 16 + i * 8192, Rr[i], Cc[i]); const int Rb = Epi::PERM ? ((Rr[i] & ~31) + perm32(Rr[i] & 31)) : Rr[i];
        voffB[i] = (unsigned)(Rb * K + Cc[i]) * 2u; }
    const size_t kstep = (size_t)(BK * 2);
    const size_t hstep = (size_t)HALF * K * 2;
    const unsigned ldsw = (unsigned)wid * 1024u;
    const int aoff = lds_byte(wr * 64 + fr, fq * 8), boff = lds_byte(wc * 32 + fr, fq * 8);
#define PG8_SA(b, h) (((b) * 2 + (h)) * HTB)
#define PG8_SB(b, h) ((4 + (b) * 2 + (h)) * HTB)
#define PG8_STAGE(bufoff, gbase, voff) do { _Pragma("unroll") for (int _i = 0; _i < 2; ++_i) \
        __builtin_amdgcn_global_load_lds((const unsigned*)((const char*)(gbase) + (voff)[_i]), (LAS unsigned*)(lds + (bufoff) + ldsw + _i * 8192), 16, 0, 0); } while (0)
#define PG8_LDA(dst, b, h) do { _Pragma("unroll") for (int m = 0; m < 4; ++m) _Pragma("unroll") for (int k = 0; k < 2; ++k) dst[m][k] = *(const LAS bf16x8*)(lds + PG8_SA(b, h) + aoff + m * 2048 + k * 1024); } while (0)
#define PG8_LDB(dst, b, h) do { _Pragma("unroll") for (int n = 0; n < 2; ++n) _Pragma("unroll") for (int k = 0; k < 2; ++k) dst[n][k] = *(const LAS bf16x8*)(lds + PG8_SB(b, h) + boff + n * 2048 + k * 1024); } while (0)
#define PG8_MMA(ai, bj, At, Bt) do { __builtin_amdgcn_s_setprio(1); _Pragma("unroll") for (int m = 0; m < 4; ++m) _Pragma("unroll") for (int n = 0; n < 2; ++n) _Pragma("unroll") for (int k = 0; k < 2; ++k) \
        acc[ai][bj][m][n] = __builtin_amdgcn_mfma_f32_16x16x32_bf16(Bt[n][k], At[m][k], acc[ai][bj][m][n], 0, 0, 0); __builtin_amdgcn_s_setprio(0); } while (0)
#define PG8_WAIT_V(n) asm volatile("s_waitcnt vmcnt(" #n ")" ::: "memory")
#define PG8_WAIT_L(n) asm volatile("s_waitcnt lgkmcnt(" #n ")" ::: "memory")
#define PG8_BAR __builtin_amdgcn_s_barrier()
#define PG8_SCHED __builtin_amdgcn_sched_barrier(0)
    Unit cur, nxt; int ui = 0;
    if (!S.next(0, cur)) return;
    f32x4 acc[2][2][4][2];
#pragma unroll
    for (int a = 0; a < 2; ++a)
#pragma unroll
        for (int b = 0; b < 2; ++b)
#pragma unroll
            for (int m = 0; m < 4; ++m)
#pragma unroll
                for (int n = 0; n < 2; ++n) acc[a][b][m][n] = (f32x4){0.f, 0.f, 0.f, 0.f};
    bf16x8 At[4][2], B0[2][2], B1[2][2];
    typename Epi::Pre epre;
    unsigned vA[2][2];
    LAS u32x4* stash = (LAS u32x4*)(lds + STAGE_BYTES) + tid;
    if (GATHER) S.aoff(cur, tid, vA);
    else {
#pragma unroll
        for (int h = 0; h < 2; ++h)
#pragma unroll
            for (int i = 0; i < 2; ++i) vA[h][i] = (unsigned)((h * HALF + Rr[i]) * K + Cc[i]) * 2u;
    }
    const char* cA = cur.A; const char* cB = cur.B;
    PG8_STAGE(PG8_SB(0, 0), cB, voffB); PG8_STAGE(PG8_SB(0, 1), cB + hstep, voffB); PG8_STAGE(PG8_SA(0, 0), cA, vA[0]); PG8_STAGE(PG8_SA(0, 1), cA, vA[1]);
    if (wr == 1) PG8_BAR;
    PG8_WAIT_V(2); PG8_BAR;
    PG8_STAGE(PG8_SB(1, 0), cB + kstep, voffB); PG8_STAGE(PG8_SA(1, 0), cA + kstep, vA[0]); PG8_STAGE(PG8_SB(1, 1), cB + hstep + kstep, voffB);
    PG8_WAIT_V(6); PG8_BAR;
    for (;;) {
        const bool has_next = S.next(ui + 1, nxt);
        const char* nA = has_next ? nxt.A : cA; const char* nB = has_next ? nxt.B : cB;
        if (GATHER) { unsigned vn[2][2];
            if (has_next) { S.aoff(nxt, tid, vn); *stash = (u32x4){vn[0][0], vn[0][1], vn[1][0], vn[1][1]}; }
            else *stash = (u32x4){vA[0][0], vA[0][1], vA[1][0], vA[1][1]}; }
        for (int t = 0; t < nt; t += 2) {
            const bool last = (t == nt - 2);
            const char* a1 = cA + (size_t)(t + 1) * kstep;
            const char* a2 = last ? nA : cA + (size_t)(t + 2) * kstep; const char* b2 = last ? nB : cB + (size_t)(t + 2) * kstep;
            const char* a3 = a2 + kstep; const char* b3 = b2 + kstep;
            if (last) E.prefetch(epre, cur, wr, wc, fr, fq);
            PG8_LDB(B0, 0, 0); PG8_LDB(B1, 0, 1); PG8_SCHED; PG8_LDA(At, 0, 0); PG8_STAGE(PG8_SA(1, 1), a1, vA[1]);
            if (GATHER && last) { const u32x4 sv = *stash; vA[0][0] = sv.x; vA[0][1] = sv.y; vA[1][0] = sv.z; vA[1][1] = sv.w; }
            PG8_WAIT_V(8); PG8_WAIT_L(0); PG8_BAR; PG8_MMA(0, 0, At, B0); PG8_MMA(0, 1, At, B1); PG8_BAR; PG8_SCHED;
            PG8_LDA(At, 0, 1); PG8_STAGE(PG8_SB(0, 0), b2, voffB); PG8_STAGE(PG8_SB(0, 1), b2 + hstep, voffB); PG8_STAGE(PG8_SA(0, 0), a2, vA[0]);
            PG8_WAIT_V(8); PG8_WAIT_L(0); PG8_BAR; PG8_MMA(1, 0, At, B0); PG8_MMA(1, 1, At, B1); PG8_BAR; PG8_SCHED;
            PG8_LDB(B0, 1, 0); PG8_LDB(B1, 1, 1); PG8_SCHED; PG8_LDA(At, 1, 0); PG8_STAGE(PG8_SA(0, 1), a2, vA[1]);
            PG8_WAIT_V(8); PG8_WAIT_L(0); PG8_BAR; PG8_MMA(0, 0, At, B0); PG8_MMA(0, 1, At, B1); PG8_BAR; PG8_SCHED;
            PG8_LDA(At, 1, 1); PG8_STAGE(PG8_SB(1, 0), b3, voffB); PG8_STAGE(PG8_SB(1, 1), b3 + hstep, voffB); PG8_STAGE(PG8_SA(1, 0), a3, vA[0]);
            PG8_WAIT_V(8); PG8_WAIT_L(0); PG8_BAR; PG8_MMA(1, 0, At, B0); PG8_MMA(1, 1, At, B1); PG8_BAR; PG8_SCHED;
        }
        if (wr == 0) PG8_BAR;
        {
            Unit eu = cur; int efr = fr, efq = fq;
            eu.pm = __builtin_amdgcn_readfirstlane(eu.pm); eu.pn = __builtin_amdgcn_readfirstlane(eu.pn); eu.e = __builtin_amdgcn_readfirstlane(eu.e); eu.cnt = __builtin_amdgcn_readfirstlane(eu.cnt);
            asm volatile("" : "+s"(eu.pm), "+s"(eu.pn), "+s"(eu.e), "+s"(eu.cnt), "+v"(efr), "+v"(efq));
            E(acc, eu, wr, wc, efr, efq, epre);
        }
        if (!has_next) break;
#pragma unroll
        for (int a = 0; a < 2; ++a)
#pragma unroll
            for (int b = 0; b < 2; ++b)
#pragma unroll
                for (int m = 0; m < 4; ++m)
#pragma unroll
                    for (int n = 0; n < 2; ++n) acc[a][b][m][n] = (f32x4){0.f, 0.f, 0.f, 0.f};
        cur = nxt; cA = nA; cB = nB; ++ui;
        if (wr == 1) PG8_BAR;
    }
    PG8_WAIT_V(0);
    PG8_BAR;
#undef PG8_SA
#undef PG8_SB
#undef PG8_STAGE
#undef PG8_LDA
#undef PG8_LDB
#undef PG8_MMA
#undef PG8_WAIT_V
#undef PG8_WAIT_L
#undef PG8_BAR
#undef PG8_SCHED
}
}

struct DenseSched {
    const bf16_t* A; const bf16_t* Bt; int K, nM, nN, nwg, G, c;
    __device__ void init(const bf16_t* A_, const bf16_t* Bt_, int M, int N, int K_, int G_, int c_) { A = A_; Bt = Bt_; K = K_; nM = M / 256; nN = N / 256; nwg = nM * nN; G = G_; c = c_; }
    __device__ __forceinline__ bool next(int i, pg8::Unit& u) const {
        const long Lx = (long)i * G + c; if (Lx >= nwg) return false;
        int wgid = (int)Lx; { const int q = nwg / 8, r = nwg % 8, xcd = wgid % 8, off = wgid / 8; wgid = (xcd < r ? xcd * (q + 1) : r * (q + 1) + (xcd - r) * q) + off; }
        const int nig = 8 * nN, gid = wgid / nig, fm = gid * 8, gsz = (nM - fm) < 8 ? (nM - fm) : 8;
        u.pm = fm + ((wgid % nig) % gsz); u.pn = (wgid % nig) / gsz; u.e = 0; u.cnt = 0;
        u.A = (const char*)A + (size_t)u.pm * 256 * K * 2; u.B = (const char*)Bt + (size_t)u.pn * 256 * K * 2; return true;
    }
    __device__ __forceinline__ void aoff(const pg8::Unit&, int, unsigned (&)[2][2]) const {}
};
struct MoeSched {
    const bf16_t* A; const bf16_t* Bt; size_t bstride;
    const int* ltok;
    LAS int* tp;
    int K, G, c, total;
    __device__ void init(const int* cnt_, const bf16_t* A_, const bf16_t* Bt_, size_t bstride_, const int* ltok_, int K_, int G_, int c_, LAS int* lds_tab, int tid) {
        A = A_; Bt = Bt_; bstride = bstride_; ltok = ltok_; K = K_; G = G_; c = (G_ % 8 == 0) ? (c_ & 7) * (G_ >> 3) + (c_ >> 3) : c_;
        tp = lds_tab;
        __syncthreads();
        if (tid < 32) tp[64 + tid] = cnt_[tid];
        __syncthreads();
        if (tid == 0) { int t = 0; for (int e = 0; e < NEXP; ++e) { tp[e] = t; t += (tp[64 + e] + 255) >> 8; } tp[32] = t; }
        __syncthreads();
        total = __builtin_amdgcn_readfirstlane(tp[32]);
    }
    __device__ __forceinline__ bool next(int i, pg8::Unit& u) const {
        const long Lx = (long)i * G + c; if (Lx >= (long)total * 4) return false;
        const int ti = (int)(Lx >> 2); u.pn = (int)(Lx & 3);
        int ln; asm volatile("v_mbcnt_lo_u32_b32 %0, -1, 0\n\tv_mbcnt_hi_u32_b32 %0, -1, %0" : "=v"(ln));
        const int l5 = ln & 31; const int lo = tp[l5], hi = tp[l5 + 1];
        const unsigned long long mask = __builtin_amdgcn_ballot_w64(lo <= ti && ti < hi);
        const int e = __builtin_amdgcn_readfirstlane((int)__builtin_ctzll(mask) & 31);
        const int base = __builtin_amdgcn_readfirstlane(tp[e]), ce = __builtin_amdgcn_readfirstlane(tp[64 + e]);
        u.e = e; u.pm = ti; u.cnt = ce - (ti - base) * 256;
        u.A = ltok ? (const char*)A : (const char*)A + (size_t)ti * 256 * K * 2;
        u.B = (const char*)(Bt + (size_t)e * bstride) + (size_t)u.pn * 256 * K * 2;
        u.pm = ti | ((ti - base) << 16);
        return true;
    }
    __device__ __forceinline__ void aoff(const pg8::Unit& u, int tid, unsigned (&v)[2][2]) const {
        const int lt = u.pm >> 16; int Rr[2], Cc[2]; pg8::stage_rc(tid * 16, Rr[0], Cc[0]); pg8::stage_rc(tid * 16 + 8192, Rr[1], Cc[1]);
        int tk[2][2];
#pragma unroll
        for (int h = 0; h < 2; ++h)
#pragma unroll
            for (int i = 0; i < 2; ++i) { const int r = h * 128 + Rr[i]; tk[h][i] = ltok[(size_t)u.e * LCAP + lt * 256 + (r < u.cnt ? r : 0)]; }
#pragma unroll
        for (int h = 0; h < 2; ++h)
#pragma unroll
            for (int i = 0; i < 2; ++i) { const int r = h * 128 + Rr[i]; const int tok = (r < u.cnt) ? (tk[h][i] >> 1) : 0; v[h][i] = (unsigned)(tok * K + Cc[i]) * 2u; }
    }
};

struct EpiProj {
    static constexpr bool PERM = true;
    struct Pre { float rs[8]; };
    bf16_t* O; const float* rs;
    __device__ __forceinline__ void prefetch(Pre& pr, const pg8::Unit& u, int wr, int wc, int fr, int fq) const {
        const int row0 = (u.pm & 0xffff) * 256 + wr * 64 + fr;
#pragma unroll
        for (int ai = 0; ai < 2; ++ai)
#pragma unroll
            for (int m = 0; m < 4; ++m) pr.rs[ai * 4 + m] = rs[row0 + ai * 128 + m * 16];
    }
    __device__ __forceinline__ void operator()(const f32x4 (&acc)[2][2][4][2], const pg8::Unit& u, int wr, int wc, int fr, int fq, const Pre& pr) const {
        const int row0 = u.pm * 256 + wr * 64 + fr, col0 = u.pn * 256 + wc * 32 + 8 * fq;
#pragma unroll
        for (int ai = 0; ai < 2; ++ai)
#pragma unroll
            for (int m = 0; m < 4; ++m) { const int row = row0 + ai * 128 + m * 16; const float s = pr.rs[ai * 4 + m]; bf16_t* rowp = O + (size_t)row * IN_DP + col0;
#pragma unroll
                for (int bj = 0; bj < 2; ++bj) { const f32x4 v0 = acc[ai][bj][m][0] * s, v1 = acc[ai][bj][m][1] * s;
                    u32x4 w; w.x = pg8::cvt_pk_bf16(v0[0], v0[1]); w.y = pg8::cvt_pk_bf16(v0[2], v0[3]); w.z = pg8::cvt_pk_bf16(v1[0], v1[1]); w.w = pg8::cvt_pk_bf16(v1[2], v1[3]);
                    *(u32x4*)(rowp + bj * 128) = w; } }
    }
};
struct EpiRes {
    static constexpr bool PERM = true;
    struct Pre { int dummy; };
    bf16_t* x16;
    __device__ __forceinline__ void prefetch(Pre&, const pg8::Unit&, int, int, int, int) const {}
    __device__ __forceinline__ void operator()(const f32x4 (&acc)[2][2][4][2], const pg8::Unit& u, int wr, int wc, int fr, int fq, const Pre&) const {
        const int row0 = u.pm * 256 + wr * 64 + fr, col0 = u.pn * 256 + wc * 32 + 8 * fq;
#pragma unroll
        for (int ai = 0; ai < 2; ++ai) {
            u32x4 braw[4][2];
#pragma unroll
            for (int m = 0; m < 4; ++m)
#pragma unroll
                for (int bj = 0; bj < 2; ++bj) braw[m][bj] = *(const u32x4*)(x16 + (size_t)(row0 + ai * 128 + m * 16) * D + col0 + bj * 128);
            asm volatile("" ::: "memory");
#pragma unroll
            for (int m = 0; m < 4; ++m) { const size_t off = (size_t)(row0 + ai * 128 + m * 16) * D + col0;
#pragma unroll
                for (int bj = 0; bj < 2; ++bj) { const f32x4 v0 = acc[ai][bj][m][0], v1 = acc[ai][bj][m][1]; float bb[8]; unpack8(braw[m][bj], bb);
                    u32x4 w; w.x = pk2(bb[0] + v0[0], bb[1] + v0[1]); w.y = pk2(bb[2] + v0[2], bb[3] + v0[3]); w.z = pk2(bb[4] + v1[0], bb[5] + v1[1]); w.w = pk2(bb[6] + v1[2], bb[7] + v1[3]);
                    *(u32x4*)(x16 + off + bj * 128) = w; } }
            asm volatile("" ::: "memory");
        }
    }
};
struct EpiMoe1 {
    static constexpr bool PERM = true;
    struct Pre { int dummy; };
    bf16_t* act; const float* lrs;
    __device__ __forceinline__ void prefetch(Pre&, const pg8::Unit&, int, int, int, int) const {}
    __device__ __forceinline__ void operator()(const f32x4 (&acc)[2][2][4][2], const pg8::Unit& u, int wr, int wc, int fr, int fq, const Pre&) const {
        const int ti = u.pm & 0xffff, lt = u.pm >> 16;
        const int r0 = wr * 64 + fr, col0 = u.pn * 256 + wc * 32 + 8 * fq;
        float sv[8];
#pragma unroll
        for (int q = 0; q < 8; ++q) { const int r = r0 + (q >> 2) * 128 + (q & 3) * 16; sv[q] = (r < u.cnt) ? lrs[(size_t)u.e * LCAP + lt * 256 + r] : 0.f; }
        asm volatile("" ::: "memory");
#pragma unroll
        for (int ai = 0; ai < 2; ++ai)
#pragma unroll
            for (int m = 0; m < 4; ++m) { const int r = r0 + ai * 128 + m * 16;
                const float s = sv[ai * 4 + m];
                bf16_t* rowp = act + ((size_t)ti * 256 + r) * FF + (col0 >> 1);
#pragma unroll
                for (int bj = 0; bj < 2; ++bj) { const f32x4 v0 = acc[ai][bj][m][0] * s, v1 = acc[ai][bj][m][1] * s;
                    const float o0 = v0[0] * frcp(1.f + __expf(-v0[0])) * v0[1], o1 = v0[2] * frcp(1.f + __expf(-v0[2])) * v0[3];
                    const float o2 = v1[0] * frcp(1.f + __expf(-v1[0])) * v1[1], o3 = v1[2] * frcp(1.f + __expf(-v1[2])) * v1[3];
                    u32x2 w; w.x = pg8::cvt_pk_bf16(o0, o1); w.y = pg8::cvt_pk_bf16(o2, o3);
                    *(u32x2*)(rowp + bj * 64) = w; } }
    }
};
struct EpiMoe2 {
    static constexpr bool PERM = true;
    struct Pre { int dummy; };
    bf16_t* ybuf; const int* ltok; const float* lgate;
    __device__ __forceinline__ void prefetch(Pre&, const pg8::Unit&, int, int, int, int) const {}
    __device__ __forceinline__ void operator()(const f32x4 (&acc)[2][2][4][2], const pg8::Unit& u, int wr, int wc, int fr, int fq, const Pre&) const {
        const int lt = u.pm >> 16, r0 = wr * 64 + fr, col0 = u.pn * 256 + wc * 32 + 8 * fq;
        int dv[8]; float gv[8];
#pragma unroll
        for (int q = 0; q < 8; ++q) { const int r = r0 + (q >> 2) * 128 + (q & 3) * 16; const bool ok = r < u.cnt;
            const size_t li = (size_t)u.e * LCAP + lt * 256 + (ok ? r : 0); const int d = ltok[li]; const float g = lgate[li];
            dv[q] = ok ? d : -1; gv[q] = g; }
        asm volatile("" ::: "memory");
#pragma unroll
        for (int ai = 0; ai < 2; ++ai)
#pragma unroll
            for (int m = 0; m < 4; ++m) { const int dest = dv[ai * 4 + m];
                if (dest >= 0) { const float g = gv[ai * 4 + m];
                    bf16_t* rowp = ybuf + (size_t)dest * D + col0;
#pragma unroll
                    for (int bj = 0; bj < 2; ++bj) { const f32x4 v0 = acc[ai][bj][m][0] * g, v1 = acc[ai][bj][m][1] * g;
                        u32x4 w; w.x = pg8::cvt_pk_bf16(v0[0], v0[1]); w.y = pg8::cvt_pk_bf16(v0[2], v0[3]); w.z = pg8::cvt_pk_bf16(v1[0], v1[1]); w.w = pg8::cvt_pk_bf16(v1[2], v1[3]);
                        *(u32x4*)(rowp + bj * 128) = w; } } }
    }
};

__device__ __forceinline__ void transpose_item(const float* __restrict__ W, int K, int N, bf16_t* WT, int rmul, int radd, const float* __restrict__ g, LAS float* scr, int item, int lane) {
    const int nblk = N / 32, kb = item / nblk, nb = item % nblk, k0 = 64 * kb, n0 = 32 * nb;
    f32x4 v[8]; float gv[8];
#pragma unroll
    for (int i = 0; i < 8; ++i) { v[i] = *(const f32x4*)(W + (size_t)(k0 + 8 * i + (lane >> 3)) * N + n0 + 4 * (lane & 7)); gv[i] = g ? g[k0 + 8 * i + (lane >> 3)] : 1.0f; }
#pragma unroll
    for (int i = 0; i < 8; ++i) { const int kk = 8 * i + (lane >> 3); *(LAS f32x4*)(scr + kk * 36 + 4 * (lane & 7)) = v[i] * gv[i]; }
    LDS_WAIT(); asm volatile("" ::: "memory");
    const int c = lane & 7;
#pragma unroll
    for (int j = 0; j < 4; ++j) { const int n = (lane >> 3) + 8 * j; const LAS float* s = scr + (8 * c) * 36 + n;
        u32x4 o; o.x = pk2(s[0 * 36], s[1 * 36]); o.y = pk2(s[2 * 36], s[3 * 36]); o.z = pk2(s[4 * 36], s[5 * 36]); o.w = pk2(s[6 * 36], s[7 * 36]);
        *(u32x4*)(WT + (size_t)(rmul * (n0 + n) + radd) * K + k0 + 8 * c) = o; }
    LDS_WAIT(); asm volatile("" ::: "memory");
}

__device__ __forceinline__ void filt_item8(const Params& p, int l, int m0, int lane, float* G) {
    const float* w1 = p.in[5] + l * 33 * 64; const float* w2 = p.in[7] + l * 4096; const float* w3 = p.in[9] + l * 4096; const float* wout = p.in[11] + l * 64 * 512;
    const float b1v = p.in[6][l * 64 + lane], b2v = p.in[8][l * 64 + lane], b3v = p.in[10][l * 64 + lane], fr = p.in[12][l * 64 + lane];
    float hcur[8], acc[8];
    {
#pragma unroll
        for (int j = 0; j < 8; ++j) { const int m = m0 + j; float zl = 0.f;
            const float wv = (6.283185307179586f / 8192.0f) * (float)m; const float fstep = (15.0f - 1e-4f) / 15.0f;
            if (lane == 0) zl = (float)m / 8191.0f; else if (lane <= 16) zl = cosf((1e-4f + (float)(lane - 1) * fstep) * wv); else if (lane <= 32) zl = -sinf((1e-4f + (float)(lane - 17) * fstep) * wv);
            hcur[j] = zl; acc[j] = b1v; }
        float wc[33];
#pragma unroll
        for (int i = 0; i < 33; ++i) wc[i] = w1[i * 64 + lane];
#pragma unroll
        for (int i = 0; i < 33; ++i)
#pragma unroll
            for (int j = 0; j < 8; ++j) acc[j] += rdlane(hcur[j], i) * wc[i];
#pragma unroll
        for (int j = 0; j < 8; ++j) { hcur[j] = sinf(fr * acc[j]); acc[j] = b2v; }
    }
    asm volatile("" ::: "memory");
    {   float wc[64];
#pragma unroll
        for (int i = 0; i < 64; ++i) wc[i] = w2[i * 64 + lane];
#pragma unroll
        for (int i = 0; i < 64; ++i)
#pragma unroll
            for (int j = 0; j < 8; ++j) acc[j] += rdlane(hcur[j], i) * wc[i];
#pragma unroll
        for (int j = 0; j < 8; ++j) { hcur[j] = sinf(fr * acc[j]); acc[j] = b3v; }
    }
    asm volatile("" ::: "memory");
    {   float wc[64];
#pragma unroll
        for (int i = 0; i < 64; ++i) wc[i] = w3[i * 64 + lane];
#pragma unroll
        for (int i = 0; i < 64; ++i)
#pragma unroll
            for (int j = 0; j < 8; ++j) acc[j] += rdlane(hcur[j], i) * wc[i];
#pragma unroll
        for (int j = 0; j < 8; ++j) hcur[j] = sinf(fr * acc[j]);
    }
    asm volatile("" ::: "memory");
    float (&h3)[8] = hcur;
    float o[8][8];
#pragma unroll
    for (int j = 0; j < 8; ++j)
#pragma unroll
        for (int q = 0; q < 8; ++q) o[j][q] = 0.f;
#pragma unroll 2
    for (int i = 0; i < 64; ++i) { float wo[8];
#pragma unroll
        for (int q = 0; q < 8; ++q) wo[q] = wout[i * 512 + q * 64 + lane];
#pragma unroll
        for (int j = 0; j < 8; ++j) { const float hv = rdlane(h3[j], i);
#pragma unroll
            for (int q = 0; q < 8; ++q) o[j][q] += hv * wo[q]; } }
    const float dmin = -3.0701134573253944f, dmax = -15.350567286626972f;
#pragma unroll
    for (int q = 0; q < 8; ++q) { const int n = q * 64 + lane, d = n >> 8, c = n & 255;
        const float delta = fabsf(dmin + (float)c * ((dmax - dmin) / 255.0f));
        float v[8];
#pragma unroll
        for (int j = 0; j < 8; ++j) v[j] = o[j][q] * expf(-((float)(m0 + j) / 8191.0f) * delta);
        float* dst = G + (size_t)c * 16384 + d * 8192 + m0;
        *(f32x4*)dst = (f32x4){v[0], v[1], v[2], v[3]}; *(f32x4*)(dst + 4) = (f32x4){v[4], v[5], v[6], v[7]}; }
}

__device__ __forceinline__ void phase_prologue(const Params& p, LAS unsigned char* lds, int G_, int bid, const int wvx) {
    const int tid = opaque_tid(wvx), lane = tid & 63, wave = tid >> 6;
    const int gw = bid * 8 + wave, NGW = G_ * 8;
    LAS float* scr = (LAS float*)(lds + wave * 16384);
    unsigned char* ws = p.ws;
    for (int it = gw; it < 16 * 108; it += NGW) transpose_item(p.in[2], D, IN_D, (bf16_t*)(ws + OFF_WTIN), 1, 0, p.in[1], scr, it, lane);
    for (int i = bid * NTHREADS + tid; i < 2 * 128 * D / 8; i += G_ * NTHREADS) { const int l = i / (128 * D / 8), r = i % (128 * D / 8);
        *(u32x4*)((bf16_t*)(ws + OFF_WTIN) + (size_t)l * IN_DP * D + (size_t)IN_D * D + (size_t)r * 8) = (u32x4){0u, 0u, 0u, 0u}; }
    for (int i = bid * NTHREADS + tid; i < 2 * 48 * D; i += G_ * NTHREADS) { const int l = i / (48 * D), r = i % (48 * D), o = r / D, k = r % D;
        const float g = p.in[27][l * D + k]; const float w = g * ((o < 4) ? p.in[28][((size_t)l * D + k) * 4 + o] : (o < 36 ? p.in[30][((size_t)l * D + k) * 32 + (o - 4)] : 0.f));
        const unsigned hi = f2bf(w); const float lo = w - bf2f(hi);
        bf16_t* rg = (bf16_t*)(ws + OFF_RGW) + (size_t)l * 2 * 48 * D; rg[o * D + k] = (bf16_t)hi; rg[48 * D + o * D + k] = (bf16_t)f2bf(lo); }
}
__device__ __forceinline__ void filters_all(const Params& p, int nwg, int rank, const int wvx) {
    const int tid = opaque_tid(wvx), lane = tid & 63, wave = tid >> 6;
    for (int it = rank * 8 + wave; it < 2 * (L / 8); it += nwg * 8) { const int l = it / (L / 8), m0 = (it % (L / 8)) * 8; filt_item8(p, l, m0, lane, (float*)(p.ws + OFF_FILT) + (size_t)l * 256 * 16384); }
}

__device__ __forceinline__ void moe_weights_chunk(const Params& p, LAS unsigned char* lds, int l, int chunk, const int wvx) {
    const int tid = opaque_tid(wvx), lane = tid & 63, wave = tid >> 6;
    LAS float* scr = (LAS float*)(lds + wave * 16384);
    bf16_t* W13 = (bf16_t*)(p.ws + OFF_W13T); bf16_t* W2 = (bf16_t*)(p.ws + OFF_W2T);
    const float* g = p.in[27] + l * D;
#pragma unroll 1
    for (int k = 0; k < 8; ++k) { const int it = chunk * 64 + wave * 8 + k;
        if (it >= NEXP * 768) { const int x = it - NEXP * 768;
            if (x < 16 * 108) transpose_item(p.in[2] + (size_t)D * IN_D, D, IN_D, (bf16_t*)(p.ws + OFF_WTIN) + (size_t)IN_DP * D, 1, 0, p.in[1] + D, scr, x, lane);
            else if (x < 16 * 108 + 1024) { const int y = x - 16 * 108, lo = y >> 9; transpose_item(p.in[26] + (size_t)lo * D * D, D, D, (bf16_t*)(p.ws + OFF_WTOUT) + (size_t)lo * D * D, 1, 0, nullptr, scr, y & 511, lane); }
            continue; }
        const int e = it / 768, r = it % 768;
        if (r < 256) transpose_item(p.in[32] + ((size_t)l * NEXP + e) * D * FF, D, FF, W13 + (size_t)e * 1024 * D, 2, 0, g, scr, r, lane);
        else if (r < 512) transpose_item(p.in[33] + ((size_t)l * NEXP + e) * D * FF, D, FF, W13 + (size_t)e * 1024 * D, 2, 1, g, scr, r - 256, lane);
        else transpose_item(p.in[34] + ((size_t)l * NEXP + e) * FF * D, FF, D, W2 + (size_t)e * D * FF, 1, 0, nullptr, scr, r - 512, lane); }
}
__device__ __forceinline__ void phase_rownorm(const float* x, bf16_t* xb, float* rs, int G_, int bid, const int wvx) {
    const int tid = opaque_tid(wvx), lane = tid & 63, wave = tid >> 6;
    for (int row = bid * 8 + wave; row < NT; row += G_ * 8) {
        const f32x4* xr = (const f32x4*)(x + (size_t)row * D) + lane; f32x4 v[4]; float s = 0.f;
#pragma unroll
        for (int j = 0; j < 4; ++j) { v[j] = xr[64 * j]; s += (v[j].x * v[j].x + v[j].y * v[j].y) + (v[j].z * v[j].z + v[j].w * v[j].w); }
        s = wave_sum(s);
        if (lane == 0) rs[row] = 1.0f / sqrtf(s * (1.0f / D) + NORM_EPS);
        u32x2* o = (u32x2*)(xb + (size_t)row * D) + lane;
#pragma unroll
        for (int j = 0; j < 4; ++j) o[64 * j] = (u32x2){pk2(v[j].x, v[j].y), pk2(v[j].z, v[j].w)};
    }
}

__device__ __forceinline__ void load8(const bf16_t* p, bool ok, float* f) { if (ok) { unpack8(*(const u32x4*)p, f); } else {
#pragma unroll
    for (int j = 0; j < 8; ++j) f[j] = 0.f; } }

__device__ __forceinline__ void hy_pre_unit(const Params& p, LAS unsigned char* lds, int l, int unit, const int wvx) {
    const int tid = opaque_tid(wvx);
    const int ct = unit & 3, tt = (unit >> 2) & 127, b = unit >> 9;
    const bf16_t* proj = (const bf16_t*)(p.ws + OFF_PROJ);
    bf16_t* zT = (bf16_t*)(p.ws + OFF_ZT);
    const float* cw = p.in[3] + l * 3 * 768; const float* cb = p.in[4] + l * 768;
    LAS bf16_t* tile = (LAS bf16_t*)lds;
    {
        const int tl = tid >> 3, c8 = (tid & 7) * 8, t = tt * 64 + tl, c = ct * 64 + c8;
        const bf16_t* row = proj + ((size_t)b * L + t) * IN_DP;
        float x1[3][8], vv[3][8];
        load8(row - IN_DP + C_HX1 + c, t > 0, x1[0]); load8(row + C_HX1 + c, true, x1[1]); load8(row + IN_DP + C_HX1 + c, t < L - 1, x1[2]);
        load8(row - IN_DP + C_HV + c, t > 0, vv[0]); load8(row + C_HV + c, true, vv[1]); load8(row + IN_DP + C_HV + c, t < L - 1, vv[2]);
#pragma unroll
        for (int j = 0; j < 8; ++j) { const int c1 = C_HX1 + c + j, c2 = C_HV + c + j;
            const float a = x1[0][j] * cw[c1] + x1[1][j] * cw[768 + c1] + x1[2][j] * cw[1536 + c1] + cb[c1];
            const float v = vv[0][j] * cw[c2] + vv[1][j] * cw[768 + c2] + vv[2][j] * cw[1536 + c2] + cb[c2];
            tile[(c8 + j) * 72 + tl] = (bf16_t)f2bf(a * v); }
    }
    __syncthreads();
    {
        const int cl = tid >> 3, seg = tid & 7;
        const u32x4 w = *(const LAS u32x4*)(tile + cl * 72 + seg * 8);
        *(u32x4*)(zT + ((size_t)(ct * 64 + cl) * NB + b) * L + tt * 64 + seg * 8) = w;
    }
    __syncthreads();
}

typedef float f32x16 __attribute__((ext_vector_type(16)));
__device__ __forceinline__ void hy_conv_unit(const Params& p, LAS unsigned char* lds, int l, int c, const int wvx) {
    const int tid = opaque_tid(wvx), lane = tid & 63, wave = __builtin_amdgcn_readfirstlane(tid >> 6);
    const float* G = (const float*)(p.ws + OFF_FILT) + ((size_t)l * 256 + c) * 16384;
    const bf16_t* zT = (const bf16_t*)(p.ws + OFF_ZT) + (size_t)c * NB * L;
    float* yT = (float*)(p.ws + OFF_YT) + (size_t)c * NB * L;
    LAS bf16_t* Re = (LAS bf16_t*)lds; LAS bf16_t* Ro = Re + 16384;
    LAS unsigned char* Zs = lds + 65536;
    constexpr int ZB = 8976;
    LAS float* red = (LAS float*)(lds + 65536 + 8 * ZB);
    __syncthreads();
    float ss = 0.f; const float GF0 = G[8192];
#pragma unroll 1
    for (int i0 = 0; i0 < 16384; i0 += 8 * NTHREADS) { float gq[8];
#pragma unroll
        for (int k = 0; k < 8; ++k) gq[k] = G[i0 + k * NTHREADS + tid];
#pragma unroll
        for (int k = 0; k < 8; ++k) { const int i = i0 + k * NTHREADS + tid; const float g = gq[k]; ss += g * g;
            if (i == 8192) { Ro[16383] = 0; Re[0] = 0; }
            else { const int dl = (i < 8192) ? i : (8192 - i); const bf16_t bv = (bf16_t)f2bf(i == 0 ? g + GF0 : g); Re[8192 - dl] = bv; Ro[8191 - dl] = bv; } } }
    ss = wave_sum(ss); if (lane == 0) red[wave] = ss;
    f32x16 acc[2][4];
#pragma unroll
    for (int mt = 0; mt < 2; ++mt)
#pragma unroll
        for (int i = 0; i < 4; ++i)
#pragma unroll
            for (int e = 0; e < 16; ++e) acc[mt][i][e] = 0.f;
    const int r = lane & 31, hh = lane >> 5;
#pragma unroll 1
    for (int h = 0; h < 2; ++h) {
        __syncthreads();
        { u32x4 zq[9];
#pragma unroll
          for (int k = 0; k < 9; ++k) { const int q = tid + k * NTHREADS; const int ch = q & 7, Jp = (q >> 3) % 70, b = (q >> 3) / 70; const int J = 64 * h + Jp - 3;
            zq[k] = (u32x4){0u, 0u, 0u, 0u}; if (q < 4480 && Jp >= 3 && Jp < 67) zq[k] = *(const u32x4*)(zT + (size_t)b * L + J * 64 + ch * 8); }
#pragma unroll
          for (int k = 0; k < 9; ++k) { const int q = tid + k * NTHREADS; const int ch = q & 7, Jp = (q >> 3) % 70, b = (q >> 3) / 70;
            if (q < 4480) *(LAS u32x4*)(Zs + b * ZB + Jp * 128 + ch * 16) = zq[k]; } }
        __syncthreads();
        int d_hi = 16 * wave + 15 - 64 * h, d_lo = 16 * wave - 64 * h - 63; d_hi = d_hi > 127 ? 127 : d_hi; d_lo = d_lo < -127 ? -127 : d_lo;
#pragma unroll 1
        for (int d = d_lo; d <= d_hi; ++d) {
            const int J0b = 16 * wave - d;
            const int aelem = 8192 + 8 * hh - r - (r & 1) - 64 * d - 32;
            const LAS unsigned* ap = (const LAS unsigned*)(lds + (r & 1) * 32768 + aelem * 2);
            bf16x8 Af[2][4];
#pragma unroll
            for (int mt = 0; mt < 2; ++mt)
#pragma unroll
                for (int ks = 0; ks < 4; ++ks) { const LAS unsigned* q = ap + (16 * ks + 32 * (1 - mt)) / 2; const u32x4 t = (u32x4){q[0], q[1], q[2], q[3]}; Af[mt][ks] = __builtin_bit_cast(bf16x8, t); }
            const LAS unsigned char* bp = Zs + (r & 7) * ZB + ((r >> 3) + J0b - 64 * h + 3) * 128 + hh * 16;
#pragma unroll
            for (int i = 0; i < 4; ++i) { const int J0 = J0b + 4 * i;
                if (J0 + 3 >= 64 * h && J0 <= 64 * h + 63) {
                    bf16x8 Bf[4];
#pragma unroll
                    for (int ks = 0; ks < 4; ++ks) Bf[ks] = *(const LAS bf16x8*)(bp + i * 512 + ks * 32);
#pragma unroll
                    for (int ks = 0; ks < 4; ++ks)
#pragma unroll
                        for (int mt = 0; mt < 2; ++mt) acc[mt][i] = __builtin_amdgcn_mfma_f32_32x32x16_bf16(Af[mt][ks], Bf[ks], acc[mt][i], 0, 0, 0);
                } }
        }
    }
    float tot = 0.f;
#pragma unroll
    for (int w = 0; w < 8; ++w) tot += red[w];
    const float scale = 1.0f / sqrtf(tot + 1e-6f);
#pragma unroll
    for (int mt = 0; mt < 2; ++mt)
#pragma unroll
        for (int i = 0; i < 4; ++i)
#pragma unroll
            for (int g = 0; g < 4; ++g) { const int t = 64 * (16 * wave + 4 * i + (r >> 3)) + 32 * mt + 8 * g + 4 * hh;
                const f32x4 v = (f32x4){acc[mt][i][4 * g] * scale, acc[mt][i][4 * g + 1] * scale, acc[mt][i][4 * g + 2] * scale, acc[mt][i][4 * g + 3] * scale};
                *(f32x4*)(yT + (size_t)(r & 7) * L + t) = v; }
    __syncthreads();
}

__device__ __forceinline__ void hy_post_unit(const Params& p, LAS unsigned char* lds, int l, int unit, const int wvx) {
    const int tid = opaque_tid(wvx);
    const int ct = unit & 3, tt = (unit >> 2) & 127, b = unit >> 9;
    const bf16_t* proj = (const bf16_t*)(p.ws + OFF_PROJ);
    const bf16_t* zT = (const bf16_t*)(p.ws + OFF_ZT);
    const float* yT = (const float*)(p.ws + OFF_YT);
    bf16_t* mix = (bf16_t*)(p.ws + OFF_MIX);
    const float* cw = p.in[3] + l * 3 * 768; const float* cb = p.in[4] + l * 768; const float* skip = p.in[13] + l * 256;
    LAS float* tile = (LAS float*)lds;
    {
        const int cl = tid >> 3, seg = tid & 7, c = ct * 64 + cl;
        const size_t off = ((size_t)c * NB + b) * L + tt * 64 + seg * 8;
        float z[8]; unpack8(*(const u32x4*)(zT + off), z);
        const f32x4 y0 = *(const f32x4*)(yT + off), y1 = *(const f32x4*)(yT + off + 4);
        const float sk = skip[c];
        tile[cl * 65 + seg * 8 + 0] = y0.x + z[0] * sk; tile[cl * 65 + seg * 8 + 1] = y0.y + z[1] * sk; tile[cl * 65 + seg * 8 + 2] = y0.z + z[2] * sk; tile[cl * 65 + seg * 8 + 3] = y0.w + z[3] * sk;
        tile[cl * 65 + seg * 8 + 4] = y1.x + z[4] * sk; tile[cl * 65 + seg * 8 + 5] = y1.y + z[5] * sk; tile[cl * 65 + seg * 8 + 6] = y1.z + z[6] * sk; tile[cl * 65 + seg * 8 + 7] = y1.w + z[7] * sk;
    }
    __syncthreads();
    {
        const int tl = tid >> 3, c8 = (tid & 7) * 8, t = tt * 64 + tl, c = ct * 64 + c8;
        const bf16_t* row = proj + ((size_t)b * L + t) * IN_DP;
        float x0[3][8];
        load8(row - IN_DP + C_HX0 + c, t > 0, x0[0]); load8(row + C_HX0 + c, true, x0[1]); load8(row + IN_DP + C_HX0 + c, t < L - 1, x0[2]);
        float o[8];
#pragma unroll
        for (int j = 0; j < 8; ++j) { const int c0 = c + j; const float a = x0[0][j] * cw[c0] + x0[1][j] * cw[768 + c0] + x0[2][j] * cw[1536 + c0] + cb[c0];
            o[j] = a * tile[(c8 + j) * 65 + tl]; }
        u32x4 w; w.x = pk2(o[0], o[1]); w.y = pk2(o[2], o[3]); w.z = pk2(o[4], o[5]); w.w = pk2(o[6], o[7]);
        *(u32x4*)(mix + ((size_t)b * L + t) * D + c) = w;
    }
    __syncthreads();
}


namespace rw {
constexpr int MATB = 9216, PITCH = 144;
constexpr int O_W2T = 0, O_A2T = MATB, O_SB = 2 * MATB, O_GBUF = 3 * MATB, O_SLOT = O_GBUF + 16384;
constexpr int O_GC = O_SLOT + 10 * MATB, O_APP = O_GC + 256, O_TPP = O_APP + 5120, O_CT = O_TPP + 2560;
__device__ __forceinline__ constexpr int slot(int k) { return O_SLOT + k * MATB; }
#define MFMA16(a, b, c) __builtin_amdgcn_mfma_f32_16x16x32_bf16((a), (b), (c), 0, 0, 0)
__device__ __forceinline__ f32x4 tile64(const LAS unsigned char* A, const LAS unsigned char* Bt, int rt, int ct, int fr, int fq, f32x4 acc) {
#pragma unroll
    for (int ks = 0; ks < 2; ++ks) { const bf16x8 a = *(const LAS bf16x8*)(A + (16 * rt + fr) * PITCH + ks * 64 + fq * 16); const bf16x8 b = *(const LAS bf16x8*)(Bt + (16 * ct + fr) * PITCH + ks * 64 + fq * 16);
        acc = MFMA16(a, b, acc); }
    return acc;
}
__device__ __forceinline__ unsigned pkbf(float lo, float hi) { return pg8::cvt_pk_bf16(lo, hi); }
}

namespace rw {
typedef short s16x4 __attribute__((ext_vector_type(4)));
__device__ __forceinline__ bf16x8 fragN(const LAS unsigned char* img, int row, int ks, int fq) { return *(const LAS bf16x8*)(img + row * PITCH + ks * 64 + fq * 16); }
__device__ __forceinline__ bf16x8 fragP(const LAS unsigned char* img, int row, int ks, int fq) {
    const u32x2 a = *(const LAS u32x2*)(img + row * PITCH + (32 * ks + 4 * fq) * 2), b = *(const LAS u32x2*)(img + row * PITCH + (32 * ks + 16 + 4 * fq) * 2);
    const u32x4 v = (u32x4){a.x, a.y, b.x, b.y}; return __builtin_bit_cast(bf16x8, v); }
__device__ __forceinline__ bf16x8 fragT(const LAS unsigned char* img, int c0, int ks, int fr, int fq) {
    const LAS unsigned char* q = img + (32 * ks + 4 * fq + (fr >> 2)) * PITCH + (c0 + 4 * (fr & 3)) * 2;
    const s16x4 a = __builtin_amdgcn_ds_read_tr16_b64_v4i16((LAS s16x4*)q), b = __builtin_amdgcn_ds_read_tr16_b64_v4i16((LAS s16x4*)(q + 16 * PITCH));
    return (bf16x8){a[0], a[1], a[2], a[3], b[0], b[1], b[2], b[3]}; }
}

__device__ __forceinline__ void rw_chain_unit(const Params& p, LAS unsigned char* lds, int l, int unit, const int wvx) {
    using namespace rw;
    const int tid = opaque_tid(wvx), wave = __builtin_amdgcn_readfirstlane(tid >> 6);
    const int dir = unit & 1, h = (unit >> 1) & 7, b = unit >> 4;
    const bf16_t* proj = (const bf16_t*)(p.ws + OFF_PROJ);
    bf16_t* Y = (bf16_t*)(p.ws + (dir ? OFF_YB : OFF_YF));
    LAS float* gbuf = (LAS float*)(lds + O_GBUF);
    LAS float* GC = (LAS float*)(lds + O_GC);
    LAS bf16_t* TPP = (LAS bf16_t*)(lds + O_TPP);
    LAS float* CT = (LAS float*)(lds + O_CT);
    float* BON = (float*)(p.ws + OFF_BON) + (size_t)dir * NT * 8;
    __syncthreads();
    {
        const float* w2 = p.in[16] + ((size_t)l * 2 + dir) * 64 * 512 + h * 64; const float* a2 = p.in[18] + ((size_t)l * 2 + dir) * 64 * 512 + h * 64;
        for (int i = tid; i < 4096; i += NTHREADS) { const int r = i >> 6, n = i & 63;
            *(LAS bf16_t*)(lds + O_W2T + n * PITCH + r * 2) = (bf16_t)f2bf(w2[r * 512 + n]); *(LAS bf16_t*)(lds + O_A2T + n * PITCH + r * 2) = (bf16_t)f2bf(a2[r * 512 + n]); }
        for (int i = tid; i < MATB / 4; i += NTHREADS) ((LAS unsigned*)(lds + O_SB))[i] = 0u;
        const float* mu = p.in[14] + (size_t)l * 3 * 2 * 512;
        for (int i = tid; i < 704; i += NTHREADS) { const int row = i >> 6, n = i & 63, col = h * 64 + n; float v;
            if (row < 6) v = mu[(row >> 1) * 1024 + (row & 1) * 512 + col];
            else if (row == 6) v = p.in[15][((size_t)l * 2 + dir) * 512 + col];
            else if (row == 7) v = p.in[17][((size_t)l * 2 + dir) * 512 + col];
            else if (row == 8) v = p.in[19][l * 512 + col];
            else if (row == 9) v = p.in[20][l * 512 + col];
            else v = p.in[21][l * 512 + col];
            CT[i] = v; }
    }
    f32x4 Sreg[4];
#pragma unroll
    for (int it = 0; it < 4; ++it) Sreg[it] = (f32x4){0.f, 0.f, 0.f, 0.f};
    const int rt = wave >> 1, chh = wave & 1;
    u32x4 pre[12];
#define issue_loads(CC) do { const int t0n = (dir ? (L / 64 - 1 - (CC)) : (CC)) * 64; int tq_ = tid; asm volatile("" : "+v"(tq_));     \
        _Pragma("unroll") for (int k = 0; k < 4; ++k) { const int q = tq_ + k * NTHREADS; pre[k] = (u32x4){0u, 0u, 0u, 0u}; \
            if (q < 1584) { const int which = q / 528, rem = q - which * 528, rr = rem >> 3, ch = rem & 7; const int t = t0n - 1 + rr; \
                if (t >= 0 && t < L) pre[k] = *(const u32x4*)(proj + ((size_t)b * L + t) * IN_DP + C_RR + which * 512 + h * 64 + ch * 8); } } \
        { const int kq_ = ((tq_ >> 4) & 3) * 8, cbase = (wave < 4 ? C_RW : C_RA) + dir * 64; \
          _Pragma("unroll") for (int r4 = 0; r4 < 4; ++r4) { const int pq_ = 16 * r4 + (tq_ & 15); const int ttn = dir ? (t0n + 63 - pq_) : (t0n + pq_); const bf16_t* row = proj + ((size_t)b * L + ttn) * IN_DP; \
            pre[4 + 2 * r4] = *(const u32x4*)(row + cbase + kq_); pre[5 + 2 * r4] = *(const u32x4*)(row + cbase + 32 + kq_); } } } while (0)
    issue_loads(0);
#pragma unroll 1
    for (int cc = 0; cc < L / 64; ++cc) {
        const int t0 = (dir ? (L / 64 - 1 - cc) : cc) * 64;
        int tq = tid; asm volatile("" : "+v"(tq));
        const int fr = tq & 15, fq = (tq >> 4) & 3, pp = tq >> 3, ig = tq & 7, i0 = ig * 8;
        const int tt = dir ? (t0 + 63 - pp) : (t0 + pp);
        __syncthreads();
#pragma unroll
        for (int k = 0; k < 4; ++k) { const int q = tid + k * NTHREADS; if (q < 1584) { const int which = q / 528, rem = q - which * 528; *(LAS u32x4*)(lds + slot(which) + (rem >> 3) * 128 + (rem & 7) * 16) = pre[k]; } }
        asm volatile("" ::: "memory");
        if (cc > 0) { const int t0p = (dir ? (L / 64 - cc) : (cc - 1)) * 64; const int ttp = dir ? (t0p + 63 - pp) : (t0p + pp);
            *(u32x4*)(Y + ((size_t)b * L + ttp) * 512 + h * 64 + i0) = *(const LAS u32x4*)(lds + slot(9) + pp * PITCH + ig * 16); }
        if (wave < 4) {
            const float w0n = CT[6 * 64 + 16 * wave + fr];
            const bf16x8 wb0 = fragN(lds + O_W2T, 16 * wave + fr, 0, fq), wb1 = fragN(lds + O_W2T, 16 * wave + fr, 1, fq);
            u32x2 lwp[4];
#pragma unroll
            for (int r4 = 0; r4 < 4; ++r4) { bf16x8 t0_, t1_;
                { float f[8]; unpack8(pre[4 + 2 * r4], f); u32x4 w; w.x = pk2(ftanh(f[0]), ftanh(f[1])); w.y = pk2(ftanh(f[2]), ftanh(f[3])); w.z = pk2(ftanh(f[4]), ftanh(f[5])); w.w = pk2(ftanh(f[6]), ftanh(f[7])); t0_ = __builtin_bit_cast(bf16x8, w); }
                { float f[8]; unpack8(pre[5 + 2 * r4], f); u32x4 w; w.x = pk2(ftanh(f[0]), ftanh(f[1])); w.y = pk2(ftanh(f[2]), ftanh(f[3])); w.z = pk2(ftanh(f[4]), ftanh(f[5])); w.w = pk2(ftanh(f[6]), ftanh(f[7])); t1_ = __builtin_bit_cast(bf16x8, w); }
                f32x4 wv = (f32x4){0.f, 0.f, 0.f, 0.f}; wv = MFMA16(t0_, wb0, wv); wv = MFMA16(t1_, wb1, wv);
                float lwv[4];
#pragma unroll
                for (int e = 0; e < 4; ++e) lwv[e] = -0.60653066f * frcp(1.0f + __expf(-(wv[e] + w0n)));
                lwp[r4] = (u32x2){pk2(lwv[0], lwv[1]), pk2(lwv[2], lwv[3])}; }
#pragma unroll
            for (int r4 = 0; r4 < 4; ++r4) { f32x4 g = (f32x4){0.f, 0.f, 0.f, 0.f};
#pragma unroll
                for (int ks = 0; ks < 2; ++ks) if (32 * ks <= 16 * r4 + 15) {
                    const int pa = 16 * r4 + fr - 32 * ks - 4 * fq, pb2 = pa - 16;
                    u32x4 lt;
                    lt.x = (pa >= 1 ? 0x3F803F80u : (pa == 0 ? 0x00003F80u : 0u)); lt.y = (pa >= 3 ? 0x3F803F80u : (pa == 2 ? 0x00003F80u : 0u));
                    lt.z = (pb2 >= 1 ? 0x3F803F80u : (pb2 == 0 ? 0x00003F80u : 0u)); lt.w = (pb2 >= 3 ? 0x3F803F80u : (pb2 == 2 ? 0x00003F80u : 0u));
                    const u32x4 bv = (u32x4){lwp[2 * ks].x, lwp[2 * ks].y, lwp[2 * ks + 1].x, lwp[2 * ks + 1].y};
                    g = MFMA16(__builtin_bit_cast(bf16x8, lt), __builtin_bit_cast(bf16x8, bv), g); }
#pragma unroll
                for (int e = 0; e < 4; ++e) gbuf[(16 * r4 + 4 * fq + e) * 64 + 16 * wave + fr] = g[e]; }
        } else {
            const int wq = wave - 4;
            const bf16x8 ab0 = fragN(lds + O_A2T, 16 * wq + fr, 0, fq), ab1 = fragN(lds + O_A2T, 16 * wq + fr, 1, fq);
#pragma unroll
            for (int r4 = 0; r4 < 4; ++r4) { f32x4 av = (f32x4){0.f, 0.f, 0.f, 0.f};
                av = MFMA16(__builtin_bit_cast(bf16x8, pre[4 + 2 * r4]), ab0, av); av = MFMA16(__builtin_bit_cast(bf16x8, pre[5 + 2 * r4]), ab1, av);
#pragma unroll
                for (int e = 0; e < 4; ++e) *(LAS bf16_t*)(lds + slot(5) + (16 * r4 + 4 * fq + e) * PITCH + (16 * wq + fr) * 2) = (bf16_t)f2bf(av[e]); }
        }
        if (cc + 1 < L / 64) issue_loads(cc + 1);
        __syncthreads();
        {
            const int rr = tt - t0 + 1;
#define LD2(dst, ptr) do { const f32x4 _a = *(const LAS f32x4*)(ptr), _b = *(const LAS f32x4*)((ptr) + 4); dst[0] = (f32x2){_a.x, _a.y}; dst[1] = (f32x2){_a.z, _a.w}; dst[2] = (f32x2){_b.x, _b.y}; dst[3] = (f32x2){_b.z, _b.w}; } while (0)
#define UP2(dst, wsrc_) do { const u32x4 _w = (wsrc_); dst[0] = (f32x2){bf2f(_w.x & 0xffffu), __uint_as_float(_w.x & 0xffff0000u)}; dst[1] = (f32x2){bf2f(_w.y & 0xffffu), __uint_as_float(_w.y & 0xffff0000u)}; \
                         dst[2] = (f32x2){bf2f(_w.z & 0xffffu), __uint_as_float(_w.z & 0xffff0000u)}; dst[3] = (f32x2){bf2f(_w.w & 0xffffu), __uint_as_float(_w.w & 0xffff0000u)}; } while (0)
#define TSHIFT(dst, sl, c0row) do { f32x2 xp[4], xc[4], xn[4], m0[4], m1[4]; \
                UP2(xp, *(const LAS u32x4*)(lds + slot(sl) + (rr - 1) * 128 + ig * 16)); UP2(xc, *(const LAS u32x4*)(lds + slot(sl) + rr * 128 + ig * 16)); UP2(xn, *(const LAS u32x4*)(lds + slot(sl) + (rr + 1) * 128 + ig * 16)); \
                LD2(m0, CT + (c0row) * 64 + i0); LD2(m1, CT + ((c0row) + 1) * 64 + i0); \
                _Pragma("unroll") for (int j2 = 0; j2 < 4; ++j2) dst[j2] = xc[j2] + m0[j2] * (xp[j2] - xc[j2]) + m1[j2] * (xn[j2] - xc[j2]); } while (0)
#define PK4(v) ((u32x4){pk2(v[0].x, v[0].y), pk2(v[1].x, v[1].y), pk2(v[2].x, v[2].y), pk2(v[3].x, v[3].y)})
            f32x2 r2[4], v2[4], k2[4], a2v[4], kd2[4], kkr2[4], gi2[4], ge2[4];
            LD2(gi2, gbuf + pp * 64 + i0);
            LD2(ge2, gbuf + (pp > 0 ? pp - 1 : 0) * 64 + i0);
            if (pp == 0) { ge2[0] = (f32x2){0.f, 0.f}; ge2[1] = ge2[0]; ge2[2] = ge2[0]; ge2[3] = ge2[0]; }
            TSHIFT(r2, 0, 0);
            TSHIFT(v2, 2, 4);
            *(LAS u32x4*)(lds + slot(6) + pp * PITCH + ig * 16) = PK4(v2);
            {   f32x2 ap[4], c7[4];
                UP2(ap, *(const LAS u32x4*)(lds + slot(5) + pp * PITCH + ig * 16)); LD2(c7, CT + 7 * 64 + i0);
#pragma unroll
                for (int j2 = 0; j2 < 4; ++j2) { const f32x2 araw = ap[j2] + c7[j2]; a2v[j2] = (f32x2){frcp(1.0f + __expf(-araw.x)), frcp(1.0f + __expf(-araw.y))}; } }
            TSHIFT(k2, 1, 2);
            f32x2 ss2 = (f32x2){0.f, 0.f}, bs2 = ss2;
            {   f32x2 c8[4], c9[4], c10[4]; LD2(c8, CT + 8 * 64 + i0); LD2(c9, CT + 9 * 64 + i0); LD2(c10, CT + 10 * 64 + i0);
#pragma unroll
                for (int j2 = 0; j2 < 4; ++j2) { kkr2[j2] = k2[j2] * c8[j2]; ss2 += kkr2[j2] * kkr2[j2]; kd2[j2] = k2[j2] * (1.0f + (a2v[j2] - 1.0f) * c9[j2]); bs2 += r2[j2] * kd2[j2] * c10[j2]; } }
            const float ss = sum8(ss2.x + ss2.y);
            { const float bs = sum8(bs2.x + bs2.y); if (ig == 0) BON[((size_t)b * 8 + h) * L + tt] = bs; }
            const float rn_ = __builtin_amdgcn_rsqf(fmaxf(ss, 1e-24f));
            f32x2 At[4], Rt[4], Bb[4], Kb[4];
#pragma unroll
            for (int j2 = 0; j2 < 4; ++j2) { const f32x2 kk = kkr2[j2] * rn_;
                const f32x2 ei = (f32x2){__expf(gi2[j2].x), __expf(gi2[j2].y)}, ee = (f32x2){__expf(ge2[j2].x), __expf(ge2[j2].y)}, inv = (f32x2){frcp(ei.x), frcp(ei.y)};
                At[j2] = -kk * ee; Rt[j2] = r2[j2] * ei; Bb[j2] = kk * a2v[j2] * inv; Kb[j2] = kd2[j2] * inv;
                if (pp == 63) { GC[i0 + 2 * j2] = ei.x; GC[i0 + 2 * j2 + 1] = ei.y; } }
            *(LAS u32x4*)(lds + slot(3) + pp * PITCH + ig * 16) = PK4(At);
            *(LAS u32x4*)(lds + slot(4) + pp * PITCH + ig * 16) = PK4(Rt);
            *(LAS u32x4*)(lds + slot(7) + pp * PITCH + ig * 16) = PK4(Bb);
            *(LAS u32x4*)(lds + slot(8) + pp * PITCH + ig * 16) = PK4(Kb);
#undef TSHIFT
#undef PK4
#undef UP2
#undef LD2
        }
        __syncthreads();
        { const bf16x8 at0 = fragN(lds + slot(3), 16 * rt + fr, 0, fq), at1 = fragN(lds + slot(3), 16 * rt + fr, 1, fq), rt0 = fragN(lds + slot(4), 16 * rt + fr, 0, fq), rt1 = fragN(lds + slot(4), 16 * rt + fr, 1, fq);
#pragma unroll
          for (int ct = 0; ct < 2; ++ct) { const int ctt = 2 * chh + ct;
            f32x4 ab = (f32x4){0.f, 0.f, 0.f, 0.f}, ak = ab, rb = ab, rk = ab;
            if (ctt <= rt) {
                const bf16x8 b0 = fragN(lds + slot(7), 16 * ctt + fr, 0, fq), b1 = fragN(lds + slot(7), 16 * ctt + fr, 1, fq), k0 = fragN(lds + slot(8), 16 * ctt + fr, 0, fq), k1 = fragN(lds + slot(8), 16 * ctt + fr, 1, fq);
                ab = MFMA16(at0, b0, ab); ab = MFMA16(at1, b1, ab); ak = MFMA16(at0, k0, ak); ak = MFMA16(at1, k1, ak);
                rb = MFMA16(rt0, b0, rb); rb = MFMA16(rt1, b1, rb); rk = MFMA16(rt0, k0, rk); rk = MFMA16(rt1, k1, rk); }
            float vab[4], vak[4], vrb[4], vrk[4];
#pragma unroll
            for (int e = 0; e < 4; ++e) { const int prow = 16 * rt + 4 * fq + e, jcol = 16 * ctt + fr; const bool st = prow > jcol, inc = prow >= jcol;
                vab[e] = st ? ab[e] : 0.f; vak[e] = st ? ak[e] : 0.f; vrb[e] = inc ? rb[e] : 0.f; vrk[e] = inc ? rk[e] : 0.f; }
            const int off = (16 * ctt + fr) * PITCH + (16 * rt + 4 * fq) * 2;
            *(LAS u32x2*)(lds + O_GBUF + off) = (u32x2){pkbf(vab[0], vab[1]), pkbf(vab[2], vab[3])};
            *(LAS u32x2*)(lds + slot(0) + off) = (u32x2){pkbf(vak[0], vak[1]), pkbf(vak[2], vak[3])};
            *(LAS u32x2*)(lds + slot(1) + off) = (u32x2){pkbf(vrb[0], vrb[1]), pkbf(vrb[2], vrb[3])};
            *(LAS u32x2*)(lds + slot(2) + off) = (u32x2){pkbf(vrk[0], vrk[1]), pkbf(vrk[2], vrk[3])}; } }
        __syncthreads();
        f32x4 accA[4];
        f32x4 accK[4];
#pragma unroll
        for (int q = 0; q < 4; ++q) { accA[q] = (f32x4){0.f, 0.f, 0.f, 0.f}; accK[q] = accA[q]; }
        const int yg = (wave == 4) ? 3 : wave - 5;
        if (wave < 4) {
            const bf16x8 s0 = fragN(lds + O_SB, 16 * wave + fr, 0, fq), s1 = fragN(lds + O_SB, 16 * wave + fr, 1, fq), v0 = fragT(lds + slot(6), 16 * wave, 0, fr, fq), v1 = fragT(lds + slot(6), 16 * wave, 1, fr, fq);
#pragma unroll
            for (int q = 0; q < 4; ++q) { f32x4 a = accA[q];
                a = MFMA16(fragN(lds + slot(3), 16 * q + fr, 0, fq), s0, a); a = MFMA16(fragN(lds + slot(3), 16 * q + fr, 1, fq), s1, a);
                a = MFMA16(fragT(lds + slot(0), 16 * q, 0, fr, fq), v0, a); if (q >= 2) a = MFMA16(fragT(lds + slot(0), 16 * q, 1, fr, fq), v1, a);
                accA[q] = a;
                f32x4 kx = accK[q]; kx = MFMA16(fragT(lds + slot(8), 16 * q, 0, fr, fq), v0, kx); kx = MFMA16(fragT(lds + slot(8), 16 * q, 1, fr, fq), v1, kx); accK[q] = kx;
                asm volatile("" ::: "memory"); }
        } else if (wave == 4) {
            const int pb = fq, j = fr; float T[16];
#pragma unroll
            for (int q = 0; q < 16; ++q) T[q] = (q == j) ? 1.f : 0.f;
#pragma unroll
            for (int sg = 0; sg < 4; ++sg) {
                u32x4 ar[4][2];
#pragma unroll
                for (int r4 = 0; r4 < 4; ++r4) { ar[r4][0] = *(const LAS u32x4*)(lds + O_GBUF + (16 * pb + 4 * sg + r4) * PITCH + 32 * pb); ar[r4][1] = *(const LAS u32x4*)(lds + O_GBUF + (16 * pb + 4 * sg + r4) * PITCH + 32 * pb + 16); }
#pragma unroll
                for (int r4 = 0; r4 < 4; ++r4) { const int s2 = 4 * sg + r4; float av[16]; unpack8(ar[r4][0], av); unpack8(ar[r4][1], av + 8);
#pragma unroll
                    for (int q = s2 + 1; q < 16; ++q) T[q] += av[q] * T[s2]; }
                asm volatile("" ::: "memory");
            }
#pragma unroll
            for (int q = 0; q < 16; ++q) TPP[(pb * 16 + q) * 20 + j] = (bf16_t)f2bf(T[q]);
        }
#define Y_PART() do { const bf16x8 s0 = fragN(lds + O_SB, 16 * yg + fr, 0, fq), s1 = fragN(lds + O_SB, 16 * yg + fr, 1, fq), v0 = fragT(lds + slot(6), 16 * yg, 0, fr, fq), v1 = fragT(lds + slot(6), 16 * yg, 1, fr, fq); \
            _Pragma("unroll") for (int q = 0; q < 4; ++q) { f32x4 a = accA[q]; \
                a = MFMA16(fragN(lds + slot(4), 16 * q + fr, 0, fq), s0, a); a = MFMA16(fragN(lds + slot(4), 16 * q + fr, 1, fq), s1, a); \
                a = MFMA16(fragT(lds + slot(2), 16 * q, 0, fr, fq), v0, a); if (q >= 2) a = MFMA16(fragT(lds + slot(2), 16 * q, 1, fr, fq), v1, a); \
                accA[q] = a; asm volatile("" ::: "memory"); } } while (0)
        if (wave >= 5) Y_PART();
        __syncthreads();
        if (wave < 4) {
            u32x2 Ub[4];
            bf16x8 fa[4]; u32x2 ft[4];
#pragma unroll
            for (int z = 0; z < 4; ++z) { const int pb = (z == 3) ? 3 : z + 1, k2 = (z == 3) ? 1 : 0;
                fa[z] = fragT(lds + O_GBUF, 16 * pb, k2, fr, fq);
                ft[z] = *(const LAS u32x2*)(lds + O_TPP + ((z * 16 + fr) * 20 + 4 * fq) * 2); }
#pragma unroll
            for (int pb = 0; pb < 4; ++pb) {
                f32x4 tmp = accA[pb];
#pragma unroll
                for (int k2 = 0; k2 < 2; ++k2) if (2 * k2 < pb) { const int z = (pb == 3 && k2 == 1) ? 3 : pb - 1;
                    const u32x2 b0 = Ub[2 * k2]; const u32x2 b1 = (2 * k2 + 1 < pb) ? Ub[2 * k2 + 1] : (u32x2){0u, 0u};
                    const u32x4 bv = (u32x4){b0.x, b0.y, b1.x, b1.y};
                    tmp = MFMA16(fa[z], __builtin_bit_cast(bf16x8, bv), tmp); }
                const u32x4 av = (u32x4){ft[pb].x, ft[pb].y, 0u, 0u}, bv = (u32x4){pkbf(tmp[0], tmp[1]), pkbf(tmp[2], tmp[3]), 0u, 0u};
                const f32x4 U = MFMA16(__builtin_bit_cast(bf16x8, av), __builtin_bit_cast(bf16x8, bv), ((f32x4){0.f, 0.f, 0.f, 0.f}));
                Ub[pb] = (u32x2){pkbf(U[0], U[1]), pkbf(U[2], U[3])};
                *(LAS u32x2*)(lds + slot(5) + (16 * wave + fr) * PITCH + (16 * pb + 4 * fq) * 2) = Ub[pb];
            }
        } else if (wave == 4) Y_PART();
#undef Y_PART
        __syncthreads();
        if (wave >= 4) {
            const bf16x8 u0 = fragP(lds + slot(5), 16 * yg + fr, 0, fq), u1 = fragP(lds + slot(5), 16 * yg + fr, 1, fq);
#pragma unroll
            for (int q = 0; q < 4; ++q) { f32x4 a = accA[q];
                a = MFMA16(fragT(lds + slot(1), 16 * q, 0, fr, fq), u0, a); if (q >= 2) a = MFMA16(fragT(lds + slot(1), 16 * q, 1, fr, fq), u1, a);
#pragma unroll
                for (int e = 0; e < 4; ++e) *(LAS bf16_t*)(lds + slot(9) + (16 * q + 4 * fq + e) * PITCH + (16 * yg + fr) * 2) = (bf16_t)f2bf(a[e]); }
        } else {
            const bf16x8 u0 = fragP(lds + slot(5), 16 * wave + fr, 0, fq), u1 = fragP(lds + slot(5), 16 * wave + fr, 1, fq);
#pragma unroll
            for (int it = 0; it < 4; ++it) { f32x4 a = Sreg[it] + accK[it];
                a = MFMA16(fragT(lds + slot(7), 16 * it, 0, fr, fq), u0, a); a = MFMA16(fragT(lds + slot(7), 16 * it, 1, fr, fq), u1, a);
                const f32x4 gc = *(const LAS f32x4*)(GC + 16 * it + 4 * fq);
                a = a * gc; Sreg[it] = a;
                *(LAS u32x2*)(lds + O_SB + (16 * wave + fr) * PITCH + (16 * it + 4 * fq) * 2) = (u32x2){pkbf(a[0], a[1]), pkbf(a[2], a[3])};
                asm volatile("" ::: "memory"); }
        }
    }
    __syncthreads();
    { int tq = tid; asm volatile("" : "+v"(tq)); const int pp = tq >> 3, ig = tq & 7, i0 = ig * 8;
      const int t0p = (dir ? 0 : (L / 64 - 1)) * 64; const int ttp = dir ? (t0p + 63 - pp) : (t0p + pp);
      *(u32x4*)(Y + ((size_t)b * L + ttp) * 512 + h * 64 + i0) = *(const LAS u32x4*)(lds + slot(9) + pp * PITCH + ig * 16); }
    __syncthreads();
#undef issue_loads
}

constexpr int PT = 128;
__device__ __forceinline__ void rw_post_wg(const Params& p, LAS unsigned char* lds, int l, int G_, int bid, const int wvx) {
    const int tid = opaque_tid(wvx), lane = tid & 63, wave = __builtin_amdgcn_readfirstlane(tid >> 6), fr = lane & 15, fq = lane >> 4;
    const int h = bid & 7;
    const bf16_t* proj = (const bf16_t*)(p.ws + OFF_PROJ);
    const bf16_t* YF = (const bf16_t*)(p.ws + OFF_YF); const bf16_t* YB = (const bf16_t*)(p.ws + OFF_YB);
    const float* BONF = (const float*)(p.ws + OFF_BON); const float* BONB = BONF + (size_t)NT * 8;
    bf16_t* mix = (bf16_t*)(p.ws + OFF_MIX);
    constexpr int GP = 272;
    LAS unsigned char* G2T = lds;
    LAS unsigned char* SG = lds + 17408;
    LAS unsigned char* RAWV = lds + 52224;
    LAS unsigned char* GATE = lds + 68864;
    __syncthreads();
    { const float* g2 = p.in[22] + (size_t)l * 128 * 512 + h * 64;
        for (int i = tid; i < 8192; i += NTHREADS) { const int r = i >> 6, n = i & 63; *(LAS bf16_t*)(G2T + n * GP + r * 2) = (bf16_t)f2bf(g2[r * 512 + n]); } }
    const int ig = tid & 7, i0 = ig * 8, col = h * 64 + i0;
    float mv0[8], mv1[8], lnw[8], lnb[8];
#pragma unroll
    for (int j = 0; j < 8; ++j) { mv0[j] = p.in[14][(size_t)l * 3072 + 2 * 1024 + col + j]; mv1[j] = p.in[14][(size_t)l * 3072 + 2 * 1024 + 512 + col + j]; lnw[j] = p.in[23][l * 512 + col + j]; lnb[j] = p.in[24][l * 512 + col + j]; }
#pragma unroll 1
    for (int tile = bid >> 3; tile < NT / PT; tile += G_ >> 3) {
        const int row0 = tile * PT, tb0 = row0 & (L - 1);
        __syncthreads();
        u32x4 gq[4], vq[3]; u32x4 yq[2][2]; float bq[2];
#pragma unroll
        for (int k = 0; k < 4; ++k) { const int q = tid + k * NTHREADS; gq[k] = *(const u32x4*)(proj + (size_t)(row0 + (q >> 4)) * IN_DP + C_RG + (q & 15) * 8); }
#pragma unroll
        for (int k = 0; k < 3; ++k) { const int q = tid + k * NTHREADS; const int rr = q >> 3, ch = q & 7; const int tt = tb0 - 1 + rr; vq[k] = (u32x4){0u, 0u, 0u, 0u};
            if (q < 1040 && tt >= 0 && tt < L) vq[k] = *(const u32x4*)(proj + (size_t)(row0 - 1 + rr) * IN_DP + C_RV + h * 64 + ch * 8); }
#pragma unroll
        for (int sl = 0; sl < 2; ++sl) { const size_t row = (size_t)row0 + (tid >> 3) + 64 * sl; yq[sl][0] = *(const u32x4*)(YF + row * 512 + col); yq[sl][1] = *(const u32x4*)(YB + row * 512 + col);
            const size_t bi = ((size_t)(row >> 13) * 8 + h) * L + (row & (L - 1)); bq[sl] = BONF[bi] + BONB[bi]; }
#pragma unroll
        for (int k = 0; k < 4; ++k) { const int q = tid + k * NTHREADS; const int t = q >> 4, ch = q & 15; float f[8]; unpack8(gq[k], f);
            u32x4 w; w.x = pk2(frcp(1.f + __expf(-f[0])), frcp(1.f + __expf(-f[1]))); w.y = pk2(frcp(1.f + __expf(-f[2])), frcp(1.f + __expf(-f[3])));
            w.z = pk2(frcp(1.f + __expf(-f[4])), frcp(1.f + __expf(-f[5]))); w.w = pk2(frcp(1.f + __expf(-f[6])), frcp(1.f + __expf(-f[7])));
            *(LAS u32x4*)(SG + t * GP + ch * 16) = w; }
#pragma unroll
        for (int k = 0; k < 3; ++k) { const int q = tid + k * NTHREADS; if (q < 1040) *(LAS u32x4*)(RAWV + (q >> 3) * 128 + (q & 7) * 16) = vq[k]; }
        __syncthreads();
#pragma unroll
        for (int ct = 0; ct < 4; ++ct) { f32x4 acc = (f32x4){0.f, 0.f, 0.f, 0.f};
#pragma unroll
            for (int ks = 0; ks < 4; ++ks) { const bf16x8 a = *(const LAS bf16x8*)(SG + (16 * wave + fr) * GP + ks * 64 + fq * 16); const bf16x8 b = *(const LAS bf16x8*)(G2T + (16 * ct + fr) * GP + ks * 64 + fq * 16);
                acc = __builtin_amdgcn_mfma_f32_16x16x32_bf16(a, b, acc, 0, 0, 0); }
#pragma unroll
            for (int e = 0; e < 4; ++e) *(LAS bf16_t*)(GATE + (16 * wave + 4 * fq + e) * 144 + (16 * ct + fr) * 2) = (bf16_t)f2bf(acc[e]); }
        __syncthreads();
#pragma unroll
        for (int sl = 0; sl < 2; ++sl) { const int t = (tid >> 3) + 64 * sl; const size_t row = (size_t)row0 + t;
            float vp[8], vc[8], vn[8], gt[8];
            unpack8(*(const LAS u32x4*)(RAWV + t * 128 + ig * 16), vp); unpack8(*(const LAS u32x4*)(RAWV + (t + 1) * 128 + ig * 16), vc); unpack8(*(const LAS u32x4*)(RAWV + (t + 2) * 128 + ig * 16), vn);
            unpack8(*(const LAS u32x4*)(GATE + t * 144 + ig * 16), gt);
            float yf8[8], yb8[8]; unpack8(yq[sl][0], yf8); unpack8(yq[sl][1], yb8);
            const float bon = bq[sl];
            float y[8] = {yf8[0] + yb8[0], yf8[1] + yb8[1], yf8[2] + yb8[2], yf8[3] + yb8[3], yf8[4] + yb8[4], yf8[5] + yb8[5], yf8[6] + yb8[6], yf8[7] + yb8[7]};
            float sm = 0.f;
#pragma unroll
            for (int j = 0; j < 8; ++j) sm += y[j];
            const float mean = sum8(sm) * (1.0f / 64.0f);
            float sq = 0.f;
#pragma unroll
            for (int j = 0; j < 8; ++j) { y[j] -= mean; sq += y[j] * y[j]; }
            const float rstd = __builtin_amdgcn_rsqf(sum8(sq) * (1.0f / 64.0f) + 64e-5f);
            float o[8];
#pragma unroll
            for (int j = 0; j < 8; ++j) { const float v = vc[j] + mv0[j] * (vp[j] - vc[j]) + mv1[j] * (vn[j] - vc[j]); o[j] = (y[j] * rstd * lnw[j] + lnb[j] + bon * v) * gt[j]; }
            u32x4 w; w.x = pk2(o[0], o[1]); w.y = pk2(o[2], o[3]); w.z = pk2(o[4], o[5]); w.w = pk2(o[6], o[7]);
            *(u32x4*)(mix + row * D + 256 + col) = w; }
    }
    __syncthreads();
}

namespace na {
constexpr int O_K = 0, O_V = 65536, O_RPB = 131072, O_MX = 133120, O_QW = 142080;
__device__ __forceinline__ int rowoff(int keycol, int byte) { return keycol * 128 + ((((byte >> 5) ^ keycol) & 3) << 5) + (byte & 31); }
typedef short s16x4 __attribute__((ext_vector_type(4)));
}
__device__ __forceinline__ void na_strip(const Params& p, LAS unsigned char* lds, int l, int strip, const int wvx) {
    using namespace na;
    const int tid = opaque_tid(wvx), lane = tid & 63, wave = __builtin_amdgcn_readfirstlane(tid >> 6), fr = lane & 15, fq = lane >> 4;
    const int b = strip >> 5, h = (strip >> 3) & 3, i0 = (strip & 7) * 16;
    const int g = wave & 3, kh = wave >> 2;
    const bf16_t* proj = (const bf16_t*)(p.ws + OFF_PROJ);
    bf16_t* mix = (bf16_t*)(p.ws + OFF_MIX);
    LAS float* RPB = (LAS float*)(lds + O_RPB);
    LAS unsigned char* MX = lds + O_MX + g * 2240;
    const int j0 = 16 * g, c0 = (g == 0) ? 0 : ((g == 3) ? 32 : 16 * g - 8);
    __syncthreads();
    for (int q = tid; q < 465; q += NTHREADS) RPB[q] = p.in[25][((size_t)l * 4 + h) * 465 + q];
    { int rs = i0 - 4; rs = rs < 0 ? 0 : (rs > 120 ? 120 : rs);
        u32x4 fw[16];
#pragma unroll
        for (int k = 0; k < 16; ++k) { const int q = tid + k * NTHREADS; const int r8 = q >> 10, which = (q >> 9) & 1, col = (q >> 3) & 63, ch = q & 7; const int kr = rs + r8;
            fw[k] = *(const u32x4*)(proj + ((size_t)b * L + kr * 64 + col) * IN_DP + (which ? C_NV : C_NK) + h * 64 + ch * 8); }
#pragma unroll
        for (int k = 0; k < 16; ++k) { const int q = tid + k * NTHREADS; const int r8 = q >> 10, which = (q >> 9) & 1, col = (q >> 3) & 63, ch = q & 7; const int kr = rs + r8;
            *(LAS u32x4*)(lds + (which ? O_V : O_K) + (kr & 7) * 8192 + rowoff(col, 16 * ch)) = fw[k]; } }
    bf16x8 Bq[2];
#pragma unroll
    for (int ks = 0; ks < 2; ++ks) Bq[ks] = *(const bf16x8*)(proj + ((size_t)b * L + i0 * 64 + j0 + fr) * IN_DP + C_NQ + h * 64 + 32 * ks + 8 * fq);
    const int jq = j0 + fr;
    int cs = jq - 8; cs = cs < 0 ? 0 : (cs > 48 ? 48 : cs);
    const u32x4 onesv = (u32x4){0x3F803F80u, 0x3F803F80u, 0x3F803F80u, 0x3F803F80u};
#pragma unroll 1
    for (int i = i0; i < i0 + 16; ++i) {
        int rs = i - 4; rs = rs < 0 ? 0 : (rs > 120 ? 120 : rs);
        int rsn = i + 1 - 4; rsn = rsn < 0 ? 0 : (rsn > 120 ? 120 : rsn);
        const bool more = (i + 1 < i0 + 16), newrow = more && (rsn > rs);
        __syncthreads();
        u32x4 pre0 = (u32x4){0u, 0u, 0u, 0u}, pre1 = pre0; bf16x8 Bqn[2] = {Bq[0], Bq[1]};
        if (newrow) { const int kr = rsn + 7;
            { const int q = tid; const int which = q >> 9, col = (q >> 3) & 63, ch = q & 7; pre0 = *(const u32x4*)(proj + ((size_t)b * L + kr * 64 + col) * IN_DP + (which ? C_NV : C_NK) + h * 64 + ch * 8); }
            { const int q = tid + 512; const int which = q >> 9, col = (q >> 3) & 63, ch = q & 7; pre1 = *(const u32x4*)(proj + ((size_t)b * L + kr * 64 + col) * IN_DP + (which ? C_NV : C_NK) + h * 64 + ch * 8); } }
        if (more) {
#pragma unroll
            for (int ks = 0; ks < 2; ++ks) Bqn[ks] = *(const bf16x8*)(proj + ((size_t)b * L + (i + 1) * 64 + j0 + fr) * IN_DP + C_NQ + h * 64 + 32 * ks + 8 * fq); }
        f32x4 S[4][2]; float mloc = -1e30f;
#pragma unroll
        for (int r4 = 0; r4 < 4; ++r4) { const int krow = rs + 4 * kh + r4, slot = krow & 7, dr = krow - i + 7;
#pragma unroll
            for (int ct = 0; ct < 2; ++ct) { const int keycol = c0 + 16 * ct + fr; f32x4 acc = (f32x4){0.f, 0.f, 0.f, 0.f};
#pragma unroll
                for (int ks = 0; ks < 2; ++ks) { const bf16x8 a = *(const LAS bf16x8*)(lds + O_K + slot * 8192 + rowoff(keycol, 64 * ks + 16 * fq)); acc = __builtin_amdgcn_mfma_f32_16x16x32_bf16(a, Bq[ks], acc, 0, 0, 0); }
#pragma unroll
                for (int e = 0; e < 4; ++e) { const int kc = c0 + 16 * ct + 4 * fq + e; const bool valid = (kc >= cs) && (kc < cs + 16);
                    int dc = kc - jq; dc = dc < -15 ? -15 : (dc > 15 ? 15 : dc); dc += 15;
                    const float sc = valid ? (acc[e] * 0.125f + RPB[dr * 31 + dc]) : -1e30f; acc[e] = sc; mloc = fmaxf(mloc, sc); }
                S[r4][ct] = acc; } }
        { int lid; asm volatile("v_mbcnt_lo_u32_b32 %0, -1, 0\n\tv_mbcnt_hi_u32_b32 %0, -1, %0" : "=v"(lid));
          mloc = fmaxf(mloc, __int_as_float(__builtin_amdgcn_ds_bpermute((lid ^ 16) << 2, __float_as_int(mloc))));
          mloc = fmaxf(mloc, __int_as_float(__builtin_amdgcn_ds_bpermute((lid ^ 32) << 2, __float_as_int(mloc)))); }
        bf16x8 Ap[4];
#pragma unroll
        for (int r4 = 0; r4 < 4; ++r4) { float pv[8];
#pragma unroll
            for (int ct = 0; ct < 2; ++ct)
#pragma unroll
                for (int e = 0; e < 4; ++e) { const float sc = S[r4][ct][e]; pv[ct * 4 + e] = (sc > -1e29f) ? __expf(sc - mloc) : 0.f; }
            const u32x4 w = (u32x4){pk2(pv[0], pv[1]), pk2(pv[2], pv[3]), pk2(pv[4], pv[5]), pk2(pv[6], pv[7])}; Ap[r4] = __builtin_bit_cast(bf16x8, w); }
        f32x4 O[4], Ls = (f32x4){0.f, 0.f, 0.f, 0.f};
#pragma unroll
        for (int dt = 0; dt < 4; ++dt) O[dt] = (f32x4){0.f, 0.f, 0.f, 0.f};
#pragma unroll
        for (int r4 = 0; r4 < 4; ++r4) { const int slot = (rs + 4 * kh + r4) & 7; const int kc0 = c0 + 4 * fq + (fr >> 2), kc1 = kc0 + 16;
            Ls = __builtin_amdgcn_mfma_f32_16x16x32_bf16(Ap[r4], __builtin_bit_cast(bf16x8, onesv), Ls, 0, 0, 0);
#pragma unroll
            for (int dt = 0; dt < 4; ++dt) {
                const s16x4 v0 = __builtin_amdgcn_ds_read_tr16_b64_v4i16((LAS s16x4*)(lds + O_V + slot * 8192 + rowoff(kc0, 32 * dt + 8 * (fr & 3))));
                const s16x4 v1 = __builtin_amdgcn_ds_read_tr16_b64_v4i16((LAS s16x4*)(lds + O_V + slot * 8192 + rowoff(kc1, 32 * dt + 8 * (fr & 3))));
                const bf16x8 bv = (bf16x8){v0[0], v0[1], v0[2], v0[3], v1[0], v1[1], v1[2], v1[3]};
                O[dt] = __builtin_amdgcn_mfma_f32_16x16x32_bf16(Ap[r4], bv, O[dt], 0, 0, 0); } }
        if (fq == 0) *(LAS float*)(MX + kh * 64 + fr * 4) = mloc;
        if (kh == 1) { if (fr == 0) *(LAS f32x4*)(MX + 128 + fq * 16) = Ls;
#pragma unroll
            for (int dt = 0; dt < 4; ++dt)
#pragma unroll
                for (int e = 0; e < 4; ++e) *(LAS bf16_t*)(MX + 192 + (4 * fq + e) * 128 + (16 * dt + fr) * 2) = (bf16_t)f2bf(O[dt][e]); }
        __syncthreads();
        if (newrow) { const int kr = rsn + 7;
            { const int q = tid; const int which = q >> 9, col = (q >> 3) & 63, ch = q & 7; *(LAS u32x4*)(lds + (which ? O_V : O_K) + (kr & 7) * 8192 + rowoff(col, 16 * ch)) = pre0; }
            { const int q = tid + 512; const int which = q >> 9, col = (q >> 3) & 63, ch = q & 7; *(LAS u32x4*)(lds + (which ? O_V : O_K) + (kr & 7) * 8192 + rowoff(col, 16 * ch)) = pre1; } }
        if (kh == 0) {
            const f32x4 m0 = *(const LAS f32x4*)(MX + fq * 16), m1 = *(const LAS f32x4*)(MX + 64 + fq * 16), l1 = *(const LAS f32x4*)(MX + 128 + fq * 16);
#pragma unroll
            for (int e = 0; e < 4; ++e) { const float M = fmaxf(m0[e], m1[e]), a0 = __expf(m0[e] - M), a1 = __expf(m1[e] - M); const float inv = frcp(Ls[e] * a0 + l1[e] * a1);
                const size_t row = (size_t)b * L + i * 64 + j0 + 4 * fq + e;
#pragma unroll
                for (int dt = 0; dt < 4; ++dt) { const float o1 = bf2f(*(const LAS bf16_t*)(MX + 192 + (4 * fq + e) * 128 + (16 * dt + fr) * 2));
                    mix[row * D + 768 + h * 64 + 16 * dt + fr] = (bf16_t)f2bf((O[dt][e] * a0 + o1 * a1) * inv); } }
        }
        Bq[0] = Bqn[0]; Bq[1] = Bqn[1];
    }
    __syncthreads();
}

__device__ __forceinline__ void wg_signal(int* ctr, const bool leader) {
    asm volatile("s_waitcnt vmcnt(0)" ::: "memory");
    __syncthreads();
    if (leader) { __builtin_amdgcn_fence(__ATOMIC_RELEASE, "agent"); asm volatile("s_waitcnt vmcnt(0)" ::: "memory"); __hip_atomic_fetch_add(ctr, 1, __ATOMIC_RELAXED, __HIP_MEMORY_SCOPE_AGENT); }
}
__device__ __forceinline__ void wg_wait(int* ctr, int target, const bool leader) {
    if (leader) { unsigned sp = 0;
        while (__hip_atomic_load(ctr, __ATOMIC_RELAXED, __HIP_MEMORY_SCOPE_AGENT) < target) { __builtin_amdgcn_s_sleep(2); if (++sp > (1u << 24)) break; }
        __builtin_amdgcn_fence(__ATOMIC_ACQUIRE, "agent"); asm volatile("s_waitcnt vmcnt(0)" ::: "memory"); }
    __syncthreads();
}
__device__ __forceinline__ int wg_pop(int* ctr, LAS int* qw, const bool leader) {
    __syncthreads();
    if (leader) *qw = __hip_atomic_fetch_add(ctr, 1, __ATOMIC_RELAXED, __HIP_MEMORY_SCOPE_AGENT);
    __syncthreads();
    return __builtin_amdgcn_readfirstlane(*qw);
}
__device__ __forceinline__ void na_queue(const Params& p, LAS unsigned char* lds, int l, const int wvx) {
    int* ctr = (int*)(p.ws + OFF_CTL) + 16 + l;
    LAS int* qw = (LAS int*)(lds + na::O_QW);
    for (;;) {
        __syncthreads();
        if (opaque_tid(wvx) == 0) *qw = atomicAdd(ctr, 1);
        __syncthreads();
        const int strip = __builtin_amdgcn_readfirstlane(*qw);
        if (strip >= 256) break;
        na_strip(p, lds, l, strip, wvx);
    }
}

__device__ __forceinline__ void phase_router(const Params& p, LAS unsigned char* lds, int l, int G_, int bid, const int wvx) {
    const int tid = opaque_tid(wvx), lane = tid & 63, wave = __builtin_amdgcn_readfirstlane(tid >> 6), fr = lane & 15, fq = lane >> 4;
    const bf16_t* x = (const bf16_t*)(p.ws + OFF_XB); float* rs = (float*)(p.ws + OFF_RS);
    const bf16_t* rgh = (const bf16_t*)(p.ws + OFF_RGW) + (size_t)l * 2 * 48 * D; const bf16_t* rgl = rgh + 48 * D;
    int* cnt = (int*)(p.ws + OFF_CTL) + 64 + l * 64;
    int* ltok = (int*)(p.ws + OFF_LTOK); float* lgate = (float*)(p.ws + OFF_LGATE); float* lrs = (float*)(p.ws + OFF_LRS);
    LAS int* lcnt = (LAS int*)lds;
    LAS int* lbase = lcnt + 32;
    LAS int* se = lbase + 32;
    LAS int* sp = se + 512;
    LAS float* sg = (LAS float*)(sp + 512);
    LAS float* LG = (LAS float*)(lds + 8192);
    LAS float* SQ = LG + 256 * 52;
    const float* bg = p.in[29] + l * 4; const float* be = p.in[31] + l * 32;
    for (int chunk = bid; chunk < NT / 256; chunk += G_) {
        __syncthreads();
        if (tid < 32) lcnt[tid] = 0;
        const int tl0 = wave * 32;
        const bf16_t* xa_p = x + (size_t)(chunk * 256 + tl0 + fr) * D + 8 * fq; const bf16_t* xb_p = xa_p + 16 * D;
        const bf16_t* wh_p = rgh + (size_t)fr * D + 8 * fq; const bf16_t* wl_p = rgl + (size_t)fr * D + 8 * fq;
        f32x4 acc[2][3];
#pragma unroll
        for (int t = 0; t < 2; ++t)
#pragma unroll
            for (int c = 0; c < 3; ++c) acc[t][c] = (f32x4){0.f, 0.f, 0.f, 0.f};
        float ssa = 0.f, ssb = 0.f;
#pragma unroll 2
        for (int ks = 0; ks < 32; ++ks) {
            const u32x4 ar = *(const u32x4*)(xa_p + 32 * ks), br = *(const u32x4*)(xb_p + 32 * ks);
            bf16x8 wh[3], wl[3];
#pragma unroll
            for (int c = 0; c < 3; ++c) { wh[c] = *(const bf16x8*)(wh_p + (size_t)16 * c * D + 32 * ks); wl[c] = *(const bf16x8*)(wl_p + (size_t)16 * c * D + 32 * ks); }
            { float f[8]; unpack8(ar, f);
#pragma unroll
              for (int j = 0; j < 8; ++j) ssa += f[j] * f[j];
              unpack8(br, f);
#pragma unroll
              for (int j = 0; j < 8; ++j) ssb += f[j] * f[j]; }
            const bf16x8 a0 = __builtin_bit_cast(bf16x8, ar), a1 = __builtin_bit_cast(bf16x8, br);
#pragma unroll
            for (int c = 0; c < 3; ++c) {
                acc[0][c] = __builtin_amdgcn_mfma_f32_16x16x32_bf16(a0, wh[c], acc[0][c], 0, 0, 0); acc[0][c] = __builtin_amdgcn_mfma_f32_16x16x32_bf16(a0, wl[c], acc[0][c], 0, 0, 0);
                acc[1][c] = __builtin_amdgcn_mfma_f32_16x16x32_bf16(a1, wh[c], acc[1][c], 0, 0, 0); acc[1][c] = __builtin_amdgcn_mfma_f32_16x16x32_bf16(a1, wl[c], acc[1][c], 0, 0, 0); }
        }
#pragma unroll
        for (int t = 0; t < 2; ++t)
#pragma unroll
            for (int c = 0; c < 3; ++c)
#pragma unroll
                for (int e = 0; e < 4; ++e) LG[(tl0 + 16 * t + 4 * fq + e) * 52 + 16 * c + fr] = acc[t][c][e];
        SQ[(tl0 + fr) * 4 + fq] = ssa; SQ[(tl0 + 16 + fr) * 4 + fq] = ssb;
        __syncthreads();
        if (lane < 32) { const int tl = tl0 + lane, row = chunk * 256 + tl;
            const f32x4 s4 = *(const LAS f32x4*)(SQ + tl * 4);
            const float rr = 1.0f / sqrtf(((s4.x + s4.y) + (s4.z + s4.w)) * (1.0f / D) + NORM_EPS);
            rs[row] = rr; SQ[tl * 4] = rr;
            const LAS float* lg = LG + tl * 52;
            const float g0 = lg[0] * rr + bg[0], g1 = lg[1] * rr + bg[1], g2 = lg[2] * rr + bg[2], g3 = lg[3] * rr + bg[3];
            int gs = 0; float gm = g0; if (g1 > gm) { gm = g1; gs = 1; } if (g2 > gm) { gm = g2; gs = 2; } if (g3 > gm) { gm = g3; gs = 3; }
            const float gprob = 1.0f / (expf(g0 - gm) + expf(g1 - gm) + expf(g2 - gm) + expf(g3 - gm));
            float ev[8];
#pragma unroll
            for (int e = 0; e < 8; ++e) ev[e] = lg[4 + gs * 8 + e] * rr + be[gs * 8 + e];
            int i0 = 0; float v0 = ev[0];
#pragma unroll
            for (int e = 1; e < 8; ++e) if (ev[e] > v0) { v0 = ev[e]; i0 = e; }
            int i1 = -1; float v1 = -3.0e38f;
#pragma unroll
            for (int e = 0; e < 8; ++e) if (e != i0 && ev[e] > v1) { v1 = ev[e]; i1 = e; }
            const float e1 = expf(v1 - v0), den = 1.0f + e1;
            const int ea = gs * 8 + i0, eb = gs * 8 + i1;
            se[tl * 2] = ea; se[tl * 2 + 1] = eb; sg[tl * 2] = gprob / den; sg[tl * 2 + 1] = gprob * e1 / den;
            sp[tl * 2] = atomicAdd((int*)lcnt + ea, 1); sp[tl * 2 + 1] = atomicAdd((int*)lcnt + eb, 1); }
        __syncthreads();
        if (tid < 32) lbase[tid] = atomicAdd(cnt + tid, lcnt[tid]);
        __syncthreads();
        { const int tl = tid >> 1, k = tid & 1, e = se[tid]; const size_t li = (size_t)e * LCAP + lbase[e] + sp[tid];
            ltok[li] = (chunk * 256 + tl) * 2 + k; lgate[li] = sg[tid]; lrs[li] = SQ[tl * 4]; }
    }
    __syncthreads();
}

__device__ __forceinline__ void phase_combine(const Params& p, bool last, int G_, int bid, const int wvx) {
    const int tid = opaque_tid(wvx), lane = tid & 63, wave = tid >> 6;
    float* out = p.out; bf16_t* x16 = (bf16_t*)(p.ws + OFF_XB); float* rs = (float*)(p.ws + OFF_RS);
    const bf16_t* yb = (const bf16_t*)(p.ws + OFF_YBUF);
    const float* gf = p.in[35];
    for (int row = bid * 8 + wave; row < NT; row += G_ * 8) {
        u32x2* xr = (u32x2*)(x16 + (size_t)row * D) + lane; const u32x2* y0 = (const u32x2*)(yb + (size_t)(2 * row) * D) + lane; const u32x2* y1 = (const u32x2*)(yb + (size_t)(2 * row + 1) * D) + lane;
        f32x4 v[4]; float s = 0.f; u32x2 xq[4], aq[4], cq[4];
#pragma unroll
        for (int j = 0; j < 4; ++j) { xq[j] = xr[64 * j]; aq[j] = y0[64 * j]; cq[j] = y1[64 * j]; }
#pragma unroll
        for (int j = 0; j < 4; ++j) { const u32x2 xx = xq[j], a = aq[j], c = cq[j];
            v[j].x = bf2f(xx.x & 0xffffu) + bf2f(a.x & 0xffffu) + bf2f(c.x & 0xffffu); v[j].y = __uint_as_float(xx.x & 0xffff0000u) + __uint_as_float(a.x & 0xffff0000u) + __uint_as_float(c.x & 0xffff0000u);
            v[j].z = bf2f(xx.y & 0xffffu) + bf2f(a.y & 0xffffu) + bf2f(c.y & 0xffffu); v[j].w = __uint_as_float(xx.y & 0xffff0000u) + __uint_as_float(a.y & 0xffff0000u) + __uint_as_float(c.y & 0xffff0000u);
            s += (v[j].x * v[j].x + v[j].y * v[j].y) + (v[j].z * v[j].z + v[j].w * v[j].w); }
        s = wave_sum(s);
        const float rr = 1.0f / sqrtf(s * (1.0f / D) + NORM_EPS);
        if (last) { f32x4* orow = (f32x4*)(out + (size_t)row * D) + lane;
#pragma unroll
            for (int j = 0; j < 4; ++j) { const f32x4 g = ((const f32x4*)gf)[lane + 64 * j]; orow[64 * j] = v[j] * rr * g; }
        } else {
            if (lane == 0) rs[row] = rr;
#pragma unroll
            for (int j = 0; j < 4; ++j) xr[64 * j] = (u32x2){pk2(v[j].x, v[j].y), pk2(v[j].z, v[j].w)};
        }
    }
}

#ifndef PH_MASK
#define PH_MASK 0xFFFFF
#endif
#define PH(k) if (PH_MASK & (1 << (k)))

#define XB_TMO      128
#define XB_XCNT(j)  (256  + 64 * (j))
#define XB_XSUB(j)  (1280 + 64 * (j))
#define XB_XGEN(j)  (2304 + 64 * (j))
#define XB_TOP      3328
#define XB_TOPGEN   3392
#define XCD_BAR_WORDS 3456
#define XB_SPIN_CAP (1u << 22)
__device__ __forceinline__ unsigned xb_ld(unsigned* p)              { return __hip_atomic_load(p, __ATOMIC_RELAXED, __HIP_MEMORY_SCOPE_AGENT); }
__device__ __forceinline__ unsigned xb_add(unsigned* p, unsigned v) { return __hip_atomic_fetch_add(p, v, __ATOMIC_RELAXED, __HIP_MEMORY_SCOPE_AGENT); }
__device__ __forceinline__ unsigned xb_xcc_id() { return (unsigned)__builtin_amdgcn_s_getreg((3 << 11) | 20) & 0xFu; }
#define XB_SPIN(cond, bar) do { unsigned _sp = 0; while (cond) { __builtin_amdgcn_s_sleep(1); \
    if ((++_sp & 255u) == 0u) { if (xb_ld(&(bar)[XB_TMO])) break; if (_sp > XB_SPIN_CAP) { atomicAdd(&(bar)[XB_TMO], 1u); break; } } } } while (0)
struct XcdBarrier { unsigned* bar; unsigned x; volatile LAS unsigned* st; };
__device__ __forceinline__ void xcd_barrier_complete(unsigned* bar, unsigned x, unsigned& nloc, unsigned& nx) {
    const unsigned G = gridDim.x * gridDim.y * gridDim.z;
    unsigned sum, cnt, mine, sp = 0u;
    for (;;) {
        sum = 0u; cnt = 0u; mine = 0u;
#pragma unroll
        for (unsigned j = 0; j < 16; ++j) { const unsigned c = xb_ld(&bar[XB_XCNT(j)]); sum += c; cnt += (c > 0u) ? 1u : 0u; mine = (j == x) ? c : mine; }
        if (sum == G) break;
        __builtin_amdgcn_s_sleep(1);
        if ((++sp & 255u) == 0u) { if (xb_ld(&bar[XB_TMO])) break; if (sp > XB_SPIN_CAP) { atomicAdd(&bar[XB_TMO], 1u); break; } }
    }
    nloc = mine > 0u ? mine : 1u; nx = cnt > 0u ? cnt : 1u;
}
__device__ __forceinline__ void xcd_barrier(const XcdBarrier& b, const bool leader) {
    asm volatile("s_waitcnt vmcnt(0)" ::: "memory");
    __syncthreads();
    if (leader) {
        unsigned* bar = b.bar;
        __builtin_amdgcn_s_waitcnt(0);
        unsigned nloc = b.st[0], nx = b.st[1];
        if (nloc == 0u) { xcd_barrier_complete(bar, b.x, nloc, nx); b.st[0] = nloc; b.st[1] = nx; }
        const unsigned old = xb_add(&bar[XB_XSUB(b.x)], 1u);
        const unsigned gen = old / nloc;
        if (old + 1u == (gen + 1u) * nloc) {
            __builtin_amdgcn_fence(__ATOMIC_RELEASE, "agent");
            asm volatile("s_waitcnt vmcnt(0)" ::: "memory");
            const unsigned og = xb_add(&bar[XB_TOP], 1u);
            const unsigned tg = og / nx;
            if (og + 1u == (tg + 1u) * nx) xb_add(&bar[XB_TOPGEN], 1u);
            else XB_SPIN(xb_ld(&bar[XB_TOPGEN]) == tg, bar);
            __builtin_amdgcn_fence(__ATOMIC_ACQUIRE, "agent");
            xb_add(&bar[XB_XGEN(b.x)], 1u);
            asm volatile("s_waitcnt vmcnt(0)" ::: "memory");
        } else {
            XB_SPIN(xb_ld(&bar[XB_XGEN(b.x)]) == gen, bar);
            __builtin_amdgcn_fence(__ATOMIC_ACQUIRE, "agent");
            asm volatile("s_waitcnt vmcnt(0)" ::: "memory");
        }
    }
    __syncthreads();
}

__device__ __forceinline__ Params load_params() {
#if defined(__HIP_DEVICE_COMPILE__)
    auto k = __builtin_amdgcn_kernarg_segment_ptr();
    asm volatile("" : "+s"(k));
    return *(const __attribute__((address_space(4))) Params*)k;
#else
    return Params{};
#endif
}
__global__ void __launch_bounds__(NTHREADS, 2) fwd_megakernel(Params p_unused) {
    extern __shared__ __attribute__((aligned(16))) unsigned char lds_raw[];
    LAS unsigned char* lds = (LAS unsigned char*)lds_raw;
    cg::grid_group grid = cg::this_grid();
    const int G_ = gridDim.x, bid = blockIdx.x;
    const int wvx = __builtin_amdgcn_readfirstlane((int)threadIdx.x >> 6);
    const bool leader = (threadIdx.x == 0);
    volatile LAS unsigned* bst = (volatile LAS unsigned*)(lds + LDS_BYTES - 16);
    if (leader) { bst[0] = 0u; bst[1] = 0u; }
    XcdBarrier xbar;
    { const Params p = load_params(); xbar.bar = (unsigned*)(p.ws + OFF_CTL) + 4096; xbar.x = xb_xcc_id(); xbar.st = bst;
      if (leader) (void)xb_add(&xbar.bar[XB_XCNT(xbar.x)], 1u); }
    __syncthreads();
#define GRID_BAR() do { const Params pb = load_params(); XcdBarrier xb2; xb2.bar = (unsigned*)(pb.ws + OFF_CTL) + 4096; xb2.x = xb_xcc_id(); xb2.st = bst; xcd_barrier(xb2, opaque_tid(wvx) == 0); } while (0)

    { const Params p = load_params(); PH(0) phase_prologue(p, lds, G_, bid, wvx); }
    { const Params p = load_params(); PH(0) filters_all(p, G_, bid, wvx); }
    { const Params p = load_params(); PH(1) phase_rownorm(p.in[0], (bf16_t*)(p.ws + OFF_XB), (float*)(p.ws + OFF_RS), G_, bid, wvx); }
    grid.sync();

#pragma unroll 1
    for (int l = 0; l < DEPTH; ++l) {
        PH(2) { const Params p = load_params(); unsigned char* ws = p.ws;
            DenseSched S; S.init((const bf16_t*)(ws + OFF_XB), (const bf16_t*)(ws + OFF_WTIN) + (size_t)l * IN_DP * D, NT, IN_DP, D, G_, bid);
            EpiProj E{(bf16_t*)(ws + OFF_PROJ), (const float*)(ws + OFF_RS)};
            pg8::gemm_phase<EpiProj, DenseSched, false>(lds, D, S, E, wvx);
        }
        GRID_BAR();
        {
            const bool lead = (opaque_tid(wvx) == 0);
            LAS int* qw = (LAS int*)(lds + na::O_QW);
#define CTR(k) ((int*)(load_params().ws + OFF_CTL) + 32 + l * 16 + (k))
            if (bid < 128) { PH(5) { const Params p = load_params(); rw_chain_unit(p, lds, l, bid, wvx); } }
            else {
                PH(3) for (;;) { const int u = wg_pop(CTR(0), qw, lead); if (u >= 4096) break; { const Params p = load_params(); hy_pre_unit(p, lds, l, u, wvx); } wg_signal(CTR(1), lead); }
                wg_wait(CTR(1), 4096, lead);
                PH(4) for (int c = bid - 128; c < 256; c += 128) { { const Params p = load_params(); hy_conv_unit(p, lds, l, c, wvx); } wg_signal(CTR(2), lead); }
            }
            PH(6) { const Params p = load_params(); na_queue(p, lds, l, wvx); }
            wg_wait(CTR(2), 256, lead);
            PH(7) for (;;) { const int u = wg_pop(CTR(3), qw, lead); if (u >= 4096) break; { const Params p = load_params(); hy_post_unit(p, lds, l, u, wvx); } wg_signal(CTR(4), lead); }
            wg_wait(CTR(4), 4096, lead);
            PH(10) for (;;) { const int u = wg_pop(CTR(5), qw, lead); if (u >= NEXP * 768 / 64 + (l == 0 ? 43 : 0)) break; { const Params p = load_params(); moe_weights_chunk(p, lds, l, u, wvx); } }
#undef CTR
        }
        GRID_BAR();
        PH(8) { const Params p = load_params(); rw_post_wg(p, lds, l, G_, bid, wvx); }
        GRID_BAR();
        PH(9) { const Params p = load_params(); unsigned char* ws = p.ws;
            DenseSched S; S.init((const bf16_t*)(ws + OFF_MIX), (const bf16_t*)(ws + OFF_WTOUT) + (size_t)l * D * D, NT, D, D, G_, bid);
            EpiRes E{(bf16_t*)(ws + OFF_XB)};
            pg8::gemm_phase<EpiRes, DenseSched, false>(lds, D, S, E, wvx);
        }
        GRID_BAR();
        PH(11) { const Params p = load_params(); phase_router(p, lds, l, G_, bid, wvx); }
        GRID_BAR();
        PH(12) { const Params p = load_params(); unsigned char* ws = p.ws;
            const int* cnt = (const int*)(ws + OFF_CTL) + 64 + l * 64;
            MoeSched S; S.init(cnt, (const bf16_t*)(ws + OFF_XB), (const bf16_t*)(ws + OFF_W13T), (size_t)1024 * D, (const int*)(ws + OFF_LTOK), D, G_, bid, (LAS int*)(lds + 139264), opaque_tid(wvx));
            EpiMoe1 E{(bf16_t*)(ws + OFF_ACT), (const float*)(ws + OFF_LRS)};
            pg8::gemm_phase<EpiMoe1, MoeSched, true>(lds, D, S, E, wvx);
        }
        GRID_BAR();
        PH(13) { const Params p = load_params(); unsigned char* ws = p.ws;
            const int* cnt = (const int*)(ws + OFF_CTL) + 64 + l * 64;
            MoeSched S; S.init(cnt, (const bf16_t*)(ws + OFF_ACT), (const bf16_t*)(ws + OFF_W2T), (size_t)D * FF, nullptr, FF, G_, bid, (LAS int*)(lds + 139264), opaque_tid(wvx));
            EpiMoe2 E{(bf16_t*)(ws + OFF_YBUF), (const int*)(ws + OFF_LTOK), (const float*)(ws + OFF_LGATE)};
            pg8::gemm_phase<EpiMoe2, MoeSched, false>(lds, FF, S, E, wvx);
        }
        GRID_BAR();
        PH(14) { const Params p = load_params(); phase_combine(p, l == DEPTH - 1, G_, bid, wvx); }
        if (l < DEPTH - 1) GRID_BAR();
    }
}

extern "C" void kernel_launch(void* const* d_in, const int* in_sizes, int n_in, void* d_out, int out_size, void* d_ws, size_t ws_size, hipStream_t stream) {
    static int grid = 0;
    if (grid == 0) {
        if (n_in != 36 || ws_size < WS_END) { fprintf(stderr, "kernel_launch: unexpected n_in %d / ws_size %zu (need %zu)\n", n_in, ws_size, (size_t)WS_END); grid = -1; return; }
        int dev = 0, cus = 0, per_cu = 0;
        hipGetDevice(&dev);
        hipDeviceGetAttribute(&cus, hipDeviceAttributeMultiprocessorCount, dev);
        hipFuncSetAttribute((const void*)fwd_megakernel, hipFuncAttributeMaxDynamicSharedMemorySize, LDS_BYTES);
        hipOccupancyMaxActiveBlocksPerMultiprocessor(&per_cu, (const void*)fwd_megakernel, NTHREADS, LDS_BYTES);
        if (per_cu < 1) { fprintf(stderr, "kernel_launch: occupancy query says %d blocks per CU\n", per_cu); per_cu = 1; }
        if (per_cu > 1) per_cu = 1;
        grid = cus * per_cu;
        if (grid != 256) { fprintf(stderr, "kernel_launch: this kernel needs exactly 256 co-resident workgroups (got %d)\n", grid); if (grid > 256) grid = 256; }
        fprintf(stderr, "kernel_launch: grid %d (cus %d), ws %zu\n", grid, cus, ws_size);
    }
    if (grid < 0) return;
    hipMemsetAsync((char*)d_ws + OFF_CTL, 0, 65536, stream);
    Params p{};
    for (int i = 0; i < 36; ++i) p.in[i] = (const float*)d_in[i];
    p.out = (float*)d_out; p.ws = (unsigned char*)d_ws;
    void* args[] = {&p};
    hipError_t e = hipLaunchCooperativeKernel((const void*)fwd_megakernel, dim3(grid), dim3(NTHREADS), args, LDS_BYTES, stream);
    if (e != hipSuccess) fprintf(stderr, "cooperative launch failed: %s (grid %d)\n", hipGetErrorString(e), grid);
}
```

```cpp
#include <hip/hip_runtime.h>
#include <hip/hip_cooperative_groups.h>
#include <cstdio>
#include <cstdint>
namespace cg = cooperative_groups;

#define LAS __attribute__((address_space(3)))
typedef unsigned short bf16_t;
typedef short bf16x8 __attribute__((ext_vector_type(8)));
typedef float f32x4 __attribute__((ext_vector_type(4)));
typedef float f32x2 __attribute__((ext_vector_type(2)));
typedef unsigned u32x4 __attribute__((ext_vector_type(4)));
typedef unsigned u32x2 __attribute__((ext_vector_type(2)));

constexpr int D = 1024, NB = 8, L = 8192, NT = NB * L, DEPTH = 2;
constexpr int IN_D = 3456, IN_DP = 3584;
constexpr int C_HX0 = 0, C_HX1 = 256, C_HV = 512, C_RR = 768, C_RK = 1280, C_RV = 1792, C_RG = 2304, C_RW = 2432, C_RA = 2560, C_NQ = 2688, C_NK = 2944, C_NV = 3200;
constexpr int NEXP = 32, FF = 512;
constexpr float NORM_EPS = 1e-6f;

constexpr size_t MiB = 1u << 20;
constexpr size_t OFF_CTL = 0;
constexpr size_t OFF_WTIN = 1 * MiB;
constexpr size_t OFF_WTOUT = 15 * MiB;
constexpr size_t OFF_RS = 19 * MiB;
constexpr size_t OFF_RGW = 20 * MiB;
constexpr size_t OFF_LTOK = 21 * MiB;
constexpr size_t OFF_LGATE = 29 * MiB;
constexpr size_t OFF_FILT = 37 * MiB;
constexpr size_t OFF_MOEW = 69 * MiB;
constexpr size_t OFF_W13T = OFF_MOEW, OFF_W2T = OFF_MOEW + 64 * MiB;
constexpr size_t OFF_ZT = OFF_MOEW;
constexpr size_t OFF_YT = OFF_MOEW + 32 * MiB;
constexpr size_t OFF_XB = 165 * MiB;
constexpr size_t OFF_MIX = 869 * MiB;
constexpr size_t OFF_PROJ = 293 * MiB;
constexpr size_t OFF_ACT = OFF_PROJ;
constexpr size_t OFF_YBUF = OFF_PROJ + 136 * MiB;
constexpr size_t OFF_YF = 741 * MiB;
constexpr size_t OFF_YB = 805 * MiB;
constexpr size_t OFF_BON = 997 * MiB;
constexpr size_t OFF_LRS = 1001 * MiB;
constexpr size_t WS_END = 1009 * MiB;
constexpr int LCAP = 65536;

constexpr int LDS_BYTES = 147456;
constexpr int NTHREADS = 512;

struct Params { const float* in[36]; float* out; unsigned char* ws; };

__device__ __forceinline__ float bf2f(unsigned b) { return __uint_as_float(b << 16); }
typedef __bf16 bf16x2_t __attribute__((ext_vector_type(2)));
__device__ __forceinline__ unsigned f2bf(float f) { return (unsigned)__builtin_bit_cast(unsigned short, (__bf16)f); }
__device__ __forceinline__ unsigned pk2(float lo, float hi) { const f32x2 v = {lo, hi}; return __builtin_bit_cast(unsigned, __builtin_convertvector(v, bf16x2_t)); }
#define DPPF(v, ctrl) __int_as_float(__builtin_amdgcn_update_dpp(0, __float_as_int(v), (ctrl), 0xF, 0xF, true))
__device__ __forceinline__ float rdlane(float v, int l) { return __int_as_float(__builtin_amdgcn_readlane(__float_as_int(v), l)); }
__device__ __forceinline__ float wave_sum(float v) {
    v += DPPF(v, 0xB1); v += DPPF(v, 0x4E); v += DPPF(v, 0x141); v += DPPF(v, 0x140);
    return (rdlane(v, 0) + rdlane(v, 16)) + (rdlane(v, 32) + rdlane(v, 48));
}
__device__ __forceinline__ float sum8(float v) { v += DPPF(v, 0xB1); v += DPPF(v, 0x4E); v += DPPF(v, 0x141); return v; }
__device__ __forceinline__ void unpack8(const u32x4 w, float* f) {
    f[0] = bf2f(w.x & 0xffffu); f[1] = __uint_as_float(w.x & 0xffff0000u);
    f[2] = bf2f(w.y & 0xffffu); f[3] = __uint_as_float(w.y & 0xffff0000u);
    f[4] = bf2f(w.z & 0xffffu); f[5] = __uint_as_float(w.z & 0xffff0000u);
    f[6] = bf2f(w.w & 0xffffu); f[7] = __uint_as_float(w.w & 0xffff0000u);
}
__device__ __forceinline__ float frcp(float x) { return __builtin_amdgcn_rcpf(x); }
__device__ __forceinline__ float ftanh(float x) { const float e = __expf(2.0f * x); return 1.0f - 2.0f * frcp(e + 1.0f); }
#define LDS_WAIT() asm volatile("s_waitcnt lgkmcnt(0)" ::: "memory")
__device__ __forceinline__ int opaque_tid(int wvx) { int ln; asm volatile("v_mbcnt_lo_u32_b32 %0, -1, 0\n\tv_mbcnt_hi_u32_b32 %0, -1, %0" : "=v"(ln)); return wvx * 64 + ln; }

namespace pg8 {
constexpr int BM = 256, BK = 64, HALF = 128, HTB = HALF * BK * 2, STAGE_BYTES = 8 * HTB;
__device__ __forceinline__ int lds_byte(int r, int c) { const int st = (r >> 4) * 2 + (c >> 5), rr = r & 15, cc = c & 31, ob = rr * 64 + cc * 2; return st * 1024 + (ob ^ (((ob >> 9) & 1) << 5)); }
__device__ __forceinline__ void stage_rc(int b, int& R, int& C) { const int st = b / 1024, sb = b % 1024, swz = sb ^ (((sb >> 9) & 1) << 5); R = (st >> 1) * 16 + swz / 64; C = (st & 1) * 32 + (swz % 64) / 2; }
__device__ __forceinline__ int perm32(int rho) { const int n = rho >> 4, i = rho & 15; return 8 * (i >> 2) + 4 * n + (i & 3); }
__device__ __forceinline__ unsigned cvt_pk_bf16(float lo, float hi) { return pk2(lo, hi); }

struct Unit { const char* A; const char* B; int pm, pn, e, cnt; };

template <class Epi, class Sched, bool GATHER>
__device__ __forceinline__ void gemm_phase(LAS unsigned char* lds, const int K, const Sched& S, const Epi& E, const int wvx) {
    const int tid = opaque_tid(wvx), wid = __builtin_amdgcn_readfirstlane(tid >> 6), lane = tid & 63, wr = wid >> 2, wc = wid & 3, fr = lane & 15, fq = lane >> 4;
    const int nt = K / BK;
    int Rr[2], Cc[2];
    unsigned voffB[2];
#pragma unroll
    for (int i = 0; i < 2; ++i) { stage_rc(tid * 16 + i * 8192, Rr[i], Cc[i]); const int Rb = Epi::PERM ? ((Rr[i] & ~31) + perm32(Rr[i] & 31)) : Rr[i];
        voffB[i] = (unsigned)(Rb * K + Cc[i]) * 2u; }
    const size_t kstep = (size_t)(BK * 2);
    const size_t hstep = (size_t)HALF * K * 2;
    const unsigned ldsw = (unsigned)wid * 1024u;
    const int aoff = lds_byte(wr * 64 + fr, fq * 8), boff = lds_byte(wc * 32 + fr, fq * 8);
#define PG8_SA(b, h) (((b) * 2 + (h)) * HTB)
#define PG8_SB(b, h) ((4 + (b) * 2 + (h)) * HTB)
#define PG8_STAGE(bufoff, gbase, voff) do { _Pragma("unroll") for (int _i = 0; _i < 2; ++_i) \
        __builtin_amdgcn_global_load_lds((const unsigned*)((const char*)(gbase) + (voff)[_i]), (LAS unsigned*)(lds + (bufoff) + ldsw + _i * 8192), 16, 0, 0); } while (0)
#define PG8_LDA(dst, b, h) do { _Pragma("unroll") for (int m = 0; m < 4; ++m) _Pragma("unroll") for (int k = 0; k < 2; ++k) dst[m][k] = *(const LAS bf16x8*)(lds + PG8_SA(b, h) + aoff + m * 2048 + k * 1024); } while (0)
#define PG8_LDB(dst, b, h) do { _Pragma("unroll") for (int n = 0; n < 2; ++n) _Pragma("unroll") for (int k = 0; k < 2; ++k) dst[n][k] = *(const LAS bf16x8*)(lds + PG8_SB(b, h) + boff + n * 2048 + k * 1024); } while (0)
#define PG8_MMA(ai, bj, At, Bt) do { __builtin_amdgcn_s_setprio(1); _Pragma("unroll") for (int m = 0; m < 4; ++m) _Pragma("unroll") for (int n = 0; n < 2; ++n) _Pragma("unroll") for (int k = 0; k < 2; ++k) \
        acc[ai][bj][m][n] = __builtin_amdgcn_mfma_f32_16x16x32_bf16(Bt[n][k], At[m][k], acc[ai][bj][m][n], 0, 0, 0); __builtin_amdgcn_s_setprio(0); } while (0)
#define PG8_WAIT_V(n) asm volatile("s_waitcnt vmcnt(" #n ")" ::: "memory")
#define PG8_WAIT_L(n) asm volatile("s_waitcnt lgkmcnt(" #n ")" ::: "memory")
#define PG8_BAR __builtin_amdgcn_s_barrier()
#define PG8_SCHED __builtin_amdgcn_sched_barrier(0)
    Unit cur, nxt; int ui = 0;
    if (!S.next(0, cur)) return;
    f32x4 acc[2][2][4][2];
#pragma unroll
    for (int a = 0; a < 2; ++a)
#pragma unroll
        for (int b = 0; b < 2; ++b)
#pragma unroll
            for (int m = 0; m < 4; ++m)
#pragma unroll
                for (int n = 0; n < 2; ++n) acc[a][b][m][n] = (f32x4){0.f, 0.f, 0.f, 0.f};
    bf16x8 At[4][2], B0[2][2], B1[2][2];
    typename Epi::Pre epre;
    unsigned vA[2][2];
    LAS u32x4* stash = (LAS u32x4*)(lds + STAGE_BYTES) + tid;
    if (GATHER) S.aoff(cur, tid, vA);
    else {
#pragma unroll
        for (int h = 0; h < 2; ++h)
#pragma unroll
            for (int i = 0; i < 2; ++i) vA[h][i] = (unsigned)((h * HALF + Rr[i]) * K + Cc[i]) * 2u;
    }
    const char* cA = cur.A; const char* cB = cur.B;
    PG8_STAGE(PG8_SB(0, 0), cB, voffB); PG8_STAGE(PG8_SB(0, 1), cB + hstep, voffB); PG8_STAGE(PG8_SA(0, 0), cA, vA[0]); PG8_STAGE(PG8_SA(0, 1), cA, vA[1]);
    if (wr == 1) PG8_BAR;
    PG8_WAIT_V(2); PG8_BAR;
    PG8_STAGE(PG8_SB(1, 0), cB + kstep, voffB); PG8_STAGE(PG8_SA(1, 0), cA + kstep, vA[0]); PG8_STAGE(PG8_SB(1, 1), cB + hstep + kstep, voffB);
    PG8_WAIT_V(6); PG8_BAR;
    for (;;) {
        const bool has_next = S.next(ui + 1, nxt);
        const char* nA = has_next ? nxt.A : cA; const char* nB = has_next ? nxt.B : cB;
        if (GATHER) { unsigned vn[2][2];
            if (has_next) { S.aoff(nxt, tid, vn); *stash = (u32x4){vn[0][0], vn[0][1], vn[1][0], vn[1][1]}; }
            else *stash = (u32x4){vA[0][0], vA[0][1], vA[1][0], vA[1][1]}; }
        for (int t = 0; t < nt; t += 2) {
            const bool last = (t == nt - 2);
            const char* a1 = cA + (size_t)(t + 1) * kstep;
            const char* a2 = last ? nA : cA + (size_t)(t + 2) * kstep; const char* b2 = last ? nB : cB + (size_t)(t + 2) * kstep;
            const char* a3 = a2 + kstep; const char* b3 = b2 + kstep;
            if (last) E.prefetch(epre, cur, wr, wc, fr, fq);
            PG8_LDB(B0, 0, 0); PG8_LDB(B1, 0, 1); PG8_SCHED; PG8_LDA(At, 0, 0); PG8_STAGE(PG8_SA(1, 1), a1, vA[1]);
            if (GATHER && last) { const u32x4 sv = *stash; vA[0][0] = sv.x; vA[0][1] = sv.y; vA[1][0] = sv.z; vA[1][1] = sv.w; }
            PG8_WAIT_V(8); PG8_WAIT_L(0); PG8_BAR; PG8_MMA(0, 0, At, B0); PG8_MMA(0, 1, At, B1); PG8_BAR; PG8_SCHED;
            PG8_LDA(At, 0, 1); PG8_STAGE(PG8_SB(0, 0), b2, voffB); PG8_STAGE(PG8_SB(0, 1), b2 + hstep, voffB); PG8_STAGE(PG8_SA(0, 0), a2, vA[0]);
            PG8_WAIT_V(8); PG8_WAIT_L(0); PG8_BAR; PG8_MMA(1, 0, At, B0); PG8_MMA(1, 1, At, B1); PG8_BAR; PG8_SCHED;
            PG8_LDB(B0, 1, 0); PG8_LDB(B1, 1, 1); PG8_SCHED; PG8_LDA(At, 1, 0); PG8_STAGE(PG8_SA(0, 1), a2, vA[1]);
            PG8_WAIT_V(8); PG8_WAIT_L(0); PG8_BAR; PG8_MMA(0, 0, At, B0); PG8_MMA(0, 1, At, B1); PG8_BAR; PG8_SCHED;
            PG8_LDA(At, 1, 1); PG8_STAGE(PG8_SB(1, 0), b3, voffB); PG8_STAGE(PG8_SB(1, 1), b3 + hstep, voffB); PG8_STAGE(PG8_SA(1, 0), a3, vA[0]);
            PG8_WAIT_V(8); PG8_WAIT_L(0); PG8_BAR; PG8_MMA(1, 0, At, B0); PG8_MMA(1, 1, At, B1); PG8_BAR; PG8_SCHED;
        }
        if (wr == 0) PG8_BAR;
        {
            Unit eu = cur; int efr = fr, efq = fq;
            eu.pm = __builtin_amdgcn_readfirstlane(eu.pm); eu.pn = __builtin_amdgcn_readfirstlane(eu.pn); eu.e = __builtin_amdgcn_readfirstlane(eu.e); eu.cnt = __builtin_amdgcn_readfirstlane(eu.cnt);
            asm volatile("" : "+s"(eu.pm), "+s"(eu.pn), "+s"(eu.e), "+s"(eu.cnt), "+v"(efr), "+v"(efq));
            E(acc, eu, wr, wc, efr, efq, epre);
        }
        if (!has_next) break;
#pragma unroll
        for (int a = 0; a < 2; ++a)
#pragma unroll
            for (int b = 0; b < 2; ++b)
#pragma unroll
                for (int m = 0; m < 4; ++m)
#pragma unroll
                    for (int n = 0; n < 2; ++n) acc[a][b][m][n] = (f32x4){0.f, 0.f, 0.f, 0.f};
        cur = nxt; cA = nA; cB = nB; ++ui;
        if (wr == 1) PG8_BAR;
    }
    PG8_WAIT_V(0);
    PG8_BAR;
#undef PG8_SA
#undef PG8_SB
#undef PG8_STAGE
#undef PG8_LDA
#undef PG8_LDB
#undef PG8_MMA
#undef PG8_WAIT_V
#undef PG8_WAIT_L
#undef PG8_BAR
#undef PG8_SCHED
}
}

struct DenseSched {
    const bf16_t* A; const bf16_t* Bt; int K, nM, nN, nwg, G, c;
    __device__ void init(const bf16_t* A_, const bf16_t* Bt_, int M, int N, int K_, int G_, int c_) { A = A_; Bt = Bt_; K = K_; nM = M / 256; nN = N / 256; nwg = nM * nN; G = G_; c = c_; }
    __device__ __forceinline__ bool next(int i, pg8::Unit& u) const {
        const long Lx = (long)i * G + c; if (Lx >= nwg) return false;
        int wgid = (int)Lx; { const int q = nwg / 8, r = nwg % 8, xcd = wgid % 8, off = wgid / 8; wgid = (xcd < r ? xcd * (q + 1) : r * (q + 1) + (xcd - r) * q) + off; }
        const int nig = 8 * nN, gid = wgid / nig, fm = gid * 8, gsz = (nM - fm) < 8 ? (nM - fm) : 8;
        u.pm = fm + ((wgid % nig) % gsz); u.pn = (wgid % nig) / gsz; u.e = 0; u.cnt = 0;
        u.A = (const char*)A + (size_t)u.pm * 256 * K * 2; u.B = (const char*)Bt + (size_t)u.pn * 256 * K * 2; return true;
    }
    __device__ __forceinline__ void aoff(const pg8::Unit&, int, unsigned (&)[2][2]) const {}
};
struct MoeSched {
    const bf16_t* A; const bf16_t* Bt; size_t bstride;
    const int* ltok;
    LAS int* tp;
    int K, G, c, total;
    __device__ void init(const int* cnt_, const bf16_t* A_, const bf16_t* Bt_, size_t bstride_, const int* ltok_, int K_, int G_, int c_, LAS int* lds_tab, int tid) {
        A = A_; Bt = Bt_; bstride = bstride_; ltok = ltok_; K = K_; G = G_; c = (G_ % 8 == 0) ? (c_ & 7) * (G_ >> 3) + (c_ >> 3) : c_;
        tp = lds_tab;
        __syncthreads();
        if (tid < 32) tp[64 + tid] = cnt_[tid];
        __syncthreads();
        if (tid == 0) { int t = 0; for (int e = 0; e < NEXP; ++e) { tp[e] = t; t += (tp[64 + e] + 255) >> 8; } tp[32] = t; }
        __syncthreads();
        total = __builtin_amdgcn_readfirstlane(tp[32]);
    }
    __device__ __forceinline__ bool next(int i, pg8::Unit& u) const {
        const long Lx = (long)i * G + c; if (Lx >= (long)total * 4) return false;
        const int ti = (int)(Lx >> 2); u.pn = (int)(Lx & 3);
        int ln; asm volatile("v_mbcnt_lo_u32_b32 %0, -1, 0\n\tv_mbcnt_hi_u32_b32 %0, -1, %0" : "=v"(ln));
        const int l5 = ln & 31; const int lo = tp[l5], hi = tp[l5 + 1];
        const unsigned long long mask = __builtin_amdgcn_ballot_w64(lo <= ti && ti < hi);
        const int e = __builtin_amdgcn_readfirstlane((int)__builtin_ctzll(mask) & 31);
        const int base = __builtin_amdgcn_readfirstlane(tp[e]), ce = __builtin_amdgcn_readfirstlane(tp[64 + e]);
        u.e = e; u.pm = ti; u.cnt = ce - (ti - base) * 256;
        u.A = ltok ? (const char*)A : (const char*)A + (size_t)ti * 256 * K * 2;
        u.B = (const char*)(Bt + (size_t)e * bstride) + (size_t)u.pn * 256 * K * 2;
        u.pm = ti | ((ti - base) << 16);
        return true;
    }
    __device__ __forceinline__ void aoff(const pg8::Unit& u, int tid, unsigned (&v)[2][2]) const {
        const int lt = u.pm >> 16; int Rr[2], Cc[2]; pg8::stage_rc(tid * 16, Rr[0], Cc[0]); pg8::stage_rc(tid * 16 + 8192, Rr[1], Cc[1]);
        int tk[2][2];
#pragma unroll
        for (int h = 0; h < 2; ++h)
#pragma unroll
            for (int i = 0; i < 2; ++i) { const int r = h * 128 + Rr[i]; tk[h][i] = ltok[(size_t)u.e * LCAP + lt * 256 + (r < u.cnt ? r : 0)]; }
#pragma unroll
        for (int h = 0; h < 2; ++h)
#pragma unroll
            for (int i = 0; i < 2; ++i) { const int r = h * 128 + Rr[i]; const int tok = (r < u.cnt) ? (tk[h][i] >> 1) : 0; v[h][i] = (unsigned)(tok * K + Cc[i]) * 2u; }
    }
};

struct EpiProj {
    static constexpr bool PERM = true;
    struct Pre { float rs[8]; };
    bf16_t* O; const float* rs;
    __device__ __forceinline__ void prefetch(Pre& pr, const pg8::Unit& u, int wr, int wc, int fr, int fq) const {
        const int row0 = (u.pm & 0xffff) * 256 + wr * 64 + fr;
#pragma unroll
        for (int ai = 0; ai < 2; ++ai)
#pragma unroll
            for (int m = 0; m < 4; ++m) pr.rs[ai * 4 + m] = rs[row0 + ai * 128 + m * 16];
    }
    __device__ __forceinline__ void operator()(const f32x4 (&acc_)[2][2][4][2], const pg8::Unit& u, int wr, int wc, int fr, int fq, const Pre& pr) const {
        const int row0 = u.pm * 256 + wr * 64 + fr, col0 = u.pn * 256 + wc * 32 + 8 * fq;
        f32x4 (&acc)[2][2][4][2] = const_cast<f32x4 (&)[2][2][4][2]>(acc_);
        const bool act = (u.pn == 9);
        if (act) {
#pragma unroll
            for (int ai = 0; ai < 2; ++ai)
#pragma unroll
                for (int m = 0; m < 4; ++m) { const float s = pr.rs[ai * 4 + m];
#pragma unroll
                    for (int n = 0; n < 2; ++n)
#pragma unroll
                        for (int e = 0; e < 4; ++e) { acc[ai][0][m][n][e] = frcp(1.0f + __expf(-acc[ai][0][m][n][e] * s)); acc[ai][1][m][n][e] = ftanh(acc[ai][1][m][n][e] * s); } }
            asm volatile("" ::: "memory");
        }
#pragma unroll
        for (int ai = 0; ai < 2; ++ai)
#pragma unroll
            for (int m = 0; m < 4; ++m) { const int row = row0 + ai * 128 + m * 16; const float s = act ? 1.0f : pr.rs[ai * 4 + m]; bf16_t* rowp = O + (size_t)row * IN_DP + col0;
#pragma unroll
                for (int bj = 0; bj < 2; ++bj) { const f32x4 v0 = acc[ai][bj][m][0] * s, v1 = acc[ai][bj][m][1] * s;
                    u32x4 w; w.x = pg8::cvt_pk_bf16(v0[0], v0[1]); w.y = pg8::cvt_pk_bf16(v0[2], v0[3]); w.z = pg8::cvt_pk_bf16(v1[0], v1[1]); w.w = pg8::cvt_pk_bf16(v1[2], v1[3]);
                    *(u32x4*)(rowp + bj * 128) = w; } }
    }
};
struct EpiRes {
    static constexpr bool PERM = true;
    struct Pre { int dummy; };
    bf16_t* x16;
    __device__ __forceinline__ void prefetch(Pre&, const pg8::Unit&, int, int, int, int) const {}
    __device__ __forceinline__ void operator()(const f32x4 (&acc)[2][2][4][2], const pg8::Unit& u, int wr, int wc, int fr, int fq, const Pre&) const {
        const int row0 = u.pm * 256 + wr * 64 + fr, col0 = u.pn * 256 + wc * 32 + 8 * fq;
#pragma unroll
        for (int ai = 0; ai < 2; ++ai) {
            u32x4 braw[4][2];
#pragma unroll
            for (int m = 0; m < 4; ++m)
#pragma unroll
                for (int bj = 0; bj < 2; ++bj) braw[m][bj] = *(const u32x4*)(x16 + (size_t)(row0 + ai * 128 + m * 16) * D + col0 + bj * 128);
            asm volatile("" ::: "memory");
#pragma unroll
            for (int m = 0; m < 4; ++m) { const size_t off = (size_t)(row0 + ai * 128 + m * 16) * D + col0;
#pragma unroll
                for (int bj = 0; bj < 2; ++bj) { const f32x4 v0 = acc[ai][bj][m][0], v1 = acc[ai][bj][m][1]; float bb[8]; unpack8(braw[m][bj], bb);
                    u32x4 w; w.x = pk2(bb[0] + v0[0], bb[1] + v0[1]); w.y = pk2(bb[2] + v0[2], bb[3] + v0[3]); w.z = pk2(bb[4] + v1[0], bb[5] + v1[1]); w.w = pk2(bb[6] + v1[2], bb[7] + v1[3]);
                    *(u32x4*)(x16 + off + bj * 128) = w; } }
            asm volatile("" ::: "memory");
        }
    }
};
struct EpiMoe1 {
    static constexpr bool PERM = true;
    struct Pre { int dummy; };
    bf16_t* act; const float* lrs;
    __device__ __forceinline__ void prefetch(Pre&, const pg8::Unit&, int, int, int, int) const {}
    __device__ __forceinline__ void operator()(const f32x4 (&acc)[2][2][4][2], const pg8::Unit& u, int wr, int wc, int fr, int fq, const Pre&) const {
        const int ti = u.pm & 0xffff, lt = u.pm >> 16;
        const int r0 = wr * 64 + fr, col0 = u.pn * 256 + wc * 32 + 8 * fq;
        float sv[8];
#pragma unroll
        for (int q = 0; q < 8; ++q) { const int r = r0 + (q >> 2) * 128 + (q & 3) * 16; sv[q] = (r < u.cnt) ? lrs[(size_t)u.e * LCAP + lt * 256 + r] : 0.f; }
        asm volatile("" ::: "memory");
#pragma unroll
        for (int ai = 0; ai < 2; ++ai)
#pragma unroll
            for (int m = 0; m < 4; ++m) { const int r = r0 + ai * 128 + m * 16;
                const float s = sv[ai * 4 + m];
                bf16_t* rowp = act + ((size_t)ti * 256 + r) * FF + (col0 >> 1);
#pragma unroll
                for (int bj = 0; bj < 2; ++bj) { const f32x4 v0 = acc[ai][bj][m][0] * s, v1 = acc[ai][bj][m][1] * s;
                    const float o0 = v0[0] * frcp(1.f + __expf(-v0[0])) * v0[1], o1 = v0[2] * frcp(1.f + __expf(-v0[2])) * v0[3];
                    const float o2 = v1[0] * frcp(1.f + __expf(-v1[0])) * v1[1], o3 = v1[2] * frcp(1.f + __expf(-v1[2])) * v1[3];
                    u32x2 w; w.x = pg8::cvt_pk_bf16(o0, o1); w.y = pg8::cvt_pk_bf16(o2, o3);
                    *(u32x2*)(rowp + bj * 64) = w; } }
    }
};
struct EpiMoe2 {
    static constexpr bool PERM = true;
    struct Pre { int dummy; };
    bf16_t* ybuf; const int* ltok; const float* lgate;
    __device__ __forceinline__ void prefetch(Pre&, const pg8::Unit&, int, int, int, int) const {}
    __device__ __forceinline__ void operator()(const f32x4 (&acc)[2][2][4][2], const pg8::Unit& u, int wr, int wc, int fr, int fq, const Pre&) const {
        const int lt = u.pm >> 16, r0 = wr * 64 + fr, col0 = u.pn * 256 + wc * 32 + 8 * fq;
        int dv[8]; float gv[8];
#pragma unroll
        for (int q = 0; q < 8; ++q) { const int r = r0 + (q >> 2) * 128 + (q & 3) * 16; const bool ok = r < u.cnt;
            const size_t li = (size_t)u.e * LCAP + lt * 256 + (ok ? r : 0); const int d = ltok[li]; const float g = lgate[li];
            dv[q] = ok ? d : -1; gv[q] = g; }
        asm volatile("" ::: "memory");
#pragma unroll
        for (int ai = 0; ai < 2; ++ai)
#pragma unroll
            for (int m = 0; m < 4; ++m) { const int dest = dv[ai * 4 + m];
                if (dest >= 0) { const float g = gv[ai * 4 + m];
                    bf16_t* rowp = ybuf + (size_t)dest * D + col0;
#pragma unroll
                    for (int bj = 0; bj < 2; ++bj) { const f32x4 v0 = acc[ai][bj][m][0] * g, v1 = acc[ai][bj][m][1] * g;
                        u32x4 w; w.x = pg8::cvt_pk_bf16(v0[0], v0[1]); w.y = pg8::cvt_pk_bf16(v0[2], v0[3]); w.z = pg8::cvt_pk_bf16(v1[0], v1[1]); w.w = pg8::cvt_pk_bf16(v1[2], v1[3]);
                        *(u32x4*)(rowp + bj * 128) = w; } } }
    }
};

__device__ __forceinline__ void transpose_item(const float* __restrict__ W, int K, int N, bf16_t* WT, int rmul, int radd, const float* __restrict__ g, LAS float* scr, int item, int lane) {
    const int nblk = N / 32, kb = item / nblk, nb = item % nblk, k0 = 64 * kb, n0 = 32 * nb;
    f32x4 v[8]; float gv[8];
#pragma unroll
    for (int i = 0; i < 8; ++i) { v[i] = *(const f32x4*)(W + (size_t)(k0 + 8 * i + (lane >> 3)) * N + n0 + 4 * (lane & 7)); gv[i] = g ? g[k0 + 8 * i + (lane >> 3)] : 1.0f; }
#pragma unroll
    for (int i = 0; i < 8; ++i) { const int kk = 8 * i + (lane >> 3); *(LAS f32x4*)(scr + kk * 36 + 4 * (lane & 7)) = v[i] * gv[i]; }
    LDS_WAIT(); asm volatile("" ::: "memory");
    const int c = lane & 7;
#pragma unroll
    for (int j = 0; j < 4; ++j) { const int n = (lane >> 3) + 8 * j; const LAS float* s = scr + (8 * c) * 36 + n;
        u32x4 o; o.x = pk2(s[0 * 36], s[1 * 36]); o.y = pk2(s[2 * 36], s[3 * 36]); o.z = pk2(s[4 * 36], s[5 * 36]); o.w = pk2(s[6 * 36], s[7 * 36]);
        *(u32x4*)(WT + (size_t)(rmul * (n0 + n) + radd) * K + k0 + 8 * c) = o; }
    LDS_WAIT(); asm volatile("" ::: "memory");
}

__device__ __forceinline__ void filt_item8(const Params& p, int l, int m0, int lane, float* G) {
    const float* w1 = p.in[5] + l * 33 * 64; const float* w2 = p.in[7] + l * 4096; const float* w3 = p.in[9] + l * 4096; const float* wout = p.in[11] + l * 64 * 512;
    const float b1v = p.in[6][l * 64 + lane], b2v = p.in[8][l * 64 + lane], b3v = p.in[10][l * 64 + lane], fr = p.in[12][l * 64 + lane];
    float hcur[8], acc[8];
    {
#pragma unroll
        for (int j = 0; j < 8; ++j) { const int m = m0 + j; float zl = 0.f;
            const float wv = (6.283185307179586f / 8192.0f) * (float)m; const float fstep = (15.0f - 1e-4f) / 15.0f;
            if (lane == 0) zl = (float)m / 8191.0f; else if (lane <= 16) zl = cosf((1e-4f + (float)(lane - 1) * fstep) * wv); else if (lane <= 32) zl = -sinf((1e-4f + (float)(lane - 17) * fstep) * wv);
            hcur[j] = zl; acc[j] = b1v; }
        float wc[33];
#pragma unroll
        for (int i = 0; i < 33; ++i) wc[i] = w1[i * 64 + lane];
#pragma unroll
        for (int i = 0; i < 33; ++i)
#pragma unroll
            for (int j = 0; j < 8; ++j) acc[j] += rdlane(hcur[j], i) * wc[i];
#pragma unroll
        for (int j = 0; j < 8; ++j) { hcur[j] = sinf(fr * acc[j]); acc[j] = b2v; }
    }
    asm volatile("" ::: "memory");
    {   float wc[64];
#pragma unroll
        for (int i = 0; i < 64; ++i) wc[i] = w2[i * 64 + lane];
#pragma unroll
        for (int i = 0; i < 64; ++i)
#pragma unroll
            for (int j = 0; j < 8; ++j) acc[j] += rdlane(hcur[j], i) * wc[i];
#pragma unroll
        for (int j = 0; j < 8; ++j) { hcur[j] = sinf(fr * acc[j]); acc[j] = b3v; }
    }
    asm volatile("" ::: "memory");
    {   float wc[64];
#pragma unroll
        for (int i = 0; i < 64; ++i) wc[i] = w3[i * 64 + lane];
#pragma unroll
        for (int i = 0; i < 64; ++i)
#pragma unroll
            for (int j = 0; j < 8; ++j) acc[j] += rdlane(hcur[j], i) * wc[i];
#pragma unroll
        for (int j = 0; j < 8; ++j) hcur[j] = sinf(fr * acc[j]);
    }
    asm volatile("" ::: "memory");
    float (&h3)[8] = hcur;
    float o[8][8];
#pragma unroll
    for (int j = 0; j < 8; ++j)
#pragma unroll
        for (int q = 0; q < 8; ++q) o[j][q] = 0.f;
#pragma unroll 2
    for (int i = 0; i < 64; ++i) { float wo[8];
#pragma unroll
        for (int q = 0; q < 8; ++q) wo[q] = wout[i * 512 + q * 64 + lane];
#pragma unroll
        for (int j = 0; j < 8; ++j) { const float hv = rdlane(h3[j], i);
#pragma unroll
            for (int q = 0; q < 8; ++q) o[j][q] += hv * wo[q]; } }
    const float dmin = -3.0701134573253944f, dmax = -15.350567286626972f;
#pragma unroll
    for (int q = 0; q < 8; ++q) { const int n = q * 64 + lane, d = n >> 8, c = n & 255;
        const float delta = fabsf(dmin + (float)c * ((dmax - dmin) / 255.0f));
        float v[8];
#pragma unroll
        for (int j = 0; j < 8; ++j) v[j] = o[j][q] * expf(-((float)(m0 + j) / 8191.0f) * delta);
        float* dst = G + (size_t)c * 16384 + d * 8192 + m0;
        *(f32x4*)dst = (f32x4){v[0], v[1], v[2], v[3]}; *(f32x4*)(dst + 4) = (f32x4){v[4], v[5], v[6], v[7]}; }
}

__device__ __forceinline__ void phase_prologue(const Params& p, LAS unsigned char* lds, int G_, int bid, const int wvx) {
    const int tid = opaque_tid(wvx), lane = tid & 63, wave = tid >> 6;
    const int gw = bid * 8 + wave, NGW = G_ * 8;
    LAS float* scr = (LAS float*)(lds + wave * 16384);
    unsigned char* ws = p.ws;
    for (int it = gw; it < 16 * 108; it += NGW) transpose_item(p.in[2], D, IN_D, (bf16_t*)(ws + OFF_WTIN), 1, 0, p.in[1], scr, it, lane);
    for (int i = bid * NTHREADS + tid; i < 2 * 128 * D / 8; i += G_ * NTHREADS) { const int l = i / (128 * D / 8), r = i % (128 * D / 8);
        *(u32x4*)((bf16_t*)(ws + OFF_WTIN) + (size_t)l * IN_DP * D + (size_t)IN_D * D + (size_t)r * 8) = (u32x4){0u, 0u, 0u, 0u}; }
    for (int i = bid * NTHREADS + tid; i < 2 * 48 * D; i += G_ * NTHREADS) { const int l = i / (48 * D), r = i % (48 * D), o = r / D, k = r % D;
        const float g = p.in[27][l * D + k]; const float w = g * ((o < 4) ? p.in[28][((size_t)l * D + k) * 4 + o] : (o < 36 ? p.in[30][((size_t)l * D + k) * 32 + (o - 4)] : 0.f));
        const unsigned hi = f2bf(w); const float lo = w - bf2f(hi);
        bf16_t* rg = (bf16_t*)(ws + OFF_RGW) + (size_t)l * 2 * 48 * D; rg[o * D + k] = (bf16_t)hi; rg[48 * D + o * D + k] = (bf16_t)f2bf(lo); }
}
__device__ __forceinline__ void filters_all(const Params& p, int nwg, int rank, const int wvx) {
    const int tid = opaque_tid(wvx), lane = tid & 63, wave = tid >> 6;
    for (int it = rank * 8 + wave; it < 2 * (L / 8); it += nwg * 8) { const int l = it / (L / 8), m0 = (it % (L / 8)) * 8; filt_item8(p, l, m0, lane, (float*)(p.ws + OFF_FILT) + (size_t)l * 256 * 16384); }
}

__device__ __forceinline__ void moe_weights_chunk(const Params& p, LAS unsigned char* lds, int l, int chunk, const int wvx) {
    const int tid = opaque_tid(wvx), lane = tid & 63, wave = tid >> 6;
    LAS float* scr = (LAS float*)(lds + wave * 16384);
    bf16_t* W13 = (bf16_t*)(p.ws + OFF_W13T); bf16_t* W2 = (bf16_t*)(p.ws + OFF_W2T);
    const float* g = p.in[27] + l * D;
#pragma unroll 1
    for (int k = 0; k < 8; ++k) { const int it = chunk * 64 + wave * 8 + k;
        if (it >= NEXP * 768) { const int x = it - NEXP * 768;
            if (x < 16 * 108) transpose_item(p.in[2] + (size_t)D * IN_D, D, IN_D, (bf16_t*)(p.ws + OFF_WTIN) + (size_t)IN_DP * D, 1, 0, p.in[1] + D, scr, x, lane);
            else if (x < 16 * 108 + 1024) { const int y = x - 16 * 108, lo = y >> 9; transpose_item(p.in[26] + (size_t)lo * D * D, D, D, (bf16_t*)(p.ws + OFF_WTOUT) + (size_t)lo * D * D, 1, 0, nullptr, scr, y & 511, lane); }
            continue; }
        const int e = it / 768, r = it % 768;
        if (r < 256) transpose_item(p.in[32] + ((size_t)l * NEXP + e) * D * FF, D, FF, W13 + (size_t)e * 1024 * D, 2, 0, g, scr, r, lane);
        else if (r < 512) transpose_item(p.in[33] + ((size_t)l * NEXP + e) * D * FF, D, FF, W13 + (size_t)e * 1024 * D, 2, 1, g, scr, r - 256, lane);
        else transpose_item(p.in[34] + ((size_t)l * NEXP + e) * FF * D, FF, D, W2 + (size_t)e * D * FF, 1, 0, nullptr, scr, r - 512, lane); }
}
__device__ __forceinline__ void phase_rownorm(const float* x, bf16_t* xb, float* rs, int G_, int bid, const int wvx) {
    const int tid = opaque_tid(wvx), lane = tid & 63, wave = tid >> 6;
    for (int row = bid * 8 + wave; row < NT; row += G_ * 8) {
        const f32x4* xr = (const f32x4*)(x + (size_t)row * D) + lane; f32x4 v[4]; float s = 0.f;
#pragma unroll
        for (int j = 0; j < 4; ++j) { v[j] = xr[64 * j]; s += (v[j].x * v[j].x + v[j].y * v[j].y) + (v[j].z * v[j].z + v[j].w * v[j].w); }
        s = wave_sum(s);
        if (lane == 0) rs[row] = 1.0f / sqrtf(s * (1.0f / D) + NORM_EPS);
        u32x2* o = (u32x2*)(xb + (size_t)row * D) + lane;
#pragma unroll
        for (int j = 0; j < 4; ++j) o[64 * j] = (u32x2){pk2(v[j].x, v[j].y), pk2(v[j].z, v[j].w)};
    }
}

__device__ __forceinline__ void load8(const bf16_t* p, bool ok, float* f) { if (ok) { unpack8(*(const u32x4*)p, f); } else {
#pragma unroll
    for (int j = 0; j < 8; ++j) f[j] = 0.f; } }

__device__ __forceinline__ void hy_pre_unit(const Params& p, LAS unsigned char* lds, int l, int unit, const int wvx) {
    const int tid = opaque_tid(wvx);
    const int ct = unit & 3, tt = (unit >> 2) & 127, b = unit >> 9;
    const bf16_t* proj = (const bf16_t*)(p.ws + OFF_PROJ);
    bf16_t* zT = (bf16_t*)(p.ws + OFF_ZT);
    const float* cw = p.in[3] + l * 3 * 768; const float* cb = p.in[4] + l * 768;
    LAS bf16_t* tile = (LAS bf16_t*)lds;
    {
        const int tl = tid >> 3, c8 = (tid & 7) * 8, t = tt * 64 + tl, c = ct * 64 + c8;
        const bf16_t* row = proj + ((size_t)b * L + t) * IN_DP;
        float x1[3][8], vv[3][8];
        load8(row - IN_DP + C_HX1 + c, t > 0, x1[0]); load8(row + C_HX1 + c, true, x1[1]); load8(row + IN_DP + C_HX1 + c, t < L - 1, x1[2]);
        load8(row - IN_DP + C_HV + c, t > 0, vv[0]); load8(row + C_HV + c, true, vv[1]); load8(row + IN_DP + C_HV + c, t < L - 1, vv[2]);
#pragma unroll
        for (int j = 0; j < 8; ++j) { const int c1 = C_HX1 + c + j, c2 = C_HV + c + j;
            const float a = x1[0][j] * cw[c1] + x1[1][j] * cw[768 + c1] + x1[2][j] * cw[1536 + c1] + cb[c1];
            const float v = vv[0][j] * cw[c2] + vv[1][j] * cw[768 + c2] + vv[2][j] * cw[1536 + c2] + cb[c2];
            tile[(c8 + j) * 72 + tl] = (bf16_t)f2bf(a * v); }
    }
    __syncthreads();
    {
        const int cl = tid >> 3, seg = tid & 7;
        const u32x4 w = *(const LAS u32x4*)(tile + cl * 72 + seg * 8);
        *(u32x4*)(zT + ((size_t)(ct * 64 + cl) * NB + b) * L + tt * 64 + seg * 8) = w;
    }
    __syncthreads();
}

typedef float f32x16 __attribute__((ext_vector_type(16)));
__device__ __forceinline__ void hy_conv_unit(const Params& p, LAS unsigned char* lds, int l, int c, const int wvx) {
    const int tid = opaque_tid(wvx), lane = tid & 63, wave = __builtin_amdgcn_readfirstlane(tid >> 6);
    const float* G = (const float*)(p.ws + OFF_FILT) + ((size_t)l * 256 + c) * 16384;
    const bf16_t* zT = (const bf16_t*)(p.ws + OFF_ZT) + (size_t)c * NB * L;
    float* yT = (float*)(p.ws + OFF_YT) + (size_t)c * NB * L;
    LAS bf16_t* Re = (LAS bf16_t*)lds; LAS bf16_t* Ro = Re + 16384;
    LAS unsigned char* Zs = lds + 65536;
    constexpr int ZB = 8976;
    LAS float* red = (LAS float*)(lds + 65536 + 8 * ZB);
    __syncthreads();
    float ss = 0.f; const float GF0 = G[8192];
#pragma unroll 1
    for (int i0 = 0; i0 < 16384; i0 += 8 * NTHREADS) { float gq[8];
#pragma unroll
        for (int k = 0; k < 8; ++k) gq[k] = G[i0 + k * NTHREADS + tid];
#pragma unroll
        for (int k = 0; k < 8; ++k) { const int i = i0 + k * NTHREADS + tid; const float g = gq[k]; ss += g * g;
            if (i == 8192) { Ro[16383] = 0; Re[0] = 0; }
            else { const int dl = (i < 8192) ? i : (8192 - i); const bf16_t bv = (bf16_t)f2bf(i == 0 ? g + GF0 : g); Re[8192 - dl] = bv; Ro[8191 - dl] = bv; } } }
    ss = wave_sum(ss); if (lane == 0) red[wave] = ss;
    f32x16 acc[2][4];
#pragma unroll
    for (int mt = 0; mt < 2; ++mt)
#pragma unroll
        for (int i = 0; i < 4; ++i)
#pragma unroll
            for (int e = 0; e < 16; ++e) acc[mt][i][e] = 0.f;
    const int r = lane & 31, hh = lane >> 5;
#pragma unroll 1
    for (int h = 0; h < 2; ++h) {
        __syncthreads();
        { u32x4 zq[9];
#pragma unroll
          for (int k = 0; k < 9; ++k) { const int q = tid + k * NTHREADS; const int ch = q & 7, Jp = (q >> 3) % 70, b = (q >> 3) / 70; const int J = 64 * h + Jp - 3;
            zq[k] = (u32x4){0u, 0u, 0u, 0u}; if (q < 4480 && Jp >= 3 && Jp < 67) zq[k] = *(const u32x4*)(zT + (size_t)b * L + J * 64 + ch * 8); }
#pragma unroll
          for (int k = 0; k < 9; ++k) { const int q = tid + k * NTHREADS; const int ch = q & 7, Jp = (q >> 3) % 70, b = (q >> 3) / 70;
            if (q < 4480) *(LAS u32x4*)(Zs + b * ZB + Jp * 128 + ch * 16) = zq[k]; } }
        __syncthreads();
        int d_hi = 16 * wave + 15 - 64 * h, d_lo = 16 * wave - 64 * h - 63; d_hi = d_hi > 127 ? 127 : d_hi; d_lo = d_lo < -127 ? -127 : d_lo;
#pragma unroll 1
        for (int d = d_lo; d <= d_hi; ++d) {
            const int J0b = 16 * wave - d;
            const int aelem = 8192 + 8 * hh - r - (r & 1) - 64 * d - 32;
            const LAS unsigned* ap = (const LAS unsigned*)(lds + (r & 1) * 32768 + aelem * 2);
            bf16x8 Af[2][4];
#pragma unroll
            for (int mt = 0; mt < 2; ++mt)
#pragma unroll
                for (int ks = 0; ks < 4; ++ks) { const LAS unsigned* q = ap + (16 * ks + 32 * (1 - mt)) / 2; const u32x4 t = (u32x4){q[0], q[1], q[2], q[3]}; Af[mt][ks] = __builtin_bit_cast(bf16x8, t); }
            const LAS unsigned char* bp = Zs + (r & 7) * ZB + ((r >> 3) + J0b - 64 * h + 3) * 128 + hh * 16;
#pragma unroll
            for (int i = 0; i < 4; ++i) { const int J0 = J0b + 4 * i;
                if (J0 + 3 >= 64 * h && J0 <= 64 * h + 63) {
                    bf16x8 Bf[4];
#pragma unroll
                    for (int ks = 0; ks < 4; ++ks) Bf[ks] = *(const LAS bf16x8*)(bp + i * 512 + ks * 32);
#pragma unroll
                    for (int ks = 0; ks < 4; ++ks)
#pragma unroll
                        for (int mt = 0; mt < 2; ++mt) acc[mt][i] = __builtin_amdgcn_mfma_f32_32x32x16_bf16(Af[mt][ks], Bf[ks], acc[mt][i], 0, 0, 0);
                } }
        }
    }
    float tot = 0.f;
#pragma unroll
    for (int w = 0; w < 8; ++w) tot += red[w];
    const float scale = 1.0f / sqrtf(tot + 1e-6f);
#pragma unroll
    for (int mt = 0; mt < 2; ++mt)
#pragma unroll
        for (int i = 0; i < 4; ++i)
#pragma unroll
            for (int g = 0; g < 4; ++g) { const int t = 64 * (16 * wave + 4 * i + (r >> 3)) + 32 * mt + 8 * g + 4 * hh;
                const f32x4 v = (f32x4){acc[mt][i][4 * g] * scale, acc[mt][i][4 * g + 1] * scale, acc[mt][i][4 * g + 2] * scale, acc[mt][i][4 * g + 3] * scale};
                *(f32x4*)(yT + (size_t)(r & 7) * L + t) = v; }
    __syncthreads();
}

__device__ __forceinline__ void hy_post_unit(const Params& p, LAS unsigned char* lds, int l, int unit, const int wvx) {
    const int tid = opaque_tid(wvx);
    const int ct = unit & 3, tt = (unit >> 2) & 127, b = unit >> 9;
    const bf16_t* proj = (const bf16_t*)(p.ws + OFF_PROJ);
    const bf16_t* zT = (const bf16_t*)(p.ws + OFF_ZT);
    const float* yT = (const float*)(p.ws + OFF_YT);
    bf16_t* mix = (bf16_t*)(p.ws + OFF_MIX);
    const float* cw = p.in[3] + l * 3 * 768; const float* cb = p.in[4] + l * 768; const float* skip = p.in[13] + l * 256;
    LAS float* tile = (LAS float*)lds;
    {
        const int cl = tid >> 3, seg = tid & 7, c = ct * 64 + cl;
        const size_t off = ((size_t)c * NB + b) * L + tt * 64 + seg * 8;
        float z[8]; unpack8(*(const u32x4*)(zT + off), z);
        const f32x4 y0 = *(const f32x4*)(yT + off), y1 = *(const f32x4*)(yT + off + 4);
        const float sk = skip[c];
        tile[cl * 65 + seg * 8 + 0] = y0.x + z[0] * sk; tile[cl * 65 + seg * 8 + 1] = y0.y + z[1] * sk; tile[cl * 65 + seg * 8 + 2] = y0.z + z[2] * sk; tile[cl * 65 + seg * 8 + 3] = y0.w + z[3] * sk;
        tile[cl * 65 + seg * 8 + 4] = y1.x + z[4] * sk; tile[cl * 65 + seg * 8 + 5] = y1.y + z[5] * sk; tile[cl * 65 + seg * 8 + 6] = y1.z + z[6] * sk; tile[cl * 65 + seg * 8 + 7] = y1.w + z[7] * sk;
    }
    __syncthreads();
    {
        const int tl = tid >> 3, c8 = (tid & 7) * 8, t = tt * 64 + tl, c = ct * 64 + c8;
        const bf16_t* row = proj + ((size_t)b * L + t) * IN_DP;
        float x0[3][8];
        load8(row - IN_DP + C_HX0 + c, t > 0, x0[0]); load8(row + C_HX0 + c, true, x0[1]); load8(row + IN_DP + C_HX0 + c, t < L - 1, x0[2]);
        float o[8];
#pragma unroll
        for (int j = 0; j < 8; ++j) { const int c0 = c + j; const float a = x0[0][j] * cw[c0] + x0[1][j] * cw[768 + c0] + x0[2][j] * cw[1536 + c0] + cb[c0];
            o[j] = a * tile[(c8 + j) * 65 + tl]; }
        u32x4 w; w.x = pk2(o[0], o[1]); w.y = pk2(o[2], o[3]); w.z = pk2(o[4], o[5]); w.w = pk2(o[6], o[7]);
        *(u32x4*)(mix + ((size_t)b * L + t) * D + c) = w;
    }
    __syncthreads();
}


__device__ __forceinline__ void hy_pre_unit4(const Params& p, LAS unsigned char* lds, int l, int unit, const int wvx) {
    const int tid = opaque_tid(wvx);
    const int tt = unit & 127, b = unit >> 7;
    const bf16_t* proj = (const bf16_t*)(p.ws + OFF_PROJ);
    bf16_t* zT = (bf16_t*)(p.ws + OFF_ZT);
    const float* cw = p.in[3] + l * 3 * 768; const float* cb = p.in[4] + l * 768;
    LAS bf16_t* tile = (LAS bf16_t*)lds;
    const int tl = tid >> 3, c8 = (tid & 7) * 8, t = tt * 64 + tl;
    const bf16_t* row = proj + ((size_t)b * L + t) * IN_DP;
    const bool hp = t > 0, hn = t < L - 1;
    u32x4 rx[4][3], rv[4][3];
#pragma unroll
    for (int ct = 0; ct < 4; ++ct) { const int c = ct * 64 + c8;
        rx[ct][0] = *(const u32x4*)(row + (hp ? -IN_DP : 0) + C_HX1 + c); rx[ct][1] = *(const u32x4*)(row + C_HX1 + c); rx[ct][2] = *(const u32x4*)(row + (hn ? IN_DP : 0) + C_HX1 + c);
        rv[ct][0] = *(const u32x4*)(row + (hp ? -IN_DP : 0) + C_HV + c); rv[ct][1] = *(const u32x4*)(row + C_HV + c); rv[ct][2] = *(const u32x4*)(row + (hn ? IN_DP : 0) + C_HV + c); }
    const float mp = hp ? 1.f : 0.f, mn = hn ? 1.f : 0.f;
#pragma unroll
    for (int ct = 0; ct < 4; ++ct) { const int c = ct * 64 + c8;
        float x1[3][8], vv[3][8]; unpack8(rx[ct][0], x1[0]); unpack8(rx[ct][1], x1[1]); unpack8(rx[ct][2], x1[2]); unpack8(rv[ct][0], vv[0]); unpack8(rv[ct][1], vv[1]); unpack8(rv[ct][2], vv[2]);
        float wa[3][8], wb[3][8], ba[8], bb[8];
#pragma unroll
        for (int k = 0; k < 3; ++k) { const f32x4 a0 = *(const f32x4*)(cw + k * 768 + C_HX1 + c), a1 = *(const f32x4*)(cw + k * 768 + C_HX1 + c + 4), b0 = *(const f32x4*)(cw + k * 768 + C_HV + c), b1 = *(const f32x4*)(cw + k * 768 + C_HV + c + 4);
            wa[k][0] = a0.x; wa[k][1] = a0.y; wa[k][2] = a0.z; wa[k][3] = a0.w; wa[k][4] = a1.x; wa[k][5] = a1.y; wa[k][6] = a1.z; wa[k][7] = a1.w;
            wb[k][0] = b0.x; wb[k][1] = b0.y; wb[k][2] = b0.z; wb[k][3] = b0.w; wb[k][4] = b1.x; wb[k][5] = b1.y; wb[k][6] = b1.z; wb[k][7] = b1.w; }
        { const f32x4 a0 = *(const f32x4*)(cb + C_HX1 + c), a1 = *(const f32x4*)(cb + C_HX1 + c + 4), b0 = *(const f32x4*)(cb + C_HV + c), b1 = *(const f32x4*)(cb + C_HV + c + 4);
            ba[0] = a0.x; ba[1] = a0.y; ba[2] = a0.z; ba[3] = a0.w; ba[4] = a1.x; ba[5] = a1.y; ba[6] = a1.z; ba[7] = a1.w; bb[0] = b0.x; bb[1] = b0.y; bb[2] = b0.z; bb[3] = b0.w; bb[4] = b1.x; bb[5] = b1.y; bb[6] = b1.z; bb[7] = b1.w; }
#pragma unroll
        for (int j = 0; j < 8; ++j) {
            const float a = mp * x1[0][j] * wa[0][j] + x1[1][j] * wa[1][j] + mn * x1[2][j] * wa[2][j] + ba[j];
            const float v = mp * vv[0][j] * wb[0][j] + vv[1][j] * wb[1][j] + mn * vv[2][j] * wb[2][j] + bb[j];
            tile[(c + j) * 72 + tl] = (bf16_t)f2bf(a * v); } }
    __syncthreads();
#pragma unroll
    for (int ct = 0; ct < 4; ++ct) { const int cl = ct * 64 + (tid >> 3), seg = tid & 7;
        const u32x4 w = *(const LAS u32x4*)(tile + cl * 72 + seg * 8);
        *(u32x4*)(zT + ((size_t)cl * NB + b) * L + tt * 64 + seg * 8) = w; }
    __syncthreads();
}
__device__ __forceinline__ void hy_post_unit4(const Params& p, LAS unsigned char* lds, int l, int unit, const int wvx) {
    const int tid = opaque_tid(wvx);
    const int tt = unit & 127, b = unit >> 7;
    const bf16_t* proj = (const bf16_t*)(p.ws + OFF_PROJ);
    const bf16_t* zT = (const bf16_t*)(p.ws + OFF_ZT);
    const float* yT = (const float*)(p.ws + OFF_YT);
    bf16_t* mix = (bf16_t*)(p.ws + OFF_MIX);
    const float* cw = p.in[3] + l * 3 * 768; const float* cb = p.in[4] + l * 768; const float* skip = p.in[13] + l * 256;
    LAS float* tile = (LAS float*)lds;
    {
        u32x4 zq[4]; f32x4 y0q[4], y1q[4]; float skq[4];
#pragma unroll
        for (int ct = 0; ct < 4; ++ct) { const int c = ct * 64 + (tid >> 3), seg = tid & 7; const size_t off = ((size_t)c * NB + b) * L + tt * 64 + seg * 8;
            zq[ct] = *(const u32x4*)(zT + off); y0q[ct] = *(const f32x4*)(yT + off); y1q[ct] = *(const f32x4*)(yT + off + 4); skq[ct] = skip[c]; }
#pragma unroll
        for (int ct = 0; ct < 4; ++ct) { const int cl = ct * 64 + (tid >> 3), seg = tid & 7; float z[8]; unpack8(zq[ct], z); const float sk = skq[ct]; LAS float* tp = tile + cl * 65 + seg * 8;
            tp[0] = y0q[ct].x + z[0] * sk; tp[1] = y0q[ct].y + z[1] * sk; tp[2] = y0q[ct].z + z[2] * sk; tp[3] = y0q[ct].w + z[3] * sk;
            tp[4] = y1q[ct].x + z[4] * sk; tp[5] = y1q[ct].y + z[5] * sk; tp[6] = y1q[ct].z + z[6] * sk; tp[7] = y1q[ct].w + z[7] * sk; }
    }
    __syncthreads();
    {
        const int tl = tid >> 3, c8 = (tid & 7) * 8, t = tt * 64 + tl;
        const bf16_t* row = proj + ((size_t)b * L + t) * IN_DP;
        const bool hp = t > 0, hn = t < L - 1; const float mp = hp ? 1.f : 0.f, mn = hn ? 1.f : 0.f;
        u32x4 r0[4], r1[4], r2[4];
#pragma unroll
        for (int ct = 0; ct < 4; ++ct) { const int c = ct * 64 + c8; r0[ct] = *(const u32x4*)(row + (hp ? -IN_DP : 0) + C_HX0 + c); r1[ct] = *(const u32x4*)(row + C_HX0 + c); r2[ct] = *(const u32x4*)(row + (hn ? IN_DP : 0) + C_HX0 + c); }
#pragma unroll
        for (int ct = 0; ct < 4; ++ct) { const int c = ct * 64 + c8;
            float x0[3][8]; unpack8(r0[ct], x0[0]); unpack8(r1[ct], x0[1]); unpack8(r2[ct], x0[2]);
            float o[8];
#pragma unroll
            for (int j = 0; j < 8; ++j) { const int c0 = c + j; const float a = mp * x0[0][j] * cw[c0] + x0[1][j] * cw[768 + c0] + mn * x0[2][j] * cw[1536 + c0] + cb[c0];
                o[j] = a * tile[(c + j) * 65 + tl]; }
            u32x4 w; w.x = pk2(o[0], o[1]); w.y = pk2(o[2], o[3]); w.z = pk2(o[4], o[5]); w.w = pk2(o[6], o[7]);
            *(u32x4*)(mix + ((size_t)b * L + t) * D + c) = w; }
    }
    __syncthreads();
}


namespace rw {
constexpr int MATB = 9216, PITCH = 144;
constexpr int O_W2T = 0, O_A2T = MATB, O_SB = 2 * MATB, O_GBUF = 3 * MATB, O_SLOT = O_GBUF + 16384;
constexpr int O_GC = O_SLOT + 10 * MATB, O_APP = O_GC + 256, O_TPP = O_APP + 5120, O_CT = O_TPP + 2560;
__device__ __forceinline__ constexpr int slot(int k) { return O_SLOT + k * MATB; }
#define MFMA16(a, b, c) __builtin_amdgcn_mfma_f32_16x16x32_bf16((a), (b), (c), 0, 0, 0)
__device__ __forceinline__ f32x4 tile64(const LAS unsigned char* A, const LAS unsigned char* Bt, int rt, int ct, int fr, int fq, f32x4 acc) {
#pragma unroll
    for (int ks = 0; ks < 2; ++ks) { const bf16x8 a = *(const LAS bf16x8*)(A + (16 * rt + fr) * PITCH + ks * 64 + fq * 16); const bf16x8 b = *(const LAS bf16x8*)(Bt + (16 * ct + fr) * PITCH + ks * 64 + fq * 16);
        acc = MFMA16(a, b, acc); }
    return acc;
}
__device__ __forceinline__ unsigned pkbf(float lo, float hi) { return pg8::cvt_pk_bf16(lo, hi); }
}

namespace rw {
typedef short s16x4 __attribute__((ext_vector_type(4)));
__device__ __forceinline__ bf16x8 fragN(const LAS unsigned char* img, int row, int ks, int fq) { return *(const LAS bf16x8*)(img + row * PITCH + ks * 64 + fq * 16); }
__device__ __forceinline__ bf16x8 fragP(const LAS unsigned char* img, int row, int ks, int fq) {
    const u32x2 a = *(const LAS u32x2*)(img + row * PITCH + (32 * ks + 4 * fq) * 2), b = *(const LAS u32x2*)(img + row * PITCH + (32 * ks + 16 + 4 * fq) * 2);
    const u32x4 v = (u32x4){a.x, a.y, b.x, b.y}; return __builtin_bit_cast(bf16x8, v); }
__device__ __forceinline__ bf16x8 fragT(const LAS unsigned char* img, int c0, int ks, int fr, int fq) {
    const LAS unsigned char* q = img + (32 * ks + 4 * fq + (fr >> 2)) * PITCH + (c0 + 4 * (fr & 3)) * 2;
    const s16x4 a = __builtin_amdgcn_ds_read_tr16_b64_v4i16((LAS s16x4*)q), b = __builtin_amdgcn_ds_read_tr16_b64_v4i16((LAS s16x4*)(q + 16 * PITCH));
    return (bf16x8){a[0], a[1], a[2], a[3], b[0], b[1], b[2], b[3]}; }
}

__device__ __forceinline__ void rw_chain_unit(const Params& p, LAS unsigned char* lds, int l, int unit, const int wvx) {
    using namespace rw;
    const int tid = opaque_tid(wvx), wave = __builtin_amdgcn_readfirstlane(tid >> 6);
    const int dir = unit & 1, h = (unit >> 1) & 7, b = unit >> 4;
    const bf16_t* proj = (const bf16_t*)(p.ws + OFF_PROJ);
    bf16_t* Y = (bf16_t*)(p.ws + (dir ? OFF_YB : OFF_YF));
    LAS float* gbuf = (LAS float*)(lds + O_GBUF);
    LAS float* GC = (LAS float*)(lds + O_GC);
    LAS bf16_t* TPP = (LAS bf16_t*)(lds + O_TPP);
    LAS float* CT = (LAS float*)(lds + O_CT);
    float* BON = (float*)(p.ws + OFF_BON) + (size_t)dir * NT * 8;
    __syncthreads();
    {
        const float* w2 = p.in[16] + ((size_t)l * 2 + dir) * 64 * 512 + h * 64; const float* a2 = p.in[18] + ((size_t)l * 2 + dir) * 64 * 512 + h * 64;
        for (int i = tid; i < 4096; i += NTHREADS) { const int r = i >> 6, n = i & 63;
            *(LAS bf16_t*)(lds + O_W2T + n * PITCH + r * 2) = (bf16_t)f2bf(w2[r * 512 + n]); *(LAS bf16_t*)(lds + O_A2T + n * PITCH + r * 2) = (bf16_t)f2bf(a2[r * 512 + n]); }
        for (int i = tid; i < MATB / 4; i += NTHREADS) ((LAS unsigned*)(lds + O_SB))[i] = 0u;
        const float* mu = p.in[14] + (size_t)l * 3 * 2 * 512;
        for (int i = tid; i < 704; i += NTHREADS) { const int row = i >> 6, n = i & 63, col = h * 64 + n; float v;
            if (row < 6) v = mu[(row >> 1) * 1024 + (row & 1) * 512 + col];
            else if (row == 6) v = p.in[15][((size_t)l * 2 + dir) * 512 + col];
            else if (row == 7) v = p.in[17][((size_t)l * 2 + dir) * 512 + col];
            else if (row == 8) v = p.in[19][l * 512 + col];
            else if (row == 9) v = p.in[20][l * 512 + col];
            else v = p.in[21][l * 512 + col];
            CT[i] = v; }
    }
    f32x4 Sreg[4];
#pragma unroll
    for (int it = 0; it < 4; ++it) Sreg[it] = (f32x4){0.f, 0.f, 0.f, 0.f};
    const int rt = wave >> 1, chh = wave & 1;
    u32x4 pre[12];
#define issue_loads(CC) do { const int t0n = (dir ? (L / 64 - 1 - (CC)) : (CC)) * 64; int tq_ = tid; asm volatile("" : "+v"(tq_));     \
        _Pragma("unroll") for (int k = 0; k < 4; ++k) { const int q = tq_ + k * NTHREADS; pre[k] = (u32x4){0u, 0u, 0u, 0u}; \
            if (q < 1584) { const int which = q / 528, rem = q - which * 528, rr = rem >> 3, ch = rem & 7; const int t = t0n - 1 + rr; \
                if (t >= 0 && t < L) pre[k] = *(const u32x4*)(proj + ((size_t)b * L + t) * IN_DP + C_RR + which * 512 + h * 64 + ch * 8); } } \
        { const int kq_ = ((tq_ >> 4) & 3) * 8, cbase = (wave < 4 ? C_RW : C_RA) + dir * 64; \
          _Pragma("unroll") for (int r4 = 0; r4 < 4; ++r4) { const int pq_ = 16 * r4 + (tq_ & 15); const int ttn = dir ? (t0n + 63 - pq_) : (t0n + pq_); const bf16_t* row = proj + ((size_t)b * L + ttn) * IN_DP; \
            pre[4 + 2 * r4] = *(const u32x4*)(row + cbase + kq_); pre[5 + 2 * r4] = *(const u32x4*)(row + cbase + 32 + kq_); } } } while (0)
    issue_loads(0);
#pragma unroll 1
    for (int cc = 0; cc < L / 64; ++cc) {
        const int t0 = (dir ? (L / 64 - 1 - cc) : cc) * 64;
        int tq = tid; asm volatile("" : "+v"(tq));
        const int fr = tq & 15, fq = (tq >> 4) & 3, pp = tq >> 3, ig = tq & 7, i0 = ig * 8;
        const int tt = dir ? (t0 + 63 - pp) : (t0 + pp);
        __syncthreads();
#pragma unroll
        for (int k = 0; k < 4; ++k) { const int q = tid + k * NTHREADS; if (q < 1584) { const int which = q / 528, rem = q - which * 528; *(LAS u32x4*)(lds + slot(which) + (rem >> 3) * 128 + (rem & 7) * 16) = pre[k]; } }
        asm volatile("" ::: "memory");
        if (cc > 0) { const int t0p = (dir ? (L / 64 - cc) : (cc - 1)) * 64; const int ttp = dir ? (t0p + 63 - pp) : (t0p + pp);
            *(u32x4*)(Y + ((size_t)b * L + ttp) * 512 + h * 64 + i0) = *(const LAS u32x4*)(lds + slot(9) + pp * PITCH + ig * 16); }
        if (wave < 4) {
            const float w0n = CT[6 * 64 + 16 * wave + fr];
            const bf16x8 wb0 = fragN(lds + O_W2T, 16 * wave + fr, 0, fq), wb1 = fragN(lds + O_W2T, 16 * wave + fr, 1, fq);
            u32x2 lwp[4];
#pragma unroll
            for (int r4 = 0; r4 < 4; ++r4) { bf16x8 t0_, t1_;
                t0_ = __builtin_bit_cast(bf16x8, pre[4 + 2 * r4]); t1_ = __builtin_bit_cast(bf16x8, pre[5 + 2 * r4]);
                f32x4 wv = (f32x4){0.f, 0.f, 0.f, 0.f}; wv = MFMA16(t0_, wb0, wv); wv = MFMA16(t1_, wb1, wv);
                float lwv[4];
#pragma unroll
                for (int e = 0; e < 4; ++e) lwv[e] = -0.60653066f * frcp(1.0f + __expf(-(wv[e] + w0n)));
                lwp[r4] = (u32x2){pk2(lwv[0], lwv[1]), pk2(lwv[2], lwv[3])}; }
#pragma unroll
            for (int r4 = 0; r4 < 4; ++r4) { f32x4 g = (f32x4){0.f, 0.f, 0.f, 0.f};
#pragma unroll
                for (int ks = 0; ks < 2; ++ks) if (32 * ks <= 16 * r4 + 15) {
                    const int pa = 16 * r4 + fr - 32 * ks - 4 * fq, pb2 = pa - 16;
                    u32x4 lt;
                    lt.x = (pa >= 1 ? 0x3F803F80u : (pa == 0 ? 0x00003F80u : 0u)); lt.y = (pa >= 3 ? 0x3F803F80u : (pa == 2 ? 0x00003F80u : 0u));
                    lt.z = (pb2 >= 1 ? 0x3F803F80u : (pb2 == 0 ? 0x00003F80u : 0u)); lt.w = (pb2 >= 3 ? 0x3F803F80u : (pb2 == 2 ? 0x00003F80u : 0u));
                    const u32x4 bv = (u32x4){lwp[2 * ks].x, lwp[2 * ks].y, lwp[2 * ks + 1].x, lwp[2 * ks + 1].y};
                    g = MFMA16(__builtin_bit_cast(bf16x8, lt), __builtin_bit_cast(bf16x8, bv), g); }
#pragma unroll
                for (int e = 0; e < 4; ++e) gbuf[(16 * r4 + 4 * fq + e) * 64 + 16 * wave + fr] = g[e]; }
        } else {
            const int wq = wave - 4;
            const bf16x8 ab0 = fragN(lds + O_A2T, 16 * wq + fr, 0, fq), ab1 = fragN(lds + O_A2T, 16 * wq + fr, 1, fq);
#pragma unroll
            for (int r4 = 0; r4 < 4; ++r4) { f32x4 av = (f32x4){0.f, 0.f, 0.f, 0.f};
                av = MFMA16(__builtin_bit_cast(bf16x8, pre[4 + 2 * r4]), ab0, av); av = MFMA16(__builtin_bit_cast(bf16x8, pre[5 + 2 * r4]), ab1, av);
#pragma unroll
                for (int e = 0; e < 4; ++e) *(LAS bf16_t*)(lds + slot(5) + (16 * r4 + 4 * fq + e) * PITCH + (16 * wq + fr) * 2) = (bf16_t)f2bf(av[e]); }
        }
        if (cc + 1 < L / 64) issue_loads(cc + 1);
        __syncthreads();
        {
            const int rr = tt - t0 + 1;
#define LD2(dst, ptr) do { const f32x4 _a = *(const LAS f32x4*)(ptr), _b = *(const LAS f32x4*)((ptr) + 4); dst[0] = (f32x2){_a.x, _a.y}; dst[1] = (f32x2){_a.z, _a.w}; dst[2] = (f32x2){_b.x, _b.y}; dst[3] = (f32x2){_b.z, _b.w}; } while (0)
#define UP2(dst, wsrc_) do { const u32x4 _w = (wsrc_); dst[0] = (f32x2){bf2f(_w.x & 0xffffu), __uint_as_float(_w.x & 0xffff0000u)}; dst[1] = (f32x2){bf2f(_w.y & 0xffffu), __uint_as_float(_w.y & 0xffff0000u)}; \
                         dst[2] = (f32x2){bf2f(_w.z & 0xffffu), __uint_as_float(_w.z & 0xffff0000u)}; dst[3] = (f32x2){bf2f(_w.w & 0xffffu), __uint_as_float(_w.w & 0xffff0000u)}; } while (0)
#define TSHIFT(dst, sl, c0row) do { f32x2 xp[4], xc[4], xn[4], m0[4], m1[4]; \
                UP2(xp, *(const LAS u32x4*)(lds + slot(sl) + (rr - 1) * 128 + ig * 16)); UP2(xc, *(const LAS u32x4*)(lds + slot(sl) + rr * 128 + ig * 16)); UP2(xn, *(const LAS u32x4*)(lds + slot(sl) + (rr + 1) * 128 + ig * 16)); \
                LD2(m0, CT + (c0row) * 64 + i0); LD2(m1, CT + ((c0row) + 1) * 64 + i0); \
                _Pragma("unroll") for (int j2 = 0; j2 < 4; ++j2) dst[j2] = xc[j2] + m0[j2] * (xp[j2] - xc[j2]) + m1[j2] * (xn[j2] - xc[j2]); } while (0)
#define PK4(v) ((u32x4){pk2(v[0].x, v[0].y), pk2(v[1].x, v[1].y), pk2(v[2].x, v[2].y), pk2(v[3].x, v[3].y)})
            f32x2 r2[4], v2[4], k2[4], a2v[4], kd2[4], kkr2[4], gi2[4], ge2[4];
            LD2(gi2, gbuf + pp * 64 + i0);
            LD2(ge2, gbuf + (pp > 0 ? pp - 1 : 0) * 64 + i0);
            if (pp == 0) { ge2[0] = (f32x2){0.f, 0.f}; ge2[1] = ge2[0]; ge2[2] = ge2[0]; ge2[3] = ge2[0]; }
            TSHIFT(r2, 0, 0);
            TSHIFT(v2, 2, 4);
            *(LAS u32x4*)(lds + slot(6) + pp * PITCH + ig * 16) = PK4(v2);
            {   f32x2 ap[4], c7[4];
                UP2(ap, *(const LAS u32x4*)(lds + slot(5) + pp * PITCH + ig * 16)); LD2(c7, CT + 7 * 64 + i0);
#pragma unroll
                for (int j2 = 0; j2 < 4; ++j2) { const f32x2 araw = ap[j2] + c7[j2]; a2v[j2] = (f32x2){frcp(1.0f + __expf(-araw.x)), frcp(1.0f + __expf(-araw.y))}; } }
            TSHIFT(k2, 1, 2);
            f32x2 ss2 = (f32x2){0.f, 0.f}, bs2 = ss2;
            {   f32x2 c8[4], c9[4], c10[4]; LD2(c8, CT + 8 * 64 + i0); LD2(c9, CT + 9 * 64 + i0); LD2(c10, CT + 10 * 64 + i0);
#pragma unroll
                for (int j2 = 0; j2 < 4; ++j2) { kkr2[j2] = k2[j2] * c8[j2]; ss2 += kkr2[j2] * kkr2[j2]; kd2[j2] = k2[j2] * (1.0f + (a2v[j2] - 1.0f) * c9[j2]); bs2 += r2[j2] * kd2[j2] * c10[j2]; } }
            const float ss = sum8(ss2.x + ss2.y);
            { const float bs = sum8(bs2.x + bs2.y); if (ig == 0) BON[((size_t)b * 8 + h) * L + tt] = bs; }
            const float rn_ = __builtin_amdgcn_rsqf(fmaxf(ss, 1e-24f));
            f32x2 At[4], Rt[4], Bb[4], Kb[4];
#pragma unroll
            for (int j2 = 0; j2 < 4; ++j2) { const f32x2 kk = kkr2[j2] * rn_;
                const f32x2 ei = (f32x2){__expf(gi2[j2].x), __expf(gi2[j2].y)}, ee = (f32x2){__expf(ge2[j2].x), __expf(ge2[j2].y)}, inv = (f32x2){frcp(ei.x), frcp(ei.y)};
                At[j2] = -kk * ee; Rt[j2] = r2[j2] * ei; Bb[j2] = kk * a2v[j2] * inv; Kb[j2] = kd2[j2] * inv;
                if (pp == 63) { GC[i0 + 2 * j2] = ei.x; GC[i0 + 2 * j2 + 1] = ei.y; } }
            *(LAS u32x4*)(lds + slot(3) + pp * PITCH + ig * 16) = PK4(At);
            *(LAS u32x4*)(lds + slot(4) + pp * PITCH + ig * 16) = PK4(Rt);
            *(LAS u32x4*)(lds + slot(7) + pp * PITCH + ig * 16) = PK4(Bb);
            *(LAS u32x4*)(lds + slot(8) + pp * PITCH + ig * 16) = PK4(Kb);
#undef TSHIFT
#undef PK4
#undef UP2
#undef LD2
        }
        __syncthreads();
        { const bf16x8 at0 = fragN(lds + slot(3), 16 * rt + fr, 0, fq), at1 = fragN(lds + slot(3), 16 * rt + fr, 1, fq), rt0 = fragN(lds + slot(4), 16 * rt + fr, 0, fq), rt1 = fragN(lds + slot(4), 16 * rt + fr, 1, fq);
#pragma unroll
          for (int ct = 0; ct < 2; ++ct) { const int ctt = 2 * chh + ct;
            f32x4 ab = (f32x4){0.f, 0.f, 0.f, 0.f}, ak = ab, rb = ab, rk = ab;
            if (ctt <= rt) {
                const bf16x8 b0 = fragN(lds + slot(7), 16 * ctt + fr, 0, fq), b1 = fragN(lds + slot(7), 16 * ctt + fr, 1, fq), k0 = fragN(lds + slot(8), 16 * ctt + fr, 0, fq), k1 = fragN(lds + slot(8), 16 * ctt + fr, 1, fq);
                ab = MFMA16(at0, b0, ab); ab = MFMA16(at1, b1, ab); ak = MFMA16(at0, k0, ak); ak = MFMA16(at1, k1, ak);
                rb = MFMA16(rt0, b0, rb); rb = MFMA16(rt1, b1, rb); rk = MFMA16(rt0, k0, rk); rk = MFMA16(rt1, k1, rk); }
            float vab[4], vak[4], vrb[4], vrk[4];
#pragma unroll
            for (int e = 0; e < 4; ++e) { const int prow = 16 * rt + 4 * fq + e, jcol = 16 * ctt + fr; const bool st = prow > jcol, inc = prow >= jcol;
                vab[e] = st ? ab[e] : 0.f; vak[e] = st ? ak[e] : 0.f; vrb[e] = inc ? rb[e] : 0.f; vrk[e] = inc ? rk[e] : 0.f; }
            const int off = (16 * ctt + fr) * PITCH + (16 * rt + 4 * fq) * 2;
            *(LAS u32x2*)(lds + O_GBUF + off) = (u32x2){pkbf(vab[0], vab[1]), pkbf(vab[2], vab[3])};
            *(LAS u32x2*)(lds + slot(0) + off) = (u32x2){pkbf(vak[0], vak[1]), pkbf(vak[2], vak[3])};
            *(LAS u32x2*)(lds + slot(1) + off) = (u32x2){pkbf(vrb[0], vrb[1]), pkbf(vrb[2], vrb[3])};
            *(LAS u32x2*)(lds + slot(2) + off) = (u32x2){pkbf(vrk[0], vrk[1]), pkbf(vrk[2], vrk[3])}; } }
        __syncthreads();
        f32x4 accA[4];
        f32x4 accK[4];
#pragma unroll
        for (int q = 0; q < 4; ++q) { accA[q] = (f32x4){0.f, 0.f, 0.f, 0.f}; accK[q] = accA[q]; }
        const int yg = (wave == 4) ? 3 : wave - 5;
        if (wave < 4) {
            const bf16x8 s0 = fragN(lds + O_SB, 16 * wave + fr, 0, fq), s1 = fragN(lds + O_SB, 16 * wave + fr, 1, fq), v0 = fragT(lds + slot(6), 16 * wave, 0, fr, fq), v1 = fragT(lds + slot(6), 16 * wave, 1, fr, fq);
#pragma unroll
            for (int q = 0; q < 4; ++q) { f32x4 a = accA[q];
                a = MFMA16(fragN(lds + slot(3), 16 * q + fr, 0, fq), s0, a); a = MFMA16(fragN(lds + slot(3), 16 * q + fr, 1, fq), s1, a);
                a = MFMA16(fragT(lds + slot(0), 16 * q, 0, fr, fq), v0, a); if (q >= 2) a = MFMA16(fragT(lds + slot(0), 16 * q, 1, fr, fq), v1, a);
                accA[q] = a;
                f32x4 kx = accK[q]; kx = MFMA16(fragT(lds + slot(8), 16 * q, 0, fr, fq), v0, kx); kx = MFMA16(fragT(lds + slot(8), 16 * q, 1, fr, fq), v1, kx); accK[q] = kx;
                asm volatile("" ::: "memory"); }
        } else if (wave == 4) {
            const int pb = fq, j = fr; float T[16];
#pragma unroll
            for (int q = 0; q < 16; ++q) T[q] = (q == j) ? 1.f : 0.f;
#pragma unroll
            for (int sg = 0; sg < 4; ++sg) {
                u32x4 ar[4][2];
#pragma unroll
                for (int r4 = 0; r4 < 4; ++r4) { ar[r4][0] = *(const LAS u32x4*)(lds + O_GBUF + (16 * pb + 4 * sg + r4) * PITCH + 32 * pb); ar[r4][1] = *(const LAS u32x4*)(lds + O_GBUF + (16 * pb + 4 * sg + r4) * PITCH + 32 * pb + 16); }
#pragma unroll
                for (int r4 = 0; r4 < 4; ++r4) { const int s2 = 4 * sg + r4; float av[16]; unpack8(ar[r4][0], av); unpack8(ar[r4][1], av + 8);
#pragma unroll
                    for (int q = s2 + 1; q < 16; ++q) T[q] += av[q] * T[s2]; }
                asm volatile("" ::: "memory");
            }
#pragma unroll
            for (int q = 0; q < 16; ++q) TPP[(pb * 16 + q) * 20 + j] = (bf16_t)f2bf(T[q]);
        }
#define Y_PART() do { const bf16x8 s0 = fragN(lds + O_SB, 16 * yg + fr, 0, fq), s1 = fragN(lds + O_SB, 16 * yg + fr, 1, fq), v0 = fragT(lds + slot(6), 16 * yg, 0, fr, fq), v1 = fragT(lds + slot(6), 16 * yg, 1, fr, fq); \
            _Pragma("unroll") for (int q = 0; q < 4; ++q) { f32x4 a = accA[q]; \
                a = MFMA16(fragN(lds + slot(4), 16 * q + fr, 0, fq), s0, a); a = MFMA16(fragN(lds + slot(4), 16 * q + fr, 1, fq), s1, a); \
                a = MFMA16(fragT(lds + slot(2), 16 * q, 0, fr, fq), v0, a); if (q >= 2) a = MFMA16(fragT(lds + slot(2), 16 * q, 1, fr, fq), v1, a); \
                accA[q] = a; asm volatile("" ::: "memory"); } } while (0)
        if (wave >= 5) Y_PART();
        __syncthreads();
        if (wave < 4) {
            u32x2 Ub[4];
            bf16x8 fa[4]; u32x2 ft[4];
#pragma unroll
            for (int z = 0; z < 4; ++z) { const int pb = (z == 3) ? 3 : z + 1, k2 = (z == 3) ? 1 : 0;
                fa[z] = fragT(lds + O_GBUF, 16 * pb, k2, fr, fq);
                ft[z] = *(const LAS u32x2*)(lds + O_TPP + ((z * 16 + fr) * 20 + 4 * fq) * 2); }
#pragma unroll
            for (int pb = 0; pb < 4; ++pb) {
                f32x4 tmp = accA[pb];
#pragma unroll
                for (int k2 = 0; k2 < 2; ++k2) if (2 * k2 < pb) { const int z = (pb == 3 && k2 == 1) ? 3 : pb - 1;
                    const u32x2 b0 = Ub[2 * k2]; const u32x2 b1 = (2 * k2 + 1 < pb) ? Ub[2 * k2 + 1] : (u32x2){0u, 0u};
                    const u32x4 bv = (u32x4){b0.x, b0.y, b1.x, b1.y};
                    tmp = MFMA16(fa[z], __builtin_bit_cast(bf16x8, bv), tmp); }
                const u32x4 av = (u32x4){ft[pb].x, ft[pb].y, 0u, 0u}, bv = (u32x4){pkbf(tmp[0], tmp[1]), pkbf(tmp[2], tmp[3]), 0u, 0u};
                const f32x4 U = MFMA16(__builtin_bit_cast(bf16x8, av), __builtin_bit_cast(bf16x8, bv), ((f32x4){0.f, 0.f, 0.f, 0.f}));
                Ub[pb] = (u32x2){pkbf(U[0], U[1]), pkbf(U[2], U[3])};
                *(LAS u32x2*)(lds + slot(5) + (16 * wave + fr) * PITCH + (16 * pb + 4 * fq) * 2) = Ub[pb];
            }
        } else if (wave == 4) Y_PART();
#undef Y_PART
        __syncthreads();
        if (wave >= 4) {
            const bf16x8 u0 = fragP(lds + slot(5), 16 * yg + fr, 0, fq), u1 = fragP(lds + slot(5), 16 * yg + fr, 1, fq);
#pragma unroll
            for (int q = 0; q < 4; ++q) { f32x4 a = accA[q];
                a = MFMA16(fragT(lds + slot(1), 16 * q, 0, fr, fq), u0, a); if (q >= 2) a = MFMA16(fragT(lds + slot(1), 16 * q, 1, fr, fq), u1, a);
#pragma unroll
                for (int e = 0; e < 4; ++e) *(LAS bf16_t*)(lds + slot(9) + (16 * q + 4 * fq + e) * PITCH + (16 * yg + fr) * 2) = (bf16_t)f2bf(a[e]); }
        } else {
            const bf16x8 u0 = fragP(lds + slot(5), 16 * wave + fr, 0, fq), u1 = fragP(lds + slot(5), 16 * wave + fr, 1, fq);
#pragma unroll
            for (int it = 0; it < 4; ++it) { f32x4 a = Sreg[it] + accK[it];
                a = MFMA16(fragT(lds + slot(7), 16 * it, 0, fr, fq), u0, a); a = MFMA16(fragT(lds + slot(7), 16 * it, 1, fr, fq), u1, a);
                const f32x4 gc = *(const LAS f32x4*)(GC + 16 * it + 4 * fq);
                a = a * gc; Sreg[it] = a;
                *(LAS u32x2*)(lds + O_SB + (16 * wave + fr) * PITCH + (16 * it + 4 * fq) * 2) = (u32x2){pkbf(a[0], a[1]), pkbf(a[2], a[3])};
                asm volatile("" ::: "memory"); }
        }
    }
    __syncthreads();
    { int tq = tid; asm volatile("" : "+v"(tq)); const int pp = tq >> 3, ig = tq & 7, i0 = ig * 8;
      const int t0p = (dir ? 0 : (L / 64 - 1)) * 64; const int ttp = dir ? (t0p + 63 - pp) : (t0p + pp);
      *(u32x4*)(Y + ((size_t)b * L + ttp) * 512 + h * 64 + i0) = *(const LAS u32x4*)(lds + slot(9) + pp * PITCH + ig * 16); }
    __syncthreads();
#undef issue_loads
}

constexpr int PT = 128;
__device__ __forceinline__ void rw_post_wg(const Params& p, LAS unsigned char* lds, int l, int G_, int bid, const int wvx) {
    const int tid = opaque_tid(wvx), lane = tid & 63, wave = __builtin_amdgcn_readfirstlane(tid >> 6), fr = lane & 15, fq = lane >> 4;
    const int h = bid & 7;
    const bf16_t* proj = (const bf16_t*)(p.ws + OFF_PROJ);
    const bf16_t* YF = (const bf16_t*)(p.ws + OFF_YF); const bf16_t* YB = (const bf16_t*)(p.ws + OFF_YB);
    const float* BONF = (const float*)(p.ws + OFF_BON); const float* BONB = BONF + (size_t)NT * 8;
    bf16_t* mix = (bf16_t*)(p.ws + OFF_MIX);
    constexpr int GP = 272;
    LAS unsigned char* G2T = lds;
    LAS unsigned char* SG = lds + 17408;
    LAS unsigned char* RAWV = lds + 52224;
    LAS unsigned char* GATE = lds + 68864;
    __syncthreads();
    { const float* g2 = p.in[22] + (size_t)l * 128 * 512 + h * 64;
        for (int i = tid; i < 8192; i += NTHREADS) { const int r = i >> 6, n = i & 63; *(LAS bf16_t*)(G2T + n * GP + r * 2) = (bf16_t)f2bf(g2[r * 512 + n]); } }
    const int ig = tid & 7, i0 = ig * 8, col = h * 64 + i0;
    float mv0[8], mv1[8], lnw[8], lnb[8];
#pragma unroll
    for (int j = 0; j < 8; ++j) { mv0[j] = p.in[14][(size_t)l * 3072 + 2 * 1024 + col + j]; mv1[j] = p.in[14][(size_t)l * 3072 + 2 * 1024 + 512 + col + j]; lnw[j] = p.in[23][l * 512 + col + j]; lnb[j] = p.in[24][l * 512 + col + j]; }
#pragma unroll 1
    for (int tile = bid >> 3; tile < NT / PT; tile += G_ >> 3) {
        const int row0 = tile * PT, tb0 = row0 & (L - 1);
        __syncthreads();
        u32x4 gq[4], vq[3]; u32x4 yq[2][2]; float bq[2];
#pragma unroll
        for (int k = 0; k < 4; ++k) { const int q = tid + k * NTHREADS; gq[k] = *(const u32x4*)(proj + (size_t)(row0 + (q >> 4)) * IN_DP + C_RG + (q & 15) * 8); }
#pragma unroll
        for (int k = 0; k < 3; ++k) { const int q = tid + k * NTHREADS; const int rr = q >> 3, ch = q & 7; const int tt = tb0 - 1 + rr; vq[k] = (u32x4){0u, 0u, 0u, 0u};
            if (q < 1040 && tt >= 0 && tt < L) vq[k] = *(const u32x4*)(proj + (size_t)(row0 - 1 + rr) * IN_DP + C_RV + h * 64 + ch * 8); }
#pragma unroll
        for (int sl = 0; sl < 2; ++sl) { const size_t row = (size_t)row0 + (tid >> 3) + 64 * sl; yq[sl][0] = *(const u32x4*)(YF + row * 512 + col); yq[sl][1] = *(const u32x4*)(YB + row * 512 + col);
            const size_t bi = ((size_t)(row >> 13) * 8 + h) * L + (row & (L - 1)); bq[sl] = BONF[bi] + BONB[bi]; }
#pragma unroll
        for (int k = 0; k < 4; ++k) { const int q = tid + k * NTHREADS; const int t = q >> 4, ch = q & 15; *(LAS u32x4*)(SG + t * GP + ch * 16) = gq[k]; }
#pragma unroll
        for (int k = 0; k < 3; ++k) { const int q = tid + k * NTHREADS; if (q < 1040) *(LAS u32x4*)(RAWV + (q >> 3) * 128 + (q & 7) * 16) = vq[k]; }
        __syncthreads();
#pragma unroll
        for (int ct = 0; ct < 4; ++ct) { f32x4 acc = (f32x4){0.f, 0.f, 0.f, 0.f};
#pragma unroll
            for (int ks = 0; ks < 4; ++ks) { const bf16x8 a = *(const LAS bf16x8*)(SG + (16 * wave + fr) * GP + ks * 64 + fq * 16); const bf16x8 b = *(const LAS bf16x8*)(G2T + (16 * ct + fr) * GP + ks * 64 + fq * 16);
                acc = __builtin_amdgcn_mfma_f32_16x16x32_bf16(a, b, acc, 0, 0, 0); }
#pragma unroll
            for (int e = 0; e < 4; ++e) *(LAS bf16_t*)(GATE + (16 * wave + 4 * fq + e) * 144 + (16 * ct + fr) * 2) = (bf16_t)f2bf(acc[e]); }
        __syncthreads();
#pragma unroll
        for (int sl = 0; sl < 2; ++sl) { const int t = (tid >> 3) + 64 * sl; const size_t row = (size_t)row0 + t;
            float vp[8], vc[8], vn[8], gt[8];
            unpack8(*(const LAS u32x4*)(RAWV + t * 128 + ig * 16), vp); unpack8(*(const LAS u32x4*)(RAWV + (t + 1) * 128 + ig * 16), vc); unpack8(*(const LAS u32x4*)(RAWV + (t + 2) * 128 + ig * 16), vn);
            unpack8(*(const LAS u32x4*)(GATE + t * 144 + ig * 16), gt);
            float yf8[8], yb8[8]; unpack8(yq[sl][0], yf8); unpack8(yq[sl][1], yb8);
            const float bon = bq[sl];
            float y[8] = {yf8[0] + yb8[0], yf8[1] + yb8[1], yf8[2] + yb8[2], yf8[3] + yb8[3], yf8[4] + yb8[4], yf8[5] + yb8[5], yf8[6] + yb8[6], yf8[7] + yb8[7]};
            float sm = 0.f;
#pragma unroll
            for (int j = 0; j < 8; ++j) sm += y[j];
            const float mean = sum8(sm) * (1.0f / 64.0f);
            float sq = 0.f;
#pragma unroll
            for (int j = 0; j < 8; ++j) { y[j] -= mean; sq += y[j] * y[j]; }
            const float rstd = __builtin_amdgcn_rsqf(sum8(sq) * (1.0f / 64.0f) + 64e-5f);
            float o[8];
#pragma unroll
            for (int j = 0; j < 8; ++j) { const float v = vc[j] + mv0[j] * (vp[j] - vc[j]) + mv1[j] * (vn[j] - vc[j]); o[j] = (y[j] * rstd * lnw[j] + lnb[j] + bon * v) * gt[j]; }
            u32x4 w; w.x = pk2(o[0], o[1]); w.y = pk2(o[2], o[3]); w.z = pk2(o[4], o[5]); w.w = pk2(o[6], o[7]);
            *(u32x4*)(mix + row * D + 256 + col) = w; }
    }
    __syncthreads();
}

namespace na {
constexpr int O_K = 0, O_V = 65536, O_RPB = 131072, O_MX = 133120, O_QW = 142080;
__device__ __forceinline__ int rowoff(int keycol, int byte) { return keycol * 128 + ((((byte >> 5) ^ keycol) & 3) << 5) + (byte & 31); }
typedef short s16x4 __attribute__((ext_vector_type(4)));
}
__device__ __forceinline__ void na_strip(const Params& p, LAS unsigned char* lds, int l, int strip, const int wvx) {
    using namespace na;
    const int tid = opaque_tid(wvx), lane = tid & 63, wave = __builtin_amdgcn_readfirstlane(tid >> 6), fr = lane & 15, fq = lane >> 4;
    const int b = strip >> 5, h = (strip >> 3) & 3, i0 = (strip & 7) * 16;
    const int g = wave & 3, kh = wave >> 2;
    const bf16_t* proj = (const bf16_t*)(p.ws + OFF_PROJ);
    bf16_t* mix = (bf16_t*)(p.ws + OFF_MIX);
    LAS float* RPB = (LAS float*)(lds + O_RPB);
    LAS unsigned char* MX = lds + O_MX + g * 2240;
    const int j0 = 16 * g, c0 = (g == 0) ? 0 : ((g == 3) ? 32 : 16 * g - 8);
    __syncthreads();
    for (int q = tid; q < 465; q += NTHREADS) RPB[q] = p.in[25][((size_t)l * 4 + h) * 465 + q];
    { int rs = i0 - 4; rs = rs < 0 ? 0 : (rs > 120 ? 120 : rs);
        u32x4 fw[16];
#pragma unroll
        for (int k = 0; k < 16; ++k) { const int q = tid + k * NTHREADS; const int r8 = q >> 10, which = (q >> 9) & 1, col = (q >> 3) & 63, ch = q & 7; const int kr = rs + r8;
            fw[k] = *(const u32x4*)(proj + ((size_t)b * L + kr * 64 + col) * IN_DP + (which ? C_NV : C_NK) + h * 64 + ch * 8); }
#pragma unroll
        for (int k = 0; k < 16; ++k) { const int q = tid + k * NTHREADS; const int r8 = q >> 10, which = (q >> 9) & 1, col = (q >> 3) & 63, ch = q & 7; const int kr = rs + r8;
            *(LAS u32x4*)(lds + (which ? O_V : O_K) + (kr & 7) * 8192 + rowoff(col, 16 * ch)) = fw[k]; } }
    bf16x8 Bq[2];
#pragma unroll
    for (int ks = 0; ks < 2; ++ks) Bq[ks] = *(const bf16x8*)(proj + ((size_t)b * L + i0 * 64 + j0 + fr) * IN_DP + C_NQ + h * 64 + 32 * ks + 8 * fq);
    const int jq = j0 + fr;
    int cs = jq - 8; cs = cs < 0 ? 0 : (cs > 48 ? 48 : cs);
    const u32x4 onesv = (u32x4){0x3F803F80u, 0x3F803F80u, 0x3F803F80u, 0x3F803F80u};
#pragma unroll 1
    for (int i = i0; i < i0 + 16; ++i) {
        int rs = i - 4; rs = rs < 0 ? 0 : (rs > 120 ? 120 : rs);
        int rsn = i + 1 - 4; rsn = rsn < 0 ? 0 : (rsn > 120 ? 120 : rsn);
        const bool more = (i + 1 < i0 + 16), newrow = more && (rsn > rs);
        __syncthreads();
        u32x4 pre0 = (u32x4){0u, 0u, 0u, 0u}, pre1 = pre0; bf16x8 Bqn[2] = {Bq[0], Bq[1]};
        if (newrow) { const int kr = rsn + 7;
            { const int q = tid; const int which = q >> 9, col = (q >> 3) & 63, ch = q & 7; pre0 = *(const u32x4*)(proj + ((size_t)b * L + kr * 64 + col) * IN_DP + (which ? C_NV : C_NK) + h * 64 + ch * 8); }
            { const int q = tid + 512; const int which = q >> 9, col = (q >> 3) & 63, ch = q & 7; pre1 = *(const u32x4*)(proj + ((size_t)b * L + kr * 64 + col) * IN_DP + (which ? C_NV : C_NK) + h * 64 + ch * 8); } }
        if (more) {
#pragma unroll
            for (int ks = 0; ks < 2; ++ks) Bqn[ks] = *(const bf16x8*)(proj + ((size_t)b * L + (i + 1) * 64 + j0 + fr) * IN_DP + C_NQ + h * 64 + 32 * ks + 8 * fq); }
        f32x4 S[4][2]; float mloc = -1e30f;
#pragma unroll
        for (int r4 = 0; r4 < 4; ++r4) { const int krow = rs + 4 * kh + r4, slot = krow & 7, dr = krow - i + 7;
#pragma unroll
            for (int ct = 0; ct < 2; ++ct) { const int keycol = c0 + 16 * ct + fr; f32x4 acc = (f32x4){0.f, 0.f, 0.f, 0.f};
#pragma unroll
                for (int ks = 0; ks < 2; ++ks) { const bf16x8 a = *(const LAS bf16x8*)(lds + O_K + slot * 8192 + rowoff(keycol, 64 * ks + 16 * fq)); acc = __builtin_amdgcn_mfma_f32_16x16x32_bf16(a, Bq[ks], acc, 0, 0, 0); }
#pragma unroll
                for (int e = 0; e < 4; ++e) { const int kc = c0 + 16 * ct + 4 * fq + e; const bool valid = (kc >= cs) && (kc < cs + 16);
                    int dc = kc - jq; dc = dc < -15 ? -15 : (dc > 15 ? 15 : dc); dc += 15;
                    const float sc = valid ? (acc[e] * 0.125f + RPB[dr * 31 + dc]) : -1e30f; acc[e] = sc; mloc = fmaxf(mloc, sc); }
                S[r4][ct] = acc; } }
        { int lid; asm volatile("v_mbcnt_lo_u32_b32 %0, -1, 0\n\tv_mbcnt_hi_u32_b32 %0, -1, %0" : "=v"(lid));
          mloc = fmaxf(mloc, __int_as_float(__builtin_amdgcn_ds_bpermute((lid ^ 16) << 2, __float_as_int(mloc))));
          mloc = fmaxf(mloc, __int_as_float(__builtin_amdgcn_ds_bpermute((lid ^ 32) << 2, __float_as_int(mloc)))); }
        bf16x8 Ap[4];
#pragma unroll
        for (int r4 = 0; r4 < 4; ++r4) { float pv[8];
#pragma unroll
            for (int ct = 0; ct < 2; ++ct)
#pragma unroll
                for (int e = 0; e < 4; ++e) { const float sc = S[r4][ct][e]; pv[ct * 4 + e] = (sc > -1e29f) ? __expf(sc - mloc) : 0.f; }
            const u32x4 w = (u32x4){pk2(pv[0], pv[1]), pk2(pv[2], pv[3]), pk2(pv[4], pv[5]), pk2(pv[6], pv[7])}; Ap[r4] = __builtin_bit_cast(bf16x8, w); }
        f32x4 O[4], Ls = (f32x4){0.f, 0.f, 0.f, 0.f};
#pragma unroll
        for (int dt = 0; dt < 4; ++dt) O[dt] = (f32x4){0.f, 0.f, 0.f, 0.f};
#pragma unroll
        for (int r4 = 0; r4 < 4; ++r4) { const int slot = (rs + 4 * kh + r4) & 7; const int kc0 = c0 + 4 * fq + (fr >> 2), kc1 = kc0 + 16;
            Ls = __builtin_amdgcn_mfma_f32_16x16x32_bf16(Ap[r4], __builtin_bit_cast(bf16x8, onesv), Ls, 0, 0, 0);
#pragma unroll
            for (int dt = 0; dt < 4; ++dt) {
                const s16x4 v0 = __builtin_amdgcn_ds_read_tr16_b64_v4i16((LAS s16x4*)(lds + O_V + slot * 8192 + rowoff(kc0, 32 * dt + 8 * (fr & 3))));
                const s16x4 v1 = __builtin_amdgcn_ds_read_tr16_b64_v4i16((LAS s16x4*)(lds + O_V + slot * 8192 + rowoff(kc1, 32 * dt + 8 * (fr & 3))));
                const bf16x8 bv = (bf16x8){v0[0], v0[1], v0[2], v0[3], v1[0], v1[1], v1[2], v1[3]};
                O[dt] = __builtin_amdgcn_mfma_f32_16x16x32_bf16(Ap[r4], bv, O[dt], 0, 0, 0); } }
        if (fq == 0) *(LAS float*)(MX + kh * 64 + fr * 4) = mloc;
        if (kh == 1) { if (fr == 0) *(LAS f32x4*)(MX + 128 + fq * 16) = Ls;
#pragma unroll
            for (int dt = 0; dt < 4; ++dt)
#pragma unroll
                for (int e = 0; e < 4; ++e) *(LAS bf16_t*)(MX + 192 + (4 * fq + e) * 128 + (16 * dt + fr) * 2) = (bf16_t)f2bf(O[dt][e]); }
        __syncthreads();
        if (newrow) { const int kr = rsn + 7;
            { const int q = tid; const int which = q >> 9, col = (q >> 3) & 63, ch = q & 7; *(LAS u32x4*)(lds + (which ? O_V : O_K) + (kr & 7) * 8192 + rowoff(col, 16 * ch)) = pre0; }
            { const int q = tid + 512; const int which = q >> 9, col = (q >> 3) & 63, ch = q & 7; *(LAS u32x4*)(lds + (which ? O_V : O_K) + (kr & 7) * 8192 + rowoff(col, 16 * ch)) = pre1; } }
        if (kh == 0) {
            const f32x4 m0 = *(const LAS f32x4*)(MX + fq * 16), m1 = *(const LAS f32x4*)(MX + 64 + fq * 16), l1 = *(const LAS f32x4*)(MX + 128 + fq * 16);
#pragma unroll
            for (int e = 0; e < 4; ++e) { const float M = fmaxf(m0[e], m1[e]), a0 = __expf(m0[e] - M), a1 = __expf(m1[e] - M); const float inv = frcp(Ls[e] * a0 + l1[e] * a1);
                const size_t row = (size_t)b * L + i * 64 + j0 + 4 * fq + e;
#pragma unroll
                for (int dt = 0; dt < 4; ++dt) { const float o1 = bf2f(*(const LAS bf16_t*)(MX + 192 + (4 * fq + e) * 128 + (16 * dt + fr) * 2));
                    mix[row * D + 768 + h * 64 + 16 * dt + fr] = (bf16_t)f2bf((O[dt][e] * a0 + o1 * a1) * inv); } }
        }
        Bq[0] = Bqn[0]; Bq[1] = Bqn[1];
    }
    __syncthreads();
}

__device__ __forceinline__ void wg_signal(int* ctr, const bool leader) {
    asm volatile("s_waitcnt vmcnt(0)" ::: "memory");
    __syncthreads();
    if (leader) { __builtin_amdgcn_fence(__ATOMIC_RELEASE, "agent"); asm volatile("s_waitcnt vmcnt(0)" ::: "memory"); __hip_atomic_fetch_add(ctr, 1, __ATOMIC_RELAXED, __HIP_MEMORY_SCOPE_AGENT); }
}
__device__ __forceinline__ void wg_wait(int* ctr, int target, const bool leader) {
    if (leader) { unsigned sp = 0;
        while (__hip_atomic_load(ctr, __ATOMIC_RELAXED, __HIP_MEMORY_SCOPE_AGENT) < target) { __builtin_amdgcn_s_sleep(2); if (++sp > (1u << 24)) break; }
        __builtin_amdgcn_fence(__ATOMIC_ACQUIRE, "agent"); asm volatile("s_waitcnt vmcnt(0)" ::: "memory"); }
    __syncthreads();
}
__device__ __forceinline__ int wg_pop(int* ctr, LAS int* qw, const bool leader) {
    __syncthreads();
    if (leader) *qw = __hip_atomic_fetch_add(ctr, 1, __ATOMIC_RELAXED, __HIP_MEMORY_SCOPE_AGENT);
    __syncthreads();
    return __builtin_amdgcn_readfirstlane(*qw);
}
__device__ __forceinline__ void na_queue(const Params& p, LAS unsigned char* lds, int l, const int wvx) {
    int* ctr = (int*)(p.ws + OFF_CTL) + 16 + l;
    LAS int* qw = (LAS int*)(lds + na::O_QW);
    for (;;) {
        __syncthreads();
        if (opaque_tid(wvx) == 0) *qw = atomicAdd(ctr, 1);
        __syncthreads();
        const int strip = __builtin_amdgcn_readfirstlane(*qw);
        if (strip >= 256) break;
        na_strip(p, lds, l, strip, wvx);
    }
}

__device__ __forceinline__ void phase_router(const Params& p, LAS unsigned char* lds, int l, int G_, int bid, const int wvx) {
    const int tid = opaque_tid(wvx), lane = tid & 63, wave = __builtin_amdgcn_readfirstlane(tid >> 6), fr = lane & 15, fq = lane >> 4;
    const bf16_t* x = (const bf16_t*)(p.ws + OFF_XB); float* rs = (float*)(p.ws + OFF_RS);
    const bf16_t* rgh = (const bf16_t*)(p.ws + OFF_RGW) + (size_t)l * 2 * 48 * D; const bf16_t* rgl = rgh + 48 * D;
    int* cnt = (int*)(p.ws + OFF_CTL) + 64 + l * 64;
    int* ltok = (int*)(p.ws + OFF_LTOK); float* lgate = (float*)(p.ws + OFF_LGATE); float* lrs = (float*)(p.ws + OFF_LRS);
    LAS int* lcnt = (LAS int*)lds;
    LAS int* lbase = lcnt + 32;
    LAS int* se = lbase + 32;
    LAS int* sp = se + 512;
    LAS float* sg = (LAS float*)(sp + 512);
    LAS float* LG = (LAS float*)(lds + 8192);
    LAS float* SQ = LG + 256 * 52;
    const float* bg = p.in[29] + l * 4; const float* be = p.in[31] + l * 32;
    for (int chunk = bid; chunk < NT / 256; chunk += G_) {
        __syncthreads();
        if (tid < 32) lcnt[tid] = 0;
        const int tl0 = wave * 32;
        const bf16_t* xa_p = x + (size_t)(chunk * 256 + tl0 + fr) * D + 8 * fq; const bf16_t* xb_p = xa_p + 16 * D;
        const bf16_t* wh_p = rgh + (size_t)fr * D + 8 * fq; const bf16_t* wl_p = rgl + (size_t)fr * D + 8 * fq;
        f32x4 acc[2][3];
#pragma unroll
        for (int t = 0; t < 2; ++t)
#pragma unroll
            for (int c = 0; c < 3; ++c) acc[t][c] = (f32x4){0.f, 0.f, 0.f, 0.f};
        float ssa = 0.f, ssb = 0.f;
#pragma unroll 2
        for (int ks = 0; ks < 32; ++ks) {
            const u32x4 ar = *(const u32x4*)(xa_p + 32 * ks), br = *(const u32x4*)(xb_p + 32 * ks);
            bf16x8 wh[3], wl[3];
#pragma unroll
            for (int c = 0; c < 3; ++c) { wh[c] = *(const bf16x8*)(wh_p + (size_t)16 * c * D + 32 * ks); wl[c] = *(const bf16x8*)(wl_p + (size_t)16 * c * D + 32 * ks); }
            { float f[8]; unpack8(ar, f);
#pragma unroll
              for (int j = 0; j < 8; ++j) ssa += f[j] * f[j];
              unpack8(br, f);
#pragma unroll
              for (int j = 0; j < 8; ++j) ssb += f[j] * f[j]; }
            const bf16x8 a0 = __builtin_bit_cast(bf16x8, ar), a1 = __builtin_bit_cast(bf16x8, br);
#pragma unroll
            for (int c = 0; c < 3; ++c) {
                acc[0][c] = __builtin_amdgcn_mfma_f32_16x16x32_bf16(a0, wh[c], acc[0][c], 0, 0, 0); acc[0][c] = __builtin_amdgcn_mfma_f32_16x16x32_bf16(a0, wl[c], acc[0][c], 0, 0, 0);
                acc[1][c] = __builtin_amdgcn_mfma_f32_16x16x32_bf16(a1, wh[c], acc[1][c], 0, 0, 0); acc[1][c] = __builtin_amdgcn_mfma_f32_16x16x32_bf16(a1, wl[c], acc[1][c], 0, 0, 0); }
        }
#pragma unroll
        for (int t = 0; t < 2; ++t)
#pragma unroll
            for (int c = 0; c < 3; ++c)
#pragma unroll
                for (int e = 0; e < 4; ++e) LG[(tl0 + 16 * t + 4 * fq + e) * 52 + 16 * c + fr] = acc[t][c][e];
        SQ[(tl0 + fr) * 4 + fq] = ssa; SQ[(tl0 + 16 + fr) * 4 + fq] = ssb;
        __syncthreads();
        if (lane < 32) { const int tl = tl0 + lane, row = chunk * 256 + tl;
            const f32x4 s4 = *(const LAS f32x4*)(SQ + tl * 4);
            const float rr = 1.0f / sqrtf(((s4.x + s4.y) + (s4.z + s4.w)) * (1.0f / D) + NORM_EPS);
            rs[row] = rr; SQ[tl * 4] = rr;
            const LAS float* lg = LG + tl * 52;
            const float g0 = lg[0] * rr + bg[0], g1 = lg[1] * rr + bg[1], g2 = lg[2] * rr + bg[2], g3 = lg[3] * rr + bg[3];
            int gs = 0; float gm = g0; if (g1 > gm) { gm = g1; gs = 1; } if (g2 > gm) { gm = g2; gs = 2; } if (g3 > gm) { gm = g3; gs = 3; }
            const float gprob = 1.0f / (expf(g0 - gm) + expf(g1 - gm) + expf(g2 - gm) + expf(g3 - gm));
            float ev[8];
#pragma unroll
            for (int e = 0; e < 8; ++e) ev[e] = lg[4 + gs * 8 + e] * rr + be[gs * 8 + e];
            int i0 = 0; float v0 = ev[0];
#pragma unroll
            for (int e = 1; e < 8; ++e) if (ev[e] > v0) { v0 = ev[e]; i0 = e; }
            int i1 = -1; float v1 = -3.0e38f;
#pragma unroll
            for (int e = 0; e < 8; ++e) if (e != i0 && ev[e] > v1) { v1 = ev[e]; i1 = e; }
            const float e1 = expf(v1 - v0), den = 1.0f + e1;
            const int ea = gs * 8 + i0, eb = gs * 8 + i1;
            se[tl * 2] = ea; se[tl * 2 + 1] = eb; sg[tl * 2] = gprob / den; sg[tl * 2 + 1] = gprob * e1 / den;
            sp[tl * 2] = atomicAdd((int*)lcnt + ea, 1); sp[tl * 2 + 1] = atomicAdd((int*)lcnt + eb, 1); }
        __syncthreads();
        if (tid < 32) lbase[tid] = atomicAdd(cnt + tid, lcnt[tid]);
        __syncthreads();
        { const int tl = tid >> 1, k = tid & 1, e = se[tid]; const size_t li = (size_t)e * LCAP + lbase[e] + sp[tid];
            ltok[li] = (chunk * 256 + tl) * 2 + k; lgate[li] = sg[tid]; lrs[li] = SQ[tl * 4]; }
    }
    __syncthreads();
}

__device__ __forceinline__ void phase_combine(const Params& p, bool last, int G_, int bid, const int wvx) {
    const int tid = opaque_tid(wvx), lane = tid & 63, wave = tid >> 6;
    float* out = p.out; bf16_t* x16 = (bf16_t*)(p.ws + OFF_XB); float* rs = (float*)(p.ws + OFF_RS);
    const bf16_t* yb = (const bf16_t*)(p.ws + OFF_YBUF);
    const float* gf = p.in[35];
    for (int row = bid * 8 + wave; row < NT; row += G_ * 8) {
        u32x2* xr = (u32x2*)(x16 + (size_t)row * D) + lane; const u32x2* y0 = (const u32x2*)(yb + (size_t)(2 * row) * D) + lane; const u32x2* y1 = (const u32x2*)(yb + (size_t)(2 * row + 1) * D) + lane;
        f32x4 v[4]; float s = 0.f; u32x2 xq[4], aq[4], cq[4];
#pragma unroll
        for (int j = 0; j < 4; ++j) { xq[j] = xr[64 * j]; aq[j] = y0[64 * j]; cq[j] = y1[64 * j]; }
#pragma unroll
        for (int j = 0; j < 4; ++j) { const u32x2 xx = xq[j], a = aq[j], c = cq[j];
            v[j].x = bf2f(xx.x & 0xffffu) + bf2f(a.x & 0xffffu) + bf2f(c.x & 0xffffu); v[j].y = __uint_as_float(xx.x & 0xffff0000u) + __uint_as_float(a.x & 0xffff0000u) + __uint_as_float(c.x & 0xffff0000u);
            v[j].z = bf2f(xx.y & 0xffffu) + bf2f(a.y & 0xffffu) + bf2f(c.y & 0xffffu); v[j].w = __uint_as_float(xx.y & 0xffff0000u) + __uint_as_float(a.y & 0xffff0000u) + __uint_as_float(c.y & 0xffff0000u);
            s += (v[j].x * v[j].x + v[j].y * v[j].y) + (v[j].z * v[j].z + v[j].w * v[j].w); }
        s = wave_sum(s);
        const float rr = 1.0f / sqrtf(s * (1.0f / D) + NORM_EPS);
        if (last) { f32x4* orow = (f32x4*)(out + (size_t)row * D) + lane;
#pragma unroll
            for (int j = 0; j < 4; ++j) { const f32x4 g = ((const f32x4*)gf)[lane + 64 * j]; orow[64 * j] = v[j] * rr * g; }
        } else {
            if (lane == 0) rs[row] = rr;
#pragma unroll
            for (int j = 0; j < 4; ++j) xr[64 * j] = (u32x2){pk2(v[j].x, v[j].y), pk2(v[j].z, v[j].w)};
        }
    }
}

#ifndef PH_MASK
#define PH_MASK 0xFFFFF
#endif
#define PH(k) if (PH_MASK & (1 << (k)))

#define XB_TMO      128
#define XB_XCNT(j)  (256  + 64 * (j))
#define XB_XSUB(j)  (1280 + 64 * (j))
#define XB_XGEN(j)  (2304 + 64 * (j))
#define XB_TOP      3328
#define XB_TOPGEN   3392
#define XCD_BAR_WORDS 3456
#define XB_SPIN_CAP (1u << 22)
__device__ __forceinline__ unsigned xb_ld(unsigned* p)              { return __hip_atomic_load(p, __ATOMIC_RELAXED, __HIP_MEMORY_SCOPE_AGENT); }
__device__ __forceinline__ unsigned xb_add(unsigned* p, unsigned v) { return __hip_atomic_fetch_add(p, v, __ATOMIC_RELAXED, __HIP_MEMORY_SCOPE_AGENT); }
__device__ __forceinline__ unsigned xb_xcc_id() { return (unsigned)__builtin_amdgcn_s_getreg((3 << 11) | 20) & 0xFu; }
#define XB_SPIN(cond, bar) do { unsigned _sp = 0; while (cond) { __builtin_amdgcn_s_sleep(1); \
    if ((++_sp & 255u) == 0u) { if (xb_ld(&(bar)[XB_TMO])) break; if (_sp > XB_SPIN_CAP) { atomicAdd(&(bar)[XB_TMO], 1u); break; } } } } while (0)
struct XcdBarrier { unsigned* bar; unsigned x; volatile LAS unsigned* st; };
__device__ __forceinline__ void xcd_barrier_complete(unsigned* bar, unsigned x, unsigned& nloc, unsigned& nx) {
    const unsigned G = gridDim.x * gridDim.y * gridDim.z;
    unsigned sum, cnt, mine, sp = 0u;
    for (;;) {
        sum = 0u; cnt = 0u; mine = 0u;
#pragma unroll
        for (unsigned j = 0; j < 16; ++j) { const unsigned c = xb_ld(&bar[XB_XCNT(j)]); sum += c; cnt += (c > 0u) ? 1u : 0u; mine = (j == x) ? c : mine; }
        if (sum == G) break;
        __builtin_amdgcn_s_sleep(1);
        if ((++sp & 255u) == 0u) { if (xb_ld(&bar[XB_TMO])) break; if (sp > XB_SPIN_CAP) { atomicAdd(&bar[XB_TMO], 1u); break; } }
    }
    nloc = mine > 0u ? mine : 1u; nx = cnt > 0u ? cnt : 1u;
}
__device__ __forceinline__ void xcd_barrier(const XcdBarrier& b, const bool leader) {
    asm volatile("s_waitcnt vmcnt(0)" ::: "memory");
    __syncthreads();
    if (leader) {
        unsigned* bar = b.bar;
        __builtin_amdgcn_s_waitcnt(0);
        unsigned nloc = b.st[0], nx = b.st[1];
        if (nloc == 0u) { xcd_barrier_complete(bar, b.x, nloc, nx); b.st[0] = nloc; b.st[1] = nx; }
        const unsigned old = xb_add(&bar[XB_XSUB(b.x)], 1u);
        const unsigned gen = old / nloc;
        if (old + 1u == (gen + 1u) * nloc) {
            __builtin_amdgcn_fence(__ATOMIC_RELEASE, "agent");
            asm volatile("s_waitcnt vmcnt(0)" ::: "memory");
            const unsigned og = xb_add(&bar[XB_TOP], 1u);
            const unsigned tg = og / nx;
            if (og + 1u == (tg + 1u) * nx) xb_add(&bar[XB_TOPGEN], 1u);
            else XB_SPIN(xb_ld(&bar[XB_TOPGEN]) == tg, bar);
            __builtin_amdgcn_fence(__ATOMIC_ACQUIRE, "agent");
            xb_add(&bar[XB_XGEN(b.x)], 1u);
            asm volatile("s_waitcnt vmcnt(0)" ::: "memory");
        } else {
            XB_SPIN(xb_ld(&bar[XB_XGEN(b.x)]) == gen, bar);
            __builtin_amdgcn_fence(__ATOMIC_ACQUIRE, "agent");
            asm volatile("s_waitcnt vmcnt(0)" ::: "memory");
        }
    }
    __syncthreads();
}

__device__ __forceinline__ Params load_params() {
#if defined(__HIP_DEVICE_COMPILE__)
    auto k = __builtin_amdgcn_kernarg_segment_ptr();
    asm volatile("" : "+s"(k));
    return *(const __attribute__((address_space(4))) Params*)k;
#else
    return Params{};
#endif
}
__global__ void __launch_bounds__(NTHREADS, 2) fwd_megakernel(Params p_unused) {
    extern __shared__ __attribute__((aligned(16))) unsigned char lds_raw[];
    LAS unsigned char* lds = (LAS unsigned char*)lds_raw;
    cg::grid_group grid = cg::this_grid();
    const int G_ = gridDim.x, bid = blockIdx.x;
    const int wvx = __builtin_amdgcn_readfirstlane((int)threadIdx.x >> 6);
    const bool leader = (threadIdx.x == 0);
    volatile LAS unsigned* bst = (volatile LAS unsigned*)(lds + LDS_BYTES - 16);
    if (leader) { bst[0] = 0u; bst[1] = 0u; }
    XcdBarrier xbar;
    { const Params p = load_params(); xbar.bar = (unsigned*)(p.ws + OFF_CTL) + 4096; xbar.x = xb_xcc_id(); xbar.st = bst;
      if (leader) (void)xb_add(&xbar.bar[XB_XCNT(xbar.x)], 1u); }
    __syncthreads();
#define GRID_BAR() do { const Params pb = load_params(); XcdBarrier xb2; xb2.bar = (unsigned*)(pb.ws + OFF_CTL) + 4096; xb2.x = xb_xcc_id(); xb2.st = bst; xcd_barrier(xb2, opaque_tid(wvx) == 0); } while (0)

    { const Params p = load_params(); PH(0) phase_prologue(p, lds, G_, bid, wvx); }
    { const Params p = load_params(); PH(0) filters_all(p, G_, bid, wvx); }
    { const Params p = load_params(); PH(1) phase_rownorm(p.in[0], (bf16_t*)(p.ws + OFF_XB), (float*)(p.ws + OFF_RS), G_, bid, wvx); }
    grid.sync();

#pragma unroll 1
    for (int l = 0; l < DEPTH; ++l) {
        PH(2) { const Params p = load_params(); unsigned char* ws = p.ws;
            DenseSched S; S.init((const bf16_t*)(ws + OFF_XB), (const bf16_t*)(ws + OFF_WTIN) + (size_t)l * IN_DP * D, NT, IN_DP, D, G_, bid);
            EpiProj E{(bf16_t*)(ws + OFF_PROJ), (const float*)(ws + OFF_RS)};
            pg8::gemm_phase<EpiProj, DenseSched, false>(lds, D, S, E, wvx);
        }
        GRID_BAR();
        {
            const bool lead = (opaque_tid(wvx) == 0);
            LAS int* qw = (LAS int*)(lds + na::O_QW);
#define CTR(k) ((int*)(load_params().ws + OFF_CTL) + 32 + l * 16 + (k))
            if (bid < 128) { PH(5) { const Params p = load_params(); rw_chain_unit(p, lds, l, bid, wvx); } }
            else {
                PH(3) for (;;) { const int u = wg_pop(CTR(0), qw, lead); if (u >= 1024) break; { const Params p = load_params(); hy_pre_unit4(p, lds, l, u, wvx); } wg_signal(CTR(1), lead); }
                wg_wait(CTR(1), 1024, lead);
                PH(4) for (int c = bid - 128; c < 256; c += 128) { { const Params p = load_params(); hy_conv_unit(p, lds, l, c, wvx); } wg_signal(CTR(2), lead); }
            }
            PH(6) { const Params p = load_params(); na_queue(p, lds, l, wvx); }
            wg_wait(CTR(2), 256, lead);
            PH(7) for (;;) { const int u = wg_pop(CTR(3), qw, lead); if (u >= 1024) break; { const Params p = load_params(); hy_post_unit4(p, lds, l, u, wvx); } wg_signal(CTR(4), lead); }
            wg_wait(CTR(4), 1024, lead);
            PH(10) for (;;) { const int u = wg_pop(CTR(5), qw, lead); if (u >= NEXP * 768 / 64 + (l == 0 ? 43 : 0)) break; { const Params p = load_params(); moe_weights_chunk(p, lds, l, u, wvx); } }
#undef CTR
        }
        GRID_BAR();
        PH(8) { const Params p = load_params(); rw_post_wg(p, lds, l, G_, bid, wvx); }
        GRID_BAR();
        PH(9) { const Params p = load_params(); unsigned char* ws = p.ws;
            DenseSched S; S.init((const bf16_t*)(ws + OFF_MIX), (const bf16_t*)(ws + OFF_WTOUT) + (size_t)l * D * D, NT, D, D, G_, bid);
            EpiRes E{(bf16_t*)(ws + OFF_XB)};
            pg8::gemm_phase<EpiRes, DenseSched, false>(lds, D, S, E, wvx);
        }
        GRID_BAR();
        PH(11) { const Params p = load_params(); phase_router(p, lds, l, G_, bid, wvx); }
        GRID_BAR();
        PH(12) { const Params p = load_params(); unsigned char* ws = p.ws;
            const int* cnt = (const int*)(ws + OFF_CTL) + 64 + l * 64;
            MoeSched S; S.init(cnt, (const bf16_t*)(ws + OFF_XB), (const bf16_t*)(ws + OFF_W13T), (size_t)1024 * D, (const int*)(ws + OFF_LTOK), D, G_, bid, (LAS int*)(lds + 139264), opaque_tid(wvx));
            EpiMoe1 E{(bf16_t*)(ws + OFF_ACT), (const float*)(ws + OFF_LRS)};
            pg8::gemm_phase<EpiMoe1, MoeSched, true>(lds, D, S, E, wvx);
        }
        GRID_BAR();
        PH(13) { const Params p = load_params(); unsigned char* ws = p.ws;
            const int* cnt = (const int*)(ws + OFF_CTL) + 64 + l * 64;
            MoeSched S; S.init(cnt, (const bf16_t*)(ws + OFF_ACT), (const bf16_t*)(ws + OFF_W2T), (size_t)D * FF, nullptr, FF, G_, bid, (LAS int*)(lds + 139264), opaque_tid(wvx));
            EpiMoe2 E{(bf16_t*)(ws + OFF_YBUF), (const int*)(ws + OFF_LTOK), (const float*)(ws + OFF_LGATE)};
            pg8::gemm_phase<EpiMoe2, MoeSched, false>(lds, FF, S, E, wvx);
        }
        GRID_BAR();
        PH(14) { const Params p = load_params(); phase_combine(p, l == DEPTH - 1, G_, bid, wvx); }
        if (l < DEPTH - 1) GRID_BAR();
    }
}

extern "C" void kernel_launch(void* const* d_in, const int* in_sizes, int n_in, void* d_out, int out_size, void* d_ws, size_t ws_size, hipStream_t stream) {
    static int grid = 0;
    if (grid == 0) {
        if (n_in != 36 || ws_size < WS_END) { fprintf(stderr, "kernel_launch: unexpected n_in %d / ws_size %zu (need %zu)\n", n_in, ws_size, (size_t)WS_END); grid = -1; return; }
        int dev = 0, cus = 0, per_cu = 0;
        hipGetDevice(&dev);
        hipDeviceGetAttribute(&cus, hipDeviceAttributeMultiprocessorCount, dev);
        hipFuncSetAttribute((const void*)fwd_megakernel, hipFuncAttributeMaxDynamicSharedMemorySize, LDS_BYTES);
        hipOccupancyMaxActiveBlocksPerMultiprocessor(&per_cu, (const void*)fwd_megakernel, NTHREADS, LDS_BYTES);
        if (per_cu < 1) { fprintf(stderr, "kernel_launch: occupancy query says %d blocks per CU\n", per_cu); per_cu = 1; }
        if (per_cu > 1) per_cu = 1;
        grid = cus * per_cu;
        if (grid != 256) { fprintf(stderr, "kernel_launch: this kernel needs exactly 256 co-resident workgroups (got %d)\n", grid); if (grid > 256) grid = 256; }
        fprintf(stderr, "kernel_launch: grid %d (cus %d), ws %zu\n", grid, cus, ws_size);
    }
    if (grid < 0) return;
    hipMemsetAsync((char*)d_ws + OFF_CTL, 0, 65536, stream);
    Params p{};
    for (int i = 0; i < 36; ++i) p.in[i] = (const float*)d_in[i];
    p.out = (float*)d_out; p.ws = (unsigned char*)d_ws;
    void* args[] = {&p};
    hipError_t e = hipLaunchCooperativeKernel((const void*)fwd_megakernel, dim3(grid), dim3(NTHREADS), args, LDS_BYTES, stream);
    if (e != hipSuccess) fprintf(stderr, "cooperative launch failed: %s (grid %d)\n", hipGetErrorString(e), grid);
}
```

```cpp
#include <hip/hip_runtime.h>
#include <hip/hip_cooperative_groups.h>
#include <cstdio>
#include <cstdint>
namespace cg = cooperative_groups;

#define LAS __attribute__((address_space(3)))
typedef unsigned short bf16_t;
typedef short bf16x8 __attribute__((ext_vector_type(8)));
typedef float f32x4 __attribute__((ext_vector_type(4)));
typedef float f32x2 __attribute__((ext_vector_type(2)));
typedef unsigned u32x4 __attribute__((ext_vector_type(4)));
typedef unsigned u32x2 __attribute__((ext_vector_type(2)));

constexpr int D = 1024, NB = 8, L = 8192, NT = NB * L, DEPTH = 2;
constexpr int IN_D = 3456, IN_DP = 3584;
constexpr int C_HX0 = 0, C_HX1 = 256, C_HV = 512, C_RR = 768, C_RK = 1280, C_RV = 1792, C_RG = 2304, C_RW = 2432, C_RA = 2560, C_NQ = 2688, C_NK = 2944, C_NV = 3200;
constexpr int NEXP = 32, FF = 512;
constexpr float NORM_EPS = 1e-6f;

constexpr size_t MiB = 1u << 20;
constexpr size_t OFF_CTL = 0;
constexpr size_t OFF_WTIN = 1 * MiB;
constexpr size_t OFF_WTOUT = 15 * MiB;
constexpr size_t OFF_RS = 19 * MiB;
constexpr size_t OFF_RGW = 20 * MiB;
constexpr size_t OFF_LTOK = 21 * MiB;
constexpr size_t OFF_LGATE = 29 * MiB;
constexpr size_t OFF_FILT = 37 * MiB;
constexpr size_t OFF_MOEW = 69 * MiB;
constexpr size_t OFF_W13T = OFF_MOEW, OFF_W2T = OFF_MOEW + 64 * MiB;
constexpr size_t OFF_ZT = OFF_MOEW;
constexpr size_t OFF_YT = OFF_MOEW + 32 * MiB;
constexpr size_t OFF_XB = 165 * MiB;
constexpr size_t OFF_MIX = 869 * MiB;
constexpr size_t OFF_PROJ = 293 * MiB;
constexpr size_t OFF_ACT = OFF_PROJ;
constexpr size_t OFF_YBUF = OFF_PROJ + 136 * MiB;
constexpr size_t OFF_YF = 741 * MiB;
constexpr size_t OFF_YB = 805 * MiB;
constexpr size_t OFF_BON = 997 * MiB;
constexpr size_t OFF_LRS = 1001 * MiB;
constexpr size_t WS_END = 1009 * MiB;
constexpr int LCAP = 65536;

constexpr int LDS_BYTES = 163840;
constexpr int NTHREADS = 512;

struct Params { const float* in[36]; float* out; unsigned char* ws; };

__device__ __forceinline__ float bf2f(unsigned b) { return __uint_as_float(b << 16); }
typedef __bf16 bf16x2_t __attribute__((ext_vector_type(2)));
__device__ __forceinline__ unsigned f2bf(float f) { return (unsigned)__builtin_bit_cast(unsigned short, (__bf16)f); }
__device__ __forceinline__ unsigned pk2(float lo, float hi) { const f32x2 v = {lo, hi}; return __builtin_bit_cast(unsigned, __builtin_convertvector(v, bf16x2_t)); }
#define DPPF(v, ctrl) __int_as_float(__builtin_amdgcn_update_dpp(0, __float_as_int(v), (ctrl), 0xF, 0xF, true))
__device__ __forceinline__ float rdlane(float v, int l) { return __int_as_float(__builtin_amdgcn_readlane(__float_as_int(v), l)); }
__device__ __forceinline__ float wave_sum(float v) {
    v += DPPF(v, 0xB1); v += DPPF(v, 0x4E); v += DPPF(v, 0x141); v += DPPF(v, 0x140);
    return (rdlane(v, 0) + rdlane(v, 16)) + (rdlane(v, 32) + rdlane(v, 48));
}
__device__ __forceinline__ float sum8(float v) { v += DPPF(v, 0xB1); v += DPPF(v, 0x4E); v += DPPF(v, 0x141); return v; }
__device__ __forceinline__ void unpack8(const u32x4 w, float* f) {
    f[0] = bf2f(w.x & 0xffffu); f[1] = __uint_as_float(w.x & 0xffff0000u);
    f[2] = bf2f(w.y & 0xffffu); f[3] = __uint_as_float(w.y & 0xffff0000u);
    f[4] = bf2f(w.z & 0xffffu); f[5] = __uint_as_float(w.z & 0xffff0000u);
    f[6] = bf2f(w.w & 0xffffu); f[7] = __uint_as_float(w.w & 0xffff0000u);
}
__device__ __forceinline__ float frcp(float x) { return __builtin_amdgcn_rcpf(x); }
__device__ __forceinline__ float ftanh(float x) { const float e = __expf(2.0f * x); return 1.0f - 2.0f * frcp(e + 1.0f); }
#define LDS_WAIT() asm volatile("s_waitcnt lgkmcnt(0)" ::: "memory")
__device__ __forceinline__ int opaque_tid(int wvx) { int ln; asm volatile("v_mbcnt_lo_u32_b32 %0, -1, 0\n\tv_mbcnt_hi_u32_b32 %0, -1, %0" : "=v"(ln)); return wvx * 64 + ln; }

namespace pg8 {
constexpr int BM = 256, BK = 64, HALF = 128, HTB = HALF * BK * 2, STAGE_BYTES = 8 * HTB;
__device__ __forceinline__ int lds_byte(int r, int c) { const int st = (r >> 4) * 2 + (c >> 5), rr = r & 15, cc = c & 31, ob = rr * 64 + cc * 2; return st * 1024 + (ob ^ (((ob >> 9) & 1) << 5)); }
__device__ __forceinline__ void stage_rc(int b, int& R, int& C) { const int st = b / 1024, sb = b % 1024, swz = sb ^ (((sb >> 9) & 1) << 5); R = (st >> 1) * 16 + swz / 64; C = (st & 1) * 32 + (swz % 64) / 2; }
__device__ __forceinline__ int perm32(int rho) { const int n = rho >> 4, i = rho & 15; return 8 * (i >> 2) + 4 * n + (i & 3); }
__device__ __forceinline__ unsigned cvt_pk_bf16(float lo, float hi) { return pk2(lo, hi); }

struct Unit { const char* A; const char* B; int pm, pn, e, cnt; };

template <class Epi, class Sched, bool GATHER>
__device__ __forceinline__ void gemm_phase(LAS unsigned char* lds, const int K, const Sched& S, const Epi& E, const int wvx) {
    const int tid = opaque_tid(wvx), wid = __builtin_amdgcn_readfirstlane(tid >> 6), lane = tid & 63, wr = wid >> 2, wc = wid & 3, fr = lane & 15, fq = lane >> 4;
    const int nt = K / BK;
    int Rr[2], Cc[2];
    unsigned voffB[2];
#pragma unroll
    for (int i = 0; i < 2; ++i) { stage_rc(tid * 16 + i * 8192, Rr[i], Cc[i]); const int Rb = Epi::PERM ? ((Rr[i] & ~31) + perm32(Rr[i] & 31)) : Rr[i];
        voffB[i] = (unsigned)(Rb * K + Cc[i]) * 2u; }
    const size_t kstep = (size_t)(BK * 2);
    const size_t hstep = (size_t)HALF * K * 2;
    const unsigned ldsw = (unsigned)wid * 1024u;
    const int aoff = lds_byte(wr * 64 + fr, fq * 8), boff = lds_byte(wc * 32 + fr, fq * 8);
#define PG8_SA(b, h) (((b) * 2 + (h)) * HTB)
#define PG8_SB(b, h) ((4 + (b) * 2 + (h)) * HTB)
#define PG8_STAGE(bufoff, gbase, voff) do { _Pragma("unroll") for (int _i = 0; _i < 2; ++_i) \
        __builtin_amdgcn_global_load_lds((const unsigned*)((const char*)(gbase) + (voff)[_i]), (LAS unsigned*)(lds + (bufoff) + ldsw + _i * 8192), 16, 0, 0); } while (0)
#define PG8_LDA(dst, b, h) do { _Pragma("unroll") for (int m = 0; m < 4; ++m) _Pragma("unroll") for (int k = 0; k < 2; ++k) dst[m][k] = *(const LAS bf16x8*)(lds + PG8_SA(b, h) + aoff + m * 2048 + k * 1024); } while (0)
#define PG8_LDB(dst, b, h) do { _Pragma("unroll") for (int n = 0; n < 2; ++n) _Pragma("unroll") for (int k = 0; k < 2; ++k) dst[n][k] = *(const LAS bf16x8*)(lds + PG8_SB(b, h) + boff + n * 2048 + k * 1024); } while (0)
#define PG8_MMA(ai, bj, At, Bt) do { __builtin_amdgcn_s_setprio(1); _Pragma("unroll") for (int m = 0; m < 4; ++m) _Pragma("unroll") for (int n = 0; n < 2; ++n) _Pragma("unroll") for (int k = 0; k < 2; ++k) \
        acc[ai][bj][m][n] = __builtin_amdgcn_mfma_f32_16x16x32_bf16(Bt[n][k], At[m][k], acc[ai][bj][m][n], 0, 0, 0); __builtin_amdgcn_s_setprio(0); } while (0)
#define PG8_WAIT_V(n) asm volatile("s_waitcnt vmcnt(" #n ")" ::: "memory")
#define PG8_WAIT_L(n) asm volatile("s_waitcnt lgkmcnt(" #n ")" ::: "memory")
#define PG8_BAR __builtin_amdgcn_s_barrier()
#define PG8_SCHED __builtin_amdgcn_sched_barrier(0)
    Unit cur, nxt; int ui = 0;
    if (!S.next(0, cur)) return;
    f32x4 acc[2][2][4][2];
#pragma unroll
    for (int a = 0; a < 2; ++a)
#pragma unroll
        for (int b = 0; b < 2; ++b)
#pragma unroll
            for (int m = 0; m < 4; ++m)
#pragma unroll
                for (int n = 0; n < 2; ++n) acc[a][b][m][n] = (f32x4){0.f, 0.f, 0.f, 0.f};
    bf16x8 At[4][2], B0[2][2], B1[2][2];
    typename Epi::Pre epre;
    unsigned vA[2][2];
    LAS u32x4* stash = (LAS u32x4*)(lds + STAGE_BYTES) + tid;
    if (GATHER) S.aoff(cur, tid, vA);
    else {
#pragma unroll
        for (int h = 0; h < 2; ++h)
#pragma unroll
            for (int i = 0; i < 2; ++i) vA[h][i] = (unsigned)((h * HALF + Rr[i]) * K + Cc[i]) * 2u;
    }
    const char* cA = cur.A; const char* cB = cur.B;
    PG8_STAGE(PG8_SB(0, 0), cB, voffB); PG8_STAGE(PG8_SB(0, 1), cB + hstep, voffB); PG8_STAGE(PG8_SA(0, 0), cA, vA[0]); PG8_STAGE(PG8_SA(0, 1), cA, vA[1]);
    if (wr == 1) PG8_BAR;
    PG8_WAIT_V(2); PG8_BAR;
    PG8_STAGE(PG8_SB(1, 0), cB + kstep, voffB); PG8_STAGE(PG8_SA(1, 0), cA + kstep, vA[0]); PG8_STAGE(PG8_SB(1, 1), cB + hstep + kstep, voffB);
    PG8_WAIT_V(6); PG8_BAR;
    for (;;) {
        const bool has_next = S.next(ui + 1, nxt);
        const char* nA = has_next ? nxt.A : cA; const char* nB = has_next ? nxt.B : cB;
        if (GATHER) { unsigned vn[2][2];
            if (has_next) { S.aoff(nxt, tid, vn); *stash = (u32x4){vn[0][0], vn[0][1], vn[1][0], vn[1][1]}; }
            else *stash = (u32x4){vA[0][0], vA[0][1], vA[1][0], vA[1][1]}; }
        for (int t = 0; t < nt; t += 2) {
            const bool last = (t == nt - 2);
            const char* a1 = cA + (size_t)(t + 1) * kstep;
            const char* a2 = last ? nA : cA + (size_t)(t + 2) * kstep; const char* b2 = last ? nB : cB + (size_t)(t + 2) * kstep;
            const char* a3 = a2 + kstep; const char* b3 = b2 + kstep;
            if (last) E.prefetch(epre, cur, wr, wc, fr, fq);
            PG8_LDB(B0, 0, 0); PG8_LDB(B1, 0, 1); PG8_SCHED; PG8_LDA(At, 0, 0); PG8_STAGE(PG8_SA(1, 1), a1, vA[1]);
            if (GATHER && last) { const u32x4 sv = *stash; vA[0][0] = sv.x; vA[0][1] = sv.y; vA[1][0] = sv.z; vA[1][1] = sv.w; }
            PG8_WAIT_V(8); PG8_WAIT_L(0); PG8_BAR; PG8_MMA(0, 0, At, B0); PG8_MMA(0, 1, At, B1); PG8_BAR; PG8_SCHED;
            PG8_LDA(At, 0, 1); PG8_STAGE(PG8_SB(0, 0), b2, voffB); PG8_STAGE(PG8_SB(0, 1), b2 + hstep, voffB); PG8_STAGE(PG8_SA(0, 0), a2, vA[0]);
            PG8_WAIT_V(8); PG8_WAIT_L(0); PG8_BAR; PG8_MMA(1, 0, At, B0); PG8_MMA(1, 1, At, B1); PG8_BAR; PG8_SCHED;
            PG8_LDB(B0, 1, 0); PG8_LDB(B1, 1, 1); PG8_SCHED; PG8_LDA(At, 1, 0); PG8_STAGE(PG8_SA(0, 1), a2, vA[1]);
            PG8_WAIT_V(8); PG8_WAIT_L(0); PG8_BAR; PG8_MMA(0, 0, At, B0); PG8_MMA(0, 1, At, B1); PG8_BAR; PG8_SCHED;
            PG8_LDA(At, 1, 1); PG8_STAGE(PG8_SB(1, 0), b3, voffB); PG8_STAGE(PG8_SB(1, 1), b3 + hstep, voffB); PG8_STAGE(PG8_SA(1, 0), a3, vA[0]);
            PG8_WAIT_V(8); PG8_WAIT_L(0); PG8_BAR; PG8_MMA(1, 0, At, B0); PG8_MMA(1, 1, At, B1); PG8_BAR; PG8_SCHED;
        }
        if (wr == 0) PG8_BAR;
        {
            Unit eu = cur; int efr = fr, efq = fq;
            eu.pm = __builtin_amdgcn_readfirstlane(eu.pm); eu.pn = __builtin_amdgcn_readfirstlane(eu.pn); eu.e = __builtin_amdgcn_readfirstlane(eu.e); eu.cnt = __builtin_amdgcn_readfirstlane(eu.cnt);
            asm volatile("" : "+s"(eu.pm), "+s"(eu.pn), "+s"(eu.e), "+s"(eu.cnt), "+v"(efr), "+v"(efq));
            E(acc, eu, wr, wc, efr, efq, epre);
        }
        if (!has_next) break;
#pragma unroll
        for (int a = 0; a < 2; ++a)
#pragma unroll
            for (int b = 0; b < 2; ++b)
#pragma unroll
                for (int m = 0; m < 4; ++m)
#pragma unroll
                    for (int n = 0; n < 2; ++n) acc[a][b][m][n] = (f32x4){0.f, 0.f, 0.f, 0.f};
        cur = nxt; cA = nA; cB = nB; ++ui;
        if (wr == 1) PG8_BAR;
    }
    PG8_WAIT_V(0);
    PG8_BAR;
#undef PG8_SA
#undef PG8_SB
#undef PG8_STAGE
#undef PG8_LDA
#undef PG8_LDB
#undef PG8_MMA
#undef PG8_WAIT_V
#undef PG8_WAIT_L
#undef PG8_BAR
#undef PG8_SCHED
}
}

struct DenseSched {
    const bf16_t* A; const bf16_t* Bt; int K, nM, nN, nwg, G, c;
    __device__ void init(const bf16_t* A_, const bf16_t* Bt_, int M, int N, int K_, int G_, int c_) { A = A_; Bt = Bt_; K = K_; nM = M / 256; nN = N / 256; nwg = nM * nN; G = G_; c = c_; }
    __device__ __forceinline__ bool next(int i, pg8::Unit& u) const {
        const long Lx = (long)i * G + c; if (Lx >= nwg) return false;
        int wgid = (int)Lx; { const int q = nwg / 8, r = nwg % 8, xcd = wgid % 8, off = wgid / 8; wgid = (xcd < r ? xcd * (q + 1) : r * (q + 1) + (xcd - r) * q) + off; }
        const int nig = 8 * nN, gid = wgid / nig, fm = gid * 8, gsz = (nM - fm) < 8 ? (nM - fm) : 8;
        u.pm = fm + ((wgid % nig) % gsz); u.pn = (wgid % nig) / gsz; u.e = 0; u.cnt = 0;
        u.A = (const char*)A + (size_t)u.pm * 256 * K * 2; u.B = (const char*)Bt + (size_t)u.pn * 256 * K * 2; return true;
    }
    __device__ __forceinline__ void aoff(const pg8::Unit&, int, unsigned (&)[2][2]) const {}
};
struct MoeSched {
    const bf16_t* A; const bf16_t* Bt; size_t bstride;
    const int* ltok;
    LAS int* tp;
    int K, G, c, total;
    __device__ void init(const int* cnt_, const bf16_t* A_, const bf16_t* Bt_, size_t bstride_, const int* ltok_, int K_, int G_, int c_, LAS int* lds_tab, int tid) {
        A = A_; Bt = Bt_; bstride = bstride_; ltok = ltok_; K = K_; G = G_; c = (G_ % 8 == 0) ? (c_ & 7) * (G_ >> 3) + (c_ >> 3) : c_;
        tp = lds_tab;
        __syncthreads();
        if (tid < 32) tp[64 + tid] = cnt_[tid];
        __syncthreads();
        if (tid == 0) { int t = 0; for (int e = 0; e < NEXP; ++e) { tp[e] = t; t += (tp[64 + e] + 255) >> 8; } tp[32] = t; }
        __syncthreads();
        total = __builtin_amdgcn_readfirstlane(tp[32]);
    }
    __device__ __forceinline__ bool next(int i, pg8::Unit& u) const {
        const long Lx = (long)i * G + c; if (Lx >= (long)total * 4) return false;
        const int ti = (int)(Lx >> 2); u.pn = (int)(Lx & 3);
        int ln; asm volatile("v_mbcnt_lo_u32_b32 %0, -1, 0\n\tv_mbcnt_hi_u32_b32 %0, -1, %0" : "=v"(ln));
        const int l5 = ln & 31; const int lo = tp[l5], hi = tp[l5 + 1];
        const unsigned long long mask = __builtin_amdgcn_ballot_w64(lo <= ti && ti < hi);
        const int e = __builtin_amdgcn_readfirstlane((int)__builtin_ctzll(mask) & 31);
        const int base = __builtin_amdgcn_readfirstlane(tp[e]), ce = __builtin_amdgcn_readfirstlane(tp[64 + e]);
        u.e = e; u.pm = ti; u.cnt = ce - (ti - base) * 256;
        u.A = ltok ? (const char*)A : (const char*)A + (size_t)ti * 256 * K * 2;
        u.B = (const char*)(Bt + (size_t)e * bstride) + (size_t)u.pn * 256 * K * 2;
        u.pm = ti | ((ti - base) << 16);
        return true;
    }
    __device__ __forceinline__ void aoff(const pg8::Unit& u, int tid, unsigned (&v)[2][2]) const {
        const int lt = u.pm >> 16; int Rr[2], Cc[2]; pg8::stage_rc(tid * 16, Rr[0], Cc[0]); pg8::stage_rc(tid * 16 + 8192, Rr[1], Cc[1]);
        int tk[2][2];
#pragma unroll
        for (int h = 0; h < 2; ++h)
#pragma unroll
            for (int i = 0; i < 2; ++i) { const int r = h * 128 + Rr[i]; tk[h][i] = ltok[(size_t)u.e * LCAP + lt * 256 + (r < u.cnt ? r : 0)]; }
#pragma unroll
        for (int h = 0; h < 2; ++h)
#pragma unroll
            for (int i = 0; i < 2; ++i) { const int r = h * 128 + Rr[i]; const int tok = (r < u.cnt) ? (tk[h][i] >> 1) : 0; v[h][i] = (unsigned)(tok * K + Cc[i]) * 2u; }
    }
};

struct EpiProj {
    static constexpr bool PERM = true;
    struct Pre { float rs[8]; };
    bf16_t* O; const float* rs;
    __device__ __forceinline__ void prefetch(Pre& pr, const pg8::Unit& u, int wr, int wc, int fr, int fq) const {
        const int row0 = (u.pm & 0xffff) * 256 + wr * 64 + fr;
#pragma unroll
        for (int ai = 0; ai < 2; ++ai)
#pragma unroll
            for (int m = 0; m < 4; ++m) pr.rs[ai * 4 + m] = rs[row0 + ai * 128 + m * 16];
    }
    __device__ __forceinline__ void operator()(const f32x4 (&acc_)[2][2][4][2], const pg8::Unit& u, int wr, int wc, int fr, int fq, const Pre& pr) const {
        const int row0 = u.pm * 256 + wr * 64 + fr, col0 = u.pn * 256 + wc * 32 + 8 * fq;
        f32x4 (&acc)[2][2][4][2] = const_cast<f32x4 (&)[2][2][4][2]>(acc_);
        const bool act = (u.pn == 9);
        if (act) {
#pragma unroll
            for (int ai = 0; ai < 2; ++ai)
#pragma unroll
                for (int m = 0; m < 4; ++m) { const float s = pr.rs[ai * 4 + m];
#pragma unroll
                    for (int n = 0; n < 2; ++n)
#pragma unroll
                        for (int e = 0; e < 4; ++e) { acc[ai][0][m][n][e] = frcp(1.0f + __expf(-acc[ai][0][m][n][e] * s)); acc[ai][1][m][n][e] = ftanh(acc[ai][1][m][n][e] * s); } }
            asm volatile("" ::: "memory");
        }
#pragma unroll
        for (int ai = 0; ai < 2; ++ai)
#pragma unroll
            for (int m = 0; m < 4; ++m) { const int row = row0 + ai * 128 + m * 16; const float s = act ? 1.0f : pr.rs[ai * 4 + m]; bf16_t* rowp = O + (size_t)row * IN_DP + col0;
#pragma unroll
                for (int bj = 0; bj < 2; ++bj) { const f32x4 v0 = acc[ai][bj][m][0] * s, v1 = acc[ai][bj][m][1] * s;
                    u32x4 w; w.x = pg8::cvt_pk_bf16(v0[0], v0[1]); w.y = pg8::cvt_pk_bf16(v0[2], v0[3]); w.z = pg8::cvt_pk_bf16(v1[0], v1[1]); w.w = pg8::cvt_pk_bf16(v1[2], v1[3]);
                    *(u32x4*)(rowp + bj * 128) = w; } }
    }
};
struct EpiRes {
    static constexpr bool PERM = true;
    struct Pre { int dummy; };
    bf16_t* x16;
    __device__ __forceinline__ void prefetch(Pre&, const pg8::Unit&, int, int, int, int) const {}
    __device__ __forceinline__ void operator()(const f32x4 (&acc)[2][2][4][2], const pg8::Unit& u, int wr, int wc, int fr, int fq, const Pre&) const {
        const int row0 = u.pm * 256 + wr * 64 + fr, col0 = u.pn * 256 + wc * 32 + 8 * fq;
#pragma unroll
        for (int ai = 0; ai < 2; ++ai) {
            u32x4 braw[4][2];
#pragma unroll
            for (int m = 0; m < 4; ++m)
#pragma unroll
                for (int bj = 0; bj < 2; ++bj) braw[m][bj] = *(const u32x4*)(x16 + (size_t)(row0 + ai * 128 + m * 16) * D + col0 + bj * 128);
            asm volatile("" ::: "memory");
#pragma unroll
            for (int m = 0; m < 4; ++m) { const size_t off = (size_t)(row0 + ai * 128 + m * 16) * D + col0;
#pragma unroll
                for (int bj = 0; bj < 2; ++bj) { const f32x4 v0 = acc[ai][bj][m][0], v1 = acc[ai][bj][m][1]; float bb[8]; unpack8(braw[m][bj], bb);
                    u32x4 w; w.x = pk2(bb[0] + v0[0], bb[1] + v0[1]); w.y = pk2(bb[2] + v0[2], bb[3] + v0[3]); w.z = pk2(bb[4] + v1[0], bb[5] + v1[1]); w.w = pk2(bb[6] + v1[2], bb[7] + v1[3]);
                    *(u32x4*)(x16 + off + bj * 128) = w; } }
            asm volatile("" ::: "memory");
        }
    }
};
struct EpiMoe1 {
    static constexpr bool PERM = true;
    struct Pre { int dummy; };
    bf16_t* act; const float* lrs;
    __device__ __forceinline__ void prefetch(Pre&, const pg8::Unit&, int, int, int, int) const {}
    __device__ __forceinline__ void operator()(const f32x4 (&acc)[2][2][4][2], const pg8::Unit& u, int wr, int wc, int fr, int fq, const Pre&) const {
        const int ti = u.pm & 0xffff, lt = u.pm >> 16;
        const int r0 = wr * 64 + fr, col0 = u.pn * 256 + wc * 32 + 8 * fq;
        float sv[8];
#pragma unroll
        for (int q = 0; q < 8; ++q) { const int r = r0 + (q >> 2) * 128 + (q & 3) * 16; sv[q] = (r < u.cnt) ? lrs[(size_t)u.e * LCAP + lt * 256 + r] : 0.f; }
        asm volatile("" ::: "memory");
#pragma unroll
        for (int ai = 0; ai < 2; ++ai)
#pragma unroll
            for (int m = 0; m < 4; ++m) { const int r = r0 + ai * 128 + m * 16;
                const float s = sv[ai * 4 + m];
                bf16_t* rowp = act + ((size_t)ti * 256 + r) * FF + (col0 >> 1);
#pragma unroll
                for (int bj = 0; bj < 2; ++bj) { const f32x4 v0 = acc[ai][bj][m][0] * s, v1 = acc[ai][bj][m][1] * s;
                    const float o0 = v0[0] * frcp(1.f + __expf(-v0[0])) * v0[1], o1 = v0[2] * frcp(1.f + __expf(-v0[2])) * v0[3];
                    const float o2 = v1[0] * frcp(1.f + __expf(-v1[0])) * v1[1], o3 = v1[2] * frcp(1.f + __expf(-v1[2])) * v1[3];
                    u32x2 w; w.x = pg8::cvt_pk_bf16(o0, o1); w.y = pg8::cvt_pk_bf16(o2, o3);
                    *(u32x2*)(rowp + bj * 64) = w; } }
    }
};
struct EpiMoe2 {
    static constexpr bool PERM = true;
    struct Pre { int dummy; };
    bf16_t* ybuf; const int* ltok; const float* lgate;
    __device__ __forceinline__ void prefetch(Pre&, const pg8::Unit&, int, int, int, int) const {}
    __device__ __forceinline__ void operator()(const f32x4 (&acc)[2][2][4][2], const pg8::Unit& u, int wr, int wc, int fr, int fq, const Pre&) const {
        const int lt = u.pm >> 16, r0 = wr * 64 + fr, col0 = u.pn * 256 + wc * 32 + 8 * fq;
        int dv[8]; float gv[8];
#pragma unroll
        for (int q = 0; q < 8; ++q) { const int r = r0 + (q >> 2) * 128 + (q & 3) * 16; const bool ok = r < u.cnt;
            const size_t li = (size_t)u.e * LCAP + lt * 256 + (ok ? r : 0); const int d = ltok[li]; const float g = lgate[li];
            dv[q] = ok ? d : -1; gv[q] = g; }
        asm volatile("" ::: "memory");
#pragma unroll
        for (int ai = 0; ai < 2; ++ai)
#pragma unroll
            for (int m = 0; m < 4; ++m) { const int dest = dv[ai * 4 + m];
                if (dest >= 0) { const float g = gv[ai * 4 + m];
                    bf16_t* rowp = ybuf + (size_t)dest * D + col0;
#pragma unroll
                    for (int bj = 0; bj < 2; ++bj) { const f32x4 v0 = acc[ai][bj][m][0] * g, v1 = acc[ai][bj][m][1] * g;
                        u32x4 w; w.x = pg8::cvt_pk_bf16(v0[0], v0[1]); w.y = pg8::cvt_pk_bf16(v0[2], v0[3]); w.z = pg8::cvt_pk_bf16(v1[0], v1[1]); w.w = pg8::cvt_pk_bf16(v1[2], v1[3]);
                        *(u32x4*)(rowp + bj * 128) = w; } } }
    }
};

__device__ __forceinline__ void transpose_item(const float* __restrict__ W, int K, int N, bf16_t* WT, int rmul, int radd, const float* __restrict__ g, LAS float* scr, int item, int lane) {
    const int nblk = N / 32, kb = item / nblk, nb = item % nblk, k0 = 64 * kb, n0 = 32 * nb;
    f32x4 v[8]; float gv[8];
#pragma unroll
    for (int i = 0; i < 8; ++i) { v[i] = *(const f32x4*)(W + (size_t)(k0 + 8 * i + (lane >> 3)) * N + n0 + 4 * (lane & 7)); gv[i] = g ? g[k0 + 8 * i + (lane >> 3)] : 1.0f; }
#pragma unroll
    for (int i = 0; i < 8; ++i) { const int kk = 8 * i + (lane >> 3); *(LAS f32x4*)(scr + kk * 36 + 4 * (lane & 7)) = v[i] * gv[i]; }
    LDS_WAIT(); asm volatile("" ::: "memory");
    const int c = lane & 7;
#pragma unroll
    for (int j = 0; j < 4; ++j) { const int n = (lane >> 3) + 8 * j; const LAS float* s = scr + (8 * c) * 36 + n;
        u32x4 o; o.x = pk2(s[0 * 36], s[1 * 36]); o.y = pk2(s[2 * 36], s[3 * 36]); o.z = pk2(s[4 * 36], s[5 * 36]); o.w = pk2(s[6 * 36], s[7 * 36]);
        *(u32x4*)(WT + (size_t)(rmul * (n0 + n) + radd) * K + k0 + 8 * c) = o; }
    LDS_WAIT(); asm volatile("" ::: "memory");
}

__device__ __forceinline__ void filt_item8(const Params& p, int l, int m0, int lane, float* G) {
    const float* w1 = p.in[5] + l * 33 * 64; const float* w2 = p.in[7] + l * 4096; const float* w3 = p.in[9] + l * 4096; const float* wout = p.in[11] + l * 64 * 512;
    const float b1v = p.in[6][l * 64 + lane], b2v = p.in[8][l * 64 + lane], b3v = p.in[10][l * 64 + lane], fr = p.in[12][l * 64 + lane];
    float hcur[8], acc[8];
    {
#pragma unroll
        for (int j = 0; j < 8; ++j) { const int m = m0 + j; float zl = 0.f;
            const float wv = (6.283185307179586f / 8192.0f) * (float)m; const float fstep = (15.0f - 1e-4f) / 15.0f;
            if (lane == 0) zl = (float)m / 8191.0f; else if (lane <= 16) zl = cosf((1e-4f + (float)(lane - 1) * fstep) * wv); else if (lane <= 32) zl = -sinf((1e-4f + (float)(lane - 17) * fstep) * wv);
            hcur[j] = zl; acc[j] = b1v; }
        float wc[33];
#pragma unroll
        for (int i = 0; i < 33; ++i) wc[i] = w1[i * 64 + lane];
#pragma unroll
        for (int i = 0; i < 33; ++i)
#pragma unroll
            for (int j = 0; j < 8; ++j) acc[j] += rdlane(hcur[j], i) * wc[i];
#pragma unroll
        for (int j = 0; j < 8; ++j) { hcur[j] = sinf(fr * acc[j]); acc[j] = b2v; }
    }
    asm volatile("" ::: "memory");
    {   float wc[64];
#pragma unroll
        for (int i = 0; i < 64; ++i) wc[i] = w2[i * 64 + lane];
#pragma unroll
        for (int i = 0; i < 64; ++i)
#pragma unroll
            for (int j = 0; j < 8; ++j) acc[j] += rdlane(hcur[j], i) * wc[i];
#pragma unroll
        for (int j = 0; j < 8; ++j) { hcur[j] = sinf(fr * acc[j]); acc[j] = b3v; }
    }
    asm volatile("" ::: "memory");
    {   float wc[64];
#pragma unroll
        for (int i = 0; i < 64; ++i) wc[i] = w3[i * 64 + lane];
#pragma unroll
        for (int i = 0; i < 64; ++i)
#pragma unroll
            for (int j = 0; j < 8; ++j) acc[j] += rdlane(hcur[j], i) * wc[i];
#pragma unroll
        for (int j = 0; j < 8; ++j) hcur[j] = sinf(fr * acc[j]);
    }
    asm volatile("" ::: "memory");
    float (&h3)[8] = hcur;
    float o[8][8];
#pragma unroll
    for (int j = 0; j < 8; ++j)
#pragma unroll
        for (int q = 0; q < 8; ++q) o[j][q] = 0.f;
#pragma unroll 2
    for (int i = 0; i < 64; ++i) { float wo[8];
#pragma unroll
        for (int q = 0; q < 8; ++q) wo[q] = wout[i * 512 + q * 64 + lane];
#pragma unroll
        for (int j = 0; j < 8; ++j) { const float hv = rdlane(h3[j], i);
#pragma unroll
            for (int q = 0; q < 8; ++q) o[j][q] += hv * wo[q]; } }
    const float dmin = -3.0701134573253944f, dmax = -15.350567286626972f;
#pragma unroll
    for (int q = 0; q < 8; ++q) { const int n = q * 64 + lane, d = n >> 8, c = n & 255;
        const float delta = fabsf(dmin + (float)c * ((dmax - dmin) / 255.0f));
        float v[8];
#pragma unroll
        for (int j = 0; j < 8; ++j) v[j] = o[j][q] * expf(-((float)(m0 + j) / 8191.0f) * delta);
        float* dst = G + (size_t)c * 16384 + d * 8192 + m0;
        *(f32x4*)dst = (f32x4){v[0], v[1], v[2], v[3]}; *(f32x4*)(dst + 4) = (f32x4){v[4], v[5], v[6], v[7]}; }
}

__device__ __forceinline__ void phase_prologue(const Params& p, LAS unsigned char* lds, int G_, int bid, const int wvx) {
    const int tid = opaque_tid(wvx), lane = tid & 63, wave = tid >> 6;
    const int gw = bid * 8 + wave, NGW = G_ * 8;
    LAS float* scr = (LAS float*)(lds + wave * 16384);
    unsigned char* ws = p.ws;
    for (int it = gw; it < 16 * 108; it += NGW) transpose_item(p.in[2], D, IN_D, (bf16_t*)(ws + OFF_WTIN), 1, 0, p.in[1], scr, it, lane);
    for (int i = bid * NTHREADS + tid; i < 2 * 128 * D / 8; i += G_ * NTHREADS) { const int l = i / (128 * D / 8), r = i % (128 * D / 8);
        *(u32x4*)((bf16_t*)(ws + OFF_WTIN) + (size_t)l * IN_DP * D + (size_t)IN_D * D + (size_t)r * 8) = (u32x4){0u, 0u, 0u, 0u}; }
    for (int i = bid * NTHREADS + tid; i < 2 * 48 * D; i += G_ * NTHREADS) { const int l = i / (48 * D), r = i % (48 * D), o = r / D, k = r % D;
        const float g = p.in[27][l * D + k]; const float w = g * ((o < 4) ? p.in[28][((size_t)l * D + k) * 4 + o] : (o < 36 ? p.in[30][((size_t)l * D + k) * 32 + (o - 4)] : 0.f));
        const unsigned hi = f2bf(w); const float lo = w - bf2f(hi);
        bf16_t* rg = (bf16_t*)(ws + OFF_RGW) + (size_t)l * 2 * 48 * D; rg[o * D + k] = (bf16_t)hi; rg[48 * D + o * D + k] = (bf16_t)f2bf(lo); }
}
__device__ __forceinline__ void filters_all(const Params& p, int nwg, int rank, const int wvx) {
    const int tid = opaque_tid(wvx), lane = tid & 63, wave = tid >> 6;
    for (int it = rank * 8 + wave; it < 2 * (L / 8); it += nwg * 8) { const int l = it / (L / 8), m0 = (it % (L / 8)) * 8; filt_item8(p, l, m0, lane, (float*)(p.ws + OFF_FILT) + (size_t)l * 256 * 16384); }
}

__device__ __forceinline__ void moe_weights_chunk(const Params& p, LAS unsigned char* lds, int l, int chunk, const int wvx) {
    const int tid = opaque_tid(wvx), lane = tid & 63, wave = tid >> 6;
    LAS float* scr = (LAS float*)(lds + wave * 16384);
    bf16_t* W13 = (bf16_t*)(p.ws + OFF_W13T); bf16_t* W2 = (bf16_t*)(p.ws + OFF_W2T);
    const float* g = p.in[27] + l * D;
#pragma unroll 1
    for (int k = 0; k < 8; ++k) { const int it = chunk * 64 + wave * 8 + k;
        if (it >= NEXP * 768) { const int x = it - NEXP * 768;
            if (x < 16 * 108) transpose_item(p.in[2] + (size_t)D * IN_D, D, IN_D, (bf16_t*)(p.ws + OFF_WTIN) + (size_t)IN_DP * D, 1, 0, p.in[1] + D, scr, x, lane);
            else if (x < 16 * 108 + 1024) { const int y = x - 16 * 108, lo = y >> 9; transpose_item(p.in[26] + (size_t)lo * D * D, D, D, (bf16_t*)(p.ws + OFF_WTOUT) + (size_t)lo * D * D, 1, 0, nullptr, scr, y & 511, lane); }
            continue; }
        const int e = it / 768, r = it % 768;
        if (r < 256) transpose_item(p.in[32] + ((size_t)l * NEXP + e) * D * FF, D, FF, W13 + (size_t)e * 1024 * D, 2, 0, g, scr, r, lane);
        else if (r < 512) transpose_item(p.in[33] + ((size_t)l * NEXP + e) * D * FF, D, FF, W13 + (size_t)e * 1024 * D, 2, 1, g, scr, r - 256, lane);
        else transpose_item(p.in[34] + ((size_t)l * NEXP + e) * FF * D, FF, D, W2 + (size_t)e * D * FF, 1, 0, nullptr, scr, r - 512, lane); }
}
__device__ __forceinline__ void phase_rownorm(const float* x, bf16_t* xb, float* rs, int G_, int bid, const int wvx) {
    const int tid = opaque_tid(wvx), lane = tid & 63, wave = tid >> 6;
    for (int row = bid * 8 + wave; row < NT; row += G_ * 8) {
        const f32x4* xr = (const f32x4*)(x + (size_t)row * D) + lane; f32x4 v[4]; float s = 0.f;
#pragma unroll
        for (int j = 0; j < 4; ++j) { v[j] = xr[64 * j]; s += (v[j].x * v[j].x + v[j].y * v[j].y) + (v[j].z * v[j].z + v[j].w * v[j].w); }
        s = wave_sum(s);
        if (lane == 0) rs[row] = 1.0f / sqrtf(s * (1.0f / D) + NORM_EPS);
        u32x2* o = (u32x2*)(xb + (size_t)row * D) + lane;
#pragma unroll
        for (int j = 0; j < 4; ++j) o[64 * j] = (u32x2){pk2(v[j].x, v[j].y), pk2(v[j].z, v[j].w)};
    }
}

__device__ __forceinline__ void load8(const bf16_t* p, bool ok, float* f) { if (ok) { unpack8(*(const u32x4*)p, f); } else {
#pragma unroll
    for (int j = 0; j < 8; ++j) f[j] = 0.f; } }

__device__ __forceinline__ void hy_pre_unit(const Params& p, LAS unsigned char* lds, int l, int unit, const int wvx) {
    const int tid = opaque_tid(wvx);
    const int ct = unit & 3, tt = (unit >> 2) & 127, b = unit >> 9;
    const bf16_t* proj = (const bf16_t*)(p.ws + OFF_PROJ);
    bf16_t* zT = (bf16_t*)(p.ws + OFF_ZT);
    const float* cw = p.in[3] + l * 3 * 768; const float* cb = p.in[4] + l * 768;
    LAS bf16_t* tile = (LAS bf16_t*)lds;
    {
        const int tl = tid >> 3, c8 = (tid & 7) * 8, t = tt * 64 + tl, c = ct * 64 + c8;
        const bf16_t* row = proj + ((size_t)b * L + t) * IN_DP;
        float x1[3][8], vv[3][8];
        load8(row - IN_DP + C_HX1 + c, t > 0, x1[0]); load8(row + C_HX1 + c, true, x1[1]); load8(row + IN_DP + C_HX1 + c, t < L - 1, x1[2]);
        load8(row - IN_DP + C_HV + c, t > 0, vv[0]); load8(row + C_HV + c, true, vv[1]); load8(row + IN_DP + C_HV + c, t < L - 1, vv[2]);
#pragma unroll
        for (int j = 0; j < 8; ++j) { const int c1 = C_HX1 + c + j, c2 = C_HV + c + j;
            const float a = x1[0][j] * cw[c1] + x1[1][j] * cw[768 + c1] + x1[2][j] * cw[1536 + c1] + cb[c1];
            const float v = vv[0][j] * cw[c2] + vv[1][j] * cw[768 + c2] + vv[2][j] * cw[1536 + c2] + cb[c2];
            tile[(c8 + j) * 72 + tl] = (bf16_t)f2bf(a * v); }
    }
    __syncthreads();
    {
        const int cl = tid >> 3, seg = tid & 7;
        const u32x4 w = *(const LAS u32x4*)(tile + cl * 72 + seg * 8);
        *(u32x4*)(zT + ((size_t)(ct * 64 + cl) * NB + b) * L + tt * 64 + seg * 8) = w;
    }
    __syncthreads();
}

typedef float f32x16 __attribute__((ext_vector_type(16)));
__device__ __forceinline__ void hy_conv_unit(const Params& p, LAS unsigned char* lds, int l, int c, const int wvx) {
    const int tid = opaque_tid(wvx), lane = tid & 63, wave = __builtin_amdgcn_readfirstlane(tid >> 6);
    const float* G = (const float*)(p.ws + OFF_FILT) + ((size_t)l * 256 + c) * 16384;
    const bf16_t* zT = (const bf16_t*)(p.ws + OFF_ZT) + (size_t)c * NB * L;
    float* yT = (float*)(p.ws + OFF_YT) + (size_t)c * NB * L;
    LAS bf16_t* Re = (LAS bf16_t*)lds; LAS bf16_t* Ro = Re + 16384;
    LAS unsigned char* Zs = lds + 65536;
    constexpr int ZB = 8976;
    LAS float* red = (LAS float*)(lds + 65536 + 8 * ZB);
    __syncthreads();
    float ss = 0.f; const float GF0 = G[8192];
#pragma unroll 1
    for (int i0 = 0; i0 < 16384; i0 += 8 * NTHREADS) { float gq[8];
#pragma unroll
        for (int k = 0; k < 8; ++k) gq[k] = G[i0 + k * NTHREADS + tid];
#pragma unroll
        for (int k = 0; k < 8; ++k) { const int i = i0 + k * NTHREADS + tid; const float g = gq[k]; ss += g * g;
            if (i == 8192) { Ro[16383] = 0; Re[0] = 0; }
            else { const int dl = (i < 8192) ? i : (8192 - i); const bf16_t bv = (bf16_t)f2bf(i == 0 ? g + GF0 : g); Re[8192 - dl] = bv; Ro[8191 - dl] = bv; } } }
    ss = wave_sum(ss); if (lane == 0) red[wave] = ss;
    f32x16 acc[2][4];
#pragma unroll
    for (int mt = 0; mt < 2; ++mt)
#pragma unroll
        for (int i = 0; i < 4; ++i)
#pragma unroll
            for (int e = 0; e < 16; ++e) acc[mt][i][e] = 0.f;
    const int r = lane & 31, hh = lane >> 5;
#pragma unroll 1
    for (int h = 0; h < 2; ++h) {
        __syncthreads();
        { u32x4 zq[9]; int tq = tid; asm volatile("" : "+v"(tq));
#pragma unroll
          for (int k = 0; k < 9; ++k) { const int q = tq + k * NTHREADS; const int ch = q & 7, Jp = (q >> 3) % 70, b = (q >> 3) / 70; const int J = 64 * h + Jp - 3;
            zq[k] = (u32x4){0u, 0u, 0u, 0u}; if (q < 4480 && Jp >= 3 && Jp < 67) zq[k] = *(const u32x4*)(zT + (size_t)b * L + J * 64 + ch * 8); }
#pragma unroll
          for (int k = 0; k < 9; ++k) { const int q = tq + k * NTHREADS; const int ch = q & 7, Jp = (q >> 3) % 70, b = (q >> 3) / 70;
            if (q < 4480) *(LAS u32x4*)(Zs + b * ZB + Jp * 128 + ch * 16) = zq[k]; } }
        __syncthreads();
        int d_hi = 16 * wave + 15 - 64 * h, d_lo = 16 * wave - 64 * h - 63; d_hi = d_hi > 127 ? 127 : d_hi; d_lo = d_lo < -127 ? -127 : d_lo;
        int mlo = 16 * wave - 64 * h - 51, mhi = 16 * wave - 64 * h + 3; mlo = mlo < d_lo ? d_lo : mlo; mhi = mhi > d_hi ? d_hi : mhi; if (mlo > mhi) { mlo = d_hi + 1; mhi = d_hi; }
        const int abase = 8192 + 8 * hh - r - (r & 1) - 32;
        const LAS unsigned char* arow = lds + (r & 1) * 32768 + abase * 2;
        const LAS unsigned char* brow = Zs + (r & 7) * ZB + ((r >> 3) + 16 * wave - 64 * h + 3) * 128 + hh * 16;
#pragma unroll 1
        for (int part = 0; part < 2; ++part) {
            const int ga = part ? mhi + 1 : d_lo, gb = part ? d_hi : mlo - 1;
#pragma unroll 1
            for (int d = ga; d <= gb; ++d) {
                const int J0b = 16 * wave - d;
                const LAS unsigned* ap = (const LAS unsigned*)(arow - 128 * d);
                bf16x8 Af[2][4];
#pragma unroll
                for (int mt = 0; mt < 2; ++mt)
#pragma unroll
                    for (int ks = 0; ks < 4; ++ks) { const LAS unsigned* q = ap + (16 * ks + 32 * (1 - mt)) / 2; const u32x4 t = (u32x4){q[0], q[1], q[2], q[3]}; Af[mt][ks] = __builtin_bit_cast(bf16x8, t); }
                const LAS unsigned char* bp = brow - 128 * d;
#pragma unroll
                for (int i = 0; i < 4; ++i) { const int J0 = J0b + 4 * i;
                    if (J0 + 3 >= 64 * h && J0 <= 64 * h + 63) {
                        bf16x8 Bf[4];
#pragma unroll
                        for (int ks = 0; ks < 4; ++ks) Bf[ks] = *(const LAS bf16x8*)(bp + i * 512 + ks * 32);
#pragma unroll
                        for (int ks = 0; ks < 4; ++ks)
#pragma unroll
                            for (int mt = 0; mt < 2; ++mt) acc[mt][i] = __builtin_amdgcn_mfma_f32_32x32x16_bf16(Af[mt][ks], Bf[ks], acc[mt][i], 0, 0, 0);
                    } }
            }
            if (part == 0 && mlo <= mhi) {
#define HC_LDA(dst, p_, k_) do { const LAS unsigned* q_ = (const LAS unsigned*)(p_) + 8 * (k_); const u32x4 t_ = (u32x4){q_[0], q_[1], q_[2], q_[3]}; dst = __builtin_bit_cast(bf16x8, t_); } while (0)
#define HC_LDB(dst, p_, i_) do { _Pragma("unroll") for (int ks = 0; ks < 4; ++ks) dst[ks] = *(const LAS bf16x8*)((p_) + (i_) * 512 + ks * 32); } while (0)
#define HC_MMA(i_, Bx) do { _Pragma("unroll") for (int ks = 0; ks < 4; ++ks) { acc[1][i_] = __builtin_amdgcn_mfma_f32_32x32x16_bf16(F[ks], Bx[ks], acc[1][i_], 0, 0, 0); \
                                acc[0][i_] = __builtin_amdgcn_mfma_f32_32x32x16_bf16(F[ks + 2], Bx[ks], acc[0][i_], 0, 0, 0); } } while (0)
                bf16x8 F[6], B0[4], B1[4];
                { const LAS unsigned char* ap = arow - 128 * mlo;
#pragma unroll
                  for (int k = 0; k < 6; ++k) HC_LDA(F[k], ap, k); }
#pragma unroll 1
                for (int d = mlo; d <= mhi; ++d) {
                    const LAS unsigned char* bp = brow - 128 * d;
                    HC_LDB(B0, bp, 0);
                    HC_LDB(B1, bp, 1); __builtin_amdgcn_sched_barrier(0); HC_MMA(0, B0); __builtin_amdgcn_sched_barrier(0);
                    HC_LDB(B0, bp, 2); __builtin_amdgcn_sched_barrier(0); HC_MMA(1, B1); __builtin_amdgcn_sched_barrier(0);
                    HC_LDB(B1, bp, 3); __builtin_amdgcn_sched_barrier(0); HC_MMA(2, B0); __builtin_amdgcn_sched_barrier(0);
                    bf16x8 Fn[4];
                    { const LAS unsigned char* apn = arow - 128 * (d + 1);
#pragma unroll
                      for (int k = 0; k < 4; ++k) HC_LDA(Fn[k], apn, k); }
                    __builtin_amdgcn_sched_barrier(0); HC_MMA(3, B1); __builtin_amdgcn_sched_barrier(0);
                    F[4] = F[0]; F[5] = F[1]; F[0] = Fn[0]; F[1] = Fn[1]; F[2] = Fn[2]; F[3] = Fn[3];
                }
#undef HC_LDA
#undef HC_LDB
#undef HC_MMA
            }
        }
    }
    float tot = 0.f;
#pragma unroll
    for (int w = 0; w < 8; ++w) tot += red[w];
    const float scale = 1.0f / sqrtf(tot + 1e-6f);
#pragma unroll
    for (int mt = 0; mt < 2; ++mt)
#pragma unroll
        for (int i = 0; i < 4; ++i)
#pragma unroll
            for (int g = 0; g < 4; ++g) { const int t = 64 * (16 * wave + 4 * i + (r >> 3)) + 32 * mt + 8 * g + 4 * hh;
                const f32x4 v = (f32x4){acc[mt][i][4 * g] * scale, acc[mt][i][4 * g + 1] * scale, acc[mt][i][4 * g + 2] * scale, acc[mt][i][4 * g + 3] * scale};
                *(f32x4*)(yT + (size_t)(r & 7) * L + t) = v; }
    __syncthreads();
}

__device__ __forceinline__ void hy_post_unit(const Params& p, LAS unsigned char* lds, int l, int unit, const int wvx) {
    const int tid = opaque_tid(wvx);
    const int ct = unit & 3, tt = (unit >> 2) & 127, b = unit >> 9;
    const bf16_t* proj = (const bf16_t*)(p.ws + OFF_PROJ);
    const bf16_t* zT = (const bf16_t*)(p.ws + OFF_ZT);
    const float* yT = (const float*)(p.ws + OFF_YT);
    bf16_t* mix = (bf16_t*)(p.ws + OFF_MIX);
    const float* cw = p.in[3] + l * 3 * 768; const float* cb = p.in[4] + l * 768; const float* skip = p.in[13] + l * 256;
    LAS float* tile = (LAS float*)lds;
    {
        const int cl = tid >> 3, seg = tid & 7, c = ct * 64 + cl;
        const size_t off = ((size_t)c * NB + b) * L + tt * 64 + seg * 8;
        float z[8]; unpack8(*(const u32x4*)(zT + off), z);
        const f32x4 y0 = *(const f32x4*)(yT + off), y1 = *(const f32x4*)(yT + off + 4);
        const float sk = skip[c];
        tile[cl * 65 + seg * 8 + 0] = y0.x + z[0] * sk; tile[cl * 65 + seg * 8 + 1] = y0.y + z[1] * sk; tile[cl * 65 + seg * 8 + 2] = y0.z + z[2] * sk; tile[cl * 65 + seg * 8 + 3] = y0.w + z[3] * sk;
        tile[cl * 65 + seg * 8 + 4] = y1.x + z[4] * sk; tile[cl * 65 + seg * 8 + 5] = y1.y + z[5] * sk; tile[cl * 65 + seg * 8 + 6] = y1.z + z[6] * sk; tile[cl * 65 + seg * 8 + 7] = y1.w + z[7] * sk;
    }
    __syncthreads();
    {
        const int tl = tid >> 3, c8 = (tid & 7) * 8, t = tt * 64 + tl, c = ct * 64 + c8;
        const bf16_t* row = proj + ((size_t)b * L + t) * IN_DP;
        float x0[3][8];
        load8(row - IN_DP + C_HX0 + c, t > 0, x0[0]); load8(row + C_HX0 + c, true, x0[1]); load8(row + IN_DP + C_HX0 + c, t < L - 1, x0[2]);
        float o[8];
#pragma unroll
        for (int j = 0; j < 8; ++j) { const int c0 = c + j; const float a = x0[0][j] * cw[c0] + x0[1][j] * cw[768 + c0] + x0[2][j] * cw[1536 + c0] + cb[c0];
            o[j] = a * tile[(c8 + j) * 65 + tl]; }
        u32x4 w; w.x = pk2(o[0], o[1]); w.y = pk2(o[2], o[3]); w.z = pk2(o[4], o[5]); w.w = pk2(o[6], o[7]);
        *(u32x4*)(mix + ((size_t)b * L + t) * D + c) = w;
    }
    __syncthreads();
}


__device__ __forceinline__ void hy_pre_unit4(const Params& p, LAS unsigned char* lds, int l, int unit, const int wvx) {
    const int tid = opaque_tid(wvx);
    const int tt = unit & 127, b = unit >> 7;
    const bf16_t* proj = (const bf16_t*)(p.ws + OFF_PROJ);
    bf16_t* zT = (bf16_t*)(p.ws + OFF_ZT);
    const float* cw = p.in[3] + l * 3 * 768; const float* cb = p.in[4] + l * 768;
    LAS bf16_t* tile = (LAS bf16_t*)lds;
    const int tl = tid >> 3, c8 = (tid & 7) * 8, t = tt * 64 + tl;
    const bf16_t* row = proj + ((size_t)b * L + t) * IN_DP;
    const bool hp = t > 0, hn = t < L - 1;
    u32x4 rx[4][3], rv[4][3];
#pragma unroll
    for (int ct = 0; ct < 4; ++ct) { const int c = ct * 64 + c8;
        rx[ct][0] = *(const u32x4*)(row + (hp ? -IN_DP : 0) + C_HX1 + c); rx[ct][1] = *(const u32x4*)(row + C_HX1 + c); rx[ct][2] = *(const u32x4*)(row + (hn ? IN_DP : 0) + C_HX1 + c);
        rv[ct][0] = *(const u32x4*)(row + (hp ? -IN_DP : 0) + C_HV + c); rv[ct][1] = *(const u32x4*)(row + C_HV + c); rv[ct][2] = *(const u32x4*)(row + (hn ? IN_DP : 0) + C_HV + c); }
    const float mp = hp ? 1.f : 0.f, mn = hn ? 1.f : 0.f;
#pragma unroll
    for (int ct = 0; ct < 4; ++ct) { const int c = ct * 64 + c8;
        float x1[3][8], vv[3][8]; unpack8(rx[ct][0], x1[0]); unpack8(rx[ct][1], x1[1]); unpack8(rx[ct][2], x1[2]); unpack8(rv[ct][0], vv[0]); unpack8(rv[ct][1], vv[1]); unpack8(rv[ct][2], vv[2]);
        float wa[3][8], wb[3][8], ba[8], bb[8];
#pragma unroll
        for (int k = 0; k < 3; ++k) { const f32x4 a0 = *(const f32x4*)(cw + k * 768 + C_HX1 + c), a1 = *(const f32x4*)(cw + k * 768 + C_HX1 + c + 4), b0 = *(const f32x4*)(cw + k * 768 + C_HV + c), b1 = *(const f32x4*)(cw + k * 768 + C_HV + c + 4);
            wa[k][0] = a0.x; wa[k][1] = a0.y; wa[k][2] = a0.z; wa[k][3] = a0.w; wa[k][4] = a1.x; wa[k][5] = a1.y; wa[k][6] = a1.z; wa[k][7] = a1.w;
            wb[k][0] = b0.x; wb[k][1] = b0.y; wb[k][2] = b0.z; wb[k][3] = b0.w; wb[k][4] = b1.x; wb[k][5] = b1.y; wb[k][6] = b1.z; wb[k][7] = b1.w; }
        { const f32x4 a0 = *(const f32x4*)(cb + C_HX1 + c), a1 = *(const f32x4*)(cb + C_HX1 + c + 4), b0 = *(const f32x4*)(cb + C_HV + c), b1 = *(const f32x4*)(cb + C_HV + c + 4);
            ba[0] = a0.x; ba[1] = a0.y; ba[2] = a0.z; ba[3] = a0.w; ba[4] = a1.x; ba[5] = a1.y; ba[6] = a1.z; ba[7] = a1.w; bb[0] = b0.x; bb[1] = b0.y; bb[2] = b0.z; bb[3] = b0.w; bb[4] = b1.x; bb[5] = b1.y; bb[6] = b1.z; bb[7] = b1.w; }
#pragma unroll
        for (int j = 0; j < 8; ++j) {
            const float a = mp * x1[0][j] * wa[0][j] + x1[1][j] * wa[1][j] + mn * x1[2][j] * wa[2][j] + ba[j];
            const float v = mp * vv[0][j] * wb[0][j] + vv[1][j] * wb[1][j] + mn * vv[2][j] * wb[2][j] + bb[j];
            tile[(c + j) * 72 + tl] = (bf16_t)f2bf(a * v); } }
    __syncthreads();
#pragma unroll
    for (int ct = 0; ct < 4; ++ct) { const int cl = ct * 64 + (tid >> 3), seg = tid & 7;
        const u32x4 w = *(const LAS u32x4*)(tile + cl * 72 + seg * 8);
        *(u32x4*)(zT + ((size_t)cl * NB + b) * L + tt * 64 + seg * 8) = w; }
    __syncthreads();
}
__device__ __forceinline__ void hy_post_unit4(const Params& p, LAS unsigned char* lds, int l, int unit, const int wvx) {
    const int tid = opaque_tid(wvx);
    const int tt = unit & 127, b = unit >> 7;
    const bf16_t* proj = (const bf16_t*)(p.ws + OFF_PROJ);
    const bf16_t* zT = (const bf16_t*)(p.ws + OFF_ZT);
    const float* yT = (const float*)(p.ws + OFF_YT);
    bf16_t* mix = (bf16_t*)(p.ws + OFF_MIX);
    const float* cw = p.in[3] + l * 3 * 768; const float* cb = p.in[4] + l * 768; const float* skip = p.in[13] + l * 256;
    LAS float* tile = (LAS float*)lds;
    {
        u32x4 zq[4]; f32x4 y0q[4], y1q[4]; float skq[4];
#pragma unroll
        for (int ct = 0; ct < 4; ++ct) { const int c = ct * 64 + (tid >> 3), seg = tid & 7; const size_t off = ((size_t)c * NB + b) * L + tt * 64 + seg * 8;
            zq[ct] = *(const u32x4*)(zT + off); y0q[ct] = *(const f32x4*)(yT + off); y1q[ct] = *(const f32x4*)(yT + off + 4); skq[ct] = skip[c]; }
#pragma unroll
        for (int ct = 0; ct < 4; ++ct) { const int cl = ct * 64 + (tid >> 3), seg = tid & 7; float z[8]; unpack8(zq[ct], z); const float sk = skq[ct]; LAS float* tp = tile + cl * 65 + seg * 8;
            tp[0] = y0q[ct].x + z[0] * sk; tp[1] = y0q[ct].y + z[1] * sk; tp[2] = y0q[ct].z + z[2] * sk; tp[3] = y0q[ct].w + z[3] * sk;
            tp[4] = y1q[ct].x + z[4] * sk; tp[5] = y1q[ct].y + z[5] * sk; tp[6] = y1q[ct].z + z[6] * sk; tp[7] = y1q[ct].w + z[7] * sk; }
    }
    __syncthreads();
    {
        const int tl = tid >> 3, c8 = (tid & 7) * 8, t = tt * 64 + tl;
        const bf16_t* row = proj + ((size_t)b * L + t) * IN_DP;
        const bool hp = t > 0, hn = t < L - 1; const float mp = hp ? 1.f : 0.f, mn = hn ? 1.f : 0.f;
        u32x4 r0[4], r1[4], r2[4];
#pragma unroll
        for (int ct = 0; ct < 4; ++ct) { const int c = ct * 64 + c8; r0[ct] = *(const u32x4*)(row + (hp ? -IN_DP : 0) + C_HX0 + c); r1[ct] = *(const u32x4*)(row + C_HX0 + c); r2[ct] = *(const u32x4*)(row + (hn ? IN_DP : 0) + C_HX0 + c); }
#pragma unroll
        for (int ct = 0; ct < 4; ++ct) { const int c = ct * 64 + c8;
            float x0[3][8]; unpack8(r0[ct], x0[0]); unpack8(r1[ct], x0[1]); unpack8(r2[ct], x0[2]);
            float o[8];
#pragma unroll
            for (int j = 0; j < 8; ++j) { const int c0 = c + j; const float a = mp * x0[0][j] * cw[c0] + x0[1][j] * cw[768 + c0] + mn * x0[2][j] * cw[1536 + c0] + cb[c0];
                o[j] = a * tile[(c + j) * 65 + tl]; }
            u32x4 w; w.x = pk2(o[0], o[1]); w.y = pk2(o[2], o[3]); w.z = pk2(o[4], o[5]); w.w = pk2(o[6], o[7]);
            *(u32x4*)(mix + ((size_t)b * L + t) * D + c) = w; }
    }
    __syncthreads();
}


__device__ __forceinline__ void wg_signal(int* ctr, const bool leader) {
    asm volatile("s_waitcnt vmcnt(0)" ::: "memory");
    __syncthreads();
    if (leader) { __builtin_amdgcn_fence(__ATOMIC_RELEASE, "agent"); asm volatile("s_waitcnt vmcnt(0)" ::: "memory"); __hip_atomic_fetch_add(ctr, 1, __ATOMIC_RELAXED, __HIP_MEMORY_SCOPE_AGENT); }
}
__device__ __forceinline__ void wg_wait(int* ctr, int target, const bool leader) {
    if (leader) { unsigned sp = 0;
        while (__hip_atomic_load(ctr, __ATOMIC_RELAXED, __HIP_MEMORY_SCOPE_AGENT) < target) { __builtin_amdgcn_s_sleep(2); if (++sp > (1u << 24)) break; }
        __builtin_amdgcn_fence(__ATOMIC_ACQUIRE, "agent"); asm volatile("s_waitcnt vmcnt(0)" ::: "memory"); }
    __syncthreads();
}
__device__ __forceinline__ int wg_pop(int* ctr, LAS int* qw, const bool leader) {
    __syncthreads();
    if (leader) *qw = __hip_atomic_fetch_add(ctr, 1, __ATOMIC_RELAXED, __HIP_MEMORY_SCOPE_AGENT);
    __syncthreads();
    return __builtin_amdgcn_readfirstlane(*qw);
}
__device__ __forceinline__ void rw_prep_unit(const Params& p, int l, int unit, const int wvx) {
    const int tid = opaque_tid(wvx), cg = tid & 63, rg = tid >> 6;
    const int lev = unit >> 4, b = unit & 7; const int c = (unit & 8) ? 127 - lev : lev;
    const int t0 = c * 64 + rg * 8, col = cg * 8;
    const bf16_t* proj = (const bf16_t*)(p.ws + OFF_PROJ);
    bf16_t* PR = (bf16_t*)p.out;
    u32x4 raw[3][10];
#pragma unroll
    for (int w = 0; w < 3; ++w)
#pragma unroll
        for (int i = 0; i < 10; ++i) { const int t = t0 - 1 + i; const int tc = t < 0 ? 0 : (t > L - 1 ? L - 1 : t);
            raw[w][i] = *(const u32x4*)(proj + ((size_t)b * L + tc) * IN_DP + C_RR + w * 512 + col); }
    { const u32x4 z = (u32x4){0u, 0u, 0u, 0u};
      if (t0 == 0) { raw[0][0] = z; raw[1][0] = z; raw[2][0] = z; }
      if (t0 + 8 == L) { raw[0][9] = z; raw[1][9] = z; raw[2][9] = z; } }
    const float* mu = p.in[14] + (size_t)l * 3 * 2 * 512;
#pragma unroll
    for (int w = 0; w < 3; ++w) {
        float m0[8], m1[8], kk_[8];
        { const f32x4 a = *(const f32x4*)(mu + w * 1024 + col), b2 = *(const f32x4*)(mu + w * 1024 + col + 4), c = *(const f32x4*)(mu + w * 1024 + 512 + col), d = *(const f32x4*)(mu + w * 1024 + 512 + col + 4);
          m0[0] = a.x; m0[1] = a.y; m0[2] = a.z; m0[3] = a.w; m0[4] = b2.x; m0[5] = b2.y; m0[6] = b2.z; m0[7] = b2.w;
          m1[0] = c.x; m1[1] = c.y; m1[2] = c.z; m1[3] = c.w; m1[4] = d.x; m1[5] = d.y; m1[6] = d.z; m1[7] = d.w; }
        if (w == 1) { const f32x4 a = *(const f32x4*)(p.in[19] + l * 512 + col), b2 = *(const f32x4*)(p.in[19] + l * 512 + col + 4);
          kk_[0] = a.x; kk_[1] = a.y; kk_[2] = a.z; kk_[3] = a.w; kk_[4] = b2.x; kk_[5] = b2.y; kk_[6] = b2.z; kk_[7] = b2.w; }
#pragma unroll
        for (int j = 0; j < 8; ++j) {
            float xp[8], xc[8], xn[8], y[8];
            unpack8(raw[w][j], xp); unpack8(raw[w][j + 1], xc); unpack8(raw[w][j + 2], xn);
#pragma unroll
            for (int e = 0; e < 8; ++e) y[e] = xc[e] + m0[e] * (xp[e] - xc[e]) + m1[e] * (xn[e] - xc[e]);
            const size_t ro = ((size_t)b * L + t0 + j) * 512 + col;
            *(u32x4*)(PR + (size_t)w * NT * 512 + ro) = (u32x4){pk2(y[0], y[1]), pk2(y[2], y[3]), pk2(y[4], y[5]), pk2(y[6], y[7])};
            if (w == 1) { float kr[8], ss = 0.f;
#pragma unroll
                for (int e = 0; e < 8; ++e) { kr[e] = y[e] * kk_[e]; ss += kr[e] * kr[e]; }
                ss = sum8(ss);
                const float rn_ = __builtin_amdgcn_rsqf(fmaxf(ss, 1e-24f));
                *(u32x4*)(PR + (size_t)3 * NT * 512 + ro) = (u32x4){pk2(kr[0] * rn_, kr[1] * rn_), pk2(kr[2] * rn_, kr[3] * rn_), pk2(kr[4] * rn_, kr[5] * rn_), pk2(kr[6] * rn_, kr[7] * rn_)}; }
        }
    }
}

namespace rw {
constexpr int MATB = 9216, PITCH = 144;
constexpr int O_W2T = 0, O_A2T = MATB, O_SB = 2 * MATB, O_GBUF = 3 * MATB, O_SLOT = O_GBUF + 16384;
constexpr int O_GC = O_SLOT + 12 * MATB, O_TPP = O_GC + 512, O_CT = O_TPP + 2560;
__device__ __forceinline__ constexpr int slot(int k) { return O_SLOT + k * MATB; }
#define MFMA16(a, b, c) __builtin_amdgcn_mfma_f32_16x16x32_bf16((a), (b), (c), 0, 0, 0)
__device__ __forceinline__ f32x4 tile64(const LAS unsigned char* A, const LAS unsigned char* Bt, int rt, int ct, int fr, int fq, f32x4 acc) {
#pragma unroll
    for (int ks = 0; ks < 2; ++ks) { const bf16x8 a = *(const LAS bf16x8*)(A + (16 * rt + fr) * PITCH + ks * 64 + fq * 16); const bf16x8 b = *(const LAS bf16x8*)(Bt + (16 * ct + fr) * PITCH + ks * 64 + fq * 16);
        acc = MFMA16(a, b, acc); }
    return acc;
}
__device__ __forceinline__ unsigned pkbf(float lo, float hi) { return pg8::cvt_pk_bf16(lo, hi); }
}

namespace rw {
typedef short s16x4 __attribute__((ext_vector_type(4)));
__device__ __forceinline__ bf16x8 fragN(const LAS unsigned char* img, int row, int ks, int fq) { return *(const LAS bf16x8*)(img + row * PITCH + ks * 64 + fq * 16); }
__device__ __forceinline__ bf16x8 fragP(const LAS unsigned char* img, int row, int ks, int fq) {
    const u32x2 a = *(const LAS u32x2*)(img + row * PITCH + (32 * ks + 4 * fq) * 2), b = *(const LAS u32x2*)(img + row * PITCH + (32 * ks + 16 + 4 * fq) * 2);
    const u32x4 v = (u32x4){a.x, a.y, b.x, b.y}; return __builtin_bit_cast(bf16x8, v); }
__device__ __forceinline__ bf16x8 fragT(const LAS unsigned char* img, int c0, int ks, int fr, int fq) {
    const LAS unsigned char* q = img + (32 * ks + 4 * fq + (fr >> 2)) * PITCH + (c0 + 4 * (fr & 3)) * 2;
    const s16x4 a = __builtin_amdgcn_ds_read_tr16_b64_v4i16((LAS s16x4*)q), b = __builtin_amdgcn_ds_read_tr16_b64_v4i16((LAS s16x4*)(q + 16 * PITCH));
    return (bf16x8){a[0], a[1], a[2], a[3], b[0], b[1], b[2], b[3]}; }
}

__device__ __forceinline__ void rw_chain_unit(const Params& p, LAS unsigned char* lds, int l, int unit, const int wvx) {
    using namespace rw;
    const int tid = opaque_tid(wvx), wave = __builtin_amdgcn_readfirstlane(tid >> 6);
    const int dir = unit & 1, h = (unit >> 1) & 7, b = unit >> 4;
    const bf16_t* proj = (const bf16_t*)(p.ws + OFF_PROJ);
    unsigned short* Y = (unsigned short*)(p.ws + (dir ? OFF_YB : OFF_YF));
    LAS float* gbuf = (LAS float*)(lds + O_GBUF);
    LAS float* GC = (LAS float*)(lds + O_GC);
    LAS bf16_t* TPP = (LAS bf16_t*)(lds + O_TPP);
    LAS float* CT = (LAS float*)(lds + O_CT);
    float* BON = (float*)(p.ws + OFF_BON) + (size_t)dir * NT * 8;
    const bf16_t* PR = (const bf16_t*)p.out;
    int* prep_ctr = (int*)(p.ws + OFF_CTL) + 32 + l * 16 + 8;
    __syncthreads();
    {
        const float* w2 = p.in[16] + ((size_t)l * 2 + dir) * 64 * 512 + h * 64; const float* a2 = p.in[18] + ((size_t)l * 2 + dir) * 64 * 512 + h * 64;
        for (int i = tid; i < 4096; i += NTHREADS) { const int r = i >> 6, n = i & 63;
            *(LAS bf16_t*)(lds + O_W2T + n * PITCH + r * 2) = (bf16_t)f2bf(w2[r * 512 + n]); *(LAS bf16_t*)(lds + O_A2T + n * PITCH + r * 2) = (bf16_t)f2bf(a2[r * 512 + n]); }
        for (int i = tid; i < MATB / 4; i += NTHREADS) ((LAS unsigned*)(lds + O_SB))[i] = 0u;
        for (int i = tid; i < 704; i += NTHREADS) { const int row = i >> 6, n = i & 63, col = h * 64 + n; float v;
            if (row < 6) v = 0.f;
            else if (row == 6) v = p.in[15][((size_t)l * 2 + dir) * 512 + col];
            else if (row == 7) v = p.in[17][((size_t)l * 2 + dir) * 512 + col];
            else if (row == 8) v = p.in[19][l * 512 + col];
            else if (row == 9) v = p.in[20][l * 512 + col];
            else v = p.in[21][l * 512 + col];
            CT[i] = v; }
    }
    const int rt = wave >> 1, chh = wave & 1;
    u32x4 pre[16];
#define F4(x) __builtin_bit_cast(f32x4, (x))
#define U4(x) __builtin_bit_cast(u32x4, (x))
#define issue_rkv(CC, HALF) do { const int t0n_ = (dir ? (L / 64 - 1 - (CC)) : (CC)) * 64; int tq_ = tid; asm volatile("" : "+v"(tq_));     \
        const int ppn = ((tq_ & 255) >> 3) + 32 * (HALF); const int ttn = dir ? (t0n_ + 63 - ppn) : (t0n_ + ppn); const bf16_t* row = PR + ((size_t)b * L + ttn) * 512 + h * 64 + (tq_ & 7) * 8; \
        _Pragma("unroll") for (int k = 0; k < 4; ++k) pre[4 * (HALF) + k] = *(const u32x4*)(row + (size_t)k * NT * 512); } while (0)
#define issue_lora(CC) do { const int t0n_ = (dir ? (L / 64 - 1 - (CC)) : (CC)) * 64; int tq_ = tid; asm volatile("" : "+v"(tq_)); \
        { const int kq_ = ((tq_ >> 4) & 3) * 8, cbase = (wave == 7 ? C_RA : C_RW) + dir * 64; \
          _Pragma("unroll") for (int r4 = 0; r4 < 4; ++r4) { const int pq_ = 16 * r4 + (tq_ & 15); const int ttn = dir ? (t0n_ + 63 - pq_) : (t0n_ + pq_); const bf16_t* row = proj + ((size_t)b * L + ttn) * IN_DP; \
            pre[8 + 2 * r4] = *(const u32x4*)(row + cbase + kq_); pre[9 + 2 * r4] = *(const u32x4*)(row + cbase + 32 + kq_); } } } while (0)
    wg_wait(prep_ctr, 128, tid == 0);
    issue_rkv(0, 0); issue_rkv(0, 1); issue_lora(0);
#pragma unroll 1
    for (int cc = -1; cc < L / 64; ++cc) {
        const bool cons = cc >= 0, prod = cc + 1 < L / 64;
        const int cn = cc + 1;
        const int t0 = (dir ? (L / 64 - 1 - cc) : cc) * 64, t0n = (dir ? (L / 64 - 1 - cn) : cn) * 64;
        int tq = tid; asm volatile("" : "+v"(tq));
        const int fr = tq & 15, fq = (tq >> 4) & 3;
        const int bbn = (cn & 1) ? slot(9) : slot(7), bbc = (cc & 1) ? slot(9) : slot(7);
        if (cc + 2 < 64 && ((cc + 2) & 7) == 0) wg_wait(prep_ctr + ((cc + 2) >> 3), 128, tid == 0);
        __syncthreads();
        if (wave < 4) {
            if (cons) {
#pragma unroll
                for (int q = 0; q < 12; ++q) pre[q] = (u32x4){0u, 0u, 0u, 0u};
                const bf16x8 s0 = fragN(lds + O_SB, 16 * wave + fr, 0, fq), s1 = fragN(lds + O_SB, 16 * wave + fr, 1, fq), v0 = fragT(lds + slot(6), 16 * wave, 0, fr, fq), v1 = fragT(lds + slot(6), 16 * wave, 1, fr, fq);
#pragma unroll
                for (int q = 0; q < 4; ++q) { f32x4 a = F4(pre[q]);
                    a = MFMA16(fragN(lds + slot(3), 16 * q + fr, 0, fq), s0, a); a = MFMA16(fragN(lds + slot(3), 16 * q + fr, 1, fq), s1, a);
                    a = MFMA16(fragT(lds + slot(0), 16 * q, 0, fr, fq), v0, a); if (q >= 2) a = MFMA16(fragT(lds + slot(0), 16 * q, 1, fr, fq), v1, a);
                    pre[q] = U4(a);
                    f32x4 kx = F4(pre[4 + q]); kx = MFMA16(fragT(lds + slot(8), 16 * q, 0, fr, fq), v0, kx); kx = MFMA16(fragT(lds + slot(8), 16 * q, 1, fr, fq), v1, kx); pre[4 + q] = U4(kx);
                    f32x4 y = F4(pre[8 + q]);
                    y = MFMA16(fragN(lds + slot(4), 16 * q + fr, 0, fq), s0, y); y = MFMA16(fragN(lds + slot(4), 16 * q + fr, 1, fq), s1, y);
                    y = MFMA16(fragT(lds + slot(2), 16 * q, 0, fr, fq), v0, y); if (q >= 2) y = MFMA16(fragT(lds + slot(2), 16 * q, 1, fr, fq), v1, y);
                    pre[8 + q] = U4(y);
                    asm volatile("" ::: "memory"); }
            }
        } else if (wave == 4) {
            if (cons) {
                const int pb = fq, j = fr; float T[16];
#pragma unroll
                for (int q = 0; q < 16; ++q) T[q] = (q == j) ? 1.f : 0.f;
#pragma unroll
                for (int sg = 0; sg < 4; ++sg) {
                    u32x4 ar[4][2];
#pragma unroll
                    for (int r4 = 0; r4 < 4; ++r4) { ar[r4][0] = *(const LAS u32x4*)(lds + slot(11) + (16 * pb + 4 * sg + r4) * PITCH + 32 * pb); ar[r4][1] = *(const LAS u32x4*)(lds + slot(11) + (16 * pb + 4 * sg + r4) * PITCH + 32 * pb + 16); }
#pragma unroll
                    for (int r4 = 0; r4 < 4; ++r4) { const int s2 = 4 * sg + r4; float av[16]; unpack8(ar[r4][0], av); unpack8(ar[r4][1], av + 8);
#pragma unroll
                        for (int q = s2 + 1; q < 16; ++q) T[q] += av[q] * T[s2]; }
                    asm volatile("" ::: "memory");
                }
#pragma unroll
                for (int q = 0; q < 16; ++q) TPP[(pb * 16 + q) * 20 + j] = (bf16_t)f2bf(T[q]);
            }
        } else if (wave <= 6) {
            if (prod) {
#pragma unroll
                for (int gi = 0; gi < 2; ++gi) { const int cgp = 2 * (wave - 5) + gi;
                    const float w0n = CT[6 * 64 + 16 * cgp + fr];
                    const bf16x8 wb0 = fragN(lds + O_W2T, 16 * cgp + fr, 0, fq), wb1 = fragN(lds + O_W2T, 16 * cgp + fr, 1, fq);
                    u32x2 lwp[4];
#pragma unroll
                    for (int r4 = 0; r4 < 4; ++r4) {
                        f32x4 wv = (f32x4){0.f, 0.f, 0.f, 0.f}; wv = MFMA16(__builtin_bit_cast(bf16x8, pre[8 + 2 * r4]), wb0, wv); wv = MFMA16(__builtin_bit_cast(bf16x8, pre[9 + 2 * r4]), wb1, wv);
                        float lwv[4];
#pragma unroll
                        for (int e = 0; e < 4; ++e) lwv[e] = -0.60653066f * frcp(1.0f + __expf(-(wv[e] + w0n)));
                        lwp[r4] = (u32x2){pk2(lwv[0], lwv[1]), pk2(lwv[2], lwv[3])}; }
#pragma unroll
                    for (int r4 = 0; r4 < 4; ++r4) { f32x4 g = (f32x4){0.f, 0.f, 0.f, 0.f};
#pragma unroll
                        for (int ks = 0; ks < 2; ++ks) if (32 * ks <= 16 * r4 + 15) {
                            const int pa = 16 * r4 + fr - 32 * ks - 4 * fq, pb2 = pa - 16;
                            u32x4 lt; unsigned one2 = 0x3F803F80u; asm volatile("" : "+s"(one2));
                            lt.x = (pa >= 1 ? one2 : (pa == 0 ? 0x00003F80u : 0u)); lt.y = (pa >= 3 ? one2 : (pa == 2 ? 0x00003F80u : 0u));
                            lt.z = (pb2 >= 1 ? one2 : (pb2 == 0 ? 0x00003F80u : 0u)); lt.w = (pb2 >= 3 ? one2 : (pb2 == 2 ? 0x00003F80u : 0u));
                            const u32x4 bv = (u32x4){lwp[2 * ks].x, lwp[2 * ks].y, lwp[2 * ks + 1].x, lwp[2 * ks + 1].y};
                            g = MFMA16(__builtin_bit_cast(bf16x8, lt), __builtin_bit_cast(bf16x8, bv), g); }
#pragma unroll
                        for (int e = 0; e < 4; ++e) gbuf[(16 * r4 + 4 * fq + e) * 64 + 16 * cgp + fr] = g[e]; }
                    asm volatile("" ::: "memory"); }
                if (cn + 1 < L / 64) issue_lora(cn + 1);
            }
        } else {
            if (prod) {
#pragma unroll
                for (int cgp = 0; cgp < 4; ++cgp) {
                    const bf16x8 ab0 = fragN(lds + O_A2T, 16 * cgp + fr, 0, fq), ab1 = fragN(lds + O_A2T, 16 * cgp + fr, 1, fq);
#pragma unroll
                    for (int r4 = 0; r4 < 4; ++r4) { f32x4 av = (f32x4){0.f, 0.f, 0.f, 0.f};
                        av = MFMA16(__builtin_bit_cast(bf16x8, pre[8 + 2 * r4]), ab0, av); av = MFMA16(__builtin_bit_cast(bf16x8, pre[9 + 2 * r4]), ab1, av);
#pragma unroll
                        for (int e = 0; e < 4; ++e) *(LAS bf16_t*)(lds + slot(5) + (16 * r4 + 4 * fq + e) * PITCH + (16 * cgp + fr) * 2) = (bf16_t)f2bf(av[e]); }
                    asm volatile("" ::: "memory"); }
                if (cn + 1 < L / 64) issue_lora(cn + 1);
            }
        }
        __syncthreads();
#define LD2(dst, ptr) do { const f32x4 _a = *(const LAS f32x4*)(ptr), _b = *(const LAS f32x4*)((ptr) + 4); dst[0] = (f32x2){_a.x, _a.y}; dst[1] = (f32x2){_a.z, _a.w}; dst[2] = (f32x2){_b.x, _b.y}; dst[3] = (f32x2){_b.z, _b.w}; } while (0)
#define UP2(dst, wsrc_) do { const u32x4 _w = (wsrc_); dst[0] = (f32x2){bf2f(_w.x & 0xffffu), __uint_as_float(_w.x & 0xffff0000u)}; dst[1] = (f32x2){bf2f(_w.y & 0xffffu), __uint_as_float(_w.y & 0xffff0000u)}; \
                         dst[2] = (f32x2){bf2f(_w.z & 0xffffu), __uint_as_float(_w.z & 0xffff0000u)}; dst[3] = (f32x2){bf2f(_w.w & 0xffffu), __uint_as_float(_w.w & 0xffff0000u)}; } while (0)
#define PK4(v) ((u32x4){pk2(v[0].x, v[0].y), pk2(v[1].x, v[1].y), pk2(v[2].x, v[2].y), pk2(v[3].x, v[3].y)})
#define S2_ITEM(HALF) do { \
            const int pp = ((tq & 255) >> 3) + 32 * (HALF), ig = tq & 7, i0 = ig * 8; \
            const int tt = dir ? (t0n + 63 - pp) : (t0n + pp);            \
            f32x2 r2[4], k2[4], a2v[4], kd2[4], kkr2[4], gi2[4], ge2[4]; \
            LD2(gi2, gbuf + pp * 64 + i0); \
            LD2(ge2, gbuf + (pp > 0 ? pp - 1 : 0) * 64 + i0);        \
            if (pp == 0) { ge2[0] = (f32x2){0.f, 0.f}; ge2[1] = ge2[0]; ge2[2] = ge2[0]; ge2[3] = ge2[0]; } \
            UP2(r2, pre[4 * (HALF) + 0]); UP2(k2, pre[4 * (HALF) + 1]); UP2(kkr2, pre[4 * (HALF) + 3]);        \
            *(LAS u32x4*)(lds + slot(6) + pp * PITCH + ig * 16) = pre[4 * (HALF) + 2];        \
            {   f32x2 ap[4], c7[4]; \
                UP2(ap, *(const LAS u32x4*)(lds + slot(5) + pp * PITCH + ig * 16)); LD2(c7, CT + 7 * 64 + i0); \
                _Pragma("unroll") for (int j2 = 0; j2 < 4; ++j2) { const f32x2 araw = ap[j2] + c7[j2]; a2v[j2] = (f32x2){frcp(1.0f + __expf(-araw.x)), frcp(1.0f + __expf(-araw.y))}; } } \
            f32x2 bs2 = (f32x2){0.f, 0.f}; \
            {   f32x2 c9[4], c10[4]; LD2(c9, CT + 9 * 64 + i0); LD2(c10, CT + 10 * 64 + i0); \
                _Pragma("unroll") for (int j2 = 0; j2 < 4; ++j2) { kd2[j2] = k2[j2] * (1.0f + (a2v[j2] - 1.0f) * c9[j2]); bs2 += r2[j2] * kd2[j2] * c10[j2]; } } \
            if (cn + 1 < L / 64) issue_rkv(cn + 1, HALF);        \
            { const float bs = sum8(bs2.x + bs2.y); if (ig == 0) BON[((size_t)b * 8 + h) * L + tt] = bs; } \
            f32x2 At[4], Rt[4], Bb[4], Kb[4]; \
            _Pragma("unroll") for (int j2 = 0; j2 < 4; ++j2) { const f32x2 kk = kkr2[j2]; \
                const f32x2 ei = (f32x2){__expf(gi2[j2].x), __expf(gi2[j2].y)}, ee = (f32x2){__expf(ge2[j2].x), __expf(ge2[j2].y)}, inv = (f32x2){frcp(ei.x), frcp(ei.y)}; \
                At[j2] = -kk * ee; Rt[j2] = r2[j2] * ei; Bb[j2] = kk * a2v[j2] * inv; Kb[j2] = kd2[j2] * inv; \
                if ((HALF) == 1 && pp == 63) { GC[(cn & 1) * 64 + i0 + 2 * j2] = ei.x; GC[(cn & 1) * 64 + i0 + 2 * j2 + 1] = ei.y; } } \
            *(LAS u32x4*)(lds + slot(3) + pp * PITCH + ig * 16) = PK4(At); \
            *(LAS u32x4*)(lds + slot(4) + pp * PITCH + ig * 16) = PK4(Rt); \
            *(LAS u32x4*)(lds + bbn + pp * PITCH + ig * 16) = PK4(Bb); \
            *(LAS u32x4*)(lds + slot(8) + pp * PITCH + ig * 16) = PK4(Kb); } while (0)
        if (wave < 4) {
            if (cons) {
                u32x2 Ub[4];
                bf16x8 fa[4]; u32x2 ft[4];
#pragma unroll
                for (int z = 0; z < 4; ++z) { const int pb = (z == 3) ? 3 : z + 1, k2 = (z == 3) ? 1 : 0;
                    fa[z] = fragT(lds + slot(11), 16 * pb, k2, fr, fq);
                    ft[z] = *(const LAS u32x2*)(lds + O_TPP + ((z * 16 + fr) * 20 + 4 * fq) * 2); }
#pragma unroll
                for (int pb = 0; pb < 4; ++pb) {
                    f32x4 tmp = F4(pre[pb]);
#pragma unroll
                    for (int k2 = 0; k2 < 2; ++k2) if (2 * k2 < pb) { const int z = (pb == 3 && k2 == 1) ? 3 : pb - 1;
                        const u32x2 b0 = Ub[2 * k2]; const u32x2 b1 = (2 * k2 + 1 < pb) ? Ub[2 * k2 + 1] : (u32x2){0u, 0u};
                        const u32x4 bv = (u32x4){b0.x, b0.y, b1.x, b1.y};
                        tmp = MFMA16(fa[z], __builtin_bit_cast(bf16x8, bv), tmp); }
                    const u32x4 av = (u32x4){ft[pb].x, ft[pb].y, 0u, 0u}, bv = (u32x4){pkbf(tmp[0], tmp[1]), pkbf(tmp[2], tmp[3]), 0u, 0u};
                    const f32x4 U = MFMA16(__builtin_bit_cast(bf16x8, av), __builtin_bit_cast(bf16x8, bv), ((f32x4){0.f, 0.f, 0.f, 0.f}));
                    Ub[pb] = (u32x2){pkbf(U[0], U[1]), pkbf(U[2], U[3])};
                    *(LAS u32x2*)(lds + slot(10) + (16 * wave + fr) * PITCH + (16 * pb + 4 * fq) * 2) = Ub[pb];
                }
            }
        } else { if (prod) S2_ITEM(0); }
        __syncthreads();
        if (wave < 4) {
            if (cons) {
                const bf16x8 u0 = fragP(lds + slot(10), 16 * wave + fr, 0, fq), u1 = fragP(lds + slot(10), 16 * wave + fr, 1, fq);
#pragma unroll
                for (int q = 0; q < 4; ++q) { f32x4 a = F4(pre[8 + q]);
                    a = MFMA16(fragT(lds + slot(1), 16 * q, 0, fr, fq), u0, a); if (q >= 2) a = MFMA16(fragT(lds + slot(1), 16 * q, 1, fr, fq), u1, a);
#pragma unroll
                    for (int e = 0; e < 4; ++e) { const int pq = 16 * q + 4 * fq + e; const int ttp = dir ? (t0 + 63 - pq) : (t0 + pq);
                        Y[((size_t)b * L + ttp) * 512 + h * 64 + 16 * wave + fr] = (unsigned short)f2bf(a[e]); } }
#pragma unroll
                for (int it = 0; it < 4; ++it) { f32x4 a = F4(pre[4 + it]); if (cc > 0) a += F4(pre[12 + it]);
                    a = MFMA16(fragT(lds + bbc, 16 * it, 0, fr, fq), u0, a); a = MFMA16(fragT(lds + bbc, 16 * it, 1, fr, fq), u1, a);
                    const f32x4 gc = *(const LAS f32x4*)(GC + (cc & 1) * 64 + 16 * it + 4 * fq);
                    a = a * gc; pre[12 + it] = U4(a);
                    *(LAS u32x2*)(lds + O_SB + (16 * wave + fr) * PITCH + (16 * it + 4 * fq) * 2) = (u32x2){pkbf(a[0], a[1]), pkbf(a[2], a[3])};
                    asm volatile("" ::: "memory"); }
            }
        } else { if (prod) S2_ITEM(1); }
#undef S2_ITEM
#undef PK4
#undef UP2
#undef LD2
        __syncthreads();
        if (prod) { const bf16x8 at0 = fragN(lds + slot(3), 16 * rt + fr, 0, fq), at1 = fragN(lds + slot(3), 16 * rt + fr, 1, fq), rt0 = fragN(lds + slot(4), 16 * rt + fr, 0, fq), rt1 = fragN(lds + slot(4), 16 * rt + fr, 1, fq);
#pragma unroll
          for (int ct = 0; ct < 2; ++ct) { const int ctt = 2 * chh + ct;
            f32x4 ab = (f32x4){0.f, 0.f, 0.f, 0.f}, ak = ab, rb = ab, rk = ab;
            if (ctt <= rt) {
                const bf16x8 b0 = fragN(lds + bbn, 16 * ctt + fr, 0, fq), b1 = fragN(lds + bbn, 16 * ctt + fr, 1, fq), k0 = fragN(lds + slot(8), 16 * ctt + fr, 0, fq), k1 = fragN(lds + slot(8), 16 * ctt + fr, 1, fq);
                ab = MFMA16(at0, b0, ab); ab = MFMA16(at1, b1, ab); ak = MFMA16(at0, k0, ak); ak = MFMA16(at1, k1, ak);
                rb = MFMA16(rt0, b0, rb); rb = MFMA16(rt1, b1, rb); rk = MFMA16(rt0, k0, rk); rk = MFMA16(rt1, k1, rk); }
            float vab[4], vak[4], vrb[4], vrk[4];
#pragma unroll
            for (int e = 0; e < 4; ++e) { const int prow = 16 * rt + 4 * fq + e, jcol = 16 * ctt + fr; const bool st = prow > jcol, inc = prow >= jcol;
                vab[e] = st ? ab[e] : 0.f; vak[e] = st ? ak[e] : 0.f; vrb[e] = inc ? rb[e] : 0.f; vrk[e] = inc ? rk[e] : 0.f; }
            const int off = (16 * ctt + fr) * PITCH + (16 * rt + 4 * fq) * 2;
            *(LAS u32x2*)(lds + slot(11) + off) = (u32x2){pkbf(vab[0], vab[1]), pkbf(vab[2], vab[3])};
            *(LAS u32x2*)(lds + slot(0) + off) = (u32x2){pkbf(vak[0], vak[1]), pkbf(vak[2], vak[3])};
            *(LAS u32x2*)(lds + slot(1) + off) = (u32x2){pkbf(vrb[0], vrb[1]), pkbf(vrb[2], vrb[3])};
            *(LAS u32x2*)(lds + slot(2) + off) = (u32x2){pkbf(vrk[0], vrk[1]), pkbf(vrk[2], vrk[3])}; } }
    }
    __syncthreads();
#undef issue_rkv
#undef issue_lora
#undef F4
#undef U4
}

constexpr int PT = 128;
__device__ __forceinline__ void rw_post_wg(const Params& p, LAS unsigned char* lds, int l, int G_, int bid, const int wvx) {
    const int tid = opaque_tid(wvx), lane = tid & 63, wave = __builtin_amdgcn_readfirstlane(tid >> 6), fr = lane & 15, fq = lane >> 4;
    const int h = bid & 7;
    const bf16_t* proj = (const bf16_t*)(p.ws + OFF_PROJ);
    const bf16_t* YF = (const bf16_t*)(p.ws + OFF_YF); const bf16_t* YB = (const bf16_t*)(p.ws + OFF_YB);
    const float* BONF = (const float*)(p.ws + OFF_BON); const float* BONB = BONF + (size_t)NT * 8;
    bf16_t* mix = (bf16_t*)(p.ws + OFF_MIX);
    constexpr int GP = 272;
    LAS unsigned char* G2T = lds;
    LAS unsigned char* SG = lds + 17408;
    LAS unsigned char* RAWV = lds + 52224;
    LAS unsigned char* GATE = lds + 68864;
    __syncthreads();
    { const float* g2 = p.in[22] + (size_t)l * 128 * 512 + h * 64;
        for (int i = tid; i < 8192; i += NTHREADS) { const int r = i >> 6, n = i & 63; *(LAS bf16_t*)(G2T + n * GP + r * 2) = (bf16_t)f2bf(g2[r * 512 + n]); } }
    const int ig = tid & 7, i0 = ig * 8, col = h * 64 + i0;
    float mv0[8], mv1[8], lnw[8], lnb[8];
#pragma unroll
    for (int j = 0; j < 8; ++j) { mv0[j] = p.in[14][(size_t)l * 3072 + 2 * 1024 + col + j]; mv1[j] = p.in[14][(size_t)l * 3072 + 2 * 1024 + 512 + col + j]; lnw[j] = p.in[23][l * 512 + col + j]; lnb[j] = p.in[24][l * 512 + col + j]; }
#pragma unroll 1
    for (int tile = bid >> 3; tile < NT / PT; tile += G_ >> 3) {
        const int row0 = tile * PT, tb0 = row0 & (L - 1);
        __syncthreads();
        u32x4 gq[4], vq[3]; u32x4 yq[2][2]; float bq[2];
#pragma unroll
        for (int k = 0; k < 4; ++k) { const int q = tid + k * NTHREADS; gq[k] = *(const u32x4*)(proj + (size_t)(row0 + (q >> 4)) * IN_DP + C_RG + (q & 15) * 8); }
#pragma unroll
        for (int k = 0; k < 3; ++k) { const int q = tid + k * NTHREADS; const int rr = q >> 3, ch = q & 7; const int tt = tb0 - 1 + rr; vq[k] = (u32x4){0u, 0u, 0u, 0u};
            if (q < 1040 && tt >= 0 && tt < L) vq[k] = *(const u32x4*)(proj + (size_t)(row0 - 1 + rr) * IN_DP + C_RV + h * 64 + ch * 8); }
#pragma unroll
        for (int sl = 0; sl < 2; ++sl) { const size_t row = (size_t)row0 + (tid >> 3) + 64 * sl; yq[sl][0] = *(const u32x4*)(YF + row * 512 + col); yq[sl][1] = *(const u32x4*)(YB + row * 512 + col);
            const size_t bi = ((size_t)(row >> 13) * 8 + h) * L + (row & (L - 1)); bq[sl] = BONF[bi] + BONB[bi]; }
#pragma unroll
        for (int k = 0; k < 4; ++k) { const int q = tid + k * NTHREADS; const int t = q >> 4, ch = q & 15; *(LAS u32x4*)(SG + t * GP + ch * 16) = gq[k]; }
#pragma unroll
        for (int k = 0; k < 3; ++k) { const int q = tid + k * NTHREADS; if (q < 1040) *(LAS u32x4*)(RAWV + (q >> 3) * 128 + (q & 7) * 16) = vq[k]; }
        __syncthreads();
#pragma unroll
        for (int ct = 0; ct < 4; ++ct) { f32x4 acc = (f32x4){0.f, 0.f, 0.f, 0.f};
#pragma unroll
            for (int ks = 0; ks < 4; ++ks) { const bf16x8 a = *(const LAS bf16x8*)(SG + (16 * wave + fr) * GP + ks * 64 + fq * 16); const bf16x8 b = *(const LAS bf16x8*)(G2T + (16 * ct + fr) * GP + ks * 64 + fq * 16);
                acc = __builtin_amdgcn_mfma_f32_16x16x32_bf16(a, b, acc, 0, 0, 0); }
#pragma unroll
            for (int e = 0; e < 4; ++e) *(LAS bf16_t*)(GATE + (16 * wave + 4 * fq + e) * 144 + (16 * ct + fr) * 2) = (bf16_t)f2bf(acc[e]); }
        __syncthreads();
#pragma unroll
        for (int sl = 0; sl < 2; ++sl) { const int t = (tid >> 3) + 64 * sl; const size_t row = (size_t)row0 + t;
            float vp[8], vc[8], vn[8], gt[8];
            unpack8(*(const LAS u32x4*)(RAWV + t * 128 + ig * 16), vp); unpack8(*(const LAS u32x4*)(RAWV + (t + 1) * 128 + ig * 16), vc); unpack8(*(const LAS u32x4*)(RAWV + (t + 2) * 128 + ig * 16), vn);
            unpack8(*(const LAS u32x4*)(GATE + t * 144 + ig * 16), gt);
            float yf8[8], yb8[8]; unpack8(yq[sl][0], yf8); unpack8(yq[sl][1], yb8);
            const float bon = bq[sl];
            float y[8] = {yf8[0] + yb8[0], yf8[1] + yb8[1], yf8[2] + yb8[2], yf8[3] + yb8[3], yf8[4] + yb8[4], yf8[5] + yb8[5], yf8[6] + yb8[6], yf8[7] + yb8[7]};
            float sm = 0.f;
#pragma unroll
            for (int j = 0; j < 8; ++j) sm += y[j];
            const float mean = sum8(sm) * (1.0f / 64.0f);
            float sq = 0.f;
#pragma unroll
            for (int j = 0; j < 8; ++j) { y[j] -= mean; sq += y[j] * y[j]; }
            const float rstd = __builtin_amdgcn_rsqf(sum8(sq) * (1.0f / 64.0f) + 64e-5f);
            float o[8];
#pragma unroll
            for (int j = 0; j < 8; ++j) { const float v = vc[j] + mv0[j] * (vp[j] - vc[j]) + mv1[j] * (vn[j] - vc[j]); o[j] = (y[j] * rstd * lnw[j] + lnb[j] + bon * v) * gt[j]; }
            u32x4 w; w.x = pk2(o[0], o[1]); w.y = pk2(o[2], o[3]); w.z = pk2(o[4], o[5]); w.w = pk2(o[6], o[7]);
            *(u32x4*)(mix + row * D + 256 + col) = w; }
    }
    __syncthreads();
}

namespace na {
constexpr int O_K = 0, O_V = 65536, O_RPB = 131072, O_MX = 133120, O_QW = 142080;
__device__ __forceinline__ int rowoff(int keycol, int byte) { return keycol * 128 + ((((byte >> 5) ^ keycol) & 3) << 5) + (byte & 31); }
typedef short s16x4 __attribute__((ext_vector_type(4)));
}
__device__ __forceinline__ void na_strip(const Params& p, LAS unsigned char* lds, int l, int strip, const int wvx) {
    using namespace na;
    const int tid = opaque_tid(wvx), lane = tid & 63, wave = __builtin_amdgcn_readfirstlane(tid >> 6), fr = lane & 15, fq = lane >> 4;
    const int b = strip >> 5, h = (strip >> 3) & 3, i0 = (strip & 7) * 16;
    const int g = wave & 3, kh = wave >> 2;
    const bf16_t* proj = (const bf16_t*)(p.ws + OFF_PROJ);
    bf16_t* mix = (bf16_t*)(p.ws + OFF_MIX);
    LAS float* RPB = (LAS float*)(lds + O_RPB);
    LAS unsigned char* MX = lds + O_MX + g * 2240;
    const int j0 = 16 * g, c0 = (g == 0) ? 0 : ((g == 3) ? 32 : 16 * g - 8);
    __syncthreads();
    for (int q = tid; q < 465; q += NTHREADS) RPB[q] = p.in[25][((size_t)l * 4 + h) * 465 + q];
    { int rs = i0 - 4; rs = rs < 0 ? 0 : (rs > 120 ? 120 : rs);
        u32x4 fw[16];
#pragma unroll
        for (int k = 0; k < 16; ++k) { const int q = tid + k * NTHREADS; const int r8 = q >> 10, which = (q >> 9) & 1, col = (q >> 3) & 63, ch = q & 7; const int kr = rs + r8;
            fw[k] = *(const u32x4*)(proj + ((size_t)b * L + kr * 64 + col) * IN_DP + (which ? C_NV : C_NK) + h * 64 + ch * 8); }
#pragma unroll
        for (int k = 0; k < 16; ++k) { const int q = tid + k * NTHREADS; const int r8 = q >> 10, which = (q >> 9) & 1, col = (q >> 3) & 63, ch = q & 7; const int kr = rs + r8;
            *(LAS u32x4*)(lds + (which ? O_V : O_K) + (kr & 7) * 8192 + rowoff(col, 16 * ch)) = fw[k]; } }
    bf16x8 Bq[2];
#pragma unroll
    for (int ks = 0; ks < 2; ++ks) Bq[ks] = *(const bf16x8*)(proj + ((size_t)b * L + i0 * 64 + j0 + fr) * IN_DP + C_NQ + h * 64 + 32 * ks + 8 * fq);
    const int jq = j0 + fr;
    int cs = jq - 8; cs = cs < 0 ? 0 : (cs > 48 ? 48 : cs);
    const u32x4 onesv = (u32x4){0x3F803F80u, 0x3F803F80u, 0x3F803F80u, 0x3F803F80u};
#pragma unroll 1
    for (int i = i0; i < i0 + 16; ++i) {
        int rs = i - 4; rs = rs < 0 ? 0 : (rs > 120 ? 120 : rs);
        int rsn = i + 1 - 4; rsn = rsn < 0 ? 0 : (rsn > 120 ? 120 : rsn);
        const bool more = (i + 1 < i0 + 16), newrow = more && (rsn > rs);
        __syncthreads();
        u32x4 pre0 = (u32x4){0u, 0u, 0u, 0u}, pre1 = pre0; bf16x8 Bqn[2] = {Bq[0], Bq[1]};
        if (newrow) { const int kr = rsn + 7;
            { const int q = tid; const int which = q >> 9, col = (q >> 3) & 63, ch = q & 7; pre0 = *(const u32x4*)(proj + ((size_t)b * L + kr * 64 + col) * IN_DP + (which ? C_NV : C_NK) + h * 64 + ch * 8); }
            { const int q = tid + 512; const int which = q >> 9, col = (q >> 3) & 63, ch = q & 7; pre1 = *(const u32x4*)(proj + ((size_t)b * L + kr * 64 + col) * IN_DP + (which ? C_NV : C_NK) + h * 64 + ch * 8); } }
        if (more) {
#pragma unroll
            for (int ks = 0; ks < 2; ++ks) Bqn[ks] = *(const bf16x8*)(proj + ((size_t)b * L + (i + 1) * 64 + j0 + fr) * IN_DP + C_NQ + h * 64 + 32 * ks + 8 * fq); }
        f32x4 S[4][2]; float mloc = -1e30f;
#pragma unroll
        for (int r4 = 0; r4 < 4; ++r4) { const int krow = rs + 4 * kh + r4, slot = krow & 7, dr = krow - i + 7;
#pragma unroll
            for (int ct = 0; ct < 2; ++ct) { const int keycol = c0 + 16 * ct + fr; f32x4 acc = (f32x4){0.f, 0.f, 0.f, 0.f};
#pragma unroll
                for (int ks = 0; ks < 2; ++ks) { const bf16x8 a = *(const LAS bf16x8*)(lds + O_K + slot * 8192 + rowoff(keycol, 64 * ks + 16 * fq)); acc = __builtin_amdgcn_mfma_f32_16x16x32_bf16(a, Bq[ks], acc, 0, 0, 0); }
#pragma unroll
                for (int e = 0; e < 4; ++e) { const int kc = c0 + 16 * ct + 4 * fq + e; const bool valid = (kc >= cs) && (kc < cs + 16);
                    int dc = kc - jq; dc = dc < -15 ? -15 : (dc > 15 ? 15 : dc); dc += 15;
                    const float sc = valid ? (acc[e] * 0.125f + RPB[dr * 31 + dc]) : -1e30f; acc[e] = sc; mloc = fmaxf(mloc, sc); }
                S[r4][ct] = acc; } }
        { int lid; asm volatile("v_mbcnt_lo_u32_b32 %0, -1, 0\n\tv_mbcnt_hi_u32_b32 %0, -1, %0" : "=v"(lid));
          mloc = fmaxf(mloc, __int_as_float(__builtin_amdgcn_ds_bpermute((lid ^ 16) << 2, __float_as_int(mloc))));
          mloc = fmaxf(mloc, __int_as_float(__builtin_amdgcn_ds_bpermute((lid ^ 32) << 2, __float_as_int(mloc)))); }
        bf16x8 Ap[4];
#pragma unroll
        for (int r4 = 0; r4 < 4; ++r4) { float pv[8];
#pragma unroll
            for (int ct = 0; ct < 2; ++ct)
#pragma unroll
                for (int e = 0; e < 4; ++e) { const float sc = S[r4][ct][e]; pv[ct * 4 + e] = (sc > -1e29f) ? __expf(sc - mloc) : 0.f; }
            const u32x4 w = (u32x4){pk2(pv[0], pv[1]), pk2(pv[2], pv[3]), pk2(pv[4], pv[5]), pk2(pv[6], pv[7])}; Ap[r4] = __builtin_bit_cast(bf16x8, w); }
        f32x4 O[4], Ls = (f32x4){0.f, 0.f, 0.f, 0.f};
#pragma unroll
        for (int dt = 0; dt < 4; ++dt) O[dt] = (f32x4){0.f, 0.f, 0.f, 0.f};
#pragma unroll
        for (int r4 = 0; r4 < 4; ++r4) { const int slot = (rs + 4 * kh + r4) & 7; const int kc0 = c0 + 4 * fq + (fr >> 2), kc1 = kc0 + 16;
            Ls = __builtin_amdgcn_mfma_f32_16x16x32_bf16(Ap[r4], __builtin_bit_cast(bf16x8, onesv), Ls, 0, 0, 0);
#pragma unroll
            for (int dt = 0; dt < 4; ++dt) {
                const s16x4 v0 = __builtin_amdgcn_ds_read_tr16_b64_v4i16((LAS s16x4*)(lds + O_V + slot * 8192 + rowoff(kc0, 32 * dt + 8 * (fr & 3))));
                const s16x4 v1 = __builtin_amdgcn_ds_read_tr16_b64_v4i16((LAS s16x4*)(lds + O_V + slot * 8192 + rowoff(kc1, 32 * dt + 8 * (fr & 3))));
                const bf16x8 bv = (bf16x8){v0[0], v0[1], v0[2], v0[3], v1[0], v1[1], v1[2], v1[3]};
                O[dt] = __builtin_amdgcn_mfma_f32_16x16x32_bf16(Ap[r4], bv, O[dt], 0, 0, 0); } }
        if (fq == 0) *(LAS float*)(MX + kh * 64 + fr * 4) = mloc;
        if (kh == 1) { if (fr == 0) *(LAS f32x4*)(MX + 128 + fq * 16) = Ls;
#pragma unroll
            for (int dt = 0; dt < 4; ++dt)
#pragma unroll
                for (int e = 0; e < 4; ++e) *(LAS bf16_t*)(MX + 192 + (4 * fq + e) * 128 + (16 * dt + fr) * 2) = (bf16_t)f2bf(O[dt][e]); }
        __syncthreads();
        if (newrow) { const int kr = rsn + 7;
            { const int q = tid; const int which = q >> 9, col = (q >> 3) & 63, ch = q & 7; *(LAS u32x4*)(lds + (which ? O_V : O_K) + (kr & 7) * 8192 + rowoff(col, 16 * ch)) = pre0; }
            { const int q = tid + 512; const int which = q >> 9, col = (q >> 3) & 63, ch = q & 7; *(LAS u32x4*)(lds + (which ? O_V : O_K) + (kr & 7) * 8192 + rowoff(col, 16 * ch)) = pre1; } }
        if (kh == 0) {
            const f32x4 m0 = *(const LAS f32x4*)(MX + fq * 16), m1 = *(const LAS f32x4*)(MX + 64 + fq * 16), l1 = *(const LAS f32x4*)(MX + 128 + fq * 16);
#pragma unroll
            for (int e = 0; e < 4; ++e) { const float M = fmaxf(m0[e], m1[e]), a0 = __expf(m0[e] - M), a1 = __expf(m1[e] - M); const float inv = frcp(Ls[e] * a0 + l1[e] * a1);
                const size_t row = (size_t)b * L + i * 64 + j0 + 4 * fq + e;
#pragma unroll
                for (int dt = 0; dt < 4; ++dt) { const float o1 = bf2f(*(const LAS bf16_t*)(MX + 192 + (4 * fq + e) * 128 + (16 * dt + fr) * 2));
                    mix[row * D + 768 + h * 64 + 16 * dt + fr] = (bf16_t)f2bf((O[dt][e] * a0 + o1 * a1) * inv); } }
        }
        Bq[0] = Bqn[0]; Bq[1] = Bqn[1];
    }
    __syncthreads();
}

__device__ __forceinline__ void na_queue(const Params& p, LAS unsigned char* lds, int l, const int wvx) {
    int* ctr = (int*)(p.ws + OFF_CTL) + 16 + l;
    LAS int* qw = (LAS int*)(lds + na::O_QW);
    for (;;) {
        __syncthreads();
        if (opaque_tid(wvx) == 0) *qw = atomicAdd(ctr, 1);
        __syncthreads();
        const int strip = __builtin_amdgcn_readfirstlane(*qw);
        if (strip >= 256) break;
        na_strip(p, lds, l, strip, wvx);
    }
}

__device__ __forceinline__ void phase_router(const Params& p, LAS unsigned char* lds, int l, int G_, int bid, const int wvx) {
    const int tid = opaque_tid(wvx), lane = tid & 63, wave = __builtin_amdgcn_readfirstlane(tid >> 6), fr = lane & 15, fq = lane >> 4;
    const bf16_t* x = (const bf16_t*)(p.ws + OFF_XB); float* rs = (float*)(p.ws + OFF_RS);
    const bf16_t* rgh = (const bf16_t*)(p.ws + OFF_RGW) + (size_t)l * 2 * 48 * D; const bf16_t* rgl = rgh + 48 * D;
    int* cnt = (int*)(p.ws + OFF_CTL) + 64 + l * 64;
    int* ltok = (int*)(p.ws + OFF_LTOK); float* lgate = (float*)(p.ws + OFF_LGATE); float* lrs = (float*)(p.ws + OFF_LRS);
    LAS int* lcnt = (LAS int*)lds;
    LAS int* lbase = lcnt + 32;
    LAS int* se = lbase + 32;
    LAS int* sp = se + 512;
    LAS float* sg = (LAS float*)(sp + 512);
    LAS float* LG = (LAS float*)(lds + 8192);
    LAS float* SQ = LG + 256 * 52;
    const float* bg = p.in[29] + l * 4; const float* be = p.in[31] + l * 32;
    for (int chunk = bid; chunk < NT / 256; chunk += G_) {
        __syncthreads();
        if (tid < 32) lcnt[tid] = 0;
        const int tl0 = wave * 32;
        const bf16_t* xa_p = x + (size_t)(chunk * 256 + tl0 + fr) * D + 8 * fq; const bf16_t* xb_p = xa_p + 16 * D;
        const bf16_t* wh_p = rgh + (size_t)fr * D + 8 * fq; const bf16_t* wl_p = rgl + (size_t)fr * D + 8 * fq;
        f32x4 acc[2][3];
#pragma unroll
        for (int t = 0; t < 2; ++t)
#pragma unroll
            for (int c = 0; c < 3; ++c) acc[t][c] = (f32x4){0.f, 0.f, 0.f, 0.f};
        float ssa = 0.f, ssb = 0.f;
#pragma unroll 2
        for (int ks = 0; ks < 32; ++ks) {
            const u32x4 ar = *(const u32x4*)(xa_p + 32 * ks), br = *(const u32x4*)(xb_p + 32 * ks);
            bf16x8 wh[3], wl[3];
#pragma unroll
            for (int c = 0; c < 3; ++c) { wh[c] = *(const bf16x8*)(wh_p + (size_t)16 * c * D + 32 * ks); wl[c] = *(const bf16x8*)(wl_p + (size_t)16 * c * D + 32 * ks); }
            { float f[8]; unpack8(ar, f);
#pragma unroll
              for (int j = 0; j < 8; ++j) ssa += f[j] * f[j];
              unpack8(br, f);
#pragma unroll
              for (int j = 0; j < 8; ++j) ssb += f[j] * f[j]; }
            const bf16x8 a0 = __builtin_bit_cast(bf16x8, ar), a1 = __builtin_bit_cast(bf16x8, br);
#pragma unroll
            for (int c = 0; c < 3; ++c) {
                acc[0][c] = __builtin_amdgcn_mfma_f32_16x16x32_bf16(a0, wh[c], acc[0][c], 0, 0, 0); acc[0][c] = __builtin_amdgcn_mfma_f32_16x16x32_bf16(a0, wl[c], acc[0][c], 0, 0, 0);
                acc[1][c] = __builtin_amdgcn_mfma_f32_16x16x32_bf16(a1, wh[c], acc[1][c], 0, 0, 0); acc[1][c] = __builtin_amdgcn_mfma_f32_16x16x32_bf16(a1, wl[c], acc[1][c], 0, 0, 0); }
        }
#pragma unroll
        for (int t = 0; t < 2; ++t)
#pragma unroll
            for (int c = 0; c < 3; ++c)
#pragma unroll
                for (int e = 0; e < 4; ++e) LG[(tl0 + 16 * t + 4 * fq + e) * 52 + 16 * c + fr] = acc[t][c][e];
        SQ[(tl0 + fr) * 4 + fq] = ssa; SQ[(tl0 + 16 + fr) * 4 + fq] = ssb;
        __syncthreads();
        if (lane < 32) { const int tl = tl0 + lane, row = chunk * 256 + tl;
            const f32x4 s4 = *(const LAS f32x4*)(SQ + tl * 4);
            const float rr = 1.0f / sqrtf(((s4.x + s4.y) + (s4.z + s4.w)) * (1.0f / D) + NORM_EPS);
            rs[row] = rr; SQ[tl * 4] = rr;
            const LAS float* lg = LG + tl * 52;
            const float g0 = lg[0] * rr + bg[0], g1 = lg[1] * rr + bg[1], g2 = lg[2] * rr + bg[2], g3 = lg[3] * rr + bg[3];
            int gs = 0; float gm = g0; if (g1 > gm) { gm = g1; gs = 1; } if (g2 > gm) { gm = g2; gs = 2; } if (g3 > gm) { gm = g3; gs = 3; }
            const float gprob = 1.0f / (expf(g0 - gm) + expf(g1 - gm) + expf(g2 - gm) + expf(g3 - gm));
            float ev[8];
#pragma unroll
            for (int e = 0; e < 8; ++e) ev[e] = lg[4 + gs * 8 + e] * rr + be[gs * 8 + e];
            int i0 = 0; float v0 = ev[0];
#pragma unroll
            for (int e = 1; e < 8; ++e) if (ev[e] > v0) { v0 = ev[e]; i0 = e; }
            int i1 = -1; float v1 = -3.0e38f;
#pragma unroll
            for (int e = 0; e < 8; ++e) if (e != i0 && ev[e] > v1) { v1 = ev[e]; i1 = e; }
            const float e1 = expf(v1 - v0), den = 1.0f + e1;
            const int ea = gs * 8 + i0, eb = gs * 8 + i1;
            se[tl * 2] = ea; se[tl * 2 + 1] = eb; sg[tl * 2] = gprob / den; sg[tl * 2 + 1] = gprob * e1 / den;
            sp[tl * 2] = atomicAdd((int*)lcnt + ea, 1); sp[tl * 2 + 1] = atomicAdd((int*)lcnt + eb, 1); }
        __syncthreads();
        if (tid < 32) lbase[tid] = atomicAdd(cnt + tid, lcnt[tid]);
        __syncthreads();
        { const int tl = tid >> 1, k = tid & 1, e = se[tid]; const size_t li = (size_t)e * LCAP + lbase[e] + sp[tid];
            ltok[li] = (chunk * 256 + tl) * 2 + k; lgate[li] = sg[tid]; lrs[li] = SQ[tl * 4]; }
    }
    __syncthreads();
}

__device__ __forceinline__ void phase_combine(const Params& p, bool last, int G_, int bid, const int wvx) {
    const int tid = opaque_tid(wvx), lane = tid & 63, wave = tid >> 6;
    float* out = p.out; bf16_t* x16 = (bf16_t*)(p.ws + OFF_XB); float* rs = (float*)(p.ws + OFF_RS);
    const bf16_t* yb = (const bf16_t*)(p.ws + OFF_YBUF);
    const float* gf = p.in[35];
    for (int row = bid * 8 + wave; row < NT; row += G_ * 8) {
        u32x2* xr = (u32x2*)(x16 + (size_t)row * D) + lane; const u32x2* y0 = (const u32x2*)(yb + (size_t)(2 * row) * D) + lane; const u32x2* y1 = (const u32x2*)(yb + (size_t)(2 * row + 1) * D) + lane;
        f32x4 v[4]; float s = 0.f; u32x2 xq[4], aq[4], cq[4];
#pragma unroll
        for (int j = 0; j < 4; ++j) { xq[j] = xr[64 * j]; aq[j] = y0[64 * j]; cq[j] = y1[64 * j]; }
#pragma unroll
        for (int j = 0; j < 4; ++j) { const u32x2 xx = xq[j], a = aq[j], c = cq[j];
            v[j].x = bf2f(xx.x & 0xffffu) + bf2f(a.x & 0xffffu) + bf2f(c.x & 0xffffu); v[j].y = __uint_as_float(xx.x & 0xffff0000u) + __uint_as_float(a.x & 0xffff0000u) + __uint_as_float(c.x & 0xffff0000u);
            v[j].z = bf2f(xx.y & 0xffffu) + bf2f(a.y & 0xffffu) + bf2f(c.y & 0xffffu); v[j].w = __uint_as_float(xx.y & 0xffff0000u) + __uint_as_float(a.y & 0xffff0000u) + __uint_as_float(c.y & 0xffff0000u);
            s += (v[j].x * v[j].x + v[j].y * v[j].y) + (v[j].z * v[j].z + v[j].w * v[j].w); }
        s = wave_sum(s);
        const float rr = 1.0f / sqrtf(s * (1.0f / D) + NORM_EPS);
        if (last) { f32x4* orow = (f32x4*)(out + (size_t)row * D) + lane;
#pragma unroll
            for (int j = 0; j < 4; ++j) { const f32x4 g = ((const f32x4*)gf)[lane + 64 * j]; orow[64 * j] = v[j] * rr * g; }
        } else {
            if (lane == 0) rs[row] = rr;
#pragma unroll
            for (int j = 0; j < 4; ++j) xr[64 * j] = (u32x2){pk2(v[j].x, v[j].y), pk2(v[j].z, v[j].w)};
        }
    }
}

#ifndef PH_MASK
#define PH_MASK 0xFFFFF
#endif
#define PH(k) if (PH_MASK & (1 << (k)))

#define XB_TMO      128
#define XB_XCNT(j)  (256  + 64 * (j))
#define XB_XSUB(j)  (1280 + 64 * (j))
#define XB_XGEN(j)  (2304 + 64 * (j))
#define XB_TOP      3328
#define XB_TOPGEN   3392
#define XCD_BAR_WORDS 3456
#define XB_SPIN_CAP (1u << 22)
__device__ __forceinline__ unsigned xb_ld(unsigned* p)              { return __hip_atomic_load(p, __ATOMIC_RELAXED, __HIP_MEMORY_SCOPE_AGENT); }
__device__ __forceinline__ unsigned xb_add(unsigned* p, unsigned v) { return __hip_atomic_fetch_add(p, v, __ATOMIC_RELAXED, __HIP_MEMORY_SCOPE_AGENT); }
__device__ __forceinline__ unsigned xb_xcc_id() { return (unsigned)__builtin_amdgcn_s_getreg((3 << 11) | 20) & 0xFu; }
#define XB_SPIN(cond, bar) do { unsigned _sp = 0; while (cond) { __builtin_amdgcn_s_sleep(1); \
    if ((++_sp & 255u) == 0u) { if (xb_ld(&(bar)[XB_TMO])) break; if (_sp > XB_SPIN_CAP) { atomicAdd(&(bar)[XB_TMO], 1u); break; } } } } while (0)
struct XcdBarrier { unsigned* bar; unsigned x; volatile LAS unsigned* st; };
__device__ __forceinline__ void xcd_barrier_complete(unsigned* bar, unsigned x, unsigned& nloc, unsigned& nx) {
    const unsigned G = gridDim.x * gridDim.y * gridDim.z;
    unsigned sum, cnt, mine, sp = 0u;
    for (;;) {
        sum = 0u; cnt = 0u; mine = 0u;
#pragma unroll
        for (unsigned j = 0; j < 16; ++j) { const unsigned c = xb_ld(&bar[XB_XCNT(j)]); sum += c; cnt += (c > 0u) ? 1u : 0u; mine = (j == x) ? c : mine; }
        if (sum == G) break;
        __builtin_amdgcn_s_sleep(1);
        if ((++sp & 255u) == 0u) { if (xb_ld(&bar[XB_TMO])) break; if (sp > XB_SPIN_CAP) { atomicAdd(&bar[XB_TMO], 1u); break; } }
    }
    nloc = mine > 0u ? mine : 1u; nx = cnt > 0u ? cnt : 1u;
}
__device__ __forceinline__ void xcd_barrier(const XcdBarrier& b, const bool leader) {
    asm volatile("s_waitcnt vmcnt(0)" ::: "memory");
    __syncthreads();
    if (leader) {
        unsigned* bar = b.bar;
        __builtin_amdgcn_s_waitcnt(0);
        unsigned nloc = b.st[0], nx = b.st[1];
        if (nloc == 0u) { xcd_barrier_complete(bar, b.x, nloc, nx); b.st[0] = nloc; b.st[1] = nx; }
        const unsigned old = xb_add(&bar[XB_XSUB(b.x)], 1u);
        const unsigned gen = old / nloc;
        if (old + 1u == (gen + 1u) * nloc) {
            __builtin_amdgcn_fence(__ATOMIC_RELEASE, "agent");
            asm volatile("s_waitcnt vmcnt(0)" ::: "memory");
            const unsigned og = xb_add(&bar[XB_TOP], 1u);
            const unsigned tg = og / nx;
            if (og + 1u == (tg + 1u) * nx) xb_add(&bar[XB_TOPGEN], 1u);
            else XB_SPIN(xb_ld(&bar[XB_TOPGEN]) == tg, bar);
            __builtin_amdgcn_fence(__ATOMIC_ACQUIRE, "agent");
            xb_add(&bar[XB_XGEN(b.x)], 1u);
            asm volatile("s_waitcnt vmcnt(0)" ::: "memory");
        } else {
            XB_SPIN(xb_ld(&bar[XB_XGEN(b.x)]) == gen, bar);
            __builtin_amdgcn_fence(__ATOMIC_ACQUIRE, "agent");
            asm volatile("s_waitcnt vmcnt(0)" ::: "memory");
        }
    }
    __syncthreads();
}

__device__ __forceinline__ Params load_params() {
#if defined(__HIP_DEVICE_COMPILE__)
    auto k = __builtin_amdgcn_kernarg_segment_ptr();
    asm volatile("" : "+s"(k));
    return *(const __attribute__((address_space(4))) Params*)k;
#else
    return Params{};
#endif
}
__global__ void __launch_bounds__(NTHREADS, 2) fwd_megakernel(Params p_unused) {
    extern __shared__ __attribute__((aligned(16))) unsigned char lds_raw[];
    LAS unsigned char* lds = (LAS unsigned char*)lds_raw;
    cg::grid_group grid = cg::this_grid();
    const int G_ = gridDim.x, bid = blockIdx.x;
    const int wvx = __builtin_amdgcn_readfirstlane((int)threadIdx.x >> 6);
    const bool leader = (threadIdx.x == 0);
    volatile LAS unsigned* bst = (volatile LAS unsigned*)(lds + LDS_BYTES - 16);
    if (leader) { bst[0] = 0u; bst[1] = 0u; }
    XcdBarrier xbar;
    { const Params p = load_params(); xbar.bar = (unsigned*)(p.ws + OFF_CTL) + 4096; xbar.x = xb_xcc_id(); xbar.st = bst;
      if (leader) (void)xb_add(&xbar.bar[XB_XCNT(xbar.x)], 1u); }
    __syncthreads();
#define GRID_BAR() do { const Params pb = load_params(); XcdBarrier xb2; xb2.bar = (unsigned*)(pb.ws + OFF_CTL) + 4096; xb2.x = xb_xcc_id(); xb2.st = bst; xcd_barrier(xb2, opaque_tid(wvx) == 0); } while (0)

    { const Params p = load_params(); PH(0) phase_prologue(p, lds, G_, bid, wvx); }
    { const Params p = load_params(); PH(0) filters_all(p, G_, bid, wvx); }
    { const Params p = load_params(); PH(1) phase_rownorm(p.in[0], (bf16_t*)(p.ws + OFF_XB), (float*)(p.ws + OFF_RS), G_, bid, wvx); }
    grid.sync();

#pragma unroll 1
    for (int l = 0; l < DEPTH; ++l) {
        PH(2) { const Params p = load_params(); unsigned char* ws = p.ws;
            DenseSched S; S.init((const bf16_t*)(ws + OFF_XB), (const bf16_t*)(ws + OFF_WTIN) + (size_t)l * IN_DP * D, NT, IN_DP, D, G_, bid);
            EpiProj E{(bf16_t*)(ws + OFF_PROJ), (const float*)(ws + OFF_RS)};
            pg8::gemm_phase<EpiProj, DenseSched, false>(lds, D, S, E, wvx);
        }
        GRID_BAR();
        {
            const bool lead = (opaque_tid(wvx) == 0);
            LAS int* qw = (LAS int*)(lds + na::O_QW);
#define CTR(k) ((int*)(load_params().ws + OFF_CTL) + 32 + l * 16 + (k))
            PH(5) for (;;) { const int u = wg_pop(CTR(6), qw, lead); if (u >= 1024) break; { const Params p = load_params(); rw_prep_unit(p, l, u, wvx); } wg_signal(CTR(8 + (u >> 7)), lead);
                             if (bid < 128 && u >= 128) break; }
            if (bid < 128) { PH(5) { const Params p = load_params(); rw_chain_unit(p, lds, l, bid, wvx); } }
            else {
                PH(3) for (;;) { const int u = wg_pop(CTR(0), qw, lead); if (u >= 1024) break; { const Params p = load_params(); hy_pre_unit4(p, lds, l, u, wvx); } wg_signal(CTR(1), lead); }
                wg_wait(CTR(1), 1024, lead);
                PH(4) for (int c = bid - 128; c < 256; c += 128) { { const Params p = load_params(); hy_conv_unit(p, lds, l, c, wvx); } wg_signal(CTR(2), lead); }
            }
            PH(6) { const Params p = load_params(); na_queue(p, lds, l, wvx); }
            wg_wait(CTR(2), 256, lead);
            PH(7) for (;;) { const int u = wg_pop(CTR(3), qw, lead); if (u >= 1024) break; { const Params p = load_params(); hy_post_unit4(p, lds, l, u, wvx); } wg_signal(CTR(4), lead); }
            wg_wait(CTR(4), 1024, lead);
            PH(10) for (;;) { const int u = wg_pop(CTR(5), qw, lead); if (u >= NEXP * 768 / 64 + (l == 0 ? 43 : 0)) break; { const Params p = load_params(); moe_weights_chunk(p, lds, l, u, wvx); } }
#undef CTR
        }
        GRID_BAR();
        PH(8) { const Params p = load_params(); rw_post_wg(p, lds, l, G_, bid, wvx); }
        GRID_BAR();
        PH(9) { const Params p = load_params(); unsigned char* ws = p.ws;
            DenseSched S; S.init((const bf16_t*)(ws + OFF_MIX), (const bf16_t*)(ws + OFF_WTOUT) + (size_t)l * D * D, NT, D, D, G_, bid);
            EpiRes E{(bf16_t*)(ws + OFF_XB)};
            pg8::gemm_phase<EpiRes, DenseSched, false>(lds, D, S, E, wvx);
        }
        GRID_BAR();
        PH(11) { const Params p = load_params(); phase_router(p, lds, l, G_, bid, wvx); }
        GRID_BAR();
        PH(12) { const Params p = load_params(); unsigned char* ws = p.ws;
            const int* cnt = (const int*)(ws + OFF_CTL) + 64 + l * 64;
            MoeSched S; S.init(cnt, (const bf16_t*)(ws + OFF_XB), (const bf16_t*)(ws + OFF_W13T), (size_t)1024 * D, (const int*)(ws + OFF_LTOK), D, G_, bid, (LAS int*)(lds + 139264), opaque_tid(wvx));
            EpiMoe1 E{(bf16_t*)(ws + OFF_ACT), (const float*)(ws + OFF_LRS)};
            pg8::gemm_phase<EpiMoe1, MoeSched, true>(lds, D, S, E, wvx);
        }
        GRID_BAR();
        PH(13) { const Params p = load_params(); unsigned char* ws = p.ws;
            const int* cnt = (const int*)(ws + OFF_CTL) + 64 + l * 64;
            MoeSched S; S.init(cnt, (const bf16_t*)(ws + OFF_ACT), (const bf16_t*)(ws + OFF_W2T), (size_t)D * FF, nullptr, FF, G_, bid, (LAS int*)(lds + 139264), opaque_tid(wvx));
            EpiMoe2 E{(bf16_t*)(ws + OFF_YBUF), (const int*)(ws + OFF_LTOK), (const float*)(ws + OFF_LGATE)};
            pg8::gemm_phase<EpiMoe2, MoeSched, false>(lds, FF, S, E, wvx);
        }
        GRID_BAR();
        PH(14) { const Params p = load_params(); phase_combine(p, l == DEPTH - 1, G_, bid, wvx); }
        if (l < DEPTH - 1) GRID_BAR();
    }
}

extern "C" void kernel_launch(void* const* d_in, const int* in_sizes, int n_in, void* d_out, int out_size, void* d_ws, size_t ws_size, hipStream_t stream) {
    static int grid = 0;
    if (grid == 0) {
        if (n_in != 36 || ws_size < WS_END) { fprintf(stderr, "kernel_launch: unexpected n_in %d / ws_size %zu (need %zu)\n", n_in, ws_size, (size_t)WS_END); grid = -1; return; }
        int dev = 0, cus = 0, per_cu = 0;
        hipGetDevice(&dev);
        hipDeviceGetAttribute(&cus, hipDeviceAttributeMultiprocessorCount, dev);
        hipFuncSetAttribute((const void*)fwd_megakernel, hipFuncAttributeMaxDynamicSharedMemorySize, LDS_BYTES);
        hipOccupancyMaxActiveBlocksPerMultiprocessor(&per_cu, (const void*)fwd_megakernel, NTHREADS, LDS_BYTES);
        if (per_cu < 1) { fprintf(stderr, "kernel_launch: occupancy query says %d blocks per CU\n", per_cu); per_cu = 1; }
        if (per_cu > 1) per_cu = 1;
        grid = cus * per_cu;
        if (grid != 256) { fprintf(stderr, "kernel_launch: this kernel needs exactly 256 co-resident workgroups (got %d)\n", grid); if (grid > 256) grid = 256; }
        fprintf(stderr, "kernel_launch: grid %d (cus %d), ws %zu\n", grid, cus, ws_size);
    }
    if (grid < 0) return;
    hipMemsetAsync((char*)d_ws + OFF_CTL, 0, 65536, stream);
    Params p{};
    for (int i = 0; i < 36; ++i) p.in[i] = (const float*)d_in[i];
    p.out = (float*)d_out; p.ws = (unsigned char*)d_ws;
    void* args[] = {&p};
    hipError_t e = hipLaunchCooperativeKernel((const void*)fwd_megakernel, dim3(grid), dim3(NTHREADS), args, LDS_BYTES, stream);
    if (e != hipSuccess) fprintf(stderr, "cooperative launch failed: %s (grid %d)\n", hipGetErrorString(e), grid);
}
```

```cpp
#include <hip/hip_runtime.h>
#include <hip/hip_cooperative_groups.h>
#include <cstdio>
#include <cstdint>
namespace cg = cooperative_groups;

#define LAS __attribute__((address_space(3)))
typedef unsigned short bf16_t;
typedef short bf16x8 __attribute__((ext_vector_type(8)));
typedef float f32x4 __attribute__((ext_vector_type(4)));
typedef float f32x2 __attribute__((ext_vector_type(2)));
typedef unsigned u32x4 __attribute__((ext_vector_type(4)));
typedef unsigned u32x2 __attribute__((ext_vector_type(2)));

constexpr int D = 1024, NB = 8, L = 8192, NT = NB * L, DEPTH = 2;
constexpr int IN_D = 3456, IN_DP = 3584;
constexpr int C_HX0 = 0, C_HX1 = 256, C_HV = 512, C_RR = 768, C_RK = 1280, C_RV = 1792, C_RG = 2304, C_RW = 2432, C_RA = 2560, C_NQ = 2688, C_NK = 2944, C_NV = 3200;
constexpr int NEXP = 32, FF = 512;
constexpr float NORM_EPS = 1e-6f;

constexpr size_t MiB = 1u << 20;
constexpr size_t OFF_CTL = 0;
constexpr size_t OFF_WTIN = 1 * MiB;
constexpr size_t OFF_WTOUT = 15 * MiB;
constexpr size_t OFF_RS = 19 * MiB;
constexpr size_t OFF_RGW = 20 * MiB;
constexpr size_t OFF_LTOK = 21 * MiB;
constexpr size_t OFF_LGATE = 29 * MiB;
constexpr size_t OFF_FILT = 37 * MiB;
constexpr size_t OFF_MOEW = 69 * MiB;
constexpr size_t OFF_W13T = OFF_MOEW, OFF_W2T = OFF_MOEW + 64 * MiB;
constexpr size_t OFF_ZT = OFF_MOEW;
constexpr size_t OFF_YT = OFF_MOEW + 32 * MiB;
constexpr size_t OFF_XB = 165 * MiB;
constexpr size_t OFF_MIX = 869 * MiB;
constexpr size_t OFF_PROJ = 293 * MiB;
constexpr size_t OFF_ACT = OFF_PROJ;
constexpr size_t OFF_YBUF = OFF_PROJ + 136 * MiB;
constexpr size_t OFF_YF = 741 * MiB;
constexpr size_t OFF_YB = 805 * MiB;
constexpr size_t OFF_BON = 997 * MiB;
constexpr size_t OFF_LRS = 1001 * MiB;
constexpr size_t WS_END = 1009 * MiB;
constexpr int LCAP = 65536;

constexpr int LDS_BYTES = 163840;
constexpr int NTHREADS = 512;

struct Params { const float* in[36]; float* out; unsigned char* ws; };

__device__ __forceinline__ float bf2f(unsigned b) { return __uint_as_float(b << 16); }
typedef __bf16 bf16x2_t __attribute__((ext_vector_type(2)));
__device__ __forceinline__ unsigned f2bf(float f) { return (unsigned)__builtin_bit_cast(unsigned short, (__bf16)f); }
__device__ __forceinline__ unsigned pk2(float lo, float hi) { const f32x2 v = {lo, hi}; return __builtin_bit_cast(unsigned, __builtin_convertvector(v, bf16x2_t)); }
#define DPPF(v, ctrl) __int_as_float(__builtin_amdgcn_update_dpp(0, __float_as_int(v), (ctrl), 0xF, 0xF, true))
__device__ __forceinline__ float rdlane(float v, int l) { return __int_as_float(__builtin_amdgcn_readlane(__float_as_int(v), l)); }
__device__ __forceinline__ float wave_sum(float v) {
    v += DPPF(v, 0xB1); v += DPPF(v, 0x4E); v += DPPF(v, 0x141); v += DPPF(v, 0x140);
    return (rdlane(v, 0) + rdlane(v, 16)) + (rdlane(v, 32) + rdlane(v, 48));
}
__device__ __forceinline__ float sum8(float v) { v += DPPF(v, 0xB1); v += DPPF(v, 0x4E); v += DPPF(v, 0x141); return v; }
__device__ __forceinline__ void unpack8(const u32x4 w, float* f) {
    f[0] = bf2f(w.x & 0xffffu); f[1] = __uint_as_float(w.x & 0xffff0000u);
    f[2] = bf2f(w.y & 0xffffu); f[3] = __uint_as_float(w.y & 0xffff0000u);
    f[4] = bf2f(w.z & 0xffffu); f[5] = __uint_as_float(w.z & 0xffff0000u);
    f[6] = bf2f(w.w & 0xffffu); f[7] = __uint_as_float(w.w & 0xffff0000u);
}
__device__ __forceinline__ float frcp(float x) { return __builtin_amdgcn_rcpf(x); }
__device__ __forceinline__ float ftanh(float x) { const float e = __expf(2.0f * x); return 1.0f - 2.0f * frcp(e + 1.0f); }
#define LDS_WAIT() asm volatile("s_waitcnt lgkmcnt(0)" ::: "memory")
__device__ __forceinline__ int opaque_tid(int wvx) { int ln; asm volatile("v_mbcnt_lo_u32_b32 %0, -1, 0\n\tv_mbcnt_hi_u32_b32 %0, -1, %0" : "=v"(ln)); return wvx * 64 + ln; }

namespace pg8 {
constexpr int BM = 256, BK = 64, HALF = 128, HTB = HALF * BK * 2, STAGE_BYTES = 8 * HTB;
__device__ __forceinline__ int lds_byte(int r, int c) { const int st = (r >> 4) * 2 + (c >> 5), rr = r & 15, cc = c & 31, ob = rr * 64 + cc * 2; return st * 1024 + (ob ^ (((ob >> 9) & 1) << 5)); }
__device__ __forceinline__ void stage_rc(int b, int& R, int& C) { const int st = b / 1024, sb = b % 1024, swz = sb ^ (((sb >> 9) & 1) << 5); R = (st >> 1) * 16 + swz / 64; C = (st & 1) * 32 + (swz % 64) / 2; }
__device__ __forceinline__ int perm32(int rho) { const int n = rho >> 4, i = rho & 15; return 8 * (i >> 2) + 4 * n + (i & 3); }
__device__ __forceinline__ unsigned cvt_pk_bf16(float lo, float hi) { return pk2(lo, hi); }

struct Unit { const char* A; const char* B; int pm, pn, e, cnt; };

template <class Epi, class Sched, bool GATHER>
__device__ __forceinline__ void gemm_phase(LAS unsigned char* lds, const int K, const Sched& S, const Epi& E, const int wvx) {
    const int tid = opaque_tid(wvx), wid = __builtin_amdgcn_readfirstlane(tid >> 6), lane = tid & 63, wr = wid >> 2, wc = wid & 3, fr = lane & 15, fq = lane >> 4;
    const int nt = K / BK;
    int Rr[2], Cc[2];
    unsigned voffB[2];
#pragma unroll
    for (int i = 0; i < 2; ++i) { stage_rc(tid * 16 + i * 8192, Rr[i], Cc[i]); const int Rb = Epi::PERM ? ((Rr[i] & ~31) + perm32(Rr[i] & 31)) : Rr[i];
        voffB[i] = (unsigned)(Rb * K + Cc[i]) * 2u; }
    const size_t kstep = (size_t)(BK * 2);
    const size_t hstep = (size_t)HALF * K * 2;
    const unsigned ldsw = (unsigned)wid * 1024u;
    const int aoff = lds_byte(wr * 64 + fr, fq * 8), boff = lds_byte(wc * 32 + fr, fq * 8);
#define PG8_SA(b, h) (((b) * 2 + (h)) * HTB)
#define PG8_SB(b, h) ((4 + (b) * 2 + (h)) * HTB)
#define PG8_STAGE(bufoff, gbase, voff) do { _Pragma("unroll") for (int _i = 0; _i < 2; ++_i) \
        __builtin_amdgcn_global_load_lds((const unsigned*)((const char*)(gbase) + (voff)[_i]), (LAS unsigned*)(lds + (bufoff) + ldsw + _i * 8192), 16, 0, 0); } while (0)
#define PG8_LDA(dst, b, h) do { _Pragma("unroll") for (int m = 0; m < 4; ++m) _Pragma("unroll") for (int k = 0; k < 2; ++k) dst[m][k] = *(const LAS bf16x8*)(lds + PG8_SA(b, h) + aoff + m * 2048 + k * 1024); } while (0)
#define PG8_LDB(dst, b, h) do { _Pragma("unroll") for (int n = 0; n < 2; ++n) _Pragma("unroll") for (int k = 0; k < 2; ++k) dst[n][k] = *(const LAS bf16x8*)(lds + PG8_SB(b, h) + boff + n * 2048 + k * 1024); } while (0)
#define PG8_MMA(ai, bj, At, Bt) do { __builtin_amdgcn_s_setprio(1); _Pragma("unroll") for (int m = 0; m < 4; ++m) _Pragma("unroll") for (int n = 0; n < 2; ++n) _Pragma("unroll") for (int k = 0; k < 2; ++k) \
        acc[ai][bj][m][n] = __builtin_amdgcn_mfma_f32_16x16x32_bf16(Bt[n][k], At[m][k], acc[ai][bj][m][n], 0, 0, 0); __builtin_amdgcn_s_setprio(0); } while (0)
#define PG8_WAIT_V(n) asm volatile("s_waitcnt vmcnt(" #n ")" ::: "memory")
#define PG8_WAIT_L(n) asm volatile("s_waitcnt lgkmcnt(" #n ")" ::: "memory")
#define PG8_BAR __builtin_amdgcn_s_barrier()
#define PG8_SCHED __builtin_amdgcn_sched_barrier(0)
    Unit cur, nxt; int ui = 0;
    if (!S.next(0, cur)) return;
    f32x4 acc[2][2][4][2];
#pragma unroll
    for (int a = 0; a < 2; ++a)
#pragma unroll
        for (int b = 0; b < 2; ++b)
#pragma unroll
            for (int m = 0; m < 4; ++m)
#pragma unroll
                for (int n = 0; n < 2; ++n) acc[a][b][m][n] = (f32x4){0.f, 0.f, 0.f, 0.f};
    bf16x8 At[4][2], B0[2][2], B1[2][2];
    typename Epi::Pre epre;
    unsigned vA[2][2];
    LAS u32x4* stash = (LAS u32x4*)(lds + STAGE_BYTES) + tid;
    if (GATHER) S.aoff(cur, tid, vA);
    else {
#pragma unroll
        for (int h = 0; h < 2; ++h)
#pragma unroll
            for (int i = 0; i < 2; ++i) vA[h][i] = (unsigned)((h * HALF + Rr[i]) * K + Cc[i]) * 2u;
    }
    const char* cA = cur.A; const char* cB = cur.B;
    PG8_STAGE(PG8_SB(0, 0), cB, voffB); PG8_STAGE(PG8_SB(0, 1), cB + hstep, voffB); PG8_STAGE(PG8_SA(0, 0), cA, vA[0]); PG8_STAGE(PG8_SA(0, 1), cA, vA[1]);
    if (wr == 1) PG8_BAR;
    PG8_WAIT_V(2); PG8_BAR;
    PG8_STAGE(PG8_SB(1, 0), cB + kstep, voffB); PG8_STAGE(PG8_SA(1, 0), cA + kstep, vA[0]); PG8_STAGE(PG8_SB(1, 1), cB + hstep + kstep, voffB);
    PG8_WAIT_V(6); PG8_BAR;
    for (;;) {
        const bool has_next = S.next(ui + 1, nxt);
        const char* nA = has_next ? nxt.A : cA; const char* nB = has_next ? nxt.B : cB;
        if (GATHER) { unsigned vn[2][2];
            if (has_next) { S.aoff(nxt, tid, vn); *stash = (u32x4){vn[0][0], vn[0][1], vn[1][0], vn[1][1]}; }
            else *stash = (u32x4){vA[0][0], vA[0][1], vA[1][0], vA[1][1]}; }
        for (int t = 0; t < nt; t += 2) {
            const bool last = (t == nt - 2);
            const char* a1 = cA + (size_t)(t + 1) * kstep;
            const char* a2 = last ? nA : cA + (size_t)(t + 2) * kstep; const char* b2 = last ? nB : cB + (size_t)(t + 2) * kstep;
            const char* a3 = a2 + kstep; const char* b3 = b2 + kstep;
            if (last) E.prefetch(epre, cur, wr, wc, fr, fq);
            PG8_LDB(B0, 0, 0); PG8_LDB(B1, 0, 1); PG8_SCHED; PG8_LDA(At, 0, 0); PG8_STAGE(PG8_SA(1, 1), a1, vA[1]);
            if (GATHER && last) { const u32x4 sv = *stash; vA[0][0] = sv.x; vA[0][1] = sv.y; vA[1][0] = sv.z; vA[1][1] = sv.w; }
            PG8_WAIT_V(8); PG8_WAIT_L(0); PG8_BAR; PG8_MMA(0, 0, At, B0); PG8_MMA(0, 1, At, B1); PG8_BAR; PG8_SCHED;
            PG8_LDA(At, 0, 1); PG8_STAGE(PG8_SB(0, 0), b2, voffB); PG8_STAGE(PG8_SB(0, 1), b2 + hstep, voffB); PG8_STAGE(PG8_SA(0, 0), a2, vA[0]);
            PG8_WAIT_V(8); PG8_WAIT_L(0); PG8_BAR; PG8_MMA(1, 0, At, B0); PG8_MMA(1, 1, At, B1); PG8_BAR; PG8_SCHED;
            PG8_LDB(B0, 1, 0); PG8_LDB(B1, 1, 1); PG8_SCHED; PG8_LDA(At, 1, 0); PG8_STAGE(PG8_SA(0, 1), a2, vA[1]);
            PG8_WAIT_V(8); PG8_WAIT_L(0); PG8_BAR; PG8_MMA(0, 0, At, B0); PG8_MMA(0, 1, At, B1); PG8_BAR; PG8_SCHED;
            PG8_LDA(At, 1, 1); PG8_STAGE(PG8_SB(1, 0), b3, voffB); PG8_STAGE(PG8_SB(1, 1), b3 + hstep, voffB); PG8_STAGE(PG8_SA(1, 0), a3, vA[0]);
            PG8_WAIT_V(8); PG8_WAIT_L(0); PG8_BAR; PG8_MMA(1, 0, At, B0); PG8_MMA(1, 1, At, B1); PG8_BAR; PG8_SCHED;
        }
        if (wr == 0) PG8_BAR;
        {
            Unit eu = cur; int efr = fr, efq = fq;
            eu.pm = __builtin_amdgcn_readfirstlane(eu.pm); eu.pn = __builtin_amdgcn_readfirstlane(eu.pn); eu.e = __builtin_amdgcn_readfirstlane(eu.e); eu.cnt = __builtin_amdgcn_readfirstlane(eu.cnt);
            asm volatile("" : "+s"(eu.pm), "+s"(eu.pn), "+s"(eu.e), "+s"(eu.cnt), "+v"(efr), "+v"(efq));
            E(acc, eu, wr, wc, efr, efq, epre);
        }
        if (!has_next) break;
#pragma unroll
        for (int a = 0; a < 2; ++a)
#pragma unroll
            for (int b = 0; b < 2; ++b)
#pragma unroll
                for (int m = 0; m < 4; ++m)
#pragma unroll
                    for (int n = 0; n < 2; ++n) acc[a][b][m][n] = (f32x4){0.f, 0.f, 0.f, 0.f};
        cur = nxt; cA = nA; cB = nB; ++ui;
        if (wr == 1) PG8_BAR;
    }
    PG8_WAIT_V(0);
    PG8_BAR;
#undef PG8_SA
#undef PG8_SB
#undef PG8_STAGE
#undef PG8_LDA
#undef PG8_LDB
#undef PG8_MMA
#undef PG8_WAIT_V
#undef PG8_WAIT_L
#undef PG8_BAR
#undef PG8_SCHED
}
}

struct DenseSched {
    const bf16_t* A; const bf16_t* Bt; int K, nM, nN, nwg, G, c;
    __device__ void init(const bf16_t* A_, const bf16_t* Bt_, int M, int N, int K_, int G_, int c_) { A = A_; Bt = Bt_; K = K_; nM = M / 256; nN = N / 256; nwg = nM * nN; G = G_; c = c_; }
    __device__ __forceinline__ bool next(int i, pg8::Unit& u) const {
        const long Lx = (long)i * G + c; if (Lx >= nwg) return false;
        int wgid = (int)Lx; { const int q = nwg / 8, r = nwg % 8, xcd = wgid % 8, off = wgid / 8; wgid = (xcd < r ? xcd * (q + 1) : r * (q + 1) + (xcd - r) * q) + off; }
        const int nig = 8 * nN, gid = wgid / nig, fm = gid * 8, gsz = (nM - fm) < 8 ? (nM - fm) : 8;
        u.pm = fm + ((wgid % nig) % gsz); u.pn = (wgid % nig) / gsz; u.e = 0; u.cnt = 0;
        u.A = (const char*)A + (size_t)u.pm * 256 * K * 2; u.B = (const char*)Bt + (size_t)u.pn * 256 * K * 2; return true;
    }
    __device__ __forceinline__ void aoff(const pg8::Unit&, int, unsigned (&)[2][2]) const {}
};
struct MoeSched {
    const bf16_t* A; const bf16_t* Bt; size_t bstride;
    const int* ltok;
    LAS int* tp;
    int K, G, c, total;
    __device__ void init(const int* cnt_, const bf16_t* A_, const bf16_t* Bt_, size_t bstride_, const int* ltok_, int K_, int G_, int c_, LAS int* lds_tab, int tid) {
        A = A_; Bt = Bt_; bstride = bstride_; ltok = ltok_; K = K_; G = G_; c = (G_ % 8 == 0) ? (c_ & 7) * (G_ >> 3) + (c_ >> 3) : c_;
        tp = lds_tab;
        __syncthreads();
        if (tid < 32) tp[64 + tid] = cnt_[tid];
        __syncthreads();
        if (tid == 0) { int t = 0; for (int e = 0; e < NEXP; ++e) { tp[e] = t; t += (tp[64 + e] + 255) >> 8; } tp[32] = t; }
        __syncthreads();
        total = __builtin_amdgcn_readfirstlane(tp[32]);
    }
    __device__ __forceinline__ bool next(int i, pg8::Unit& u) const {
        const long Lx = (long)i * G + c; if (Lx >= (long)total * 4) return false;
        const int ti = (int)(Lx >> 2); u.pn = (int)(Lx & 3);
        int ln; asm volatile("v_mbcnt_lo_u32_b32 %0, -1, 0\n\tv_mbcnt_hi_u32_b32 %0, -1, %0" : "=v"(ln));
        const int l5 = ln & 31; const int lo = tp[l5], hi = tp[l5 + 1];
        const unsigned long long mask = __builtin_amdgcn_ballot_w64(lo <= ti && ti < hi);
        const int e = __builtin_amdgcn_readfirstlane((int)__builtin_ctzll(mask) & 31);
        const int base = __builtin_amdgcn_readfirstlane(tp[e]), ce = __builtin_amdgcn_readfirstlane(tp[64 + e]);
        u.e = e; u.pm = ti; u.cnt = ce - (ti - base) * 256;
        u.A = ltok ? (const char*)A : (const char*)A + (size_t)ti * 256 * K * 2;
        u.B = (const char*)(Bt + (size_t)e * bstride) + (size_t)u.pn * 256 * K * 2;
        u.pm = ti | ((ti - base) << 16);
        return true;
    }
    __device__ __forceinline__ void aoff(const pg8::Unit& u, int tid, unsigned (&v)[2][2]) const {
        const int lt = u.pm >> 16; int Rr[2], Cc[2]; pg8::stage_rc(tid * 16, Rr[0], Cc[0]); pg8::stage_rc(tid * 16 + 8192, Rr[1], Cc[1]);
        int tk[2][2];
#pragma unroll
        for (int h = 0; h < 2; ++h)
#pragma unroll
            for (int i = 0; i < 2; ++i) { const int r = h * 128 + Rr[i]; tk[h][i] = ltok[(size_t)u.e * LCAP + lt * 256 + (r < u.cnt ? r : 0)]; }
#pragma unroll
        for (int h = 0; h < 2; ++h)
#pragma unroll
            for (int i = 0; i < 2; ++i) { const int r = h * 128 + Rr[i]; const int tok = (r < u.cnt) ? (tk[h][i] >> 1) : 0; v[h][i] = (unsigned)(tok * K + Cc[i]) * 2u; }
    }
};

struct EpiProj {
    static constexpr bool PERM = true;
    struct Pre { float rs[8]; };
    bf16_t* O; const float* rs;
    __device__ __forceinline__ void prefetch(Pre& pr, const pg8::Unit& u, int wr, int wc, int fr, int fq) const {
        const int row0 = (u.pm & 0xffff) * 256 + wr * 64 + fr;
#pragma unroll
        for (int ai = 0; ai < 2; ++ai)
#pragma unroll
            for (int m = 0; m < 4; ++m) pr.rs[ai * 4 + m] = rs[row0 + ai * 128 + m * 16];
    }
    __device__ __forceinline__ void operator()(const f32x4 (&acc_)[2][2][4][2], const pg8::Unit& u, int wr, int wc, int fr, int fq, const Pre& pr) const {
        const int row0 = u.pm * 256 + wr * 64 + fr, col0 = u.pn * 256 + wc * 32 + 8 * fq;
        f32x4 (&acc)[2][2][4][2] = const_cast<f32x4 (&)[2][2][4][2]>(acc_);
        const bool act = (u.pn == 9);
        if (act) {
#pragma unroll
            for (int ai = 0; ai < 2; ++ai)
#pragma unroll
                for (int m = 0; m < 4; ++m) { const float s = pr.rs[ai * 4 + m];
#pragma unroll
                    for (int n = 0; n < 2; ++n)
#pragma unroll
                        for (int e = 0; e < 4; ++e) { acc[ai][0][m][n][e] = frcp(1.0f + __expf(-acc[ai][0][m][n][e] * s)); acc[ai][1][m][n][e] = ftanh(acc[ai][1][m][n][e] * s); } }
            asm volatile("" ::: "memory");
        }
#pragma unroll
        for (int ai = 0; ai < 2; ++ai)
#pragma unroll
            for (int m = 0; m < 4; ++m) { const int row = row0 + ai * 128 + m * 16; const float s = act ? 1.0f : pr.rs[ai * 4 + m]; bf16_t* rowp = O + (size_t)row * IN_DP + col0;
#pragma unroll
                for (int bj = 0; bj < 2; ++bj) { const f32x4 v0 = acc[ai][bj][m][0] * s, v1 = acc[ai][bj][m][1] * s;
                    u32x4 w; w.x = pg8::cvt_pk_bf16(v0[0], v0[1]); w.y = pg8::cvt_pk_bf16(v0[2], v0[3]); w.z = pg8::cvt_pk_bf16(v1[0], v1[1]); w.w = pg8::cvt_pk_bf16(v1[2], v1[3]);
                    *(u32x4*)(rowp + bj * 128) = w; } }
    }
};
struct EpiRes {
    static constexpr bool PERM = true;
    struct Pre { int dummy; };
    bf16_t* x16;
    __device__ __forceinline__ void prefetch(Pre&, const pg8::Unit&, int, int, int, int) const {}
    __device__ __forceinline__ void operator()(const f32x4 (&acc)[2][2][4][2], const pg8::Unit& u, int wr, int wc, int fr, int fq, const Pre&) const {
        const int row0 = u.pm * 256 + wr * 64 + fr, col0 = u.pn * 256 + wc * 32 + 8 * fq;
#pragma unroll
        for (int ai = 0; ai < 2; ++ai) {
            u32x4 braw[4][2];
#pragma unroll
            for (int m = 0; m < 4; ++m)
#pragma unroll
                for (int bj = 0; bj < 2; ++bj) braw[m][bj] = *(const u32x4*)(x16 + (size_t)(row0 + ai * 128 + m * 16) * D + col0 + bj * 128);
            asm volatile("" ::: "memory");
#pragma unroll
            for (int m = 0; m < 4; ++m) { const size_t off = (size_t)(row0 + ai * 128 + m * 16) * D + col0;
#pragma unroll
                for (int bj = 0; bj < 2; ++bj) { const f32x4 v0 = acc[ai][bj][m][0], v1 = acc[ai][bj][m][1]; float bb[8]; unpack8(braw[m][bj], bb);
                    u32x4 w; w.x = pk2(bb[0] + v0[0], bb[1] + v0[1]); w.y = pk2(bb[2] + v0[2], bb[3] + v0[3]); w.z = pk2(bb[4] + v1[0], bb[5] + v1[1]); w.w = pk2(bb[6] + v1[2], bb[7] + v1[3]);
                    *(u32x4*)(x16 + off + bj * 128) = w; } }
            asm volatile("" ::: "memory");
        }
    }
};
struct EpiMoe1 {
    static constexpr bool PERM = true;
    struct Pre { int dummy; };
    bf16_t* act; const float* lrs;
    __device__ __forceinline__ void prefetch(Pre&, const pg8::Unit&, int, int, int, int) const {}
    __device__ __forceinline__ void operator()(const f32x4 (&acc)[2][2][4][2], const pg8::Unit& u, int wr, int wc, int fr, int fq, const Pre&) const {
        const int ti = u.pm & 0xffff, lt = u.pm >> 16;
        const int r0 = wr * 64 + fr, col0 = u.pn * 256 + wc * 32 + 8 * fq;
        float sv[8];
#pragma unroll
        for (int q = 0; q < 8; ++q) { const int r = r0 + (q >> 2) * 128 + (q & 3) * 16; sv[q] = (r < u.cnt) ? lrs[(size_t)u.e * LCAP + lt * 256 + r] : 0.f; }
        asm volatile("" ::: "memory");
#pragma unroll
        for (int ai = 0; ai < 2; ++ai)
#pragma unroll
            for (int m = 0; m < 4; ++m) { const int r = r0 + ai * 128 + m * 16;
                const float s = sv[ai * 4 + m];
                bf16_t* rowp = act + ((size_t)ti * 256 + r) * FF + (col0 >> 1);
#pragma unroll
                for (int bj = 0; bj < 2; ++bj) { const f32x4 v0 = acc[ai][bj][m][0] * s, v1 = acc[ai][bj][m][1] * s;
                    const float o0 = v0[0] * frcp(1.f + __expf(-v0[0])) * v0[1], o1 = v0[2] * frcp(1.f + __expf(-v0[2])) * v0[3];
                    const float o2 = v1[0] * frcp(1.f + __expf(-v1[0])) * v1[1], o3 = v1[2] * frcp(1.f + __expf(-v1[2])) * v1[3];
                    u32x2 w; w.x = pg8::cvt_pk_bf16(o0, o1); w.y = pg8::cvt_pk_bf16(o2, o3);
                    *(u32x2*)(rowp + bj * 64) = w; } }
    }
};
struct EpiMoe2 {
    static constexpr bool PERM = true;
    struct Pre { int dummy; };
    bf16_t* ybuf; const int* ltok; const float* lgate;
    __device__ __forceinline__ void prefetch(Pre&, const pg8::Unit&, int, int, int, int) const {}
    __device__ __forceinline__ void operator()(const f32x4 (&acc)[2][2][4][2], const pg8::Unit& u, int wr, int wc, int fr, int fq, const Pre&) const {
        const int lt = u.pm >> 16, r0 = wr * 64 + fr, col0 = u.pn * 256 + wc * 32 + 8 * fq;
        int dv[8]; float gv[8];
#pragma unroll
        for (int q = 0; q < 8; ++q) { const int r = r0 + (q >> 2) * 128 + (q & 3) * 16; const bool ok = r < u.cnt;
            const size_t li = (size_t)u.e * LCAP + lt * 256 + (ok ? r : 0); const int d = ltok[li]; const float g = lgate[li];
            dv[q] = ok ? d : -1; gv[q] = g; }
        asm volatile("" ::: "memory");
#pragma unroll
        for (int ai = 0; ai < 2; ++ai)
#pragma unroll
            for (int m = 0; m < 4; ++m) { const int dest = dv[ai * 4 + m];
                if (dest >= 0) { const float g = gv[ai * 4 + m];
                    bf16_t* rowp = ybuf + (size_t)dest * D + col0;
#pragma unroll
                    for (int bj = 0; bj < 2; ++bj) { const f32x4 v0 = acc[ai][bj][m][0] * g, v1 = acc[ai][bj][m][1] * g;
                        u32x4 w; w.x = pg8::cvt_pk_bf16(v0[0], v0[1]); w.y = pg8::cvt_pk_bf16(v0[2], v0[3]); w.z = pg8::cvt_pk_bf16(v1[0], v1[1]); w.w = pg8::cvt_pk_bf16(v1[2], v1[3]);
                        *(u32x4*)(rowp + bj * 128) = w; } } }
    }
};

__device__ __forceinline__ void transpose_item(const float* __restrict__ W, int K, int N, bf16_t* WT, int rmul, int radd, const float* __restrict__ g, LAS float* scr, int item, int lane) {
    const int nblk = N / 32, kb = item / nblk, nb = item % nblk, k0 = 64 * kb, n0 = 32 * nb;
    f32x4 v[8]; float gv[8];
#pragma unroll
    for (int i = 0; i < 8; ++i) { v[i] = *(const f32x4*)(W + (size_t)(k0 + 8 * i + (lane >> 3)) * N + n0 + 4 * (lane & 7)); gv[i] = g ? g[k0 + 8 * i + (lane >> 3)] : 1.0f; }
#pragma unroll
    for (int i = 0; i < 8; ++i) { const int kk = 8 * i + (lane >> 3); *(LAS f32x4*)(scr + kk * 36 + 4 * (lane & 7)) = v[i] * gv[i]; }
    LDS_WAIT(); asm volatile("" ::: "memory");
    const int c = lane & 7;
#pragma unroll
    for (int j = 0; j < 4; ++j) { const int n = (lane >> 3) + 8 * j; const LAS float* s = scr + (8 * c) * 36 + n;
        u32x4 o; o.x = pk2(s[0 * 36], s[1 * 36]); o.y = pk2(s[2 * 36], s[3 * 36]); o.z = pk2(s[4 * 36], s[5 * 36]); o.w = pk2(s[6 * 36], s[7 * 36]);
        *(u32x4*)(WT + (size_t)(rmul * (n0 + n) + radd) * K + k0 + 8 * c) = o; }
    LDS_WAIT(); asm volatile("" ::: "memory");
}

__device__ __forceinline__ void filt_item8(const Params& p, int l, int m0, int lane, float* G) {
    const float* w1 = p.in[5] + l * 33 * 64; const float* w2 = p.in[7] + l * 4096; const float* w3 = p.in[9] + l * 4096; const float* wout = p.in[11] + l * 64 * 512;
    const float b1v = p.in[6][l * 64 + lane], b2v = p.in[8][l * 64 + lane], b3v = p.in[10][l * 64 + lane], fr = p.in[12][l * 64 + lane];
    float hcur[8], acc[8];
    {
#pragma unroll
        for (int j = 0; j < 8; ++j) { const int m = m0 + j; float zl = 0.f;
            const float wv = (6.283185307179586f / 8192.0f) * (float)m; const float fstep = (15.0f - 1e-4f) / 15.0f;
            if (lane == 0) zl = (float)m / 8191.0f; else if (lane <= 16) zl = cosf((1e-4f + (float)(lane - 1) * fstep) * wv); else if (lane <= 32) zl = -sinf((1e-4f + (float)(lane - 17) * fstep) * wv);
            hcur[j] = zl; acc[j] = b1v; }
        float wc[33];
#pragma unroll
        for (int i = 0; i < 33; ++i) wc[i] = w1[i * 64 + lane];
#pragma unroll
        for (int i = 0; i < 33; ++i)
#pragma unroll
            for (int j = 0; j < 8; ++j) acc[j] += rdlane(hcur[j], i) * wc[i];
#pragma unroll
        for (int j = 0; j < 8; ++j) { hcur[j] = sinf(fr * acc[j]); acc[j] = b2v; }
    }
    asm volatile("" ::: "memory");
    {   float wc[64];
#pragma unroll
        for (int i = 0; i < 64; ++i) wc[i] = w2[i * 64 + lane];
#pragma unroll
        for (int i = 0; i < 64; ++i)
#pragma unroll
            for (int j = 0; j < 8; ++j) acc[j] += rdlane(hcur[j], i) * wc[i];
#pragma unroll
        for (int j = 0; j < 8; ++j) { hcur[j] = sinf(fr * acc[j]); acc[j] = b3v; }
    }
    asm volatile("" ::: "memory");
    {   float wc[64];
#pragma unroll
        for (int i = 0; i < 64; ++i) wc[i] = w3[i * 64 + lane];
#pragma unroll
        for (int i = 0; i < 64; ++i)
#pragma unroll
            for (int j = 0; j < 8; ++j) acc[j] += rdlane(hcur[j], i) * wc[i];
#pragma unroll
        for (int j = 0; j < 8; ++j) hcur[j] = sinf(fr * acc[j]);
    }
    asm volatile("" ::: "memory");
    float (&h3)[8] = hcur;
    float o[8][8];
#pragma unroll
    for (int j = 0; j < 8; ++j)
#pragma unroll
        for (int q = 0; q < 8; ++q) o[j][q] = 0.f;
#pragma unroll 2
    for (int i = 0; i < 64; ++i) { float wo[8];
#pragma unroll
        for (int q = 0; q < 8; ++q) wo[q] = wout[i * 512 + q * 64 + lane];
#pragma unroll
        for (int j = 0; j < 8; ++j) { const float hv = rdlane(h3[j], i);
#pragma unroll
            for (int q = 0; q < 8; ++q) o[j][q] += hv * wo[q]; } }
    const float dmin = -3.0701134573253944f, dmax = -15.350567286626972f;
#pragma unroll
    for (int q = 0; q < 8; ++q) { const int n = q * 64 + lane, d = n >> 8, c = n & 255;
        const float delta = fabsf(dmin + (float)c * ((dmax - dmin) / 255.0f));
        float v[8];
#pragma unroll
        for (int j = 0; j < 8; ++j) v[j] = o[j][q] * expf(-((float)(m0 + j) / 8191.0f) * delta);
        float* dst = G + (size_t)c * 16384 + d * 8192 + m0;
        *(f32x4*)dst = (f32x4){v[0], v[1], v[2], v[3]}; *(f32x4*)(dst + 4) = (f32x4){v[4], v[5], v[6], v[7]}; }
}

__device__ __forceinline__ void phase_prologue(const Params& p, LAS unsigned char* lds, int G_, int bid, const int wvx) {
    const int tid = opaque_tid(wvx), lane = tid & 63, wave = tid >> 6;
    const int gw = bid * 8 + wave, NGW = G_ * 8;
    LAS float* scr = (LAS float*)(lds + wave * 16384);
    unsigned char* ws = p.ws;
    for (int it = gw; it < 16 * 108; it += NGW) transpose_item(p.in[2], D, IN_D, (bf16_t*)(ws + OFF_WTIN), 1, 0, p.in[1], scr, it, lane);
    for (int i = bid * NTHREADS + tid; i < 2 * 128 * D / 8; i += G_ * NTHREADS) { const int l = i / (128 * D / 8), r = i % (128 * D / 8);
        *(u32x4*)((bf16_t*)(ws + OFF_WTIN) + (size_t)l * IN_DP * D + (size_t)IN_D * D + (size_t)r * 8) = (u32x4){0u, 0u, 0u, 0u}; }
    for (int i = bid * NTHREADS + tid; i < 2 * 48 * D; i += G_ * NTHREADS) { const int l = i / (48 * D), r = i % (48 * D), o = r / D, k = r % D;
        const float g = p.in[27][l * D + k]; const float w = g * ((o < 4) ? p.in[28][((size_t)l * D + k) * 4 + o] : (o < 36 ? p.in[30][((size_t)l * D + k) * 32 + (o - 4)] : 0.f));
        const unsigned hi = f2bf(w); const float lo = w - bf2f(hi);
        bf16_t* rg = (bf16_t*)(ws + OFF_RGW) + (size_t)l * 2 * 48 * D; rg[o * D + k] = (bf16_t)hi; rg[48 * D + o * D + k] = (bf16_t)f2bf(lo); }
}
__device__ __forceinline__ void filters_all(const Params& p, int nwg, int rank, const int wvx) {
    const int tid = opaque_tid(wvx), lane = tid & 63, wave = tid >> 6;
    for (int it = rank * 8 + wave; it < 2 * (L / 8); it += nwg * 8) { const int l = it / (L / 8), m0 = (it % (L / 8)) * 8; filt_item8(p, l, m0, lane, (float*)(p.ws + OFF_FILT) + (size_t)l * 256 * 16384); }
}

__device__ __forceinline__ void moe_weights_chunk(const Params& p, LAS unsigned char* lds, int l, int chunk, const int wvx) {
    const int tid = opaque_tid(wvx), lane = tid & 63, wave = tid >> 6;
    LAS float* scr = (LAS float*)(lds + wave * 16384);
    bf16_t* W13 = (bf16_t*)(p.ws + OFF_W13T); bf16_t* W2 = (bf16_t*)(p.ws + OFF_W2T);
    const float* g = p.in[27] + l * D;
#pragma unroll 1
    for (int k = 0; k < 8; ++k) { const int it = chunk * 64 + wave * 8 + k;
        if (it >= NEXP * 768) { const int x = it - NEXP * 768;
            if (x < 16 * 108) transpose_item(p.in[2] + (size_t)D * IN_D, D, IN_D, (bf16_t*)(p.ws + OFF_WTIN) + (size_t)IN_DP * D, 1, 0, p.in[1] + D, scr, x, lane);
            else if (x < 16 * 108 + 1024) { const int y = x - 16 * 108, lo = y >> 9; transpose_item(p.in[26] + (size_t)lo * D * D, D, D, (bf16_t*)(p.ws + OFF_WTOUT) + (size_t)lo * D * D, 1, 0, nullptr, scr, y & 511, lane); }
            continue; }
        const int e = it / 768, r = it % 768;
        if (r < 256) transpose_item(p.in[32] + ((size_t)l * NEXP + e) * D * FF, D, FF, W13 + (size_t)e * 1024 * D, 2, 0, g, scr, r, lane);
        else if (r < 512) transpose_item(p.in[33] + ((size_t)l * NEXP + e) * D * FF, D, FF, W13 + (size_t)e * 1024 * D, 2, 1, g, scr, r - 256, lane);
        else transpose_item(p.in[34] + ((size_t)l * NEXP + e) * FF * D, FF, D, W2 + (size_t)e * D * FF, 1, 0, nullptr, scr, r - 512, lane); }
}
__device__ __forceinline__ void phase_rownorm(const float* x, bf16_t* xb, float* rs, int G_, int bid, const int wvx) {
    const int tid = opaque_tid(wvx), lane = tid & 63, wave = tid >> 6;
    for (int row = bid * 8 + wave; row < NT; row += G_ * 8) {
        const f32x4* xr = (const f32x4*)(x + (size_t)row * D) + lane; f32x4 v[4]; float s = 0.f;
#pragma unroll
        for (int j = 0; j < 4; ++j) { v[j] = xr[64 * j]; s += (v[j].x * v[j].x + v[j].y * v[j].y) + (v[j].z * v[j].z + v[j].w * v[j].w); }
        s = wave_sum(s);
        if (lane == 0) rs[row] = 1.0f / sqrtf(s * (1.0f / D) + NORM_EPS);
        u32x2* o = (u32x2*)(xb + (size_t)row * D) + lane;
#pragma unroll
        for (int j = 0; j < 4; ++j) o[64 * j] = (u32x2){pk2(v[j].x, v[j].y), pk2(v[j].z, v[j].w)};
    }
}

__device__ __forceinline__ void load8(const bf16_t* p, bool ok, float* f) { if (ok) { unpack8(*(const u32x4*)p, f); } else {
#pragma unroll
    for (int j = 0; j < 8; ++j) f[j] = 0.f; } }

__device__ __forceinline__ void hy_pre_unit(const Params& p, LAS unsigned char* lds, int l, int unit, const int wvx) {
    const int tid = opaque_tid(wvx);
    const int ct = unit & 3, tt = (unit >> 2) & 127, b = unit >> 9;
    const bf16_t* proj = (const bf16_t*)(p.ws + OFF_PROJ);
    bf16_t* zT = (bf16_t*)(p.ws + OFF_ZT);
    const float* cw = p.in[3] + l * 3 * 768; const float* cb = p.in[4] + l * 768;
    LAS bf16_t* tile = (LAS bf16_t*)lds;
    {
        const int tl = tid >> 3, c8 = (tid & 7) * 8, t = tt * 64 + tl, c = ct * 64 + c8;
        const bf16_t* row = proj + ((size_t)b * L + t) * IN_DP;
        float x1[3][8], vv[3][8];
        load8(row - IN_DP + C_HX1 + c, t > 0, x1[0]); load8(row + C_HX1 + c, true, x1[1]); load8(row + IN_DP + C_HX1 + c, t < L - 1, x1[2]);
        load8(row - IN_DP + C_HV + c, t > 0, vv[0]); load8(row + C_HV + c, true, vv[1]); load8(row + IN_DP + C_HV + c, t < L - 1, vv[2]);
#pragma unroll
        for (int j = 0; j < 8; ++j) { const int c1 = C_HX1 + c + j, c2 = C_HV + c + j;
            const float a = x1[0][j] * cw[c1] + x1[1][j] * cw[768 + c1] + x1[2][j] * cw[1536 + c1] + cb[c1];
            const float v = vv[0][j] * cw[c2] + vv[1][j] * cw[768 + c2] + vv[2][j] * cw[1536 + c2] + cb[c2];
            tile[(c8 + j) * 72 + tl] = (bf16_t)f2bf(a * v); }
    }
    __syncthreads();
    {
        const int cl = tid >> 3, seg = tid & 7;
        const u32x4 w = *(const LAS u32x4*)(tile + cl * 72 + seg * 8);
        *(u32x4*)(zT + ((size_t)(ct * 64 + cl) * NB + b) * L + tt * 64 + seg * 8) = w;
    }
    __syncthreads();
}

typedef float f32x16 __attribute__((ext_vector_type(16)));
__device__ __forceinline__ void hy_conv_unit(const Params& p, LAS unsigned char* lds, int l, int c, const int wvx) {
    const int tid = opaque_tid(wvx), lane = tid & 63, wave = __builtin_amdgcn_readfirstlane(tid >> 6);
    const float* G = (const float*)(p.ws + OFF_FILT) + ((size_t)l * 256 + c) * 16384;
    const bf16_t* zT = (const bf16_t*)(p.ws + OFF_ZT) + (size_t)c * NB * L;
    float* yT = (float*)(p.ws + OFF_YT) + (size_t)c * NB * L;
    LAS bf16_t* Re = (LAS bf16_t*)lds; LAS bf16_t* Ro = Re + 16384;
    LAS unsigned char* Zs = lds + 65536;
    constexpr int ZB = 8976;
    LAS float* red = (LAS float*)(lds + 65536 + 8 * ZB);
    __syncthreads();
    float ss = 0.f; const float GF0 = G[8192];
#pragma unroll 1
    for (int i0 = 0; i0 < 16384; i0 += 8 * NTHREADS) { float gq[8];
#pragma unroll
        for (int k = 0; k < 8; ++k) gq[k] = G[i0 + k * NTHREADS + tid];
#pragma unroll
        for (int k = 0; k < 8; ++k) { const int i = i0 + k * NTHREADS + tid; const float g = gq[k]; ss += g * g;
            if (i == 8192) { Ro[16383] = 0; Re[0] = 0; }
            else { const int dl = (i < 8192) ? i : (8192 - i); const bf16_t bv = (bf16_t)f2bf(i == 0 ? g + GF0 : g); Re[8192 - dl] = bv; Ro[8191 - dl] = bv; } } }
    ss = wave_sum(ss); if (lane == 0) red[wave] = ss;
    f32x16 acc[2][4];
#pragma unroll
    for (int mt = 0; mt < 2; ++mt)
#pragma unroll
        for (int i = 0; i < 4; ++i)
#pragma unroll
            for (int e = 0; e < 16; ++e) acc[mt][i][e] = 0.f;
    const int r = lane & 31, hh = lane >> 5;
#pragma unroll 1
    for (int h = 0; h < 2; ++h) {
        __syncthreads();
        { u32x4 zq[9]; int tq = tid; asm volatile("" : "+v"(tq));
#pragma unroll
          for (int k = 0; k < 9; ++k) { const int q = tq + k * NTHREADS; const int ch = q & 7, Jp = (q >> 3) % 70, b = (q >> 3) / 70; const int J = 64 * h + Jp - 3;
            zq[k] = (u32x4){0u, 0u, 0u, 0u}; if (q < 4480 && Jp >= 3 && Jp < 67) zq[k] = *(const u32x4*)(zT + (size_t)b * L + J * 64 + ch * 8); }
#pragma unroll
          for (int k = 0; k < 9; ++k) { const int q = tq + k * NTHREADS; const int ch = q & 7, Jp = (q >> 3) % 70, b = (q >> 3) / 70;
            if (q < 4480) *(LAS u32x4*)(Zs + b * ZB + Jp * 128 + ch * 16) = zq[k]; } }
        __syncthreads();
        int d_hi = 16 * wave + 15 - 64 * h, d_lo = 16 * wave - 64 * h - 63; d_hi = d_hi > 127 ? 127 : d_hi; d_lo = d_lo < -127 ? -127 : d_lo;
        int mlo = 16 * wave - 64 * h - 51, mhi = 16 * wave - 64 * h + 3; mlo = mlo < d_lo ? d_lo : mlo; mhi = mhi > d_hi ? d_hi : mhi; if (mlo > mhi) { mlo = d_hi + 1; mhi = d_hi; }
        const int abase = 8192 + 8 * hh - r - (r & 1) - 32;
        const LAS unsigned char* arow = lds + (r & 1) * 32768 + abase * 2;
        const LAS unsigned char* brow = Zs + (r & 7) * ZB + ((r >> 3) + 16 * wave - 64 * h + 3) * 128 + hh * 16;
#pragma unroll 1
        for (int part = 0; part < 2; ++part) {
            const int ga = part ? mhi + 1 : d_lo, gb = part ? d_hi : mlo - 1;
#pragma unroll 1
            for (int d = ga; d <= gb; ++d) {
                const int J0b = 16 * wave - d;
                const LAS unsigned* ap = (const LAS unsigned*)(arow - 128 * d);
                bf16x8 Af[2][4];
#pragma unroll
                for (int mt = 0; mt < 2; ++mt)
#pragma unroll
                    for (int ks = 0; ks < 4; ++ks) { const LAS unsigned* q = ap + (16 * ks + 32 * (1 - mt)) / 2; const u32x4 t = (u32x4){q[0], q[1], q[2], q[3]}; Af[mt][ks] = __builtin_bit_cast(bf16x8, t); }
                const LAS unsigned char* bp = brow - 128 * d;
#pragma unroll
                for (int i = 0; i < 4; ++i) { const int J0 = J0b + 4 * i;
                    if (J0 + 3 >= 64 * h && J0 <= 64 * h + 63) {
                        bf16x8 Bf[4];
#pragma unroll
                        for (int ks = 0; ks < 4; ++ks) Bf[ks] = *(const LAS bf16x8*)(bp + i * 512 + ks * 32);
#pragma unroll
                        for (int ks = 0; ks < 4; ++ks)
#pragma unroll
                            for (int mt = 0; mt < 2; ++mt) acc[mt][i] = __builtin_amdgcn_mfma_f32_32x32x16_bf16(Af[mt][ks], Bf[ks], acc[mt][i], 0, 0, 0);
                    } }
            }
            if (part == 0 && mlo <= mhi) {
#define HC_LDA(dst, p_, k_) do { const LAS unsigned* q_ = (const LAS unsigned*)(p_) + 8 * (k_); const u32x4 t_ = (u32x4){q_[0], q_[1], q_[2], q_[3]}; dst = __builtin_bit_cast(bf16x8, t_); } while (0)
#define HC_LDB(dst, p_, i_) do { _Pragma("unroll") for (int ks = 0; ks < 4; ++ks) dst[ks] = *(const LAS bf16x8*)((p_) + (i_) * 512 + ks * 32); } while (0)
#define HC_MMA(i_, Bx) do { _Pragma("unroll") for (int ks = 0; ks < 4; ++ks) { acc[1][i_] = __builtin_amdgcn_mfma_f32_32x32x16_bf16(F[ks], Bx[ks], acc[1][i_], 0, 0, 0); \
                                acc[0][i_] = __builtin_amdgcn_mfma_f32_32x32x16_bf16(F[ks + 2], Bx[ks], acc[0][i_], 0, 0, 0); } } while (0)
                bf16x8 F[6], B0[4], B1[4];
                { const LAS unsigned char* ap = arow - 128 * mlo;
#pragma unroll
                  for (int k = 0; k < 6; ++k) HC_LDA(F[k], ap, k); }
#pragma unroll 1
                for (int d = mlo; d <= mhi; ++d) {
                    const LAS unsigned char* bp = brow - 128 * d;
                    HC_LDB(B0, bp, 0);
                    HC_LDB(B1, bp, 1); __builtin_amdgcn_sched_barrier(0); HC_MMA(0, B0); __builtin_amdgcn_sched_barrier(0);
                    HC_LDB(B0, bp, 2); __builtin_amdgcn_sched_barrier(0); HC_MMA(1, B1); __builtin_amdgcn_sched_barrier(0);
                    HC_LDB(B1, bp, 3); __builtin_amdgcn_sched_barrier(0); HC_MMA(2, B0); __builtin_amdgcn_sched_barrier(0);
                    bf16x8 Fn[4];
                    { const LAS unsigned char* apn = arow - 128 * (d + 1);
#pragma unroll
                      for (int k = 0; k < 4; ++k) HC_LDA(Fn[k], apn, k); }
                    __builtin_amdgcn_sched_barrier(0); HC_MMA(3, B1); __builtin_amdgcn_sched_barrier(0);
                    F[4] = F[0]; F[5] = F[1]; F[0] = Fn[0]; F[1] = Fn[1]; F[2] = Fn[2]; F[3] = Fn[3];
                }
#undef HC_LDA
#undef HC_LDB
#undef HC_MMA
            }
        }
    }
    float tot = 0.f;
#pragma unroll
    for (int w = 0; w < 8; ++w) tot += red[w];
    const float scale = 1.0f / sqrtf(tot + 1e-6f);
#pragma unroll
    for (int mt = 0; mt < 2; ++mt)
#pragma unroll
        for (int i = 0; i < 4; ++i)
#pragma unroll
            for (int g = 0; g < 4; ++g) { const int t = 64 * (16 * wave + 4 * i + (r >> 3)) + 32 * mt + 8 * g + 4 * hh;
                const f32x4 v = (f32x4){acc[mt][i][4 * g] * scale, acc[mt][i][4 * g + 1] * scale, acc[mt][i][4 * g + 2] * scale, acc[mt][i][4 * g + 3] * scale};
                *(f32x4*)(yT + (size_t)(r & 7) * L + t) = v; }
    __syncthreads();
}

__device__ __forceinline__ void hy_post_unit(const Params& p, LAS unsigned char* lds, int l, int unit, const int wvx) {
    const int tid = opaque_tid(wvx);
    const int ct = unit & 3, tt = (unit >> 2) & 127, b = unit >> 9;
    const bf16_t* proj = (const bf16_t*)(p.ws + OFF_PROJ);
    const bf16_t* zT = (const bf16_t*)(p.ws + OFF_ZT);
    const float* yT = (const float*)(p.ws + OFF_YT);
    bf16_t* mix = (bf16_t*)(p.ws + OFF_MIX);
    const float* cw = p.in[3] + l * 3 * 768; const float* cb = p.in[4] + l * 768; const float* skip = p.in[13] + l * 256;
    LAS float* tile = (LAS float*)lds;
    {
        const int cl = tid >> 3, seg = tid & 7, c = ct * 64 + cl;
        const size_t off = ((size_t)c * NB + b) * L + tt * 64 + seg * 8;
        float z[8]; unpack8(*(const u32x4*)(zT + off), z);
        const f32x4 y0 = *(const f32x4*)(yT + off), y1 = *(const f32x4*)(yT + off + 4);
        const float sk = skip[c];
        tile[cl * 65 + seg * 8 + 0] = y0.x + z[0] * sk; tile[cl * 65 + seg * 8 + 1] = y0.y + z[1] * sk; tile[cl * 65 + seg * 8 + 2] = y0.z + z[2] * sk; tile[cl * 65 + seg * 8 + 3] = y0.w + z[3] * sk;
        tile[cl * 65 + seg * 8 + 4] = y1.x + z[4] * sk; tile[cl * 65 + seg * 8 + 5] = y1.y + z[5] * sk; tile[cl * 65 + seg * 8 + 6] = y1.z + z[6] * sk; tile[cl * 65 + seg * 8 + 7] = y1.w + z[7] * sk;
    }
    __syncthreads();
    {
        const int tl = tid >> 3, c8 = (tid & 7) * 8, t = tt * 64 + tl, c = ct * 64 + c8;
        const bf16_t* row = proj + ((size_t)b * L + t) * IN_DP;
        float x0[3][8];
        load8(row - IN_DP + C_HX0 + c, t > 0, x0[0]); load8(row + C_HX0 + c, true, x0[1]); load8(row + IN_DP + C_HX0 + c, t < L - 1, x0[2]);
        float o[8];
#pragma unroll
        for (int j = 0; j < 8; ++j) { const int c0 = c + j; const float a = x0[0][j] * cw[c0] + x0[1][j] * cw[768 + c0] + x0[2][j] * cw[1536 + c0] + cb[c0];
            o[j] = a * tile[(c8 + j) * 65 + tl]; }
        u32x4 w; w.x = pk2(o[0], o[1]); w.y = pk2(o[2], o[3]); w.z = pk2(o[4], o[5]); w.w = pk2(o[6], o[7]);
        *(u32x4*)(mix + ((size_t)b * L + t) * D + c) = w;
    }
    __syncthreads();
}


__device__ __forceinline__ void hy_pre_unit4(const Params& p, LAS unsigned char* lds, int l, int unit, const int wvx) {
    const int tid = opaque_tid(wvx);
    const int tt = unit & 127, b = unit >> 7;
    const bf16_t* proj = (const bf16_t*)(p.ws + OFF_PROJ);
    bf16_t* zT = (bf16_t*)(p.ws + OFF_ZT);
    const float* cw = p.in[3] + l * 3 * 768; const float* cb = p.in[4] + l * 768;
    LAS bf16_t* tile = (LAS bf16_t*)lds;
    const int tl = tid >> 3, c8 = (tid & 7) * 8, t = tt * 64 + tl;
    const bf16_t* row = proj + ((size_t)b * L + t) * IN_DP;
    const bool hp = t > 0, hn = t < L - 1;
    u32x4 rx[4][3], rv[4][3];
#pragma unroll
    for (int ct = 0; ct < 4; ++ct) { const int c = ct * 64 + c8;
        rx[ct][0] = *(const u32x4*)(row + (hp ? -IN_DP : 0) + C_HX1 + c); rx[ct][1] = *(const u32x4*)(row + C_HX1 + c); rx[ct][2] = *(const u32x4*)(row + (hn ? IN_DP : 0) + C_HX1 + c);
        rv[ct][0] = *(const u32x4*)(row + (hp ? -IN_DP : 0) + C_HV + c); rv[ct][1] = *(const u32x4*)(row + C_HV + c); rv[ct][2] = *(const u32x4*)(row + (hn ? IN_DP : 0) + C_HV + c); }
    const float mp = hp ? 1.f : 0.f, mn = hn ? 1.f : 0.f;
#pragma unroll
    for (int ct = 0; ct < 4; ++ct) { const int c = ct * 64 + c8;
        float x1[3][8], vv[3][8]; unpack8(rx[ct][0], x1[0]); unpack8(rx[ct][1], x1[1]); unpack8(rx[ct][2], x1[2]); unpack8(rv[ct][0], vv[0]); unpack8(rv[ct][1], vv[1]); unpack8(rv[ct][2], vv[2]);
        float wa[3][8], wb[3][8], ba[8], bb[8];
#pragma unroll
        for (int k = 0; k < 3; ++k) { const f32x4 a0 = *(const f32x4*)(cw + k * 768 + C_HX1 + c), a1 = *(const f32x4*)(cw + k * 768 + C_HX1 + c + 4), b0 = *(const f32x4*)(cw + k * 768 + C_HV + c), b1 = *(const f32x4*)(cw + k * 768 + C_HV + c + 4);
            wa[k][0] = a0.x; wa[k][1] = a0.y; wa[k][2] = a0.z; wa[k][3] = a0.w; wa[k][4] = a1.x; wa[k][5] = a1.y; wa[k][6] = a1.z; wa[k][7] = a1.w;
            wb[k][0] = b0.x; wb[k][1] = b0.y; wb[k][2] = b0.z; wb[k][3] = b0.w; wb[k][4] = b1.x; wb[k][5] = b1.y; wb[k][6] = b1.z; wb[k][7] = b1.w; }
        { const f32x4 a0 = *(const f32x4*)(cb + C_HX1 + c), a1 = *(const f32x4*)(cb + C_HX1 + c + 4), b0 = *(const f32x4*)(cb + C_HV + c), b1 = *(const f32x4*)(cb + C_HV + c + 4);
            ba[0] = a0.x; ba[1] = a0.y; ba[2] = a0.z; ba[3] = a0.w; ba[4] = a1.x; ba[5] = a1.y; ba[6] = a1.z; ba[7] = a1.w; bb[0] = b0.x; bb[1] = b0.y; bb[2] = b0.z; bb[3] = b0.w; bb[4] = b1.x; bb[5] = b1.y; bb[6] = b1.z; bb[7] = b1.w; }
#pragma unroll
        for (int j = 0; j < 8; ++j) {
            const float a = mp * x1[0][j] * wa[0][j] + x1[1][j] * wa[1][j] + mn * x1[2][j] * wa[2][j] + ba[j];
            const float v = mp * vv[0][j] * wb[0][j] + vv[1][j] * wb[1][j] + mn * vv[2][j] * wb[2][j] + bb[j];
            tile[(c + j) * 72 + tl] = (bf16_t)f2bf(a * v); } }
    __syncthreads();
#pragma unroll
    for (int ct = 0; ct < 4; ++ct) { const int cl = ct * 64 + (tid >> 3), seg = tid & 7;
        const u32x4 w = *(const LAS u32x4*)(tile + cl * 72 + seg * 8);
        *(u32x4*)(zT + ((size_t)cl * NB + b) * L + tt * 64 + seg * 8) = w; }
    __syncthreads();
}
__device__ __forceinline__ void hy_post_unit4(const Params& p, LAS unsigned char* lds, int l, int unit, const int wvx) {
    const int tid = opaque_tid(wvx);
    const int tt = unit & 127, b = unit >> 7;
    const bf16_t* proj = (const bf16_t*)(p.ws + OFF_PROJ);
    const bf16_t* zT = (const bf16_t*)(p.ws + OFF_ZT);
    const float* yT = (const float*)(p.ws + OFF_YT);
    bf16_t* mix = (bf16_t*)(p.ws + OFF_MIX);
    const float* cw = p.in[3] + l * 3 * 768; const float* cb = p.in[4] + l * 768; const float* skip = p.in[13] + l * 256;
    LAS float* tile = (LAS float*)lds;
    {
        u32x4 zq[4]; f32x4 y0q[4], y1q[4]; float skq[4];
#pragma unroll
        for (int ct = 0; ct < 4; ++ct) { const int c = ct * 64 + (tid >> 3), seg = tid & 7; const size_t off = ((size_t)c * NB + b) * L + tt * 64 + seg * 8;
            zq[ct] = *(const u32x4*)(zT + off); y0q[ct] = *(const f32x4*)(yT + off); y1q[ct] = *(const f32x4*)(yT + off + 4); skq[ct] = skip[c]; }
#pragma unroll
        for (int ct = 0; ct < 4; ++ct) { const int cl = ct * 64 + (tid >> 3), seg = tid & 7; float z[8]; unpack8(zq[ct], z); const float sk = skq[ct]; LAS float* tp = tile + cl * 65 + seg * 8;
            tp[0] = y0q[ct].x + z[0] * sk; tp[1] = y0q[ct].y + z[1] * sk; tp[2] = y0q[ct].z + z[2] * sk; tp[3] = y0q[ct].w + z[3] * sk;
            tp[4] = y1q[ct].x + z[4] * sk; tp[5] = y1q[ct].y + z[5] * sk; tp[6] = y1q[ct].z + z[6] * sk; tp[7] = y1q[ct].w + z[7] * sk; }
    }
    __syncthreads();
    {
        const int tl = tid >> 3, c8 = (tid & 7) * 8, t = tt * 64 + tl;
        const bf16_t* row = proj + ((size_t)b * L + t) * IN_DP;
        const bool hp = t > 0, hn = t < L - 1; const float mp = hp ? 1.f : 0.f, mn = hn ? 1.f : 0.f;
        u32x4 r0[4], r1[4], r2[4];
#pragma unroll
        for (int ct = 0; ct < 4; ++ct) { const int c = ct * 64 + c8; r0[ct] = *(const u32x4*)(row + (hp ? -IN_DP : 0) + C_HX0 + c); r1[ct] = *(const u32x4*)(row + C_HX0 + c); r2[ct] = *(const u32x4*)(row + (hn ? IN_DP : 0) + C_HX0 + c); }
#pragma unroll
        for (int ct = 0; ct < 4; ++ct) { const int c = ct * 64 + c8;
            float x0[3][8]; unpack8(r0[ct], x0[0]); unpack8(r1[ct], x0[1]); unpack8(r2[ct], x0[2]);
            float o[8];
#pragma unroll
            for (int j = 0; j < 8; ++j) { const int c0 = c + j; const float a = mp * x0[0][j] * cw[c0] + x0[1][j] * cw[768 + c0] + mn * x0[2][j] * cw[1536 + c0] + cb[c0];
                o[j] = a * tile[(c + j) * 65 + tl]; }
            u32x4 w; w.x = pk2(o[0], o[1]); w.y = pk2(o[2], o[3]); w.z = pk2(o[4], o[5]); w.w = pk2(o[6], o[7]);
            *(u32x4*)(mix + ((size_t)b * L + t) * D + c) = w; }
    }
    __syncthreads();
}


__device__ __forceinline__ void wg_signal(int* ctr, const bool leader) {
    asm volatile("s_waitcnt vmcnt(0)" ::: "memory");
    __syncthreads();
    if (leader) { __builtin_amdgcn_fence(__ATOMIC_RELEASE, "agent"); asm volatile("s_waitcnt vmcnt(0)" ::: "memory"); __hip_atomic_fetch_add(ctr, 1, __ATOMIC_RELAXED, __HIP_MEMORY_SCOPE_AGENT); }
}
__device__ __forceinline__ void wg_wait(int* ctr, int target, const bool leader) {
    if (leader) { unsigned sp = 0;
        while (__hip_atomic_load(ctr, __ATOMIC_RELAXED, __HIP_MEMORY_SCOPE_AGENT) < target) { __builtin_amdgcn_s_sleep(2); if (++sp > (1u << 24)) break; }
        __builtin_amdgcn_fence(__ATOMIC_ACQUIRE, "agent"); asm volatile("s_waitcnt vmcnt(0)" ::: "memory"); }
    __syncthreads();
}
__device__ __forceinline__ int wg_pop(int* ctr, LAS int* qw, const bool leader) {
    __syncthreads();
    if (leader) *qw = __hip_atomic_fetch_add(ctr, 1, __ATOMIC_RELAXED, __HIP_MEMORY_SCOPE_AGENT);
    __syncthreads();
    return __builtin_amdgcn_readfirstlane(*qw);
}
__device__ __forceinline__ void rw_prep_unit(const Params& p, int l, int unit, const int wvx) {
    const int tid = opaque_tid(wvx), cg = tid & 63, rg = tid >> 6;
    const int lev = unit >> 4, b = unit & 7; const int c = (unit & 8) ? 127 - lev : lev;
    const int t0 = c * 64 + rg * 8, col = cg * 8;
    const bf16_t* proj = (const bf16_t*)(p.ws + OFF_PROJ);
    bf16_t* PR = (bf16_t*)p.out;
    u32x4 raw[3][10];
#pragma unroll
    for (int w = 0; w < 3; ++w)
#pragma unroll
        for (int i = 0; i < 10; ++i) { const int t = t0 - 1 + i; const int tc = t < 0 ? 0 : (t > L - 1 ? L - 1 : t);
            raw[w][i] = *(const u32x4*)(proj + ((size_t)b * L + tc) * IN_DP + C_RR + w * 512 + col); }
    { const u32x4 z = (u32x4){0u, 0u, 0u, 0u};
      if (t0 == 0) { raw[0][0] = z; raw[1][0] = z; raw[2][0] = z; }
      if (t0 + 8 == L) { raw[0][9] = z; raw[1][9] = z; raw[2][9] = z; } }
    const float* mu = p.in[14] + (size_t)l * 3 * 2 * 512;
#pragma unroll
    for (int w = 0; w < 3; ++w) {
        float m0[8], m1[8], kk_[8];
        { const f32x4 a = *(const f32x4*)(mu + w * 1024 + col), b2 = *(const f32x4*)(mu + w * 1024 + col + 4), c = *(const f32x4*)(mu + w * 1024 + 512 + col), d = *(const f32x4*)(mu + w * 1024 + 512 + col + 4);
          m0[0] = a.x; m0[1] = a.y; m0[2] = a.z; m0[3] = a.w; m0[4] = b2.x; m0[5] = b2.y; m0[6] = b2.z; m0[7] = b2.w;
          m1[0] = c.x; m1[1] = c.y; m1[2] = c.z; m1[3] = c.w; m1[4] = d.x; m1[5] = d.y; m1[6] = d.z; m1[7] = d.w; }
        if (w == 1) { const f32x4 a = *(const f32x4*)(p.in[19] + l * 512 + col), b2 = *(const f32x4*)(p.in[19] + l * 512 + col + 4);
          kk_[0] = a.x; kk_[1] = a.y; kk_[2] = a.z; kk_[3] = a.w; kk_[4] = b2.x; kk_[5] = b2.y; kk_[6] = b2.z; kk_[7] = b2.w; }
#pragma unroll
        for (int j = 0; j < 8; ++j) {
            float xp[8], xc[8], xn[8], y[8];
            unpack8(raw[w][j], xp); unpack8(raw[w][j + 1], xc); unpack8(raw[w][j + 2], xn);
#pragma unroll
            for (int e = 0; e < 8; ++e) y[e] = xc[e] + m0[e] * (xp[e] - xc[e]) + m1[e] * (xn[e] - xc[e]);
            const size_t ro = ((size_t)b * L + t0 + j) * 512 + col;
            *(u32x4*)(PR + (size_t)w * NT * 512 + ro) = (u32x4){pk2(y[0], y[1]), pk2(y[2], y[3]), pk2(y[4], y[5]), pk2(y[6], y[7])};
            if (w == 1) { float kr[8], ss = 0.f;
#pragma unroll
                for (int e = 0; e < 8; ++e) { kr[e] = y[e] * kk_[e]; ss += kr[e] * kr[e]; }
                ss = sum8(ss);
                const float rn_ = __builtin_amdgcn_rsqf(fmaxf(ss, 1e-24f));
                *(u32x4*)(PR + (size_t)3 * NT * 512 + ro) = (u32x4){pk2(kr[0] * rn_, kr[1] * rn_), pk2(kr[2] * rn_, kr[3] * rn_), pk2(kr[4] * rn_, kr[5] * rn_), pk2(kr[6] * rn_, kr[7] * rn_)}; }
        }
    }
}

namespace rw {
constexpr int MATB = 9216, PITCH = 144;
constexpr int O_W2T = 0, O_A2T = MATB, O_SB = 2 * MATB, O_GBUF = 3 * MATB, O_SLOT = O_GBUF + 16384;
constexpr int O_GC = O_SLOT + 12 * MATB, O_TPP = O_GC + 512, O_CT = O_TPP + 2560;
__device__ __forceinline__ constexpr int slot(int k) { return O_SLOT + k * MATB; }
#define MFMA16(a, b, c) __builtin_amdgcn_mfma_f32_16x16x32_bf16((a), (b), (c), 0, 0, 0)
__device__ __forceinline__ f32x4 tile64(const LAS unsigned char* A, const LAS unsigned char* Bt, int rt, int ct, int fr, int fq, f32x4 acc) {
#pragma unroll
    for (int ks = 0; ks < 2; ++ks) { const bf16x8 a = *(const LAS bf16x8*)(A + (16 * rt + fr) * PITCH + ks * 64 + fq * 16); const bf16x8 b = *(const LAS bf16x8*)(Bt + (16 * ct + fr) * PITCH + ks * 64 + fq * 16);
        acc = MFMA16(a, b, acc); }
    return acc;
}
__device__ __forceinline__ unsigned pkbf(float lo, float hi) { return pg8::cvt_pk_bf16(lo, hi); }
}

namespace rw {
typedef short s16x4 __attribute__((ext_vector_type(4)));
__device__ __forceinline__ bf16x8 fragN(const LAS unsigned char* img, int row, int ks, int fq) { return *(const LAS bf16x8*)(img + row * PITCH + ks * 64 + fq * 16); }
__device__ __forceinline__ bf16x8 fragP(const LAS unsigned char* img, int row, int ks, int fq) {
    const u32x2 a = *(const LAS u32x2*)(img + row * PITCH + (32 * ks + 4 * fq) * 2), b = *(const LAS u32x2*)(img + row * PITCH + (32 * ks + 16 + 4 * fq) * 2);
    const u32x4 v = (u32x4){a.x, a.y, b.x, b.y}; return __builtin_bit_cast(bf16x8, v); }
__device__ __forceinline__ bf16x8 fragT(const LAS unsigned char* img, int c0, int ks, int fr, int fq) {
    const LAS unsigned char* q = img + (32 * ks + 4 * fq + (fr >> 2)) * PITCH + (c0 + 4 * (fr & 3)) * 2;
    const s16x4 a = __builtin_amdgcn_ds_read_tr16_b64_v4i16((LAS s16x4*)q), b = __builtin_amdgcn_ds_read_tr16_b64_v4i16((LAS s16x4*)(q + 16 * PITCH));
    return (bf16x8){a[0], a[1], a[2], a[3], b[0], b[1], b[2], b[3]}; }
}

__device__ __forceinline__ void rw_chain_unit(const Params& p, LAS unsigned char* lds, int l, int unit, const int wvx) {
    using namespace rw;
    const int tid = opaque_tid(wvx), wave = __builtin_amdgcn_readfirstlane(tid >> 6);
    const int dir = unit & 1, h = (unit >> 1) & 7, b = unit >> 4;
    const bf16_t* proj = (const bf16_t*)(p.ws + OFF_PROJ);
    unsigned short* Y = (unsigned short*)(p.ws + (dir ? OFF_YB : OFF_YF));
    LAS float* gbuf = (LAS float*)(lds + O_GBUF);
    LAS float* GC = (LAS float*)(lds + O_GC);
    LAS bf16_t* TPP = (LAS bf16_t*)(lds + O_TPP);
    LAS float* CT = (LAS float*)(lds + O_CT);
    float* BON = (float*)(p.ws + OFF_BON) + (size_t)dir * NT * 8;
    const bf16_t* PR = (const bf16_t*)p.out;
    int* prep_ctr = (int*)(p.ws + OFF_CTL) + 32 + l * 16 + 8;
    __syncthreads();
    {
        const float* w2 = p.in[16] + ((size_t)l * 2 + dir) * 64 * 512 + h * 64; const float* a2 = p.in[18] + ((size_t)l * 2 + dir) * 64 * 512 + h * 64;
        for (int i = tid; i < 4096; i += NTHREADS) { const int r = i >> 6, n = i & 63;
            *(LAS bf16_t*)(lds + O_W2T + n * PITCH + r * 2) = (bf16_t)f2bf(w2[r * 512 + n]); *(LAS bf16_t*)(lds + O_A2T + n * PITCH + r * 2) = (bf16_t)f2bf(a2[r * 512 + n]); }
        for (int i = tid; i < MATB / 4; i += NTHREADS) ((LAS unsigned*)(lds + O_SB))[i] = 0u;
        for (int i = tid; i < 704; i += NTHREADS) { const int row = i >> 6, n = i & 63, col = h * 64 + n; float v;
            if (row < 6) v = 0.f;
            else if (row == 6) v = p.in[15][((size_t)l * 2 + dir) * 512 + col];
            else if (row == 7) v = p.in[17][((size_t)l * 2 + dir) * 512 + col];
            else if (row == 8) v = p.in[19][l * 512 + col];
            else if (row == 9) v = p.in[20][l * 512 + col];
            else v = p.in[21][l * 512 + col];
            CT[i] = v; }
    }
    const int rt = wave >> 1, chh = wave & 1;
    u32x4 pre[16];
    f32x4 acc_[16];
#define F4(x) __builtin_bit_cast(f32x4, (x))
#define U4(x) __builtin_bit_cast(u32x4, (x))
#define issue_rkv(CC, HALF) do { const int t0n_ = (dir ? (L / 64 - 1 - (CC)) : (CC)) * 64; int tq_ = tid; asm volatile("" : "+v"(tq_));     \
        const int ppn = ((tq_ & 255) >> 3) + 32 * (HALF); const int ttn = dir ? (t0n_ + 63 - ppn) : (t0n_ + ppn); const bf16_t* row = PR + ((size_t)b * L + ttn) * 512 + h * 64 + (tq_ & 7) * 8; \
        _Pragma("unroll") for (int k = 0; k < 4; ++k) pre[4 * (HALF) + k] = *(const u32x4*)(row + (size_t)k * NT * 512); } while (0)
#define issue_lora(CC) do { const int t0n_ = (dir ? (L / 64 - 1 - (CC)) : (CC)) * 64; int tq_ = tid; asm volatile("" : "+v"(tq_)); \
        { const int kq_ = ((tq_ >> 4) & 3) * 8, cbase = (wave == 7 ? C_RA : C_RW) + dir * 64; \
          _Pragma("unroll") for (int r4 = 0; r4 < 4; ++r4) { const int pq_ = 16 * r4 + (tq_ & 15); const int ttn = dir ? (t0n_ + 63 - pq_) : (t0n_ + pq_); const bf16_t* row = proj + ((size_t)b * L + ttn) * IN_DP; \
            pre[8 + 2 * r4] = *(const u32x4*)(row + cbase + kq_); pre[9 + 2 * r4] = *(const u32x4*)(row + cbase + 32 + kq_); } } } while (0)
    wg_wait(prep_ctr, 128, tid == 0);
    issue_lora(0); issue_rkv(0, 0); issue_rkv(0, 1);
#pragma unroll
    for (int q = 0; q < 16; ++q) acc_[q] = (f32x4){0.f, 0.f, 0.f, 0.f};
#pragma unroll 1
    for (int cc = -1; cc < L / 64; ++cc) {
        const bool cons = cc >= 0, prod = cc + 1 < L / 64;
        const int cn = cc + 1;
        const int cx = cn + 1 < L / 64 ? cn + 1 : L / 64 - 1;
        const int t0 = (dir ? (L / 64 - 1 - cc) : cc) * 64, t0n = (dir ? (L / 64 - 1 - cn) : cn) * 64;
        int tq = tid; asm volatile("" : "+v"(tq));
        const int fr = tq & 15, fq = (tq >> 4) & 3;
        const int bbn = (cn & 1) ? slot(9) : slot(7), bbc = (cc & 1) ? slot(9) : slot(7);
        if (cc + 2 < 64 && ((cc + 2) & 7) == 0) wg_wait(prep_ctr + ((cc + 2) >> 3), 128, tid == 0);
        __syncthreads();
        if (wave < 4) {
            if (cons) {
#pragma unroll
                for (int q = 0; q < 12; ++q) acc_[q] = (f32x4){0.f, 0.f, 0.f, 0.f};
                const bf16x8 s0 = fragN(lds + O_SB, 16 * wave + fr, 0, fq), s1 = fragN(lds + O_SB, 16 * wave + fr, 1, fq), v0 = fragT(lds + slot(6), 16 * wave, 0, fr, fq), v1 = fragT(lds + slot(6), 16 * wave, 1, fr, fq);
#pragma unroll
                for (int q = 0; q < 4; ++q) { f32x4 a = acc_[q];
                    a = MFMA16(fragN(lds + slot(3), 16 * q + fr, 0, fq), s0, a); a = MFMA16(fragN(lds + slot(3), 16 * q + fr, 1, fq), s1, a);
                    a = MFMA16(fragT(lds + slot(0), 16 * q, 0, fr, fq), v0, a); if (q >= 2) a = MFMA16(fragT(lds + slot(0), 16 * q, 1, fr, fq), v1, a);
                    acc_[q] = a;
                    f32x4 kx = acc_[4 + q]; kx = MFMA16(fragT(lds + slot(8), 16 * q, 0, fr, fq), v0, kx); kx = MFMA16(fragT(lds + slot(8), 16 * q, 1, fr, fq), v1, kx); acc_[4 + q] = kx;
                    f32x4 y = acc_[8 + q];
                    y = MFMA16(fragN(lds + slot(4), 16 * q + fr, 0, fq), s0, y); y = MFMA16(fragN(lds + slot(4), 16 * q + fr, 1, fq), s1, y);
                    y = MFMA16(fragT(lds + slot(2), 16 * q, 0, fr, fq), v0, y); if (q >= 2) y = MFMA16(fragT(lds + slot(2), 16 * q, 1, fr, fq), v1, y);
                    acc_[8 + q] = y;
                    asm volatile("" ::: "memory"); }
            }
        } else if (wave == 4) {
            if (cons) {
                const int pb = fq, j = fr; float T[16];
#pragma unroll
                for (int q = 0; q < 16; ++q) T[q] = (q == j) ? 1.f : 0.f;
#pragma unroll
                for (int sg = 0; sg < 4; ++sg) {
                    u32x4 ar[4][2];
#pragma unroll
                    for (int r4 = 0; r4 < 4; ++r4) { ar[r4][0] = *(const LAS u32x4*)(lds + slot(11) + (16 * pb + 4 * sg + r4) * PITCH + 32 * pb); ar[r4][1] = *(const LAS u32x4*)(lds + slot(11) + (16 * pb + 4 * sg + r4) * PITCH + 32 * pb + 16); }
#pragma unroll
                    for (int r4 = 0; r4 < 4; ++r4) { const int s2 = 4 * sg + r4; float av[16]; unpack8(ar[r4][0], av); unpack8(ar[r4][1], av + 8);
#pragma unroll
                        for (int q = s2 + 1; q < 16; ++q) T[q] += av[q] * T[s2]; }
                    asm volatile("" ::: "memory");
                }
#pragma unroll
                for (int q = 0; q < 16; ++q) TPP[(pb * 16 + q) * 20 + j] = (bf16_t)f2bf(T[q]);
            }
        } else if (wave <= 6) {
            if (prod) {
#pragma unroll
                for (int gi = 0; gi < 2; ++gi) { const int cgp = 2 * (wave - 5) + gi;
                    const float w0n = CT[6 * 64 + 16 * cgp + fr];
                    const bf16x8 wb0 = fragN(lds + O_W2T, 16 * cgp + fr, 0, fq), wb1 = fragN(lds + O_W2T, 16 * cgp + fr, 1, fq);
                    u32x2 lwp[4];
#pragma unroll
                    for (int r4 = 0; r4 < 4; ++r4) {
                        f32x4 wv = (f32x4){0.f, 0.f, 0.f, 0.f}; wv = MFMA16(__builtin_bit_cast(bf16x8, pre[8 + 2 * r4]), wb0, wv); wv = MFMA16(__builtin_bit_cast(bf16x8, pre[9 + 2 * r4]), wb1, wv);
                        float lwv[4];
#pragma unroll
                        for (int e = 0; e < 4; ++e) lwv[e] = -0.60653066f * frcp(1.0f + __expf(-(wv[e] + w0n)));
                        lwp[r4] = (u32x2){pk2(lwv[0], lwv[1]), pk2(lwv[2], lwv[3])}; }
#pragma unroll
                    for (int r4 = 0; r4 < 4; ++r4) { f32x4 g = (f32x4){0.f, 0.f, 0.f, 0.f};
#pragma unroll
                        for (int ks = 0; ks < 2; ++ks) if (32 * ks <= 16 * r4 + 15) {
                            const int pa = 16 * r4 + fr - 32 * ks - 4 * fq, pb2 = pa - 16;
                            u32x4 lt; unsigned one2 = 0x3F803F80u; asm volatile("" : "+s"(one2));
                            lt.x = (pa >= 1 ? one2 : (pa == 0 ? 0x00003F80u : 0u)); lt.y = (pa >= 3 ? one2 : (pa == 2 ? 0x00003F80u : 0u));
                            lt.z = (pb2 >= 1 ? one2 : (pb2 == 0 ? 0x00003F80u : 0u)); lt.w = (pb2 >= 3 ? one2 : (pb2 == 2 ? 0x00003F80u : 0u));
                            const u32x4 bv = (u32x4){lwp[2 * ks].x, lwp[2 * ks].y, lwp[2 * ks + 1].x, lwp[2 * ks + 1].y};
                            g = MFMA16(__builtin_bit_cast(bf16x8, lt), __builtin_bit_cast(bf16x8, bv), g); }
#pragma unroll
                        for (int e = 0; e < 4; ++e) gbuf[(16 * r4 + 4 * fq + e) * 64 + 16 * cgp + fr] = g[e]; }
                    asm volatile("" ::: "memory"); }
            }
        } else {
            if (prod) {
#pragma unroll
                for (int cgp = 0; cgp < 4; ++cgp) {
                    const bf16x8 ab0 = fragN(lds + O_A2T, 16 * cgp + fr, 0, fq), ab1 = fragN(lds + O_A2T, 16 * cgp + fr, 1, fq);
#pragma unroll
                    for (int r4 = 0; r4 < 4; ++r4) { f32x4 av = (f32x4){0.f, 0.f, 0.f, 0.f};
                        av = MFMA16(__builtin_bit_cast(bf16x8, pre[8 + 2 * r4]), ab0, av); av = MFMA16(__builtin_bit_cast(bf16x8, pre[9 + 2 * r4]), ab1, av);
#pragma unroll
                        for (int e = 0; e < 4; ++e) *(LAS bf16_t*)(lds + slot(5) + (16 * r4 + 4 * fq + e) * PITCH + (16 * cgp + fr) * 2) = (bf16_t)f2bf(av[e]); }
                    asm volatile("" ::: "memory"); }
            }
        }
        __builtin_amdgcn_sched_barrier(0);
        issue_lora(cx);
        __syncthreads();
#define LD2(dst, ptr) do { const f32x4 _a = *(const LAS f32x4*)(ptr), _b = *(const LAS f32x4*)((ptr) + 4); dst[0] = (f32x2){_a.x, _a.y}; dst[1] = (f32x2){_a.z, _a.w}; dst[2] = (f32x2){_b.x, _b.y}; dst[3] = (f32x2){_b.z, _b.w}; } while (0)
#define UP2(dst, wsrc_) do { const u32x4 _w = (wsrc_); dst[0] = (f32x2){bf2f(_w.x & 0xffffu), __uint_as_float(_w.x & 0xffff0000u)}; dst[1] = (f32x2){bf2f(_w.y & 0xffffu), __uint_as_float(_w.y & 0xffff0000u)}; \
                         dst[2] = (f32x2){bf2f(_w.z & 0xffffu), __uint_as_float(_w.z & 0xffff0000u)}; dst[3] = (f32x2){bf2f(_w.w & 0xffffu), __uint_as_float(_w.w & 0xffff0000u)}; } while (0)
#define PK4(v) ((u32x4){pk2(v[0].x, v[0].y), pk2(v[1].x, v[1].y), pk2(v[2].x, v[2].y), pk2(v[3].x, v[3].y)})
#define S2_ITEM(HALF) do { \
            const int pp = ((tq & 255) >> 3) + 32 * (HALF), ig = tq & 7, i0 = ig * 8; \
            const int tt = dir ? (t0n + 63 - pp) : (t0n + pp);            \
            f32x2 r2[4], k2[4], a2v[4], kd2[4], kkr2[4], gi2[4], ge2[4]; \
            LD2(gi2, gbuf + pp * 64 + i0); \
            LD2(ge2, gbuf + (pp > 0 ? pp - 1 : 0) * 64 + i0);        \
            if (pp == 0) { ge2[0] = (f32x2){0.f, 0.f}; ge2[1] = ge2[0]; ge2[2] = ge2[0]; ge2[3] = ge2[0]; } \
            UP2(r2, pre[4 * (HALF) + 0]); UP2(k2, pre[4 * (HALF) + 1]); UP2(kkr2, pre[4 * (HALF) + 3]);        \
            *(LAS u32x4*)(lds + slot(6) + pp * PITCH + ig * 16) = pre[4 * (HALF) + 2];        \
            {   f32x2 ap[4], c7[4]; \
                UP2(ap, *(const LAS u32x4*)(lds + slot(5) + pp * PITCH + ig * 16)); LD2(c7, CT + 7 * 64 + i0); \
                _Pragma("unroll") for (int j2 = 0; j2 < 4; ++j2) { const f32x2 araw = ap[j2] + c7[j2]; a2v[j2] = (f32x2){frcp(1.0f + __expf(-araw.x)), frcp(1.0f + __expf(-araw.y))}; } } \
            f32x2 bs2 = (f32x2){0.f, 0.f}; \
            {   f32x2 c9[4], c10[4]; LD2(c9, CT + 9 * 64 + i0); LD2(c10, CT + 10 * 64 + i0); \
                _Pragma("unroll") for (int j2 = 0; j2 < 4; ++j2) { kd2[j2] = k2[j2] * (1.0f + (a2v[j2] - 1.0f) * c9[j2]); bs2 += r2[j2] * kd2[j2] * c10[j2]; } } \
            { const float bs = sum8(bs2.x + bs2.y); if (ig == 0) BON[((size_t)b * 8 + h) * L + tt] = bs; } \
            f32x2 At[4], Rt[4], Bb[4], Kb[4]; \
            _Pragma("unroll") for (int j2 = 0; j2 < 4; ++j2) { const f32x2 kk = kkr2[j2]; \
                const f32x2 ei = (f32x2){__expf(gi2[j2].x), __expf(gi2[j2].y)}, ee = (f32x2){__expf(ge2[j2].x), __expf(ge2[j2].y)}, inv = (f32x2){frcp(ei.x), frcp(ei.y)}; \
                At[j2] = -kk * ee; Rt[j2] = r2[j2] * ei; Bb[j2] = kk * a2v[j2] * inv; Kb[j2] = kd2[j2] * inv; \
                if ((HALF) == 1 && pp == 63) { GC[(cn & 1) * 64 + i0 + 2 * j2] = ei.x; GC[(cn & 1) * 64 + i0 + 2 * j2 + 1] = ei.y; } } \
            *(LAS u32x4*)(lds + slot(3) + pp * PITCH + ig * 16) = PK4(At); \
            *(LAS u32x4*)(lds + slot(4) + pp * PITCH + ig * 16) = PK4(Rt); \
            *(LAS u32x4*)(lds + bbn + pp * PITCH + ig * 16) = PK4(Bb); \
            *(LAS u32x4*)(lds + slot(8) + pp * PITCH + ig * 16) = PK4(Kb); } while (0)
        if (wave < 4) {
            if (cons) {
                u32x2 Ub[4];
                bf16x8 fa[4]; u32x2 ft[4];
#pragma unroll
                for (int z = 0; z < 4; ++z) { const int pb = (z == 3) ? 3 : z + 1, k2 = (z == 3) ? 1 : 0;
                    fa[z] = fragT(lds + slot(11), 16 * pb, k2, fr, fq);
                    ft[z] = *(const LAS u32x2*)(lds + O_TPP + ((z * 16 + fr) * 20 + 4 * fq) * 2); }
#pragma unroll
                for (int pb = 0; pb < 4; ++pb) {
                    f32x4 tmp = acc_[pb];
#pragma unroll
                    for (int k2 = 0; k2 < 2; ++k2) if (2 * k2 < pb) { const int z = (pb == 3 && k2 == 1) ? 3 : pb - 1;
                        const u32x2 b0 = Ub[2 * k2]; const u32x2 b1 = (2 * k2 + 1 < pb) ? Ub[2 * k2 + 1] : (u32x2){0u, 0u};
                        const u32x4 bv = (u32x4){b0.x, b0.y, b1.x, b1.y};
                        tmp = MFMA16(fa[z], __builtin_bit_cast(bf16x8, bv), tmp); }
                    const u32x4 av = (u32x4){ft[pb].x, ft[pb].y, 0u, 0u}, bv = (u32x4){pkbf(tmp[0], tmp[1]), pkbf(tmp[2], tmp[3]), 0u, 0u};
                    const f32x4 U = MFMA16(__builtin_bit_cast(bf16x8, av), __builtin_bit_cast(bf16x8, bv), ((f32x4){0.f, 0.f, 0.f, 0.f}));
                    Ub[pb] = (u32x2){pkbf(U[0], U[1]), pkbf(U[2], U[3])};
                    *(LAS u32x2*)(lds + slot(10) + (16 * wave + fr) * PITCH + (16 * pb + 4 * fq) * 2) = Ub[pb];
                }
            }
        } else { if (prod) S2_ITEM(0); }
        __builtin_amdgcn_sched_barrier(0);
        issue_rkv(cx, 0);
        __syncthreads();
        if (wave < 4) {
            if (cons) {
                const bf16x8 u0 = fragP(lds + slot(10), 16 * wave + fr, 0, fq), u1 = fragP(lds + slot(10), 16 * wave + fr, 1, fq);
#pragma unroll
                for (int q = 0; q < 4; ++q) { f32x4 a = acc_[8 + q];
                    a = MFMA16(fragT(lds + slot(1), 16 * q, 0, fr, fq), u0, a); if (q >= 2) a = MFMA16(fragT(lds + slot(1), 16 * q, 1, fr, fq), u1, a);
#pragma unroll
                    for (int e = 0; e < 4; ++e) { const int pq = 16 * q + 4 * fq + e; const int ttp = dir ? (t0 + 63 - pq) : (t0 + pq);
                        Y[((size_t)b * L + ttp) * 512 + h * 64 + 16 * wave + fr] = (unsigned short)f2bf(a[e]); } }
#pragma unroll
                for (int it = 0; it < 4; ++it) { f32x4 a = acc_[4 + it] + acc_[12 + it];
                    a = MFMA16(fragT(lds + bbc, 16 * it, 0, fr, fq), u0, a); a = MFMA16(fragT(lds + bbc, 16 * it, 1, fr, fq), u1, a);
                    const f32x4 gc = *(const LAS f32x4*)(GC + (cc & 1) * 64 + 16 * it + 4 * fq);
                    a = a * gc; acc_[12 + it] = a;
                    *(LAS u32x2*)(lds + O_SB + (16 * wave + fr) * PITCH + (16 * it + 4 * fq) * 2) = (u32x2){pkbf(a[0], a[1]), pkbf(a[2], a[3])};
                    asm volatile("" ::: "memory"); }
            }
        } else { if (prod) S2_ITEM(1); }
        __builtin_amdgcn_sched_barrier(0);
        issue_rkv(cx, 1);
#undef S2_ITEM
#undef PK4
#undef UP2
#undef LD2
        __syncthreads();
        if (prod) { const bf16x8 at0 = fragN(lds + slot(3), 16 * rt + fr, 0, fq), at1 = fragN(lds + slot(3), 16 * rt + fr, 1, fq), rt0 = fragN(lds + slot(4), 16 * rt + fr, 0, fq), rt1 = fragN(lds + slot(4), 16 * rt + fr, 1, fq);
#pragma unroll
          for (int ct = 0; ct < 2; ++ct) { const int ctt = 2 * chh + ct;
            f32x4 ab = (f32x4){0.f, 0.f, 0.f, 0.f}, ak = ab, rb = ab, rk = ab;
            if (ctt <= rt) {
                const bf16x8 b0 = fragN(lds + bbn, 16 * ctt + fr, 0, fq), b1 = fragN(lds + bbn, 16 * ctt + fr, 1, fq), k0 = fragN(lds + slot(8), 16 * ctt + fr, 0, fq), k1 = fragN(lds + slot(8), 16 * ctt + fr, 1, fq);
                ab = MFMA16(at0, b0, ab); ab = MFMA16(at1, b1, ab); ak = MFMA16(at0, k0, ak); ak = MFMA16(at1, k1, ak);
                rb = MFMA16(rt0, b0, rb); rb = MFMA16(rt1, b1, rb); rk = MFMA16(rt0, k0, rk); rk = MFMA16(rt1, k1, rk); }
            float vab[4], vak[4], vrb[4], vrk[4];
#pragma unroll
            for (int e = 0; e < 4; ++e) { const int prow = 16 * rt + 4 * fq + e, jcol = 16 * ctt + fr; const bool st = prow > jcol, inc = prow >= jcol;
                vab[e] = st ? ab[e] : 0.f; vak[e] = st ? ak[e] : 0.f; vrb[e] = inc ? rb[e] : 0.f; vrk[e] = inc ? rk[e] : 0.f; }
            const int off = (16 * ctt + fr) * PITCH + (16 * rt + 4 * fq) * 2;
            *(LAS u32x2*)(lds + slot(11) + off) = (u32x2){pkbf(vab[0], vab[1]), pkbf(vab[2], vab[3])};
            *(LAS u32x2*)(lds + slot(0) + off) = (u32x2){pkbf(vak[0], vak[1]), pkbf(vak[2], vak[3])};
            *(LAS u32x2*)(lds + slot(1) + off) = (u32x2){pkbf(vrb[0], vrb[1]), pkbf(vrb[2], vrb[3])};
            *(LAS u32x2*)(lds + slot(2) + off) = (u32x2){pkbf(vrk[0], vrk[1]), pkbf(vrk[2], vrk[3])}; } }
    }
    __syncthreads();
#undef issue_rkv
#undef issue_lora
#undef F4
#undef U4
}

constexpr int PT = 128;
__device__ __forceinline__ void rw_post_wg(const Params& p, LAS unsigned char* lds, int l, int G_, int bid, const int wvx) {
    const int tid = opaque_tid(wvx), lane = tid & 63, wave = __builtin_amdgcn_readfirstlane(tid >> 6), fr = lane & 15, fq = lane >> 4;
    const int h = bid & 7;
    const bf16_t* proj = (const bf16_t*)(p.ws + OFF_PROJ);
    const bf16_t* YF = (const bf16_t*)(p.ws + OFF_YF); const bf16_t* YB = (const bf16_t*)(p.ws + OFF_YB);
    const float* BONF = (const float*)(p.ws + OFF_BON); const float* BONB = BONF + (size_t)NT * 8;
    bf16_t* mix = (bf16_t*)(p.ws + OFF_MIX);
    constexpr int GP = 272;
    LAS unsigned char* G2T = lds;
    LAS unsigned char* SG = lds + 17408;
    LAS unsigned char* RAWV = lds + 52224;
    LAS unsigned char* GATE = lds + 68864;
    __syncthreads();
    { const float* g2 = p.in[22] + (size_t)l * 128 * 512 + h * 64;
        for (int i = tid; i < 8192; i += NTHREADS) { const int r = i >> 6, n = i & 63; *(LAS bf16_t*)(G2T + n * GP + r * 2) = (bf16_t)f2bf(g2[r * 512 + n]); } }
    const int ig = tid & 7, i0 = ig * 8, col = h * 64 + i0;
    float mv0[8], mv1[8], lnw[8], lnb[8];
#pragma unroll
    for (int j = 0; j < 8; ++j) { mv0[j] = p.in[14][(size_t)l * 3072 + 2 * 1024 + col + j]; mv1[j] = p.in[14][(size_t)l * 3072 + 2 * 1024 + 512 + col + j]; lnw[j] = p.in[23][l * 512 + col + j]; lnb[j] = p.in[24][l * 512 + col + j]; }
#pragma unroll 1
    for (int tile = bid >> 3; tile < NT / PT; tile += G_ >> 3) {
        const int row0 = tile * PT, tb0 = row0 & (L - 1);
        __syncthreads();
        u32x4 gq[4], vq[3]; u32x4 yq[2][2]; float bq[2];
#pragma unroll
        for (int k = 0; k < 4; ++k) { const int q = tid + k * NTHREADS; gq[k] = *(const u32x4*)(proj + (size_t)(row0 + (q >> 4)) * IN_DP + C_RG + (q & 15) * 8); }
#pragma unroll
        for (int k = 0; k < 3; ++k) { const int q = tid + k * NTHREADS; const int rr = q >> 3, ch = q & 7; const int tt = tb0 - 1 + rr; vq[k] = (u32x4){0u, 0u, 0u, 0u};
            if (q < 1040 && tt >= 0 && tt < L) vq[k] = *(const u32x4*)(proj + (size_t)(row0 - 1 + rr) * IN_DP + C_RV + h * 64 + ch * 8); }
#pragma unroll
        for (int sl = 0; sl < 2; ++sl) { const size_t row = (size_t)row0 + (tid >> 3) + 64 * sl; yq[sl][0] = *(const u32x4*)(YF + row * 512 + col); yq[sl][1] = *(const u32x4*)(YB + row * 512 + col);
            const size_t bi = ((size_t)(row >> 13) * 8 + h) * L + (row & (L - 1)); bq[sl] = BONF[bi] + BONB[bi]; }
#pragma unroll
        for (int k = 0; k < 4; ++k) { const int q = tid + k * NTHREADS; const int t = q >> 4, ch = q & 15; *(LAS u32x4*)(SG + t * GP + ch * 16) = gq[k]; }
#pragma unroll
        for (int k = 0; k < 3; ++k) { const int q = tid + k * NTHREADS; if (q < 1040) *(LAS u32x4*)(RAWV + (q >> 3) * 128 + (q & 7) * 16) = vq[k]; }
        __syncthreads();
#pragma unroll
        for (int ct = 0; ct < 4; ++ct) { f32x4 acc = (f32x4){0.f, 0.f, 0.f, 0.f};
#pragma unroll
            for (int ks = 0; ks < 4; ++ks) { const bf16x8 a = *(const LAS bf16x8*)(SG + (16 * wave + fr) * GP + ks * 64 + fq * 16); const bf16x8 b = *(const LAS bf16x8*)(G2T + (16 * ct + fr) * GP + ks * 64 + fq * 16);
                acc = __builtin_amdgcn_mfma_f32_16x16x32_bf16(a, b, acc, 0, 0, 0); }
#pragma unroll
            for (int e = 0; e < 4; ++e) *(LAS bf16_t*)(GATE + (16 * wave + 4 * fq + e) * 144 + (16 * ct + fr) * 2) = (bf16_t)f2bf(acc[e]); }
        __syncthreads();
#pragma unroll
        for (int sl = 0; sl < 2; ++sl) { const int t = (tid >> 3) + 64 * sl; const size_t row = (size_t)row0 + t;
            float vp[8], vc[8], vn[8], gt[8];
            unpack8(*(const LAS u32x4*)(RAWV + t * 128 + ig * 16), vp); unpack8(*(const LAS u32x4*)(RAWV + (t + 1) * 128 + ig * 16), vc); unpack8(*(const LAS u32x4*)(RAWV + (t + 2) * 128 + ig * 16), vn);
            unpack8(*(const LAS u32x4*)(GATE + t * 144 + ig * 16), gt);
            float yf8[8], yb8[8]; unpack8(yq[sl][0], yf8); unpack8(yq[sl][1], yb8);
            const float bon = bq[sl];
            float y[8] = {yf8[0] + yb8[0], yf8[1] + yb8[1], yf8[2] + yb8[2], yf8[3] + yb8[3], yf8[4] + yb8[4], yf8[5] + yb8[5], yf8[6] + yb8[6], yf8[7] + yb8[7]};
            float sm = 0.f;
#pragma unroll
            for (int j = 0; j < 8; ++j) sm += y[j];
            const float mean = sum8(sm) * (1.0f / 64.0f);
            float sq = 0.f;
#pragma unroll
            for (int j = 0; j < 8; ++j) { y[j] -= mean; sq += y[j] * y[j]; }
            const float rstd = __builtin_amdgcn_rsqf(sum8(sq) * (1.0f / 64.0f) + 64e-5f);
            float o[8];
#pragma unroll
            for (int j = 0; j < 8; ++j) { const float v = vc[j] + mv0[j] * (vp[j] - vc[j]) + mv1[j] * (vn[j] - vc[j]); o[j] = (y[j] * rstd * lnw[j] + lnb[j] + bon * v) * gt[j]; }
            u32x4 w; w.x = pk2(o[0], o[1]); w.y = pk2(o[2], o[3]); w.z = pk2(o[4], o[5]); w.w = pk2(o[6], o[7]);
            *(u32x4*)(mix + row * D + 256 + col) = w; }
    }
    __syncthreads();
}

namespace na {
constexpr int O_K = 0, O_V = 65536, O_RPB = 131072, O_MX = 133120, O_QW = 142080;
__device__ __forceinline__ int rowoff(int keycol, int byte) { return keycol * 128 + ((((byte >> 5) ^ keycol) & 3) << 5) + (byte & 31); }
typedef short s16x4 __attribute__((ext_vector_type(4)));
}
__device__ __forceinline__ void na_strip(const Params& p, LAS unsigned char* lds, int l, int strip, const int wvx) {
    using namespace na;
    const int tid = opaque_tid(wvx), lane = tid & 63, wave = __builtin_amdgcn_readfirstlane(tid >> 6), fr = lane & 15, fq = lane >> 4;
    const int b = strip >> 5, h = (strip >> 3) & 3, i0 = (strip & 7) * 16;
    const int g = wave & 3, kh = wave >> 2;
    const bf16_t* proj = (const bf16_t*)(p.ws + OFF_PROJ);
    bf16_t* mix = (bf16_t*)(p.ws + OFF_MIX);
    LAS float* RPB = (LAS float*)(lds + O_RPB);
    LAS unsigned char* MX = lds + O_MX + g * 2240;
    const int j0 = 16 * g, c0 = (g == 0) ? 0 : ((g == 3) ? 32 : 16 * g - 8);
    __syncthreads();
    for (int q = tid; q < 465; q += NTHREADS) RPB[q] = p.in[25][((size_t)l * 4 + h) * 465 + q];
    { int rs = i0 - 4; rs = rs < 0 ? 0 : (rs > 120 ? 120 : rs);
        u32x4 fw[16];
#pragma unroll
        for (int k = 0; k < 16; ++k) { const int q = tid + k * NTHREADS; const int r8 = q >> 10, which = (q >> 9) & 1, col = (q >> 3) & 63, ch = q & 7; const int kr = rs + r8;
            fw[k] = *(const u32x4*)(proj + ((size_t)b * L + kr * 64 + col) * IN_DP + (which ? C_NV : C_NK) + h * 64 + ch * 8); }
#pragma unroll
        for (int k = 0; k < 16; ++k) { const int q = tid + k * NTHREADS; const int r8 = q >> 10, which = (q >> 9) & 1, col = (q >> 3) & 63, ch = q & 7; const int kr = rs + r8;
            *(LAS u32x4*)(lds + (which ? O_V : O_K) + (kr & 7) * 8192 + rowoff(col, 16 * ch)) = fw[k]; } }
    bf16x8 Bq[2];
#pragma unroll
    for (int ks = 0; ks < 2; ++ks) Bq[ks] = *(const bf16x8*)(proj + ((size_t)b * L + i0 * 64 + j0 + fr) * IN_DP + C_NQ + h * 64 + 32 * ks + 8 * fq);
    const int jq = j0 + fr;
    int cs = jq - 8; cs = cs < 0 ? 0 : (cs > 48 ? 48 : cs);
    const u32x4 onesv = (u32x4){0x3F803F80u, 0x3F803F80u, 0x3F803F80u, 0x3F803F80u};
#pragma unroll 1
    for (int i = i0; i < i0 + 16; ++i) {
        int rs = i - 4; rs = rs < 0 ? 0 : (rs > 120 ? 120 : rs);
        int rsn = i + 1 - 4; rsn = rsn < 0 ? 0 : (rsn > 120 ? 120 : rsn);
        const bool more = (i + 1 < i0 + 16), newrow = more && (rsn > rs);
        __syncthreads();
        u32x4 pre0 = (u32x4){0u, 0u, 0u, 0u}, pre1 = pre0; bf16x8 Bqn[2] = {Bq[0], Bq[1]};
        if (newrow) { const int kr = rsn + 7;
            { const int q = tid; const int which = q >> 9, col = (q >> 3) & 63, ch = q & 7; pre0 = *(const u32x4*)(proj + ((size_t)b * L + kr * 64 + col) * IN_DP + (which ? C_NV : C_NK) + h * 64 + ch * 8); }
            { const int q = tid + 512; const int which = q >> 9, col = (q >> 3) & 63, ch = q & 7; pre1 = *(const u32x4*)(proj + ((size_t)b * L + kr * 64 + col) * IN_DP + (which ? C_NV : C_NK) + h * 64 + ch * 8); } }
        if (more) {
#pragma unroll
            for (int ks = 0; ks < 2; ++ks) Bqn[ks] = *(const bf16x8*)(proj + ((size_t)b * L + (i + 1) * 64 + j0 + fr) * IN_DP + C_NQ + h * 64 + 32 * ks + 8 * fq); }
        f32x4 S[4][2]; float mloc = -1e30f;
#pragma unroll
        for (int r4 = 0; r4 < 4; ++r4) { const int krow = rs + 4 * kh + r4, slot = krow & 7, dr = krow - i + 7;
#pragma unroll
            for (int ct = 0; ct < 2; ++ct) { const int keycol = c0 + 16 * ct + fr; f32x4 acc = (f32x4){0.f, 0.f, 0.f, 0.f};
#pragma unroll
                for (int ks = 0; ks < 2; ++ks) { const bf16x8 a = *(const LAS bf16x8*)(lds + O_K + slot * 8192 + rowoff(keycol, 64 * ks + 16 * fq)); acc = __builtin_amdgcn_mfma_f32_16x16x32_bf16(a, Bq[ks], acc, 0, 0, 0); }
#pragma unroll
                for (int e = 0; e < 4; ++e) { const int kc = c0 + 16 * ct + 4 * fq + e; const bool valid = (kc >= cs) && (kc < cs + 16);
                    int dc = kc - jq; dc = dc < -15 ? -15 : (dc > 15 ? 15 : dc); dc += 15;
                    const float sc = valid ? (acc[e] * 0.125f + RPB[dr * 31 + dc]) : -1e30f; acc[e] = sc; mloc = fmaxf(mloc, sc); }
                S[r4][ct] = acc; } }
        { int lid; asm volatile("v_mbcnt_lo_u32_b32 %0, -1, 0\n\tv_mbcnt_hi_u32_b32 %0, -1, %0" : "=v"(lid));
          mloc = fmaxf(mloc, __int_as_float(__builtin_amdgcn_ds_bpermute((lid ^ 16) << 2, __float_as_int(mloc))));
          mloc = fmaxf(mloc, __int_as_float(__builtin_amdgcn_ds_bpermute((lid ^ 32) << 2, __float_as_int(mloc)))); }
        bf16x8 Ap[4];
#pragma unroll
        for (int r4 = 0; r4 < 4; ++r4) { float pv[8];
#pragma unroll
            for (int ct = 0; ct < 2; ++ct)
#pragma unroll
                for (int e = 0; e < 4; ++e) { const float sc = S[r4][ct][e]; pv[ct * 4 + e] = (sc > -1e29f) ? __expf(sc - mloc) : 0.f; }
            const u32x4 w = (u32x4){pk2(pv[0], pv[1]), pk2(pv[2], pv[3]), pk2(pv[4], pv[5]), pk2(pv[6], pv[7])}; Ap[r4] = __builtin_bit_cast(bf16x8, w); }
        f32x4 O[4], Ls = (f32x4){0.f, 0.f, 0.f, 0.f};
#pragma unroll
        for (int dt = 0; dt < 4; ++dt) O[dt] = (f32x4){0.f, 0.f, 0.f, 0.f};
#pragma unroll
        for (int r4 = 0; r4 < 4; ++r4) { const int slot = (rs + 4 * kh + r4) & 7; const int kc0 = c0 + 4 * fq + (fr >> 2), kc1 = kc0 + 16;
            Ls = __builtin_amdgcn_mfma_f32_16x16x32_bf16(Ap[r4], __builtin_bit_cast(bf16x8, onesv), Ls, 0, 0, 0);
#pragma unroll
            for (int dt = 0; dt < 4; ++dt) {
                const s16x4 v0 = __builtin_amdgcn_ds_read_tr16_b64_v4i16((LAS s16x4*)(lds + O_V + slot * 8192 + rowoff(kc0, 32 * dt + 8 * (fr & 3))));
                const s16x4 v1 = __builtin_amdgcn_ds_read_tr16_b64_v4i16((LAS s16x4*)(lds + O_V + slot * 8192 + rowoff(kc1, 32 * dt + 8 * (fr & 3))));
                const bf16x8 bv = (bf16x8){v0[0], v0[1], v0[2], v0[3], v1[0], v1[1], v1[2], v1[3]};
                O[dt] = __builtin_amdgcn_mfma_f32_16x16x32_bf16(Ap[r4], bv, O[dt], 0, 0, 0); } }
        if (fq == 0) *(LAS float*)(MX + kh * 64 + fr * 4) = mloc;
        if (kh == 1) { if (fr == 0) *(LAS f32x4*)(MX + 128 + fq * 16) = Ls;
#pragma unroll
            for (int dt = 0; dt < 4; ++dt)
#pragma unroll
                for (int e = 0; e < 4; ++e) *(LAS bf16_t*)(MX + 192 + (4 * fq + e) * 128 + (16 * dt + fr) * 2) = (bf16_t)f2bf(O[dt][e]); }
        __syncthreads();
        if (newrow) { const int kr = rsn + 7;
            { const int q = tid; const int which = q >> 9, col = (q >> 3) & 63, ch = q & 7; *(LAS u32x4*)(lds + (which ? O_V : O_K) + (kr & 7) * 8192 + rowoff(col, 16 * ch)) = pre0; }
            { const int q = tid + 512; const int which = q >> 9, col = (q >> 3) & 63, ch = q & 7; *(LAS u32x4*)(lds + (which ? O_V : O_K) + (kr & 7) * 8192 + rowoff(col, 16 * ch)) = pre1; } }
        if (kh == 0) {
            const f32x4 m0 = *(const LAS f32x4*)(MX + fq * 16), m1 = *(const LAS f32x4*)(MX + 64 + fq * 16), l1 = *(const LAS f32x4*)(MX + 128 + fq * 16);
#pragma unroll
            for (int e = 0; e < 4; ++e) { const float M = fmaxf(m0[e], m1[e]), a0 = __expf(m0[e] - M), a1 = __expf(m1[e] - M); const float inv = frcp(Ls[e] * a0 + l1[e] * a1);
                const size_t row = (size_t)b * L + i * 64 + j0 + 4 * fq + e;
#pragma unroll
                for (int dt = 0; dt < 4; ++dt) { const float o1 = bf2f(*(const LAS bf16_t*)(MX + 192 + (4 * fq + e) * 128 + (16 * dt + fr) * 2));
                    mix[row * D + 768 + h * 64 + 16 * dt + fr] = (bf16_t)f2bf((O[dt][e] * a0 + o1 * a1) * inv); } }
        }
        Bq[0] = Bqn[0]; Bq[1] = Bqn[1];
    }
    __syncthreads();
}

__device__ __forceinline__ void na_queue(const Params& p, LAS unsigned char* lds, int l, const int wvx) {
    int* ctr = (int*)(p.ws + OFF_CTL) + 16 + l;
    LAS int* qw = (LAS int*)(lds + na::O_QW);
    for (;;) {
        __syncthreads();
        if (opaque_tid(wvx) == 0) *qw = atomicAdd(ctr, 1);
        __syncthreads();
        const int strip = __builtin_amdgcn_readfirstlane(*qw);
        if (strip >= 256) break;
        na_strip(p, lds, l, strip, wvx);
    }
}

__device__ __forceinline__ void phase_router(const Params& p, LAS unsigned char* lds, int l, int G_, int bid, const int wvx) {
    const int tid = opaque_tid(wvx), lane = tid & 63, wave = __builtin_amdgcn_readfirstlane(tid >> 6), fr = lane & 15, fq = lane >> 4;
    const bf16_t* x = (const bf16_t*)(p.ws + OFF_XB); float* rs = (float*)(p.ws + OFF_RS);
    const bf16_t* rgh = (const bf16_t*)(p.ws + OFF_RGW) + (size_t)l * 2 * 48 * D; const bf16_t* rgl = rgh + 48 * D;
    int* cnt = (int*)(p.ws + OFF_CTL) + 64 + l * 64;
    int* ltok = (int*)(p.ws + OFF_LTOK); float* lgate = (float*)(p.ws + OFF_LGATE); float* lrs = (float*)(p.ws + OFF_LRS);
    LAS int* lcnt = (LAS int*)lds;
    LAS int* lbase = lcnt + 32;
    LAS int* se = lbase + 32;
    LAS int* sp = se + 512;
    LAS float* sg = (LAS float*)(sp + 512);
    LAS float* LG = (LAS float*)(lds + 8192);
    LAS float* SQ = LG + 256 * 52;
    const float* bg = p.in[29] + l * 4; const float* be = p.in[31] + l * 32;
    for (int chunk = bid; chunk < NT / 256; chunk += G_) {
        __syncthreads();
        if (tid < 32) lcnt[tid] = 0;
        const int tl0 = wave * 32;
        const bf16_t* xa_p = x + (size_t)(chunk * 256 + tl0 + fr) * D + 8 * fq; const bf16_t* xb_p = xa_p + 16 * D;
        const bf16_t* wh_p = rgh + (size_t)fr * D + 8 * fq; const bf16_t* wl_p = rgl + (size_t)fr * D + 8 * fq;
        f32x4 acc[2][3];
#pragma unroll
        for (int t = 0; t < 2; ++t)
#pragma unroll
            for (int c = 0; c < 3; ++c) acc[t][c] = (f32x4){0.f, 0.f, 0.f, 0.f};
        float ssa = 0.f, ssb = 0.f;
#pragma unroll 2
        for (int ks = 0; ks < 32; ++ks) {
            const u32x4 ar = *(const u32x4*)(xa_p + 32 * ks), br = *(const u32x4*)(xb_p + 32 * ks);
            bf16x8 wh[3], wl[3];
#pragma unroll
            for (int c = 0; c < 3; ++c) { wh[c] = *(const bf16x8*)(wh_p + (size_t)16 * c * D + 32 * ks); wl[c] = *(const bf16x8*)(wl_p + (size_t)16 * c * D + 32 * ks); }
            { float f[8]; unpack8(ar, f);
#pragma unroll
              for (int j = 0; j < 8; ++j) ssa += f[j] * f[j];
              unpack8(br, f);
#pragma unroll
              for (int j = 0; j < 8; ++j) ssb += f[j] * f[j]; }
            const bf16x8 a0 = __builtin_bit_cast(bf16x8, ar), a1 = __builtin_bit_cast(bf16x8, br);
#pragma unroll
            for (int c = 0; c < 3; ++c) {
                acc[0][c] = __builtin_amdgcn_mfma_f32_16x16x32_bf16(a0, wh[c], acc[0][c], 0, 0, 0); acc[0][c] = __builtin_amdgcn_mfma_f32_16x16x32_bf16(a0, wl[c], acc[0][c], 0, 0, 0);
                acc[1][c] = __builtin_amdgcn_mfma_f32_16x16x32_bf16(a1, wh[c], acc[1][c], 0, 0, 0); acc[1][c] = __builtin_amdgcn_mfma_f32_16x16x32_bf16(a1, wl[c], acc[1][c], 0, 0, 0); }
        }
#pragma unroll
        for (int t = 0; t < 2; ++t)
#pragma unroll
            for (int c = 0; c < 3; ++c)
#pragma unroll
                for (int e = 0; e < 4; ++e) LG[(tl0 + 16 * t + 4 * fq + e) * 52 + 16 * c + fr] = acc[t][c][e];
        SQ[(tl0 + fr) * 4 + fq] = ssa; SQ[(tl0 + 16 + fr) * 4 + fq] = ssb;
        __syncthreads();
        if (lane < 32) { const int tl = tl0 + lane, row = chunk * 256 + tl;
            const f32x4 s4 = *(const LAS f32x4*)(SQ + tl * 4);
            const float rr = 1.0f / sqrtf(((s4.x + s4.y) + (s4.z + s4.w)) * (1.0f / D) + NORM_EPS);
            rs[row] = rr; SQ[tl * 4] = rr;
            const LAS float* lg = LG + tl * 52;
            const float g0 = lg[0] * rr + bg[0], g1 = lg[1] * rr + bg[1], g2 = lg[2] * rr + bg[2], g3 = lg[3] * rr + bg[3];
            int gs = 0; float gm = g0; if (g1 > gm) { gm = g1; gs = 1; } if (g2 > gm) { gm = g2; gs = 2; } if (g3 > gm) { gm = g3; gs = 3; }
            const float gprob = 1.0f / (expf(g0 - gm) + expf(g1 - gm) + expf(g2 - gm) + expf(g3 - gm));
            float ev[8];
#pragma unroll
            for (int e = 0; e < 8; ++e) ev[e] = lg[4 + gs * 8 + e] * rr + be[gs * 8 + e];
            int i0 = 0; float v0 = ev[0];
#pragma unroll
            for (int e = 1; e < 8; ++e) if (ev[e] > v0) { v0 = ev[e]; i0 = e; }
            int i1 = -1; float v1 = -3.0e38f;
#pragma unroll
            for (int e = 0; e < 8; ++e) if (e != i0 && ev[e] > v1) { v1 = ev[e]; i1 = e; }
            const float e1 = expf(v1 - v0), den = 1.0f + e1;
            const int ea = gs * 8 + i0, eb = gs * 8 + i1;
            se[tl * 2] = ea; se[tl * 2 + 1] = eb; sg[tl * 2] = gprob / den; sg[tl * 2 + 1] = gprob * e1 / den;
            sp[tl * 2] = atomicAdd((int*)lcnt + ea, 1); sp[tl * 2 + 1] = atomicAdd((int*)lcnt + eb, 1); }
        __syncthreads();
        if (tid < 32) lbase[tid] = atomicAdd(cnt + tid, lcnt[tid]);
        __syncthreads();
        { const int tl = tid >> 1, k = tid & 1, e = se[tid]; const size_t li = (size_t)e * LCAP + lbase[e] + sp[tid];
            ltok[li] = (chunk * 256 + tl) * 2 + k; lgate[li] = sg[tid]; lrs[li] = SQ[tl * 4]; }
    }
    __syncthreads();
}

__device__ __forceinline__ void phase_combine(const Params& p, bool last, int G_, int bid, const int wvx) {
    const int tid = opaque_tid(wvx), lane = tid & 63, wave = tid >> 6;
    float* out = p.out; bf16_t* x16 = (bf16_t*)(p.ws + OFF_XB); float* rs = (float*)(p.ws + OFF_RS);
    const bf16_t* yb = (const bf16_t*)(p.ws + OFF_YBUF);
    const float* gf = p.in[35];
    for (int row = bid * 8 + wave; row < NT; row += G_ * 8) {
        u32x2* xr = (u32x2*)(x16 + (size_t)row * D) + lane; const u32x2* y0 = (const u32x2*)(yb + (size_t)(2 * row) * D) + lane; const u32x2* y1 = (const u32x2*)(yb + (size_t)(2 * row + 1) * D) + lane;
        f32x4 v[4]; float s = 0.f; u32x2 xq[4], aq[4], cq[4];
#pragma unroll
        for (int j = 0; j < 4; ++j) { xq[j] = xr[64 * j]; aq[j] = y0[64 * j]; cq[j] = y1[64 * j]; }
#pragma unroll
        for (int j = 0; j < 4; ++j) { const u32x2 xx = xq[j], a = aq[j], c = cq[j];
            v[j].x = bf2f(xx.x & 0xffffu) + bf2f(a.x & 0xffffu) + bf2f(c.x & 0xffffu); v[j].y = __uint_as_float(xx.x & 0xffff0000u) + __uint_as_float(a.x & 0xffff0000u) + __uint_as_float(c.x & 0xffff0000u);
            v[j].z = bf2f(xx.y & 0xffffu) + bf2f(a.y & 0xffffu) + bf2f(c.y & 0xffffu); v[j].w = __uint_as_float(xx.y & 0xffff0000u) + __uint_as_float(a.y & 0xffff0000u) + __uint_as_float(c.y & 0xffff0000u);
            s += (v[j].x * v[j].x + v[j].y * v[j].y) + (v[j].z * v[j].z + v[j].w * v[j].w); }
        s = wave_sum(s);
        const float rr = 1.0f / sqrtf(s * (1.0f / D) + NORM_EPS);
        if (last) { f32x4* orow = (f32x4*)(out + (size_t)row * D) + lane;
#pragma unroll
            for (int j = 0; j < 4; ++j) { const f32x4 g = ((const f32x4*)gf)[lane + 64 * j]; orow[64 * j] = v[j] * rr * g; }
        } else {
            if (lane == 0) rs[row] = rr;
#pragma unroll
            for (int j = 0; j < 4; ++j) xr[64 * j] = (u32x2){pk2(v[j].x, v[j].y), pk2(v[j].z, v[j].w)};
        }
    }
}

#ifndef PH_MASK
#define PH_MASK 0xFFFFF
#endif
#define PH(k) if (PH_MASK & (1 << (k)))

#define XB_TMO      128
#define XB_XCNT(j)  (256  + 64 * (j))
#define XB_XSUB(j)  (1280 + 64 * (j))
#define XB_XGEN(j)  (2304 + 64 * (j))
#define XB_TOP      3328
#define XB_TOPGEN   3392
#define XCD_BAR_WORDS 3456
#define XB_SPIN_CAP (1u << 22)
__device__ __forceinline__ unsigned xb_ld(unsigned* p)              { return __hip_atomic_load(p, __ATOMIC_RELAXED, __HIP_MEMORY_SCOPE_AGENT); }
__device__ __forceinline__ unsigned xb_add(unsigned* p, unsigned v) { return __hip_atomic_fetch_add(p, v, __ATOMIC_RELAXED, __HIP_MEMORY_SCOPE_AGENT); }
__device__ __forceinline__ unsigned xb_xcc_id() { return (unsigned)__builtin_amdgcn_s_getreg((3 << 11) | 20) & 0xFu; }
#define XB_SPIN(cond, bar) do { unsigned _sp = 0; while (cond) { __builtin_amdgcn_s_sleep(1); \
    if ((++_sp & 255u) == 0u) { if (xb_ld(&(bar)[XB_TMO])) break; if (_sp > XB_SPIN_CAP) { atomicAdd(&(bar)[XB_TMO], 1u); break; } } } } while (0)
struct XcdBarrier { unsigned* bar; unsigned x; volatile LAS unsigned* st; };
__device__ __forceinline__ void xcd_barrier_complete(unsigned* bar, unsigned x, unsigned& nloc, unsigned& nx) {
    const unsigned G = gridDim.x * gridDim.y * gridDim.z;
    unsigned sum, cnt, mine, sp = 0u;
    for (;;) {
        sum = 0u; cnt = 0u; mine = 0u;
#pragma unroll
        for (unsigned j = 0; j < 16; ++j) { const unsigned c = xb_ld(&bar[XB_XCNT(j)]); sum += c; cnt += (c > 0u) ? 1u : 0u; mine = (j == x) ? c : mine; }
        if (sum == G) break;
        __builtin_amdgcn_s_sleep(1);
        if ((++sp & 255u) == 0u) { if (xb_ld(&bar[XB_TMO])) break; if (sp > XB_SPIN_CAP) { atomicAdd(&bar[XB_TMO], 1u); break; } }
    }
    nloc = mine > 0u ? mine : 1u; nx = cnt > 0u ? cnt : 1u;
}
__device__ __forceinline__ void xcd_barrier(const XcdBarrier& b, const bool leader) {
    asm volatile("s_waitcnt vmcnt(0)" ::: "memory");
    __syncthreads();
    if (leader) {
        unsigned* bar = b.bar;
        __builtin_amdgcn_s_waitcnt(0);
        unsigned nloc = b.st[0], nx = b.st[1];
        if (nloc == 0u) { xcd_barrier_complete(bar, b.x, nloc, nx); b.st[0] = nloc; b.st[1] = nx; }
        const unsigned old = xb_add(&bar[XB_XSUB(b.x)], 1u);
        const unsigned gen = old / nloc;
        if (old + 1u == (gen + 1u) * nloc) {
            __builtin_amdgcn_fence(__ATOMIC_RELEASE, "agent");
            asm volatile("s_waitcnt vmcnt(0)" ::: "memory");
            const unsigned og = xb_add(&bar[XB_TOP], 1u);
            const unsigned tg = og / nx;
            if (og + 1u == (tg + 1u) * nx) xb_add(&bar[XB_TOPGEN], 1u);
            else XB_SPIN(xb_ld(&bar[XB_TOPGEN]) == tg, bar);
            __builtin_amdgcn_fence(__ATOMIC_ACQUIRE, "agent");
            xb_add(&bar[XB_XGEN(b.x)], 1u);
            asm volatile("s_waitcnt vmcnt(0)" ::: "memory");
        } else {
            XB_SPIN(xb_ld(&bar[XB_XGEN(b.x)]) == gen, bar);
            __builtin_amdgcn_fence(__ATOMIC_ACQUIRE, "agent");
            asm volatile("s_waitcnt vmcnt(0)" ::: "memory");
        }
    }
    __syncthreads();
}

__device__ __forceinline__ Params load_params() {
#if defined(__HIP_DEVICE_COMPILE__)
    auto k = __builtin_amdgcn_kernarg_segment_ptr();
    asm volatile("" : "+s"(k));
    return *(const __attribute__((address_space(4))) Params*)k;
#else
    return Params{};
#endif
}
__global__ void __launch_bounds__(NTHREADS, 2) fwd_megakernel(Params p_unused) {
    extern __shared__ __attribute__((aligned(16))) unsigned char lds_raw[];
    LAS unsigned char* lds = (LAS unsigned char*)lds_raw;
    cg::grid_group grid = cg::this_grid();
    const int G_ = gridDim.x, bid = blockIdx.x;
    const int wvx = __builtin_amdgcn_readfirstlane((int)threadIdx.x >> 6);
    const bool leader = (threadIdx.x == 0);
    volatile LAS unsigned* bst = (volatile LAS unsigned*)(lds + LDS_BYTES - 16);
    if (leader) { bst[0] = 0u; bst[1] = 0u; }
    XcdBarrier xbar;
    { const Params p = load_params(); xbar.bar = (unsigned*)(p.ws + OFF_CTL) + 4096; xbar.x = xb_xcc_id(); xbar.st = bst;
      if (leader) (void)xb_add(&xbar.bar[XB_XCNT(xbar.x)], 1u); }
    __syncthreads();
#define GRID_BAR() do { const Params pb = load_params(); XcdBarrier xb2; xb2.bar = (unsigned*)(pb.ws + OFF_CTL) + 4096; xb2.x = xb_xcc_id(); xb2.st = bst; xcd_barrier(xb2, opaque_tid(wvx) == 0); } while (0)

    { const Params p = load_params(); PH(0) phase_prologue(p, lds, G_, bid, wvx); }
    { const Params p = load_params(); PH(0) filters_all(p, G_, bid, wvx); }
    { const Params p = load_params(); PH(1) phase_rownorm(p.in[0], (bf16_t*)(p.ws + OFF_XB), (float*)(p.ws + OFF_RS), G_, bid, wvx); }
    grid.sync();

#pragma unroll 1
    for (int l = 0; l < DEPTH; ++l) {
        PH(2) { const Params p = load_params(); unsigned char* ws = p.ws;
            DenseSched S; S.init((const bf16_t*)(ws + OFF_XB), (const bf16_t*)(ws + OFF_WTIN) + (size_t)l * IN_DP * D, NT, IN_DP, D, G_, bid);
            EpiProj E{(bf16_t*)(ws + OFF_PROJ), (const float*)(ws + OFF_RS)};
            pg8::gemm_phase<EpiProj, DenseSched, false>(lds, D, S, E, wvx);
        }
        GRID_BAR();
        {
            const bool lead = (opaque_tid(wvx) == 0);
            LAS int* qw = (LAS int*)(lds + na::O_QW);
#define CTR(k) ((int*)(load_params().ws + OFF_CTL) + 32 + l * 16 + (k))
            PH(5) for (;;) { const int u = wg_pop(CTR(6), qw, lead); if (u >= 1024) break; { const Params p = load_params(); rw_prep_unit(p, l, u, wvx); } wg_signal(CTR(8 + (u >> 7)), lead);
                             if (bid < 128 && u >= 128) break; }
            if (bid < 128) { PH(5) { const Params p = load_params(); rw_chain_unit(p, lds, l, bid, wvx); } }
            PH(3) for (;;) { const int u = wg_pop(CTR(0), qw, lead); if (u >= 1024) break; { const Params p = load_params(); hy_pre_unit4(p, lds, l, u, wvx); } wg_signal(CTR(1), lead); }
            PH(6) { const Params p = load_params(); na_queue(p, lds, l, wvx); }
            wg_wait(CTR(1), 1024, lead);
            PH(4) for (;;) { const int c = wg_pop(CTR(7), qw, lead); if (c >= 256) break; { const Params p = load_params(); hy_conv_unit(p, lds, l, c, wvx); } wg_signal(CTR(2), lead); }
            wg_wait(CTR(2), 256, lead);
            PH(7) for (;;) { const int u = wg_pop(CTR(3), qw, lead); if (u >= 1024) break; { const Params p = load_params(); hy_post_unit4(p, lds, l, u, wvx); } wg_signal(CTR(4), lead); }
            wg_wait(CTR(4), 1024, lead);
            PH(10) for (;;) { const int u = wg_pop(CTR(5), qw, lead); if (u >= NEXP * 768 / 64 + (l == 0 ? 43 : 0)) break; { const Params p = load_params(); moe_weights_chunk(p, lds, l, u, wvx); } }
#undef CTR
        }
        GRID_BAR();
        PH(8) { const Params p = load_params(); rw_post_wg(p, lds, l, G_, bid, wvx); }
        GRID_BAR();
        PH(9) { const Params p = load_params(); unsigned char* ws = p.ws;
            DenseSched S; S.init((const bf16_t*)(ws + OFF_MIX), (const bf16_t*)(ws + OFF_WTOUT) + (size_t)l * D * D, NT, D, D, G_, bid);
            EpiRes E{(bf16_t*)(ws + OFF_XB)};
            pg8::gemm_phase<EpiRes, DenseSched, false>(lds, D, S, E, wvx);
        }
        GRID_BAR();
        PH(11) { const Params p = load_params(); phase_router(p, lds, l, G_, bid, wvx); }
        GRID_BAR();
        PH(12) { const Params p = load_params(); unsigned char* ws = p.ws;
            const int* cnt = (const int*)(ws + OFF_CTL) + 64 + l * 64;
            MoeSched S; S.init(cnt, (const bf16_t*)(ws + OFF_XB), (const bf16_t*)(ws + OFF_W13T), (size_t)1024 * D, (const int*)(ws + OFF_LTOK), D, G_, bid, (LAS int*)(lds + 139264), opaque_tid(wvx));
            EpiMoe1 E{(bf16_t*)(ws + OFF_ACT), (const float*)(ws + OFF_LRS)};
            pg8::gemm_phase<EpiMoe1, MoeSched, true>(lds, D, S, E, wvx);
        }
        GRID_BAR();
        PH(13) { const Params p = load_params(); unsigned char* ws = p.ws;
            const int* cnt = (const int*)(ws + OFF_CTL) + 64 + l * 64;
            MoeSched S; S.init(cnt, (const bf16_t*)(ws + OFF_ACT), (const bf16_t*)(ws + OFF_W2T), (size_t)D * FF, nullptr, FF, G_, bid, (LAS int*)(lds + 139264), opaque_tid(wvx));
            EpiMoe2 E{(bf16_t*)(ws + OFF_YBUF), (const int*)(ws + OFF_LTOK), (const float*)(ws + OFF_LGATE)};
            pg8::gemm_phase<EpiMoe2, MoeSched, false>(lds, FF, S, E, wvx);
        }
        GRID_BAR();
        PH(14) { const Params p = load_params(); phase_combine(p, l == DEPTH - 1, G_, bid, wvx); }
        if (l < DEPTH - 1) GRID_BAR();
    }
}

extern "C" void kernel_launch(void* const* d_in, const int* in_sizes, int n_in, void* d_out, int out_size, void* d_ws, size_t ws_size, hipStream_t stream) {
    static int grid = 0;
    if (grid == 0) {
        if (n_in != 36 || ws_size < WS_END) { fprintf(stderr, "kernel_launch: unexpected n_in %d / ws_size %zu (need %zu)\n", n_in, ws_size, (size_t)WS_END); grid = -1; return; }
        int dev = 0, cus = 0, per_cu = 0;
        hipGetDevice(&dev);
        hipDeviceGetAttribute(&cus, hipDeviceAttributeMultiprocessorCount, dev);
        hipFuncSetAttribute((const void*)fwd_megakernel, hipFuncAttributeMaxDynamicSharedMemorySize, LDS_BYTES);
        hipOccupancyMaxActiveBlocksPerMultiprocessor(&per_cu, (const void*)fwd_megakernel, NTHREADS, LDS_BYTES);
        if (per_cu < 1) { fprintf(stderr, "kernel_launch: occupancy query says %d blocks per CU\n", per_cu); per_cu = 1; }
        if (per_cu > 1) per_cu = 1;
        grid = cus * per_cu;
        if (grid != 256) { fprintf(stderr, "kernel_launch: this kernel needs exactly 256 co-resident workgroups (got %d)\n", grid); if (grid > 256) grid = 256; }
        fprintf(stderr, "kernel_launch: grid %d (cus %d), ws %zu\n", grid, cus, ws_size);
    }
    if (grid < 0) return;
    hipMemsetAsync((char*)d_ws + OFF_CTL, 0, 65536, stream);
    Params p{};
    for (int i = 0; i < 36; ++i) p.in[i] = (const float*)d_in[i];
    p.out = (float*)d_out; p.ws = (unsigned char*)d_ws;
    void* args[] = {&p};
    hipError_t e = hipLaunchCooperativeKernel((const void*)fwd_megakernel, dim3(grid), dim3(NTHREADS), args, LDS_BYTES, stream);
    if (e != hipSuccess) fprintf(stderr, "cooperative launch failed: %s (grid %d)\n", hipGetErrorString(e), grid);
}
```

```cpp
#include <hip/hip_runtime.h>
#include <hip/hip_cooperative_groups.h>
#include <cstdio>
#include <cstdint>
namespace cg = cooperative_groups;

#define LAS __attribute__((address_space(3)))
typedef unsigned short bf16_t;
typedef short bf16x8 __attribute__((ext_vector_type(8)));
typedef float f32x4 __attribute__((ext_vector_type(4)));
typedef float f32x2 __attribute__((ext_vector_type(2)));
typedef unsigned u32x4 __attribute__((ext_vector_type(4)));
typedef unsigned u32x2 __attribute__((ext_vector_type(2)));

constexpr int D = 1024, NB = 8, L = 8192, NT = NB * L, DEPTH = 2;
constexpr int IN_D = 3456, IN_DP = 3584;
constexpr int C_HX0 = 0, C_HX1 = 256, C_HV = 512, C_RR = 768, C_RK = 1280, C_RV = 1792, C_RG = 2304, C_RW = 2432, C_RA = 2560, C_NQ = 2688, C_NK = 2944, C_NV = 3200;
constexpr int NEXP = 32, FF = 512;
constexpr float NORM_EPS = 1e-6f;

constexpr size_t MiB = 1u << 20;
constexpr size_t OFF_CTL = 0;
constexpr size_t OFF_WTIN = 1 * MiB;
constexpr size_t OFF_WTOUT = 15 * MiB;
constexpr size_t OFF_RS = 19 * MiB;
constexpr size_t OFF_RGW = 20 * MiB;
constexpr size_t OFF_LTOK = 21 * MiB;
constexpr size_t OFF_LGATE = 29 * MiB;
constexpr size_t OFF_FILT = 37 * MiB;
constexpr size_t OFF_MOEW = 69 * MiB;
constexpr size_t OFF_W13T = OFF_MOEW, OFF_W2T = OFF_MOEW + 64 * MiB;
constexpr size_t OFF_ZT = OFF_MOEW;
constexpr size_t OFF_YT = OFF_MOEW + 32 * MiB;
constexpr size_t OFF_XB = 165 * MiB;
constexpr size_t OFF_MIX = 869 * MiB;
constexpr size_t OFF_PROJ = 293 * MiB;
constexpr size_t OFF_ACT = OFF_PROJ;
constexpr size_t OFF_YBUF = OFF_PROJ + 136 * MiB;
constexpr size_t OFF_YF = 741 * MiB;
constexpr size_t OFF_YB = 805 * MiB;
constexpr size_t OFF_BON = 997 * MiB;
constexpr size_t OFF_LRS = 1001 * MiB;
constexpr size_t WS_END = 1009 * MiB;
constexpr int LCAP = 65536;

constexpr int LDS_BYTES = 163840;
constexpr int NTHREADS = 512;

struct Params { const float* in[36]; float* out; unsigned char* ws; };

__device__ __forceinline__ float bf2f(unsigned b) { return __uint_as_float(b << 16); }
typedef __bf16 bf16x2_t __attribute__((ext_vector_type(2)));
__device__ __forceinline__ unsigned f2bf(float f) { return (unsigned)__builtin_bit_cast(unsigned short, (__bf16)f); }
__device__ __forceinline__ unsigned pk2(float lo, float hi) { const f32x2 v = {lo, hi}; return __builtin_bit_cast(unsigned, __builtin_convertvector(v, bf16x2_t)); }
#define DPPF(v, ctrl) __int_as_float(__builtin_amdgcn_update_dpp(0, __float_as_int(v), (ctrl), 0xF, 0xF, true))
__device__ __forceinline__ float rdlane(float v, int l) { return __int_as_float(__builtin_amdgcn_readlane(__float_as_int(v), l)); }
__device__ __forceinline__ float wave_sum(float v) {
    v += DPPF(v, 0xB1); v += DPPF(v, 0x4E); v += DPPF(v, 0x141); v += DPPF(v, 0x140);
    return (rdlane(v, 0) + rdlane(v, 16)) + (rdlane(v, 32) + rdlane(v, 48));
}
__device__ __forceinline__ float sum8(float v) { v += DPPF(v, 0xB1); v += DPPF(v, 0x4E); v += DPPF(v, 0x141); return v; }
__device__ __forceinline__ void unpack8(const u32x4 w, float* f) {
    f[0] = bf2f(w.x & 0xffffu); f[1] = __uint_as_float(w.x & 0xffff0000u);
    f[2] = bf2f(w.y & 0xffffu); f[3] = __uint_as_float(w.y & 0xffff0000u);
    f[4] = bf2f(w.z & 0xffffu); f[5] = __uint_as_float(w.z & 0xffff0000u);
    f[6] = bf2f(w.w & 0xffffu); f[7] = __uint_as_float(w.w & 0xffff0000u);
}
__device__ __forceinline__ float frcp(float x) { return __builtin_amdgcn_rcpf(x); }
__device__ __forceinline__ float ftanh(float x) { const float e = __expf(2.0f * x); return 1.0f - 2.0f * frcp(e + 1.0f); }
#define LDS_WAIT() asm volatile("s_waitcnt lgkmcnt(0)" ::: "memory")
__device__ __forceinline__ int opaque_tid(int wvx) { int ln; asm volatile("v_mbcnt_lo_u32_b32 %0, -1, 0\n\tv_mbcnt_hi_u32_b32 %0, -1, %0" : "=v"(ln)); return wvx * 64 + ln; }

namespace pg8 {
constexpr int BM = 256, BK = 64, HALF = 128, HTB = HALF * BK * 2, STAGE_BYTES = 8 * HTB;
__device__ __forceinline__ int lds_byte(int r, int c) { const int st = (r >> 4) * 2 + (c >> 5), rr = r & 15, cc = c & 31, ob = rr * 64 + cc * 2; return st * 1024 + (ob ^ (((ob >> 9) & 1) << 5)); }
__device__ __forceinline__ void stage_rc(int b, int& R, int& C) { const int st = b / 1024, sb = b % 1024, swz = sb ^ (((sb >> 9) & 1) << 5); R = (st >> 1) * 16 + swz / 64; C = (st & 1) * 32 + (swz % 64) / 2; }
__device__ __forceinline__ int perm32(int rho) { const int n = rho >> 4, i = rho & 15; return 8 * (i >> 2) + 4 * n + (i & 3); }
__device__ __forceinline__ unsigned cvt_pk_bf16(float lo, float hi) { return pk2(lo, hi); }

struct Unit { const char* A; const char* B; int pm, pn, e, cnt; };

template <class Epi, class Sched, bool GATHER>
__device__ __forceinline__ void gemm_phase(LAS unsigned char* lds, const int K, const Sched& S, const Epi& E, const int wvx) {
    const int tid = opaque_tid(wvx), wid = __builtin_amdgcn_readfirstlane(tid >> 6), lane = tid & 63, wr = wid >> 2, wc = wid & 3, fr = lane & 15, fq = lane >> 4;
    const int nt = K / BK;
    int Rr[2], Cc[2];
    unsigned voffB[2];
#pragma unroll
    for (int i = 0; i < 2; ++i) { stage_rc(tid * 16 + i * 8192, Rr[i], Cc[i]); const int Rb = Epi::PERM ? ((Rr[i] & ~31) + perm32(Rr[i] & 31)) : Rr[i];
        voffB[i] = (unsigned)(Rb * K + Cc[i]) * 2u; }
    const size_t kstep = (size_t)(BK * 2);
    const size_t hstep = (size_t)HALF * K * 2;
    const unsigned ldsw = (unsigned)wid * 1024u;
    const int aoff = lds_byte(wr * 64 + fr, fq * 8), boff = lds_byte(wc * 32 + fr, fq * 8);
#define PG8_SA(b, h) (((b) * 2 + (h)) * HTB)
#define PG8_SB(b, h) ((4 + (b) * 2 + (h)) * HTB)
#define PG8_STAGE(bufoff, gbase, voff) do { _Pragma("unroll") for (int _i = 0; _i < 2; ++_i) \
        __builtin_amdgcn_global_load_lds((const unsigned*)((const char*)(gbase) + (voff)[_i]), (LAS unsigned*)(lds + (bufoff) + ldsw + _i * 8192), 16, 0, 0); } while (0)
#define PG8_LDA(dst, b, h) do { _Pragma("unroll") for (int m = 0; m < 4; ++m) _Pragma("unroll") for (int k = 0; k < 2; ++k) dst[m][k] = *(const LAS bf16x8*)(lds + PG8_SA(b, h) + aoff + m * 2048 + k * 1024); } while (0)
#define PG8_LDB(dst, b, h) do { _Pragma("unroll") for (int n = 0; n < 2; ++n) _Pragma("unroll") for (int k = 0; k < 2; ++k) dst[n][k] = *(const LAS bf16x8*)(lds + PG8_SB(b, h) + boff + n * 2048 + k * 1024); } while (0)
#define PG8_MMA(ai, bj, At, Bt) do { __builtin_amdgcn_s_setprio(1); _Pragma("unroll") for (int m = 0; m < 4; ++m) _Pragma("unroll") for (int n = 0; n < 2; ++n) _Pragma("unroll") for (int k = 0; k < 2; ++k) \
        acc[ai][bj][m][n] = __builtin_amdgcn_mfma_f32_16x16x32_bf16(Bt[n][k], At[m][k], acc[ai][bj][m][n], 0, 0, 0); __builtin_amdgcn_s_setprio(0); } while (0)
#define PG8_WAIT_V(n) asm volatile("s_waitcnt vmcnt(" #n ")" ::: "memory")
#define PG8_WAIT_L(n) asm volatile("s_waitcnt lgkmcnt(" #n ")" ::: "memory")
#define PG8_BAR __builtin_amdgcn_s_barrier()
#define PG8_SCHED __builtin_amdgcn_sched_barrier(0)
    Unit cur, nxt; int ui = 0;
    if (!S.next(0, cur)) return;
    f32x4 acc[2][2][4][2];
#pragma unroll
    for (int a = 0; a < 2; ++a)
#pragma unroll
        for (int b = 0; b < 2; ++b)
#pragma unroll
            for (int m = 0; m < 4; ++m)
#pragma unroll
                for (int n = 0; n < 2; ++n) acc[a][b][m][n] = (f32x4){0.f, 0.f, 0.f, 0.f};
    bf16x8 At[4][2], B0[2][2], B1[2][2];
    typename Epi::Pre epre;
    unsigned vA[2][2];
    LAS u32x4* stash = (LAS u32x4*)(lds + STAGE_BYTES) + tid;
    if (GATHER) S.aoff(cur, tid, vA);
    else {
#pragma unroll
        for (int h = 0; h < 2; ++h)
#pragma unroll
            for (int i = 0; i < 2; ++i) vA[h][i] = (unsigned)((h * HALF + Rr[i]) * K + Cc[i]) * 2u;
    }
    const char* cA = cur.A; const char* cB = cur.B;
    PG8_STAGE(PG8_SB(0, 0), cB, voffB); PG8_STAGE(PG8_SB(0, 1), cB + hstep, voffB); PG8_STAGE(PG8_SA(0, 0), cA, vA[0]); PG8_STAGE(PG8_SA(0, 1), cA, vA[1]);
    if (wr == 1) PG8_BAR;
    PG8_WAIT_V(2); PG8_BAR;
    PG8_STAGE(PG8_SB(1, 0), cB + kstep, voffB); PG8_STAGE(PG8_SA(1, 0), cA + kstep, vA[0]); PG8_STAGE(PG8_SB(1, 1), cB + hstep + kstep, voffB);
    PG8_WAIT_V(6); PG8_BAR;
    for (;;) {
        const bool has_next = S.next(ui + 1, nxt);
        const char* nA = has_next ? nxt.A : cA; const char* nB = has_next ? nxt.B : cB;
        if (GATHER) { unsigned vn[2][2];
            if (has_next) { S.aoff(nxt, tid, vn); *stash = (u32x4){vn[0][0], vn[0][1], vn[1][0], vn[1][1]}; }
            else *stash = (u32x4){vA[0][0], vA[0][1], vA[1][0], vA[1][1]}; }
        for (int t = 0; t < nt; t += 2) {
            const bool last = (t == nt - 2);
            const char* a1 = cA + (size_t)(t + 1) * kstep;
            const char* a2 = last ? nA : cA + (size_t)(t + 2) * kstep; const char* b2 = last ? nB : cB + (size_t)(t + 2) * kstep;
            const char* a3 = a2 + kstep; const char* b3 = b2 + kstep;
            if (last) E.prefetch(epre, cur, wr, wc, fr, fq);
            PG8_LDB(B0, 0, 0); PG8_LDB(B1, 0, 1); PG8_SCHED; PG8_LDA(At, 0, 0); PG8_STAGE(PG8_SA(1, 1), a1, vA[1]);
            if (GATHER && last) { const u32x4 sv = *stash; vA[0][0] = sv.x; vA[0][1] = sv.y; vA[1][0] = sv.z; vA[1][1] = sv.w; }
            PG8_WAIT_V(8); PG8_WAIT_L(0); PG8_BAR; PG8_MMA(0, 0, At, B0); PG8_MMA(0, 1, At, B1); PG8_BAR; PG8_SCHED;
            PG8_LDA(At, 0, 1); PG8_STAGE(PG8_SB(0, 0), b2, voffB); PG8_STAGE(PG8_SB(0, 1), b2 + hstep, voffB); PG8_STAGE(PG8_SA(0, 0), a2, vA[0]);
            PG8_WAIT_V(8); PG8_WAIT_L(0); PG8_BAR; PG8_MMA(1, 0, At, B0); PG8_MMA(1, 1, At, B1); PG8_BAR; PG8_SCHED;
            PG8_LDB(B0, 1, 0); PG8_LDB(B1, 1, 1); PG8_SCHED; PG8_LDA(At, 1, 0); PG8_STAGE(PG8_SA(0, 1), a2, vA[1]);
            PG8_WAIT_V(8); PG8_WAIT_L(0); PG8_BAR; PG8_MMA(0, 0, At, B0); PG8_MMA(0, 1, At, B1); PG8_BAR; PG8_SCHED;
            PG8_LDA(At, 1, 1); PG8_STAGE(PG8_SB(1, 0), b3, voffB); PG8_STAGE(PG8_SB(1, 1), b3 + hstep, voffB); PG8_STAGE(PG8_SA(1, 0), a3, vA[0]);
            PG8_WAIT_V(8); PG8_WAIT_L(0); PG8_BAR; PG8_MMA(1, 0, At, B0); PG8_MMA(1, 1, At, B1); PG8_BAR; PG8_SCHED;
        }
        if (wr == 0) PG8_BAR;
        {
            Unit eu = cur; int efr = fr, efq = fq;
            eu.pm = __builtin_amdgcn_readfirstlane(eu.pm); eu.pn = __builtin_amdgcn_readfirstlane(eu.pn); eu.e = __builtin_amdgcn_readfirstlane(eu.e); eu.cnt = __builtin_amdgcn_readfirstlane(eu.cnt);
            asm volatile("" : "+s"(eu.pm), "+s"(eu.pn), "+s"(eu.e), "+s"(eu.cnt), "+v"(efr), "+v"(efq));
            E(acc, eu, wr, wc, efr, efq, epre);
        }
        if (!has_next) break;
#pragma unroll
        for (int a = 0; a < 2; ++a)
#pragma unroll
            for (int b = 0; b < 2; ++b)
#pragma unroll
                for (int m = 0; m < 4; ++m)
#pragma unroll
                    for (int n = 0; n < 2; ++n) acc[a][b][m][n] = (f32x4){0.f, 0.f, 0.f, 0.f};
        cur = nxt; cA = nA; cB = nB; ++ui;
        if (wr == 1) PG8_BAR;
    }
    PG8_WAIT_V(0);
    PG8_BAR;
#undef PG8_SA
#undef PG8_SB
#undef PG8_STAGE
#undef PG8_LDA
#undef PG8_LDB
#undef PG8_MMA
#undef PG8_WAIT_V
#undef PG8_WAIT_L
#undef PG8_BAR
#undef PG8_SCHED
}
}

struct DenseSched {
    const bf16_t* A; const bf16_t* Bt; int K, nM, nN, nwg, G, c;
    __device__ void init(const bf16_t* A_, const bf16_t* Bt_, int M, int N, int K_, int G_, int c_) { A = A_; Bt = Bt_; K = K_; nM = M / 256; nN = N / 256; nwg = nM * nN; G = G_; c = c_; }
    __device__ __forceinline__ bool next(int i, pg8::Unit& u) const {
        const long Lx = (long)i * G + c; if (Lx >= nwg) return false;
        int wgid = (int)Lx; { const int q = nwg / 8, r = nwg % 8, xcd = wgid % 8, off = wgid / 8; wgid = (xcd < r ? xcd * (q + 1) : r * (q + 1) + (xcd - r) * q) + off; }
        const int nig = 8 * nN, gid = wgid / nig, fm = gid * 8, gsz = (nM - fm) < 8 ? (nM - fm) : 8;
        u.pm = fm + ((wgid % nig) % gsz); u.pn = (wgid % nig) / gsz; u.e = 0; u.cnt = 0;
        u.A = (const char*)A + (size_t)u.pm * 256 * K * 2; u.B = (const char*)Bt + (size_t)u.pn * 256 * K * 2; return true;
    }
    __device__ __forceinline__ void aoff(const pg8::Unit&, int, unsigned (&)[2][2]) const {}
};
struct MoeSched {
    const bf16_t* A; const bf16_t* Bt; size_t bstride;
    const int* ltok;
    LAS int* tp;
    int K, G, c, total;
    __device__ void init(const int* cnt_, const bf16_t* A_, const bf16_t* Bt_, size_t bstride_, const int* ltok_, int K_, int G_, int c_, LAS int* lds_tab, int tid) {
        A = A_; Bt = Bt_; bstride = bstride_; ltok = ltok_; K = K_; G = G_; c = (G_ % 8 == 0) ? (c_ & 7) * (G_ >> 3) + (c_ >> 3) : c_;
        tp = lds_tab;
        __syncthreads();
        if (tid < 32) tp[64 + tid] = cnt_[tid];
        __syncthreads();
        if (tid == 0) { int t = 0; for (int e = 0; e < NEXP; ++e) { tp[e] = t; t += (tp[64 + e] + 255) >> 8; } tp[32] = t; }
        __syncthreads();
        total = __builtin_amdgcn_readfirstlane(tp[32]);
    }
    __device__ __forceinline__ bool next(int i, pg8::Unit& u) const {
        const long Lx = (long)i * G + c; if (Lx >= (long)total * 4) return false;
        const int ti = (int)(Lx >> 2); u.pn = (int)(Lx & 3);
        int ln; asm volatile("v_mbcnt_lo_u32_b32 %0, -1, 0\n\tv_mbcnt_hi_u32_b32 %0, -1, %0" : "=v"(ln));
        const int l5 = ln & 31; const int lo = tp[l5], hi = tp[l5 + 1];
        const unsigned long long mask = __builtin_amdgcn_ballot_w64(lo <= ti && ti < hi);
        const int e = __builtin_amdgcn_readfirstlane((int)__builtin_ctzll(mask) & 31);
        const int base = __builtin_amdgcn_readfirstlane(tp[e]), ce = __builtin_amdgcn_readfirstlane(tp[64 + e]);
        u.e = e; u.pm = ti; u.cnt = ce - (ti - base) * 256;
        u.A = ltok ? (const char*)A : (const char*)A + (size_t)ti * 256 * K * 2;
        u.B = (const char*)(Bt + (size_t)e * bstride) + (size_t)u.pn * 256 * K * 2;
        u.pm = ti | ((ti - base) << 16);
        return true;
    }
    __device__ __forceinline__ void aoff(const pg8::Unit& u, int tid, unsigned (&v)[2][2]) const {
        const int lt = u.pm >> 16; int Rr[2], Cc[2]; pg8::stage_rc(tid * 16, Rr[0], Cc[0]); pg8::stage_rc(tid * 16 + 8192, Rr[1], Cc[1]);
        int tk[2][2];
#pragma unroll
        for (int h = 0; h < 2; ++h)
#pragma unroll
            for (int i = 0; i < 2; ++i) { const int r = h * 128 + Rr[i]; tk[h][i] = ltok[(size_t)u.e * LCAP + lt * 256 + (r < u.cnt ? r : 0)]; }
#pragma unroll
        for (int h = 0; h < 2; ++h)
#pragma unroll
            for (int i = 0; i < 2; ++i) { const int r = h * 128 + Rr[i]; const int tok = (r < u.cnt) ? (tk[h][i] >> 1) : 0; v[h][i] = (unsigned)(tok * K + Cc[i]) * 2u; }
    }
};

struct EpiProj {
    static constexpr bool PERM = true;
    struct Pre { float rs[8]; };
    bf16_t* O; const float* rs;
    __device__ __forceinline__ void prefetch(Pre& pr, const pg8::Unit& u, int wr, int wc, int fr, int fq) const {
        const int row0 = (u.pm & 0xffff) * 256 + wr * 64 + fr;
#pragma unroll
        for (int ai = 0; ai < 2; ++ai)
#pragma unroll
            for (int m = 0; m < 4; ++m) pr.rs[ai * 4 + m] = rs[row0 + ai * 128 + m * 16];
    }
    __device__ __forceinline__ void operator()(const f32x4 (&acc_)[2][2][4][2], const pg8::Unit& u, int wr, int wc, int fr, int fq, const Pre& pr) const {
        const int row0 = u.pm * 256 + wr * 64 + fr, col0 = u.pn * 256 + wc * 32 + 8 * fq;
        f32x4 (&acc)[2][2][4][2] = const_cast<f32x4 (&)[2][2][4][2]>(acc_);
        const bool act = (u.pn == 9);
        if (act) {
#pragma unroll
            for (int ai = 0; ai < 2; ++ai)
#pragma unroll
                for (int m = 0; m < 4; ++m) { const float s = pr.rs[ai * 4 + m];
#pragma unroll
                    for (int n = 0; n < 2; ++n)
#pragma unroll
                        for (int e = 0; e < 4; ++e) { acc[ai][0][m][n][e] = frcp(1.0f + __expf(-acc[ai][0][m][n][e] * s)); acc[ai][1][m][n][e] = ftanh(acc[ai][1][m][n][e] * s); } }
            asm volatile("" ::: "memory");
        }
#pragma unroll
        for (int ai = 0; ai < 2; ++ai)
#pragma unroll
            for (int m = 0; m < 4; ++m) { const int row = row0 + ai * 128 + m * 16; const float s = act ? 1.0f : pr.rs[ai * 4 + m]; bf16_t* rowp = O + (size_t)row * IN_DP + col0;
#pragma unroll
                for (int bj = 0; bj < 2; ++bj) { const f32x4 v0 = acc[ai][bj][m][0] * s, v1 = acc[ai][bj][m][1] * s;
                    u32x4 w; w.x = pg8::cvt_pk_bf16(v0[0], v0[1]); w.y = pg8::cvt_pk_bf16(v0[2], v0[3]); w.z = pg8::cvt_pk_bf16(v1[0], v1[1]); w.w = pg8::cvt_pk_bf16(v1[2], v1[3]);
                    *(u32x4*)(rowp + bj * 128) = w; } }
    }
};
struct EpiRes {
    static constexpr bool PERM = true;
    struct Pre { int dummy; };
    bf16_t* x16;
    __device__ __forceinline__ void prefetch(Pre&, const pg8::Unit&, int, int, int, int) const {}
    __device__ __forceinline__ void operator()(const f32x4 (&acc)[2][2][4][2], const pg8::Unit& u, int wr, int wc, int fr, int fq, const Pre&) const {
        const int row0 = u.pm * 256 + wr * 64 + fr, col0 = u.pn * 256 + wc * 32 + 8 * fq;
#pragma unroll
        for (int ai = 0; ai < 2; ++ai) {
            u32x4 braw[4][2];
#pragma unroll
            for (int m = 0; m < 4; ++m)
#pragma unroll
                for (int bj = 0; bj < 2; ++bj) braw[m][bj] = *(const u32x4*)(x16 + (size_t)(row0 + ai * 128 + m * 16) * D + col0 + bj * 128);
            asm volatile("" ::: "memory");
#pragma unroll
            for (int m = 0; m < 4; ++m) { const size_t off = (size_t)(row0 + ai * 128 + m * 16) * D + col0;
#pragma unroll
                for (int bj = 0; bj < 2; ++bj) { const f32x4 v0 = acc[ai][bj][m][0], v1 = acc[ai][bj][m][1]; float bb[8]; unpack8(braw[m][bj], bb);
                    u32x4 w; w.x = pk2(bb[0] + v0[0], bb[1] + v0[1]); w.y = pk2(bb[2] + v0[2], bb[3] + v0[3]); w.z = pk2(bb[4] + v1[0], bb[5] + v1[1]); w.w = pk2(bb[6] + v1[2], bb[7] + v1[3]);
                    *(u32x4*)(x16 + off + bj * 128) = w; } }
            asm volatile("" ::: "memory");
        }
    }
};
struct EpiMoe1 {
    static constexpr bool PERM = true;
    struct Pre { int dummy; };
    bf16_t* act; const float* lrs;
    __device__ __forceinline__ void prefetch(Pre&, const pg8::Unit&, int, int, int, int) const {}
    __device__ __forceinline__ void operator()(const f32x4 (&acc)[2][2][4][2], const pg8::Unit& u, int wr, int wc, int fr, int fq, const Pre&) const {
        const int ti = u.pm & 0xffff, lt = u.pm >> 16;
        const int r0 = wr * 64 + fr, col0 = u.pn * 256 + wc * 32 + 8 * fq;
        float sv[8];
#pragma unroll
        for (int q = 0; q < 8; ++q) { const int r = r0 + (q >> 2) * 128 + (q & 3) * 16; sv[q] = (r < u.cnt) ? lrs[(size_t)u.e * LCAP + lt * 256 + r] : 0.f; }
        asm volatile("" ::: "memory");
#pragma unroll
        for (int ai = 0; ai < 2; ++ai)
#pragma unroll
            for (int m = 0; m < 4; ++m) { const int r = r0 + ai * 128 + m * 16;
                const float s = sv[ai * 4 + m];
                bf16_t* rowp = act + ((size_t)ti * 256 + r) * FF + (col0 >> 1);
#pragma unroll
                for (int bj = 0; bj < 2; ++bj) { const f32x4 v0 = acc[ai][bj][m][0] * s, v1 = acc[ai][bj][m][1] * s;
                    const float o0 = v0[0] * frcp(1.f + __expf(-v0[0])) * v0[1], o1 = v0[2] * frcp(1.f + __expf(-v0[2])) * v0[3];
                    const float o2 = v1[0] * frcp(1.f + __expf(-v1[0])) * v1[1], o3 = v1[2] * frcp(1.f + __expf(-v1[2])) * v1[3];
                    u32x2 w; w.x = pg8::cvt_pk_bf16(o0, o1); w.y = pg8::cvt_pk_bf16(o2, o3);
                    *(u32x2*)(rowp + bj * 64) = w; } }
    }
};
struct EpiMoe2 {
    static constexpr bool PERM = true;
    struct Pre { int dummy; };
    bf16_t* ybuf; const int* ltok; const float* lgate;
    __device__ __forceinline__ void prefetch(Pre&, const pg8::Unit&, int, int, int, int) const {}
    __device__ __forceinline__ void operator()(const f32x4 (&acc)[2][2][4][2], const pg8::Unit& u, int wr, int wc, int fr, int fq, const Pre&) const {
        const int lt = u.pm >> 16, r0 = wr * 64 + fr, col0 = u.pn * 256 + wc * 32 + 8 * fq;
        int dv[8]; float gv[8];
#pragma unroll
        for (int q = 0; q < 8; ++q) { const int r = r0 + (q >> 2) * 128 + (q & 3) * 16; const bool ok = r < u.cnt;
            const size_t li = (size_t)u.e * LCAP + lt * 256 + (ok ? r : 0); const int d = ltok[li]; const float g = lgate[li];
            dv[q] = ok ? d : -1; gv[q] = g; }
        asm volatile("" ::: "memory");
#pragma unroll
        for (int ai = 0; ai < 2; ++ai)
#pragma unroll
            for (int m = 0; m < 4; ++m) { const int dest = dv[ai * 4 + m];
                if (dest >= 0) { const float g = gv[ai * 4 + m];
                    bf16_t* rowp = ybuf + (size_t)dest * D + col0;
#pragma unroll
                    for (int bj = 0; bj < 2; ++bj) { const f32x4 v0 = acc[ai][bj][m][0] * g, v1 = acc[ai][bj][m][1] * g;
                        u32x4 w; w.x = pg8::cvt_pk_bf16(v0[0], v0[1]); w.y = pg8::cvt_pk_bf16(v0[2], v0[3]); w.z = pg8::cvt_pk_bf16(v1[0], v1[1]); w.w = pg8::cvt_pk_bf16(v1[2], v1[3]);
                        *(u32x4*)(rowp + bj * 128) = w; } } }
    }
};

__device__ __forceinline__ void transpose_item(const float* __restrict__ W, int K, int N, bf16_t* WT, int rmul, int radd, const float* __restrict__ g, LAS float* scr, int item, int lane) {
    const int nblk = N / 32, kb = item / nblk, nb = item % nblk, k0 = 64 * kb, n0 = 32 * nb;
    f32x4 v[8]; float gv[8];
#pragma unroll
    for (int i = 0; i < 8; ++i) { v[i] = *(const f32x4*)(W + (size_t)(k0 + 8 * i + (lane >> 3)) * N + n0 + 4 * (lane & 7)); gv[i] = g ? g[k0 + 8 * i + (lane >> 3)] : 1.0f; }
#pragma unroll
    for (int i = 0; i < 8; ++i) { const int kk = 8 * i + (lane >> 3); *(LAS f32x4*)(scr + kk * 36 + 4 * (lane & 7)) = v[i] * gv[i]; }
    LDS_WAIT(); asm volatile("" ::: "memory");
    const int c = lane & 7;
#pragma unroll
    for (int j = 0; j < 4; ++j) { const int n = (lane >> 3) + 8 * j; const LAS float* s = scr + (8 * c) * 36 + n;
        u32x4 o; o.x = pk2(s[0 * 36], s[1 * 36]); o.y = pk2(s[2 * 36], s[3 * 36]); o.z = pk2(s[4 * 36], s[5 * 36]); o.w = pk2(s[6 * 36], s[7 * 36]);
        *(u32x4*)(WT + (size_t)(rmul * (n0 + n) + radd) * K + k0 + 8 * c) = o; }
    LDS_WAIT(); asm volatile("" ::: "memory");
}

__device__ __forceinline__ void filt_item8(const Params& p, int l, int m0, int lane, float* G) {
    const float* w1 = p.in[5] + l * 33 * 64; const float* w2 = p.in[7] + l * 4096; const float* w3 = p.in[9] + l * 4096; const float* wout = p.in[11] + l * 64 * 512;
    const float b1v = p.in[6][l * 64 + lane], b2v = p.in[8][l * 64 + lane], b3v = p.in[10][l * 64 + lane], fr = p.in[12][l * 64 + lane];
    float hcur[8], acc[8];
    {
#pragma unroll
        for (int j = 0; j < 8; ++j) { const int m = m0 + j; float zl = 0.f;
            const float wv = (6.283185307179586f / 8192.0f) * (float)m; const float fstep = (15.0f - 1e-4f) / 15.0f;
            if (lane == 0) zl = (float)m / 8191.0f; else if (lane <= 16) zl = cosf((1e-4f + (float)(lane - 1) * fstep) * wv); else if (lane <= 32) zl = -sinf((1e-4f + (float)(lane - 17) * fstep) * wv);
            hcur[j] = zl; acc[j] = b1v; }
        float wc[33];
#pragma unroll
        for (int i = 0; i < 33; ++i) wc[i] = w1[i * 64 + lane];
#pragma unroll
        for (int i = 0; i < 33; ++i)
#pragma unroll
            for (int j = 0; j < 8; ++j) acc[j] += rdlane(hcur[j], i) * wc[i];
#pragma unroll
        for (int j = 0; j < 8; ++j) { hcur[j] = sinf(fr * acc[j]); acc[j] = b2v; }
    }
    asm volatile("" ::: "memory");
    {   float wc[64];
#pragma unroll
        for (int i = 0; i < 64; ++i) wc[i] = w2[i * 64 + lane];
#pragma unroll
        for (int i = 0; i < 64; ++i)
#pragma unroll
            for (int j = 0; j < 8; ++j) acc[j] += rdlane(hcur[j], i) * wc[i];
#pragma unroll
        for (int j = 0; j < 8; ++j) { hcur[j] = sinf(fr * acc[j]); acc[j] = b3v; }
    }
    asm volatile("" ::: "memory");
    {   float wc[64];
#pragma unroll
        for (int i = 0; i < 64; ++i) wc[i] = w3[i * 64 + lane];
#pragma unroll
        for (int i = 0; i < 64; ++i)
#pragma unroll
            for (int j = 0; j < 8; ++j) acc[j] += rdlane(hcur[j], i) * wc[i];
#pragma unroll
        for (int j = 0; j < 8; ++j) hcur[j] = sinf(fr * acc[j]);
    }
    asm volatile("" ::: "memory");
    float (&h3)[8] = hcur;
    float o[8][8];
#pragma unroll
    for (int j = 0; j < 8; ++j)
#pragma unroll
        for (int q = 0; q < 8; ++q) o[j][q] = 0.f;
#pragma unroll 2
    for (int i = 0; i < 64; ++i) { float wo[8];
#pragma unroll
        for (int q = 0; q < 8; ++q) wo[q] = wout[i * 512 + q * 64 + lane];
#pragma unroll
        for (int j = 0; j < 8; ++j) { const float hv = rdlane(h3[j], i);
#pragma unroll
            for (int q = 0; q < 8; ++q) o[j][q] += hv * wo[q]; } }
    const float dmin = -3.0701134573253944f, dmax = -15.350567286626972f;
#pragma unroll
    for (int q = 0; q < 8; ++q) { const int n = q * 64 + lane, d = n >> 8, c = n & 255;
        const float delta = fabsf(dmin + (float)c * ((dmax - dmin) / 255.0f));
        float v[8];
#pragma unroll
        for (int j = 0; j < 8; ++j) v[j] = o[j][q] * expf(-((float)(m0 + j) / 8191.0f) * delta);
        float* dst = G + (size_t)c * 16384 + d * 8192 + m0;
        *(f32x4*)dst = (f32x4){v[0], v[1], v[2], v[3]}; *(f32x4*)(dst + 4) = (f32x4){v[4], v[5], v[6], v[7]}; }
}

__device__ __forceinline__ void phase_prologue(const Params& p, LAS unsigned char* lds, int G_, int bid, const int wvx) {
    const int tid = opaque_tid(wvx), lane = tid & 63, wave = tid >> 6;
    const int gw = bid * 8 + wave, NGW = G_ * 8;
    LAS float* scr = (LAS float*)(lds + wave * 16384);
    unsigned char* ws = p.ws;
    for (int it = gw; it < 16 * 108; it += NGW) transpose_item(p.in[2], D, IN_D, (bf16_t*)(ws + OFF_WTIN), 1, 0, p.in[1], scr, it, lane);
    for (int i = bid * NTHREADS + tid; i < 2 * 128 * D / 8; i += G_ * NTHREADS) { const int l = i / (128 * D / 8), r = i % (128 * D / 8);
        *(u32x4*)((bf16_t*)(ws + OFF_WTIN) + (size_t)l * IN_DP * D + (size_t)IN_D * D + (size_t)r * 8) = (u32x4){0u, 0u, 0u, 0u}; }
    for (int i = bid * NTHREADS + tid; i < 2 * 48 * D; i += G_ * NTHREADS) { const int l = i / (48 * D), r = i % (48 * D), o = r / D, k = r % D;
        const float g = p.in[27][l * D + k]; const float w = g * ((o < 4) ? p.in[28][((size_t)l * D + k) * 4 + o] : (o < 36 ? p.in[30][((size_t)l * D + k) * 32 + (o - 4)] : 0.f));
        const unsigned hi = f2bf(w); const float lo = w - bf2f(hi);
        bf16_t* rg = (bf16_t*)(ws + OFF_RGW) + (size_t)l * 2 * 48 * D; rg[o * D + k] = (bf16_t)hi; rg[48 * D + o * D + k] = (bf16_t)f2bf(lo); }
}
__device__ __forceinline__ void filters_all(const Params& p, int nwg, int rank, const int wvx) {
    const int tid = opaque_tid(wvx), lane = tid & 63, wave = tid >> 6;
    for (int it = rank * 8 + wave; it < 2 * (L / 8); it += nwg * 8) { const int l = it / (L / 8), m0 = (it % (L / 8)) * 8; filt_item8(p, l, m0, lane, (float*)(p.ws + OFF_FILT) + (size_t)l * 256 * 16384); }
}

__device__ __forceinline__ void moe_weights_chunk(const Params& p, LAS unsigned char* lds, int l, int chunk, const int wvx) {
    const int tid = opaque_tid(wvx), lane = tid & 63, wave = tid >> 6;
    LAS float* scr = (LAS float*)(lds + wave * 16384);
    bf16_t* W13 = (bf16_t*)(p.ws + OFF_W13T); bf16_t* W2 = (bf16_t*)(p.ws + OFF_W2T);
    const float* g = p.in[27] + l * D;
#pragma unroll 1
    for (int k = 0; k < 8; ++k) { const int it = chunk * 64 + wave * 8 + k;
        if (it >= NEXP * 768) { const int x = it - NEXP * 768;
            if (x < 16 * 108) transpose_item(p.in[2] + (size_t)D * IN_D, D, IN_D, (bf16_t*)(p.ws + OFF_WTIN) + (size_t)IN_DP * D, 1, 0, p.in[1] + D, scr, x, lane);
            else if (x < 16 * 108 + 1024) { const int y = x - 16 * 108, lo = y >> 9; transpose_item(p.in[26] + (size_t)lo * D * D, D, D, (bf16_t*)(p.ws + OFF_WTOUT) + (size_t)lo * D * D, 1, 0, nullptr, scr, y & 511, lane); }
            continue; }
        const int e = it / 768, r = it % 768;
        if (r < 256) transpose_item(p.in[32] + ((size_t)l * NEXP + e) * D * FF, D, FF, W13 + (size_t)e * 1024 * D, 2, 0, g, scr, r, lane);
        else if (r < 512) transpose_item(p.in[33] + ((size_t)l * NEXP + e) * D * FF, D, FF, W13 + (size_t)e * 1024 * D, 2, 1, g, scr, r - 256, lane);
        else transpose_item(p.in[34] + ((size_t)l * NEXP + e) * FF * D, FF, D, W2 + (size_t)e * D * FF, 1, 0, nullptr, scr, r - 512, lane); }
}
__device__ __forceinline__ void phase_rownorm(const float* x, bf16_t* xb, float* rs, int G_, int bid, const int wvx) {
    const int tid = opaque_tid(wvx), lane = tid & 63, wave = tid >> 6;
    for (int row = bid * 8 + wave; row < NT; row += G_ * 8) {
        const f32x4* xr = (const f32x4*)(x + (size_t)row * D) + lane; f32x4 v[4]; float s = 0.f;
#pragma unroll
        for (int j = 0; j < 4; ++j) { v[j] = xr[64 * j]; s += (v[j].x * v[j].x + v[j].y * v[j].y) + (v[j].z * v[j].z + v[j].w * v[j].w); }
        s = wave_sum(s);
        if (lane == 0) rs[row] = 1.0f / sqrtf(s * (1.0f / D) + NORM_EPS);
        u32x2* o = (u32x2*)(xb + (size_t)row * D) + lane;
#pragma unroll
        for (int j = 0; j < 4; ++j) o[64 * j] = (u32x2){pk2(v[j].x, v[j].y), pk2(v[j].z, v[j].w)};
    }
}

__device__ __forceinline__ void load8(const bf16_t* p, bool ok, float* f) { if (ok) { unpack8(*(const u32x4*)p, f); } else {
#pragma unroll
    for (int j = 0; j < 8; ++j) f[j] = 0.f; } }

__device__ __forceinline__ void hy_pre_unit(const Params& p, LAS unsigned char* lds, int l, int unit, const int wvx) {
    const int tid = opaque_tid(wvx);
    const int ct = unit & 3, tt = (unit >> 2) & 127, b = unit >> 9;
    const bf16_t* proj = (const bf16_t*)(p.ws + OFF_PROJ);
    bf16_t* zT = (bf16_t*)(p.ws + OFF_ZT);
    const float* cw = p.in[3] + l * 3 * 768; const float* cb = p.in[4] + l * 768;
    LAS bf16_t* tile = (LAS bf16_t*)lds;
    {
        const int tl = tid >> 3, c8 = (tid & 7) * 8, t = tt * 64 + tl, c = ct * 64 + c8;
        const bf16_t* row = proj + ((size_t)b * L + t) * IN_DP;
        float x1[3][8], vv[3][8];
        load8(row - IN_DP + C_HX1 + c, t > 0, x1[0]); load8(row + C_HX1 + c, true, x1[1]); load8(row + IN_DP + C_HX1 + c, t < L - 1, x1[2]);
        load8(row - IN_DP + C_HV + c, t > 0, vv[0]); load8(row + C_HV + c, true, vv[1]); load8(row + IN_DP + C_HV + c, t < L - 1, vv[2]);
#pragma unroll
        for (int j = 0; j < 8; ++j) { const int c1 = C_HX1 + c + j, c2 = C_HV + c + j;
            const float a = x1[0][j] * cw[c1] + x1[1][j] * cw[768 + c1] + x1[2][j] * cw[1536 + c1] + cb[c1];
            const float v = vv[0][j] * cw[c2] + vv[1][j] * cw[768 + c2] + vv[2][j] * cw[1536 + c2] + cb[c2];
            tile[(c8 + j) * 72 + tl] = (bf16_t)f2bf(a * v); }
    }
    __syncthreads();
    {
        const int cl = tid >> 3, seg = tid & 7;
        const u32x4 w = *(const LAS u32x4*)(tile + cl * 72 + seg * 8);
        *(u32x4*)(zT + ((size_t)(ct * 64 + cl) * NB + b) * L + tt * 64 + seg * 8) = w;
    }
    __syncthreads();
}

typedef float f32x16 __attribute__((ext_vector_type(16)));
__device__ __forceinline__ void hy_conv_unit(const Params& p, LAS unsigned char* lds, int l, int c, const int wvx) {
    const int tid = opaque_tid(wvx), lane = tid & 63, wave = __builtin_amdgcn_readfirstlane(tid >> 6);
    const float* G = (const float*)(p.ws + OFF_FILT) + ((size_t)l * 256 + c) * 16384;
    const bf16_t* zT = (const bf16_t*)(p.ws + OFF_ZT) + (size_t)c * NB * L;
    float* yT = (float*)(p.ws + OFF_YT) + (size_t)c * NB * L;
    LAS bf16_t* Re = (LAS bf16_t*)lds; LAS bf16_t* Ro = Re + 16384;
    LAS unsigned char* Zs = lds + 65536;
    constexpr int ZB = 8976;
    LAS float* red = (LAS float*)(lds + 65536 + 8 * ZB);
    __syncthreads();
    float ss = 0.f; const float GF0 = G[8192];
#pragma unroll 1
    for (int i0 = 0; i0 < 16384; i0 += 8 * NTHREADS) { float gq[8];
#pragma unroll
        for (int k = 0; k < 8; ++k) gq[k] = G[i0 + k * NTHREADS + tid];
#pragma unroll
        for (int k = 0; k < 8; ++k) { const int i = i0 + k * NTHREADS + tid; const float g = gq[k]; ss += g * g;
            if (i == 8192) { Ro[16383] = 0; Re[0] = 0; }
            else { const int dl = (i < 8192) ? i : (8192 - i); const bf16_t bv = (bf16_t)f2bf(i == 0 ? g + GF0 : g); Re[8192 - dl] = bv; Ro[8191 - dl] = bv; } } }
    ss = wave_sum(ss); if (lane == 0) red[wave] = ss;
    f32x16 acc[2][4];
#pragma unroll
    for (int mt = 0; mt < 2; ++mt)
#pragma unroll
        for (int i = 0; i < 4; ++i)
#pragma unroll
            for (int e = 0; e < 16; ++e) acc[mt][i][e] = 0.f;
    const int r = lane & 31, hh = lane >> 5;
#pragma unroll 1
    for (int h = 0; h < 2; ++h) {
        __syncthreads();
        { u32x4 zq[9]; int tq = tid; asm volatile("" : "+v"(tq));
#pragma unroll
          for (int k = 0; k < 9; ++k) { const int q = tq + k * NTHREADS; const int ch = q & 7, Jp = (q >> 3) % 70, b = (q >> 3) / 70; const int J = 64 * h + Jp - 3;
            zq[k] = (u32x4){0u, 0u, 0u, 0u}; if (q < 4480 && Jp >= 3 && Jp < 67) zq[k] = *(const u32x4*)(zT + (size_t)b * L + J * 64 + ch * 8); }
#pragma unroll
          for (int k = 0; k < 9; ++k) { const int q = tq + k * NTHREADS; const int ch = q & 7, Jp = (q >> 3) % 70, b = (q >> 3) / 70;
            if (q < 4480) *(LAS u32x4*)(Zs + b * ZB + Jp * 128 + ch * 16) = zq[k]; } }
        __syncthreads();
        int d_hi = 16 * wave + 15 - 64 * h, d_lo = 16 * wave - 64 * h - 63; d_hi = d_hi > 127 ? 127 : d_hi; d_lo = d_lo < -127 ? -127 : d_lo;
        int mlo = 16 * wave - 64 * h - 51, mhi = 16 * wave - 64 * h + 3; mlo = mlo < d_lo ? d_lo : mlo; mhi = mhi > d_hi ? d_hi : mhi; if (mlo > mhi) { mlo = d_hi + 1; mhi = d_hi; }
        const int abase = 8192 + 8 * hh - r - (r & 1) - 32;
        const LAS unsigned char* arow = lds + (r & 1) * 32768 + abase * 2;
        const LAS unsigned char* brow = Zs + (r & 7) * ZB + ((r >> 3) + 16 * wave - 64 * h + 3) * 128 + hh * 16;
#pragma unroll 1
        for (int part = 0; part < 2; ++part) {
            const int ga = part ? mhi + 1 : d_lo, gb = part ? d_hi : mlo - 1;
#pragma unroll 1
            for (int d = ga; d <= gb; ++d) {
                const int J0b = 16 * wave - d;
                const LAS unsigned* ap = (const LAS unsigned*)(arow - 128 * d);
                bf16x8 Af[2][4];
#pragma unroll
                for (int mt = 0; mt < 2; ++mt)
#pragma unroll
                    for (int ks = 0; ks < 4; ++ks) { const LAS unsigned* q = ap + (16 * ks + 32 * (1 - mt)) / 2; const u32x4 t = (u32x4){q[0], q[1], q[2], q[3]}; Af[mt][ks] = __builtin_bit_cast(bf16x8, t); }
                const LAS unsigned char* bp = brow - 128 * d;
#pragma unroll
                for (int i = 0; i < 4; ++i) { const int J0 = J0b + 4 * i;
                    if (J0 + 3 >= 64 * h && J0 <= 64 * h + 63) {
                        bf16x8 Bf[4];
#pragma unroll
                        for (int ks = 0; ks < 4; ++ks) Bf[ks] = *(const LAS bf16x8*)(bp + i * 512 + ks * 32);
#pragma unroll
                        for (int ks = 0; ks < 4; ++ks)
#pragma unroll
                            for (int mt = 0; mt < 2; ++mt) acc[mt][i] = __builtin_amdgcn_mfma_f32_32x32x16_bf16(Af[mt][ks], Bf[ks], acc[mt][i], 0, 0, 0);
                    } }
            }
            if (part == 0 && mlo <= mhi) {
#define HC_LDA(dst, p_, k_) do { const LAS unsigned* q_ = (const LAS unsigned*)(p_) + 8 * (k_); const u32x4 t_ = (u32x4){q_[0], q_[1], q_[2], q_[3]}; dst = __builtin_bit_cast(bf16x8, t_); } while (0)
#define HC_LDB(dst, p_, i_) do { _Pragma("unroll") for (int ks = 0; ks < 4; ++ks) dst[ks] = *(const LAS bf16x8*)((p_) + (i_) * 512 + ks * 32); } while (0)
#define HC_MMA(i_, Bx) do { _Pragma("unroll") for (int ks = 0; ks < 4; ++ks) { acc[1][i_] = __builtin_amdgcn_mfma_f32_32x32x16_bf16(F[ks], Bx[ks], acc[1][i_], 0, 0, 0); \
                                acc[0][i_] = __builtin_amdgcn_mfma_f32_32x32x16_bf16(F[ks + 2], Bx[ks], acc[0][i_], 0, 0, 0); } } while (0)
                bf16x8 F[6], B0[4], B1[4];
                { const LAS unsigned char* ap = arow - 128 * mlo;
#pragma unroll
                  for (int k = 0; k < 6; ++k) HC_LDA(F[k], ap, k); }
#pragma unroll 1
                for (int d = mlo; d <= mhi; ++d) {
                    const LAS unsigned char* bp = brow - 128 * d;
                    HC_LDB(B0, bp, 0);
                    HC_LDB(B1, bp, 1); __builtin_amdgcn_sched_barrier(0); HC_MMA(0, B0); __builtin_amdgcn_sched_barrier(0);
                    HC_LDB(B0, bp, 2); __builtin_amdgcn_sched_barrier(0); HC_MMA(1, B1); __builtin_amdgcn_sched_barrier(0);
                    HC_LDB(B1, bp, 3); __builtin_amdgcn_sched_barrier(0); HC_MMA(2, B0); __builtin_amdgcn_sched_barrier(0);
                    bf16x8 Fn[4];
                    { const LAS unsigned char* apn = arow - 128 * (d + 1);
#pragma unroll
                      for (int k = 0; k < 4; ++k) HC_LDA(Fn[k], apn, k); }
                    __builtin_amdgcn_sched_barrier(0); HC_MMA(3, B1); __builtin_amdgcn_sched_barrier(0);
                    F[4] = F[0]; F[5] = F[1]; F[0] = Fn[0]; F[1] = Fn[1]; F[2] = Fn[2]; F[3] = Fn[3];
                }
#undef HC_LDA
#undef HC_LDB
#undef HC_MMA
            }
        }
    }
    float tot = 0.f;
#pragma unroll
    for (int w = 0; w < 8; ++w) tot += red[w];
    const float scale = 1.0f / sqrtf(tot + 1e-6f);
#pragma unroll
    for (int mt = 0; mt < 2; ++mt)
#pragma unroll
        for (int i = 0; i < 4; ++i)
#pragma unroll
            for (int g = 0; g < 4; ++g) { const int t = 64 * (16 * wave + 4 * i + (r >> 3)) + 32 * mt + 8 * g + 4 * hh;
                const f32x4 v = (f32x4){acc[mt][i][4 * g] * scale, acc[mt][i][4 * g + 1] * scale, acc[mt][i][4 * g + 2] * scale, acc[mt][i][4 * g + 3] * scale};
                *(f32x4*)(yT + (size_t)(r & 7) * L + t) = v; }
    __syncthreads();
}

__device__ __forceinline__ void hy_post_unit(const Params& p, LAS unsigned char* lds, int l, int unit, const int wvx) {
    const int tid = opaque_tid(wvx);
    const int ct = unit & 3, tt = (unit >> 2) & 127, b = unit >> 9;
    const bf16_t* proj = (const bf16_t*)(p.ws + OFF_PROJ);
    const bf16_t* zT = (const bf16_t*)(p.ws + OFF_ZT);
    const float* yT = (const float*)(p.ws + OFF_YT);
    bf16_t* mix = (bf16_t*)(p.ws + OFF_MIX);
    const float* cw = p.in[3] + l * 3 * 768; const float* cb = p.in[4] + l * 768; const float* skip = p.in[13] + l * 256;
    LAS float* tile = (LAS float*)lds;
    {
        const int cl = tid >> 3, seg = tid & 7, c = ct * 64 + cl;
        const size_t off = ((size_t)c * NB + b) * L + tt * 64 + seg * 8;
        float z[8]; unpack8(*(const u32x4*)(zT + off), z);
        const f32x4 y0 = *(const f32x4*)(yT + off), y1 = *(const f32x4*)(yT + off + 4);
        const float sk = skip[c];
        tile[cl * 65 + seg * 8 + 0] = y0.x + z[0] * sk; tile[cl * 65 + seg * 8 + 1] = y0.y + z[1] * sk; tile[cl * 65 + seg * 8 + 2] = y0.z + z[2] * sk; tile[cl * 65 + seg * 8 + 3] = y0.w + z[3] * sk;
        tile[cl * 65 + seg * 8 + 4] = y1.x + z[4] * sk; tile[cl * 65 + seg * 8 + 5] = y1.y + z[5] * sk; tile[cl * 65 + seg * 8 + 6] = y1.z + z[6] * sk; tile[cl * 65 + seg * 8 + 7] = y1.w + z[7] * sk;
    }
    __syncthreads();
    {
        const int tl = tid >> 3, c8 = (tid & 7) * 8, t = tt * 64 + tl, c = ct * 64 + c8;
        const bf16_t* row = proj + ((size_t)b * L + t) * IN_DP;
        float x0[3][8];
        load8(row - IN_DP + C_HX0 + c, t > 0, x0[0]); load8(row + C_HX0 + c, true, x0[1]); load8(row + IN_DP + C_HX0 + c, t < L - 1, x0[2]);
        float o[8];
#pragma unroll
        for (int j = 0; j < 8; ++j) { const int c0 = c + j; const float a = x0[0][j] * cw[c0] + x0[1][j] * cw[768 + c0] + x0[2][j] * cw[1536 + c0] + cb[c0];
            o[j] = a * tile[(c8 + j) * 65 + tl]; }
        u32x4 w; w.x = pk2(o[0], o[1]); w.y = pk2(o[2], o[3]); w.z = pk2(o[4], o[5]); w.w = pk2(o[6], o[7]);
        *(u32x4*)(mix + ((size_t)b * L + t) * D + c) = w;
    }
    __syncthreads();
}


__device__ __forceinline__ void hy_pre_unit4(const Params& p, LAS unsigned char* lds, int l, int unit, const int wvx) {
    const int tid = opaque_tid(wvx);
    const int tt = unit & 127, b = unit >> 7;
    const bf16_t* proj = (const bf16_t*)(p.ws + OFF_PROJ);
    bf16_t* zT = (bf16_t*)(p.ws + OFF_ZT);
    const float* cw = p.in[3] + l * 3 * 768; const float* cb = p.in[4] + l * 768;
    LAS bf16_t* tile = (LAS bf16_t*)lds;
    const int tl = tid >> 3, c8 = (tid & 7) * 8, t = tt * 64 + tl;
    const bf16_t* row = proj + ((size_t)b * L + t) * IN_DP;
    const bool hp = t > 0, hn = t < L - 1;
    u32x4 rx[4][3], rv[4][3];
#pragma unroll
    for (int ct = 0; ct < 4; ++ct) { const int c = ct * 64 + c8;
        rx[ct][0] = *(const u32x4*)(row + (hp ? -IN_DP : 0) + C_HX1 + c); rx[ct][1] = *(const u32x4*)(row + C_HX1 + c); rx[ct][2] = *(const u32x4*)(row + (hn ? IN_DP : 0) + C_HX1 + c);
        rv[ct][0] = *(const u32x4*)(row + (hp ? -IN_DP : 0) + C_HV + c); rv[ct][1] = *(const u32x4*)(row + C_HV + c); rv[ct][2] = *(const u32x4*)(row + (hn ? IN_DP : 0) + C_HV + c); }
    const float mp = hp ? 1.f : 0.f, mn = hn ? 1.f : 0.f;
#pragma unroll
    for (int ct = 0; ct < 4; ++ct) { const int c = ct * 64 + c8;
        float x1[3][8], vv[3][8]; unpack8(rx[ct][0], x1[0]); unpack8(rx[ct][1], x1[1]); unpack8(rx[ct][2], x1[2]); unpack8(rv[ct][0], vv[0]); unpack8(rv[ct][1], vv[1]); unpack8(rv[ct][2], vv[2]);
        float wa[3][8], wb[3][8], ba[8], bb[8];
#pragma unroll
        for (int k = 0; k < 3; ++k) { const f32x4 a0 = *(const f32x4*)(cw + k * 768 + C_HX1 + c), a1 = *(const f32x4*)(cw + k * 768 + C_HX1 + c + 4), b0 = *(const f32x4*)(cw + k * 768 + C_HV + c), b1 = *(const f32x4*)(cw + k * 768 + C_HV + c + 4);
            wa[k][0] = a0.x; wa[k][1] = a0.y; wa[k][2] = a0.z; wa[k][3] = a0.w; wa[k][4] = a1.x; wa[k][5] = a1.y; wa[k][6] = a1.z; wa[k][7] = a1.w;
            wb[k][0] = b0.x; wb[k][1] = b0.y; wb[k][2] = b0.z; wb[k][3] = b0.w; wb[k][4] = b1.x; wb[k][5] = b1.y; wb[k][6] = b1.z; wb[k][7] = b1.w; }
        { const f32x4 a0 = *(const f32x4*)(cb + C_HX1 + c), a1 = *(const f32x4*)(cb + C_HX1 + c + 4), b0 = *(const f32x4*)(cb + C_HV + c), b1 = *(const f32x4*)(cb + C_HV + c + 4);
            ba[0] = a0.x; ba[1] = a0.y; ba[2] = a0.z; ba[3] = a0.w; ba[4] = a1.x; ba[5] = a1.y; ba[6] = a1.z; ba[7] = a1.w; bb[0] = b0.x; bb[1] = b0.y; bb[2] = b0.z; bb[3] = b0.w; bb[4] = b1.x; bb[5] = b1.y; bb[6] = b1.z; bb[7] = b1.w; }
#pragma unroll
        for (int j = 0; j < 8; ++j) {
            const float a = mp * x1[0][j] * wa[0][j] + x1[1][j] * wa[1][j] + mn * x1[2][j] * wa[2][j] + ba[j];
            const float v = mp * vv[0][j] * wb[0][j] + vv[1][j] * wb[1][j] + mn * vv[2][j] * wb[2][j] + bb[j];
            tile[(c + j) * 72 + tl] = (bf16_t)f2bf(a * v); } }
    __syncthreads();
#pragma unroll
    for (int ct = 0; ct < 4; ++ct) { const int cl = ct * 64 + (tid >> 3), seg = tid & 7;
        const u32x4 w = *(const LAS u32x4*)(tile + cl * 72 + seg * 8);
        *(u32x4*)(zT + ((size_t)cl * NB + b) * L + tt * 64 + seg * 8) = w; }
    __syncthreads();
}
__device__ __forceinline__ void hy_post_unit4(const Params& p, LAS unsigned char* lds, int l, int unit, const int wvx) {
    const int tid = opaque_tid(wvx);
    const int tt = unit & 127, b = unit >> 7;
    const bf16_t* proj = (const bf16_t*)(p.ws + OFF_PROJ);
    const bf16_t* zT = (const bf16_t*)(p.ws + OFF_ZT);
    const float* yT = (const float*)(p.ws + OFF_YT);
    bf16_t* mix = (bf16_t*)(p.ws + OFF_MIX);
    const float* cw = p.in[3] + l * 3 * 768; const float* cb = p.in[4] + l * 768; const float* skip = p.in[13] + l * 256;
    LAS float* tile = (LAS float*)lds;
    {
        u32x4 zq[4]; f32x4 y0q[4], y1q[4]; float skq[4];
#pragma unroll
        for (int ct = 0; ct < 4; ++ct) { const int c = ct * 64 + (tid >> 3), seg = tid & 7; const size_t off = ((size_t)c * NB + b) * L + tt * 64 + seg * 8;
            zq[ct] = *(const u32x4*)(zT + off); y0q[ct] = *(const f32x4*)(yT + off); y1q[ct] = *(const f32x4*)(yT + off + 4); skq[ct] = skip[c]; }
#pragma unroll
        for (int ct = 0; ct < 4; ++ct) { const int cl = ct * 64 + (tid >> 3), seg = tid & 7; float z[8]; unpack8(zq[ct], z); const float sk = skq[ct]; LAS float* tp = tile + cl * 65 + seg * 8;
            tp[0] = y0q[ct].x + z[0] * sk; tp[1] = y0q[ct].y + z[1] * sk; tp[2] = y0q[ct].z + z[2] * sk; tp[3] = y0q[ct].w + z[3] * sk;
            tp[4] = y1q[ct].x + z[4] * sk; tp[5] = y1q[ct].y + z[5] * sk; tp[6] = y1q[ct].z + z[6] * sk; tp[7] = y1q[ct].w + z[7] * sk; }
    }
    __syncthreads();
    {
        const int tl = tid >> 3, c8 = (tid & 7) * 8, t = tt * 64 + tl;
        const bf16_t* row = proj + ((size_t)b * L + t) * IN_DP;
        const bool hp = t > 0, hn = t < L - 1; const float mp = hp ? 1.f : 0.f, mn = hn ? 1.f : 0.f;
        u32x4 r0[4], r1[4], r2[4];
#pragma unroll
        for (int ct = 0; ct < 4; ++ct) { const int c = ct * 64 + c8; r0[ct] = *(const u32x4*)(row + (hp ? -IN_DP : 0) + C_HX0 + c); r1[ct] = *(const u32x4*)(row + C_HX0 + c); r2[ct] = *(const u32x4*)(row + (hn ? IN_DP : 0) + C_HX0 + c); }
#pragma unroll
        for (int ct = 0; ct < 4; ++ct) { const int c = ct * 64 + c8;
            float x0[3][8]; unpack8(r0[ct], x0[0]); unpack8(r1[ct], x0[1]); unpack8(r2[ct], x0[2]);
            float o[8];
#pragma unroll
            for (int j = 0; j < 8; ++j) { const int c0 = c + j; const float a = mp * x0[0][j] * cw[c0] + x0[1][j] * cw[768 + c0] + mn * x0[2][j] * cw[1536 + c0] + cb[c0];
                o[j] = a * tile[(c + j) * 65 + tl]; }
            u32x4 w; w.x = pk2(o[0], o[1]); w.y = pk2(o[2], o[3]); w.z = pk2(o[4], o[5]); w.w = pk2(o[6], o[7]);
            *(u32x4*)(mix + ((size_t)b * L + t) * D + c) = w; }
    }
    __syncthreads();
}


__device__ __forceinline__ void wg_signal(int* ctr, const bool leader) {
    asm volatile("s_waitcnt vmcnt(0)" ::: "memory");
    __syncthreads();
    if (leader) { __builtin_amdgcn_fence(__ATOMIC_RELEASE, "agent"); asm volatile("s_waitcnt vmcnt(0)" ::: "memory"); __hip_atomic_fetch_add(ctr, 1, __ATOMIC_RELAXED, __HIP_MEMORY_SCOPE_AGENT); }
}
__device__ __forceinline__ void wg_wait(int* ctr, int target, const bool leader) {
    if (leader) { unsigned sp = 0;
        while (__hip_atomic_load(ctr, __ATOMIC_RELAXED, __HIP_MEMORY_SCOPE_AGENT) < target) { __builtin_amdgcn_s_sleep(2); if (++sp > (1u << 24)) break; }
        __builtin_amdgcn_fence(__ATOMIC_ACQUIRE, "agent"); asm volatile("s_waitcnt vmcnt(0)" ::: "memory"); }
    __syncthreads();
}
__device__ __forceinline__ int wg_pop(int* ctr, LAS int* qw, const bool leader) {
    __syncthreads();
    if (leader) *qw = __hip_atomic_fetch_add(ctr, 1, __ATOMIC_RELAXED, __HIP_MEMORY_SCOPE_AGENT);
    __syncthreads();
    return __builtin_amdgcn_readfirstlane(*qw);
}
__device__ __forceinline__ void rw_prep_unit(const Params& p, int l, int unit, const int wvx) {
    const int tid = opaque_tid(wvx), cg = tid & 63, rg = tid >> 6;
    const int lev = unit >> 4, b = unit & 7; const int c = (unit & 8) ? 127 - lev : lev;
    const int t0 = c * 64 + rg * 8, col = cg * 8;
    const bf16_t* proj = (const bf16_t*)(p.ws + OFF_PROJ);
    bf16_t* PR = (bf16_t*)p.out;
    u32x4 raw[3][10];
#pragma unroll
    for (int w = 0; w < 3; ++w)
#pragma unroll
        for (int i = 0; i < 10; ++i) { const int t = t0 - 1 + i; const int tc = t < 0 ? 0 : (t > L - 1 ? L - 1 : t);
            raw[w][i] = *(const u32x4*)(proj + ((size_t)b * L + tc) * IN_DP + C_RR + w * 512 + col); }
    { const u32x4 z = (u32x4){0u, 0u, 0u, 0u};
      if (t0 == 0) { raw[0][0] = z; raw[1][0] = z; raw[2][0] = z; }
      if (t0 + 8 == L) { raw[0][9] = z; raw[1][9] = z; raw[2][9] = z; } }
    const float* mu = p.in[14] + (size_t)l * 3 * 2 * 512;
#pragma unroll
    for (int w = 0; w < 3; ++w) {
        float m0[8], m1[8], kk_[8];
        { const f32x4 a = *(const f32x4*)(mu + w * 1024 + col), b2 = *(const f32x4*)(mu + w * 1024 + col + 4), c = *(const f32x4*)(mu + w * 1024 + 512 + col), d = *(const f32x4*)(mu + w * 1024 + 512 + col + 4);
          m0[0] = a.x; m0[1] = a.y; m0[2] = a.z; m0[3] = a.w; m0[4] = b2.x; m0[5] = b2.y; m0[6] = b2.z; m0[7] = b2.w;
          m1[0] = c.x; m1[1] = c.y; m1[2] = c.z; m1[3] = c.w; m1[4] = d.x; m1[5] = d.y; m1[6] = d.z; m1[7] = d.w; }
        if (w == 1) { const f32x4 a = *(const f32x4*)(p.in[19] + l * 512 + col), b2 = *(const f32x4*)(p.in[19] + l * 512 + col + 4);
          kk_[0] = a.x; kk_[1] = a.y; kk_[2] = a.z; kk_[3] = a.w; kk_[4] = b2.x; kk_[5] = b2.y; kk_[6] = b2.z; kk_[7] = b2.w; }
#pragma unroll
        for (int j = 0; j < 8; ++j) {
            float xp[8], xc[8], xn[8], y[8];
            unpack8(raw[w][j], xp); unpack8(raw[w][j + 1], xc); unpack8(raw[w][j + 2], xn);
#pragma unroll
            for (int e = 0; e < 8; ++e) y[e] = xc[e] + m0[e] * (xp[e] - xc[e]) + m1[e] * (xn[e] - xc[e]);
            const size_t ro = ((size_t)b * L + t0 + j) * 512 + col;
            *(u32x4*)(PR + (size_t)w * NT * 512 + ro) = (u32x4){pk2(y[0], y[1]), pk2(y[2], y[3]), pk2(y[4], y[5]), pk2(y[6], y[7])};
            if (w == 1) { float kr[8], ss = 0.f;
#pragma unroll
                for (int e = 0; e < 8; ++e) { kr[e] = y[e] * kk_[e]; ss += kr[e] * kr[e]; }
                ss = sum8(ss);
                const float rn_ = __builtin_amdgcn_rsqf(fmaxf(ss, 1e-24f));
                *(u32x4*)(PR + (size_t)3 * NT * 512 + ro) = (u32x4){pk2(kr[0] * rn_, kr[1] * rn_), pk2(kr[2] * rn_, kr[3] * rn_), pk2(kr[4] * rn_, kr[5] * rn_), pk2(kr[6] * rn_, kr[7] * rn_)}; }
        }
    }
}

namespace rw {
constexpr int MATB = 9216, PITCH = 144;
constexpr int O_W2T = 0, O_A2T = MATB, O_SB = 2 * MATB, O_GBUF = 3 * MATB, O_SLOT = O_GBUF + 16384;
constexpr int O_GC = O_SLOT + 12 * MATB, O_TPP = O_GC + 512, O_CT = O_TPP + 2560, O_BONS = O_CT + 2816;
__device__ __forceinline__ constexpr int slot(int k) { return O_SLOT + k * MATB; }
#define MFMA16(a, b, c) __builtin_amdgcn_mfma_f32_16x16x32_bf16((a), (b), (c), 0, 0, 0)
__device__ __forceinline__ f32x4 tile64(const LAS unsigned char* A, const LAS unsigned char* Bt, int rt, int ct, int fr, int fq, f32x4 acc) {
#pragma unroll
    for (int ks = 0; ks < 2; ++ks) { const bf16x8 a = *(const LAS bf16x8*)(A + (16 * rt + fr) * PITCH + ks * 64 + fq * 16); const bf16x8 b = *(const LAS bf16x8*)(Bt + (16 * ct + fr) * PITCH + ks * 64 + fq * 16);
        acc = MFMA16(a, b, acc); }
    return acc;
}
__device__ __forceinline__ unsigned pkbf(float lo, float hi) { return pg8::cvt_pk_bf16(lo, hi); }
}

namespace rw {
typedef short s16x4 __attribute__((ext_vector_type(4)));
__device__ __forceinline__ bf16x8 fragN(const LAS unsigned char* img, int row, int ks, int fq) { return *(const LAS bf16x8*)(img + row * PITCH + ks * 64 + fq * 16); }
__device__ __forceinline__ bf16x8 fragP(const LAS unsigned char* img, int row, int ks, int fq) {
    const u32x2 a = *(const LAS u32x2*)(img + row * PITCH + (32 * ks + 4 * fq) * 2), b = *(const LAS u32x2*)(img + row * PITCH + (32 * ks + 16 + 4 * fq) * 2);
    const u32x4 v = (u32x4){a.x, a.y, b.x, b.y}; return __builtin_bit_cast(bf16x8, v); }
__device__ __forceinline__ bf16x8 fragT(const LAS unsigned char* img, int c0, int ks, int fr, int fq) {
    const LAS unsigned char* q = img + (32 * ks + 4 * fq + (fr >> 2)) * PITCH + (c0 + 4 * (fr & 3)) * 2;
    const s16x4 a = __builtin_amdgcn_ds_read_tr16_b64_v4i16((LAS s16x4*)q), b = __builtin_amdgcn_ds_read_tr16_b64_v4i16((LAS s16x4*)(q + 16 * PITCH));
    return (bf16x8){a[0], a[1], a[2], a[3], b[0], b[1], b[2], b[3]}; }
}

__device__ __forceinline__ void rw_chain_unit(const Params& p, LAS unsigned char* lds, int l, int unit, const int wvx) {
    using namespace rw;
    const int tid = opaque_tid(wvx), wave = __builtin_amdgcn_readfirstlane(tid >> 6);
    const int dir = unit & 1, h = (unit >> 1) & 7, b = unit >> 4;
    const bf16_t* proj = (const bf16_t*)(p.ws + OFF_PROJ);
    unsigned short* Y = (unsigned short*)(p.ws + (dir ? OFF_YB : OFF_YF));
    LAS float* gbuf = (LAS float*)(lds + O_GBUF);
    LAS float* GC = (LAS float*)(lds + O_GC);
    LAS bf16_t* TPP = (LAS bf16_t*)(lds + O_TPP);
    LAS float* CT = (LAS float*)(lds + O_CT);
    float* BON = (float*)(p.ws + OFF_BON) + (size_t)dir * NT * 8;
    const bf16_t* PR = (const bf16_t*)p.out;
    int* prep_ctr = (int*)(p.ws + OFF_CTL) + 32 + l * 16 + 8;
    __syncthreads();
    {
        const float* w2 = p.in[16] + ((size_t)l * 2 + dir) * 64 * 512 + h * 64; const float* a2 = p.in[18] + ((size_t)l * 2 + dir) * 64 * 512 + h * 64;
        for (int i = tid; i < 4096; i += NTHREADS) { const int r = i >> 6, n = i & 63;
            *(LAS bf16_t*)(lds + O_W2T + n * PITCH + r * 2) = (bf16_t)f2bf(w2[r * 512 + n]); *(LAS bf16_t*)(lds + O_A2T + n * PITCH + r * 2) = (bf16_t)f2bf(a2[r * 512 + n]); }
        for (int i = tid; i < MATB / 4; i += NTHREADS) ((LAS unsigned*)(lds + O_SB))[i] = 0u;
        for (int i = tid; i < 704; i += NTHREADS) { const int row = i >> 6, n = i & 63, col = h * 64 + n; float v;
            if (row < 6) v = 0.f;
            else if (row == 6) v = p.in[15][((size_t)l * 2 + dir) * 512 + col];
            else if (row == 7) v = p.in[17][((size_t)l * 2 + dir) * 512 + col];
            else if (row == 8) v = p.in[19][l * 512 + col];
            else if (row == 9) v = p.in[20][l * 512 + col];
            else v = p.in[21][l * 512 + col];
            CT[i] = v; }
    }
    const int rt = wave >> 1, chh = wave & 1;
    u32x4 pre[16];
    f32x4 acc_[16];
#define F4(x) __builtin_bit_cast(f32x4, (x))
#define U4(x) __builtin_bit_cast(u32x4, (x))
#define issue_rkv(CC, HALF) do { const int t0n_ = (dir ? (L / 64 - 1 - (CC)) : (CC)) * 64; int tq_ = tid; asm volatile("" : "+v"(tq_));     \
        const int ppn = ((tq_ & 255) >> 3) + 32 * (HALF); const int ttn = dir ? (t0n_ + 63 - ppn) : (t0n_ + ppn); const bf16_t* row = (wave >= 4) ? PR + ((size_t)b * L + ttn) * 512 + h * 64 + (tq_ & 7) * 8 : PR;     \
        _Pragma("unroll") for (int k = 0; k < 4; ++k) pre[4 * (HALF) + k] = *(const u32x4*)(row + (size_t)k * NT * 512); } while (0)
#define issue_lora(CC) do { const int t0n_ = (dir ? (L / 64 - 1 - (CC)) : (CC)) * 64; int tq_ = tid; asm volatile("" : "+v"(tq_)); \
        { const int kq_ = ((tq_ >> 4) & 3) * 8, cbase = (wave == 7 ? C_RA : C_RW) + dir * 64; \
          _Pragma("unroll") for (int r4 = 0; r4 < 4; ++r4) { const int pq_ = 16 * r4 + (tq_ & 15); const int ttn = dir ? (t0n_ + 63 - pq_) : (t0n_ + pq_); const bf16_t* row = (wave >= 5) ? proj + ((size_t)b * L + ttn) * IN_DP + cbase + kq_ : proj; \
            pre[8 + 2 * r4] = *(const u32x4*)(row); pre[9 + 2 * r4] = *(const u32x4*)(row + 32); } } } while (0)
    wg_wait(prep_ctr, 128, tid == 0);
    issue_lora(0); issue_rkv(0, 0); issue_rkv(0, 1);
#pragma unroll
    for (int q = 0; q < 16; ++q) acc_[q] = (f32x4){0.f, 0.f, 0.f, 0.f};
#pragma unroll 1
    for (int cc = -1; cc < L / 64; ++cc) {
        const bool cons = cc >= 0, prod = cc + 1 < L / 64;
        const int cn = cc + 1;
        const int cx = cn + 1 < L / 64 ? cn + 1 : L / 64 - 1;
        const int t0 = (dir ? (L / 64 - 1 - cc) : cc) * 64, t0n = (dir ? (L / 64 - 1 - cn) : cn) * 64;
        int tq = tid; asm volatile("" : "+v"(tq));
        const int fr = tq & 15, fq = (tq >> 4) & 3;
        const int bbn = (cn & 1) ? slot(9) : slot(7), bbc = (cc & 1) ? slot(9) : slot(7);
        if (cc + 2 < 64 && ((cc + 2) & 7) == 0) wg_wait(prep_ctr + ((cc + 2) >> 3), 128, tid == 0);
        __syncthreads();
        if (wave < 4) {
            if (cons) {
#pragma unroll
                for (int q = 0; q < 12; ++q) acc_[q] = (f32x4){0.f, 0.f, 0.f, 0.f};
                const bf16x8 s0 = fragN(lds + O_SB, 16 * wave + fr, 0, fq), s1 = fragN(lds + O_SB, 16 * wave + fr, 1, fq), v0 = fragT(lds + slot(6), 16 * wave, 0, fr, fq), v1 = fragT(lds + slot(6), 16 * wave, 1, fr, fq);
#pragma unroll
                for (int q = 0; q < 4; ++q) { f32x4 a = acc_[q];
                    a = MFMA16(fragN(lds + slot(3), 16 * q + fr, 0, fq), s0, a); a = MFMA16(fragN(lds + slot(3), 16 * q + fr, 1, fq), s1, a);
                    a = MFMA16(fragT(lds + slot(0), 16 * q, 0, fr, fq), v0, a); if (q >= 2) a = MFMA16(fragT(lds + slot(0), 16 * q, 1, fr, fq), v1, a);
                    acc_[q] = a;
                    f32x4 kx = acc_[4 + q]; kx = MFMA16(fragT(lds + slot(8), 16 * q, 0, fr, fq), v0, kx); kx = MFMA16(fragT(lds + slot(8), 16 * q, 1, fr, fq), v1, kx); acc_[4 + q] = kx;
                    f32x4 y = acc_[8 + q];
                    y = MFMA16(fragN(lds + slot(4), 16 * q + fr, 0, fq), s0, y); y = MFMA16(fragN(lds + slot(4), 16 * q + fr, 1, fq), s1, y);
                    y = MFMA16(fragT(lds + slot(2), 16 * q, 0, fr, fq), v0, y); if (q >= 2) y = MFMA16(fragT(lds + slot(2), 16 * q, 1, fr, fq), v1, y);
                    acc_[8 + q] = y;
                    asm volatile("" ::: "memory"); }
            }
        } else if (wave == 4) {
            if (cons) {
                const int pb = fq, j = fr; float T[16];
#pragma unroll
                for (int q = 0; q < 16; ++q) T[q] = (q == j) ? 1.f : 0.f;
#pragma unroll
                for (int sg = 0; sg < 4; ++sg) {
                    u32x4 ar[4][2];
#pragma unroll
                    for (int r4 = 0; r4 < 4; ++r4) { ar[r4][0] = *(const LAS u32x4*)(lds + slot(11) + (16 * pb + 4 * sg + r4) * PITCH + 32 * pb); ar[r4][1] = *(const LAS u32x4*)(lds + slot(11) + (16 * pb + 4 * sg + r4) * PITCH + 32 * pb + 16); }
#pragma unroll
                    for (int r4 = 0; r4 < 4; ++r4) { const int s2 = 4 * sg + r4; float av[16]; unpack8(ar[r4][0], av); unpack8(ar[r4][1], av + 8);
#pragma unroll
                        for (int q = s2 + 1; q < 16; ++q) T[q] += av[q] * T[s2]; }
                    asm volatile("" ::: "memory");
                }
#pragma unroll
                for (int q = 0; q < 16; ++q) TPP[(pb * 16 + q) * 20 + j] = (bf16_t)f2bf(T[q]);
            }
        } else if (wave <= 6) {
            if (prod) {
#pragma unroll
                for (int gi = 0; gi < 2; ++gi) { const int cgp = 2 * (wave - 5) + gi;
                    const float w0n = CT[6 * 64 + 16 * cgp + fr];
                    const bf16x8 wb0 = fragN(lds + O_W2T, 16 * cgp + fr, 0, fq), wb1 = fragN(lds + O_W2T, 16 * cgp + fr, 1, fq);
                    u32x2 lwp[4];
#pragma unroll
                    for (int r4 = 0; r4 < 4; ++r4) {
                        f32x4 wv = (f32x4){0.f, 0.f, 0.f, 0.f}; wv = MFMA16(__builtin_bit_cast(bf16x8, pre[8 + 2 * r4]), wb0, wv); wv = MFMA16(__builtin_bit_cast(bf16x8, pre[9 + 2 * r4]), wb1, wv);
                        float lwv[4];
#pragma unroll
                        for (int e = 0; e < 4; ++e) lwv[e] = -0.60653066f * frcp(1.0f + __expf(-(wv[e] + w0n)));
                        lwp[r4] = (u32x2){pk2(lwv[0], lwv[1]), pk2(lwv[2], lwv[3])}; }
#pragma unroll
                    for (int r4 = 0; r4 < 4; ++r4) { f32x4 g = (f32x4){0.f, 0.f, 0.f, 0.f};
#pragma unroll
                        for (int ks = 0; ks < 2; ++ks) if (32 * ks <= 16 * r4 + 15) {
                            const int pa = 16 * r4 + fr - 32 * ks - 4 * fq, pb2 = pa - 16;
                            u32x4 lt; unsigned one2 = 0x3F803F80u; asm volatile("" : "+s"(one2));
                            lt.x = (pa >= 1 ? one2 : (pa == 0 ? 0x00003F80u : 0u)); lt.y = (pa >= 3 ? one2 : (pa == 2 ? 0x00003F80u : 0u));
                            lt.z = (pb2 >= 1 ? one2 : (pb2 == 0 ? 0x00003F80u : 0u)); lt.w = (pb2 >= 3 ? one2 : (pb2 == 2 ? 0x00003F80u : 0u));
                            const u32x4 bv = (u32x4){lwp[2 * ks].x, lwp[2 * ks].y, lwp[2 * ks + 1].x, lwp[2 * ks + 1].y};
                            g = MFMA16(__builtin_bit_cast(bf16x8, lt), __builtin_bit_cast(bf16x8, bv), g); }
#pragma unroll
                        for (int e = 0; e < 4; ++e) gbuf[(16 * r4 + 4 * fq + e) * 64 + 16 * cgp + fr] = g[e]; }
                    asm volatile("" ::: "memory"); }
            }
        } else {
            if (prod) {
#pragma unroll
                for (int cgp = 0; cgp < 4; ++cgp) {
                    const bf16x8 ab0 = fragN(lds + O_A2T, 16 * cgp + fr, 0, fq), ab1 = fragN(lds + O_A2T, 16 * cgp + fr, 1, fq);
#pragma unroll
                    for (int r4 = 0; r4 < 4; ++r4) { f32x4 av = (f32x4){0.f, 0.f, 0.f, 0.f};
                        av = MFMA16(__builtin_bit_cast(bf16x8, pre[8 + 2 * r4]), ab0, av); av = MFMA16(__builtin_bit_cast(bf16x8, pre[9 + 2 * r4]), ab1, av);
#pragma unroll
                        for (int e = 0; e < 4; ++e) *(LAS bf16_t*)(lds + slot(5) + (16 * r4 + 4 * fq + e) * PITCH + (16 * cgp + fr) * 2) = (bf16_t)f2bf(av[e]); }
                    asm volatile("" ::: "memory"); }
            }
        }
        __builtin_amdgcn_sched_barrier(0);
        issue_lora(cx);
        __syncthreads();
#define LD2(dst, ptr) do { const f32x4 _a = *(const LAS f32x4*)(ptr), _b = *(const LAS f32x4*)((ptr) + 4); dst[0] = (f32x2){_a.x, _a.y}; dst[1] = (f32x2){_a.z, _a.w}; dst[2] = (f32x2){_b.x, _b.y}; dst[3] = (f32x2){_b.z, _b.w}; } while (0)
#define UP2(dst, wsrc_) do { const u32x4 _w = (wsrc_); dst[0] = (f32x2){bf2f(_w.x & 0xffffu), __uint_as_float(_w.x & 0xffff0000u)}; dst[1] = (f32x2){bf2f(_w.y & 0xffffu), __uint_as_float(_w.y & 0xffff0000u)}; \
                         dst[2] = (f32x2){bf2f(_w.z & 0xffffu), __uint_as_float(_w.z & 0xffff0000u)}; dst[3] = (f32x2){bf2f(_w.w & 0xffffu), __uint_as_float(_w.w & 0xffff0000u)}; } while (0)
#define PK4(v) ((u32x4){pk2(v[0].x, v[0].y), pk2(v[1].x, v[1].y), pk2(v[2].x, v[2].y), pk2(v[3].x, v[3].y)})
#define S2_ITEM(HALF) do { \
            const int pp = ((tq & 255) >> 3) + 32 * (HALF), ig = tq & 7, i0 = ig * 8; \
            const int tt = dir ? (t0n + 63 - pp) : (t0n + pp);            \
            f32x2 r2[4], k2[4], a2v[4], kd2[4], kkr2[4], gi2[4], ge2[4]; \
            LD2(gi2, gbuf + pp * 64 + i0); \
            LD2(ge2, gbuf + (pp > 0 ? pp - 1 : 0) * 64 + i0);        \
            if (pp == 0) { ge2[0] = (f32x2){0.f, 0.f}; ge2[1] = ge2[0]; ge2[2] = ge2[0]; ge2[3] = ge2[0]; } \
            UP2(r2, pre[4 * (HALF) + 0]); UP2(k2, pre[4 * (HALF) + 1]); UP2(kkr2, pre[4 * (HALF) + 3]);        \
            *(LAS u32x4*)(lds + slot(6) + pp * PITCH + ig * 16) = pre[4 * (HALF) + 2];        \
            {   f32x2 ap[4], c7[4]; \
                UP2(ap, *(const LAS u32x4*)(lds + slot(5) + pp * PITCH + ig * 16)); LD2(c7, CT + 7 * 64 + i0); \
                _Pragma("unroll") for (int j2 = 0; j2 < 4; ++j2) { const f32x2 araw = ap[j2] + c7[j2]; a2v[j2] = (f32x2){frcp(1.0f + __expf(-araw.x)), frcp(1.0f + __expf(-araw.y))}; } } \
            f32x2 bs2 = (f32x2){0.f, 0.f}; \
            {   f32x2 c9[4], c10[4]; LD2(c9, CT + 9 * 64 + i0); LD2(c10, CT + 10 * 64 + i0); \
                _Pragma("unroll") for (int j2 = 0; j2 < 4; ++j2) { kd2[j2] = k2[j2] * (1.0f + (a2v[j2] - 1.0f) * c9[j2]); bs2 += r2[j2] * kd2[j2] * c10[j2]; } } \
            { const float bs = sum8(bs2.x + bs2.y); if (ig == 0) ((LAS float*)(lds + O_BONS))[pp] = bs; }        \
            f32x2 At[4], Rt[4], Bb[4], Kb[4]; \
            _Pragma("unroll") for (int j2 = 0; j2 < 4; ++j2) { const f32x2 kk = kkr2[j2]; \
                const f32x2 ei = (f32x2){__expf(gi2[j2].x), __expf(gi2[j2].y)}, ee = (f32x2){__expf(ge2[j2].x), __expf(ge2[j2].y)}, inv = (f32x2){frcp(ei.x), frcp(ei.y)}; \
                At[j2] = -kk * ee; Rt[j2] = r2[j2] * ei; Bb[j2] = kk * a2v[j2] * inv; Kb[j2] = kd2[j2] * inv; \
                if ((HALF) == 1 && pp == 63) { GC[(cn & 1) * 64 + i0 + 2 * j2] = ei.x; GC[(cn & 1) * 64 + i0 + 2 * j2 + 1] = ei.y; } } \
            *(LAS u32x4*)(lds + slot(3) + pp * PITCH + ig * 16) = PK4(At); \
            *(LAS u32x4*)(lds + slot(4) + pp * PITCH + ig * 16) = PK4(Rt); \
            *(LAS u32x4*)(lds + bbn + pp * PITCH + ig * 16) = PK4(Bb); \
            *(LAS u32x4*)(lds + slot(8) + pp * PITCH + ig * 16) = PK4(Kb); } while (0)
        if (wave < 4) {
            if (cons) {
                u32x2 Ub[4];
                bf16x8 fa[4]; u32x2 ft[4];
#pragma unroll
                for (int z = 0; z < 4; ++z) { const int pb = (z == 3) ? 3 : z + 1, k2 = (z == 3) ? 1 : 0;
                    fa[z] = fragT(lds + slot(11), 16 * pb, k2, fr, fq);
                    ft[z] = *(const LAS u32x2*)(lds + O_TPP + ((z * 16 + fr) * 20 + 4 * fq) * 2); }
#pragma unroll
                for (int pb = 0; pb < 4; ++pb) {
                    f32x4 tmp = acc_[pb];
#pragma unroll
                    for (int k2 = 0; k2 < 2; ++k2) if (2 * k2 < pb) { const int z = (pb == 3 && k2 == 1) ? 3 : pb - 1;
                        const u32x2 b0 = Ub[2 * k2]; const u32x2 b1 = (2 * k2 + 1 < pb) ? Ub[2 * k2 + 1] : (u32x2){0u, 0u};
                        const u32x4 bv = (u32x4){b0.x, b0.y, b1.x, b1.y};
                        tmp = MFMA16(fa[z], __builtin_bit_cast(bf16x8, bv), tmp); }
                    const u32x4 av = (u32x4){ft[pb].x, ft[pb].y, 0u, 0u}, bv = (u32x4){pkbf(tmp[0], tmp[1]), pkbf(tmp[2], tmp[3]), 0u, 0u};
                    const f32x4 U = MFMA16(__builtin_bit_cast(bf16x8, av), __builtin_bit_cast(bf16x8, bv), ((f32x4){0.f, 0.f, 0.f, 0.f}));
                    Ub[pb] = (u32x2){pkbf(U[0], U[1]), pkbf(U[2], U[3])};
                    *(LAS u32x2*)(lds + slot(10) + (16 * wave + fr) * PITCH + (16 * pb + 4 * fq) * 2) = Ub[pb];
                }
            }
        } else { if (prod) S2_ITEM(0); }
        __builtin_amdgcn_sched_barrier(0);
        issue_rkv(cx, 0);
        __syncthreads();
        if (wave < 4) {
            if (cons) {
                const bf16x8 u0 = fragP(lds + slot(10), 16 * wave + fr, 0, fq), u1 = fragP(lds + slot(10), 16 * wave + fr, 1, fq);
#pragma unroll
                for (int q = 0; q < 4; ++q) { f32x4 a = acc_[8 + q];
                    a = MFMA16(fragT(lds + slot(1), 16 * q, 0, fr, fq), u0, a); if (q >= 2) a = MFMA16(fragT(lds + slot(1), 16 * q, 1, fr, fq), u1, a);
#pragma unroll
                    for (int e = 0; e < 4; ++e) *(LAS bf16_t*)(lds + slot(11) + (16 * q + 4 * fq + e) * PITCH + (16 * wave + fr) * 2) = (bf16_t)f2bf(a[e]); }
#pragma unroll
                for (int it = 0; it < 4; ++it) { f32x4 a = acc_[4 + it] + acc_[12 + it];
                    a = MFMA16(fragT(lds + bbc, 16 * it, 0, fr, fq), u0, a); a = MFMA16(fragT(lds + bbc, 16 * it, 1, fr, fq), u1, a);
                    const f32x4 gc = *(const LAS f32x4*)(GC + (cc & 1) * 64 + 16 * it + 4 * fq);
                    a = a * gc; acc_[12 + it] = a;
                    *(LAS u32x2*)(lds + O_SB + (16 * wave + fr) * PITCH + (16 * it + 4 * fq) * 2) = (u32x2){pkbf(a[0], a[1]), pkbf(a[2], a[3])};
                    asm volatile("" ::: "memory"); }
            }
        } else { if (prod) S2_ITEM(1); }
        __builtin_amdgcn_sched_barrier(0);
        issue_rkv(cx, 1);
#undef S2_ITEM
#undef PK4
#undef UP2
#undef LD2
        __syncthreads();
        if (cons) { const int lane = tq & 63, row = 32 * chh + (lane >> 1); const int ttp = dir ? (t0 + 63 - row) : (t0 + row);
            *(u32x4*)(Y + ((size_t)b * L + ttp) * 512 + h * 64 + 16 * rt + 8 * (lane & 1)) = *(const LAS u32x4*)(lds + slot(11) + row * PITCH + 32 * rt + 16 * (lane & 1)); }
        if (prod && tq < 64) BON[((size_t)b * 8 + h) * L + (dir ? (t0n + 63 - tq) : (t0n + tq))] = ((const LAS float*)(lds + O_BONS))[tq];
        if (prod) { const bf16x8 at0 = fragN(lds + slot(3), 16 * rt + fr, 0, fq), at1 = fragN(lds + slot(3), 16 * rt + fr, 1, fq), rt0 = fragN(lds + slot(4), 16 * rt + fr, 0, fq), rt1 = fragN(lds + slot(4), 16 * rt + fr, 1, fq);
#pragma unroll
          for (int ct = 0; ct < 2; ++ct) { const int ctt = 2 * chh + ct;
            f32x4 ab = (f32x4){0.f, 0.f, 0.f, 0.f}, ak = ab, rb = ab, rk = ab;
            if (ctt <= rt) {
                const bf16x8 b0 = fragN(lds + bbn, 16 * ctt + fr, 0, fq), b1 = fragN(lds + bbn, 16 * ctt + fr, 1, fq), k0 = fragN(lds + slot(8), 16 * ctt + fr, 0, fq), k1 = fragN(lds + slot(8), 16 * ctt + fr, 1, fq);
                ab = MFMA16(at0, b0, ab); ab = MFMA16(at1, b1, ab); ak = MFMA16(at0, k0, ak); ak = MFMA16(at1, k1, ak);
                rb = MFMA16(rt0, b0, rb); rb = MFMA16(rt1, b1, rb); rk = MFMA16(rt0, k0, rk); rk = MFMA16(rt1, k1, rk); }
            float vab[4], vak[4], vrb[4], vrk[4];
#pragma unroll
            for (int e = 0; e < 4; ++e) { const int prow = 16 * rt + 4 * fq + e, jcol = 16 * ctt + fr; const bool st = prow > jcol, inc = prow >= jcol;
                vab[e] = st ? ab[e] : 0.f; vak[e] = st ? ak[e] : 0.f; vrb[e] = inc ? rb[e] : 0.f; vrk[e] = inc ? rk[e] : 0.f; }
            const int off = (16 * ctt + fr) * PITCH + (16 * rt + 4 * fq) * 2;
            *(LAS u32x2*)(lds + slot(11) + off) = (u32x2){pkbf(vab[0], vab[1]), pkbf(vab[2], vab[3])};
            *(LAS u32x2*)(lds + slot(0) + off) = (u32x2){pkbf(vak[0], vak[1]), pkbf(vak[2], vak[3])};
            *(LAS u32x2*)(lds + slot(1) + off) = (u32x2){pkbf(vrb[0], vrb[1]), pkbf(vrb[2], vrb[3])};
            *(LAS u32x2*)(lds + slot(2) + off) = (u32x2){pkbf(vrk[0], vrk[1]), pkbf(vrk[2], vrk[3])}; } }
    }
    __syncthreads();
#undef issue_rkv
#undef issue_lora
#undef F4
#undef U4
}

constexpr int PT = 128;
__device__ __forceinline__ void rw_post_wg(const Params& p, LAS unsigned char* lds, int l, int G_, int bid, const int wvx) {
    const int tid = opaque_tid(wvx), lane = tid & 63, wave = __builtin_amdgcn_readfirstlane(tid >> 6), fr = lane & 15, fq = lane >> 4;
    const int h = bid & 7;
    const bf16_t* proj = (const bf16_t*)(p.ws + OFF_PROJ);
    const bf16_t* YF = (const bf16_t*)(p.ws + OFF_YF); const bf16_t* YB = (const bf16_t*)(p.ws + OFF_YB);
    const float* BONF = (const float*)(p.ws + OFF_BON); const float* BONB = BONF + (size_t)NT * 8;
    bf16_t* mix = (bf16_t*)(p.ws + OFF_MIX);
    constexpr int GP = 272;
    LAS unsigned char* G2T = lds;
    LAS unsigned char* SG = lds + 17408;
    LAS unsigned char* RAWV = lds + 52224;
    LAS unsigned char* GATE = lds + 68864;
    __syncthreads();
    { const float* g2 = p.in[22] + (size_t)l * 128 * 512 + h * 64;
        for (int i = tid; i < 8192; i += NTHREADS) { const int r = i >> 6, n = i & 63; *(LAS bf16_t*)(G2T + n * GP + r * 2) = (bf16_t)f2bf(g2[r * 512 + n]); } }
    const int ig = tid & 7, i0 = ig * 8, col = h * 64 + i0;
    float mv0[8], mv1[8], lnw[8], lnb[8];
#pragma unroll
    for (int j = 0; j < 8; ++j) { mv0[j] = p.in[14][(size_t)l * 3072 + 2 * 1024 + col + j]; mv1[j] = p.in[14][(size_t)l * 3072 + 2 * 1024 + 512 + col + j]; lnw[j] = p.in[23][l * 512 + col + j]; lnb[j] = p.in[24][l * 512 + col + j]; }
#pragma unroll 1
    for (int tile = bid >> 3; tile < NT / PT; tile += G_ >> 3) {
        const int row0 = tile * PT, tb0 = row0 & (L - 1);
        __syncthreads();
        u32x4 gq[4], vq[3]; u32x4 yq[2][2]; float bq[2];
#pragma unroll
        for (int k = 0; k < 4; ++k) { const int q = tid + k * NTHREADS; gq[k] = *(const u32x4*)(proj + (size_t)(row0 + (q >> 4)) * IN_DP + C_RG + (q & 15) * 8); }
#pragma unroll
        for (int k = 0; k < 3; ++k) { const int q = tid + k * NTHREADS; const int rr = q >> 3, ch = q & 7; const int tt = tb0 - 1 + rr; vq[k] = (u32x4){0u, 0u, 0u, 0u};
            if (q < 1040 && tt >= 0 && tt < L) vq[k] = *(const u32x4*)(proj + (size_t)(row0 - 1 + rr) * IN_DP + C_RV + h * 64 + ch * 8); }
#pragma unroll
        for (int sl = 0; sl < 2; ++sl) { const size_t row = (size_t)row0 + (tid >> 3) + 64 * sl; yq[sl][0] = *(const u32x4*)(YF + row * 512 + col); yq[sl][1] = *(const u32x4*)(YB + row * 512 + col);
            const size_t bi = ((size_t)(row >> 13) * 8 + h) * L + (row & (L - 1)); bq[sl] = BONF[bi] + BONB[bi]; }
#pragma unroll
        for (int k = 0; k < 4; ++k) { const int q = tid + k * NTHREADS; const int t = q >> 4, ch = q & 15; *(LAS u32x4*)(SG + t * GP + ch * 16) = gq[k]; }
#pragma unroll
        for (int k = 0; k < 3; ++k) { const int q = tid + k * NTHREADS; if (q < 1040) *(LAS u32x4*)(RAWV + (q >> 3) * 128 + (q & 7) * 16) = vq[k]; }
        __syncthreads();
#pragma unroll
        for (int ct = 0; ct < 4; ++ct) { f32x4 acc = (f32x4){0.f, 0.f, 0.f, 0.f};
#pragma unroll
            for (int ks = 0; ks < 4; ++ks) { const bf16x8 a = *(const LAS bf16x8*)(SG + (16 * wave + fr) * GP + ks * 64 + fq * 16); const bf16x8 b = *(const LAS bf16x8*)(G2T + (16 * ct + fr) * GP + ks * 64 + fq * 16);
                acc = __builtin_amdgcn_mfma_f32_16x16x32_bf16(a, b, acc, 0, 0, 0); }
#pragma unroll
            for (int e = 0; e < 4; ++e) *(LAS bf16_t*)(GATE + (16 * wave + 4 * fq + e) * 144 + (16 * ct + fr) * 2) = (bf16_t)f2bf(acc[e]); }
        __syncthreads();
#pragma unroll
        for (int sl = 0; sl < 2; ++sl) { const int t = (tid >> 3) + 64 * sl; const size_t row = (size_t)row0 + t;
            float vp[8], vc[8], vn[8], gt[8];
            unpack8(*(const LAS u32x4*)(RAWV + t * 128 + ig * 16), vp); unpack8(*(const LAS u32x4*)(RAWV + (t + 1) * 128 + ig * 16), vc); unpack8(*(const LAS u32x4*)(RAWV + (t + 2) * 128 + ig * 16), vn);
            unpack8(*(const LAS u32x4*)(GATE + t * 144 + ig * 16), gt);
            float yf8[8], yb8[8]; unpack8(yq[sl][0], yf8); unpack8(yq[sl][1], yb8);
            const float bon = bq[sl];
            float y[8] = {yf8[0] + yb8[0], yf8[1] + yb8[1], yf8[2] + yb8[2], yf8[3] + yb8[3], yf8[4] + yb8[4], yf8[5] + yb8[5], yf8[6] + yb8[6], yf8[7] + yb8[7]};
            float sm = 0.f;
#pragma unroll
            for (int j = 0; j < 8; ++j) sm += y[j];
            const float mean = sum8(sm) * (1.0f / 64.0f);
            float sq = 0.f;
#pragma unroll
            for (int j = 0; j < 8; ++j) { y[j] -= mean; sq += y[j] * y[j]; }
            const float rstd = __builtin_amdgcn_rsqf(sum8(sq) * (1.0f / 64.0f) + 64e-5f);
            float o[8];
#pragma unroll
            for (int j = 0; j < 8; ++j) { const float v = vc[j] + mv0[j] * (vp[j] - vc[j]) + mv1[j] * (vn[j] - vc[j]); o[j] = (y[j] * rstd * lnw[j] + lnb[j] + bon * v) * gt[j]; }
            u32x4 w; w.x = pk2(o[0], o[1]); w.y = pk2(o[2], o[3]); w.z = pk2(o[4], o[5]); w.w = pk2(o[6], o[7]);
            *(u32x4*)(mix + row * D + 256 + col) = w; }
    }
    __syncthreads();
}

namespace na {
constexpr int O_K = 0, O_V = 65536, O_RPB = 131072, O_MX = 133120, O_QW = 142080;
__device__ __forceinline__ int rowoff(int keycol, int byte) { return keycol * 128 + ((((byte >> 5) ^ keycol) & 3) << 5) + (byte & 31); }
typedef short s16x4 __attribute__((ext_vector_type(4)));
}
__device__ __forceinline__ void na_strip(const Params& p, LAS unsigned char* lds, int l, int strip, const int wvx) {
    using namespace na;
    const int tid = opaque_tid(wvx), lane = tid & 63, wave = __builtin_amdgcn_readfirstlane(tid >> 6), fr = lane & 15, fq = lane >> 4;
    const int b = strip >> 5, h = (strip >> 3) & 3, i0 = (strip & 7) * 16;
    const int g = wave & 3, kh = wave >> 2;
    const bf16_t* proj = (const bf16_t*)(p.ws + OFF_PROJ);
    bf16_t* mix = (bf16_t*)(p.ws + OFF_MIX);
    LAS float* RPB = (LAS float*)(lds + O_RPB);
    LAS unsigned char* MX = lds + O_MX + g * 2240;
    const int j0 = 16 * g, c0 = (g == 0) ? 0 : ((g == 3) ? 32 : 16 * g - 8);
    __syncthreads();
    for (int q = tid; q < 465; q += NTHREADS) RPB[q] = p.in[25][((size_t)l * 4 + h) * 465 + q];
    { int rs = i0 - 4; rs = rs < 0 ? 0 : (rs > 120 ? 120 : rs);
        u32x4 fw[16];
#pragma unroll
        for (int k = 0; k < 16; ++k) { const int q = tid + k * NTHREADS; const int r8 = q >> 10, which = (q >> 9) & 1, col = (q >> 3) & 63, ch = q & 7; const int kr = rs + r8;
            fw[k] = *(const u32x4*)(proj + ((size_t)b * L + kr * 64 + col) * IN_DP + (which ? C_NV : C_NK) + h * 64 + ch * 8); }
#pragma unroll
        for (int k = 0; k < 16; ++k) { const int q = tid + k * NTHREADS; const int r8 = q >> 10, which = (q >> 9) & 1, col = (q >> 3) & 63, ch = q & 7; const int kr = rs + r8;
            *(LAS u32x4*)(lds + (which ? O_V : O_K) + (kr & 7) * 8192 + rowoff(col, 16 * ch)) = fw[k]; } }
    bf16x8 Bq[2];
#pragma unroll
    for (int ks = 0; ks < 2; ++ks) Bq[ks] = *(const bf16x8*)(proj + ((size_t)b * L + i0 * 64 + j0 + fr) * IN_DP + C_NQ + h * 64 + 32 * ks + 8 * fq);
    const int jq = j0 + fr;
    int cs = jq - 8; cs = cs < 0 ? 0 : (cs > 48 ? 48 : cs);
    const u32x4 onesv = (u32x4){0x3F803F80u, 0x3F803F80u, 0x3F803F80u, 0x3F803F80u};
#pragma unroll 1
    for (int i = i0; i < i0 + 16; ++i) {
        int rs = i - 4; rs = rs < 0 ? 0 : (rs > 120 ? 120 : rs);
        int rsn = i + 1 - 4; rsn = rsn < 0 ? 0 : (rsn > 120 ? 120 : rsn);
        const bool more = (i + 1 < i0 + 16), newrow = more && (rsn > rs);
        __syncthreads();
        u32x4 pre0 = (u32x4){0u, 0u, 0u, 0u}, pre1 = pre0; bf16x8 Bqn[2] = {Bq[0], Bq[1]};
        if (newrow) { const int kr = rsn + 7;
            { const int q = tid; const int which = q >> 9, col = (q >> 3) & 63, ch = q & 7; pre0 = *(const u32x4*)(proj + ((size_t)b * L + kr * 64 + col) * IN_DP + (which ? C_NV : C_NK) + h * 64 + ch * 8); }
            { const int q = tid + 512; const int which = q >> 9, col = (q >> 3) & 63, ch = q & 7; pre1 = *(const u32x4*)(proj + ((size_t)b * L + kr * 64 + col) * IN_DP + (which ? C_NV : C_NK) + h * 64 + ch * 8); } }
        if (more) {
#pragma unroll
            for (int ks = 0; ks < 2; ++ks) Bqn[ks] = *(const bf16x8*)(proj + ((size_t)b * L + (i + 1) * 64 + j0 + fr) * IN_DP + C_NQ + h * 64 + 32 * ks + 8 * fq); }
        f32x4 S[4][2]; float mloc = -1e30f;
#pragma unroll
        for (int r4 = 0; r4 < 4; ++r4) { const int krow = rs + 4 * kh + r4, slot = krow & 7, dr = krow - i + 7;
#pragma unroll
            for (int ct = 0; ct < 2; ++ct) { const int keycol = c0 + 16 * ct + fr; f32x4 acc = (f32x4){0.f, 0.f, 0.f, 0.f};
#pragma unroll
                for (int ks = 0; ks < 2; ++ks) { const bf16x8 a = *(const LAS bf16x8*)(lds + O_K + slot * 8192 + rowoff(keycol, 64 * ks + 16 * fq)); acc = __builtin_amdgcn_mfma_f32_16x16x32_bf16(a, Bq[ks], acc, 0, 0, 0); }
#pragma unroll
                for (int e = 0; e < 4; ++e) { const int kc = c0 + 16 * ct + 4 * fq + e; const bool valid = (kc >= cs) && (kc < cs + 16);
                    int dc = kc - jq; dc = dc < -15 ? -15 : (dc > 15 ? 15 : dc); dc += 15;
                    const float sc = valid ? (acc[e] * 0.125f + RPB[dr * 31 + dc]) : -1e30f; acc[e] = sc; mloc = fmaxf(mloc, sc); }
                S[r4][ct] = acc; } }
        { int lid; asm volatile("v_mbcnt_lo_u32_b32 %0, -1, 0\n\tv_mbcnt_hi_u32_b32 %0, -1, %0" : "=v"(lid));
          mloc = fmaxf(mloc, __int_as_float(__builtin_amdgcn_ds_bpermute((lid ^ 16) << 2, __float_as_int(mloc))));
          mloc = fmaxf(mloc, __int_as_float(__builtin_amdgcn_ds_bpermute((lid ^ 32) << 2, __float_as_int(mloc)))); }
        bf16x8 Ap[4];
#pragma unroll
        for (int r4 = 0; r4 < 4; ++r4) { float pv[8];
#pragma unroll
            for (int ct = 0; ct < 2; ++ct)
#pragma unroll
                for (int e = 0; e < 4; ++e) { const float sc = S[r4][ct][e]; pv[ct * 4 + e] = (sc > -1e29f) ? __expf(sc - mloc) : 0.f; }
            const u32x4 w = (u32x4){pk2(pv[0], pv[1]), pk2(pv[2], pv[3]), pk2(pv[4], pv[5]), pk2(pv[6], pv[7])}; Ap[r4] = __builtin_bit_cast(bf16x8, w); }
        f32x4 O[4], Ls = (f32x4){0.f, 0.f, 0.f, 0.f};
#pragma unroll
        for (int dt = 0; dt < 4; ++dt) O[dt] = (f32x4){0.f, 0.f, 0.f, 0.f};
#pragma unroll
        for (int r4 = 0; r4 < 4; ++r4) { const int slot = (rs + 4 * kh + r4) & 7; const int kc0 = c0 + 4 * fq + (fr >> 2), kc1 = kc0 + 16;
            Ls = __builtin_amdgcn_mfma_f32_16x16x32_bf16(Ap[r4], __builtin_bit_cast(bf16x8, onesv), Ls, 0, 0, 0);
#pragma unroll
            for (int dt = 0; dt < 4; ++dt) {
                const s16x4 v0 = __builtin_amdgcn_ds_read_tr16_b64_v4i16((LAS s16x4*)(lds + O_V + slot * 8192 + rowoff(kc0, 32 * dt + 8 * (fr & 3))));
                const s16x4 v1 = __builtin_amdgcn_ds_read_tr16_b64_v4i16((LAS s16x4*)(lds + O_V + slot * 8192 + rowoff(kc1, 32 * dt + 8 * (fr & 3))));
                const bf16x8 bv = (bf16x8){v0[0], v0[1], v0[2], v0[3], v1[0], v1[1], v1[2], v1[3]};
                O[dt] = __builtin_amdgcn_mfma_f32_16x16x32_bf16(Ap[r4], bv, O[dt], 0, 0, 0); } }
        if (fq == 0) *(LAS float*)(MX + kh * 64 + fr * 4) = mloc;
        if (kh == 1) { if (fr == 0) *(LAS f32x4*)(MX + 128 + fq * 16) = Ls;
#pragma unroll
            for (int dt = 0; dt < 4; ++dt)
#pragma unroll
                for (int e = 0; e < 4; ++e) *(LAS bf16_t*)(MX + 192 + (4 * fq + e) * 128 + (16 * dt + fr) * 2) = (bf16_t)f2bf(O[dt][e]); }
        __syncthreads();
        if (newrow) { const int kr = rsn + 7;
            { const int q = tid; const int which = q >> 9, col = (q >> 3) & 63, ch = q & 7; *(LAS u32x4*)(lds + (which ? O_V : O_K) + (kr & 7) * 8192 + rowoff(col, 16 * ch)) = pre0; }
            { const int q = tid + 512; const int which = q >> 9, col = (q >> 3) & 63, ch = q & 7; *(LAS u32x4*)(lds + (which ? O_V : O_K) + (kr & 7) * 8192 + rowoff(col, 16 * ch)) = pre1; } }
        if (kh == 0) {
            const f32x4 m0 = *(const LAS f32x4*)(MX + fq * 16), m1 = *(const LAS f32x4*)(MX + 64 + fq * 16), l1 = *(const LAS f32x4*)(MX + 128 + fq * 16);
#pragma unroll
            for (int e = 0; e < 4; ++e) { const float M = fmaxf(m0[e], m1[e]), a0 = __expf(m0[e] - M), a1 = __expf(m1[e] - M); const float inv = frcp(Ls[e] * a0 + l1[e] * a1);
                const size_t row = (size_t)b * L + i * 64 + j0 + 4 * fq + e;
#pragma unroll
                for (int dt = 0; dt < 4; ++dt) { const float o1 = bf2f(*(const LAS bf16_t*)(MX + 192 + (4 * fq + e) * 128 + (16 * dt + fr) * 2));
                    mix[row * D + 768 + h * 64 + 16 * dt + fr] = (bf16_t)f2bf((O[dt][e] * a0 + o1 * a1) * inv); } }
        }
        Bq[0] = Bqn[0]; Bq[1] = Bqn[1];
    }
    __syncthreads();
}

__device__ __forceinline__ void na_queue(const Params& p, LAS unsigned char* lds, int l, const int wvx) {
    int* ctr = (int*)(p.ws + OFF_CTL) + 16 + l;
    LAS int* qw = (LAS int*)(lds + na::O_QW);
    for (;;) {
        __syncthreads();
        if (opaque_tid(wvx) == 0) *qw = atomicAdd(ctr, 1);
        __syncthreads();
        const int strip = __builtin_amdgcn_readfirstlane(*qw);
        if (strip >= 256) break;
        na_strip(p, lds, l, strip, wvx);
    }
}

__device__ __forceinline__ void phase_router(const Params& p, LAS unsigned char* lds, int l, int G_, int bid, const int wvx) {
    const int tid = opaque_tid(wvx), lane = tid & 63, wave = __builtin_amdgcn_readfirstlane(tid >> 6), fr = lane & 15, fq = lane >> 4;
    const bf16_t* x = (const bf16_t*)(p.ws + OFF_XB); float* rs = (float*)(p.ws + OFF_RS);
    const bf16_t* rgh = (const bf16_t*)(p.ws + OFF_RGW) + (size_t)l * 2 * 48 * D; const bf16_t* rgl = rgh + 48 * D;
    int* cnt = (int*)(p.ws + OFF_CTL) + 64 + l * 64;
    int* ltok = (int*)(p.ws + OFF_LTOK); float* lgate = (float*)(p.ws + OFF_LGATE); float* lrs = (float*)(p.ws + OFF_LRS);
    LAS int* lcnt = (LAS int*)lds;
    LAS int* lbase = lcnt + 32;
    LAS int* se = lbase + 32;
    LAS int* sp = se + 512;
    LAS float* sg = (LAS float*)(sp + 512);
    LAS float* LG = (LAS float*)(lds + 8192);
    LAS float* SQ = LG + 256 * 52;
    const float* bg = p.in[29] + l * 4; const float* be = p.in[31] + l * 32;
    for (int chunk = bid; chunk < NT / 256; chunk += G_) {
        __syncthreads();
        if (tid < 32) lcnt[tid] = 0;
        const int tl0 = wave * 32;
        const bf16_t* xa_p = x + (size_t)(chunk * 256 + tl0 + fr) * D + 8 * fq; const bf16_t* xb_p = xa_p + 16 * D;
        const bf16_t* wh_p = rgh + (size_t)fr * D + 8 * fq; const bf16_t* wl_p = rgl + (size_t)fr * D + 8 * fq;
        f32x4 acc[2][3];
#pragma unroll
        for (int t = 0; t < 2; ++t)
#pragma unroll
            for (int c = 0; c < 3; ++c) acc[t][c] = (f32x4){0.f, 0.f, 0.f, 0.f};
        float ssa = 0.f, ssb = 0.f;
#pragma unroll 2
        for (int ks = 0; ks < 32; ++ks) {
            const u32x4 ar = *(const u32x4*)(xa_p + 32 * ks), br = *(const u32x4*)(xb_p + 32 * ks);
            bf16x8 wh[3], wl[3];
#pragma unroll
            for (int c = 0; c < 3; ++c) { wh[c] = *(const bf16x8*)(wh_p + (size_t)16 * c * D + 32 * ks); wl[c] = *(const bf16x8*)(wl_p + (size_t)16 * c * D + 32 * ks); }
            { float f[8]; unpack8(ar, f);
#pragma unroll
              for (int j = 0; j < 8; ++j) ssa += f[j] * f[j];
              unpack8(br, f);
#pragma unroll
              for (int j = 0; j < 8; ++j) ssb += f[j] * f[j]; }
            const bf16x8 a0 = __builtin_bit_cast(bf16x8, ar), a1 = __builtin_bit_cast(bf16x8, br);
#pragma unroll
            for (int c = 0; c < 3; ++c) {
                acc[0][c] = __builtin_amdgcn_mfma_f32_16x16x32_bf16(a0, wh[c], acc[0][c], 0, 0, 0); acc[0][c] = __builtin_amdgcn_mfma_f32_16x16x32_bf16(a0, wl[c], acc[0][c], 0, 0, 0);
                acc[1][c] = __builtin_amdgcn_mfma_f32_16x16x32_bf16(a1, wh[c], acc[1][c], 0, 0, 0); acc[1][c] = __builtin_amdgcn_mfma_f32_16x16x32_bf16(a1, wl[c], acc[1][c], 0, 0, 0); }
        }
#pragma unroll
        for (int t = 0; t < 2; ++t)
#pragma unroll
            for (int c = 0; c < 3; ++c)
#pragma unroll
                for (int e = 0; e < 4; ++e) LG[(tl0 + 16 * t + 4 * fq + e) * 52 + 16 * c + fr] = acc[t][c][e];
        SQ[(tl0 + fr) * 4 + fq] = ssa; SQ[(tl0 + 16 + fr) * 4 + fq] = ssb;
        __syncthreads();
        if (lane < 32) { const int tl = tl0 + lane, row = chunk * 256 + tl;
            const f32x4 s4 = *(const LAS f32x4*)(SQ + tl * 4);
            const float rr = 1.0f / sqrtf(((s4.x + s4.y) + (s4.z + s4.w)) * (1.0f / D) + NORM_EPS);
            rs[row] = rr; SQ[tl * 4] = rr;
            const LAS float* lg = LG + tl * 52;
            const float g0 = lg[0] * rr + bg[0], g1 = lg[1] * rr + bg[1], g2 = lg[2] * rr + bg[2], g3 = lg[3] * rr + bg[3];
            int gs = 0; float gm = g0; if (g1 > gm) { gm = g1; gs = 1; } if (g2 > gm) { gm = g2; gs = 2; } if (g3 > gm) { gm = g3; gs = 3; }
            const float gprob = 1.0f / (expf(g0 - gm) + expf(g1 - gm) + expf(g2 - gm) + expf(g3 - gm));
            float ev[8];
#pragma unroll
            for (int e = 0; e < 8; ++e) ev[e] = lg[4 + gs * 8 + e] * rr + be[gs * 8 + e];
            int i0 = 0; float v0 = ev[0];
#pragma unroll
            for (int e = 1; e < 8; ++e) if (ev[e] > v0) { v0 = ev[e]; i0 = e; }
            int i1 = -1; float v1 = -3.0e38f;
#pragma unroll
            for (int e = 0; e < 8; ++e) if (e != i0 && ev[e] > v1) { v1 = ev[e]; i1 = e; }
            const float e1 = expf(v1 - v0), den = 1.0f + e1;
            const int ea = gs * 8 + i0, eb = gs * 8 + i1;
            se[tl * 2] = ea; se[tl * 2 + 1] = eb; sg[tl * 2] = gprob / den; sg[tl * 2 + 1] = gprob * e1 / den;
            sp[tl * 2] = atomicAdd((int*)lcnt + ea, 1); sp[tl * 2 + 1] = atomicAdd((int*)lcnt + eb, 1); }
        __syncthreads();
        if (tid < 32) lbase[tid] = atomicAdd(cnt + tid, lcnt[tid]);
        __syncthreads();
        { const int tl = tid >> 1, k = tid & 1, e = se[tid]; const size_t li = (size_t)e * LCAP + lbase[e] + sp[tid];
            ltok[li] = (chunk * 256 + tl) * 2 + k; lgate[li] = sg[tid]; lrs[li] = SQ[tl * 4]; }
    }
    __syncthreads();
}

__device__ __forceinline__ void phase_combine(const Params& p, bool last, int G_, int bid, const int wvx) {
    const int tid = opaque_tid(wvx), lane = tid & 63, wave = tid >> 6;
    float* out = p.out; bf16_t* x16 = (bf16_t*)(p.ws + OFF_XB); float* rs = (float*)(p.ws + OFF_RS);
    const bf16_t* yb = (const bf16_t*)(p.ws + OFF_YBUF);
    const float* gf = p.in[35];
    for (int row = bid * 8 + wave; row < NT; row += G_ * 8) {
        u32x2* xr = (u32x2*)(x16 + (size_t)row * D) + lane; const u32x2* y0 = (const u32x2*)(yb + (size_t)(2 * row) * D) + lane; const u32x2* y1 = (const u32x2*)(yb + (size_t)(2 * row + 1) * D) + lane;
        f32x4 v[4]; float s = 0.f; u32x2 xq[4], aq[4], cq[4];
#pragma unroll
        for (int j = 0; j < 4; ++j) { xq[j] = xr[64 * j]; aq[j] = y0[64 * j]; cq[j] = y1[64 * j]; }
#pragma unroll
        for (int j = 0; j < 4; ++j) { const u32x2 xx = xq[j], a = aq[j], c = cq[j];
            v[j].x = bf2f(xx.x & 0xffffu) + bf2f(a.x & 0xffffu) + bf2f(c.x & 0xffffu); v[j].y = __uint_as_float(xx.x & 0xffff0000u) + __uint_as_float(a.x & 0xffff0000u) + __uint_as_float(c.x & 0xffff0000u);
            v[j].z = bf2f(xx.y & 0xffffu) + bf2f(a.y & 0xffffu) + bf2f(c.y & 0xffffu); v[j].w = __uint_as_float(xx.y & 0xffff0000u) + __uint_as_float(a.y & 0xffff0000u) + __uint_as_float(c.y & 0xffff0000u);
            s += (v[j].x * v[j].x + v[j].y * v[j].y) + (v[j].z * v[j].z + v[j].w * v[j].w); }
        s = wave_sum(s);
        const float rr = 1.0f / sqrtf(s * (1.0f / D) + NORM_EPS);
        if (last) { f32x4* orow = (f32x4*)(out + (size_t)row * D) + lane;
#pragma unroll
            for (int j = 0; j < 4; ++j) { const f32x4 g = ((const f32x4*)gf)[lane + 64 * j]; orow[64 * j] = v[j] * rr * g; }
        } else {
            if (lane == 0) rs[row] = rr;
#pragma unroll
            for (int j = 0; j < 4; ++j) xr[64 * j] = (u32x2){pk2(v[j].x, v[j].y), pk2(v[j].z, v[j].w)};
        }
    }
}

#ifndef PH_MASK
#define PH_MASK 0xFFFFF
#endif
#define PH(k) if (PH_MASK & (1 << (k)))

#define XB_TMO      128
#define XB_XCNT(j)  (256  + 64 * (j))
#define XB_XSUB(j)  (1280 + 64 * (j))
#define XB_XGEN(j)  (2304 + 64 * (j))
#define XB_TOP      3328
#define XB_TOPGEN   3392
#define XCD_BAR_WORDS 3456
#define XB_SPIN_CAP (1u << 22)
__device__ __forceinline__ unsigned xb_ld(unsigned* p)              { return __hip_atomic_load(p, __ATOMIC_RELAXED, __HIP_MEMORY_SCOPE_AGENT); }
__device__ __forceinline__ unsigned xb_add(unsigned* p, unsigned v) { return __hip_atomic_fetch_add(p, v, __ATOMIC_RELAXED, __HIP_MEMORY_SCOPE_AGENT); }
__device__ __forceinline__ unsigned xb_xcc_id() { return (unsigned)__builtin_amdgcn_s_getreg((3 << 11) | 20) & 0xFu; }
#define XB_SPIN(cond, bar) do { unsigned _sp = 0; while (cond) { __builtin_amdgcn_s_sleep(1); \
    if ((++_sp & 255u) == 0u) { if (xb_ld(&(bar)[XB_TMO])) break; if (_sp > XB_SPIN_CAP) { atomicAdd(&(bar)[XB_TMO], 1u); break; } } } } while (0)
struct XcdBarrier { unsigned* bar; unsigned x; volatile LAS unsigned* st; };
__device__ __forceinline__ void xcd_barrier_complete(unsigned* bar, unsigned x, unsigned& nloc, unsigned& nx) {
    const unsigned G = gridDim.x * gridDim.y * gridDim.z;
    unsigned sum, cnt, mine, sp = 0u;
    for (;;) {
        sum = 0u; cnt = 0u; mine = 0u;
#pragma unroll
        for (unsigned j = 0; j < 16; ++j) { const unsigned c = xb_ld(&bar[XB_XCNT(j)]); sum += c; cnt += (c > 0u) ? 1u : 0u; mine = (j == x) ? c : mine; }
        if (sum == G) break;
        __builtin_amdgcn_s_sleep(1);
        if ((++sp & 255u) == 0u) { if (xb_ld(&bar[XB_TMO])) break; if (sp > XB_SPIN_CAP) { atomicAdd(&bar[XB_TMO], 1u); break; } }
    }
    nloc = mine > 0u ? mine : 1u; nx = cnt > 0u ? cnt : 1u;
}
__device__ __forceinline__ void xcd_barrier(const XcdBarrier& b, const bool leader) {
    asm volatile("s_waitcnt vmcnt(0)" ::: "memory");
    __syncthreads();
    if (leader) {
        unsigned* bar = b.bar;
        __builtin_amdgcn_s_waitcnt(0);
        unsigned nloc = b.st[0], nx = b.st[1];
        if (nloc == 0u) { xcd_barrier_complete(bar, b.x, nloc, nx); b.st[0] = nloc; b.st[1] = nx; }
        const unsigned old = xb_add(&bar[XB_XSUB(b.x)], 1u);
        const unsigned gen = old / nloc;
        if (old + 1u == (gen + 1u) * nloc) {
            __builtin_amdgcn_fence(__ATOMIC_RELEASE, "agent");
            asm volatile("s_waitcnt vmcnt(0)" ::: "memory");
            const unsigned og = xb_add(&bar[XB_TOP], 1u);
            const unsigned tg = og / nx;
            if (og + 1u == (tg + 1u) * nx) xb_add(&bar[XB_TOPGEN], 1u);
            else XB_SPIN(xb_ld(&bar[XB_TOPGEN]) == tg, bar);
            __builtin_amdgcn_fence(__ATOMIC_ACQUIRE, "agent");
            xb_add(&bar[XB_XGEN(b.x)], 1u);
            asm volatile("s_waitcnt vmcnt(0)" ::: "memory");
        } else {
            XB_SPIN(xb_ld(&bar[XB_XGEN(b.x)]) == gen, bar);
            __builtin_amdgcn_fence(__ATOMIC_ACQUIRE, "agent");
            asm volatile("s_waitcnt vmcnt(0)" ::: "memory");
        }
    }
    __syncthreads();
}

__device__ __forceinline__ Params load_params() {
#if defined(__HIP_DEVICE_COMPILE__)
    auto k = __builtin_amdgcn_kernarg_segment_ptr();
    asm volatile("" : "+s"(k));
    return *(const __attribute__((address_space(4))) Params*)k;
#else
    return Params{};
#endif
}
__global__ void __launch_bounds__(NTHREADS, 2) fwd_megakernel(Params p_unused) {
    extern __shared__ __attribute__((aligned(16))) unsigned char lds_raw[];
    LAS unsigned char* lds = (LAS unsigned char*)lds_raw;
    cg::grid_group grid = cg::this_grid();
    const int G_ = gridDim.x, bid = blockIdx.x;
    const int wvx = __builtin_amdgcn_readfirstlane((int)threadIdx.x >> 6);
    const bool leader = (threadIdx.x == 0);
    volatile LAS unsigned* bst = (volatile LAS unsigned*)(lds + LDS_BYTES - 16);
    if (leader) { bst[0] = 0u; bst[1] = 0u; }
    XcdBarrier xbar;
    { const Params p = load_params(); xbar.bar = (unsigned*)(p.ws + OFF_CTL) + 4096; xbar.x = xb_xcc_id(); xbar.st = bst;
      if (leader) (void)xb_add(&xbar.bar[XB_XCNT(xbar.x)], 1u); }
    __syncthreads();
#define GRID_BAR() do { const Params pb = load_params(); XcdBarrier xb2; xb2.bar = (unsigned*)(pb.ws + OFF_CTL) + 4096; xb2.x = xb_xcc_id(); xb2.st = bst; xcd_barrier(xb2, opaque_tid(wvx) == 0); } while (0)

    { const Params p = load_params(); PH(0) phase_prologue(p, lds, G_, bid, wvx); }
    { const Params p = load_params(); PH(0) filters_all(p, G_, bid, wvx); }
    { const Params p = load_params(); PH(1) phase_rownorm(p.in[0], (bf16_t*)(p.ws + OFF_XB), (float*)(p.ws + OFF_RS), G_, bid, wvx); }
    grid.sync();

#pragma unroll 1
    for (int l = 0; l < DEPTH; ++l) {
        PH(2) { const Params p = load_params(); unsigned char* ws = p.ws;
            DenseSched S; S.init((const bf16_t*)(ws + OFF_XB), (const bf16_t*)(ws + OFF_WTIN) + (size_t)l * IN_DP * D, NT, IN_DP, D, G_, bid);
            EpiProj E{(bf16_t*)(ws + OFF_PROJ), (const float*)(ws + OFF_RS)};
            pg8::gemm_phase<EpiProj, DenseSched, false>(lds, D, S, E, wvx);
        }
        GRID_BAR();
        {
            const bool lead = (opaque_tid(wvx) == 0);
            LAS int* qw = (LAS int*)(lds + na::O_QW);
#define CTR(k) ((int*)(load_params().ws + OFF_CTL) + 32 + l * 16 + (k))
            PH(5) for (;;) { const int u = wg_pop(CTR(6), qw, lead); if (u >= 1024) break; { const Params p = load_params(); rw_prep_unit(p, l, u, wvx); } wg_signal(CTR(8 + (u >> 7)), lead);
                             if (bid < 128 && u >= 128) break; }
            if (bid < 128) { PH(5) { const Params p = load_params(); rw_chain_unit(p, lds, l, bid, wvx); } }
            PH(3) for (;;) { const int u = wg_pop(CTR(0), qw, lead); if (u >= 1024) break; { const Params p = load_params(); hy_pre_unit4(p, lds, l, u, wvx); } wg_signal(CTR(1), lead); }
            wg_wait(CTR(1), 1024, lead);
            PH(4) for (;;) { const int c = wg_pop(CTR(7), qw, lead); if (c >= 256) break; { const Params p = load_params(); hy_conv_unit(p, lds, l, c, wvx); } wg_signal(CTR(2), lead); }
            PH(6) { const Params p = load_params(); na_queue(p, lds, l, wvx); }
            wg_wait(CTR(2), 256, lead);
            PH(7) for (;;) { const int u = wg_pop(CTR(3), qw, lead); if (u >= 1024) break; { const Params p = load_params(); hy_post_unit4(p, lds, l, u, wvx); } wg_signal(CTR(4), lead); }
            wg_wait(CTR(4), 1024, lead);
            PH(10) for (;;) { const int u = wg_pop(CTR(5), qw, lead); if (u >= NEXP * 768 / 64 + (l == 0 ? 43 : 0)) break; { const Params p = load_params(); moe_weights_chunk(p, lds, l, u, wvx); } }
#undef CTR
        }
        GRID_BAR();
        PH(8) { const Params p = load_params(); rw_post_wg(p, lds, l, G_, bid, wvx); }
        GRID_BAR();
        PH(9) { const Params p = load_params(); unsigned char* ws = p.ws;
            DenseSched S; S.init((const bf16_t*)(ws + OFF_MIX), (const bf16_t*)(ws + OFF_WTOUT) + (size_t)l * D * D, NT, D, D, G_, bid);
            EpiRes E{(bf16_t*)(ws + OFF_XB)};
            pg8::gemm_phase<EpiRes, DenseSched, false>(lds, D, S, E, wvx);
        }
        GRID_BAR();
        PH(11) { const Params p = load_params(); phase_router(p, lds, l, G_, bid, wvx); }
        GRID_BAR();
        PH(12) { const Params p = load_params(); unsigned char* ws = p.ws;
            const int* cnt = (const int*)(ws + OFF_CTL) + 64 + l * 64;
            MoeSched S; S.init(cnt, (const bf16_t*)(ws + OFF_XB), (const bf16_t*)(ws + OFF_W13T), (size_t)1024 * D, (const int*)(ws + OFF_LTOK), D, G_, bid, (LAS int*)(lds + 139264), opaque_tid(wvx));
            EpiMoe1 E{(bf16_t*)(ws + OFF_ACT), (const float*)(ws + OFF_LRS)};
            pg8::gemm_phase<EpiMoe1, MoeSched, true>(lds, D, S, E, wvx);
        }
        GRID_BAR();
        PH(13) { const Params p = load_params(); unsigned char* ws = p.ws;
            const int* cnt = (const int*)(ws + OFF_CTL) + 64 + l * 64;
            MoeSched S; S.init(cnt, (const bf16_t*)(ws + OFF_ACT), (const bf16_t*)(ws + OFF_W2T), (size_t)D * FF, nullptr, FF, G_, bid, (LAS int*)(lds + 139264), opaque_tid(wvx));
            EpiMoe2 E{(bf16_t*)(ws + OFF_YBUF), (const int*)(ws + OFF_LTOK), (const float*)(ws + OFF_LGATE)};
            pg8::gemm_phase<EpiMoe2, MoeSched, false>(lds, FF, S, E, wvx);
        }
        GRID_BAR();
        PH(14) { const Params p = load_params(); phase_combine(p, l == DEPTH - 1, G_, bid, wvx); }
        if (l < DEPTH - 1) GRID_BAR();
    }
}

extern "C" void kernel_launch(void* const* d_in, const int* in_sizes, int n_in, void* d_out, int out_size, void* d_ws, size_t ws_size, hipStream_t stream) {
    static int grid = 0;
    if (grid == 0) {
        if (n_in != 36 || ws_size < WS_END) { fprintf(stderr, "kernel_launch: unexpected n_in %d / ws_size %zu (need %zu)\n", n_in, ws_size, (size_t)WS_END); grid = -1; return; }
        int dev = 0, cus = 0, per_cu = 0;
        hipGetDevice(&dev);
        hipDeviceGetAttribute(&cus, hipDeviceAttributeMultiprocessorCount, dev);
        hipFuncSetAttribute((const void*)fwd_megakernel, hipFuncAttributeMaxDynamicSharedMemorySize, LDS_BYTES);
        hipOccupancyMaxActiveBlocksPerMultiprocessor(&per_cu, (const void*)fwd_megakernel, NTHREADS, LDS_BYTES);
        if (per_cu < 1) { fprintf(stderr, "kernel_launch: occupancy query says %d blocks per CU\n", per_cu); per_cu = 1; }
        if (per_cu > 1) per_cu = 1;
        grid = cus * per_cu;
        if (grid != 256) { fprintf(stderr, "kernel_launch: this kernel needs exactly 256 co-resident workgroups (got %d)\n", grid); if (grid > 256) grid = 256; }
        fprintf(stderr, "kernel_launch: grid %d (cus %d), ws %zu\n", grid, cus, ws_size);
    }
    if (grid < 0) return;
    hipMemsetAsync((char*)d_ws + OFF_CTL, 0, 65536, stream);
    Params p{};
    for (int i = 0; i < 36; ++i) p.in[i] = (const float*)d_in[i];
    p.out = (float*)d_out; p.ws = (unsigned char*)d_ws;
    void* args[] = {&p};
    hipError_t e = hipLaunchCooperativeKernel((const void*)fwd_megakernel, dim3(grid), dim3(NTHREADS), args, LDS_BYTES, stream);
    if (e != hipSuccess) fprintf(stderr, "cooperative launch failed: %s (grid %d)\n", hipGetErrorString(e), grid);
}
```

```cpp
#include <hip/hip_runtime.h>
#include <hip/hip_cooperative_groups.h>
#include <cstdio>
#include <cstdint>
namespace cg = cooperative_groups;

#define LAS __attribute__((address_space(3)))
typedef unsigned short bf16_t;
typedef short bf16x8 __attribute__((ext_vector_type(8)));
typedef float f32x4 __attribute__((ext_vector_type(4)));
typedef float f32x2 __attribute__((ext_vector_type(2)));
typedef unsigned u32x4 __attribute__((ext_vector_type(4)));
typedef unsigned u32x2 __attribute__((ext_vector_type(2)));

constexpr int D = 1024, NB = 8, L = 8192, NT = NB * L, DEPTH = 2;
constexpr int IN_D = 3456, IN_DP = 3584;
constexpr int C_HX0 = 0, C_HX1 = 256, C_HV = 512, C_RR = 768, C_RK = 1280, C_RV = 1792, C_RG = 2304, C_RW = 2432, C_RA = 2560, C_NQ = 2688, C_NK = 2944, C_NV = 3200;
constexpr int NEXP = 32, FF = 512;
constexpr float NORM_EPS = 1e-6f;

constexpr size_t MiB = 1u << 20;
constexpr size_t OFF_CTL = 0;
constexpr size_t OFF_WTIN = 1 * MiB;
constexpr size_t OFF_WTOUT = 15 * MiB;
constexpr size_t OFF_RS = 19 * MiB;
constexpr size_t OFF_RGW = 20 * MiB;
constexpr size_t OFF_LTOK = 21 * MiB;
constexpr size_t OFF_LGATE = 29 * MiB;
constexpr size_t OFF_FILT = 37 * MiB;
constexpr size_t OFF_MOEW = 69 * MiB;
constexpr size_t OFF_W13T = OFF_MOEW, OFF_W2T = OFF_MOEW + 64 * MiB;
constexpr size_t OFF_ZT = OFF_MOEW;
constexpr size_t OFF_YT = OFF_MOEW + 32 * MiB;
constexpr size_t OFF_XB = 165 * MiB;
constexpr size_t OFF_MIX = 869 * MiB;
constexpr size_t OFF_PROJ = 293 * MiB;
constexpr size_t OFF_ACT = OFF_PROJ;
constexpr size_t OFF_YBUF = OFF_PROJ + 136 * MiB;
constexpr size_t OFF_YF = 741 * MiB;
constexpr size_t OFF_YB = 805 * MiB;
constexpr size_t OFF_BON = 997 * MiB;
constexpr size_t OFF_LRS = 1001 * MiB;
constexpr size_t WS_END = 1009 * MiB;
constexpr int LCAP = 65536;

constexpr int LDS_BYTES = 163840;
constexpr int NTHREADS = 512;

struct Params { const float* in[36]; float* out; unsigned char* ws; };

__device__ __forceinline__ float bf2f(unsigned b) { return __uint_as_float(b << 16); }
typedef __bf16 bf16x2_t __attribute__((ext_vector_type(2)));
__device__ __forceinline__ unsigned f2bf(float f) { return (unsigned)__builtin_bit_cast(unsigned short, (__bf16)f); }
__device__ __forceinline__ unsigned pk2(float lo, float hi) { const f32x2 v = {lo, hi}; return __builtin_bit_cast(unsigned, __builtin_convertvector(v, bf16x2_t)); }
#define DPPF(v, ctrl) __int_as_float(__builtin_amdgcn_update_dpp(0, __float_as_int(v), (ctrl), 0xF, 0xF, true))
__device__ __forceinline__ float rdlane(float v, int l) { return __int_as_float(__builtin_amdgcn_readlane(__float_as_int(v), l)); }
__device__ __forceinline__ float wave_sum(float v) {
    v += DPPF(v, 0xB1); v += DPPF(v, 0x4E); v += DPPF(v, 0x141); v += DPPF(v, 0x140);
    return (rdlane(v, 0) + rdlane(v, 16)) + (rdlane(v, 32) + rdlane(v, 48));
}
__device__ __forceinline__ float sum8(float v) { v += DPPF(v, 0xB1); v += DPPF(v, 0x4E); v += DPPF(v, 0x141); return v; }
__device__ __forceinline__ void unpack8(const u32x4 w, float* f) {
    f[0] = bf2f(w.x & 0xffffu); f[1] = __uint_as_float(w.x & 0xffff0000u);
    f[2] = bf2f(w.y & 0xffffu); f[3] = __uint_as_float(w.y & 0xffff0000u);
    f[4] = bf2f(w.z & 0xffffu); f[5] = __uint_as_float(w.z & 0xffff0000u);
    f[6] = bf2f(w.w & 0xffffu); f[7] = __uint_as_float(w.w & 0xffff0000u);
}
__device__ __forceinline__ float frcp(float x) { return __builtin_amdgcn_rcpf(x); }
__device__ __forceinline__ float ftanh(float x) { const float e = __expf(2.0f * x); return 1.0f - 2.0f * frcp(e + 1.0f); }
#define LDS_WAIT() asm volatile("s_waitcnt lgkmcnt(0)" ::: "memory")
__device__ __forceinline__ int opaque_tid(int wvx) { int ln; asm volatile("v_mbcnt_lo_u32_b32 %0, -1, 0\n\tv_mbcnt_hi_u32_b32 %0, -1, %0" : "=v"(ln)); return wvx * 64 + ln; }

namespace pg8 {
constexpr int BM = 256, BK = 64, HALF = 128, HTB = HALF * BK * 2, STAGE_BYTES = 8 * HTB;
__device__ __forceinline__ int lds_byte(int r, int c) { const int st = (r >> 4) * 2 + (c >> 5), rr = r & 15, cc = c & 31, ob = rr * 64 + cc * 2; return st * 1024 + (ob ^ (((ob >> 9) & 1) << 5)); }
__device__ __forceinline__ void stage_rc(int b, int& R, int& C) { const int st = b / 1024, sb = b % 1024, swz = sb ^ (((sb >> 9) & 1) << 5); R = (st >> 1) * 16 + swz / 64; C = (st & 1) * 32 + (swz % 64) / 2; }
__device__ __forceinline__ int perm32(int rho) { const int n = rho >> 4, i = rho & 15; return 8 * (i >> 2) + 4 * n + (i & 3); }
__device__ __forceinline__ unsigned cvt_pk_bf16(float lo, float hi) { return pk2(lo, hi); }

struct Unit { const char* A; const char* B; int pm, pn, e, cnt; };

template <class Epi, class Sched, bool GATHER>
__device__ __forceinline__ void gemm_phase(LAS unsigned char* lds, const int K, const Sched& S, const Epi& E, const int wvx) {
    const int tid = opaque_tid(wvx), wid = __builtin_amdgcn_readfirstlane(tid >> 6), lane = tid & 63, wr = wid >> 2, wc = wid & 3, fr = lane & 15, fq = lane >> 4;
    const int nt = K / BK;
    int Rr[2], Cc[2];
    unsigned voffB[2];
#pragma unroll
    for (int i = 0; i < 2; ++i) { stage_rc(tid * 16 + i * 8192, Rr[i], Cc[i]); const int Rb = Epi::PERM ? ((Rr[i] & ~31) + perm32(Rr[i] & 31)) : Rr[i];
        voffB[i] = (unsigned)(Rb * K + Cc[i]) * 2u; }
    const size_t kstep = (size_t)(BK * 2);
    const size_t hstep = (size_t)HALF * K * 2;
    const unsigned ldsw = (unsigned)wid * 1024u;
    const int aoff = lds_byte(wr * 64 + fr, fq * 8), boff = lds_byte(wc * 32 + fr, fq * 8);
#define PG8_SA(b, h) (((b) * 2 + (h)) * HTB)
#define PG8_SB(b, h) ((4 + (b) * 2 + (h)) * HTB)
#define PG8_STAGE(bufoff, gbase, voff) do { _Pragma("unroll") for (int _i = 0; _i < 2; ++_i) \
        __builtin_amdgcn_global_load_lds((const unsigned*)((const char*)(gbase) + (voff)[_i]), (LAS unsigned*)(lds + (bufoff) + ldsw + _i * 8192), 16, 0, 0); } while (0)
#define PG8_LDA(dst, b, h) do { _Pragma("unroll") for (int m = 0; m < 4; ++m) _Pragma("unroll") for (int k = 0; k < 2; ++k) dst[m][k] = *(const LAS bf16x8*)(lds + PG8_SA(b, h) + aoff + m * 2048 + k * 1024); } while (0)
#define PG8_LDB(dst, b, h) do { _Pragma("unroll") for (int n = 0; n < 2; ++n) _Pragma("unroll") for (int k = 0; k < 2; ++k) dst[n][k] = *(const LAS bf16x8*)(lds + PG8_SB(b, h) + boff + n * 2048 + k * 1024); } while (0)
#define PG8_MMA(ai, bj, At, Bt) do { __builtin_amdgcn_s_setprio(1); _Pragma("unroll") for (int m = 0; m < 4; ++m) _Pragma("unroll") for (int n = 0; n < 2; ++n) _Pragma("unroll") for (int k = 0; k < 2; ++k) \
        acc[ai][bj][m][n] = __builtin_amdgcn_mfma_f32_16x16x32_bf16(Bt[n][k], At[m][k], acc[ai][bj][m][n], 0, 0, 0); __builtin_amdgcn_s_setprio(0); } while (0)
#define PG8_WAIT_V(n) asm volatile("s_waitcnt vmcnt(" #n ")" ::: "memory")
#define PG8_WAIT_L(n) asm volatile("s_waitcnt lgkmcnt(" #n ")" ::: "memory")
#define PG8_BAR __builtin_amdgcn_s_barrier()
#define PG8_SCHED __builtin_amdgcn_sched_barrier(0)
    Unit cur, nxt; int ui = 0;
    if (!S.next(0, cur)) return;
    f32x4 acc[2][2][4][2];
#pragma unroll
    for (int a = 0; a < 2; ++a)
#pragma unroll
        for (int b = 0; b < 2; ++b)
#pragma unroll
            for (int m = 0; m < 4; ++m)
#pragma unroll
                for (int n = 0; n < 2; ++n) acc[a][b][m][n] = (f32x4){0.f, 0.f, 0.f, 0.f};
    bf16x8 At[4][2], B0[2][2], B1[2][2];
    typename Epi::Pre epre;
    unsigned vA[2][2];
    LAS u32x4* stash = (LAS u32x4*)(lds + STAGE_BYTES) + tid;
    if (GATHER) S.aoff(cur, tid, vA);
    else {
#pragma unroll
        for (int h = 0; h < 2; ++h)
#pragma unroll
            for (int i = 0; i < 2; ++i) vA[h][i] = (unsigned)((h * HALF + Rr[i]) * K + Cc[i]) * 2u;
    }
    const char* cA = cur.A; const char* cB = cur.B;
    PG8_STAGE(PG8_SB(0, 0), cB, voffB); PG8_STAGE(PG8_SB(0, 1), cB + hstep, voffB); PG8_STAGE(PG8_SA(0, 0), cA, vA[0]); PG8_STAGE(PG8_SA(0, 1), cA, vA[1]);
    if (wr == 1) PG8_BAR;
    PG8_WAIT_V(2); PG8_BAR;
    PG8_STAGE(PG8_SB(1, 0), cB + kstep, voffB); PG8_STAGE(PG8_SA(1, 0), cA + kstep, vA[0]); PG8_STAGE(PG8_SB(1, 1), cB + hstep + kstep, voffB);
    PG8_WAIT_V(6); PG8_BAR;
    for (;;) {
        const bool has_next = S.next(ui + 1, nxt);
        const char* nA = has_next ? nxt.A : cA; const char* nB = has_next ? nxt.B : cB;
        if (GATHER) { unsigned vn[2][2];
            if (has_next) { S.aoff(nxt, tid, vn); *stash = (u32x4){vn[0][0], vn[0][1], vn[1][0], vn[1][1]}; }
            else *stash = (u32x4){vA[0][0], vA[0][1], vA[1][0], vA[1][1]}; }
        for (int t = 0; t < nt; t += 2) {
            const bool last = (t == nt - 2);
            const char* a1 = cA + (size_t)(t + 1) * kstep;
            const char* a2 = last ? nA : cA + (size_t)(t + 2) * kstep; const char* b2 = last ? nB : cB + (size_t)(t + 2) * kstep;
            const char* a3 = a2 + kstep; const char* b3 = b2 + kstep;
            if (last) E.prefetch(epre, cur, wr, wc, fr, fq);
            PG8_LDB(B0, 0, 0); PG8_LDB(B1, 0, 1); PG8_SCHED; PG8_LDA(At, 0, 0); PG8_STAGE(PG8_SA(1, 1), a1, vA[1]);
            if (GATHER && last) { const u32x4 sv = *stash; vA[0][0] = sv.x; vA[0][1] = sv.y; vA[1][0] = sv.z; vA[1][1] = sv.w; }
            PG8_WAIT_V(8); PG8_WAIT_L(0); PG8_BAR; PG8_MMA(0, 0, At, B0); PG8_MMA(0, 1, At, B1); PG8_BAR; PG8_SCHED;
            PG8_LDA(At, 0, 1); PG8_STAGE(PG8_SB(0, 0), b2, voffB); PG8_STAGE(PG8_SB(0, 1), b2 + hstep, voffB); PG8_STAGE(PG8_SA(0, 0), a2, vA[0]);
            PG8_WAIT_V(8); PG8_WAIT_L(0); PG8_BAR; PG8_MMA(1, 0, At, B0); PG8_MMA(1, 1, At, B1); PG8_BAR; PG8_SCHED;
            PG8_LDB(B0, 1, 0); PG8_LDB(B1, 1, 1); PG8_SCHED; PG8_LDA(At, 1, 0); PG8_STAGE(PG8_SA(0, 1), a2, vA[1]);
            PG8_WAIT_V(8); PG8_WAIT_L(0); PG8_BAR; PG8_MMA(0, 0, At, B0); PG8_MMA(0, 1, At, B1); PG8_BAR; PG8_SCHED;
            PG8_LDA(At, 1, 1); PG8_STAGE(PG8_SB(1, 0), b3, voffB); PG8_STAGE(PG8_SB(1, 1), b3 + hstep, voffB); PG8_STAGE(PG8_SA(1, 0), a3, vA[0]);
            PG8_WAIT_V(8); PG8_WAIT_L(0); PG8_BAR; PG8_MMA(1, 0, At, B0); PG8_MMA(1, 1, At, B1); PG8_BAR; PG8_SCHED;
        }
        if (wr == 0) PG8_BAR;
        {
            Unit eu = cur; int efr = fr, efq = fq;
            eu.pm = __builtin_amdgcn_readfirstlane(eu.pm); eu.pn = __builtin_amdgcn_readfirstlane(eu.pn); eu.e = __builtin_amdgcn_readfirstlane(eu.e); eu.cnt = __builtin_amdgcn_readfirstlane(eu.cnt);
            asm volatile("" : "+s"(eu.pm), "+s"(eu.pn), "+s"(eu.e), "+s"(eu.cnt), "+v"(efr), "+v"(efq));
            E(acc, eu, wr, wc, efr, efq, epre);
        }
        if (!has_next) break;
#pragma unroll
        for (int a = 0; a < 2; ++a)
#pragma unroll
            for (int b = 0; b < 2; ++b)
#pragma unroll
                for (int m = 0; m < 4; ++m)
#pragma unroll
                    for (int n = 0; n < 2; ++n) acc[a][b][m][n] = (f32x4){0.f, 0.f, 0.f, 0.f};
        cur = nxt; cA = nA; cB = nB; ++ui;
        if (wr == 1) PG8_BAR;
    }
    PG8_WAIT_V(0);
    PG8_BAR;
#undef PG8_SA
#undef PG8_SB
#undef PG8_STAGE
#undef PG8_LDA
#undef PG8_LDB
#undef PG8_MMA
#undef PG8_WAIT_V
#undef PG8_WAIT_L
#undef PG8_BAR
#undef PG8_SCHED
}
}

struct DenseSched {
    const bf16_t* A; const bf16_t* Bt; int K, nM, nN, nwg, G, c;
    __device__ void init(const bf16_t* A_, const bf16_t* Bt_, int M, int N, int K_, int G_, int c_) { A = A_; Bt = Bt_; K = K_; nM = M / 256; nN = N / 256; nwg = nM * nN; G = G_; c = c_; }
    __device__ __forceinline__ bool next(int i, pg8::Unit& u) const {
        const long Lx = (long)i * G + c; if (Lx >= nwg) return false;
        int wgid = (int)Lx; { const int q = nwg / 8, r = nwg % 8, xcd = wgid % 8, off = wgid / 8; wgid = (xcd < r ? xcd * (q + 1) : r * (q + 1) + (xcd - r) * q) + off; }
        const int nig = 8 * nN, gid = wgid / nig, fm = gid * 8, gsz = (nM - fm) < 8 ? (nM - fm) : 8;
        u.pm = fm + ((wgid % nig) % gsz); u.pn = (wgid % nig) / gsz; u.e = 0; u.cnt = 0;
        u.A = (const char*)A + (size_t)u.pm * 256 * K * 2; u.B = (const char*)Bt + (size_t)u.pn * 256 * K * 2; return true;
    }
    __device__ __forceinline__ void aoff(const pg8::Unit&, int, unsigned (&)[2][2]) const {}
};
struct MoeSched {
    const bf16_t* A; const bf16_t* Bt; size_t bstride;
    const int* ltok;
    LAS int* tp;
    int K, G, c, total;
    __device__ void init(const int* cnt_, const bf16_t* A_, const bf16_t* Bt_, size_t bstride_, const int* ltok_, int K_, int G_, int c_, LAS int* lds_tab, int tid) {
        A = A_; Bt = Bt_; bstride = bstride_; ltok = ltok_; K = K_; G = G_; c = (G_ % 8 == 0) ? (c_ & 7) * (G_ >> 3) + (c_ >> 3) : c_;
        tp = lds_tab;
        __syncthreads();
        if (tid < 32) tp[64 + tid] = cnt_[tid];
        __syncthreads();
        if (tid == 0) { int t = 0; for (int e = 0; e < NEXP; ++e) { tp[e] = t; t += (tp[64 + e] + 255) >> 8; } tp[32] = t; }
        __syncthreads();
        total = __builtin_amdgcn_readfirstlane(tp[32]);
    }
    __device__ __forceinline__ bool next(int i, pg8::Unit& u) const {
        const long Lx = (long)i * G + c; if (Lx >= (long)total * 4) return false;
        const int ti = (int)(Lx >> 2); u.pn = (int)(Lx & 3);
        int ln; asm volatile("v_mbcnt_lo_u32_b32 %0, -1, 0\n\tv_mbcnt_hi_u32_b32 %0, -1, %0" : "=v"(ln));
        const int l5 = ln & 31; const int lo = tp[l5], hi = tp[l5 + 1];
        const unsigned long long mask = __builtin_amdgcn_ballot_w64(lo <= ti && ti < hi);
        const int e = __builtin_amdgcn_readfirstlane((int)__builtin_ctzll(mask) & 31);
        const int base = __builtin_amdgcn_readfirstlane(tp[e]), ce = __builtin_amdgcn_readfirstlane(tp[64 + e]);
        u.e = e; u.pm = ti; u.cnt = ce - (ti - base) * 256;
        u.A = ltok ? (const char*)A : (const char*)A + (size_t)ti * 256 * K * 2;
        u.B = (const char*)(Bt + (size_t)e * bstride) + (size_t)u.pn * 256 * K * 2;
        u.pm = ti | ((ti - base) << 16);
        return true;
    }
    __device__ __forceinline__ void aoff(const pg8::Unit& u, int tid, unsigned (&v)[2][2]) const {
        const int lt = u.pm >> 16; int Rr[2], Cc[2]; pg8::stage_rc(tid * 16, Rr[0], Cc[0]); pg8::stage_rc(tid * 16 + 8192, Rr[1], Cc[1]);
        int tk[2][2];
#pragma unroll
        for (int h = 0; h < 2; ++h)
#pragma unroll
            for (int i = 0; i < 2; ++i) { const int r = h * 128 + Rr[i]; tk[h][i] = ltok[(size_t)u.e * LCAP + lt * 256 + (r < u.cnt ? r : 0)]; }
#pragma unroll
        for (int h = 0; h < 2; ++h)
#pragma unroll
            for (int i = 0; i < 2; ++i) { const int r = h * 128 + Rr[i]; const int tok = (r < u.cnt) ? (tk[h][i] >> 1) : 0; v[h][i] = (unsigned)(tok * K + Cc[i]) * 2u; }
    }
};

struct EpiProj {
    static constexpr bool PERM = true;
    struct Pre { float rs[8]; };
    bf16_t* O; const float* rs;
    __device__ __forceinline__ void prefetch(Pre& pr, const pg8::Unit& u, int wr, int wc, int fr, int fq) const {
        const int row0 = (u.pm & 0xffff) * 256 + wr * 64 + fr;
#pragma unroll
        for (int ai = 0; ai < 2; ++ai)
#pragma unroll
            for (int m = 0; m < 4; ++m) pr.rs[ai * 4 + m] = rs[row0 + ai * 128 + m * 16];
    }
    __device__ __forceinline__ void operator()(const f32x4 (&acc_)[2][2][4][2], const pg8::Unit& u, int wr, int wc, int fr, int fq, const Pre& pr) const {
        const int row0 = u.pm * 256 + wr * 64 + fr, col0 = u.pn * 256 + wc * 32 + 8 * fq;
        f32x4 (&acc)[2][2][4][2] = const_cast<f32x4 (&)[2][2][4][2]>(acc_);
        const bool act = (u.pn == 9);
        if (act) {
#pragma unroll
            for (int ai = 0; ai < 2; ++ai)
#pragma unroll
                for (int m = 0; m < 4; ++m) { const float s = pr.rs[ai * 4 + m];
#pragma unroll
                    for (int n = 0; n < 2; ++n)
#pragma unroll
                        for (int e = 0; e < 4; ++e) { acc[ai][0][m][n][e] = frcp(1.0f + __expf(-acc[ai][0][m][n][e] * s)); acc[ai][1][m][n][e] = ftanh(acc[ai][1][m][n][e] * s); } }
            asm volatile("" ::: "memory");
        }
#pragma unroll
        for (int ai = 0; ai < 2; ++ai)
#pragma unroll
            for (int m = 0; m < 4; ++m) { const int row = row0 + ai * 128 + m * 16; const float s = act ? 1.0f : pr.rs[ai * 4 + m]; bf16_t* rowp = O + (size_t)row * IN_DP + col0;
#pragma unroll
                for (int bj = 0; bj < 2; ++bj) { const f32x4 v0 = acc[ai][bj][m][0] * s, v1 = acc[ai][bj][m][1] * s;
                    u32x4 w; w.x = pg8::cvt_pk_bf16(v0[0], v0[1]); w.y = pg8::cvt_pk_bf16(v0[2], v0[3]); w.z = pg8::cvt_pk_bf16(v1[0], v1[1]); w.w = pg8::cvt_pk_bf16(v1[2], v1[3]);
                    *(u32x4*)(rowp + bj * 128) = w; } }
    }
};
struct EpiRes {
    static constexpr bool PERM = true;
    struct Pre { int dummy; };
    bf16_t* x16;
    __device__ __forceinline__ void prefetch(Pre&, const pg8::Unit&, int, int, int, int) const {}
    __device__ __forceinline__ void operator()(const f32x4 (&acc)[2][2][4][2], const pg8::Unit& u, int wr, int wc, int fr, int fq, const Pre&) const {
        const int row0 = u.pm * 256 + wr * 64 + fr, col0 = u.pn * 256 + wc * 32 + 8 * fq;
#pragma unroll
        for (int ai = 0; ai < 2; ++ai) {
            u32x4 braw[4][2];
#pragma unroll
            for (int m = 0; m < 4; ++m)
#pragma unroll
                for (int bj = 0; bj < 2; ++bj) braw[m][bj] = *(const u32x4*)(x16 + (size_t)(row0 + ai * 128 + m * 16) * D + col0 + bj * 128);
            asm volatile("" ::: "memory");
#pragma unroll
            for (int m = 0; m < 4; ++m) { const size_t off = (size_t)(row0 + ai * 128 + m * 16) * D + col0;
#pragma unroll
                for (int bj = 0; bj < 2; ++bj) { const f32x4 v0 = acc[ai][bj][m][0], v1 = acc[ai][bj][m][1]; float bb[8]; unpack8(braw[m][bj], bb);
                    u32x4 w; w.x = pk2(bb[0] + v0[0], bb[1] + v0[1]); w.y = pk2(bb[2] + v0[2], bb[3] + v0[3]); w.z = pk2(bb[4] + v1[0], bb[5] + v1[1]); w.w = pk2(bb[6] + v1[2], bb[7] + v1[3]);
                    *(u32x4*)(x16 + off + bj * 128) = w; } }
            asm volatile("" ::: "memory");
        }
    }
};
struct EpiMoe1 {
    static constexpr bool PERM = true;
    struct Pre { int dummy; };
    bf16_t* act; const float* lrs;
    __device__ __forceinline__ void prefetch(Pre&, const pg8::Unit&, int, int, int, int) const {}
    __device__ __forceinline__ void operator()(const f32x4 (&acc)[2][2][4][2], const pg8::Unit& u, int wr, int wc, int fr, int fq, const Pre&) const {
        const int ti = u.pm & 0xffff, lt = u.pm >> 16;
        const int r0 = wr * 64 + fr, col0 = u.pn * 256 + wc * 32 + 8 * fq;
        float sv[8];
#pragma unroll
        for (int q = 0; q < 8; ++q) { const int r = r0 + (q >> 2) * 128 + (q & 3) * 16; sv[q] = (r < u.cnt) ? lrs[(size_t)u.e * LCAP + lt * 256 + r] : 0.f; }
        asm volatile("" ::: "memory");
#pragma unroll
        for (int ai = 0; ai < 2; ++ai)
#pragma unroll
            for (int m = 0; m < 4; ++m) { const int r = r0 + ai * 128 + m * 16;
                const float s = sv[ai * 4 + m];
                bf16_t* rowp = act + ((size_t)ti * 256 + r) * FF + (col0 >> 1);
#pragma unroll
                for (int bj = 0; bj < 2; ++bj) { const f32x4 v0 = acc[ai][bj][m][0] * s, v1 = acc[ai][bj][m][1] * s;
                    const float o0 = v0[0] * frcp(1.f + __expf(-v0[0])) * v0[1], o1 = v0[2] * frcp(1.f + __expf(-v0[2])) * v0[3];
                    const float o2 = v1[0] * frcp(1.f + __expf(-v1[0])) * v1[1], o3 = v1[2] * frcp(1.f + __expf(-v1[2])) * v1[3];
                    u32x2 w; w.x = pg8::cvt_pk_bf16(o0, o1); w.y = pg8::cvt_pk_bf16(o2, o3);
                    *(u32x2*)(rowp + bj * 64) = w; } }
    }
};
struct EpiMoe2 {
    static constexpr bool PERM = true;
    struct Pre { int dummy; };
    bf16_t* ybuf; const int* ltok; const float* lgate;
    __device__ __forceinline__ void prefetch(Pre&, const pg8::Unit&, int, int, int, int) const {}
    __device__ __forceinline__ void operator()(const f32x4 (&acc)[2][2][4][2], const pg8::Unit& u, int wr, int wc, int fr, int fq, const Pre&) const {
        const int lt = u.pm >> 16, r0 = wr * 64 + fr, col0 = u.pn * 256 + wc * 32 + 8 * fq;
        int dv[8]; float gv[8];
#pragma unroll
        for (int q = 0; q < 8; ++q) { const int r = r0 + (q >> 2) * 128 + (q & 3) * 16; const bool ok = r < u.cnt;
            const size_t li = (size_t)u.e * LCAP + lt * 256 + (ok ? r : 0); const int d = ltok[li]; const float g = lgate[li];
            dv[q] = ok ? d : -1; gv[q] = g; }
        asm volatile("" ::: "memory");
#pragma unroll
        for (int ai = 0; ai < 2; ++ai)
#pragma unroll
            for (int m = 0; m < 4; ++m) { const int dest = dv[ai * 4 + m];
                if (dest >= 0) { const float g = gv[ai * 4 + m];
                    bf16_t* rowp = ybuf + (size_t)dest * D + col0;
#pragma unroll
                    for (int bj = 0; bj < 2; ++bj) { const f32x4 v0 = acc[ai][bj][m][0] * g, v1 = acc[ai][bj][m][1] * g;
                        u32x4 w; w.x = pg8::cvt_pk_bf16(v0[0], v0[1]); w.y = pg8::cvt_pk_bf16(v0[2], v0[3]); w.z = pg8::cvt_pk_bf16(v1[0], v1[1]); w.w = pg8::cvt_pk_bf16(v1[2], v1[3]);
                        *(u32x4*)(rowp + bj * 128) = w; } } }
    }
};

__device__ __forceinline__ void transpose_item(const float* __restrict__ W, int K, int N, bf16_t* WT, int rmul, int radd, const float* __restrict__ g, LAS float* scr, int item, int lane) {
    const int nblk = N / 32, kb = item / nblk, nb = item % nblk, k0 = 64 * kb, n0 = 32 * nb;
    f32x4 v[8]; float gv[8];
#pragma unroll
    for (int i = 0; i < 8; ++i) { v[i] = *(const f32x4*)(W + (size_t)(k0 + 8 * i + (lane >> 3)) * N + n0 + 4 * (lane & 7)); gv[i] = g ? g[k0 + 8 * i + (lane >> 3)] : 1.0f; }
#pragma unroll
    for (int i = 0; i < 8; ++i) { const int kk = 8 * i + (lane >> 3); *(LAS f32x4*)(scr + kk * 36 + 4 * (lane & 7)) = v[i] * gv[i]; }
    LDS_WAIT(); asm volatile("" ::: "memory");
    const int c = lane & 7;
#pragma unroll
    for (int j = 0; j < 4; ++j) { const int n = (lane >> 3) + 8 * j; const LAS float* s = scr + (8 * c) * 36 + n;
        u32x4 o; o.x = pk2(s[0 * 36], s[1 * 36]); o.y = pk2(s[2 * 36], s[3 * 36]); o.z = pk2(s[4 * 36], s[5 * 36]); o.w = pk2(s[6 * 36], s[7 * 36]);
        *(u32x4*)(WT + (size_t)(rmul * (n0 + n) + radd) * K + k0 + 8 * c) = o; }
    LDS_WAIT(); asm volatile("" ::: "memory");
}

__device__ __forceinline__ void filt_item8(const Params& p, int l, int m0, int lane, float* G) {
    const float* w1 = p.in[5] + l * 33 * 64; const float* w2 = p.in[7] + l * 4096; const float* w3 = p.in[9] + l * 4096; const float* wout = p.in[11] + l * 64 * 512;
    const float b1v = p.in[6][l * 64 + lane], b2v = p.in[8][l * 64 + lane], b3v = p.in[10][l * 64 + lane], fr = p.in[12][l * 64 + lane];
    float hcur[8], acc[8];
    {
#pragma unroll
        for (int j = 0; j < 8; ++j) { const int m = m0 + j; float zl = 0.f;
            const float wv = (6.283185307179586f / 8192.0f) * (float)m; const float fstep = (15.0f - 1e-4f) / 15.0f;
            if (lane == 0) zl = (float)m / 8191.0f; else if (lane <= 16) zl = cosf((1e-4f + (float)(lane - 1) * fstep) * wv); else if (lane <= 32) zl = -sinf((1e-4f + (float)(lane - 17) * fstep) * wv);
            hcur[j] = zl; acc[j] = b1v; }
        float wc[33];
#pragma unroll
        for (int i = 0; i < 33; ++i) wc[i] = w1[i * 64 + lane];
#pragma unroll
        for (int i = 0; i < 33; ++i)
#pragma unroll
            for (int j = 0; j < 8; ++j) acc[j] += rdlane(hcur[j], i) * wc[i];
#pragma unroll
        for (int j = 0; j < 8; ++j) { hcur[j] = sinf(fr * acc[j]); acc[j] = b2v; }
    }
    asm volatile("" ::: "memory");
    {   float wc[64];
#pragma unroll
        for (int i = 0; i < 64; ++i) wc[i] = w2[i * 64 + lane];
#pragma unroll
        for (int i = 0; i < 64; ++i)
#pragma unroll
            for (int j = 0; j < 8; ++j) acc[j] += rdlane(hcur[j], i) * wc[i];
#pragma unroll
        for (int j = 0; j < 8; ++j) { hcur[j] = sinf(fr * acc[j]); acc[j] = b3v; }
    }
    asm volatile("" ::: "memory");
    {   float wc[64];
#pragma unroll
        for (int i = 0; i < 64; ++i) wc[i] = w3[i * 64 + lane];
#pragma unroll
        for (int i = 0; i < 64; ++i)
#pragma unroll
            for (int j = 0; j < 8; ++j) acc[j] += rdlane(hcur[j], i) * wc[i];
#pragma unroll
        for (int j = 0; j < 8; ++j) hcur[j] = sinf(fr * acc[j]);
    }
    asm volatile("" ::: "memory");
    float (&h3)[8] = hcur;
    float o[8][8];
#pragma unroll
    for (int j = 0; j < 8; ++j)
#pragma unroll
        for (int q = 0; q < 8; ++q) o[j][q] = 0.f;
#pragma unroll 2
    for (int i = 0; i < 64; ++i) { float wo[8];
#pragma unroll
        for (int q = 0; q < 8; ++q) wo[q] = wout[i * 512 + q * 64 + lane];
#pragma unroll
        for (int j = 0; j < 8; ++j) { const float hv = rdlane(h3[j], i);
#pragma unroll
            for (int q = 0; q < 8; ++q) o[j][q] += hv * wo[q]; } }
    const float dmin = -3.0701134573253944f, dmax = -15.350567286626972f;
#pragma unroll
    for (int q = 0; q < 8; ++q) { const int n = q * 64 + lane, d = n >> 8, c = n & 255;
        const float delta = fabsf(dmin + (float)c * ((dmax - dmin) / 255.0f));
        float v[8];
#pragma unroll
        for (int j = 0; j < 8; ++j) v[j] = o[j][q] * expf(-((float)(m0 + j) / 8191.0f) * delta);
        float* dst = G + (size_t)c * 16384 + d * 8192 + m0;
        *(f32x4*)dst = (f32x4){v[0], v[1], v[2], v[3]}; *(f32x4*)(dst + 4) = (f32x4){v[4], v[5], v[6], v[7]}; }
}

__device__ __forceinline__ void phase_prologue(const Params& p, LAS unsigned char* lds, int G_, int bid, const int wvx) {
    const int tid = opaque_tid(wvx), lane = tid & 63, wave = tid >> 6;
    const int gw = bid * 8 + wave, NGW = G_ * 8;
    LAS float* scr = (LAS float*)(lds + wave * 16384);
    unsigned char* ws = p.ws;
    for (int it = gw; it < 16 * 108; it += NGW) transpose_item(p.in[2], D, IN_D, (bf16_t*)(ws + OFF_WTIN), 1, 0, p.in[1], scr, it, lane);
    for (int i = bid * NTHREADS + tid; i < 2 * 128 * D / 8; i += G_ * NTHREADS) { const int l = i / (128 * D / 8), r = i % (128 * D / 8);
        *(u32x4*)((bf16_t*)(ws + OFF_WTIN) + (size_t)l * IN_DP * D + (size_t)IN_D * D + (size_t)r * 8) = (u32x4){0u, 0u, 0u, 0u}; }
    for (int i = bid * NTHREADS + tid; i < 2 * 48 * D; i += G_ * NTHREADS) { const int l = i / (48 * D), r = i % (48 * D), o = r / D, k = r % D;
        const float g = p.in[27][l * D + k]; const float w = g * ((o < 4) ? p.in[28][((size_t)l * D + k) * 4 + o] : (o < 36 ? p.in[30][((size_t)l * D + k) * 32 + (o - 4)] : 0.f));
        const unsigned hi = f2bf(w); const float lo = w - bf2f(hi);
        bf16_t* rg = (bf16_t*)(ws + OFF_RGW) + (size_t)l * 2 * 48 * D; rg[o * D + k] = (bf16_t)hi; rg[48 * D + o * D + k] = (bf16_t)f2bf(lo); }
}
__device__ __forceinline__ void filters_all(const Params& p, int nwg, int rank, const int wvx) {
    const int tid = opaque_tid(wvx), lane = tid & 63, wave = tid >> 6;
    for (int it = rank * 8 + wave; it < 2 * (L / 8); it += nwg * 8) { const int l = it / (L / 8), m0 = (it % (L / 8)) * 8; filt_item8(p, l, m0, lane, (float*)(p.ws + OFF_FILT) + (size_t)l * 256 * 16384); }
}

__device__ __forceinline__ void moe_weights_chunk(const Params& p, LAS unsigned char* lds, int l, int chunk, const int wvx) {
    const int tid = opaque_tid(wvx), lane = tid & 63, wave = tid >> 6;
    LAS float* scr = (LAS float*)(lds + wave * 16384);
    bf16_t* W13 = (bf16_t*)(p.ws + OFF_W13T); bf16_t* W2 = (bf16_t*)(p.ws + OFF_W2T);
    const float* g = p.in[27] + l * D;
#pragma unroll 1
    for (int k = 0; k < 8; ++k) { const int it = chunk * 64 + wave * 8 + k;
        if (it >= NEXP * 768) { const int x = it - NEXP * 768;
            if (x < 16 * 108) transpose_item(p.in[2] + (size_t)D * IN_D, D, IN_D, (bf16_t*)(p.ws + OFF_WTIN) + (size_t)IN_DP * D, 1, 0, p.in[1] + D, scr, x, lane);
            else if (x < 16 * 108 + 1024) { const int y = x - 16 * 108, lo = y >> 9; transpose_item(p.in[26] + (size_t)lo * D * D, D, D, (bf16_t*)(p.ws + OFF_WTOUT) + (size_t)lo * D * D, 1, 0, nullptr, scr, y & 511, lane); }
            continue; }
        const int e = it / 768, r = it % 768;
        if (r < 256) transpose_item(p.in[32] + ((size_t)l * NEXP + e) * D * FF, D, FF, W13 + (size_t)e * 1024 * D, 2, 0, g, scr, r, lane);
        else if (r < 512) transpose_item(p.in[33] + ((size_t)l * NEXP + e) * D * FF, D, FF, W13 + (size_t)e * 1024 * D, 2, 1, g, scr, r - 256, lane);
        else transpose_item(p.in[34] + ((size_t)l * NEXP + e) * FF * D, FF, D, W2 + (size_t)e * D * FF, 1, 0, nullptr, scr, r - 512, lane); }
}
__device__ __forceinline__ void phase_rownorm(const float* x, bf16_t* xb, float* rs, int G_, int bid, const int wvx) {
    const int tid = opaque_tid(wvx), lane = tid & 63, wave = tid >> 6;
    for (int row = bid * 8 + wave; row < NT; row += G_ * 8) {
        const f32x4* xr = (const f32x4*)(x + (size_t)row * D) + lane; f32x4 v[4]; float s = 0.f;
#pragma unroll
        for (int j = 0; j < 4; ++j) { v[j] = xr[64 * j]; s += (v[j].x * v[j].x + v[j].y * v[j].y) + (v[j].z * v[j].z + v[j].w * v[j].w); }
        s = wave_sum(s);
        if (lane == 0) rs[row] = 1.0f / sqrtf(s * (1.0f / D) + NORM_EPS);
        u32x2* o = (u32x2*)(xb + (size_t)row * D) + lane;
#pragma unroll
        for (int j = 0; j < 4; ++j) o[64 * j] = (u32x2){pk2(v[j].x, v[j].y), pk2(v[j].z, v[j].w)};
    }
}

__device__ __forceinline__ void load8(const bf16_t* p, bool ok, float* f) { if (ok) { unpack8(*(const u32x4*)p, f); } else {
#pragma unroll
    for (int j = 0; j < 8; ++j) f[j] = 0.f; } }

__device__ __forceinline__ void hy_pre_unit(const Params& p, LAS unsigned char* lds, int l, int unit, const int wvx) {
    const int tid = opaque_tid(wvx);
    const int ct = unit & 3, tt = (unit >> 2) & 127, b = unit >> 9;
    const bf16_t* proj = (const bf16_t*)(p.ws + OFF_PROJ);
    bf16_t* zT = (bf16_t*)(p.ws + OFF_ZT);
    const float* cw = p.in[3] + l * 3 * 768; const float* cb = p.in[4] + l * 768;
    LAS bf16_t* tile = (LAS bf16_t*)lds;
    {
        const int tl = tid >> 3, c8 = (tid & 7) * 8, t = tt * 64 + tl, c = ct * 64 + c8;
        const bf16_t* row = proj + ((size_t)b * L + t) * IN_DP;
        float x1[3][8], vv[3][8];
        load8(row - IN_DP + C_HX1 + c, t > 0, x1[0]); load8(row + C_HX1 + c, true, x1[1]); load8(row + IN_DP + C_HX1 + c, t < L - 1, x1[2]);
        load8(row - IN_DP + C_HV + c, t > 0, vv[0]); load8(row + C_HV + c, true, vv[1]); load8(row + IN_DP + C_HV + c, t < L - 1, vv[2]);
#pragma unroll
        for (int j = 0; j < 8; ++j) { const int c1 = C_HX1 + c + j, c2 = C_HV + c + j;
            const float a = x1[0][j] * cw[c1] + x1[1][j] * cw[768 + c1] + x1[2][j] * cw[1536 + c1] + cb[c1];
            const float v = vv[0][j] * cw[c2] + vv[1][j] * cw[768 + c2] + vv[2][j] * cw[1536 + c2] + cb[c2];
            tile[(c8 + j) * 72 + tl] = (bf16_t)f2bf(a * v); }
    }
    __syncthreads();
    {
        const int cl = tid >> 3, seg = tid & 7;
        const u32x4 w = *(const LAS u32x4*)(tile + cl * 72 + seg * 8);
        *(u32x4*)(zT + ((size_t)(ct * 64 + cl) * NB + b) * L + tt * 64 + seg * 8) = w;
    }
    __syncthreads();
}

typedef float f32x16 __attribute__((ext_vector_type(16)));
__device__ __forceinline__ void hy_conv_unit(const Params& p, LAS unsigned char* lds, int l, int c, const int wvx) {
    const int tid = opaque_tid(wvx), lane = tid & 63, wave = __builtin_amdgcn_readfirstlane(tid >> 6);
    const float* G = (const float*)(p.ws + OFF_FILT) + ((size_t)l * 256 + c) * 16384;
    const bf16_t* zT = (const bf16_t*)(p.ws + OFF_ZT) + (size_t)c * NB * L;
    float* yT = (float*)(p.ws + OFF_YT) + (size_t)c * NB * L;
    LAS bf16_t* Re = (LAS bf16_t*)lds; LAS bf16_t* Ro = Re + 16384;
    LAS unsigned char* Zs = lds + 65536;
    constexpr int ZB = 8976;
    LAS float* red = (LAS float*)(lds + 65536 + 8 * ZB);
    __syncthreads();
    float ss = 0.f; const float GF0 = G[8192];
#pragma unroll 1
    for (int i0 = 0; i0 < 16384; i0 += 8 * NTHREADS) { float gq[8];
#pragma unroll
        for (int k = 0; k < 8; ++k) gq[k] = G[i0 + k * NTHREADS + tid];
#pragma unroll
        for (int k = 0; k < 8; ++k) { const int i = i0 + k * NTHREADS + tid; const float g = gq[k]; ss += g * g;
            if (i == 8192) { Ro[16383] = 0; Re[0] = 0; }
            else { const int dl = (i < 8192) ? i : (8192 - i); const bf16_t bv = (bf16_t)f2bf(i == 0 ? g + GF0 : g); Re[8192 - dl] = bv; Ro[8191 - dl] = bv; } } }
    ss = wave_sum(ss); if (lane == 0) red[wave] = ss;
    f32x16 acc[2][4];
#pragma unroll
    for (int mt = 0; mt < 2; ++mt)
#pragma unroll
        for (int i = 0; i < 4; ++i)
#pragma unroll
            for (int e = 0; e < 16; ++e) acc[mt][i][e] = 0.f;
    const int r = lane & 31, hh = lane >> 5;
#pragma unroll 1
    for (int h = 0; h < 2; ++h) {
        __syncthreads();
        { u32x4 zq[9]; int tq = tid; asm volatile("" : "+v"(tq));
#pragma unroll
          for (int k = 0; k < 9; ++k) { const int q = tq + k * NTHREADS; const int ch = q & 7, Jp = (q >> 3) % 70, b = (q >> 3) / 70; const int J = 64 * h + Jp - 3;
            zq[k] = (u32x4){0u, 0u, 0u, 0u}; if (q < 4480 && Jp >= 3 && Jp < 67) zq[k] = *(const u32x4*)(zT + (size_t)b * L + J * 64 + ch * 8); }
#pragma unroll
          for (int k = 0; k < 9; ++k) { const int q = tq + k * NTHREADS; const int ch = q & 7, Jp = (q >> 3) % 70, b = (q >> 3) / 70;
            if (q < 4480) *(LAS u32x4*)(Zs + b * ZB + Jp * 128 + ch * 16) = zq[k]; } }
        __syncthreads();
        int d_hi = 16 * wave + 15 - 64 * h, d_lo = 16 * wave - 64 * h - 63; d_hi = d_hi > 127 ? 127 : d_hi; d_lo = d_lo < -127 ? -127 : d_lo;
        int mlo = 16 * wave - 64 * h - 51, mhi = 16 * wave - 64 * h + 3; mlo = mlo < d_lo ? d_lo : mlo; mhi = mhi > d_hi ? d_hi : mhi; if (mlo > mhi) { mlo = d_hi + 1; mhi = d_hi; }
        const int abase = 8192 + 8 * hh - r - (r & 1) - 32;
        const LAS unsigned char* arow = lds + (r & 1) * 32768 + abase * 2;
        const LAS unsigned char* brow = Zs + (r & 7) * ZB + ((r >> 3) + 16 * wave - 64 * h + 3) * 128 + hh * 16;
#pragma unroll 1
        for (int part = 0; part < 2; ++part) {
            const int ga = part ? mhi + 1 : d_lo, gb = part ? d_hi : mlo - 1;
#pragma unroll 1
            for (int d = ga; d <= gb; ++d) {
                const int J0b = 16 * wave - d;
                const LAS unsigned* ap = (const LAS unsigned*)(arow - 128 * d);
                bf16x8 Af[2][4];
#pragma unroll
                for (int mt = 0; mt < 2; ++mt)
#pragma unroll
                    for (int ks = 0; ks < 4; ++ks) { const LAS unsigned* q = ap + (16 * ks + 32 * (1 - mt)) / 2; const u32x4 t = (u32x4){q[0], q[1], q[2], q[3]}; Af[mt][ks] = __builtin_bit_cast(bf16x8, t); }
                const LAS unsigned char* bp = brow - 128 * d;
#pragma unroll
                for (int i = 0; i < 4; ++i) { const int J0 = J0b + 4 * i;
                    if (J0 + 3 >= 64 * h && J0 <= 64 * h + 63) {
                        bf16x8 Bf[4];
#pragma unroll
                        for (int ks = 0; ks < 4; ++ks) Bf[ks] = *(const LAS bf16x8*)(bp + i * 512 + ks * 32);
#pragma unroll
                        for (int ks = 0; ks < 4; ++ks)
#pragma unroll
                            for (int mt = 0; mt < 2; ++mt) acc[mt][i] = __builtin_amdgcn_mfma_f32_32x32x16_bf16(Af[mt][ks], Bf[ks], acc[mt][i], 0, 0, 0);
                    } }
            }
            if (part == 0 && mlo <= mhi) {
#define HC_LDA(dst, p_, k_) do { const LAS unsigned* q_ = (const LAS unsigned*)(p_) + 8 * (k_); const u32x4 t_ = (u32x4){q_[0], q_[1], q_[2], q_[3]}; dst = __builtin_bit_cast(bf16x8, t_); } while (0)
#define HC_LDB(dst, p_, i_) do { _Pragma("unroll") for (int ks = 0; ks < 4; ++ks) dst[ks] = *(const LAS bf16x8*)((p_) + (i_) * 512 + ks * 32); } while (0)
#define HC_MMA(i_, Bx) do { _Pragma("unroll") for (int ks = 0; ks < 4; ++ks) { acc[1][i_] = __builtin_amdgcn_mfma_f32_32x32x16_bf16(F[ks], Bx[ks], acc[1][i_], 0, 0, 0); \
                                acc[0][i_] = __builtin_amdgcn_mfma_f32_32x32x16_bf16(F[ks + 2], Bx[ks], acc[0][i_], 0, 0, 0); } } while (0)
                bf16x8 F[6], B0[4], B1[4];
                { const LAS unsigned char* ap = arow - 128 * mlo;
#pragma unroll
                  for (int k = 0; k < 6; ++k) HC_LDA(F[k], ap, k); }
#pragma unroll 1
                for (int d = mlo; d <= mhi; ++d) {
                    const LAS unsigned char* bp = brow - 128 * d;
                    HC_LDB(B0, bp, 0);
                    HC_LDB(B1, bp, 1); __builtin_amdgcn_sched_barrier(0); HC_MMA(0, B0); __builtin_amdgcn_sched_barrier(0);
                    HC_LDB(B0, bp, 2); __builtin_amdgcn_sched_barrier(0); HC_MMA(1, B1); __builtin_amdgcn_sched_barrier(0);
                    HC_LDB(B1, bp, 3); __builtin_amdgcn_sched_barrier(0); HC_MMA(2, B0); __builtin_amdgcn_sched_barrier(0);
                    bf16x8 Fn[4];
                    { const LAS unsigned char* apn = arow - 128 * (d + 1);
#pragma unroll
                      for (int k = 0; k < 4; ++k) HC_LDA(Fn[k], apn, k); }
                    __builtin_amdgcn_sched_barrier(0); HC_MMA(3, B1); __builtin_amdgcn_sched_barrier(0);
                    F[4] = F[0]; F[5] = F[1]; F[0] = Fn[0]; F[1] = Fn[1]; F[2] = Fn[2]; F[3] = Fn[3];
                }
#undef HC_LDA
#undef HC_LDB
#undef HC_MMA
            }
        }
    }
    float tot = 0.f;
#pragma unroll
    for (int w = 0; w < 8; ++w) tot += red[w];
    const float scale = 1.0f / sqrtf(tot + 1e-6f);
#pragma unroll
    for (int mt = 0; mt < 2; ++mt)
#pragma unroll
        for (int i = 0; i < 4; ++i)
#pragma unroll
            for (int g = 0; g < 4; ++g) { const int t = 64 * (16 * wave + 4 * i + (r >> 3)) + 32 * mt + 8 * g + 4 * hh;
                const f32x4 v = (f32x4){acc[mt][i][4 * g] * scale, acc[mt][i][4 * g + 1] * scale, acc[mt][i][4 * g + 2] * scale, acc[mt][i][4 * g + 3] * scale};
                *(f32x4*)(yT + (size_t)(r & 7) * L + t) = v; }
    __syncthreads();
}

__device__ __forceinline__ void hy_post_unit(const Params& p, LAS unsigned char* lds, int l, int unit, const int wvx) {
    const int tid = opaque_tid(wvx);
    const int ct = unit & 3, tt = (unit >> 2) & 127, b = unit >> 9;
    const bf16_t* proj = (const bf16_t*)(p.ws + OFF_PROJ);
    const bf16_t* zT = (const bf16_t*)(p.ws + OFF_ZT);
    const float* yT = (const float*)(p.ws + OFF_YT);
    bf16_t* mix = (bf16_t*)(p.ws + OFF_MIX);
    const float* cw = p.in[3] + l * 3 * 768; const float* cb = p.in[4] + l * 768; const float* skip = p.in[13] + l * 256;
    LAS float* tile = (LAS float*)lds;
    {
        const int cl = tid >> 3, seg = tid & 7, c = ct * 64 + cl;
        const size_t off = ((size_t)c * NB + b) * L + tt * 64 + seg * 8;
        float z[8]; unpack8(*(const u32x4*)(zT + off), z);
        const f32x4 y0 = *(const f32x4*)(yT + off), y1 = *(const f32x4*)(yT + off + 4);
        const float sk = skip[c];
        tile[cl * 65 + seg * 8 + 0] = y0.x + z[0] * sk; tile[cl * 65 + seg * 8 + 1] = y0.y + z[1] * sk; tile[cl * 65 + seg * 8 + 2] = y0.z + z[2] * sk; tile[cl * 65 + seg * 8 + 3] = y0.w + z[3] * sk;
        tile[cl * 65 + seg * 8 + 4] = y1.x + z[4] * sk; tile[cl * 65 + seg * 8 + 5] = y1.y + z[5] * sk; tile[cl * 65 + seg * 8 + 6] = y1.z + z[6] * sk; tile[cl * 65 + seg * 8 + 7] = y1.w + z[7] * sk;
    }
    __syncthreads();
    {
        const int tl = tid >> 3, c8 = (tid & 7) * 8, t = tt * 64 + tl, c = ct * 64 + c8;
        const bf16_t* row = proj + ((size_t)b * L + t) * IN_DP;
        float x0[3][8];
        load8(row - IN_DP + C_HX0 + c, t > 0, x0[0]); load8(row + C_HX0 + c, true, x0[1]); load8(row + IN_DP + C_HX0 + c, t < L - 1, x0[2]);
        float o[8];
#pragma unroll
        for (int j = 0; j < 8; ++j) { const int c0 = c + j; const float a = x0[0][j] * cw[c0] + x0[1][j] * cw[768 + c0] + x0[2][j] * cw[1536 + c0] + cb[c0];
            o[j] = a * tile[(c8 + j) * 65 + tl]; }
        u32x4 w; w.x = pk2(o[0], o[1]); w.y = pk2(o[2], o[3]); w.z = pk2(o[4], o[5]); w.w = pk2(o[6], o[7]);
        *(u32x4*)(mix + ((size_t)b * L + t) * D + c) = w;
    }
    __syncthreads();
}


__device__ __forceinline__ void hy_pre_unit4(const Params& p, LAS unsigned char* lds, int l, int unit, const int wvx) {
    const int tid = opaque_tid(wvx);
    const int tt = unit & 127, b = unit >> 7;
    const bf16_t* proj = (const bf16_t*)(p.ws + OFF_PROJ);
    bf16_t* zT = (bf16_t*)(p.ws + OFF_ZT);
    const float* cw = p.in[3] + l * 3 * 768; const float* cb = p.in[4] + l * 768;
    LAS bf16_t* tile = (LAS bf16_t*)lds;
    const int tl = tid >> 3, c8 = (tid & 7) * 8, t = tt * 64 + tl;
    const bf16_t* row = proj + ((size_t)b * L + t) * IN_DP;
    const bool hp = t > 0, hn = t < L - 1;
    u32x4 rx[4][3], rv[4][3];
#pragma unroll
    for (int ct = 0; ct < 4; ++ct) { const int c = ct * 64 + c8;
        rx[ct][0] = *(const u32x4*)(row + (hp ? -IN_DP : 0) + C_HX1 + c); rx[ct][1] = *(const u32x4*)(row + C_HX1 + c); rx[ct][2] = *(const u32x4*)(row + (hn ? IN_DP : 0) + C_HX1 + c);
        rv[ct][0] = *(const u32x4*)(row + (hp ? -IN_DP : 0) + C_HV + c); rv[ct][1] = *(const u32x4*)(row + C_HV + c); rv[ct][2] = *(const u32x4*)(row + (hn ? IN_DP : 0) + C_HV + c); }
    const float mp = hp ? 1.f : 0.f, mn = hn ? 1.f : 0.f;
#pragma unroll
    for (int ct = 0; ct < 4; ++ct) { const int c = ct * 64 + c8;
        float x1[3][8], vv[3][8]; unpack8(rx[ct][0], x1[0]); unpack8(rx[ct][1], x1[1]); unpack8(rx[ct][2], x1[2]); unpack8(rv[ct][0], vv[0]); unpack8(rv[ct][1], vv[1]); unpack8(rv[ct][2], vv[2]);
        float wa[3][8], wb[3][8], ba[8], bb[8];
#pragma unroll
        for (int k = 0; k < 3; ++k) { const f32x4 a0 = *(const f32x4*)(cw + k * 768 + C_HX1 + c), a1 = *(const f32x4*)(cw + k * 768 + C_HX1 + c + 4), b0 = *(const f32x4*)(cw + k * 768 + C_HV + c), b1 = *(const f32x4*)(cw + k * 768 + C_HV + c + 4);
            wa[k][0] = a0.x; wa[k][1] = a0.y; wa[k][2] = a0.z; wa[k][3] = a0.w; wa[k][4] = a1.x; wa[k][5] = a1.y; wa[k][6] = a1.z; wa[k][7] = a1.w;
            wb[k][0] = b0.x; wb[k][1] = b0.y; wb[k][2] = b0.z; wb[k][3] = b0.w; wb[k][4] = b1.x; wb[k][5] = b1.y; wb[k][6] = b1.z; wb[k][7] = b1.w; }
        { const f32x4 a0 = *(const f32x4*)(cb + C_HX1 + c), a1 = *(const f32x4*)(cb + C_HX1 + c + 4), b0 = *(const f32x4*)(cb + C_HV + c), b1 = *(const f32x4*)(cb + C_HV + c + 4);
            ba[0] = a0.x; ba[1] = a0.y; ba[2] = a0.z; ba[3] = a0.w; ba[4] = a1.x; ba[5] = a1.y; ba[6] = a1.z; ba[7] = a1.w; bb[0] = b0.x; bb[1] = b0.y; bb[2] = b0.z; bb[3] = b0.w; bb[4] = b1.x; bb[5] = b1.y; bb[6] = b1.z; bb[7] = b1.w; }
#pragma unroll
        for (int j = 0; j < 8; ++j) {
            const float a = mp * x1[0][j] * wa[0][j] + x1[1][j] * wa[1][j] + mn * x1[2][j] * wa[2][j] + ba[j];
            const float v = mp * vv[0][j] * wb[0][j] + vv[1][j] * wb[1][j] + mn * vv[2][j] * wb[2][j] + bb[j];
            tile[(c + j) * 72 + tl] = (bf16_t)f2bf(a * v); } }
    __syncthreads();
#pragma unroll
    for (int ct = 0; ct < 4; ++ct) { const int cl = ct * 64 + (tid >> 3), seg = tid & 7;
        const u32x4 w = *(const LAS u32x4*)(tile + cl * 72 + seg * 8);
        *(u32x4*)(zT + ((size_t)cl * NB + b) * L + tt * 64 + seg * 8) = w; }
    __syncthreads();
}
__device__ __forceinline__ void hy_post_unit4(const Params& p, LAS unsigned char* lds, int l, int unit, const int wvx) {
    const int tid = opaque_tid(wvx);
    const int tt = unit & 127, b = unit >> 7;
    const bf16_t* proj = (const bf16_t*)(p.ws + OFF_PROJ);
    const bf16_t* zT = (const bf16_t*)(p.ws + OFF_ZT);
    const float* yT = (const float*)(p.ws + OFF_YT);
    bf16_t* mix = (bf16_t*)(p.ws + OFF_MIX);
    const float* cw = p.in[3] + l * 3 * 768; const float* cb = p.in[4] + l * 768; const float* skip = p.in[13] + l * 256;
    LAS float* tile = (LAS float*)lds;
    {
        u32x4 zq[4]; f32x4 y0q[4], y1q[4]; float skq[4];
#pragma unroll
        for (int ct = 0; ct < 4; ++ct) { const int c = ct * 64 + (tid >> 3), seg = tid & 7; const size_t off = ((size_t)c * NB + b) * L + tt * 64 + seg * 8;
            zq[ct] = *(const u32x4*)(zT + off); y0q[ct] = *(const f32x4*)(yT + off); y1q[ct] = *(const f32x4*)(yT + off + 4); skq[ct] = skip[c]; }
#pragma unroll
        for (int ct = 0; ct < 4; ++ct) { const int cl = ct * 64 + (tid >> 3), seg = tid & 7; float z[8]; unpack8(zq[ct], z); const float sk = skq[ct]; LAS float* tp = tile + cl * 65 + seg * 8;
            tp[0] = y0q[ct].x + z[0] * sk; tp[1] = y0q[ct].y + z[1] * sk; tp[2] = y0q[ct].z + z[2] * sk; tp[3] = y0q[ct].w + z[3] * sk;
            tp[4] = y1q[ct].x + z[4] * sk; tp[5] = y1q[ct].y + z[5] * sk; tp[6] = y1q[ct].z + z[6] * sk; tp[7] = y1q[ct].w + z[7] * sk; }
    }
    __syncthreads();
    {
        const int tl = tid >> 3, c8 = (tid & 7) * 8, t = tt * 64 + tl;
        const bf16_t* row = proj + ((size_t)b * L + t) * IN_DP;
        const bool hp = t > 0, hn = t < L - 1; const float mp = hp ? 1.f : 0.f, mn = hn ? 1.f : 0.f;
        u32x4 r0[4], r1[4], r2[4];
#pragma unroll
        for (int ct = 0; ct < 4; ++ct) { const int c = ct * 64 + c8; r0[ct] = *(const u32x4*)(row + (hp ? -IN_DP : 0) + C_HX0 + c); r1[ct] = *(const u32x4*)(row + C_HX0 + c); r2[ct] = *(const u32x4*)(row + (hn ? IN_DP : 0) + C_HX0 + c); }
#pragma unroll
        for (int ct = 0; ct < 4; ++ct) { const int c = ct * 64 + c8;
            float x0[3][8]; unpack8(r0[ct], x0[0]); unpack8(r1[ct], x0[1]); unpack8(r2[ct], x0[2]);
            float o[8];
#pragma unroll
            for (int j = 0; j < 8; ++j) { const int c0 = c + j; const float a = mp * x0[0][j] * cw[c0] + x0[1][j] * cw[768 + c0] + mn * x0[2][j] * cw[1536 + c0] + cb[c0];
                o[j] = a * tile[(c + j) * 65 + tl]; }
            u32x4 w; w.x = pk2(o[0], o[1]); w.y = pk2(o[2], o[3]); w.z = pk2(o[4], o[5]); w.w = pk2(o[6], o[7]);
            *(u32x4*)(mix + ((size_t)b * L + t) * D + c) = w; }
    }
    __syncthreads();
}


__device__ __forceinline__ void wg_signal(int* ctr, const bool leader, const int n = 1) {
    asm volatile("s_waitcnt vmcnt(0)" ::: "memory");
    __syncthreads();
    if (leader) { __builtin_amdgcn_fence(__ATOMIC_RELEASE, "agent"); asm volatile("s_waitcnt vmcnt(0)" ::: "memory"); __hip_atomic_fetch_add(ctr, n, __ATOMIC_RELAXED, __HIP_MEMORY_SCOPE_AGENT); }
}
__device__ __forceinline__ void wg_wait(int* ctr, int target, const bool leader) {
    if (leader) { unsigned sp = 0;
        while (__hip_atomic_load(ctr, __ATOMIC_RELAXED, __HIP_MEMORY_SCOPE_AGENT) < target) { __builtin_amdgcn_s_sleep(2); if (++sp > (1u << 24)) break; }
        __builtin_amdgcn_fence(__ATOMIC_ACQUIRE, "agent"); asm volatile("s_waitcnt vmcnt(0)" ::: "memory"); }
    __syncthreads();
}
__device__ __forceinline__ int wg_pop(int* ctr, LAS int* qw, const bool leader, const int n = 1) {
    __syncthreads();
    if (leader) *qw = __hip_atomic_fetch_add(ctr, n, __ATOMIC_RELAXED, __HIP_MEMORY_SCOPE_AGENT);
    __syncthreads();
    return __builtin_amdgcn_readfirstlane(*qw);
}
__device__ __forceinline__ void rw_prep_unit(const Params& p, int l, int unit, const int wvx) {
    const int tid = opaque_tid(wvx), cg = tid & 63, rg = tid >> 6;
    const int lev = unit >> 4, b = unit & 7; const int c = (unit & 8) ? 127 - lev : lev;
    const int t0 = c * 64 + rg * 8, col = cg * 8;
    const bf16_t* proj = (const bf16_t*)(p.ws + OFF_PROJ);
    bf16_t* PR = (bf16_t*)p.out;
    u32x4 raw[3][10];
#pragma unroll
    for (int w = 0; w < 3; ++w)
#pragma unroll
        for (int i = 0; i < 10; ++i) { const int t = t0 - 1 + i; const int tc = t < 0 ? 0 : (t > L - 1 ? L - 1 : t);
            raw[w][i] = *(const u32x4*)(proj + ((size_t)b * L + tc) * IN_DP + C_RR + w * 512 + col); }
    { const u32x4 z = (u32x4){0u, 0u, 0u, 0u};
      if (t0 == 0) { raw[0][0] = z; raw[1][0] = z; raw[2][0] = z; }
      if (t0 + 8 == L) { raw[0][9] = z; raw[1][9] = z; raw[2][9] = z; } }
    const float* mu = p.in[14] + (size_t)l * 3 * 2 * 512;
#pragma unroll
    for (int w = 0; w < 3; ++w) {
        float m0[8], m1[8], kk_[8];
        { const f32x4 a = *(const f32x4*)(mu + w * 1024 + col), b2 = *(const f32x4*)(mu + w * 1024 + col + 4), c = *(const f32x4*)(mu + w * 1024 + 512 + col), d = *(const f32x4*)(mu + w * 1024 + 512 + col + 4);
          m0[0] = a.x; m0[1] = a.y; m0[2] = a.z; m0[3] = a.w; m0[4] = b2.x; m0[5] = b2.y; m0[6] = b2.z; m0[7] = b2.w;
          m1[0] = c.x; m1[1] = c.y; m1[2] = c.z; m1[3] = c.w; m1[4] = d.x; m1[5] = d.y; m1[6] = d.z; m1[7] = d.w; }
        if (w == 1) { const f32x4 a = *(const f32x4*)(p.in[19] + l * 512 + col), b2 = *(const f32x4*)(p.in[19] + l * 512 + col + 4);
          kk_[0] = a.x; kk_[1] = a.y; kk_[2] = a.z; kk_[3] = a.w; kk_[4] = b2.x; kk_[5] = b2.y; kk_[6] = b2.z; kk_[7] = b2.w; }
#pragma unroll
        for (int j = 0; j < 8; ++j) {
            float xp[8], xc[8], xn[8], y[8];
            unpack8(raw[w][j], xp); unpack8(raw[w][j + 1], xc); unpack8(raw[w][j + 2], xn);
#pragma unroll
            for (int e = 0; e < 8; ++e) y[e] = xc[e] + m0[e] * (xp[e] - xc[e]) + m1[e] * (xn[e] - xc[e]);
            const size_t ro = ((size_t)b * L + t0 + j) * 512 + col;
            *(u32x4*)(PR + (size_t)w * NT * 512 + ro) = (u32x4){pk2(y[0], y[1]), pk2(y[2], y[3]), pk2(y[4], y[5]), pk2(y[6], y[7])};
            if (w == 1) { float kr[8], ss = 0.f;
#pragma unroll
                for (int e = 0; e < 8; ++e) { kr[e] = y[e] * kk_[e]; ss += kr[e] * kr[e]; }
                ss = sum8(ss);
                const float rn_ = __builtin_amdgcn_rsqf(fmaxf(ss, 1e-24f));
                *(u32x4*)(PR + (size_t)3 * NT * 512 + ro) = (u32x4){pk2(kr[0] * rn_, kr[1] * rn_), pk2(kr[2] * rn_, kr[3] * rn_), pk2(kr[4] * rn_, kr[5] * rn_), pk2(kr[6] * rn_, kr[7] * rn_)}; }
        }
    }
}

namespace rw {
constexpr int MATB = 9216, PITCH = 144;
constexpr int O_W2T = 0, O_A2T = MATB, O_SB = 2 * MATB, O_GBUF = 3 * MATB, O_SLOT = O_GBUF + 16384;
constexpr int O_GC = O_SLOT + 12 * MATB, O_TPP = O_GC + 512, O_CT = O_TPP + 2560, O_BONS = O_CT + 2816;
__device__ __forceinline__ constexpr int slot(int k) { return O_SLOT + k * MATB; }
#define MFMA16(a, b, c) __builtin_amdgcn_mfma_f32_16x16x32_bf16((a), (b), (c), 0, 0, 0)
__device__ __forceinline__ f32x4 tile64(const LAS unsigned char* A, const LAS unsigned char* Bt, int rt, int ct, int fr, int fq, f32x4 acc) {
#pragma unroll
    for (int ks = 0; ks < 2; ++ks) { const bf16x8 a = *(const LAS bf16x8*)(A + (16 * rt + fr) * PITCH + ks * 64 + fq * 16); const bf16x8 b = *(const LAS bf16x8*)(Bt + (16 * ct + fr) * PITCH + ks * 64 + fq * 16);
        acc = MFMA16(a, b, acc); }
    return acc;
}
__device__ __forceinline__ unsigned pkbf(float lo, float hi) { return pg8::cvt_pk_bf16(lo, hi); }
}

namespace rw {
typedef short s16x4 __attribute__((ext_vector_type(4)));
__device__ __forceinline__ bf16x8 fragN(const LAS unsigned char* img, int row, int ks, int fq) { return *(const LAS bf16x8*)(img + row * PITCH + ks * 64 + fq * 16); }
__device__ __forceinline__ bf16x8 fragP(const LAS unsigned char* img, int row, int ks, int fq) {
    const u32x2 a = *(const LAS u32x2*)(img + row * PITCH + (32 * ks + 4 * fq) * 2), b = *(const LAS u32x2*)(img + row * PITCH + (32 * ks + 16 + 4 * fq) * 2);
    const u32x4 v = (u32x4){a.x, a.y, b.x, b.y}; return __builtin_bit_cast(bf16x8, v); }
__device__ __forceinline__ bf16x8 fragT(const LAS unsigned char* img, int c0, int ks, int fr, int fq) {
    const LAS unsigned char* q = img + (32 * ks + 4 * fq + (fr >> 2)) * PITCH + (c0 + 4 * (fr & 3)) * 2;
    const s16x4 a = __builtin_amdgcn_ds_read_tr16_b64_v4i16((LAS s16x4*)q), b = __builtin_amdgcn_ds_read_tr16_b64_v4i16((LAS s16x4*)(q + 16 * PITCH));
    return (bf16x8){a[0], a[1], a[2], a[3], b[0], b[1], b[2], b[3]}; }
}

__device__ __forceinline__ void rw_chain_unit(const Params& p, LAS unsigned char* lds, int l, int unit, const int wvx) {
    using namespace rw;
    const int tid = opaque_tid(wvx), wave = __builtin_amdgcn_readfirstlane(tid >> 6);
    const int dir = unit & 1, h = (unit >> 1) & 7, b = unit >> 4;
    const bf16_t* proj = (const bf16_t*)(p.ws + OFF_PROJ);
    unsigned short* Y = (unsigned short*)(p.ws + (dir ? OFF_YB : OFF_YF));
    LAS float* gbuf = (LAS float*)(lds + O_GBUF);
    LAS float* GC = (LAS float*)(lds + O_GC);
    LAS bf16_t* TPP = (LAS bf16_t*)(lds + O_TPP);
    LAS float* CT = (LAS float*)(lds + O_CT);
    float* BON = (float*)(p.ws + OFF_BON) + (size_t)dir * NT * 8;
    const bf16_t* PR = (const bf16_t*)p.out;
    int* prep_ctr = (int*)(p.ws + OFF_CTL) + 32 + l * 16 + 8;
    __syncthreads();
    {
        const float* w2 = p.in[16] + ((size_t)l * 2 + dir) * 64 * 512 + h * 64; const float* a2 = p.in[18] + ((size_t)l * 2 + dir) * 64 * 512 + h * 64;
        for (int i = tid; i < 4096; i += NTHREADS) { const int r = i >> 6, n = i & 63;
            *(LAS bf16_t*)(lds + O_W2T + n * PITCH + r * 2) = (bf16_t)f2bf(w2[r * 512 + n]); *(LAS bf16_t*)(lds + O_A2T + n * PITCH + r * 2) = (bf16_t)f2bf(a2[r * 512 + n]); }
        for (int i = tid; i < MATB / 4; i += NTHREADS) ((LAS unsigned*)(lds + O_SB))[i] = 0u;
        for (int i = tid; i < 704; i += NTHREADS) { const int row = i >> 6, n = i & 63, col = h * 64 + n; float v;
            if (row < 6) v = 0.f;
            else if (row == 6) v = p.in[15][((size_t)l * 2 + dir) * 512 + col];
            else if (row == 7) v = p.in[17][((size_t)l * 2 + dir) * 512 + col];
            else if (row == 8) v = p.in[19][l * 512 + col];
            else if (row == 9) v = p.in[20][l * 512 + col];
            else v = p.in[21][l * 512 + col];
            CT[i] = v; }
    }
    const int rt = wave >> 1, chh = wave & 1;
    u32x4 pre[16];
    f32x4 acc_[16];
#define F4(x) __builtin_bit_cast(f32x4, (x))
#define U4(x) __builtin_bit_cast(u32x4, (x))
#define issue_rkv(CC, HALF) do { const int t0n_ = (dir ? (L / 64 - 1 - (CC)) : (CC)) * 64; int tq_ = tid; asm volatile("" : "+v"(tq_));     \
        const int ppn = ((tq_ & 255) >> 3) + 32 * (HALF); const int ttn = dir ? (t0n_ + 63 - ppn) : (t0n_ + ppn); const bf16_t* row = (wave >= 4) ? PR + ((size_t)b * L + ttn) * 512 + h * 64 + (tq_ & 7) * 8 : PR;     \
        _Pragma("unroll") for (int k = 0; k < 4; ++k) pre[4 * (HALF) + k] = *(const u32x4*)(row + (size_t)k * NT * 512); } while (0)
#define issue_lora(CC) do { const int t0n_ = (dir ? (L / 64 - 1 - (CC)) : (CC)) * 64; int tq_ = tid; asm volatile("" : "+v"(tq_)); \
        { const int kq_ = ((tq_ >> 4) & 3) * 8, cbase = (wave == 7 ? C_RA : C_RW) + dir * 64; \
          _Pragma("unroll") for (int r4 = 0; r4 < 4; ++r4) { const int pq_ = 16 * r4 + (tq_ & 15); const int ttn = dir ? (t0n_ + 63 - pq_) : (t0n_ + pq_); const bf16_t* row = (wave >= 5) ? proj + ((size_t)b * L + ttn) * IN_DP + cbase + kq_ : proj; \
            pre[8 + 2 * r4] = *(const u32x4*)(row); pre[9 + 2 * r4] = *(const u32x4*)(row + 32); } } } while (0)
    wg_wait(prep_ctr, 128, tid == 0);
    issue_lora(0); issue_rkv(0, 0); issue_rkv(0, 1);
#pragma unroll
    for (int q = 0; q < 16; ++q) acc_[q] = (f32x4){0.f, 0.f, 0.f, 0.f};
#pragma unroll 1
    for (int cc = -1; cc < L / 64; ++cc) {
        const bool cons = cc >= 0, prod = cc + 1 < L / 64;
        const int cn = cc + 1;
        const int cx = cn + 1 < L / 64 ? cn + 1 : L / 64 - 1;
        const int t0 = (dir ? (L / 64 - 1 - cc) : cc) * 64, t0n = (dir ? (L / 64 - 1 - cn) : cn) * 64;
        int tq = tid; asm volatile("" : "+v"(tq));
        const int fr = tq & 15, fq = (tq >> 4) & 3;
        const int bbn = (cn & 1) ? slot(9) : slot(7), bbc = (cc & 1) ? slot(9) : slot(7);
        if (cc + 2 < 64 && ((cc + 2) & 7) == 0) wg_wait(prep_ctr + ((cc + 2) >> 3), 128, tid == 0);
        __syncthreads();
        if (wave < 4) {
            if (cons) {
#pragma unroll
                for (int q = 0; q < 12; ++q) acc_[q] = (f32x4){0.f, 0.f, 0.f, 0.f};
                const bf16x8 s0 = fragN(lds + O_SB, 16 * wave + fr, 0, fq), s1 = fragN(lds + O_SB, 16 * wave + fr, 1, fq), v0 = fragT(lds + slot(6), 16 * wave, 0, fr, fq), v1 = fragT(lds + slot(6), 16 * wave, 1, fr, fq);
#pragma unroll
                for (int q = 0; q < 4; ++q) { f32x4 a = acc_[q];
                    a = MFMA16(fragN(lds + slot(3), 16 * q + fr, 0, fq), s0, a); a = MFMA16(fragN(lds + slot(3), 16 * q + fr, 1, fq), s1, a);
                    a = MFMA16(fragT(lds + slot(0), 16 * q, 0, fr, fq), v0, a); if (q >= 2) a = MFMA16(fragT(lds + slot(0), 16 * q, 1, fr, fq), v1, a);
                    acc_[q] = a;
                    f32x4 kx = acc_[4 + q]; kx = MFMA16(fragT(lds + slot(8), 16 * q, 0, fr, fq), v0, kx); kx = MFMA16(fragT(lds + slot(8), 16 * q, 1, fr, fq), v1, kx); acc_[4 + q] = kx;
                    f32x4 y = acc_[8 + q];
                    y = MFMA16(fragN(lds + slot(4), 16 * q + fr, 0, fq), s0, y); y = MFMA16(fragN(lds + slot(4), 16 * q + fr, 1, fq), s1, y);
                    y = MFMA16(fragT(lds + slot(2), 16 * q, 0, fr, fq), v0, y); if (q >= 2) y = MFMA16(fragT(lds + slot(2), 16 * q, 1, fr, fq), v1, y);
                    acc_[8 + q] = y;
                    asm volatile("" ::: "memory"); }
            }
        } else if (wave == 4) {
            if (cons) {
                const int pb = fq, j = fr; float T[16];
#pragma unroll
                for (int q = 0; q < 16; ++q) T[q] = (q == j) ? 1.f : 0.f;
#pragma unroll
                for (int sg = 0; sg < 4; ++sg) {
                    u32x4 ar[4][2];
#pragma unroll
                    for (int r4 = 0; r4 < 4; ++r4) { ar[r4][0] = *(const LAS u32x4*)(lds + slot(11) + (16 * pb + 4 * sg + r4) * PITCH + 32 * pb); ar[r4][1] = *(const LAS u32x4*)(lds + slot(11) + (16 * pb + 4 * sg + r4) * PITCH + 32 * pb + 16); }
#pragma unroll
                    for (int r4 = 0; r4 < 4; ++r4) { const int s2 = 4 * sg + r4; float av[16]; unpack8(ar[r4][0], av); unpack8(ar[r4][1], av + 8);
#pragma unroll
                        for (int q = s2 + 1; q < 16; ++q) T[q] += av[q] * T[s2]; }
                    asm volatile("" ::: "memory");
                }
#pragma unroll
                for (int q = 0; q < 16; ++q) TPP[(pb * 16 + q) * 20 + j] = (bf16_t)f2bf(T[q]);
            }
        } else if (wave <= 6) {
            if (prod) {
#pragma unroll
                for (int gi = 0; gi < 2; ++gi) { const int cgp = 2 * (wave - 5) + gi;
                    const float w0n = CT[6 * 64 + 16 * cgp + fr];
                    const bf16x8 wb0 = fragN(lds + O_W2T, 16 * cgp + fr, 0, fq), wb1 = fragN(lds + O_W2T, 16 * cgp + fr, 1, fq);
                    u32x2 lwp[4];
#pragma unroll
                    for (int r4 = 0; r4 < 4; ++r4) {
                        f32x4 wv = (f32x4){0.f, 0.f, 0.f, 0.f}; wv = MFMA16(__builtin_bit_cast(bf16x8, pre[8 + 2 * r4]), wb0, wv); wv = MFMA16(__builtin_bit_cast(bf16x8, pre[9 + 2 * r4]), wb1, wv);
                        float lwv[4];
#pragma unroll
                        for (int e = 0; e < 4; ++e) lwv[e] = -0.60653066f * frcp(1.0f + __expf(-(wv[e] + w0n)));
                        lwp[r4] = (u32x2){pk2(lwv[0], lwv[1]), pk2(lwv[2], lwv[3])}; }
#pragma unroll
                    for (int r4 = 0; r4 < 4; ++r4) { f32x4 g = (f32x4){0.f, 0.f, 0.f, 0.f};
#pragma unroll
                        for (int ks = 0; ks < 2; ++ks) if (32 * ks <= 16 * r4 + 15) {
                            const int pa = 16 * r4 + fr - 32 * ks - 4 * fq, pb2 = pa - 16;
                            u32x4 lt; unsigned one2 = 0x3F803F80u; asm volatile("" : "+s"(one2));
                            lt.x = (pa >= 1 ? one2 : (pa == 0 ? 0x00003F80u : 0u)); lt.y = (pa >= 3 ? one2 : (pa == 2 ? 0x00003F80u : 0u));
                            lt.z = (pb2 >= 1 ? one2 : (pb2 == 0 ? 0x00003F80u : 0u)); lt.w = (pb2 >= 3 ? one2 : (pb2 == 2 ? 0x00003F80u : 0u));
                            const u32x4 bv = (u32x4){lwp[2 * ks].x, lwp[2 * ks].y, lwp[2 * ks + 1].x, lwp[2 * ks + 1].y};
                            g = MFMA16(__builtin_bit_cast(bf16x8, lt), __builtin_bit_cast(bf16x8, bv), g); }
#pragma unroll
                        for (int e = 0; e < 4; ++e) gbuf[(16 * r4 + 4 * fq + e) * 64 + 16 * cgp + fr] = g[e]; }
                    asm volatile("" ::: "memory"); }
            }
        } else {
            if (prod) {
#pragma unroll
                for (int cgp = 0; cgp < 4; ++cgp) {
                    const bf16x8 ab0 = fragN(lds + O_A2T, 16 * cgp + fr, 0, fq), ab1 = fragN(lds + O_A2T, 16 * cgp + fr, 1, fq);
#pragma unroll
                    for (int r4 = 0; r4 < 4; ++r4) { f32x4 av = (f32x4){0.f, 0.f, 0.f, 0.f};
                        av = MFMA16(__builtin_bit_cast(bf16x8, pre[8 + 2 * r4]), ab0, av); av = MFMA16(__builtin_bit_cast(bf16x8, pre[9 + 2 * r4]), ab1, av);
#pragma unroll
                        for (int e = 0; e < 4; ++e) *(LAS bf16_t*)(lds + slot(5) + (16 * r4 + 4 * fq + e) * PITCH + (16 * cgp + fr) * 2) = (bf16_t)f2bf(av[e]); }
                    asm volatile("" ::: "memory"); }
            }
        }
        __builtin_amdgcn_sched_barrier(0);
        issue_lora(cx);
        __syncthreads();
#define LD2(dst, ptr) do { const f32x4 _a = *(const LAS f32x4*)(ptr), _b = *(const LAS f32x4*)((ptr) + 4); dst[0] = (f32x2){_a.x, _a.y}; dst[1] = (f32x2){_a.z, _a.w}; dst[2] = (f32x2){_b.x, _b.y}; dst[3] = (f32x2){_b.z, _b.w}; } while (0)
#define UP2(dst, wsrc_) do { const u32x4 _w = (wsrc_); dst[0] = (f32x2){bf2f(_w.x & 0xffffu), __uint_as_float(_w.x & 0xffff0000u)}; dst[1] = (f32x2){bf2f(_w.y & 0xffffu), __uint_as_float(_w.y & 0xffff0000u)}; \
                         dst[2] = (f32x2){bf2f(_w.z & 0xffffu), __uint_as_float(_w.z & 0xffff0000u)}; dst[3] = (f32x2){bf2f(_w.w & 0xffffu), __uint_as_float(_w.w & 0xffff0000u)}; } while (0)
#define PK4(v) ((u32x4){pk2(v[0].x, v[0].y), pk2(v[1].x, v[1].y), pk2(v[2].x, v[2].y), pk2(v[3].x, v[3].y)})
#define S2_ITEM(HALF) do { \
            const int pp = ((tq & 255) >> 3) + 32 * (HALF), ig = tq & 7, i0 = ig * 8; \
            const int tt = dir ? (t0n + 63 - pp) : (t0n + pp);            \
            f32x2 r2[4], k2[4], a2v[4], kd2[4], kkr2[4], gi2[4], ge2[4]; \
            LD2(gi2, gbuf + pp * 64 + i0); \
            LD2(ge2, gbuf + (pp > 0 ? pp - 1 : 0) * 64 + i0);        \
            if (pp == 0) { ge2[0] = (f32x2){0.f, 0.f}; ge2[1] = ge2[0]; ge2[2] = ge2[0]; ge2[3] = ge2[0]; } \
            UP2(r2, pre[4 * (HALF) + 0]); UP2(k2, pre[4 * (HALF) + 1]); UP2(kkr2, pre[4 * (HALF) + 3]);        \
            *(LAS u32x4*)(lds + slot(6) + pp * PITCH + ig * 16) = pre[4 * (HALF) + 2];        \
            {   f32x2 ap[4], c7[4]; \
                UP2(ap, *(const LAS u32x4*)(lds + slot(5) + pp * PITCH + ig * 16)); LD2(c7, CT + 7 * 64 + i0); \
                _Pragma("unroll") for (int j2 = 0; j2 < 4; ++j2) { const f32x2 araw = ap[j2] + c7[j2]; a2v[j2] = (f32x2){frcp(1.0f + __expf(-araw.x)), frcp(1.0f + __expf(-araw.y))}; } } \
            f32x2 bs2 = (f32x2){0.f, 0.f}; \
            {   f32x2 c9[4], c10[4]; LD2(c9, CT + 9 * 64 + i0); LD2(c10, CT + 10 * 64 + i0); \
                _Pragma("unroll") for (int j2 = 0; j2 < 4; ++j2) { kd2[j2] = k2[j2] * (1.0f + (a2v[j2] - 1.0f) * c9[j2]); bs2 += r2[j2] * kd2[j2] * c10[j2]; } } \
            { const float bs = sum8(bs2.x + bs2.y); if (ig == 0) ((LAS float*)(lds + O_BONS))[pp] = bs; }        \
            f32x2 At[4], Rt[4], Bb[4], Kb[4]; \
            _Pragma("unroll") for (int j2 = 0; j2 < 4; ++j2) { const f32x2 kk = kkr2[j2]; \
                const f32x2 ei = (f32x2){__expf(gi2[j2].x), __expf(gi2[j2].y)}, ee = (f32x2){__expf(ge2[j2].x), __expf(ge2[j2].y)}, inv = (f32x2){frcp(ei.x), frcp(ei.y)}; \
                At[j2] = -kk * ee; Rt[j2] = r2[j2] * ei; Bb[j2] = kk * a2v[j2] * inv; Kb[j2] = kd2[j2] * inv; \
                if ((HALF) == 1 && pp == 63) { GC[(cn & 1) * 64 + i0 + 2 * j2] = ei.x; GC[(cn & 1) * 64 + i0 + 2 * j2 + 1] = ei.y; } } \
            *(LAS u32x4*)(lds + slot(3) + pp * PITCH + ig * 16) = PK4(At); \
            *(LAS u32x4*)(lds + slot(4) + pp * PITCH + ig * 16) = PK4(Rt); \
            *(LAS u32x4*)(lds + bbn + pp * PITCH + ig * 16) = PK4(Bb); \
            *(LAS u32x4*)(lds + slot(8) + pp * PITCH + ig * 16) = PK4(Kb); } while (0)
        if (wave < 4) {
            if (cons) {
                u32x2 Ub[4];
                bf16x8 fa[4]; u32x2 ft[4];
#pragma unroll
                for (int z = 0; z < 4; ++z) { const int pb = (z == 3) ? 3 : z + 1, k2 = (z == 3) ? 1 : 0;
                    fa[z] = fragT(lds + slot(11), 16 * pb, k2, fr, fq);
                    ft[z] = *(const LAS u32x2*)(lds + O_TPP + ((z * 16 + fr) * 20 + 4 * fq) * 2); }
#pragma unroll
                for (int pb = 0; pb < 4; ++pb) {
                    f32x4 tmp = acc_[pb];
#pragma unroll
                    for (int k2 = 0; k2 < 2; ++k2) if (2 * k2 < pb) { const int z = (pb == 3 && k2 == 1) ? 3 : pb - 1;
                        const u32x2 b0 = Ub[2 * k2]; const u32x2 b1 = (2 * k2 + 1 < pb) ? Ub[2 * k2 + 1] : (u32x2){0u, 0u};
                        const u32x4 bv = (u32x4){b0.x, b0.y, b1.x, b1.y};
                        tmp = MFMA16(fa[z], __builtin_bit_cast(bf16x8, bv), tmp); }
                    const u32x4 av = (u32x4){ft[pb].x, ft[pb].y, 0u, 0u}, bv = (u32x4){pkbf(tmp[0], tmp[1]), pkbf(tmp[2], tmp[3]), 0u, 0u};
                    const f32x4 U = MFMA16(__builtin_bit_cast(bf16x8, av), __builtin_bit_cast(bf16x8, bv), ((f32x4){0.f, 0.f, 0.f, 0.f}));
                    Ub[pb] = (u32x2){pkbf(U[0], U[1]), pkbf(U[2], U[3])};
                    *(LAS u32x2*)(lds + slot(10) + (16 * wave + fr) * PITCH + (16 * pb + 4 * fq) * 2) = Ub[pb];
                }
            }
        } else { if (prod) S2_ITEM(0); }
        __builtin_amdgcn_sched_barrier(0);
        issue_rkv(cx, 0);
        __syncthreads();
        if (wave < 4) {
            if (cons) {
                const bf16x8 u0 = fragP(lds + slot(10), 16 * wave + fr, 0, fq), u1 = fragP(lds + slot(10), 16 * wave + fr, 1, fq);
#pragma unroll
                for (int q = 0; q < 4; ++q) { f32x4 a = acc_[8 + q];
                    a = MFMA16(fragT(lds + slot(1), 16 * q, 0, fr, fq), u0, a); if (q >= 2) a = MFMA16(fragT(lds + slot(1), 16 * q, 1, fr, fq), u1, a);
#pragma unroll
                    for (int e = 0; e < 4; ++e) *(LAS bf16_t*)(lds + slot(11) + (16 * q + 4 * fq + e) * PITCH + (16 * wave + fr) * 2) = (bf16_t)f2bf(a[e]); }
#pragma unroll
                for (int it = 0; it < 4; ++it) { f32x4 a = acc_[4 + it] + acc_[12 + it];
                    a = MFMA16(fragT(lds + bbc, 16 * it, 0, fr, fq), u0, a); a = MFMA16(fragT(lds + bbc, 16 * it, 1, fr, fq), u1, a);
                    const f32x4 gc = *(const LAS f32x4*)(GC + (cc & 1) * 64 + 16 * it + 4 * fq);
                    a = a * gc; acc_[12 + it] = a;
                    *(LAS u32x2*)(lds + O_SB + (16 * wave + fr) * PITCH + (16 * it + 4 * fq) * 2) = (u32x2){pkbf(a[0], a[1]), pkbf(a[2], a[3])};
                    asm volatile("" ::: "memory"); }
            }
        } else { if (prod) S2_ITEM(1); }
        __builtin_amdgcn_sched_barrier(0);
        issue_rkv(cx, 1);
#undef S2_ITEM
#undef PK4
#undef UP2
#undef LD2
        __syncthreads();
        if (cons) { const int lane = tq & 63, row = 32 * chh + (lane >> 1); const int ttp = dir ? (t0 + 63 - row) : (t0 + row);
            *(u32x4*)(Y + ((size_t)b * L + ttp) * 512 + h * 64 + 16 * rt + 8 * (lane & 1)) = *(const LAS u32x4*)(lds + slot(11) + row * PITCH + 32 * rt + 16 * (lane & 1)); }
        if (prod && tq < 64) BON[((size_t)b * 8 + h) * L + (dir ? (t0n + 63 - tq) : (t0n + tq))] = ((const LAS float*)(lds + O_BONS))[tq];
        if (prod) { const bf16x8 at0 = fragN(lds + slot(3), 16 * rt + fr, 0, fq), at1 = fragN(lds + slot(3), 16 * rt + fr, 1, fq), rt0 = fragN(lds + slot(4), 16 * rt + fr, 0, fq), rt1 = fragN(lds + slot(4), 16 * rt + fr, 1, fq);
#pragma unroll
          for (int ct = 0; ct < 2; ++ct) { const int ctt = 2 * chh + ct;
            f32x4 ab = (f32x4){0.f, 0.f, 0.f, 0.f}, ak = ab, rb = ab, rk = ab;
            if (ctt <= rt) {
                const bf16x8 b0 = fragN(lds + bbn, 16 * ctt + fr, 0, fq), b1 = fragN(lds + bbn, 16 * ctt + fr, 1, fq), k0 = fragN(lds + slot(8), 16 * ctt + fr, 0, fq), k1 = fragN(lds + slot(8), 16 * ctt + fr, 1, fq);
                ab = MFMA16(at0, b0, ab); ab = MFMA16(at1, b1, ab); ak = MFMA16(at0, k0, ak); ak = MFMA16(at1, k1, ak);
                rb = MFMA16(rt0, b0, rb); rb = MFMA16(rt1, b1, rb); rk = MFMA16(rt0, k0, rk); rk = MFMA16(rt1, k1, rk); }
            float vab[4], vak[4], vrb[4], vrk[4];
#pragma unroll
            for (int e = 0; e < 4; ++e) { const int prow = 16 * rt + 4 * fq + e, jcol = 16 * ctt + fr; const bool st = prow > jcol, inc = prow >= jcol;
                vab[e] = st ? ab[e] : 0.f; vak[e] = st ? ak[e] : 0.f; vrb[e] = inc ? rb[e] : 0.f; vrk[e] = inc ? rk[e] : 0.f; }
            const int off = (16 * ctt + fr) * PITCH + (16 * rt + 4 * fq) * 2;
            *(LAS u32x2*)(lds + slot(11) + off) = (u32x2){pkbf(vab[0], vab[1]), pkbf(vab[2], vab[3])};
            *(LAS u32x2*)(lds + slot(0) + off) = (u32x2){pkbf(vak[0], vak[1]), pkbf(vak[2], vak[3])};
            *(LAS u32x2*)(lds + slot(1) + off) = (u32x2){pkbf(vrb[0], vrb[1]), pkbf(vrb[2], vrb[3])};
            *(LAS u32x2*)(lds + slot(2) + off) = (u32x2){pkbf(vrk[0], vrk[1]), pkbf(vrk[2], vrk[3])}; } }
    }
    __syncthreads();
#undef issue_rkv
#undef issue_lora
#undef F4
#undef U4
}

constexpr int PT = 128;
__device__ __forceinline__ void rw_post_wg(const Params& p, LAS unsigned char* lds, int l, int G_, int bid, const int wvx) {
    const int tid = opaque_tid(wvx), lane = tid & 63, wave = __builtin_amdgcn_readfirstlane(tid >> 6), fr = lane & 15, fq = lane >> 4;
    const int h = bid & 7;
    const bf16_t* proj = (const bf16_t*)(p.ws + OFF_PROJ);
    const bf16_t* YF = (const bf16_t*)(p.ws + OFF_YF); const bf16_t* YB = (const bf16_t*)(p.ws + OFF_YB);
    const float* BONF = (const float*)(p.ws + OFF_BON); const float* BONB = BONF + (size_t)NT * 8;
    bf16_t* mix = (bf16_t*)(p.ws + OFF_MIX);
    constexpr int GP = 272;
    LAS unsigned char* G2T = lds;
    LAS unsigned char* SG = lds + 17408;
    LAS unsigned char* RAWV = lds + 52224;
    LAS unsigned char* GATE = lds + 68864;
    __syncthreads();
    { const float* g2 = p.in[22] + (size_t)l * 128 * 512 + h * 64;
        for (int i = tid; i < 8192; i += NTHREADS) { const int r = i >> 6, n = i & 63; *(LAS bf16_t*)(G2T + n * GP + r * 2) = (bf16_t)f2bf(g2[r * 512 + n]); } }
    const int ig = tid & 7, i0 = ig * 8, col = h * 64 + i0;
    float mv0[8], mv1[8], lnw[8], lnb[8];
#pragma unroll
    for (int j = 0; j < 8; ++j) { mv0[j] = p.in[14][(size_t)l * 3072 + 2 * 1024 + col + j]; mv1[j] = p.in[14][(size_t)l * 3072 + 2 * 1024 + 512 + col + j]; lnw[j] = p.in[23][l * 512 + col + j]; lnb[j] = p.in[24][l * 512 + col + j]; }
#pragma unroll 1
    for (int tile = bid >> 3; tile < NT / PT; tile += G_ >> 3) {
        const int row0 = tile * PT, tb0 = row0 & (L - 1);
        __syncthreads();
        u32x4 gq[4], vq[3]; u32x4 yq[2][2]; float bq[2];
#pragma unroll
        for (int k = 0; k < 4; ++k) { const int q = tid + k * NTHREADS; gq[k] = *(const u32x4*)(proj + (size_t)(row0 + (q >> 4)) * IN_DP + C_RG + (q & 15) * 8); }
#pragma unroll
        for (int k = 0; k < 3; ++k) { const int q = tid + k * NTHREADS; const int rr = q >> 3, ch = q & 7; const int tt = tb0 - 1 + rr; vq[k] = (u32x4){0u, 0u, 0u, 0u};
            if (q < 1040 && tt >= 0 && tt < L) vq[k] = *(const u32x4*)(proj + (size_t)(row0 - 1 + rr) * IN_DP + C_RV + h * 64 + ch * 8); }
#pragma unroll
        for (int sl = 0; sl < 2; ++sl) { const size_t row = (size_t)row0 + (tid >> 3) + 64 * sl; yq[sl][0] = *(const u32x4*)(YF + row * 512 + col); yq[sl][1] = *(const u32x4*)(YB + row * 512 + col);
            const size_t bi = ((size_t)(row >> 13) * 8 + h) * L + (row & (L - 1)); bq[sl] = BONF[bi] + BONB[bi]; }
#pragma unroll
        for (int k = 0; k < 4; ++k) { const int q = tid + k * NTHREADS; const int t = q >> 4, ch = q & 15; *(LAS u32x4*)(SG + t * GP + ch * 16) = gq[k]; }
#pragma unroll
        for (int k = 0; k < 3; ++k) { const int q = tid + k * NTHREADS; if (q < 1040) *(LAS u32x4*)(RAWV + (q >> 3) * 128 + (q & 7) * 16) = vq[k]; }
        __syncthreads();
#pragma unroll
        for (int ct = 0; ct < 4; ++ct) { f32x4 acc = (f32x4){0.f, 0.f, 0.f, 0.f};
#pragma unroll
            for (int ks = 0; ks < 4; ++ks) { const bf16x8 a = *(const LAS bf16x8*)(SG + (16 * wave + fr) * GP + ks * 64 + fq * 16); const bf16x8 b = *(const LAS bf16x8*)(G2T + (16 * ct + fr) * GP + ks * 64 + fq * 16);
                acc = __builtin_amdgcn_mfma_f32_16x16x32_bf16(a, b, acc, 0, 0, 0); }
#pragma unroll
            for (int e = 0; e < 4; ++e) *(LAS bf16_t*)(GATE + (16 * wave + 4 * fq + e) * 144 + (16 * ct + fr) * 2) = (bf16_t)f2bf(acc[e]); }
        __syncthreads();
#pragma unroll
        for (int sl = 0; sl < 2; ++sl) { const int t = (tid >> 3) + 64 * sl; const size_t row = (size_t)row0 + t;
            float vp[8], vc[8], vn[8], gt[8];
            unpack8(*(const LAS u32x4*)(RAWV + t * 128 + ig * 16), vp); unpack8(*(const LAS u32x4*)(RAWV + (t + 1) * 128 + ig * 16), vc); unpack8(*(const LAS u32x4*)(RAWV + (t + 2) * 128 + ig * 16), vn);
            unpack8(*(const LAS u32x4*)(GATE + t * 144 + ig * 16), gt);
            float yf8[8], yb8[8]; unpack8(yq[sl][0], yf8); unpack8(yq[sl][1], yb8);
            const float bon = bq[sl];
            float y[8] = {yf8[0] + yb8[0], yf8[1] + yb8[1], yf8[2] + yb8[2], yf8[3] + yb8[3], yf8[4] + yb8[4], yf8[5] + yb8[5], yf8[6] + yb8[6], yf8[7] + yb8[7]};
            float sm = 0.f;
#pragma unroll
            for (int j = 0; j < 8; ++j) sm += y[j];
            const float mean = sum8(sm) * (1.0f / 64.0f);
            float sq = 0.f;
#pragma unroll
            for (int j = 0; j < 8; ++j) { y[j] -= mean; sq += y[j] * y[j]; }
            const float rstd = __builtin_amdgcn_rsqf(sum8(sq) * (1.0f / 64.0f) + 64e-5f);
            float o[8];
#pragma unroll
            for (int j = 0; j < 8; ++j) { const float v = vc[j] + mv0[j] * (vp[j] - vc[j]) + mv1[j] * (vn[j] - vc[j]); o[j] = (y[j] * rstd * lnw[j] + lnb[j] + bon * v) * gt[j]; }
            u32x4 w; w.x = pk2(o[0], o[1]); w.y = pk2(o[2], o[3]); w.z = pk2(o[4], o[5]); w.w = pk2(o[6], o[7]);
            *(u32x4*)(mix + row * D + 256 + col) = w; }
    }
    __syncthreads();
}

namespace na {
constexpr int O_K = 0, O_V = 65536, O_RPB = 131072, O_MX = 133120, O_QW = 142080;
__device__ __forceinline__ int rowoff(int keycol, int byte) { return keycol * 128 + ((((byte >> 5) ^ keycol) & 3) << 5) + (byte & 31); }
typedef short s16x4 __attribute__((ext_vector_type(4)));
}
__device__ __forceinline__ void na_strip(const Params& p, LAS unsigned char* lds, int l, int strip, const int wvx) {
    using namespace na;
    const int tid = opaque_tid(wvx), lane = tid & 63, wave = __builtin_amdgcn_readfirstlane(tid >> 6), fr = lane & 15, fq = lane >> 4;
    const int b = strip >> 5, h = (strip >> 3) & 3, i0 = (strip & 7) * 16;
    const int g = wave & 3, kh = wave >> 2;
    const bf16_t* proj = (const bf16_t*)(p.ws + OFF_PROJ);
    bf16_t* mix = (bf16_t*)(p.ws + OFF_MIX);
    LAS float* RPB = (LAS float*)(lds + O_RPB);
    LAS unsigned char* MX = lds + O_MX + g * 2240;
    const int j0 = 16 * g, c0 = (g == 0) ? 0 : ((g == 3) ? 32 : 16 * g - 8);
    __syncthreads();
    for (int q = tid; q < 465; q += NTHREADS) RPB[q] = p.in[25][((size_t)l * 4 + h) * 465 + q];
    { int rs = i0 - 4; rs = rs < 0 ? 0 : (rs > 120 ? 120 : rs);
        u32x4 fw[16];
#pragma unroll
        for (int k = 0; k < 16; ++k) { const int q = tid + k * NTHREADS; const int r8 = q >> 10, which = (q >> 9) & 1, col = (q >> 3) & 63, ch = q & 7; const int kr = rs + r8;
            fw[k] = *(const u32x4*)(proj + ((size_t)b * L + kr * 64 + col) * IN_DP + (which ? C_NV : C_NK) + h * 64 + ch * 8); }
#pragma unroll
        for (int k = 0; k < 16; ++k) { const int q = tid + k * NTHREADS; const int r8 = q >> 10, which = (q >> 9) & 1, col = (q >> 3) & 63, ch = q & 7; const int kr = rs + r8;
            *(LAS u32x4*)(lds + (which ? O_V : O_K) + (kr & 7) * 8192 + rowoff(col, 16 * ch)) = fw[k]; } }
    bf16x8 Bq[2];
#pragma unroll
    for (int ks = 0; ks < 2; ++ks) Bq[ks] = *(const bf16x8*)(proj + ((size_t)b * L + i0 * 64 + j0 + fr) * IN_DP + C_NQ + h * 64 + 32 * ks + 8 * fq);
    const int jq = j0 + fr;
    int cs = jq - 8; cs = cs < 0 ? 0 : (cs > 48 ? 48 : cs);
    const u32x4 onesv = (u32x4){0x3F803F80u, 0x3F803F80u, 0x3F803F80u, 0x3F803F80u};
#pragma unroll 1
    for (int i = i0; i < i0 + 16; ++i) {
        int rs = i - 4; rs = rs < 0 ? 0 : (rs > 120 ? 120 : rs);
        int rsn = i + 1 - 4; rsn = rsn < 0 ? 0 : (rsn > 120 ? 120 : rsn);
        const bool more = (i + 1 < i0 + 16), newrow = more && (rsn > rs);
        __syncthreads();
        u32x4 pre0 = (u32x4){0u, 0u, 0u, 0u}, pre1 = pre0; bf16x8 Bqn[2] = {Bq[0], Bq[1]};
        if (newrow) { const int kr = rsn + 7;
            { const int q = tid; const int which = q >> 9, col = (q >> 3) & 63, ch = q & 7; pre0 = *(const u32x4*)(proj + ((size_t)b * L + kr * 64 + col) * IN_DP + (which ? C_NV : C_NK) + h * 64 + ch * 8); }
            { const int q = tid + 512; const int which = q >> 9, col = (q >> 3) & 63, ch = q & 7; pre1 = *(const u32x4*)(proj + ((size_t)b * L + kr * 64 + col) * IN_DP + (which ? C_NV : C_NK) + h * 64 + ch * 8); } }
        if (more) {
#pragma unroll
            for (int ks = 0; ks < 2; ++ks) Bqn[ks] = *(const bf16x8*)(proj + ((size_t)b * L + (i + 1) * 64 + j0 + fr) * IN_DP + C_NQ + h * 64 + 32 * ks + 8 * fq); }
        f32x4 S[4][2]; float mloc = -1e30f;
#pragma unroll
        for (int r4 = 0; r4 < 4; ++r4) { const int krow = rs + 4 * kh + r4, slot = krow & 7, dr = krow - i + 7;
#pragma unroll
            for (int ct = 0; ct < 2; ++ct) { const int keycol = c0 + 16 * ct + fr; f32x4 acc = (f32x4){0.f, 0.f, 0.f, 0.f};
#pragma unroll
                for (int ks = 0; ks < 2; ++ks) { const bf16x8 a = *(const LAS bf16x8*)(lds + O_K + slot * 8192 + rowoff(keycol, 64 * ks + 16 * fq)); acc = __builtin_amdgcn_mfma_f32_16x16x32_bf16(a, Bq[ks], acc, 0, 0, 0); }
#pragma unroll
                for (int e = 0; e < 4; ++e) { const int kc = c0 + 16 * ct + 4 * fq + e; const bool valid = (kc >= cs) && (kc < cs + 16);
                    int dc = kc - jq; dc = dc < -15 ? -15 : (dc > 15 ? 15 : dc); dc += 15;
                    const float sc = valid ? (acc[e] * 0.125f + RPB[dr * 31 + dc]) : -1e30f; acc[e] = sc; mloc = fmaxf(mloc, sc); }
                S[r4][ct] = acc; } }
        { int lid; asm volatile("v_mbcnt_lo_u32_b32 %0, -1, 0\n\tv_mbcnt_hi_u32_b32 %0, -1, %0" : "=v"(lid));
          mloc = fmaxf(mloc, __int_as_float(__builtin_amdgcn_ds_bpermute((lid ^ 16) << 2, __float_as_int(mloc))));
          mloc = fmaxf(mloc, __int_as_float(__builtin_amdgcn_ds_bpermute((lid ^ 32) << 2, __float_as_int(mloc)))); }
        bf16x8 Ap[4];
#pragma unroll
        for (int r4 = 0; r4 < 4; ++r4) { float pv[8];
#pragma unroll
            for (int ct = 0; ct < 2; ++ct)
#pragma unroll
                for (int e = 0; e < 4; ++e) { const float sc = S[r4][ct][e]; pv[ct * 4 + e] = (sc > -1e29f) ? __expf(sc - mloc) : 0.f; }
            const u32x4 w = (u32x4){pk2(pv[0], pv[1]), pk2(pv[2], pv[3]), pk2(pv[4], pv[5]), pk2(pv[6], pv[7])}; Ap[r4] = __builtin_bit_cast(bf16x8, w); }
        f32x4 O[4], Ls = (f32x4){0.f, 0.f, 0.f, 0.f};
#pragma unroll
        for (int dt = 0; dt < 4; ++dt) O[dt] = (f32x4){0.f, 0.f, 0.f, 0.f};
#pragma unroll
        for (int r4 = 0; r4 < 4; ++r4) { const int slot = (rs + 4 * kh + r4) & 7; const int kc0 = c0 + 4 * fq + (fr >> 2), kc1 = kc0 + 16;
            Ls = __builtin_amdgcn_mfma_f32_16x16x32_bf16(Ap[r4], __builtin_bit_cast(bf16x8, onesv), Ls, 0, 0, 0);
#pragma unroll
            for (int dt = 0; dt < 4; ++dt) {
                const s16x4 v0 = __builtin_amdgcn_ds_read_tr16_b64_v4i16((LAS s16x4*)(lds + O_V + slot * 8192 + rowoff(kc0, 32 * dt + 8 * (fr & 3))));
                const s16x4 v1 = __builtin_amdgcn_ds_read_tr16_b64_v4i16((LAS s16x4*)(lds + O_V + slot * 8192 + rowoff(kc1, 32 * dt + 8 * (fr & 3))));
                const bf16x8 bv = (bf16x8){v0[0], v0[1], v0[2], v0[3], v1[0], v1[1], v1[2], v1[3]};
                O[dt] = __builtin_amdgcn_mfma_f32_16x16x32_bf16(Ap[r4], bv, O[dt], 0, 0, 0); } }
        if (fq == 0) *(LAS float*)(MX + kh * 64 + fr * 4) = mloc;
        if (kh == 1) { if (fr == 0) *(LAS f32x4*)(MX + 128 + fq * 16) = Ls;
#pragma unroll
            for (int dt = 0; dt < 4; ++dt)
#pragma unroll
                for (int e = 0; e < 4; ++e) *(LAS bf16_t*)(MX + 192 + (4 * fq + e) * 128 + (16 * dt + fr) * 2) = (bf16_t)f2bf(O[dt][e]); }
        __syncthreads();
        if (newrow) { const int kr = rsn + 7;
            { const int q = tid; const int which = q >> 9, col = (q >> 3) & 63, ch = q & 7; *(LAS u32x4*)(lds + (which ? O_V : O_K) + (kr & 7) * 8192 + rowoff(col, 16 * ch)) = pre0; }
            { const int q = tid + 512; const int which = q >> 9, col = (q >> 3) & 63, ch = q & 7; *(LAS u32x4*)(lds + (which ? O_V : O_K) + (kr & 7) * 8192 + rowoff(col, 16 * ch)) = pre1; } }
        if (kh == 0) {
            const f32x4 m0 = *(const LAS f32x4*)(MX + fq * 16), m1 = *(const LAS f32x4*)(MX + 64 + fq * 16), l1 = *(const LAS f32x4*)(MX + 128 + fq * 16);
#pragma unroll
            for (int e = 0; e < 4; ++e) { const float M = fmaxf(m0[e], m1[e]), a0 = __expf(m0[e] - M), a1 = __expf(m1[e] - M); const float inv = frcp(Ls[e] * a0 + l1[e] * a1);
                const size_t row = (size_t)b * L + i * 64 + j0 + 4 * fq + e;
#pragma unroll
                for (int dt = 0; dt < 4; ++dt) { const float o1 = bf2f(*(const LAS bf16_t*)(MX + 192 + (4 * fq + e) * 128 + (16 * dt + fr) * 2));
                    mix[row * D + 768 + h * 64 + 16 * dt + fr] = (bf16_t)f2bf((O[dt][e] * a0 + o1 * a1) * inv); } }
        }
        Bq[0] = Bqn[0]; Bq[1] = Bqn[1];
    }
    __syncthreads();
}

__device__ __forceinline__ void na_queue(const Params& p, LAS unsigned char* lds, int l, const int wvx) {
    int* ctr = (int*)(p.ws + OFF_CTL) + 16 + l;
    LAS int* qw = (LAS int*)(lds + na::O_QW);
    for (;;) {
        __syncthreads();
        if (opaque_tid(wvx) == 0) *qw = atomicAdd(ctr, 1);
        __syncthreads();
        const int strip = __builtin_amdgcn_readfirstlane(*qw);
        if (strip >= 256) break;
        na_strip(p, lds, l, strip, wvx);
    }
}

__device__ __forceinline__ void phase_router(const Params& p, LAS unsigned char* lds, int l, int G_, int bid, const int wvx) {
    const int tid = opaque_tid(wvx), lane = tid & 63, wave = __builtin_amdgcn_readfirstlane(tid >> 6), fr = lane & 15, fq = lane >> 4;
    const bf16_t* x = (const bf16_t*)(p.ws + OFF_XB); float* rs = (float*)(p.ws + OFF_RS);
    const bf16_t* rgh = (const bf16_t*)(p.ws + OFF_RGW) + (size_t)l * 2 * 48 * D; const bf16_t* rgl = rgh + 48 * D;
    int* cnt = (int*)(p.ws + OFF_CTL) + 64 + l * 64;
    int* ltok = (int*)(p.ws + OFF_LTOK); float* lgate = (float*)(p.ws + OFF_LGATE); float* lrs = (float*)(p.ws + OFF_LRS);
    LAS int* lcnt = (LAS int*)lds;
    LAS int* lbase = lcnt + 32;
    LAS int* se = lbase + 32;
    LAS int* sp = se + 512;
    LAS float* sg = (LAS float*)(sp + 512);
    LAS float* LG = (LAS float*)(lds + 8192);
    LAS float* SQ = LG + 256 * 52;
    const float* bg = p.in[29] + l * 4; const float* be = p.in[31] + l * 32;
    for (int chunk = bid; chunk < NT / 256; chunk += G_) {
        __syncthreads();
        if (tid < 32) lcnt[tid] = 0;
        const int tl0 = wave * 32;
        const bf16_t* xa_p = x + (size_t)(chunk * 256 + tl0 + fr) * D + 8 * fq; const bf16_t* xb_p = xa_p + 16 * D;
        const bf16_t* wh_p = rgh + (size_t)fr * D + 8 * fq; const bf16_t* wl_p = rgl + (size_t)fr * D + 8 * fq;
        f32x4 acc[2][3];
#pragma unroll
        for (int t = 0; t < 2; ++t)
#pragma unroll
            for (int c = 0; c < 3; ++c) acc[t][c] = (f32x4){0.f, 0.f, 0.f, 0.f};
        float ssa = 0.f, ssb = 0.f;
#pragma unroll 2
        for (int ks = 0; ks < 32; ++ks) {
            const u32x4 ar = *(const u32x4*)(xa_p + 32 * ks), br = *(const u32x4*)(xb_p + 32 * ks);
            bf16x8 wh[3], wl[3];
#pragma unroll
            for (int c = 0; c < 3; ++c) { wh[c] = *(const bf16x8*)(wh_p + (size_t)16 * c * D + 32 * ks); wl[c] = *(const bf16x8*)(wl_p + (size_t)16 * c * D + 32 * ks); }
            { float f[8]; unpack8(ar, f);
#pragma unroll
              for (int j = 0; j < 8; ++j) ssa += f[j] * f[j];
              unpack8(br, f);
#pragma unroll
              for (int j = 0; j < 8; ++j) ssb += f[j] * f[j]; }
            const bf16x8 a0 = __builtin_bit_cast(bf16x8, ar), a1 = __builtin_bit_cast(bf16x8, br);
#pragma unroll
            for (int c = 0; c < 3; ++c) {
                acc[0][c] = __builtin_amdgcn_mfma_f32_16x16x32_bf16(a0, wh[c], acc[0][c], 0, 0, 0); acc[0][c] = __builtin_amdgcn_mfma_f32_16x16x32_bf16(a0, wl[c], acc[0][c], 0, 0, 0);
                acc[1][c] = __builtin_amdgcn_mfma_f32_16x16x32_bf16(a1, wh[c], acc[1][c], 0, 0, 0); acc[1][c] = __builtin_amdgcn_mfma_f32_16x16x32_bf16(a1, wl[c], acc[1][c], 0, 0, 0); }
        }
#pragma unroll
        for (int t = 0; t < 2; ++t)
#pragma unroll
            for (int c = 0; c < 3; ++c)
#pragma unroll
                for (int e = 0; e < 4; ++e) LG[(tl0 + 16 * t + 4 * fq + e) * 52 + 16 * c + fr] = acc[t][c][e];
        SQ[(tl0 + fr) * 4 + fq] = ssa; SQ[(tl0 + 16 + fr) * 4 + fq] = ssb;
        __syncthreads();
        if (lane < 32) { const int tl = tl0 + lane, row = chunk * 256 + tl;
            const f32x4 s4 = *(const LAS f32x4*)(SQ + tl * 4);
            const float rr = 1.0f / sqrtf(((s4.x + s4.y) + (s4.z + s4.w)) * (1.0f / D) + NORM_EPS);
            rs[row] = rr; SQ[tl * 4] = rr;
            const LAS float* lg = LG + tl * 52;
            const float g0 = lg[0] * rr + bg[0], g1 = lg[1] * rr + bg[1], g2 = lg[2] * rr + bg[2], g3 = lg[3] * rr + bg[3];
            int gs = 0; float gm = g0; if (g1 > gm) { gm = g1; gs = 1; } if (g2 > gm) { gm = g2; gs = 2; } if (g3 > gm) { gm = g3; gs = 3; }
            const float gprob = 1.0f / (expf(g0 - gm) + expf(g1 - gm) + expf(g2 - gm) + expf(g3 - gm));
            float ev[8];
#pragma unroll
            for (int e = 0; e < 8; ++e) ev[e] = lg[4 + gs * 8 + e] * rr + be[gs * 8 + e];
            int i0 = 0; float v0 = ev[0];
#pragma unroll
            for (int e = 1; e < 8; ++e) if (ev[e] > v0) { v0 = ev[e]; i0 = e; }
            int i1 = -1; float v1 = -3.0e38f;
#pragma unroll
            for (int e = 0; e < 8; ++e) if (e != i0 && ev[e] > v1) { v1 = ev[e]; i1 = e; }
            const float e1 = expf(v1 - v0), den = 1.0f + e1;
            const int ea = gs * 8 + i0, eb = gs * 8 + i1;
            se[tl * 2] = ea; se[tl * 2 + 1] = eb; sg[tl * 2] = gprob / den; sg[tl * 2 + 1] = gprob * e1 / den;
            sp[tl * 2] = atomicAdd((int*)lcnt + ea, 1); sp[tl * 2 + 1] = atomicAdd((int*)lcnt + eb, 1); }
        __syncthreads();
        if (tid < 32) lbase[tid] = atomicAdd(cnt + tid, lcnt[tid]);
        __syncthreads();
        { const int tl = tid >> 1, k = tid & 1, e = se[tid]; const size_t li = (size_t)e * LCAP + lbase[e] + sp[tid];
            ltok[li] = (chunk * 256 + tl) * 2 + k; lgate[li] = sg[tid]; lrs[li] = SQ[tl * 4]; }
    }
    __syncthreads();
}

__device__ __forceinline__ void phase_combine(const Params& p, bool last, int G_, int bid, const int wvx) {
    const int tid = opaque_tid(wvx), lane = tid & 63, wave = tid >> 6;
    float* out = p.out; bf16_t* x16 = (bf16_t*)(p.ws + OFF_XB); float* rs = (float*)(p.ws + OFF_RS);
    const bf16_t* yb = (const bf16_t*)(p.ws + OFF_YBUF);
    const float* gf = p.in[35];
    for (int row = bid * 8 + wave; row < NT; row += G_ * 8) {
        u32x2* xr = (u32x2*)(x16 + (size_t)row * D) + lane; const u32x2* y0 = (const u32x2*)(yb + (size_t)(2 * row) * D) + lane; const u32x2* y1 = (const u32x2*)(yb + (size_t)(2 * row + 1) * D) + lane;
        f32x4 v[4]; float s = 0.f; u32x2 xq[4], aq[4], cq[4];
#pragma unroll
        for (int j = 0; j < 4; ++j) { xq[j] = xr[64 * j]; aq[j] = y0[64 * j]; cq[j] = y1[64 * j]; }
#pragma unroll
        for (int j = 0; j < 4; ++j) { const u32x2 xx = xq[j], a = aq[j], c = cq[j];
            v[j].x = bf2f(xx.x & 0xffffu) + bf2f(a.x & 0xffffu) + bf2f(c.x & 0xffffu); v[j].y = __uint_as_float(xx.x & 0xffff0000u) + __uint_as_float(a.x & 0xffff0000u) + __uint_as_float(c.x & 0xffff0000u);
            v[j].z = bf2f(xx.y & 0xffffu) + bf2f(a.y & 0xffffu) + bf2f(c.y & 0xffffu); v[j].w = __uint_as_float(xx.y & 0xffff0000u) + __uint_as_float(a.y & 0xffff0000u) + __uint_as_float(c.y & 0xffff0000u);
            s += (v[j].x * v[j].x + v[j].y * v[j].y) + (v[j].z * v[j].z + v[j].w * v[j].w); }
        s = wave_sum(s);
        const float rr = 1.0f / sqrtf(s * (1.0f / D) + NORM_EPS);
        if (last) { f32x4* orow = (f32x4*)(out + (size_t)row * D) + lane;
#pragma unroll
            for (int j = 0; j < 4; ++j) { const f32x4 g = ((const f32x4*)gf)[lane + 64 * j]; orow[64 * j] = v[j] * rr * g; }
        } else {
            if (lane == 0) rs[row] = rr;
#pragma unroll
            for (int j = 0; j < 4; ++j) xr[64 * j] = (u32x2){pk2(v[j].x, v[j].y), pk2(v[j].z, v[j].w)};
        }
    }
}

#ifndef PH_MASK
#define PH_MASK 0xFFFFF
#endif
#define PH(k) if (PH_MASK & (1 << (k)))

#define XB_TMO      128
#define XB_XCNT(j)  (256  + 64 * (j))
#define XB_XSUB(j)  (1280 + 64 * (j))
#define XB_XGEN(j)  (2304 + 64 * (j))
#define XB_TOP      3328
#define XB_TOPGEN   3392
#define XCD_BAR_WORDS 3456
#define XB_SPIN_CAP (1u << 22)
__device__ __forceinline__ unsigned xb_ld(unsigned* p)              { return __hip_atomic_load(p, __ATOMIC_RELAXED, __HIP_MEMORY_SCOPE_AGENT); }
__device__ __forceinline__ unsigned xb_add(unsigned* p, unsigned v) { return __hip_atomic_fetch_add(p, v, __ATOMIC_RELAXED, __HIP_MEMORY_SCOPE_AGENT); }
__device__ __forceinline__ unsigned xb_xcc_id() { return (unsigned)__builtin_amdgcn_s_getreg((3 << 11) | 20) & 0xFu; }
#define XB_SPIN(cond, bar) do { unsigned _sp = 0; while (cond) { __builtin_amdgcn_s_sleep(1); \
    if ((++_sp & 255u) == 0u) { if (xb_ld(&(bar)[XB_TMO])) break; if (_sp > XB_SPIN_CAP) { atomicAdd(&(bar)[XB_TMO], 1u); break; } } } } while (0)
struct XcdBarrier { unsigned* bar; unsigned x; volatile LAS unsigned* st; };
__device__ __forceinline__ void xcd_barrier_complete(unsigned* bar, unsigned x, unsigned& nloc, unsigned& nx) {
    const unsigned G = gridDim.x * gridDim.y * gridDim.z;
    unsigned sum, cnt, mine, sp = 0u;
    for (;;) {
        sum = 0u; cnt = 0u; mine = 0u;
#pragma unroll
        for (unsigned j = 0; j < 16; ++j) { const unsigned c = xb_ld(&bar[XB_XCNT(j)]); sum += c; cnt += (c > 0u) ? 1u : 0u; mine = (j == x) ? c : mine; }
        if (sum == G) break;
        __builtin_amdgcn_s_sleep(1);
        if ((++sp & 255u) == 0u) { if (xb_ld(&bar[XB_TMO])) break; if (sp > XB_SPIN_CAP) { atomicAdd(&bar[XB_TMO], 1u); break; } }
    }
    nloc = mine > 0u ? mine : 1u; nx = cnt > 0u ? cnt : 1u;
}
__device__ __forceinline__ void xcd_barrier(const XcdBarrier& b, const bool leader) {
    asm volatile("s_waitcnt vmcnt(0)" ::: "memory");
    __syncthreads();
    if (leader) {
        unsigned* bar = b.bar;
        __builtin_amdgcn_s_waitcnt(0);
        unsigned nloc = b.st[0], nx = b.st[1];
        if (nloc == 0u) { xcd_barrier_complete(bar, b.x, nloc, nx); b.st[0] = nloc; b.st[1] = nx; }
        const unsigned old = xb_add(&bar[XB_XSUB(b.x)], 1u);
        const unsigned gen = old / nloc;
        if (old + 1u == (gen + 1u) * nloc) {
            __builtin_amdgcn_fence(__ATOMIC_RELEASE, "agent");
            asm volatile("s_waitcnt vmcnt(0)" ::: "memory");
            const unsigned og = xb_add(&bar[XB_TOP], 1u);
            const unsigned tg = og / nx;
            if (og + 1u == (tg + 1u) * nx) xb_add(&bar[XB_TOPGEN], 1u);
            else XB_SPIN(xb_ld(&bar[XB_TOPGEN]) == tg, bar);
            __builtin_amdgcn_fence(__ATOMIC_ACQUIRE, "agent");
            xb_add(&bar[XB_XGEN(b.x)], 1u);
            asm volatile("s_waitcnt vmcnt(0)" ::: "memory");
        } else {
            XB_SPIN(xb_ld(&bar[XB_XGEN(b.x)]) == gen, bar);
            __builtin_amdgcn_fence(__ATOMIC_ACQUIRE, "agent");
            asm volatile("s_waitcnt vmcnt(0)" ::: "memory");
        }
    }
    __syncthreads();
}

__device__ __forceinline__ Params load_params() {
#if defined(__HIP_DEVICE_COMPILE__)
    auto k = __builtin_amdgcn_kernarg_segment_ptr();
    asm volatile("" : "+s"(k));
    return *(const __attribute__((address_space(4))) Params*)k;
#else
    return Params{};
#endif
}
__global__ void __launch_bounds__(NTHREADS, 2) fwd_megakernel(Params p_unused) {
    extern __shared__ __attribute__((aligned(16))) unsigned char lds_raw[];
    LAS unsigned char* lds = (LAS unsigned char*)lds_raw;
    cg::grid_group grid = cg::this_grid();
    const int G_ = gridDim.x, bid = blockIdx.x;
    const int wvx = __builtin_amdgcn_readfirstlane((int)threadIdx.x >> 6);
    const bool leader = (threadIdx.x == 0);
    volatile LAS unsigned* bst = (volatile LAS unsigned*)(lds + LDS_BYTES - 16);
    if (leader) { bst[0] = 0u; bst[1] = 0u; }
    XcdBarrier xbar;
    { const Params p = load_params(); xbar.bar = (unsigned*)(p.ws + OFF_CTL) + 4096; xbar.x = xb_xcc_id(); xbar.st = bst;
      if (leader) (void)xb_add(&xbar.bar[XB_XCNT(xbar.x)], 1u); }
    __syncthreads();
#define GRID_BAR() do { const Params pb = load_params(); XcdBarrier xb2; xb2.bar = (unsigned*)(pb.ws + OFF_CTL) + 4096; xb2.x = xb_xcc_id(); xb2.st = bst; xcd_barrier(xb2, opaque_tid(wvx) == 0); } while (0)

    { const Params p = load_params(); PH(0) phase_prologue(p, lds, G_, bid, wvx); }
    { const Params p = load_params(); PH(0) filters_all(p, G_, bid, wvx); }
    { const Params p = load_params(); PH(1) phase_rownorm(p.in[0], (bf16_t*)(p.ws + OFF_XB), (float*)(p.ws + OFF_RS), G_, bid, wvx); }
    grid.sync();

#pragma unroll 1
    for (int l = 0; l < DEPTH; ++l) {
        PH(2) { const Params p = load_params(); unsigned char* ws = p.ws;
            DenseSched S; S.init((const bf16_t*)(ws + OFF_XB), (const bf16_t*)(ws + OFF_WTIN) + (size_t)l * IN_DP * D, NT, IN_DP, D, G_, bid);
            EpiProj E{(bf16_t*)(ws + OFF_PROJ), (const float*)(ws + OFF_RS)};
            pg8::gemm_phase<EpiProj, DenseSched, false>(lds, D, S, E, wvx);
        }
        GRID_BAR();
        {
            const bool lead = (opaque_tid(wvx) == 0);
            LAS int* qw = (LAS int*)(lds + na::O_QW);
#define CTR(k) ((int*)(load_params().ws + OFF_CTL) + 32 + l * 16 + (k))
            PH(5) for (;;) { const int u = wg_pop(CTR(6), qw, lead, 8); if (u >= 1024) break;
                             for (int j = 0; j < 8; ++j) { const Params p = load_params(); rw_prep_unit(p, l, u + j, wvx); } wg_signal(CTR(8 + (u >> 7)), lead, 8);
                             if (bid < 128 && u >= 128) break; }
            if (bid < 128) { PH(5) { const Params p = load_params(); rw_chain_unit(p, lds, l, bid, wvx); } }
            PH(3) for (;;) { const int u = wg_pop(CTR(0), qw, lead, 4); if (u >= 1024) break; for (int j = 0; j < 4; ++j) { const Params p = load_params(); hy_pre_unit4(p, lds, l, u + j, wvx); } wg_signal(CTR(1), lead, 4); }
            wg_wait(CTR(1), 1024, lead);
            PH(4) for (;;) { const int c = wg_pop(CTR(7), qw, lead); if (c >= 256) break; { const Params p = load_params(); hy_conv_unit(p, lds, l, c, wvx); } wg_signal(CTR(2), lead); }
            PH(6) { const Params p = load_params(); na_queue(p, lds, l, wvx); }
            wg_wait(CTR(2), 256, lead);
            PH(7) for (;;) { const int u = wg_pop(CTR(3), qw, lead, 4); if (u >= 1024) break; for (int j = 0; j < 4; ++j) { const Params p = load_params(); hy_post_unit4(p, lds, l, u + j, wvx); } wg_signal(CTR(4), lead, 4); }
            wg_wait(CTR(4), 1024, lead);
            PH(10) for (;;) { const int u = wg_pop(CTR(5), qw, lead); if (u >= NEXP * 768 / 64 + (l == 0 ? 43 : 0)) break; { const Params p = load_params(); moe_weights_chunk(p, lds, l, u, wvx); } }
#undef CTR
        }
        GRID_BAR();
        PH(8) { const Params p = load_params(); rw_post_wg(p, lds, l, G_, bid, wvx); }
        GRID_BAR();
        PH(9) { const Params p = load_params(); unsigned char* ws = p.ws;
            DenseSched S; S.init((const bf16_t*)(ws + OFF_MIX), (const bf16_t*)(ws + OFF_WTOUT) + (size_t)l * D * D, NT, D, D, G_, bid);
            EpiRes E{(bf16_t*)(ws + OFF_XB)};
            pg8::gemm_phase<EpiRes, DenseSched, false>(lds, D, S, E, wvx);
        }
        GRID_BAR();
        PH(11) { const Params p = load_params(); phase_router(p, lds, l, G_, bid, wvx); }
        GRID_BAR();
        PH(12) { const Params p = load_params(); unsigned char* ws = p.ws;
            const int* cnt = (const int*)(ws + OFF_CTL) + 64 + l * 64;
            MoeSched S; S.init(cnt, (const bf16_t*)(ws + OFF_XB), (const bf16_t*)(ws + OFF_W13T), (size_t)1024 * D, (const int*)(ws + OFF_LTOK), D, G_, bid, (LAS int*)(lds + 139264), opaque_tid(wvx));
            EpiMoe1 E{(bf16_t*)(ws + OFF_ACT), (const float*)(ws + OFF_LRS)};
            pg8::gemm_phase<EpiMoe1, MoeSched, true>(lds, D, S, E, wvx);
        }
        GRID_BAR();
        PH(13) { const Params p = load_params(); unsigned char* ws = p.ws;
            const int* cnt = (const int*)(ws + OFF_CTL) + 64 + l * 64;
            MoeSched S; S.init(cnt, (const bf16_t*)(ws + OFF_ACT), (const bf16_t*)(ws + OFF_W2T), (size_t)D * FF, nullptr, FF, G_, bid, (LAS int*)(lds + 139264), opaque_tid(wvx));
            EpiMoe2 E{(bf16_t*)(ws + OFF_YBUF), (const int*)(ws + OFF_LTOK), (const float*)(ws + OFF_LGATE)};
            pg8::gemm_phase<EpiMoe2, MoeSched, false>(lds, FF, S, E, wvx);
        }
        GRID_BAR();
        PH(14) { const Params p = load_params(); phase_combine(p, l == DEPTH - 1, G_, bid, wvx); }
        if (l < DEPTH - 1) GRID_BAR();
    }
}

extern "C" void kernel_launch(void* const* d_in, const int* in_sizes, int n_in, void* d_out, int out_size, void* d_ws, size_t ws_size, hipStream_t stream) {
    static int grid = 0;
    if (grid == 0) {
        if (n_in != 36 || ws_size < WS_END) { fprintf(stderr, "kernel_launch: unexpected n_in %d / ws_size %zu (need %zu)\n", n_in, ws_size, (size_t)WS_END); grid = -1; return; }
        int dev = 0, cus = 0, per_cu = 0;
        hipGetDevice(&dev);
        hipDeviceGetAttribute(&cus, hipDeviceAttributeMultiprocessorCount, dev);
        hipFuncSetAttribute((const void*)fwd_megakernel, hipFuncAttributeMaxDynamicSharedMemorySize, LDS_BYTES);
        hipOccupancyMaxActiveBlocksPerMultiprocessor(&per_cu, (const void*)fwd_megakernel, NTHREADS, LDS_BYTES);
        if (per_cu < 1) { fprintf(stderr, "kernel_launch: occupancy query says %d blocks per CU\n", per_cu); per_cu = 1; }
        if (per_cu > 1) per_cu = 1;
        grid = cus * per_cu;
        if (grid != 256) { fprintf(stderr, "kernel_launch: this kernel needs exactly 256 co-resident workgroups (got %d)\n", grid); if (grid > 256) grid = 256; }
        fprintf(stderr, "kernel_launch: grid %d (cus %d), ws %zu\n", grid, cus, ws_size);
    }
    if (grid < 0) return;
    hipMemsetAsync((char*)d_ws + OFF_CTL, 0, 65536, stream);
    Params p{};
    for (int i = 0; i < 36; ++i) p.in[i] = (const float*)d_in[i];
    p.out = (float*)d_out; p.ws = (unsigned char*)d_ws;
    void* args[] = {&p};
    hipError_t e = hipLaunchCooperativeKernel((const void*)fwd_megakernel, dim3(grid), dim3(NTHREADS), args, LDS_BYTES, stream);
    if (e != hipSuccess) fprintf(stderr, "cooperative launch failed: %s (grid %d)\n", hipGetErrorString(e), grid);
}
```

```cpp
#include <hip/hip_runtime.h>
#include <hip/hip_cooperative_groups.h>
#include <cstdio>
#include <cstdint>
namespace cg = cooperative_groups;

#define LAS __attribute__((address_space(3)))
typedef unsigned short bf16_t;
typedef short bf16x8 __attribute__((ext_vector_type(8)));
typedef float f32x4 __attribute__((ext_vector_type(4)));
typedef float f32x2 __attribute__((ext_vector_type(2)));
typedef unsigned u32x4 __attribute__((ext_vector_type(4)));
typedef unsigned u32x2 __attribute__((ext_vector_type(2)));

constexpr int D = 1024, NB = 8, L = 8192, NT = NB * L, DEPTH = 2;
constexpr int IN_D = 3456, IN_DP = 3584;
constexpr int C_HX0 = 0, C_HX1 = 256, C_HV = 512, C_RR = 768, C_RK = 1280, C_RV = 1792, C_RG = 2304, C_RW = 2432, C_RA = 2560, C_NQ = 2688, C_NK = 2944, C_NV = 3200;
constexpr int NEXP = 32, FF = 512;
constexpr float NORM_EPS = 1e-6f;

constexpr size_t MiB = 1u << 20;
constexpr size_t OFF_CTL = 0;
constexpr size_t OFF_WTIN = 1 * MiB;
constexpr size_t OFF_WTOUT = 15 * MiB;
constexpr size_t OFF_RS = 19 * MiB;
constexpr size_t OFF_RGW = 20 * MiB;
constexpr size_t OFF_LTOK = 21 * MiB;
constexpr size_t OFF_LGATE = 29 * MiB;
constexpr size_t OFF_FILT = 37 * MiB;
constexpr size_t OFF_MOEW = 69 * MiB;
constexpr size_t OFF_W13T = OFF_MOEW, OFF_W2T = OFF_MOEW + 64 * MiB;
constexpr size_t OFF_ZT = OFF_MOEW;
constexpr size_t OFF_YT = OFF_MOEW + 32 * MiB;
constexpr size_t OFF_XB = 165 * MiB;
constexpr size_t OFF_MIX = 869 * MiB;
constexpr size_t OFF_PROJ = 293 * MiB;
constexpr size_t OFF_ACT = OFF_PROJ;
constexpr size_t OFF_YBUF = OFF_PROJ + 136 * MiB;
constexpr size_t OFF_YF = 741 * MiB;
constexpr size_t OFF_YB = 805 * MiB;
constexpr size_t OFF_BON = 997 * MiB;
constexpr size_t OFF_LRS = 1001 * MiB;
constexpr size_t WS_END = 1009 * MiB;
constexpr int LCAP = 65536;

constexpr int LDS_BYTES = 163840;
constexpr int NTHREADS = 512;

struct Params { const float* in[36]; float* out; unsigned char* ws; };

__device__ __forceinline__ float bf2f(unsigned b) { return __uint_as_float(b << 16); }
typedef __bf16 bf16x2_t __attribute__((ext_vector_type(2)));
__device__ __forceinline__ unsigned f2bf(float f) { return (unsigned)__builtin_bit_cast(unsigned short, (__bf16)f); }
__device__ __forceinline__ unsigned pk2(float lo, float hi) { const f32x2 v = {lo, hi}; return __builtin_bit_cast(unsigned, __builtin_convertvector(v, bf16x2_t)); }
#define DPPF(v, ctrl) __int_as_float(__builtin_amdgcn_update_dpp(0, __float_as_int(v), (ctrl), 0xF, 0xF, true))
__device__ __forceinline__ float rdlane(float v, int l) { return __int_as_float(__builtin_amdgcn_readlane(__float_as_int(v), l)); }
__device__ __forceinline__ float wave_sum(float v) {
    v += DPPF(v, 0xB1); v += DPPF(v, 0x4E); v += DPPF(v, 0x141); v += DPPF(v, 0x140);
    return (rdlane(v, 0) + rdlane(v, 16)) + (rdlane(v, 32) + rdlane(v, 48));
}
__device__ __forceinline__ float sum8(float v) { v += DPPF(v, 0xB1); v += DPPF(v, 0x4E); v += DPPF(v, 0x141); return v; }
__device__ __forceinline__ void unpack8(const u32x4 w, float* f) {
    f[0] = bf2f(w.x & 0xffffu); f[1] = __uint_as_float(w.x & 0xffff0000u);
    f[2] = bf2f(w.y & 0xffffu); f[3] = __uint_as_float(w.y & 0xffff0000u);
    f[4] = bf2f(w.z & 0xffffu); f[5] = __uint_as_float(w.z & 0xffff0000u);
    f[6] = bf2f(w.w & 0xffffu); f[7] = __uint_as_float(w.w & 0xffff0000u);
}
__device__ __forceinline__ float frcp(float x) { return __builtin_amdgcn_rcpf(x); }
__device__ __forceinline__ float ftanh(float x) { const float e = __expf(2.0f * x); return 1.0f - 2.0f * frcp(e + 1.0f); }
#define LDS_WAIT() asm volatile("s_waitcnt lgkmcnt(0)" ::: "memory")
__device__ __forceinline__ int opaque_tid(int wvx) { int ln; asm volatile("v_mbcnt_lo_u32_b32 %0, -1, 0\n\tv_mbcnt_hi_u32_b32 %0, -1, %0" : "=v"(ln)); return wvx * 64 + ln; }

namespace pg8 {
constexpr int BM = 256, BK = 64, HALF = 128, HTB = HALF * BK * 2, STAGE_BYTES = 8 * HTB;
__device__ __forceinline__ int lds_byte(int r, int c) { const int st = (r >> 4) * 2 + (c >> 5), rr = r & 15, cc = c & 31, ob = rr * 64 + cc * 2; return st * 1024 + (ob ^ (((ob >> 9) & 1) << 5)); }
__device__ __forceinline__ void stage_rc(int b, int& R, int& C) { const int st = b / 1024, sb = b % 1024, swz = sb ^ (((sb >> 9) & 1) << 5); R = (st >> 1) * 16 + swz / 64; C = (st & 1) * 32 + (swz % 64) / 2; }
__device__ __forceinline__ int perm32(int rho) { const int n = rho >> 4, i = rho & 15; return 8 * (i >> 2) + 4 * n + (i & 3); }
__device__ __forceinline__ unsigned cvt_pk_bf16(float lo, float hi) { return pk2(lo, hi); }

struct Unit { const char* A; const char* B; int pm, pn, e, cnt; };

template <class Epi, class Sched, bool GATHER>
__device__ __forceinline__ void gemm_phase(LAS unsigned char* lds, const int K, const Sched& S, const Epi& E, const int wvx) {
    const int tid = opaque_tid(wvx), wid = __builtin_amdgcn_readfirstlane(tid >> 6), lane = tid & 63, wr = wid >> 2, wc = wid & 3, fr = lane & 15, fq = lane >> 4;
    const int nt = K / BK;
    int Rr[2], Cc[2];
    unsigned voffB[2];
#pragma unroll
    for (int i = 0; i < 2; ++i) { stage_rc(tid * 16 + i * 8192, Rr[i], Cc[i]); const int Rb = Epi::PERM ? ((Rr[i] & ~31) + perm32(Rr[i] & 31)) : Rr[i];
        voffB[i] = (unsigned)(Rb * K + Cc[i]) * 2u; }
    const size_t kstep = (size_t)(BK * 2);
    const size_t hstep = (size_t)HALF * K * 2;
    const unsigned ldsw = (unsigned)wid * 1024u;
    const int aoff = lds_byte(wr * 64 + fr, fq * 8), boff = lds_byte(wc * 32 + fr, fq * 8);
#define PG8_SA(b, h) (((b) * 2 + (h)) * HTB)
#define PG8_SB(b, h) ((4 + (b) * 2 + (h)) * HTB)
#define PG8_STAGE(bufoff, gbase, voff) do { _Pragma("unroll") for (int _i = 0; _i < 2; ++_i) \
        __builtin_amdgcn_global_load_lds((const unsigned*)((const char*)(gbase) + (voff)[_i]), (LAS unsigned*)(lds + (bufoff) + ldsw + _i * 8192), 16, 0, 0); } while (0)
#define PG8_LDA(dst, b, h) do { _Pragma("unroll") for (int m = 0; m < 4; ++m) _Pragma("unroll") for (int k = 0; k < 2; ++k) dst[m][k] = *(const LAS bf16x8*)(lds + PG8_SA(b, h) + aoff + m * 2048 + k * 1024); } while (0)
#define PG8_LDB(dst, b, h) do { _Pragma("unroll") for (int n = 0; n < 2; ++n) _Pragma("unroll") for (int k = 0; k < 2; ++k) dst[n][k] = *(const LAS bf16x8*)(lds + PG8_SB(b, h) + boff + n * 2048 + k * 1024); } while (0)
#define PG8_MMA(ai, bj, At, Bt) do { __builtin_amdgcn_s_setprio(1); _Pragma("unroll") for (int m = 0; m < 4; ++m) _Pragma("unroll") for (int n = 0; n < 2; ++n) _Pragma("unroll") for (int k = 0; k < 2; ++k) \
        acc[ai][bj][m][n] = __builtin_amdgcn_mfma_f32_16x16x32_bf16(Bt[n][k], At[m][k], acc[ai][bj][m][n], 0, 0, 0); __builtin_amdgcn_s_setprio(0); } while (0)
#define PG8_WAIT_V(n) asm volatile("s_waitcnt vmcnt(" #n ")" ::: "memory")
#define PG8_WAIT_L(n) asm volatile("s_waitcnt lgkmcnt(" #n ")" ::: "memory")
#define PG8_BAR __builtin_amdgcn_s_barrier()
#define PG8_SCHED __builtin_amdgcn_sched_barrier(0)
    Unit cur, nxt; int ui = 0;
    if (!S.next(0, cur)) return;
    f32x4 acc[2][2][4][2];
#pragma unroll
    for (int a = 0; a < 2; ++a)
#pragma unroll
        for (int b = 0; b < 2; ++b)
#pragma unroll
            for (int m = 0; m < 4; ++m)
#pragma unroll
                for (int n = 0; n < 2; ++n) acc[a][b][m][n] = (f32x4){0.f, 0.f, 0.f, 0.f};
    bf16x8 At[4][2], B0[2][2], B1[2][2];
    typename Epi::Pre epre;
    unsigned vA[2][2];
    LAS u32x4* stash = (LAS u32x4*)(lds + STAGE_BYTES) + tid;
    if (GATHER) S.aoff(cur, tid, vA);
    else {
#pragma unroll
        for (int h = 0; h < 2; ++h)
#pragma unroll
            for (int i = 0; i < 2; ++i) vA[h][i] = (unsigned)((h * HALF + Rr[i]) * K + Cc[i]) * 2u;
    }
    const char* cA = cur.A; const char* cB = cur.B;
    PG8_STAGE(PG8_SB(0, 0), cB, voffB); PG8_STAGE(PG8_SB(0, 1), cB + hstep, voffB); PG8_STAGE(PG8_SA(0, 0), cA, vA[0]); PG8_STAGE(PG8_SA(0, 1), cA, vA[1]);
    if (wr == 1) PG8_BAR;
    PG8_WAIT_V(2); PG8_BAR;
    PG8_STAGE(PG8_SB(1, 0), cB + kstep, voffB); PG8_STAGE(PG8_SA(1, 0), cA + kstep, vA[0]); PG8_STAGE(PG8_SB(1, 1), cB + hstep + kstep, voffB);
    PG8_WAIT_V(6); PG8_BAR;
    for (;;) {
        const bool has_next = S.next(ui + 1, nxt);
        const char* nA = has_next ? nxt.A : cA; const char* nB = has_next ? nxt.B : cB;
        if (GATHER) { unsigned vn[2][2];
            if (has_next) { S.aoff(nxt, tid, vn); *stash = (u32x4){vn[0][0], vn[0][1], vn[1][0], vn[1][1]}; }
            else *stash = (u32x4){vA[0][0], vA[0][1], vA[1][0], vA[1][1]}; }
        for (int t = 0; t < nt; t += 2) {
            const bool last = (t == nt - 2);
            const char* a1 = cA + (size_t)(t + 1) * kstep;
            const char* a2 = last ? nA : cA + (size_t)(t + 2) * kstep; const char* b2 = last ? nB : cB + (size_t)(t + 2) * kstep;
            const char* a3 = a2 + kstep; const char* b3 = b2 + kstep;
            if (last) E.prefetch(epre, cur, wr, wc, fr, fq);
            PG8_LDB(B0, 0, 0); PG8_LDB(B1, 0, 1); PG8_SCHED; PG8_LDA(At, 0, 0); PG8_STAGE(PG8_SA(1, 1), a1, vA[1]);
            if (GATHER && last) { const u32x4 sv = *stash; vA[0][0] = sv.x; vA[0][1] = sv.y; vA[1][0] = sv.z; vA[1][1] = sv.w; }
            PG8_WAIT_V(8); PG8_WAIT_L(0); PG8_BAR; PG8_MMA(0, 0, At, B0); PG8_MMA(0, 1, At, B1); PG8_BAR; PG8_SCHED;
            PG8_LDA(At, 0, 1); PG8_STAGE(PG8_SB(0, 0), b2, voffB); PG8_STAGE(PG8_SB(0, 1), b2 + hstep, voffB); PG8_STAGE(PG8_SA(0, 0), a2, vA[0]);
            PG8_WAIT_V(8); PG8_WAIT_L(0); PG8_BAR; PG8_MMA(1, 0, At, B0); PG8_MMA(1, 1, At, B1); PG8_BAR; PG8_SCHED;
            PG8_LDB(B0, 1, 0); PG8_LDB(B1, 1, 1); PG8_SCHED; PG8_LDA(At, 1, 0); PG8_STAGE(PG8_SA(0, 1), a2, vA[1]);
            PG8_WAIT_V(8); PG8_WAIT_L(0); PG8_BAR; PG8_MMA(0, 0, At, B0); PG8_MMA(0, 1, At, B1); PG8_BAR; PG8_SCHED;
            PG8_LDA(At, 1, 1); PG8_STAGE(PG8_SB(1, 0), b3, voffB); PG8_STAGE(PG8_SB(1, 1), b3 + hstep, voffB); PG8_STAGE(PG8_SA(1, 0), a3, vA[0]);
            PG8_WAIT_V(8); PG8_WAIT_L(0); PG8_BAR; PG8_MMA(1, 0, At, B0); PG8_MMA(1, 1, At, B1); PG8_BAR; PG8_SCHED;
        }
        if (wr == 0) PG8_BAR;
        {
            Unit eu = cur; int efr = fr, efq = fq;
            eu.pm = __builtin_amdgcn_readfirstlane(eu.pm); eu.pn = __builtin_amdgcn_readfirstlane(eu.pn); eu.e = __builtin_amdgcn_readfirstlane(eu.e); eu.cnt = __builtin_amdgcn_readfirstlane(eu.cnt);
            asm volatile("" : "+s"(eu.pm), "+s"(eu.pn), "+s"(eu.e), "+s"(eu.cnt), "+v"(efr), "+v"(efq));
            E(acc, eu, wr, wc, efr, efq, epre);
        }
        if (!has_next) break;
#pragma unroll
        for (int a = 0; a < 2; ++a)
#pragma unroll
            for (int b = 0; b < 2; ++b)
#pragma unroll
                for (int m = 0; m < 4; ++m)
#pragma unroll
                    for (int n = 0; n < 2; ++n) acc[a][b][m][n] = (f32x4){0.f, 0.f, 0.f, 0.f};
        cur = nxt; cA = nA; cB = nB; ++ui;
        if (wr == 1) PG8_BAR;
    }
    PG8_WAIT_V(0);
    PG8_BAR;
#undef PG8_SA
#undef PG8_SB
#undef PG8_STAGE
#undef PG8_LDA
#undef PG8_LDB
#undef PG8_MMA
#undef PG8_WAIT_V
#undef PG8_WAIT_L
#undef PG8_BAR
#undef PG8_SCHED
}
}

struct DenseSched {
    const bf16_t* A; const bf16_t* Bt; int K, nM, nN, nwg, G, c;
    __device__ void init(const bf16_t* A_, const bf16_t* Bt_, int M, int N, int K_, int G_, int c_) { A = A_; Bt = Bt_; K = K_; nM = M / 256; nN = N / 256; nwg = nM * nN; G = G_; c = c_; }
    __device__ __forceinline__ bool next(int i, pg8::Unit& u) const {
        const long Lx = (long)i * G + c; if (Lx >= nwg) return false;
        int wgid = (int)Lx; { const int q = nwg / 8, r = nwg % 8, xcd = wgid % 8, off = wgid / 8; wgid = (xcd < r ? xcd * (q + 1) : r * (q + 1) + (xcd - r) * q) + off; }
        const int nig = 8 * nN, gid = wgid / nig, fm = gid * 8, gsz = (nM - fm) < 8 ? (nM - fm) : 8;
        u.pm = fm + ((wgid % nig) % gsz); u.pn = (wgid % nig) / gsz; u.e = 0; u.cnt = 0;
        u.A = (const char*)A + (size_t)u.pm * 256 * K * 2; u.B = (const char*)Bt + (size_t)u.pn * 256 * K * 2; return true;
    }
    __device__ __forceinline__ void aoff(const pg8::Unit&, int, unsigned (&)[2][2]) const {}
};
struct MoeSched {
    const bf16_t* A; const bf16_t* Bt; size_t bstride;
    const int* ltok;
    LAS int* tp;
    int K, G, c, total;
    __device__ void init(const int* cnt_, const bf16_t* A_, const bf16_t* Bt_, size_t bstride_, const int* ltok_, int K_, int G_, int c_, LAS int* lds_tab, int tid) {
        A = A_; Bt = Bt_; bstride = bstride_; ltok = ltok_; K = K_; G = G_; c = (G_ % 8 == 0) ? (c_ & 7) * (G_ >> 3) + (c_ >> 3) : c_;
        tp = lds_tab;
        __syncthreads();
        if (tid < 32) tp[64 + tid] = cnt_[tid];
        __syncthreads();
        if (tid == 0) { int t = 0; for (int e = 0; e < NEXP; ++e) { tp[e] = t; t += (tp[64 + e] + 255) >> 8; } tp[32] = t; }
        __syncthreads();
        total = __builtin_amdgcn_readfirstlane(tp[32]);
    }
    __device__ __forceinline__ bool next(int i, pg8::Unit& u) const {
        const long Lx = (long)i * G + c; if (Lx >= (long)total * 4) return false;
        const int ti = (int)(Lx >> 2); u.pn = (int)(Lx & 3);
        int ln; asm volatile("v_mbcnt_lo_u32_b32 %0, -1, 0\n\tv_mbcnt_hi_u32_b32 %0, -1, %0" : "=v"(ln));
        const int l5 = ln & 31; const int lo = tp[l5], hi = tp[l5 + 1];
        const unsigned long long mask = __builtin_amdgcn_ballot_w64(lo <= ti && ti < hi);
        const int e = __builtin_amdgcn_readfirstlane((int)__builtin_ctzll(mask) & 31);
        const int base = __builtin_amdgcn_readfirstlane(tp[e]), ce = __builtin_amdgcn_readfirstlane(tp[64 + e]);
        u.e = e; u.pm = ti; u.cnt = ce - (ti - base) * 256;
        u.A = ltok ? (const char*)A : (const char*)A + (size_t)ti * 256 * K * 2;
        u.B = (const char*)(Bt + (size_t)e * bstride) + (size_t)u.pn * 256 * K * 2;
        u.pm = ti | ((ti - base) << 16);
        return true;
    }
    __device__ __forceinline__ void aoff(const pg8::Unit& u, int tid, unsigned (&v)[2][2]) const {
        const int lt = u.pm >> 16; int Rr[2], Cc[2]; pg8::stage_rc(tid * 16, Rr[0], Cc[0]); pg8::stage_rc(tid * 16 + 8192, Rr[1], Cc[1]);
        int tk[2][2];
#pragma unroll
        for (int h = 0; h < 2; ++h)
#pragma unroll
            for (int i = 0; i < 2; ++i) { const int r = h * 128 + Rr[i]; tk[h][i] = ltok[(size_t)u.e * LCAP + lt * 256 + (r < u.cnt ? r : 0)]; }
#pragma unroll
        for (int h = 0; h < 2; ++h)
#pragma unroll
            for (int i = 0; i < 2; ++i) { const int r = h * 128 + Rr[i]; const int tok = (r < u.cnt) ? (tk[h][i] >> 1) : 0; v[h][i] = (unsigned)(tok * K + Cc[i]) * 2u; }
    }
};

struct EpiProj {
    static constexpr bool PERM = true;
    struct Pre { float rs[8]; };
    bf16_t* O; const float* rs;
    __device__ __forceinline__ void prefetch(Pre& pr, const pg8::Unit& u, int wr, int wc, int fr, int fq) const {
        const int row0 = (u.pm & 0xffff) * 256 + wr * 64 + fr;
#pragma unroll
        for (int ai = 0; ai < 2; ++ai)
#pragma unroll
            for (int m = 0; m < 4; ++m) pr.rs[ai * 4 + m] = rs[row0 + ai * 128 + m * 16];
    }
    __device__ __forceinline__ void operator()(const f32x4 (&acc_)[2][2][4][2], const pg8::Unit& u, int wr, int wc, int fr, int fq, const Pre& pr) const {
        const int row0 = u.pm * 256 + wr * 64 + fr, col0 = u.pn * 256 + wc * 32 + 8 * fq;
        f32x4 (&acc)[2][2][4][2] = const_cast<f32x4 (&)[2][2][4][2]>(acc_);
        const bool act = (u.pn == 9);
        if (act) {
#pragma unroll
            for (int ai = 0; ai < 2; ++ai)
#pragma unroll
                for (int m = 0; m < 4; ++m) { const float s = pr.rs[ai * 4 + m];
#pragma unroll
                    for (int n = 0; n < 2; ++n)
#pragma unroll
                        for (int e = 0; e < 4; ++e) { acc[ai][0][m][n][e] = frcp(1.0f + __expf(-acc[ai][0][m][n][e] * s)); acc[ai][1][m][n][e] = ftanh(acc[ai][1][m][n][e] * s); } }
            asm volatile("" ::: "memory");
        }
#pragma unroll
        for (int ai = 0; ai < 2; ++ai)
#pragma unroll
            for (int m = 0; m < 4; ++m) { const int row = row0 + ai * 128 + m * 16; const float s = act ? 1.0f : pr.rs[ai * 4 + m]; bf16_t* rowp = O + (size_t)row * IN_DP + col0;
#pragma unroll
                for (int bj = 0; bj < 2; ++bj) { const f32x4 v0 = acc[ai][bj][m][0] * s, v1 = acc[ai][bj][m][1] * s;
                    u32x4 w; w.x = pg8::cvt_pk_bf16(v0[0], v0[1]); w.y = pg8::cvt_pk_bf16(v0[2], v0[3]); w.z = pg8::cvt_pk_bf16(v1[0], v1[1]); w.w = pg8::cvt_pk_bf16(v1[2], v1[3]);
                    *(u32x4*)(rowp + bj * 128) = w; } }
    }
};
struct EpiRes {
    static constexpr bool PERM = true;
    struct Pre { int dummy; };
    bf16_t* x16;
    __device__ __forceinline__ void prefetch(Pre&, const pg8::Unit&, int, int, int, int) const {}
    __device__ __forceinline__ void operator()(const f32x4 (&acc)[2][2][4][2], const pg8::Unit& u, int wr, int wc, int fr, int fq, const Pre&) const {
        const int row0 = u.pm * 256 + wr * 64 + fr, col0 = u.pn * 256 + wc * 32 + 8 * fq;
#pragma unroll
        for (int ai = 0; ai < 2; ++ai) {
            u32x4 braw[4][2];
#pragma unroll
            for (int m = 0; m < 4; ++m)
#pragma unroll
                for (int bj = 0; bj < 2; ++bj) braw[m][bj] = *(const u32x4*)(x16 + (size_t)(row0 + ai * 128 + m * 16) * D + col0 + bj * 128);
            asm volatile("" ::: "memory");
#pragma unroll
            for (int m = 0; m < 4; ++m) { const size_t off = (size_t)(row0 + ai * 128 + m * 16) * D + col0;
#pragma unroll
                for (int bj = 0; bj < 2; ++bj) { const f32x4 v0 = acc[ai][bj][m][0], v1 = acc[ai][bj][m][1]; float bb[8]; unpack8(braw[m][bj], bb);
                    u32x4 w; w.x = pk2(bb[0] + v0[0], bb[1] + v0[1]); w.y = pk2(bb[2] + v0[2], bb[3] + v0[3]); w.z = pk2(bb[4] + v1[0], bb[5] + v1[1]); w.w = pk2(bb[6] + v1[2], bb[7] + v1[3]);
                    *(u32x4*)(x16 + off + bj * 128) = w; } }
            asm volatile("" ::: "memory");
        }
    }
};
struct EpiMoe1 {
    static constexpr bool PERM = true;
    struct Pre { int dummy; };
    bf16_t* act; const float* lrs;
    __device__ __forceinline__ void prefetch(Pre&, const pg8::Unit&, int, int, int, int) const {}
    __device__ __forceinline__ void operator()(const f32x4 (&acc)[2][2][4][2], const pg8::Unit& u, int wr, int wc, int fr, int fq, const Pre&) const {
        const int ti = u.pm & 0xffff, lt = u.pm >> 16;
        const int r0 = wr * 64 + fr, col0 = u.pn * 256 + wc * 32 + 8 * fq;
        float sv[8];
#pragma unroll
        for (int q = 0; q < 8; ++q) { const int r = r0 + (q >> 2) * 128 + (q & 3) * 16; sv[q] = (r < u.cnt) ? lrs[(size_t)u.e * LCAP + lt * 256 + r] : 0.f; }
        asm volatile("" ::: "memory");
#pragma unroll
        for (int ai = 0; ai < 2; ++ai)
#pragma unroll
            for (int m = 0; m < 4; ++m) { const int r = r0 + ai * 128 + m * 16;
                const float s = sv[ai * 4 + m];
                bf16_t* rowp = act + ((size_t)ti * 256 + r) * FF + (col0 >> 1);
#pragma unroll
                for (int bj = 0; bj < 2; ++bj) { const f32x4 v0 = acc[ai][bj][m][0] * s, v1 = acc[ai][bj][m][1] * s;
                    const float o0 = v0[0] * frcp(1.f + __expf(-v0[0])) * v0[1], o1 = v0[2] * frcp(1.f + __expf(-v0[2])) * v0[3];
                    const float o2 = v1[0] * frcp(1.f + __expf(-v1[0])) * v1[1], o3 = v1[2] * frcp(1.f + __expf(-v1[2])) * v1[3];
                    u32x2 w; w.x = pg8::cvt_pk_bf16(o0, o1); w.y = pg8::cvt_pk_bf16(o2, o3);
                    *(u32x2*)(rowp + bj * 64) = w; } }
    }
};
struct EpiMoe2 {
    static constexpr bool PERM = true;
    struct Pre { int dummy; };
    bf16_t* ybuf; const int* ltok; const float* lgate;
    __device__ __forceinline__ void prefetch(Pre&, const pg8::Unit&, int, int, int, int) const {}
    __device__ __forceinline__ void operator()(const f32x4 (&acc)[2][2][4][2], const pg8::Unit& u, int wr, int wc, int fr, int fq, const Pre&) const {
        const int lt = u.pm >> 16, r0 = wr * 64 + fr, col0 = u.pn * 256 + wc * 32 + 8 * fq;
        int dv[8]; float gv[8];
#pragma unroll
        for (int q = 0; q < 8; ++q) { const int r = r0 + (q >> 2) * 128 + (q & 3) * 16; const bool ok = r < u.cnt;
            const size_t li = (size_t)u.e * LCAP + lt * 256 + (ok ? r : 0); const int d = ltok[li]; const float g = lgate[li];
            dv[q] = ok ? d : -1; gv[q] = g; }
        asm volatile("" ::: "memory");
#pragma unroll
        for (int ai = 0; ai < 2; ++ai)
#pragma unroll
            for (int m = 0; m < 4; ++m) { const int dest = dv[ai * 4 + m];
                if (dest >= 0) { const float g = gv[ai * 4 + m];
                    bf16_t* rowp = ybuf + (size_t)dest * D + col0;
#pragma unroll
                    for (int bj = 0; bj < 2; ++bj) { const f32x4 v0 = acc[ai][bj][m][0] * g, v1 = acc[ai][bj][m][1] * g;
                        u32x4 w; w.x = pg8::cvt_pk_bf16(v0[0], v0[1]); w.y = pg8::cvt_pk_bf16(v0[2], v0[3]); w.z = pg8::cvt_pk_bf16(v1[0], v1[1]); w.w = pg8::cvt_pk_bf16(v1[2], v1[3]);
                        *(u32x4*)(rowp + bj * 128) = w; } } }
    }
};

__device__ __forceinline__ void transpose_item(const float* __restrict__ W, int K, int N, bf16_t* WT, int rmul, int radd, const float* __restrict__ g, LAS float* scr, int item, int lane) {
    const int nblk = N / 32, kb = item / nblk, nb = item % nblk, k0 = 64 * kb, n0 = 32 * nb;
    f32x4 v[8]; float gv[8];
#pragma unroll
    for (int i = 0; i < 8; ++i) { v[i] = *(const f32x4*)(W + (size_t)(k0 + 8 * i + (lane >> 3)) * N + n0 + 4 * (lane & 7)); gv[i] = g ? g[k0 + 8 * i + (lane >> 3)] : 1.0f; }
#pragma unroll
    for (int i = 0; i < 8; ++i) { const int kk = 8 * i + (lane >> 3); *(LAS f32x4*)(scr + kk * 36 + 4 * (lane & 7)) = v[i] * gv[i]; }
    LDS_WAIT(); asm volatile("" ::: "memory");
    const int c = lane & 7;
#pragma unroll
    for (int j = 0; j < 4; ++j) { const int n = (lane >> 3) + 8 * j; const LAS float* s = scr + (8 * c) * 36 + n;
        u32x4 o; o.x = pk2(s[0 * 36], s[1 * 36]); o.y = pk2(s[2 * 36], s[3 * 36]); o.z = pk2(s[4 * 36], s[5 * 36]); o.w = pk2(s[6 * 36], s[7 * 36]);
        *(u32x4*)(WT + (size_t)(rmul * (n0 + n) + radd) * K + k0 + 8 * c) = o; }
    LDS_WAIT(); asm volatile("" ::: "memory");
}

__device__ __forceinline__ void filt_item8(const Params& p, int l, int m0, int lane, float* G) {
    const float* w1 = p.in[5] + l * 33 * 64; const float* w2 = p.in[7] + l * 4096; const float* w3 = p.in[9] + l * 4096; const float* wout = p.in[11] + l * 64 * 512;
    const float b1v = p.in[6][l * 64 + lane], b2v = p.in[8][l * 64 + lane], b3v = p.in[10][l * 64 + lane], fr = p.in[12][l * 64 + lane];
    float hcur[8], acc[8];
    {
#pragma unroll
        for (int j = 0; j < 8; ++j) { const int m = m0 + j; float zl = 0.f;
            const float wv = (6.283185307179586f / 8192.0f) * (float)m; const float fstep = (15.0f - 1e-4f) / 15.0f;
            if (lane == 0) zl = (float)m / 8191.0f; else if (lane <= 16) zl = cosf((1e-4f + (float)(lane - 1) * fstep) * wv); else if (lane <= 32) zl = -sinf((1e-4f + (float)(lane - 17) * fstep) * wv);
            hcur[j] = zl; acc[j] = b1v; }
        float wc[33];
#pragma unroll
        for (int i = 0; i < 33; ++i) wc[i] = w1[i * 64 + lane];
#pragma unroll
        for (int i = 0; i < 33; ++i)
#pragma unroll
            for (int j = 0; j < 8; ++j) acc[j] += rdlane(hcur[j], i) * wc[i];
#pragma unroll
        for (int j = 0; j < 8; ++j) { hcur[j] = sinf(fr * acc[j]); acc[j] = b2v; }
    }
    asm volatile("" ::: "memory");
    {   float wc[64];
#pragma unroll
        for (int i = 0; i < 64; ++i) wc[i] = w2[i * 64 + lane];
#pragma unroll
        for (int i = 0; i < 64; ++i)
#pragma unroll
            for (int j = 0; j < 8; ++j) acc[j] += rdlane(hcur[j], i) * wc[i];
#pragma unroll
        for (int j = 0; j < 8; ++j) { hcur[j] = sinf(fr * acc[j]); acc[j] = b3v; }
    }
    asm volatile("" ::: "memory");
    {   float wc[64];
#pragma unroll
        for (int i = 0; i < 64; ++i) wc[i] = w3[i * 64 + lane];
#pragma unroll
        for (int i = 0; i < 64; ++i)
#pragma unroll
            for (int j = 0; j < 8; ++j) acc[j] += rdlane(hcur[j], i) * wc[i];
#pragma unroll
        for (int j = 0; j < 8; ++j) hcur[j] = sinf(fr * acc[j]);
    }
    asm volatile("" ::: "memory");
    float (&h3)[8] = hcur;
    float o[8][8];
#pragma unroll
    for (int j = 0; j < 8; ++j)
#pragma unroll
        for (int q = 0; q < 8; ++q) o[j][q] = 0.f;
#pragma unroll 2
    for (int i = 0; i < 64; ++i) { float wo[8];
#pragma unroll
        for (int q = 0; q < 8; ++q) wo[q] = wout[i * 512 + q * 64 + lane];
#pragma unroll
        for (int j = 0; j < 8; ++j) { const float hv = rdlane(h3[j], i);
#pragma unroll
            for (int q = 0; q < 8; ++q) o[j][q] += hv * wo[q]; } }
    const float dmin = -3.0701134573253944f, dmax = -15.350567286626972f;
#pragma unroll
    for (int q = 0; q < 8; ++q) { const int n = q * 64 + lane, d = n >> 8, c = n & 255;
        const float delta = fabsf(dmin + (float)c * ((dmax - dmin) / 255.0f));
        float v[8];
#pragma unroll
        for (int j = 0; j < 8; ++j) v[j] = o[j][q] * expf(-((float)(m0 + j) / 8191.0f) * delta);
        float* dst = G + (size_t)c * 16384 + d * 8192 + m0;
        *(f32x4*)dst = (f32x4){v[0], v[1], v[2], v[3]}; *(f32x4*)(dst + 4) = (f32x4){v[4], v[5], v[6], v[7]}; }
}

__device__ __forceinline__ void phase_prologue(const Params& p, LAS unsigned char* lds, int G_, int bid, const int wvx) {
    const int tid = opaque_tid(wvx), lane = tid & 63, wave = tid >> 6;
    const int gw = bid * 8 + wave, NGW = G_ * 8;
    LAS float* scr = (LAS float*)(lds + wave * 16384);
    unsigned char* ws = p.ws;
    for (int it = gw; it < 16 * 108; it += NGW) transpose_item(p.in[2], D, IN_D, (bf16_t*)(ws + OFF_WTIN), 1, 0, p.in[1], scr, it, lane);
    for (int i = bid * NTHREADS + tid; i < 2 * 128 * D / 8; i += G_ * NTHREADS) { const int l = i / (128 * D / 8), r = i % (128 * D / 8);
        *(u32x4*)((bf16_t*)(ws + OFF_WTIN) + (size_t)l * IN_DP * D + (size_t)IN_D * D + (size_t)r * 8) = (u32x4){0u, 0u, 0u, 0u}; }
    for (int i = bid * NTHREADS + tid; i < 2 * 48 * D; i += G_ * NTHREADS) { const int l = i / (48 * D), r = i % (48 * D), o = r / D, k = r % D;
        const float g = p.in[27][l * D + k]; const float w = g * ((o < 4) ? p.in[28][((size_t)l * D + k) * 4 + o] : (o < 36 ? p.in[30][((size_t)l * D + k) * 32 + (o - 4)] : 0.f));
        const unsigned hi = f2bf(w); const float lo = w - bf2f(hi);
        bf16_t* rg = (bf16_t*)(ws + OFF_RGW) + (size_t)l * 2 * 48 * D; rg[o * D + k] = (bf16_t)hi; rg[48 * D + o * D + k] = (bf16_t)f2bf(lo); }
}
__device__ __forceinline__ void filters_all(const Params& p, int nwg, int rank, const int wvx) {
    const int tid = opaque_tid(wvx), lane = tid & 63, wave = tid >> 6;
    for (int it = rank * 8 + wave; it < 2 * (L / 8); it += nwg * 8) { const int l = it / (L / 8), m0 = (it % (L / 8)) * 8; filt_item8(p, l, m0, lane, (float*)(p.ws + OFF_FILT) + (size_t)l * 256 * 16384); }
}

__device__ __forceinline__ void moe_weights_chunk(const Params& p, LAS unsigned char* lds, int l, int chunk, const int wvx) {
    const int tid = opaque_tid(wvx), lane = tid & 63, wave = tid >> 6;
    LAS float* scr = (LAS float*)(lds + wave * 16384);
    bf16_t* W13 = (bf16_t*)(p.ws + OFF_W13T); bf16_t* W2 = (bf16_t*)(p.ws + OFF_W2T);
    const float* g = p.in[27] + l * D;
#pragma unroll 1
    for (int k = 0; k < 8; ++k) { const int it = chunk * 64 + wave * 8 + k;
        if (it >= NEXP * 768) { const int x = it - NEXP * 768;
            if (x < 16 * 108) transpose_item(p.in[2] + (size_t)D * IN_D, D, IN_D, (bf16_t*)(p.ws + OFF_WTIN) + (size_t)IN_DP * D, 1, 0, p.in[1] + D, scr, x, lane);
            else if (x < 16 * 108 + 1024) { const int y = x - 16 * 108, lo = y >> 9; transpose_item(p.in[26] + (size_t)lo * D * D, D, D, (bf16_t*)(p.ws + OFF_WTOUT) + (size_t)lo * D * D, 1, 0, nullptr, scr, y & 511, lane); }
            continue; }
        const int e = it / 768, r = it % 768;
        if (r < 256) transpose_item(p.in[32] + ((size_t)l * NEXP + e) * D * FF, D, FF, W13 + (size_t)e * 1024 * D, 2, 0, g, scr, r, lane);
        else if (r < 512) transpose_item(p.in[33] + ((size_t)l * NEXP + e) * D * FF, D, FF, W13 + (size_t)e * 1024 * D, 2, 1, g, scr, r - 256, lane);
        else transpose_item(p.in[34] + ((size_t)l * NEXP + e) * FF * D, FF, D, W2 + (size_t)e * D * FF, 1, 0, nullptr, scr, r - 512, lane); }
}
__device__ __forceinline__ void phase_rownorm(const float* x, bf16_t* xb, float* rs, int G_, int bid, const int wvx) {
    const int tid = opaque_tid(wvx), lane = tid & 63, wave = tid >> 6;
    const int stride = G_ * 8;
    for (int row = bid * 8 + wave; row < NT; row += 2 * stride) {
        const int row1 = row + stride; const bool has1 = row1 < NT;
        const f32x4* xr0 = (const f32x4*)(x + (size_t)row * D) + lane; const f32x4* xr1 = (const f32x4*)(x + (size_t)(has1 ? row1 : row) * D) + lane;
        f32x4 v0[4], v1[4]; float s0 = 0.f, s1 = 0.f;
#pragma unroll
        for (int j = 0; j < 4; ++j) { v0[j] = xr0[64 * j]; v1[j] = xr1[64 * j]; }
#pragma unroll
        for (int j = 0; j < 4; ++j) { s0 += (v0[j].x * v0[j].x + v0[j].y * v0[j].y) + (v0[j].z * v0[j].z + v0[j].w * v0[j].w); s1 += (v1[j].x * v1[j].x + v1[j].y * v1[j].y) + (v1[j].z * v1[j].z + v1[j].w * v1[j].w); }
        s0 = wave_sum(s0); s1 = wave_sum(s1);
        if (lane == 0) { rs[row] = 1.0f / sqrtf(s0 * (1.0f / D) + NORM_EPS); if (has1) rs[row1] = 1.0f / sqrtf(s1 * (1.0f / D) + NORM_EPS); }
        u32x2* o0 = (u32x2*)(xb + (size_t)row * D) + lane;
#pragma unroll
        for (int j = 0; j < 4; ++j) o0[64 * j] = (u32x2){pk2(v0[j].x, v0[j].y), pk2(v0[j].z, v0[j].w)};
        if (has1) { u32x2* o1 = (u32x2*)(xb + (size_t)row1 * D) + lane;
#pragma unroll
            for (int j = 0; j < 4; ++j) o1[64 * j] = (u32x2){pk2(v1[j].x, v1[j].y), pk2(v1[j].z, v1[j].w)}; }
    }
}

__device__ __forceinline__ void load8(const bf16_t* p, bool ok, float* f) { if (ok) { unpack8(*(const u32x4*)p, f); } else {
#pragma unroll
    for (int j = 0; j < 8; ++j) f[j] = 0.f; } }

__device__ __forceinline__ void hy_pre_unit(const Params& p, LAS unsigned char* lds, int l, int unit, const int wvx) {
    const int tid = opaque_tid(wvx);
    const int ct = unit & 3, tt = (unit >> 2) & 127, b = unit >> 9;
    const bf16_t* proj = (const bf16_t*)(p.ws + OFF_PROJ);
    bf16_t* zT = (bf16_t*)(p.ws + OFF_ZT);
    const float* cw = p.in[3] + l * 3 * 768; const float* cb = p.in[4] + l * 768;
    LAS bf16_t* tile = (LAS bf16_t*)lds;
    {
        const int tl = tid >> 3, c8 = (tid & 7) * 8, t = tt * 64 + tl, c = ct * 64 + c8;
        const bf16_t* row = proj + ((size_t)b * L + t) * IN_DP;
        float x1[3][8], vv[3][8];
        load8(row - IN_DP + C_HX1 + c, t > 0, x1[0]); load8(row + C_HX1 + c, true, x1[1]); load8(row + IN_DP + C_HX1 + c, t < L - 1, x1[2]);
        load8(row - IN_DP + C_HV + c, t > 0, vv[0]); load8(row + C_HV + c, true, vv[1]); load8(row + IN_DP + C_HV + c, t < L - 1, vv[2]);
#pragma unroll
        for (int j = 0; j < 8; ++j) { const int c1 = C_HX1 + c + j, c2 = C_HV + c + j;
            const float a = x1[0][j] * cw[c1] + x1[1][j] * cw[768 + c1] + x1[2][j] * cw[1536 + c1] + cb[c1];
            const float v = vv[0][j] * cw[c2] + vv[1][j] * cw[768 + c2] + vv[2][j] * cw[1536 + c2] + cb[c2];
            tile[(c8 + j) * 72 + tl] = (bf16_t)f2bf(a * v); }
    }
    __syncthreads();
    {
        const int cl = tid >> 3, seg = tid & 7;
        const u32x4 w = *(const LAS u32x4*)(tile + cl * 72 + seg * 8);
        *(u32x4*)(zT + ((size_t)(ct * 64 + cl) * NB + b) * L + tt * 64 + seg * 8) = w;
    }
    __syncthreads();
}

typedef float f32x16 __attribute__((ext_vector_type(16)));
__device__ __forceinline__ void hy_conv_unit(const Params& p, LAS unsigned char* lds, int l, int c, const int wvx) {
    const int tid = opaque_tid(wvx), lane = tid & 63, wave = __builtin_amdgcn_readfirstlane(tid >> 6);
    const float* G = (const float*)(p.ws + OFF_FILT) + ((size_t)l * 256 + c) * 16384;
    const bf16_t* zT = (const bf16_t*)(p.ws + OFF_ZT) + (size_t)c * NB * L;
    float* yT = (float*)(p.ws + OFF_YT) + (size_t)c * NB * L;
    LAS bf16_t* Re = (LAS bf16_t*)lds; LAS bf16_t* Ro = Re + 16384;
    LAS unsigned char* Zs = lds + 65536;
    constexpr int ZB = 8976;
    LAS float* red = (LAS float*)(lds + 65536 + 8 * ZB);
    __syncthreads();
    float ss = 0.f; const float GF0 = G[8192];
#pragma unroll 1
    for (int i0 = 0; i0 < 16384; i0 += 8 * NTHREADS) { float gq[8];
#pragma unroll
        for (int k = 0; k < 8; ++k) gq[k] = G[i0 + k * NTHREADS + tid];
#pragma unroll
        for (int k = 0; k < 8; ++k) { const int i = i0 + k * NTHREADS + tid; const float g = gq[k]; ss += g * g;
            if (i == 8192) { Ro[16383] = 0; Re[0] = 0; }
            else { const int dl = (i < 8192) ? i : (8192 - i); const bf16_t bv = (bf16_t)f2bf(i == 0 ? g + GF0 : g); Re[8192 - dl] = bv; Ro[8191 - dl] = bv; } } }
    ss = wave_sum(ss); if (lane == 0) red[wave] = ss;
#define HC_M16(a_, b_, c_) __builtin_amdgcn_mfma_f32_16x16x32_bf16((a_), (b_), (c_), 0, 0, 0)
    f32x4 acc[4][8];
#pragma unroll
    for (int mt = 0; mt < 4; ++mt)
#pragma unroll
        for (int i = 0; i < 8; ++i) acc[mt][i] = (f32x4){0.f, 0.f, 0.f, 0.f};
    const int r = lane & 15, fq = lane >> 4;
#pragma unroll 1
    for (int h = 0; h < 2; ++h) {
        __syncthreads();
        { u32x4 zq[9]; int tq = tid; asm volatile("" : "+v"(tq));
#pragma unroll
          for (int k = 0; k < 9; ++k) { const int q = tq + k * NTHREADS; const int ch = q & 7, Jp = (q >> 3) % 70, b = (q >> 3) / 70; const int J = 64 * h + Jp - 3;
            zq[k] = (u32x4){0u, 0u, 0u, 0u}; if (q < 4480 && Jp >= 3 && Jp < 67) zq[k] = *(const u32x4*)(zT + (size_t)b * L + J * 64 + ch * 8); }
#pragma unroll
          for (int k = 0; k < 9; ++k) { const int q = tq + k * NTHREADS; const int ch = q & 7, Jp = (q >> 3) % 70, b = (q >> 3) / 70;
            if (q < 4480) *(LAS u32x4*)(Zs + b * ZB + Jp * 128 + ch * 16) = zq[k]; } }
        __syncthreads();
        int d_hi = 16 * wave + 15 - 64 * h, d_lo = 16 * wave - 64 * h - 63; d_hi = d_hi > 127 ? 127 : d_hi; d_lo = d_lo < -127 ? -127 : d_lo;
        int mlo = 16 * wave - 64 * h - 51, mhi = 16 * wave - 64 * h + 3; mlo = mlo < d_lo ? d_lo : mlo; mhi = mhi > d_hi ? d_hi : mhi; if (mlo > mhi) { mlo = d_hi + 1; mhi = d_hi; }
        const int abase = 8192 + 8 * fq - r - (r & 1) - 48;
        const LAS unsigned char* arow = lds + (r & 1) * 32768 + abase * 2;
        const LAS unsigned char* brow = Zs + (r & 7) * ZB + ((r >> 3) + 16 * wave - 64 * h + 3) * 128 + fq * 16;
#define HC_LDA(dst, p_, k_) do { const LAS unsigned* q_ = (const LAS unsigned*)(p_) + 8 * (k_); const u32x4 t_ = (u32x4){q_[0], q_[1], q_[2], q_[3]}; dst = __builtin_bit_cast(bf16x8, t_); } while (0)
#pragma unroll 1
        for (int part = 0; part < 2; ++part) {
            const int ga = part ? mhi + 1 : d_lo, gb = part ? d_hi : mlo - 1;
#pragma unroll 1
            for (int d = ga; d <= gb; ++d) {
                const int J0b = 16 * wave - d;
                const LAS unsigned char* ap = arow - 128 * d;
                bf16x8 Af[6];
#pragma unroll
                for (int k = 0; k < 6; ++k) HC_LDA(Af[k], ap, k);
                const LAS unsigned char* bp = brow - 128 * d;
#pragma unroll
                for (int i = 0; i < 8; ++i) { const int J0 = J0b + 2 * i;
                    if (J0 + 1 >= 64 * h && J0 <= 64 * h + 63) {
                        const bf16x8 b0 = *(const LAS bf16x8*)(bp + i * 256), b1 = *(const LAS bf16x8*)(bp + i * 256 + 64);
#pragma unroll
                        for (int mt = 0; mt < 4; ++mt) { acc[mt][i] = HC_M16(Af[3 - mt], b0, acc[mt][i]); acc[mt][i] = HC_M16(Af[5 - mt], b1, acc[mt][i]); }
                    } }
            }
            if (part == 0 && mlo <= mhi) {
#define HC_LDB(dst, p_, s_) do { _Pragma("unroll") for (int ii = 0; ii < 2; ++ii) _Pragma("unroll") for (int ks = 0; ks < 2; ++ks) dst[2 * ii + ks] = *(const LAS bf16x8*)((p_) + (s_) * 512 + ii * 256 + ks * 64); } while (0)
#define HC_MMA(s_, Bx) do { _Pragma("unroll") for (int ii = 0; ii < 2; ++ii) _Pragma("unroll") for (int mt = 0; mt < 4; ++mt) _Pragma("unroll") for (int ks = 0; ks < 2; ++ks) \
                                acc[mt][2 * (s_) + ii] = HC_M16(F[3 - mt + 2 * ks], Bx[2 * ii + ks], acc[mt][2 * (s_) + ii]); } while (0)
                bf16x8 F[6], B0[4], B1[4];
                { const LAS unsigned char* ap = arow - 128 * mlo;
#pragma unroll
                  for (int k = 0; k < 6; ++k) HC_LDA(F[k], ap, k); }
#pragma unroll 1
                for (int d = mlo; d <= mhi; ++d) {
                    const LAS unsigned char* bp = brow - 128 * d;
                    HC_LDB(B0, bp, 0);
                    HC_LDB(B1, bp, 1); __builtin_amdgcn_sched_barrier(0); HC_MMA(0, B0); __builtin_amdgcn_sched_barrier(0);
                    HC_LDB(B0, bp, 2); __builtin_amdgcn_sched_barrier(0); HC_MMA(1, B1); __builtin_amdgcn_sched_barrier(0);
                    HC_LDB(B1, bp, 3); __builtin_amdgcn_sched_barrier(0); HC_MMA(2, B0); __builtin_amdgcn_sched_barrier(0);
                    bf16x8 Fn[4];
                    { const LAS unsigned char* apn = arow - 128 * (d + 1);
#pragma unroll
                      for (int k = 0; k < 4; ++k) HC_LDA(Fn[k], apn, k); }
                    __builtin_amdgcn_sched_barrier(0); HC_MMA(3, B1); __builtin_amdgcn_sched_barrier(0);
                    F[4] = F[0]; F[5] = F[1]; F[0] = Fn[0]; F[1] = Fn[1]; F[2] = Fn[2]; F[3] = Fn[3];
                }
#undef HC_LDB
#undef HC_MMA
            }
        }
#undef HC_LDA
    }
    float tot = 0.f;
#pragma unroll
    for (int w = 0; w < 8; ++w) tot += red[w];
    const float scale = 1.0f / sqrtf(tot + 1e-6f);
#pragma unroll
    for (int mt = 0; mt < 4; ++mt)
#pragma unroll
        for (int i = 0; i < 8; ++i) { const int t = 64 * (16 * wave + 2 * i + (r >> 3)) + 16 * mt + 4 * fq;
            *(f32x4*)(yT + (size_t)(r & 7) * L + t) = acc[mt][i] * scale; }
    __syncthreads();
#undef HC_M16
}

__device__ __forceinline__ void hy_post_unit(const Params& p, LAS unsigned char* lds, int l, int unit, const int wvx) {
    const int tid = opaque_tid(wvx);
    const int ct = unit & 3, tt = (unit >> 2) & 127, b = unit >> 9;
    const bf16_t* proj = (const bf16_t*)(p.ws + OFF_PROJ);
    const bf16_t* zT = (const bf16_t*)(p.ws + OFF_ZT);
    const float* yT = (const float*)(p.ws + OFF_YT);
    bf16_t* mix = (bf16_t*)(p.ws + OFF_MIX);
    const float* cw = p.in[3] + l * 3 * 768; const float* cb = p.in[4] + l * 768; const float* skip = p.in[13] + l * 256;
    LAS float* tile = (LAS float*)lds;
    {
        const int cl = tid >> 3, seg = tid & 7, c = ct * 64 + cl;
        const size_t off = ((size_t)c * NB + b) * L + tt * 64 + seg * 8;
        float z[8]; unpack8(*(const u32x4*)(zT + off), z);
        const f32x4 y0 = *(const f32x4*)(yT + off), y1 = *(const f32x4*)(yT + off + 4);
        const float sk = skip[c];
        tile[cl * 65 + seg * 8 + 0] = y0.x + z[0] * sk; tile[cl * 65 + seg * 8 + 1] = y0.y + z[1] * sk; tile[cl * 65 + seg * 8 + 2] = y0.z + z[2] * sk; tile[cl * 65 + seg * 8 + 3] = y0.w + z[3] * sk;
        tile[cl * 65 + seg * 8 + 4] = y1.x + z[4] * sk; tile[cl * 65 + seg * 8 + 5] = y1.y + z[5] * sk; tile[cl * 65 + seg * 8 + 6] = y1.z + z[6] * sk; tile[cl * 65 + seg * 8 + 7] = y1.w + z[7] * sk;
    }
    __syncthreads();
    {
        const int tl = tid >> 3, c8 = (tid & 7) * 8, t = tt * 64 + tl, c = ct * 64 + c8;
        const bf16_t* row = proj + ((size_t)b * L + t) * IN_DP;
        float x0[3][8];
        load8(row - IN_DP + C_HX0 + c, t > 0, x0[0]); load8(row + C_HX0 + c, true, x0[1]); load8(row + IN_DP + C_HX0 + c, t < L - 1, x0[2]);
        float o[8];
#pragma unroll
        for (int j = 0; j < 8; ++j) { const int c0 = c + j; const float a = x0[0][j] * cw[c0] + x0[1][j] * cw[768 + c0] + x0[2][j] * cw[1536 + c0] + cb[c0];
            o[j] = a * tile[(c8 + j) * 65 + tl]; }
        u32x4 w; w.x = pk2(o[0], o[1]); w.y = pk2(o[2], o[3]); w.z = pk2(o[4], o[5]); w.w = pk2(o[6], o[7]);
        *(u32x4*)(mix + ((size_t)b * L + t) * D + c) = w;
    }
    __syncthreads();
}


constexpr int HY_WOFF = 100352;
__device__ __forceinline__ void hy_weights_to_lds(const Params& p, LAS unsigned char* lds, int l, const int wvx) {
    const int tid = opaque_tid(wvx); LAS float* W = (LAS float*)(lds + HY_WOFF);
    const float* cw = p.in[3] + l * 3 * 768; const float* cb = p.in[4] + l * 768;
    __syncthreads();
    for (int i = tid; i < 2304; i += NTHREADS) W[i] = cw[i];
    for (int i = tid; i < 768; i += NTHREADS) W[2304 + i] = cb[i];
    __syncthreads();
}
__device__ __forceinline__ void hy_pre_unit4(const Params& p, LAS unsigned char* lds, int l, int unit, const int wvx) {
    const int tid = opaque_tid(wvx);
    const int tt = unit & 127, b = unit >> 7;
    const bf16_t* proj = (const bf16_t*)(p.ws + OFF_PROJ);
    bf16_t* zT = (bf16_t*)(p.ws + OFF_ZT);
    const LAS float* cw = (const LAS float*)(lds + HY_WOFF); const LAS float* cb = cw + 2304;
    LAS bf16_t* tile = (LAS bf16_t*)lds;
    const int tl = tid >> 3, c8 = (tid & 7) * 8, t = tt * 64 + tl;
    const bf16_t* row = proj + ((size_t)b * L + t) * IN_DP;
    const bool hp = t > 0, hn = t < L - 1;
    u32x4 rx[4][3], rv[4][3];
#pragma unroll
    for (int ct = 0; ct < 4; ++ct) { const int c = ct * 64 + c8;
        rx[ct][0] = *(const u32x4*)(row + (hp ? -IN_DP : 0) + C_HX1 + c); rx[ct][1] = *(const u32x4*)(row + C_HX1 + c); rx[ct][2] = *(const u32x4*)(row + (hn ? IN_DP : 0) + C_HX1 + c);
        rv[ct][0] = *(const u32x4*)(row + (hp ? -IN_DP : 0) + C_HV + c); rv[ct][1] = *(const u32x4*)(row + C_HV + c); rv[ct][2] = *(const u32x4*)(row + (hn ? IN_DP : 0) + C_HV + c); }
    const float mp = hp ? 1.f : 0.f, mn = hn ? 1.f : 0.f;
#pragma unroll
    for (int ct = 0; ct < 4; ++ct) { const int c = ct * 64 + c8;
        float x1[3][8], vv[3][8]; unpack8(rx[ct][0], x1[0]); unpack8(rx[ct][1], x1[1]); unpack8(rx[ct][2], x1[2]); unpack8(rv[ct][0], vv[0]); unpack8(rv[ct][1], vv[1]); unpack8(rv[ct][2], vv[2]);
        float wa[3][8], wb[3][8], ba[8], bb[8];
#pragma unroll
        for (int k = 0; k < 3; ++k) { const f32x4 a0 = *(const LAS f32x4*)(cw + k * 768 + C_HX1 + c), a1 = *(const LAS f32x4*)(cw + k * 768 + C_HX1 + c + 4), b0 = *(const LAS f32x4*)(cw + k * 768 + C_HV + c), b1 = *(const LAS f32x4*)(cw + k * 768 + C_HV + c + 4);
            wa[k][0] = a0.x; wa[k][1] = a0.y; wa[k][2] = a0.z; wa[k][3] = a0.w; wa[k][4] = a1.x; wa[k][5] = a1.y; wa[k][6] = a1.z; wa[k][7] = a1.w;
            wb[k][0] = b0.x; wb[k][1] = b0.y; wb[k][2] = b0.z; wb[k][3] = b0.w; wb[k][4] = b1.x; wb[k][5] = b1.y; wb[k][6] = b1.z; wb[k][7] = b1.w; }
        { const f32x4 a0 = *(const LAS f32x4*)(cb + C_HX1 + c), a1 = *(const LAS f32x4*)(cb + C_HX1 + c + 4), b0 = *(const LAS f32x4*)(cb + C_HV + c), b1 = *(const LAS f32x4*)(cb + C_HV + c + 4);
            ba[0] = a0.x; ba[1] = a0.y; ba[2] = a0.z; ba[3] = a0.w; ba[4] = a1.x; ba[5] = a1.y; ba[6] = a1.z; ba[7] = a1.w; bb[0] = b0.x; bb[1] = b0.y; bb[2] = b0.z; bb[3] = b0.w; bb[4] = b1.x; bb[5] = b1.y; bb[6] = b1.z; bb[7] = b1.w; }
#pragma unroll
        for (int j = 0; j < 8; ++j) {
            const float a = mp * x1[0][j] * wa[0][j] + x1[1][j] * wa[1][j] + mn * x1[2][j] * wa[2][j] + ba[j];
            const float v = mp * vv[0][j] * wb[0][j] + vv[1][j] * wb[1][j] + mn * vv[2][j] * wb[2][j] + bb[j];
            tile[(c + j) * 72 + tl] = (bf16_t)f2bf(a * v); } }
    __syncthreads();
#pragma unroll
    for (int ct = 0; ct < 4; ++ct) { const int cl = ct * 64 + (tid >> 3), seg = tid & 7;
        const u32x4 w = *(const LAS u32x4*)(tile + cl * 72 + seg * 8);
        *(u32x4*)(zT + ((size_t)cl * NB + b) * L + tt * 64 + seg * 8) = w; }
    __syncthreads();
}
__device__ __forceinline__ void hy_post_unit4(const Params& p, LAS unsigned char* lds, int l, int unit, const int wvx) {
    const int tid = opaque_tid(wvx);
    const int tt = unit & 127, b = unit >> 7;
    const bf16_t* proj = (const bf16_t*)(p.ws + OFF_PROJ);
    const bf16_t* zT = (const bf16_t*)(p.ws + OFF_ZT);
    const float* yT = (const float*)(p.ws + OFF_YT);
    bf16_t* mix = (bf16_t*)(p.ws + OFF_MIX);
    const LAS float* cw = (const LAS float*)(lds + HY_WOFF); const LAS float* cb = cw + 2304; const float* skip = p.in[13] + l * 256;
    LAS float* tile = (LAS float*)lds;
    {
        u32x4 zq[4]; f32x4 y0q[4], y1q[4]; float skq[4];
#pragma unroll
        for (int ct = 0; ct < 4; ++ct) { const int c = ct * 64 + (tid >> 3), seg = tid & 7; const size_t off = ((size_t)c * NB + b) * L + tt * 64 + seg * 8;
            zq[ct] = *(const u32x4*)(zT + off); y0q[ct] = *(const f32x4*)(yT + off); y1q[ct] = *(const f32x4*)(yT + off + 4); skq[ct] = skip[c]; }
#pragma unroll
        for (int ct = 0; ct < 4; ++ct) { const int cl = ct * 64 + (tid >> 3), seg = tid & 7; float z[8]; unpack8(zq[ct], z); const float sk = skq[ct]; LAS float* tp = tile + cl * 65 + seg * 8;
            tp[0] = y0q[ct].x + z[0] * sk; tp[1] = y0q[ct].y + z[1] * sk; tp[2] = y0q[ct].z + z[2] * sk; tp[3] = y0q[ct].w + z[3] * sk;
            tp[4] = y1q[ct].x + z[4] * sk; tp[5] = y1q[ct].y + z[5] * sk; tp[6] = y1q[ct].z + z[6] * sk; tp[7] = y1q[ct].w + z[7] * sk; }
    }
    __syncthreads();
    {
        const int tl = tid >> 3, c8 = (tid & 7) * 8, t = tt * 64 + tl;
        const bf16_t* row = proj + ((size_t)b * L + t) * IN_DP;
        const bool hp = t > 0, hn = t < L - 1; const float mp = hp ? 1.f : 0.f, mn = hn ? 1.f : 0.f;
        u32x4 r0[4], r1[4], r2[4];
#pragma unroll
        for (int ct = 0; ct < 4; ++ct) { const int c = ct * 64 + c8; r0[ct] = *(const u32x4*)(row + (hp ? -IN_DP : 0) + C_HX0 + c); r1[ct] = *(const u32x4*)(row + C_HX0 + c); r2[ct] = *(const u32x4*)(row + (hn ? IN_DP : 0) + C_HX0 + c); }
#pragma unroll
        for (int ct = 0; ct < 4; ++ct) { const int c = ct * 64 + c8;
            float x0[3][8]; unpack8(r0[ct], x0[0]); unpack8(r1[ct], x0[1]); unpack8(r2[ct], x0[2]);
            float o[8];
#pragma unroll
            for (int j = 0; j < 8; ++j) { const int c0 = c + j; const float a = mp * x0[0][j] * cw[c0] + x0[1][j] * cw[768 + c0] + mn * x0[2][j] * cw[1536 + c0] + cb[c0];
                o[j] = a * tile[(c + j) * 65 + tl]; }
            u32x4 w; w.x = pk2(o[0], o[1]); w.y = pk2(o[2], o[3]); w.z = pk2(o[4], o[5]); w.w = pk2(o[6], o[7]);
            *(u32x4*)(mix + ((size_t)b * L + t) * D + c) = w; }
    }
    __syncthreads();
}


__device__ __forceinline__ void wg_signal(int* ctr, const bool leader, const int n = 1) {
    asm volatile("s_waitcnt vmcnt(0)" ::: "memory");
    __syncthreads();
    if (leader) { __builtin_amdgcn_fence(__ATOMIC_RELEASE, "agent"); asm volatile("s_waitcnt vmcnt(0)" ::: "memory"); __hip_atomic_fetch_add(ctr, n, __ATOMIC_RELAXED, __HIP_MEMORY_SCOPE_AGENT); }
}
__device__ __forceinline__ void wg_wait(int* ctr, int target, const bool leader) {
    if (leader) { unsigned sp = 0;
        while (__hip_atomic_load(ctr, __ATOMIC_RELAXED, __HIP_MEMORY_SCOPE_AGENT) < target) { __builtin_amdgcn_s_sleep(2); if (++sp > (1u << 24)) break; }
        __builtin_amdgcn_fence(__ATOMIC_ACQUIRE, "agent"); asm volatile("s_waitcnt vmcnt(0)" ::: "memory"); }
    __syncthreads();
}
__device__ __forceinline__ int wg_pop(int* ctr, LAS int* qw, const bool leader, const int n = 1) {
    __syncthreads();
    if (leader) *qw = __hip_atomic_fetch_add(ctr, n, __ATOMIC_RELAXED, __HIP_MEMORY_SCOPE_AGENT);
    __syncthreads();
    return __builtin_amdgcn_readfirstlane(*qw);
}
__device__ __forceinline__ void rw_prep_unit(const Params& p, int l, int unit, const int wvx) {
    const int tid = opaque_tid(wvx), cg = tid & 63, rg = tid >> 6;
    const int lev = unit >> 4, b = unit & 7; const int c = (unit & 8) ? 127 - lev : lev;
    const int t0 = c * 64 + rg * 8, col = cg * 8;
    const bf16_t* proj = (const bf16_t*)(p.ws + OFF_PROJ);
    bf16_t* PR = (bf16_t*)p.out;
    u32x4 raw[3][10];
#pragma unroll
    for (int w = 0; w < 3; ++w)
#pragma unroll
        for (int i = 0; i < 10; ++i) { const int t = t0 - 1 + i; const int tc = t < 0 ? 0 : (t > L - 1 ? L - 1 : t);
            raw[w][i] = *(const u32x4*)(proj + ((size_t)b * L + tc) * IN_DP + C_RR + w * 512 + col); }
    { const u32x4 z = (u32x4){0u, 0u, 0u, 0u};
      if (t0 == 0) { raw[0][0] = z; raw[1][0] = z; raw[2][0] = z; }
      if (t0 + 8 == L) { raw[0][9] = z; raw[1][9] = z; raw[2][9] = z; } }
    const float* mu = p.in[14] + (size_t)l * 3 * 2 * 512;
#pragma unroll
    for (int w = 0; w < 3; ++w) {
        float m0[8], m1[8];
        { const f32x4 a = *(const f32x4*)(mu + w * 1024 + col), b2 = *(const f32x4*)(mu + w * 1024 + col + 4), c = *(const f32x4*)(mu + w * 1024 + 512 + col), d = *(const f32x4*)(mu + w * 1024 + 512 + col + 4);
          m0[0] = a.x; m0[1] = a.y; m0[2] = a.z; m0[3] = a.w; m0[4] = b2.x; m0[5] = b2.y; m0[6] = b2.z; m0[7] = b2.w;
          m1[0] = c.x; m1[1] = c.y; m1[2] = c.z; m1[3] = c.w; m1[4] = d.x; m1[5] = d.y; m1[6] = d.z; m1[7] = d.w; }
#pragma unroll
        for (int j = 0; j < 8; ++j) {
            float xp[8], xc[8], xn[8], y[8];
            unpack8(raw[w][j], xp); unpack8(raw[w][j + 1], xc); unpack8(raw[w][j + 2], xn);
#pragma unroll
            for (int e = 0; e < 8; ++e) y[e] = xc[e] + m0[e] * (xp[e] - xc[e]) + m1[e] * (xn[e] - xc[e]);
            const size_t ro = ((size_t)b * L + t0 + j) * 512 + col;
            *(u32x4*)(PR + (size_t)w * NT * 512 + ro) = (u32x4){pk2(y[0], y[1]), pk2(y[2], y[3]), pk2(y[4], y[5]), pk2(y[6], y[7])};
        }
    }
}

namespace rw {
constexpr int MATB = 9216, PITCH = 144;
constexpr int O_W2T = 0, O_A2T = MATB, O_SB = 2 * MATB, O_GBUF = 3 * MATB, O_SLOT = O_GBUF + 16384;
constexpr int O_GC = O_SLOT + 12 * MATB, O_TPP = O_GC + 512, O_CT = O_TPP + 2560, O_BONS = O_CT + 2816;
__device__ __forceinline__ constexpr int slot(int k) { return O_SLOT + k * MATB; }
#define MFMA16(a, b, c) __builtin_amdgcn_mfma_f32_16x16x32_bf16((a), (b), (c), 0, 0, 0)
__device__ __forceinline__ f32x4 tile64(const LAS unsigned char* A, const LAS unsigned char* Bt, int rt, int ct, int fr, int fq, f32x4 acc) {
#pragma unroll
    for (int ks = 0; ks < 2; ++ks) { const bf16x8 a = *(const LAS bf16x8*)(A + (16 * rt + fr) * PITCH + ks * 64 + fq * 16); const bf16x8 b = *(const LAS bf16x8*)(Bt + (16 * ct + fr) * PITCH + ks * 64 + fq * 16);
        acc = MFMA16(a, b, acc); }
    return acc;
}
__device__ __forceinline__ unsigned pkbf(float lo, float hi) { return pg8::cvt_pk_bf16(lo, hi); }
}

namespace rw {
typedef short s16x4 __attribute__((ext_vector_type(4)));
__device__ __forceinline__ bf16x8 fragN(const LAS unsigned char* img, int row, int ks, int fq) { return *(const LAS bf16x8*)(img + row * PITCH + ks * 64 + fq * 16); }
__device__ __forceinline__ bf16x8 fragP(const LAS unsigned char* img, int row, int ks, int fq) {
    const u32x2 a = *(const LAS u32x2*)(img + row * PITCH + (32 * ks + 4 * fq) * 2), b = *(const LAS u32x2*)(img + row * PITCH + (32 * ks + 16 + 4 * fq) * 2);
    const u32x4 v = (u32x4){a.x, a.y, b.x, b.y}; return __builtin_bit_cast(bf16x8, v); }
__device__ __forceinline__ bf16x8 fragT(const LAS unsigned char* img, int c0, int ks, int fr, int fq) {
    const LAS unsigned char* q = img + (32 * ks + 4 * fq + (fr >> 2)) * PITCH + (c0 + 4 * (fr & 3)) * 2;
    const s16x4 a = __builtin_amdgcn_ds_read_tr16_b64_v4i16((LAS s16x4*)q), b = __builtin_amdgcn_ds_read_tr16_b64_v4i16((LAS s16x4*)(q + 16 * PITCH));
    return (bf16x8){a[0], a[1], a[2], a[3], b[0], b[1], b[2], b[3]}; }
}

__device__ __forceinline__ void rw_chain_unit(const Params& p, LAS unsigned char* lds, int l, int unit, const int wvx) {
    using namespace rw;
    const int tid = opaque_tid(wvx), wave = __builtin_amdgcn_readfirstlane(tid >> 6);
    const int dir = unit & 1, h = (unit >> 1) & 7, b = unit >> 4;
    const bf16_t* proj = (const bf16_t*)(p.ws + OFF_PROJ);
    unsigned short* Y = (unsigned short*)(p.ws + (dir ? OFF_YB : OFF_YF));
    LAS float* gbuf = (LAS float*)(lds + O_GBUF);
    LAS float* GC = (LAS float*)(lds + O_GC);
    LAS bf16_t* TPP = (LAS bf16_t*)(lds + O_TPP);
    LAS float* CT = (LAS float*)(lds + O_CT);
    float* BON = (float*)(p.ws + OFF_BON) + (size_t)dir * NT * 8;
    const bf16_t* PR = (const bf16_t*)p.out;
    int* prep_ctr = (int*)(p.ws + OFF_CTL) + 32 + l * 16 + 8;
    __syncthreads();
    {
        const float* w2 = p.in[16] + ((size_t)l * 2 + dir) * 64 * 512 + h * 64; const float* a2 = p.in[18] + ((size_t)l * 2 + dir) * 64 * 512 + h * 64;
        for (int i = tid; i < 4096; i += NTHREADS) { const int r = i >> 6, n = i & 63;
            *(LAS bf16_t*)(lds + O_W2T + n * PITCH + r * 2) = (bf16_t)f2bf(-1.44269504f * w2[r * 512 + n]); *(LAS bf16_t*)(lds + O_A2T + n * PITCH + r * 2) = (bf16_t)f2bf(-1.44269504f * a2[r * 512 + n]); }
        for (int i = tid; i < MATB / 4; i += NTHREADS) ((LAS unsigned*)(lds + O_SB))[i] = 0u;
        for (int i = tid; i < 704; i += NTHREADS) { const int row = i >> 6, n = i & 63, col = h * 64 + n; float v;
            if (row < 6) v = 0.f;
            else if (row == 6) v = -1.44269504f * p.in[15][((size_t)l * 2 + dir) * 512 + col];
            else if (row == 7) v = -1.44269504f * p.in[17][((size_t)l * 2 + dir) * 512 + col];
            else if (row == 8) v = p.in[19][l * 512 + col];
            else if (row == 9) v = p.in[20][l * 512 + col];
            else v = p.in[21][l * 512 + col];
            CT[i] = v; }
    }
    const int rt = wave >> 1, chh = wave & 1;
    u32x4 pre[16];
    f32x4 acc_[16];
#define F4(x) __builtin_bit_cast(f32x4, (x))
#define U4(x) __builtin_bit_cast(u32x4, (x))
#define issue_rkv(CC, HALF) do { const int t0n_ = (dir ? (L / 64 - 1 - (CC)) : (CC)) * 64; int tq_ = tid; asm volatile("" : "+v"(tq_));     \
        const int ppn = ((tq_ & 255) >> 3) + 32 * (HALF); const int ttn = dir ? (t0n_ + 63 - ppn) : (t0n_ + ppn); const bf16_t* row = (wave >= 4) ? PR + ((size_t)b * L + ttn) * 512 + h * 64 + (tq_ & 7) * 8 : PR;     \
        _Pragma("unroll") for (int k = 0; k < 3; ++k) pre[4 * (HALF) + k] = *(const u32x4*)(row + (size_t)k * NT * 512); } while (0)
#define issue_lora(CC) do { const int t0n_ = (dir ? (L / 64 - 1 - (CC)) : (CC)) * 64; int tq_ = tid; asm volatile("" : "+v"(tq_)); \
        { const int kq_ = ((tq_ >> 4) & 3) * 8, cbase = (wave == 7 ? C_RA : C_RW) + dir * 64; \
          _Pragma("unroll") for (int r4 = 0; r4 < 4; ++r4) { const int pq_ = 16 * r4 + (tq_ & 15); const int ttn = dir ? (t0n_ + 63 - pq_) : (t0n_ + pq_); const bf16_t* row = (wave >= 5) ? proj + ((size_t)b * L + ttn) * IN_DP + cbase + kq_ : proj; \
            pre[8 + 2 * r4] = *(const u32x4*)(row); pre[9 + 2 * r4] = *(const u32x4*)(row + 32); } } } while (0)
    wg_wait(prep_ctr, 128, tid == 0);
    issue_lora(0); issue_rkv(0, 0); issue_rkv(0, 1);
#pragma unroll
    for (int q = 0; q < 16; ++q) acc_[q] = (f32x4){0.f, 0.f, 0.f, 0.f};
#pragma unroll 1
    for (int cc = -1; cc < L / 64; ++cc) {
        const bool cons = cc >= 0, prod = cc + 1 < L / 64;
        const int cn = cc + 1;
        const int cx = cn + 1 < L / 64 ? cn + 1 : L / 64 - 1;
        const int t0 = (dir ? (L / 64 - 1 - cc) : cc) * 64, t0n = (dir ? (L / 64 - 1 - cn) : cn) * 64;
        int tq = tid; asm volatile("" : "+v"(tq));
        const int fr = tq & 15, fq = (tq >> 4) & 3;
        const int bbn = (cn & 1) ? slot(9) : slot(7), bbc = (cc & 1) ? slot(9) : slot(7);
        if (cc + 2 < 64 && ((cc + 2) & 7) == 0) wg_wait(prep_ctr + ((cc + 2) >> 3), 128, tid == 0);
        __syncthreads();
        if (wave < 4) {
            if (cons) {
#pragma unroll
                for (int q = 0; q < 12; ++q) acc_[q] = (f32x4){0.f, 0.f, 0.f, 0.f};
                const bf16x8 s0 = fragN(lds + O_SB, 16 * wave + fr, 0, fq), s1 = fragN(lds + O_SB, 16 * wave + fr, 1, fq), v0 = fragT(lds + slot(6), 16 * wave, 0, fr, fq), v1 = fragT(lds + slot(6), 16 * wave, 1, fr, fq);
#pragma unroll
                for (int q = 0; q < 4; ++q) { f32x4 a = acc_[q];
                    a = MFMA16(fragN(lds + slot(3), 16 * q + fr, 0, fq), s0, a); a = MFMA16(fragN(lds + slot(3), 16 * q + fr, 1, fq), s1, a);
                    a = MFMA16(fragT(lds + slot(0), 16 * q, 0, fr, fq), v0, a); if (q >= 2) a = MFMA16(fragT(lds + slot(0), 16 * q, 1, fr, fq), v1, a);
                    acc_[q] = a;
                    f32x4 kx = acc_[4 + q]; kx = MFMA16(fragT(lds + slot(8), 16 * q, 0, fr, fq), v0, kx); kx = MFMA16(fragT(lds + slot(8), 16 * q, 1, fr, fq), v1, kx); acc_[4 + q] = kx;
                    f32x4 y = acc_[8 + q];
                    y = MFMA16(fragN(lds + slot(4), 16 * q + fr, 0, fq), s0, y); y = MFMA16(fragN(lds + slot(4), 16 * q + fr, 1, fq), s1, y);
                    y = MFMA16(fragT(lds + slot(2), 16 * q, 0, fr, fq), v0, y); if (q >= 2) y = MFMA16(fragT(lds + slot(2), 16 * q, 1, fr, fq), v1, y);
                    acc_[8 + q] = y;
                    asm volatile("" ::: "memory"); }
            }
        } else if (wave == 4) {
            if (cons) {
                const int pb = fq, j = fr; float T[16];
#pragma unroll
                for (int q = 0; q < 16; ++q) T[q] = (q == j) ? 1.f : 0.f;
#pragma unroll
                for (int sg = 0; sg < 4; ++sg) {
                    u32x4 ar[4][2];
#pragma unroll
                    for (int r4 = 0; r4 < 4; ++r4) { ar[r4][0] = *(const LAS u32x4*)(lds + slot(11) + (16 * pb + 4 * sg + r4) * PITCH + 32 * pb); ar[r4][1] = *(const LAS u32x4*)(lds + slot(11) + (16 * pb + 4 * sg + r4) * PITCH + 32 * pb + 16); }
#pragma unroll
                    for (int r4 = 0; r4 < 4; ++r4) { const int s2 = 4 * sg + r4; float av[16]; unpack8(ar[r4][0], av); unpack8(ar[r4][1], av + 8);
#pragma unroll
                        for (int q = s2 + 1; q < 16; ++q) T[q] += av[q] * T[s2]; }
                    asm volatile("" ::: "memory");
                }
#pragma unroll
                for (int q = 0; q < 16; ++q) TPP[(pb * 16 + q) * 20 + j] = (bf16_t)f2bf(T[q]);
            }
        } else if (wave <= 6) {
            if (prod) {
#pragma unroll
                for (int gi = 0; gi < 2; ++gi) { const int cgp = 2 * (wave - 5) + gi;
                    const float w0n = CT[6 * 64 + 16 * cgp + fr];
                    const bf16x8 wb0 = fragN(lds + O_W2T, 16 * cgp + fr, 0, fq), wb1 = fragN(lds + O_W2T, 16 * cgp + fr, 1, fq);
                    u32x2 lwp[4];
#pragma unroll
                    for (int r4 = 0; r4 < 4; ++r4) {
                        f32x4 wv = (f32x4){0.f, 0.f, 0.f, 0.f}; wv = MFMA16(__builtin_bit_cast(bf16x8, pre[8 + 2 * r4]), wb0, wv); wv = MFMA16(__builtin_bit_cast(bf16x8, pre[9 + 2 * r4]), wb1, wv);
                        float lwv[4];
#pragma unroll
                        for (int e = 0; e < 4; ++e) lwv[e] = -0.87503878f * frcp(1.0f + __builtin_amdgcn_exp2f(wv[e] + w0n));
                        lwp[r4] = (u32x2){pk2(lwv[0], lwv[1]), pk2(lwv[2], lwv[3])}; }
#pragma unroll
                    for (int r4 = 0; r4 < 4; ++r4) { f32x4 g = (f32x4){0.f, 0.f, 0.f, 0.f};
#pragma unroll
                        for (int ks = 0; ks < 2; ++ks) if (32 * ks <= 16 * r4 + 15) {
                            const int pa = 16 * r4 + fr - 32 * ks - 4 * fq, pb2 = pa - 16;
                            u32x4 lt; unsigned one2 = 0x3F803F80u; asm volatile("" : "+s"(one2));
                            lt.x = (pa >= 1 ? one2 : (pa == 0 ? 0x00003F80u : 0u)); lt.y = (pa >= 3 ? one2 : (pa == 2 ? 0x00003F80u : 0u));
                            lt.z = (pb2 >= 1 ? one2 : (pb2 == 0 ? 0x00003F80u : 0u)); lt.w = (pb2 >= 3 ? one2 : (pb2 == 2 ? 0x00003F80u : 0u));
                            const u32x4 bv = (u32x4){lwp[2 * ks].x, lwp[2 * ks].y, lwp[2 * ks + 1].x, lwp[2 * ks + 1].y};
                            g = MFMA16(__builtin_bit_cast(bf16x8, lt), __builtin_bit_cast(bf16x8, bv), g); }
#pragma unroll
                        for (int e = 0; e < 4; ++e) gbuf[(16 * r4 + 4 * fq + e) * 64 + 16 * cgp + fr] = g[e]; }
                    asm volatile("" ::: "memory"); }
            }
        } else {
            if (prod) {
#pragma unroll
                for (int cgp = 0; cgp < 4; ++cgp) {
                    const bf16x8 ab0 = fragN(lds + O_A2T, 16 * cgp + fr, 0, fq), ab1 = fragN(lds + O_A2T, 16 * cgp + fr, 1, fq);
#pragma unroll
                    for (int r4 = 0; r4 < 4; ++r4) { f32x4 av = (f32x4){0.f, 0.f, 0.f, 0.f};
                        av = MFMA16(__builtin_bit_cast(bf16x8, pre[8 + 2 * r4]), ab0, av); av = MFMA16(__builtin_bit_cast(bf16x8, pre[9 + 2 * r4]), ab1, av);
#pragma unroll
                        for (int e = 0; e < 4; ++e) *(LAS bf16_t*)(lds + slot(5) + (16 * r4 + 4 * fq + e) * PITCH + (16 * cgp + fr) * 2) = (bf16_t)f2bf(av[e]); }
                    asm volatile("" ::: "memory"); }
            }
        }
        __builtin_amdgcn_sched_barrier(0);
        issue_lora(cx);
        __syncthreads();
#define LD2(dst, ptr) do { const f32x4 _a = *(const LAS f32x4*)(ptr), _b = *(const LAS f32x4*)((ptr) + 4); dst[0] = (f32x2){_a.x, _a.y}; dst[1] = (f32x2){_a.z, _a.w}; dst[2] = (f32x2){_b.x, _b.y}; dst[3] = (f32x2){_b.z, _b.w}; } while (0)
#define UP2(dst, wsrc_) do { const u32x4 _w = (wsrc_); dst[0] = (f32x2){bf2f(_w.x & 0xffffu), __uint_as_float(_w.x & 0xffff0000u)}; dst[1] = (f32x2){bf2f(_w.y & 0xffffu), __uint_as_float(_w.y & 0xffff0000u)}; \
                         dst[2] = (f32x2){bf2f(_w.z & 0xffffu), __uint_as_float(_w.z & 0xffff0000u)}; dst[3] = (f32x2){bf2f(_w.w & 0xffffu), __uint_as_float(_w.w & 0xffff0000u)}; } while (0)
#define PK4(v) ((u32x4){pk2(v[0].x, v[0].y), pk2(v[1].x, v[1].y), pk2(v[2].x, v[2].y), pk2(v[3].x, v[3].y)})
#define S2_ITEM(HALF) do { \
            const int pp = ((tq & 255) >> 3) + 32 * (HALF), ig = tq & 7, i0 = ig * 8; \
            const int tt = dir ? (t0n + 63 - pp) : (t0n + pp);            \
            f32x2 r2[4], k2[4], a2v[4], kd2[4], kkr2[4], gi2[4], ge2[4]; \
            LD2(gi2, gbuf + pp * 64 + i0); \
            LD2(ge2, gbuf + (pp > 0 ? pp - 1 : 0) * 64 + i0);        \
            if (pp == 0) { ge2[0] = (f32x2){0.f, 0.f}; ge2[1] = ge2[0]; ge2[2] = ge2[0]; ge2[3] = ge2[0]; } \
            UP2(r2, pre[4 * (HALF) + 0]); UP2(k2, pre[4 * (HALF) + 1]);        \
            {   f32x2 c8[4]; LD2(c8, CT + 8 * 64 + i0); f32x2 ss2 = (f32x2){0.f, 0.f};        \
                _Pragma("unroll") for (int j2 = 0; j2 < 4; ++j2) { kkr2[j2] = k2[j2] * c8[j2]; ss2 += kkr2[j2] * kkr2[j2]; } \
                const float rn_ = __builtin_amdgcn_rsqf(fmaxf(sum8(ss2.x + ss2.y), 1e-24f)); \
                _Pragma("unroll") for (int j2 = 0; j2 < 4; ++j2) kkr2[j2] = kkr2[j2] * rn_; } \
            *(LAS u32x4*)(lds + slot(6) + pp * PITCH + ig * 16) = pre[4 * (HALF) + 2];        \
            {   f32x2 ap[4], c7[4]; \
                UP2(ap, *(const LAS u32x4*)(lds + slot(5) + pp * PITCH + ig * 16)); LD2(c7, CT + 7 * 64 + i0); \
                _Pragma("unroll") for (int j2 = 0; j2 < 4; ++j2) { const f32x2 araw = ap[j2] + c7[j2]; a2v[j2] = (f32x2){frcp(1.0f + __builtin_amdgcn_exp2f(araw.x)), frcp(1.0f + __builtin_amdgcn_exp2f(araw.y))}; } } \
            f32x2 bs2 = (f32x2){0.f, 0.f}; \
            {   f32x2 c9[4], c10[4]; LD2(c9, CT + 9 * 64 + i0); LD2(c10, CT + 10 * 64 + i0); \
                _Pragma("unroll") for (int j2 = 0; j2 < 4; ++j2) { kd2[j2] = k2[j2] * (1.0f + (a2v[j2] - 1.0f) * c9[j2]); bs2 += r2[j2] * kd2[j2] * c10[j2]; } } \
            { const float bs = sum8(bs2.x + bs2.y); if (ig == 0) ((LAS float*)(lds + O_BONS))[pp] = bs; }        \
            f32x2 At[4], Rt[4], Bb[4], Kb[4]; \
            _Pragma("unroll") for (int j2 = 0; j2 < 4; ++j2) { const f32x2 kk = kkr2[j2]; \
                const f32x2 ei = (f32x2){__builtin_amdgcn_exp2f(gi2[j2].x), __builtin_amdgcn_exp2f(gi2[j2].y)}, ee = (f32x2){__builtin_amdgcn_exp2f(ge2[j2].x), __builtin_amdgcn_exp2f(ge2[j2].y)}, inv = (f32x2){frcp(ei.x), frcp(ei.y)}; \
                At[j2] = -kk * ee; Rt[j2] = r2[j2] * ei; Bb[j2] = kk * a2v[j2] * inv; Kb[j2] = kd2[j2] * inv; \
                if ((HALF) == 1 && pp == 63) { GC[(cn & 1) * 64 + i0 + 2 * j2] = ei.x; GC[(cn & 1) * 64 + i0 + 2 * j2 + 1] = ei.y; } } \
            *(LAS u32x4*)(lds + slot(3) + pp * PITCH + ig * 16) = PK4(At); \
            *(LAS u32x4*)(lds + slot(4) + pp * PITCH + ig * 16) = PK4(Rt); \
            *(LAS u32x4*)(lds + bbn + pp * PITCH + ig * 16) = PK4(Bb); \
            *(LAS u32x4*)(lds + slot(8) + pp * PITCH + ig * 16) = PK4(Kb); } while (0)
        if (wave < 4) {
            if (cons) {
                u32x2 Ub[4];
                bf16x8 fa[4]; u32x2 ft[4];
#pragma unroll
                for (int z = 0; z < 4; ++z) { const int pb = (z == 3) ? 3 : z + 1, k2 = (z == 3) ? 1 : 0;
                    fa[z] = fragT(lds + slot(11), 16 * pb, k2, fr, fq);
                    ft[z] = *(const LAS u32x2*)(lds + O_TPP + ((z * 16 + fr) * 20 + 4 * fq) * 2); }
#pragma unroll
                for (int pb = 0; pb < 4; ++pb) {
                    f32x4 tmp = acc_[pb];
#pragma unroll
                    for (int k2 = 0; k2 < 2; ++k2) if (2 * k2 < pb) { const int z = (pb == 3 && k2 == 1) ? 3 : pb - 1;
                        const u32x2 b0 = Ub[2 * k2]; const u32x2 b1 = (2 * k2 + 1 < pb) ? Ub[2 * k2 + 1] : (u32x2){0u, 0u};
                        const u32x4 bv = (u32x4){b0.x, b0.y, b1.x, b1.y};
                        tmp = MFMA16(fa[z], __builtin_bit_cast(bf16x8, bv), tmp); }
                    const u32x4 av = (u32x4){ft[pb].x, ft[pb].y, 0u, 0u}, bv = (u32x4){pkbf(tmp[0], tmp[1]), pkbf(tmp[2], tmp[3]), 0u, 0u};
                    const f32x4 U = MFMA16(__builtin_bit_cast(bf16x8, av), __builtin_bit_cast(bf16x8, bv), ((f32x4){0.f, 0.f, 0.f, 0.f}));
                    Ub[pb] = (u32x2){pkbf(U[0], U[1]), pkbf(U[2], U[3])};
                    *(LAS u32x2*)(lds + slot(10) + (16 * wave + fr) * PITCH + (16 * pb + 4 * fq) * 2) = Ub[pb];
                }
            }
        } else { if (prod) S2_ITEM(0); }
        __builtin_amdgcn_sched_barrier(0);
        issue_rkv(cx, 0);
        __syncthreads();
        if (wave < 4) {
            if (cons) {
                const bf16x8 u0 = fragP(lds + slot(10), 16 * wave + fr, 0, fq), u1 = fragP(lds + slot(10), 16 * wave + fr, 1, fq);
#pragma unroll
                for (int q = 0; q < 4; ++q) { f32x4 a = acc_[8 + q];
                    a = MFMA16(fragT(lds + slot(1), 16 * q, 0, fr, fq), u0, a); if (q >= 2) a = MFMA16(fragT(lds + slot(1), 16 * q, 1, fr, fq), u1, a);
#pragma unroll
                    for (int e = 0; e < 4; ++e) *(LAS bf16_t*)(lds + slot(11) + (16 * q + 4 * fq + e) * PITCH + (16 * wave + fr) * 2) = (bf16_t)f2bf(a[e]); }
#pragma unroll
                for (int it = 0; it < 4; ++it) { f32x4 a = acc_[4 + it] + acc_[12 + it];
                    a = MFMA16(fragT(lds + bbc, 16 * it, 0, fr, fq), u0, a); a = MFMA16(fragT(lds + bbc, 16 * it, 1, fr, fq), u1, a);
                    const f32x4 gc = *(const LAS f32x4*)(GC + (cc & 1) * 64 + 16 * it + 4 * fq);
                    a = a * gc; acc_[12 + it] = a;
                    *(LAS u32x2*)(lds + O_SB + (16 * wave + fr) * PITCH + (16 * it + 4 * fq) * 2) = (u32x2){pkbf(a[0], a[1]), pkbf(a[2], a[3])};
                    asm volatile("" ::: "memory"); }
            }
        } else { if (prod) S2_ITEM(1); }
        __builtin_amdgcn_sched_barrier(0);
        issue_rkv(cx, 1);
#undef S2_ITEM
#undef PK4
#undef UP2
#undef LD2
        __syncthreads();
        if (cons) { const int lane = tq & 63, row = 32 * chh + (lane >> 1); const int ttp = dir ? (t0 + 63 - row) : (t0 + row);
            *(u32x4*)(Y + ((size_t)b * L + ttp) * 512 + h * 64 + 16 * rt + 8 * (lane & 1)) = *(const LAS u32x4*)(lds + slot(11) + row * PITCH + 32 * rt + 16 * (lane & 1)); }
        if (prod && tq < 64) BON[((size_t)b * 8 + h) * L + (dir ? (t0n + 63 - tq) : (t0n + tq))] = ((const LAS float*)(lds + O_BONS))[tq];
        if (prod) { const bf16x8 at0 = fragN(lds + slot(3), 16 * rt + fr, 0, fq), at1 = fragN(lds + slot(3), 16 * rt + fr, 1, fq), rt0 = fragN(lds + slot(4), 16 * rt + fr, 0, fq), rt1 = fragN(lds + slot(4), 16 * rt + fr, 1, fq);
#pragma unroll
          for (int ct = 0; ct < 2; ++ct) { const int ctt = 2 * chh + ct;
            f32x4 ab = (f32x4){0.f, 0.f, 0.f, 0.f}, ak = ab, rb = ab, rk = ab;
            if (ctt <= rt) {
                const bf16x8 b0 = fragN(lds + bbn, 16 * ctt + fr, 0, fq), b1 = fragN(lds + bbn, 16 * ctt + fr, 1, fq), k0 = fragN(lds + slot(8), 16 * ctt + fr, 0, fq), k1 = fragN(lds + slot(8), 16 * ctt + fr, 1, fq);
                ab = MFMA16(at0, b0, ab); ab = MFMA16(at1, b1, ab); ak = MFMA16(at0, k0, ak); ak = MFMA16(at1, k1, ak);
                rb = MFMA16(rt0, b0, rb); rb = MFMA16(rt1, b1, rb); rk = MFMA16(rt0, k0, rk); rk = MFMA16(rt1, k1, rk); }
            float vab[4], vak[4], vrb[4], vrk[4];
#pragma unroll
            for (int e = 0; e < 4; ++e) { const int prow = 16 * rt + 4 * fq + e, jcol = 16 * ctt + fr; const bool st = prow > jcol, inc = prow >= jcol;
                vab[e] = st ? ab[e] : 0.f; vak[e] = st ? ak[e] : 0.f; vrb[e] = inc ? rb[e] : 0.f; vrk[e] = inc ? rk[e] : 0.f; }
            const int off = (16 * ctt + fr) * PITCH + (16 * rt + 4 * fq) * 2;
            *(LAS u32x2*)(lds + slot(11) + off) = (u32x2){pkbf(vab[0], vab[1]), pkbf(vab[2], vab[3])};
            *(LAS u32x2*)(lds + slot(0) + off) = (u32x2){pkbf(vak[0], vak[1]), pkbf(vak[2], vak[3])};
            *(LAS u32x2*)(lds + slot(1) + off) = (u32x2){pkbf(vrb[0], vrb[1]), pkbf(vrb[2], vrb[3])};
            *(LAS u32x2*)(lds + slot(2) + off) = (u32x2){pkbf(vrk[0], vrk[1]), pkbf(vrk[2], vrk[3])}; } }
    }
    __syncthreads();
#undef issue_rkv
#undef issue_lora
#undef F4
#undef U4
}

constexpr int PT = 128;
__device__ __forceinline__ void rw_post_wg(const Params& p, LAS unsigned char* lds, int l, int G_, int bid, const int wvx) {
    const int tid = opaque_tid(wvx), lane = tid & 63, wave = __builtin_amdgcn_readfirstlane(tid >> 6), fr = lane & 15, fq = lane >> 4;
    const int h = bid & 7;
    const bf16_t* proj = (const bf16_t*)(p.ws + OFF_PROJ);
    const bf16_t* YF = (const bf16_t*)(p.ws + OFF_YF); const bf16_t* YB = (const bf16_t*)(p.ws + OFF_YB);
    const float* BONF = (const float*)(p.ws + OFF_BON); const float* BONB = BONF + (size_t)NT * 8;
    bf16_t* mix = (bf16_t*)(p.ws + OFF_MIX);
    constexpr int GP = 272;
    LAS unsigned char* G2T = lds;
    LAS unsigned char* SG = lds + 17408;
    LAS unsigned char* RAWV = lds + 52224;
    LAS unsigned char* GATE = lds + 68864;
    __syncthreads();
    { const float* g2 = p.in[22] + (size_t)l * 128 * 512 + h * 64;
        for (int i = tid; i < 8192; i += NTHREADS) { const int r = i >> 6, n = i & 63; *(LAS bf16_t*)(G2T + n * GP + r * 2) = (bf16_t)f2bf(g2[r * 512 + n]); } }
    const int ig = tid & 7, i0 = ig * 8, col = h * 64 + i0;
    float mv0[8], mv1[8], lnw[8], lnb[8];
#pragma unroll
    for (int j = 0; j < 8; ++j) { mv0[j] = p.in[14][(size_t)l * 3072 + 2 * 1024 + col + j]; mv1[j] = p.in[14][(size_t)l * 3072 + 2 * 1024 + 512 + col + j]; lnw[j] = p.in[23][l * 512 + col + j]; lnb[j] = p.in[24][l * 512 + col + j]; }
#pragma unroll 1
    for (int tile = bid >> 3; tile < NT / PT; tile += G_ >> 3) {
        const int row0 = tile * PT, tb0 = row0 & (L - 1);
        __syncthreads();
        u32x4 gq[4], vq[3]; u32x4 yq[2][2]; float bq[2];
#pragma unroll
        for (int k = 0; k < 4; ++k) { const int q = tid + k * NTHREADS; gq[k] = *(const u32x4*)(proj + (size_t)(row0 + (q >> 4)) * IN_DP + C_RG + (q & 15) * 8); }
#pragma unroll
        for (int k = 0; k < 3; ++k) { const int q = tid + k * NTHREADS; const int rr = q >> 3, ch = q & 7; const int tt = tb0 - 1 + rr; vq[k] = (u32x4){0u, 0u, 0u, 0u};
            if (q < 1040 && tt >= 0 && tt < L) vq[k] = *(const u32x4*)(proj + (size_t)(row0 - 1 + rr) * IN_DP + C_RV + h * 64 + ch * 8); }
#pragma unroll
        for (int sl = 0; sl < 2; ++sl) { const size_t row = (size_t)row0 + (tid >> 3) + 64 * sl; yq[sl][0] = *(const u32x4*)(YF + row * 512 + col); yq[sl][1] = *(const u32x4*)(YB + row * 512 + col);
            const size_t bi = ((size_t)(row >> 13) * 8 + h) * L + (row & (L - 1)); bq[sl] = BONF[bi] + BONB[bi]; }
#pragma unroll
        for (int k = 0; k < 4; ++k) { const int q = tid + k * NTHREADS; const int t = q >> 4, ch = q & 15; *(LAS u32x4*)(SG + t * GP + ch * 16) = gq[k]; }
#pragma unroll
        for (int k = 0; k < 3; ++k) { const int q = tid + k * NTHREADS; if (q < 1040) *(LAS u32x4*)(RAWV + (q >> 3) * 128 + (q & 7) * 16) = vq[k]; }
        __syncthreads();
#pragma unroll
        for (int ct = 0; ct < 4; ++ct) { f32x4 acc = (f32x4){0.f, 0.f, 0.f, 0.f};
#pragma unroll
            for (int ks = 0; ks < 4; ++ks) { const bf16x8 a = *(const LAS bf16x8*)(SG + (16 * wave + fr) * GP + ks * 64 + fq * 16); const bf16x8 b = *(const LAS bf16x8*)(G2T + (16 * ct + fr) * GP + ks * 64 + fq * 16);
                acc = __builtin_amdgcn_mfma_f32_16x16x32_bf16(a, b, acc, 0, 0, 0); }
#pragma unroll
            for (int e = 0; e < 4; ++e) *(LAS bf16_t*)(GATE + (16 * wave + 4 * fq + e) * 144 + (16 * ct + fr) * 2) = (bf16_t)f2bf(acc[e]); }
        __syncthreads();
#pragma unroll
        for (int sl = 0; sl < 2; ++sl) { const int t = (tid >> 3) + 64 * sl; const size_t row = (size_t)row0 + t;
            float vp[8], vc[8], vn[8], gt[8];
            unpack8(*(const LAS u32x4*)(RAWV + t * 128 + ig * 16), vp); unpack8(*(const LAS u32x4*)(RAWV + (t + 1) * 128 + ig * 16), vc); unpack8(*(const LAS u32x4*)(RAWV + (t + 2) * 128 + ig * 16), vn);
            unpack8(*(const LAS u32x4*)(GATE + t * 144 + ig * 16), gt);
            float yf8[8], yb8[8]; unpack8(yq[sl][0], yf8); unpack8(yq[sl][1], yb8);
            const float bon = bq[sl];
            float y[8] = {yf8[0] + yb8[0], yf8[1] + yb8[1], yf8[2] + yb8[2], yf8[3] + yb8[3], yf8[4] + yb8[4], yf8[5] + yb8[5], yf8[6] + yb8[6], yf8[7] + yb8[7]};
            float sm = 0.f;
#pragma unroll
            for (int j = 0; j < 8; ++j) sm += y[j];
            const float mean = sum8(sm) * (1.0f / 64.0f);
            float sq = 0.f;
#pragma unroll
            for (int j = 0; j < 8; ++j) { y[j] -= mean; sq += y[j] * y[j]; }
            const float rstd = __builtin_amdgcn_rsqf(sum8(sq) * (1.0f / 64.0f) + 64e-5f);
            float o[8];
#pragma unroll
            for (int j = 0; j < 8; ++j) { const float v = vc[j] + mv0[j] * (vp[j] - vc[j]) + mv1[j] * (vn[j] - vc[j]); o[j] = (y[j] * rstd * lnw[j] + lnb[j] + bon * v) * gt[j]; }
            u32x4 w; w.x = pk2(o[0], o[1]); w.y = pk2(o[2], o[3]); w.z = pk2(o[4], o[5]); w.w = pk2(o[6], o[7]);
            *(u32x4*)(mix + row * D + 256 + col) = w; }
    }
    __syncthreads();
}

namespace na {
constexpr int O_K = 0, O_V = 65536, O_RPB = 131072, O_MX = 133120, O_QW = 142080;
__device__ __forceinline__ int rowoff(int keycol, int byte) { return keycol * 128 + ((((byte >> 5) ^ keycol) & 3) << 5) + (byte & 31); }
typedef short s16x4 __attribute__((ext_vector_type(4)));
}
__device__ __forceinline__ void na_strip(const Params& p, LAS unsigned char* lds, int l, int strip, const int wvx) {
    using namespace na;
    const int tid = opaque_tid(wvx), lane = tid & 63, wave = __builtin_amdgcn_readfirstlane(tid >> 6), fr = lane & 15, fq = lane >> 4;
    const int b = strip >> 5, h = (strip >> 3) & 3, i0 = (strip & 7) * 16;
    const int g = wave & 3, kh = wave >> 2;
    const bf16_t* proj = (const bf16_t*)(p.ws + OFF_PROJ);
    bf16_t* mix = (bf16_t*)(p.ws + OFF_MIX);
    LAS float* RPB = (LAS float*)(lds + O_RPB);
    LAS unsigned char* MX = lds + O_MX + g * 2240;
    const int j0 = 16 * g, c0 = (g == 0) ? 0 : ((g == 3) ? 32 : 16 * g - 8);
    __syncthreads();
    for (int q = tid; q < 465; q += NTHREADS) RPB[q] = p.in[25][((size_t)l * 4 + h) * 465 + q];
    { int rs = i0 - 4; rs = rs < 0 ? 0 : (rs > 120 ? 120 : rs);
        u32x4 fw[16];
#pragma unroll
        for (int k = 0; k < 16; ++k) { const int q = tid + k * NTHREADS; const int r8 = q >> 10, which = (q >> 9) & 1, col = (q >> 3) & 63, ch = q & 7; const int kr = rs + r8;
            fw[k] = *(const u32x4*)(proj + ((size_t)b * L + kr * 64 + col) * IN_DP + (which ? C_NV : C_NK) + h * 64 + ch * 8); }
#pragma unroll
        for (int k = 0; k < 16; ++k) { const int q = tid + k * NTHREADS; const int r8 = q >> 10, which = (q >> 9) & 1, col = (q >> 3) & 63, ch = q & 7; const int kr = rs + r8;
            *(LAS u32x4*)(lds + (which ? O_V : O_K) + (kr & 7) * 8192 + rowoff(col, 16 * ch)) = fw[k]; } }
    bf16x8 Bq[2];
#pragma unroll
    for (int ks = 0; ks < 2; ++ks) Bq[ks] = *(const bf16x8*)(proj + ((size_t)b * L + i0 * 64 + j0 + fr) * IN_DP + C_NQ + h * 64 + 32 * ks + 8 * fq);
    const int jq = j0 + fr;
    int cs = jq - 8; cs = cs < 0 ? 0 : (cs > 48 ? 48 : cs);
    const u32x4 onesv = (u32x4){0x3F803F80u, 0x3F803F80u, 0x3F803F80u, 0x3F803F80u};
    float bias[4][2][4];
    int boff = 0x7fffffff;
#pragma unroll 1
    for (int i = i0; i < i0 + 16; ++i) {
        int rs = i - 4; rs = rs < 0 ? 0 : (rs > 120 ? 120 : rs);
        int rsn = i + 1 - 4; rsn = rsn < 0 ? 0 : (rsn > 120 ? 120 : rsn);
        const bool more = (i + 1 < i0 + 16), newrow = more && (rsn > rs);
        __syncthreads();
        u32x4 pre0 = (u32x4){0u, 0u, 0u, 0u}, pre1 = pre0; bf16x8 Bqn[2] = {Bq[0], Bq[1]};
        if (newrow) { const int kr = rsn + 7;
            { const int q = tid; const int which = q >> 9, col = (q >> 3) & 63, ch = q & 7; pre0 = *(const u32x4*)(proj + ((size_t)b * L + kr * 64 + col) * IN_DP + (which ? C_NV : C_NK) + h * 64 + ch * 8); }
            { const int q = tid + 512; const int which = q >> 9, col = (q >> 3) & 63, ch = q & 7; pre1 = *(const u32x4*)(proj + ((size_t)b * L + kr * 64 + col) * IN_DP + (which ? C_NV : C_NK) + h * 64 + ch * 8); } }
        if (more) {
#pragma unroll
            for (int ks = 0; ks < 2; ++ks) Bqn[ks] = *(const bf16x8*)(proj + ((size_t)b * L + (i + 1) * 64 + j0 + fr) * IN_DP + C_NQ + h * 64 + 32 * ks + 8 * fq); }
        if (rs - i != boff) { boff = rs - i;
#pragma unroll
            for (int r4 = 0; r4 < 4; ++r4) { const int dr = boff + 4 * kh + r4 + 7;
#pragma unroll
                for (int ct = 0; ct < 2; ++ct)
#pragma unroll
                    for (int e = 0; e < 4; ++e) { const int kc = c0 + 16 * ct + 4 * fq + e; const bool valid = (kc >= cs) && (kc < cs + 16);
                        int dc = kc - jq; dc = dc < -15 ? -15 : (dc > 15 ? 15 : dc); dc += 15;
                        bias[r4][ct][e] = valid ? RPB[dr * 31 + dc] * 1.44269504f : -1e30f; } } }
        f32x4 S[4][2]; float mloc = -1e30f;
#pragma unroll
        for (int r4 = 0; r4 < 4; ++r4) { const int krow = rs + 4 * kh + r4, slot = krow & 7;
#pragma unroll
            for (int ct = 0; ct < 2; ++ct) { const int keycol = c0 + 16 * ct + fr; f32x4 acc = (f32x4){0.f, 0.f, 0.f, 0.f};
#pragma unroll
                for (int ks = 0; ks < 2; ++ks) { const bf16x8 a = *(const LAS bf16x8*)(lds + O_K + slot * 8192 + rowoff(keycol, 64 * ks + 16 * fq)); acc = __builtin_amdgcn_mfma_f32_16x16x32_bf16(a, Bq[ks], acc, 0, 0, 0); }
#pragma unroll
                for (int e = 0; e < 4; ++e) { const float sc = acc[e] * (0.125f * 1.44269504f) + bias[r4][ct][e]; acc[e] = sc; mloc = fmaxf(mloc, sc); }
                S[r4][ct] = acc; } }
        { int lid; asm volatile("v_mbcnt_lo_u32_b32 %0, -1, 0\n\tv_mbcnt_hi_u32_b32 %0, -1, %0" : "=v"(lid));
          mloc = fmaxf(mloc, __int_as_float(__builtin_amdgcn_ds_bpermute((lid ^ 16) << 2, __float_as_int(mloc))));
          mloc = fmaxf(mloc, __int_as_float(__builtin_amdgcn_ds_bpermute((lid ^ 32) << 2, __float_as_int(mloc)))); }
        bf16x8 Ap[4];
#pragma unroll
        for (int r4 = 0; r4 < 4; ++r4) { float pv[8];
#pragma unroll
            for (int ct = 0; ct < 2; ++ct)
#pragma unroll
                for (int e = 0; e < 4; ++e) pv[ct * 4 + e] = __builtin_amdgcn_exp2f(S[r4][ct][e] - mloc);
            const u32x4 w = (u32x4){pk2(pv[0], pv[1]), pk2(pv[2], pv[3]), pk2(pv[4], pv[5]), pk2(pv[6], pv[7])}; Ap[r4] = __builtin_bit_cast(bf16x8, w); }
        f32x4 O[4], Ls = (f32x4){0.f, 0.f, 0.f, 0.f};
#pragma unroll
        for (int dt = 0; dt < 4; ++dt) O[dt] = (f32x4){0.f, 0.f, 0.f, 0.f};
#pragma unroll
        for (int r4 = 0; r4 < 4; ++r4) { const int slot = (rs + 4 * kh + r4) & 7; const int kc0 = c0 + 4 * fq + (fr >> 2), kc1 = kc0 + 16;
            Ls = __builtin_amdgcn_mfma_f32_16x16x32_bf16(Ap[r4], __builtin_bit_cast(bf16x8, onesv), Ls, 0, 0, 0);
#pragma unroll
            for (int dt = 0; dt < 4; ++dt) {
                const s16x4 v0 = __builtin_amdgcn_ds_read_tr16_b64_v4i16((LAS s16x4*)(lds + O_V + slot * 8192 + rowoff(kc0, 32 * dt + 8 * (fr & 3))));
                const s16x4 v1 = __builtin_amdgcn_ds_read_tr16_b64_v4i16((LAS s16x4*)(lds + O_V + slot * 8192 + rowoff(kc1, 32 * dt + 8 * (fr & 3))));
                const bf16x8 bv = (bf16x8){v0[0], v0[1], v0[2], v0[3], v1[0], v1[1], v1[2], v1[3]};
                O[dt] = __builtin_amdgcn_mfma_f32_16x16x32_bf16(Ap[r4], bv, O[dt], 0, 0, 0); } }
        if (fq == 0) *(LAS float*)(MX + kh * 64 + fr * 4) = mloc;
        if (kh == 1) { if (fr == 0) *(LAS f32x4*)(MX + 128 + fq * 16) = Ls;
#pragma unroll
            for (int dt = 0; dt < 4; ++dt)
#pragma unroll
                for (int e = 0; e < 4; ++e) *(LAS bf16_t*)(MX + 192 + (4 * fq + e) * 128 + (16 * dt + fr) * 2) = (bf16_t)f2bf(O[dt][e]); }
        __syncthreads();
        if (newrow) { const int kr = rsn + 7;
            { const int q = tid; const int which = q >> 9, col = (q >> 3) & 63, ch = q & 7; *(LAS u32x4*)(lds + (which ? O_V : O_K) + (kr & 7) * 8192 + rowoff(col, 16 * ch)) = pre0; }
            { const int q = tid + 512; const int which = q >> 9, col = (q >> 3) & 63, ch = q & 7; *(LAS u32x4*)(lds + (which ? O_V : O_K) + (kr & 7) * 8192 + rowoff(col, 16 * ch)) = pre1; } }
        if (kh == 0) {
            const f32x4 m0 = *(const LAS f32x4*)(MX + fq * 16), m1 = *(const LAS f32x4*)(MX + 64 + fq * 16), l1 = *(const LAS f32x4*)(MX + 128 + fq * 16);
#pragma unroll
            for (int e = 0; e < 4; ++e) { const float M = fmaxf(m0[e], m1[e]), a0 = __builtin_amdgcn_exp2f(m0[e] - M), a1 = __builtin_amdgcn_exp2f(m1[e] - M); const float inv = frcp(Ls[e] * a0 + l1[e] * a1);
                const size_t row = (size_t)b * L + i * 64 + j0 + 4 * fq + e;
#pragma unroll
                for (int dt = 0; dt < 4; ++dt) { const float o1 = bf2f(*(const LAS bf16_t*)(MX + 192 + (4 * fq + e) * 128 + (16 * dt + fr) * 2));
                    mix[row * D + 768 + h * 64 + 16 * dt + fr] = (bf16_t)f2bf((O[dt][e] * a0 + o1 * a1) * inv); } }
        }
        Bq[0] = Bqn[0]; Bq[1] = Bqn[1];
    }
    __syncthreads();
}

__device__ __forceinline__ void na_queue(const Params& p, LAS unsigned char* lds, int l, const int wvx) {
    int* ctr = (int*)(p.ws + OFF_CTL) + 16 + l;
    LAS int* qw = (LAS int*)(lds + na::O_QW);
    for (;;) {
        __syncthreads();
        if (opaque_tid(wvx) == 0) *qw = atomicAdd(ctr, 1);
        __syncthreads();
        const int strip = __builtin_amdgcn_readfirstlane(*qw);
        if (strip >= 256) break;
        na_strip(p, lds, l, strip, wvx);
    }
}

__device__ __forceinline__ void phase_router(const Params& p, LAS unsigned char* lds, int l, int G_, int bid, const int wvx) {
    const int tid = opaque_tid(wvx), lane = tid & 63, wave = __builtin_amdgcn_readfirstlane(tid >> 6), fr = lane & 15, fq = lane >> 4;
    const bf16_t* x = (const bf16_t*)(p.ws + OFF_XB); float* rs = (float*)(p.ws + OFF_RS);
    const bf16_t* rgh = (const bf16_t*)(p.ws + OFF_RGW) + (size_t)l * 2 * 48 * D; const bf16_t* rgl = rgh + 48 * D;
    int* cnt = (int*)(p.ws + OFF_CTL) + 64 + l * 64;
    int* ltok = (int*)(p.ws + OFF_LTOK); float* lgate = (float*)(p.ws + OFF_LGATE); float* lrs = (float*)(p.ws + OFF_LRS);
    LAS int* lcnt = (LAS int*)lds;
    LAS int* lbase = lcnt + 32;
    LAS int* se = lbase + 32;
    LAS int* sp = se + 512;
    LAS float* sg = (LAS float*)(sp + 512);
    LAS float* LG = (LAS float*)(lds + 8192);
    LAS float* SQ = LG + 256 * 52;
    const float* bg = p.in[29] + l * 4; const float* be = p.in[31] + l * 32;
    for (int chunk = bid; chunk < NT / 256; chunk += G_) {
        __syncthreads();
        if (tid < 32) lcnt[tid] = 0;
        const int tl0 = wave * 32;
        const bf16_t* xa_p = x + (size_t)(chunk * 256 + tl0 + fr) * D + 8 * fq; const bf16_t* xb_p = xa_p + 16 * D;
        constexpr int WSL = 81920, WPITCH = 528;
        f32x4 acc[2][3];
#pragma unroll
        for (int t = 0; t < 2; ++t)
#pragma unroll
            for (int c = 0; c < 3; ++c) acc[t][c] = (f32x4){0.f, 0.f, 0.f, 0.f};
        float ssa = 0.f, ssb = 0.f;
        u32x4 wq[6], aq[16];
#define RT_LOADW(SL) do { _Pragma("unroll") for (int k = 0; k < 6; ++k) { const int q = tid + k * NTHREADS; wq[k] = *(const u32x4*)(rgh + (size_t)(q >> 5) * D + (SL) * 256 + (q & 31) * 8); } } while (0)
#define RT_LOADA(K8, SL) do { aq[2 * (K8)] = *(const u32x4*)(xa_p + (SL) * 256 + 32 * (K8)); aq[2 * (K8) + 1] = *(const u32x4*)(xb_p + (SL) * 256 + 32 * (K8)); } while (0)
        RT_LOADW(0);
#pragma unroll
        for (int k8 = 0; k8 < 8; ++k8) RT_LOADA(k8, 0);
#pragma unroll
        for (int sl = 0; sl < 4; ++sl) {
#pragma unroll
            for (int k = 0; k < 6; ++k) { const int q = tid + k * NTHREADS; *(LAS u32x4*)(lds + WSL + (q >> 5) * WPITCH + (q & 31) * 16) = wq[k]; }
            __syncthreads();
            if (sl < 3) RT_LOADW(sl + 1);
#pragma unroll
            for (int k8 = 0; k8 < 8; ++k8) {
                const u32x4 ar = aq[2 * k8], br = aq[2 * k8 + 1];
                bf16x8 wh[3], wl[3];
#pragma unroll
                for (int c = 0; c < 3; ++c) { wh[c] = *(const LAS bf16x8*)(lds + WSL + (16 * c + fr) * WPITCH + k8 * 64 + fq * 16); wl[c] = *(const LAS bf16x8*)(lds + WSL + (48 + 16 * c + fr) * WPITCH + k8 * 64 + fq * 16); }
                { float f[8]; unpack8(ar, f);
#pragma unroll
                  for (int j = 0; j < 8; ++j) ssa += f[j] * f[j];
                  unpack8(br, f);
#pragma unroll
                  for (int j = 0; j < 8; ++j) ssb += f[j] * f[j]; }
                const bf16x8 a0 = __builtin_bit_cast(bf16x8, ar), a1 = __builtin_bit_cast(bf16x8, br);
#pragma unroll
                for (int c = 0; c < 3; ++c) {
                    acc[0][c] = __builtin_amdgcn_mfma_f32_16x16x32_bf16(a0, wh[c], acc[0][c], 0, 0, 0); acc[0][c] = __builtin_amdgcn_mfma_f32_16x16x32_bf16(a0, wl[c], acc[0][c], 0, 0, 0);
                    acc[1][c] = __builtin_amdgcn_mfma_f32_16x16x32_bf16(a1, wh[c], acc[1][c], 0, 0, 0); acc[1][c] = __builtin_amdgcn_mfma_f32_16x16x32_bf16(a1, wl[c], acc[1][c], 0, 0, 0); }
                if (sl < 3) RT_LOADA(k8, sl + 1);
            }
            __syncthreads();
        }
#undef RT_LOADW
#undef RT_LOADA
#pragma unroll
        for (int t = 0; t < 2; ++t)
#pragma unroll
            for (int c = 0; c < 3; ++c)
#pragma unroll
                for (int e = 0; e < 4; ++e) LG[(tl0 + 16 * t + 4 * fq + e) * 52 + 16 * c + fr] = acc[t][c][e];
        SQ[(tl0 + fr) * 4 + fq] = ssa; SQ[(tl0 + 16 + fr) * 4 + fq] = ssb;
        __syncthreads();
        if (lane < 32) { const int tl = tl0 + lane, row = chunk * 256 + tl;
            const f32x4 s4 = *(const LAS f32x4*)(SQ + tl * 4);
            const float rr = 1.0f / sqrtf(((s4.x + s4.y) + (s4.z + s4.w)) * (1.0f / D) + NORM_EPS);
            rs[row] = rr; SQ[tl * 4] = rr;
            const LAS float* lg = LG + tl * 52;
            const float g0 = lg[0] * rr + bg[0], g1 = lg[1] * rr + bg[1], g2 = lg[2] * rr + bg[2], g3 = lg[3] * rr + bg[3];
            int gs = 0; float gm = g0; if (g1 > gm) { gm = g1; gs = 1; } if (g2 > gm) { gm = g2; gs = 2; } if (g3 > gm) { gm = g3; gs = 3; }
            const float gprob = 1.0f / (expf(g0 - gm) + expf(g1 - gm) + expf(g2 - gm) + expf(g3 - gm));
            float ev[8];
#pragma unroll
            for (int e = 0; e < 8; ++e) ev[e] = lg[4 + gs * 8 + e] * rr + be[gs * 8 + e];
            int i0 = 0; float v0 = ev[0];
#pragma unroll
            for (int e = 1; e < 8; ++e) if (ev[e] > v0) { v0 = ev[e]; i0 = e; }
            int i1 = -1; float v1 = -3.0e38f;
#pragma unroll
            for (int e = 0; e < 8; ++e) if (e != i0 && ev[e] > v1) { v1 = ev[e]; i1 = e; }
            const float e1 = expf(v1 - v0), den = 1.0f + e1;
            const int ea = gs * 8 + i0, eb = gs * 8 + i1;
            se[tl * 2] = ea; se[tl * 2 + 1] = eb; sg[tl * 2] = gprob / den; sg[tl * 2 + 1] = gprob * e1 / den;
            sp[tl * 2] = atomicAdd((int*)lcnt + ea, 1); sp[tl * 2 + 1] = atomicAdd((int*)lcnt + eb, 1); }
        __syncthreads();
        if (tid < 32) lbase[tid] = atomicAdd(cnt + tid, lcnt[tid]);
        __syncthreads();
        { const int tl = tid >> 1, k = tid & 1, e = se[tid]; const size_t li = (size_t)e * LCAP + lbase[e] + sp[tid];
            ltok[li] = (chunk * 256 + tl) * 2 + k; lgate[li] = sg[tid]; lrs[li] = SQ[tl * 4]; }
    }
    __syncthreads();
}

__device__ __forceinline__ void phase_combine(const Params& p, bool last, int G_, int bid, const int wvx) {
    const int tid = opaque_tid(wvx), lane = tid & 63, wave = tid >> 6;
    float* out = p.out; bf16_t* x16 = (bf16_t*)(p.ws + OFF_XB); float* rs = (float*)(p.ws + OFF_RS);
    const bf16_t* yb = (const bf16_t*)(p.ws + OFF_YBUF);
    const float* gf = p.in[35];
    for (int row = bid * 8 + wave; row < NT; row += G_ * 8) {
        u32x2* xr = (u32x2*)(x16 + (size_t)row * D) + lane; const u32x2* y0 = (const u32x2*)(yb + (size_t)(2 * row) * D) + lane; const u32x2* y1 = (const u32x2*)(yb + (size_t)(2 * row + 1) * D) + lane;
        f32x4 v[4]; float s = 0.f; u32x2 xq[4], aq[4], cq[4];
#pragma unroll
        for (int j = 0; j < 4; ++j) { xq[j] = xr[64 * j]; aq[j] = y0[64 * j]; cq[j] = y1[64 * j]; }
#pragma unroll
        for (int j = 0; j < 4; ++j) { const u32x2 xx = xq[j], a = aq[j], c = cq[j];
            v[j].x = bf2f(xx.x & 0xffffu) + bf2f(a.x & 0xffffu) + bf2f(c.x & 0xffffu); v[j].y = __uint_as_float(xx.x & 0xffff0000u) + __uint_as_float(a.x & 0xffff0000u) + __uint_as_float(c.x & 0xffff0000u);
            v[j].z = bf2f(xx.y & 0xffffu) + bf2f(a.y & 0xffffu) + bf2f(c.y & 0xffffu); v[j].w = __uint_as_float(xx.y & 0xffff0000u) + __uint_as_float(a.y & 0xffff0000u) + __uint_as_float(c.y & 0xffff0000u);
            s += (v[j].x * v[j].x + v[j].y * v[j].y) + (v[j].z * v[j].z + v[j].w * v[j].w); }
        s = wave_sum(s);
        const float rr = 1.0f / sqrtf(s * (1.0f / D) + NORM_EPS);
        if (last) { f32x4* orow = (f32x4*)(out + (size_t)row * D) + lane;
#pragma unroll
            for (int j = 0; j < 4; ++j) { const f32x4 g = ((const f32x4*)gf)[lane + 64 * j]; orow[64 * j] = v[j] * rr * g; }
        } else {
            if (lane == 0) rs[row] = rr;
#pragma unroll
            for (int j = 0; j < 4; ++j) xr[64 * j] = (u32x2){pk2(v[j].x, v[j].y), pk2(v[j].z, v[j].w)};
        }
    }
}

#ifndef PH_MASK
#define PH_MASK 0xFFFFF
#endif
#define PH(k) if (PH_MASK & (1 << (k)))

#define XB_TMO      128
#define XB_XCNT(j)  (256  + 64 * (j))
#define XB_XSUB(j)  (1280 + 64 * (j))
#define XB_XGEN(j)  (2304 + 64 * (j))
#define XB_TOP      3328
#define XB_TOPGEN   3392
#define XCD_BAR_WORDS 3456
#define XB_SPIN_CAP (1u << 22)
__device__ __forceinline__ unsigned xb_ld(unsigned* p)              { return __hip_atomic_load(p, __ATOMIC_RELAXED, __HIP_MEMORY_SCOPE_AGENT); }
__device__ __forceinline__ unsigned xb_add(unsigned* p, unsigned v) { return __hip_atomic_fetch_add(p, v, __ATOMIC_RELAXED, __HIP_MEMORY_SCOPE_AGENT); }
__device__ __forceinline__ unsigned xb_xcc_id() { return (unsigned)__builtin_amdgcn_s_getreg((3 << 11) | 20) & 0xFu; }
#define XB_SPIN(cond, bar) do { unsigned _sp = 0; while (cond) { __builtin_amdgcn_s_sleep(1); \
    if ((++_sp & 255u) == 0u) { if (xb_ld(&(bar)[XB_TMO])) break; if (_sp > XB_SPIN_CAP) { atomicAdd(&(bar)[XB_TMO], 1u); break; } } } } while (0)
struct XcdBarrier { unsigned* bar; unsigned x; volatile LAS unsigned* st; };
__device__ __forceinline__ void xcd_barrier_complete(unsigned* bar, unsigned x, unsigned& nloc, unsigned& nx) {
    const unsigned G = gridDim.x * gridDim.y * gridDim.z;
    unsigned sum, cnt, mine, sp = 0u;
    for (;;) {
        sum = 0u; cnt = 0u; mine = 0u;
#pragma unroll
        for (unsigned j = 0; j < 16; ++j) { const unsigned c = xb_ld(&bar[XB_XCNT(j)]); sum += c; cnt += (c > 0u) ? 1u : 0u; mine = (j == x) ? c : mine; }
        if (sum == G) break;
        __builtin_amdgcn_s_sleep(1);
        if ((++sp & 255u) == 0u) { if (xb_ld(&bar[XB_TMO])) break; if (sp > XB_SPIN_CAP) { atomicAdd(&bar[XB_TMO], 1u); break; } }
    }
    nloc = mine > 0u ? mine : 1u; nx = cnt > 0u ? cnt : 1u;
}
__device__ __forceinline__ void xcd_barrier(const XcdBarrier& b, const bool leader) {
    asm volatile("s_waitcnt vmcnt(0)" ::: "memory");
    __syncthreads();
    if (leader) {
        unsigned* bar = b.bar;
        __builtin_amdgcn_s_waitcnt(0);
        unsigned nloc = b.st[0], nx = b.st[1];
        if (nloc == 0u) { xcd_barrier_complete(bar, b.x, nloc, nx); b.st[0] = nloc; b.st[1] = nx; }
        const unsigned old = xb_add(&bar[XB_XSUB(b.x)], 1u);
        const unsigned gen = old / nloc;
        if (old + 1u == (gen + 1u) * nloc) {
            __builtin_amdgcn_fence(__ATOMIC_RELEASE, "agent");
            asm volatile("s_waitcnt vmcnt(0)" ::: "memory");
            const unsigned og = xb_add(&bar[XB_TOP], 1u);
            const unsigned tg = og / nx;
            if (og + 1u == (tg + 1u) * nx) xb_add(&bar[XB_TOPGEN], 1u);
            else XB_SPIN(xb_ld(&bar[XB_TOPGEN]) == tg, bar);
            __builtin_amdgcn_fence(__ATOMIC_ACQUIRE, "agent");
            xb_add(&bar[XB_XGEN(b.x)], 1u);
            asm volatile("s_waitcnt vmcnt(0)" ::: "memory");
        } else {
            XB_SPIN(xb_ld(&bar[XB_XGEN(b.x)]) == gen, bar);
            __builtin_amdgcn_fence(__ATOMIC_ACQUIRE, "agent");
            asm volatile("s_waitcnt vmcnt(0)" ::: "memory");
        }
    }
    __syncthreads();
}

__device__ __forceinline__ Params load_params() {
#if defined(__HIP_DEVICE_COMPILE__)
    auto k = __builtin_amdgcn_kernarg_segment_ptr();
    asm volatile("" : "+s"(k));
    return *(const __attribute__((address_space(4))) Params*)k;
#else
    return Params{};
#endif
}
__global__ void __launch_bounds__(NTHREADS, 2) fwd_megakernel(Params p_unused) {
    extern __shared__ __attribute__((aligned(16))) unsigned char lds_raw[];
    LAS unsigned char* lds = (LAS unsigned char*)lds_raw;
    cg::grid_group grid = cg::this_grid();
    const int G_ = gridDim.x, bid = blockIdx.x;
    const int wvx = __builtin_amdgcn_readfirstlane((int)threadIdx.x >> 6);
    const bool leader = (threadIdx.x == 0);
    volatile LAS unsigned* bst = (volatile LAS unsigned*)(lds + LDS_BYTES - 16);
    if (leader) { bst[0] = 0u; bst[1] = 0u; }
    XcdBarrier xbar;
    { const Params p = load_params(); xbar.bar = (unsigned*)(p.ws + OFF_CTL) + 4096; xbar.x = xb_xcc_id(); xbar.st = bst;
      if (leader) (void)xb_add(&xbar.bar[XB_XCNT(xbar.x)], 1u); }
    __syncthreads();
#define GRID_BAR() do { const Params pb = load_params(); XcdBarrier xb2; xb2.bar = (unsigned*)(pb.ws + OFF_CTL) + 4096; xb2.x = xb_xcc_id(); xb2.st = bst; xcd_barrier(xb2, opaque_tid(wvx) == 0); } while (0)

    { const Params p = load_params(); PH(0) phase_prologue(p, lds, G_, bid, wvx); }
    { const Params p = load_params(); PH(0) filters_all(p, G_, bid, wvx); }
    { const Params p = load_params(); PH(1) phase_rownorm(p.in[0], (bf16_t*)(p.ws + OFF_XB), (float*)(p.ws + OFF_RS), G_, bid, wvx); }
    grid.sync();

#pragma unroll 1
    for (int l = 0; l < DEPTH; ++l) {
        PH(2) { const Params p = load_params(); unsigned char* ws = p.ws;
            DenseSched S; S.init((const bf16_t*)(ws + OFF_XB), (const bf16_t*)(ws + OFF_WTIN) + (size_t)l * IN_DP * D, NT, IN_DP, D, G_, bid);
            EpiProj E{(bf16_t*)(ws + OFF_PROJ), (const float*)(ws + OFF_RS)};
            pg8::gemm_phase<EpiProj, DenseSched, false>(lds, D, S, E, wvx);
        }
        GRID_BAR();
        {
            const bool lead = (opaque_tid(wvx) == 0);
            LAS int* qw = (LAS int*)(lds + na::O_QW);
#define CTR(k) ((int*)(load_params().ws + OFF_CTL) + 32 + l * 16 + (k))
            if (bid >= 128) {
                PH(3) for (;;) { const int u = wg_pop(CTR(0), qw, lead, 4); if (u >= 1024) break; { const Params p = load_params(); hy_weights_to_lds(p, lds, l, wvx); } for (int j = 0; j < 4; ++j) { const Params p = load_params(); hy_pre_unit4(p, lds, l, u + j, wvx); } wg_signal(CTR(1), lead, 4); }
            }
            PH(5) { for (int j = 0; j < 4; ++j) { const Params p = load_params(); rw_prep_unit(p, l, 4 * bid + j, wvx); } wg_signal(CTR(8 + (bid >> 5)), lead, 4); }
            if (bid < 128) { PH(5) { const Params p = load_params(); rw_chain_unit(p, lds, l, bid, wvx); } }
            wg_wait(CTR(1), 1024, lead);
            if (bid >= 128) { PH(4) for (int c = bid - 128; c < 256; c += 128) { { const Params p = load_params(); hy_conv_unit(p, lds, l, c, wvx); } wg_signal(CTR(2), lead); } }
            PH(6) { const Params p = load_params(); na_queue(p, lds, l, wvx); }
            wg_wait(CTR(2), 256, lead);
            PH(7) for (;;) { const int u = wg_pop(CTR(3), qw, lead, 4); if (u >= 1024) break; { const Params p = load_params(); hy_weights_to_lds(p, lds, l, wvx); } for (int j = 0; j < 4; ++j) { const Params p = load_params(); hy_post_unit4(p, lds, l, u + j, wvx); } wg_signal(CTR(4), lead, 4); }
            wg_wait(CTR(4), 1024, lead);
            PH(10) for (;;) { const int u = wg_pop(CTR(5), qw, lead); if (u >= NEXP * 768 / 64 + (l == 0 ? 43 : 0)) break; { const Params p = load_params(); moe_weights_chunk(p, lds, l, u, wvx); } }
#undef CTR
        }
        GRID_BAR();
        PH(8) { const Params p = load_params(); rw_post_wg(p, lds, l, G_, bid, wvx); }
        GRID_BAR();
        PH(9) { const Params p = load_params(); unsigned char* ws = p.ws;
            DenseSched S; S.init((const bf16_t*)(ws + OFF_MIX), (const bf16_t*)(ws + OFF_WTOUT) + (size_t)l * D * D, NT, D, D, G_, bid);
            EpiRes E{(bf16_t*)(ws + OFF_XB)};
            pg8::gemm_phase<EpiRes, DenseSched, false>(lds, D, S, E, wvx);
        }
        GRID_BAR();
        PH(11) { const Params p = load_params(); phase_router(p, lds, l, G_, bid, wvx); }
        GRID_BAR();
        PH(12) { const Params p = load_params(); unsigned char* ws = p.ws;
            const int* cnt = (const int*)(ws + OFF_CTL) + 64 + l * 64;
            MoeSched S; S.init(cnt, (const bf16_t*)(ws + OFF_XB), (const bf16_t*)(ws + OFF_W13T), (size_t)1024 * D, (const int*)(ws + OFF_LTOK), D, G_, bid, (LAS int*)(lds + 139264), opaque_tid(wvx));
            EpiMoe1 E{(bf16_t*)(ws + OFF_ACT), (const float*)(ws + OFF_LRS)};
            pg8::gemm_phase<EpiMoe1, MoeSched, true>(lds, D, S, E, wvx);
        }
        GRID_BAR();
        PH(13) { const Params p = load_params(); unsigned char* ws = p.ws;
            const int* cnt = (const int*)(ws + OFF_CTL) + 64 + l * 64;
            MoeSched S; S.init(cnt, (const bf16_t*)(ws + OFF_ACT), (const bf16_t*)(ws + OFF_W2T), (size_t)D * FF, nullptr, FF, G_, bid, (LAS int*)(lds + 139264), opaque_tid(wvx));
            EpiMoe2 E{(bf16_t*)(ws + OFF_YBUF), (const int*)(ws + OFF_LTOK), (const float*)(ws + OFF_LGATE)};
            pg8::gemm_phase<EpiMoe2, MoeSched, false>(lds, FF, S, E, wvx);
        }
        GRID_BAR();
        PH(14) { const Params p = load_params(); phase_combine(p, l == DEPTH - 1, G_, bid, wvx); }
        if (l < DEPTH - 1) GRID_BAR();
    }
}

extern "C" void kernel_launch(void* const* d_in, const int* in_sizes, int n_in, void* d_out, int out_size, void* d_ws, size_t ws_size, hipStream_t stream) {
    static int grid = 0;
    if (grid == 0) {
        if (n_in != 36 || ws_size < WS_END) { fprintf(stderr, "kernel_launch: unexpected n_in %d / ws_size %zu (need %zu)\n", n_in, ws_size, (size_t)WS_END); grid = -1; return; }
        int dev = 0, cus = 0, per_cu = 0;
        hipGetDevice(&dev);
        hipDeviceGetAttribute(&cus, hipDeviceAttributeMultiprocessorCount, dev);
        hipFuncSetAttribute((const void*)fwd_megakernel, hipFuncAttributeMaxDynamicSharedMemorySize, LDS_BYTES);
        hipOccupancyMaxActiveBlocksPerMultiprocessor(&per_cu, (const void*)fwd_megakernel, NTHREADS, LDS_BYTES);
        if (per_cu < 1) { fprintf(stderr, "kernel_launch: occupancy query says %d blocks per CU\n", per_cu); per_cu = 1; }
        if (per_cu > 1) per_cu = 1;
        grid = cus * per_cu;
        if (grid != 256) { fprintf(stderr, "kernel_launch: this kernel needs exactly 256 co-resident workgroups (got %d)\n", grid); if (grid > 256) grid = 256; }
        fprintf(stderr, "kernel_launch: grid %d (cus %d), ws %zu\n", grid, cus, ws_size);
    }
    if (grid < 0) return;
    hipMemsetAsync((char*)d_ws + OFF_CTL, 0, 65536, stream);
    Params p{};
    for (int i = 0; i < 36; ++i) p.in[i] = (const float*)d_in[i];
    p.out = (float*)d_out; p.ws = (unsigned char*)d_ws;
    void* args[] = {&p};
    hipError_t e = hipLaunchCooperativeKernel((const void*)fwd_megakernel, dim3(grid), dim3(NTHREADS), args, LDS_BYTES, stream);
    if (e != hipSuccess) fprintf(stderr, "cooperative launch failed: %s (grid %d)\n", hipGetErrorString(e), grid);
}
```
